# Optimizing an MI355X kernel written in HIP

```python
import math
import jax, jax.numpy as jnp
from jax import lax
import numpy as np

D_MODEL = 2048
BATCH = 2
SEQ = 4096
DEPTH = 2

MLA_HEADS = 8
MLA_Q_LORA = 512
MLA_KV_LORA = 512
MLA_NOPE_DIM = 128
MLA_ROPE_DIM = 64
MLA_V_DIM = 128
DSA_HEADS = 8
DSA_HEAD_DIM = 128
DSA_ROPE_DIM = DSA_HEAD_DIM // 4
IDX_HEADS = 16
IDX_DIM = 64
IDX_ROPE_DIM = IDX_DIM // 4
DSA_MAX_TOPK = 256
ROPE_THETA = 500000.0
IN_SPLIT_WIDTHS = (MLA_Q_LORA, MLA_KV_LORA, MLA_ROPE_DIM,
                   DSA_HEADS * DSA_HEAD_DIM, DSA_HEADS * DSA_HEAD_DIM, DSA_HEADS * DSA_HEAD_DIM,
                   IDX_HEADS * IDX_DIM, IDX_DIM, IDX_HEADS,
                   D_MODEL, D_MODEL)
IN_WIDTH = sum(IN_SPLIT_WIDTHS)
N_GROUPS = 8
EXPERTS_PER_GROUP = 8
N_EXPERTS = N_GROUPS * EXPERTS_PER_GROUP
TOPK_IN_GROUP = 2
D_EXPERT = 512
Q_BLOCK = 128
MOE_ROW_BLOCK = 128
DEEPNORM_ALPHA = (2 * DEPTH) ** 0.25
DEEPNORM_BETA = (8 * DEPTH) ** -0.25
LN_EPS = 1e-5
RMS_EPS = 1e-6

kernel_name = "hybrid_mla_dsa_hmoe_deepnorm"


def _layer_norm(x, g, b):
    xf = x.astype(jnp.float32)
    mu = jnp.mean(xf, axis=-1, keepdims=True)
    var = jnp.mean(jnp.square(xf - mu), axis=-1, keepdims=True)
    y = (xf - mu) * lax.rsqrt(var + LN_EPS) * g.astype(jnp.float32) + b.astype(jnp.float32)
    return y.astype(x.dtype)


def _rms_norm(x, g):
    xf = x.astype(jnp.float32)
    y = xf * lax.rsqrt(jnp.mean(jnp.square(xf), axis=-1, keepdims=True) + RMS_EPS) * g.astype(jnp.float32)
    return y.astype(x.dtype)


def _rope_tables(positions, rot_dim):
    inv = ROPE_THETA ** (-jnp.arange(0, rot_dim, 2, dtype=jnp.float32) / rot_dim)
    ang = positions.astype(jnp.float32)[..., None] * inv
    return jnp.cos(ang)[:, :, None, :], jnp.sin(ang)[:, :, None, :]


def _apply_rope(x, cos, sin):
    half = cos.shape[-1]
    rot = 2 * half
    c = cos.astype(x.dtype)
    s = sin.astype(x.dtype)
    x1 = x[..., :half]
    x2 = x[..., half:rot]
    return jnp.concatenate([x1 * c - x2 * s, x2 * c + x1 * s, x[..., rot:]], axis=-1)


def _split_points():
    pts, acc = [], 0
    for w in IN_SPLIT_WIDTHS[:-1]:
        acc += w
        pts.append(acc)
    return pts


def _to_query_blocks(a):
    B, S = a.shape[0], a.shape[1]
    return jnp.swapaxes(a.reshape((B, S // Q_BLOCK, Q_BLOCK) + a.shape[2:]), 0, 1)


def _from_query_blocks(o):
    o = jnp.swapaxes(o, 0, 1)
    B, nb, qb, H, d = o.shape
    return o.reshape(B, nb * qb, H * d)


def _causal_block_attention(q, k, v, positions, scale):
    def one(args):
        qi, pi = args
        s = jnp.einsum('bqhd,bkhd->bhqk', qi, k).astype(jnp.float32) * scale
        mask = positions[:, None, None, :] <= pi[:, None, :, None]
        p = jax.nn.softmax(jnp.where(mask, s, -jnp.inf), axis=-1).astype(v.dtype)
        return jnp.einsum('bhqk,bkhd->bqhd', p, v)
    o = lax.map(one, (_to_query_blocks(q), _to_query_blocks(positions)))
    return _from_query_blocks(o)


def _gather_rows(arr, idx):
    return jax.vmap(lambda a, i: a[i])(arr, idx)


def _indexed_sparse_attention(q, k, v, q_idx, k_idx, w_idx, positions, scale):
    n_keys = k.shape[1]
    top_k = min(DSA_MAX_TOPK, n_keys // 4)

    def one(args):
        qi, qii, wi, pi = args
        rel = jax.nn.relu(jnp.einsum('bqhd,bsd->bqhs', qii, k_idx).astype(jnp.float32))
        score = jnp.einsum('bqhs,bqh->bqs', rel, wi.astype(jnp.float32))
        causal = positions[:, None, :] <= pi[:, :, None]
        score = jnp.where(causal, score, -jnp.inf)
        _, idx = lax.top_k(score, top_k)
        k_sel = _gather_rows(k, idx)
        v_sel = _gather_rows(v, idx)
        p_sel = _gather_rows(positions, idx)
        s = jnp.einsum('bqhd,bqkhd->bhqk', qi, k_sel).astype(jnp.float32) * scale
        valid = (p_sel <= pi[:, :, None])[:, None, :, :]
        p = jax.nn.softmax(jnp.where(valid, s, -jnp.inf), axis=-1).astype(v.dtype)
        return jnp.einsum('bhqk,bqkhd->bqhd', p, v_sel)

    o = lax.map(one, (_to_query_blocks(q), _to_query_blocks(q_idx),
                      _to_query_blocks(w_idx), _to_query_blocks(positions)))
    return _from_query_blocks(o)


def _hybrid_mixer(h, positions, ropes, w_in, g_q_lora, w_q_b, g_kv_lora, w_kv_b, w_o_a, w_o_b, w_out):
    B, S, _ = h.shape
    (cos_mla, sin_mla), (cos_dsa, sin_dsa), (cos_idx, sin_idx) = ropes
    proj = h @ w_in
    (c_q, c_kv, k_pe, q_b, k_b, v_b, q_idx, k_idx, w_idx, gate_a, gate_b) = jnp.split(
        proj, _split_points(), axis=-1)

    q_a = (_rms_norm(c_q, g_q_lora) @ w_q_b).reshape(B, S, MLA_HEADS, MLA_NOPE_DIM + MLA_ROPE_DIM)
    q_nope, q_pe = q_a[..., :MLA_NOPE_DIM], q_a[..., MLA_NOPE_DIM:]
    q_pe = _apply_rope(q_pe, cos_mla, sin_mla)
    kv = (_rms_norm(c_kv, g_kv_lora) @ w_kv_b).reshape(B, S, MLA_HEADS, MLA_NOPE_DIM + MLA_V_DIM)
    k_nope, v_a = kv[..., :MLA_NOPE_DIM], kv[..., MLA_NOPE_DIM:]
    k_pe = _apply_rope(k_pe[:, :, None, :], cos_mla, sin_mla)
    k_a = jnp.concatenate([k_nope, jnp.broadcast_to(k_pe, (B, S, MLA_HEADS, MLA_ROPE_DIM))], axis=-1)
    q_a = jnp.concatenate([q_nope, q_pe], axis=-1)
    o_a = _causal_block_attention(q_a, k_a, v_a, positions,
                                  (MLA_NOPE_DIM + MLA_ROPE_DIM) ** -0.5)

    q_b = _apply_rope(q_b.reshape(B, S, DSA_HEADS, DSA_HEAD_DIM), cos_dsa, sin_dsa)
    k_b = _apply_rope(k_b.reshape(B, S, DSA_HEADS, DSA_HEAD_DIM), cos_dsa, sin_dsa)
    v_b = v_b.reshape(B, S, DSA_HEADS, DSA_HEAD_DIM)
    q_idx = _apply_rope(q_idx.reshape(B, S, IDX_HEADS, IDX_DIM), cos_idx, sin_idx)
    k_idx = _apply_rope(k_idx[:, :, None, :], cos_idx, sin_idx)[:, :, 0, :]
    w_idx = w_idx * ((IDX_HEADS ** -0.5) * (IDX_DIM ** -0.5))
    o_b = _indexed_sparse_attention(q_b, k_b, v_b, q_idx, k_idx, w_idx, positions,
                                    DSA_HEAD_DIM ** -0.5)

    y = jax.nn.sigmoid(gate_a) * (o_a @ w_o_a) + jax.nn.sigmoid(gate_b) * (o_b @ w_o_b)
    return y @ w_out


def _hierarchical_moe(h, w_group, b_group, w_router, b_router, w_gate, w_up, w_down):
    B, S, D = h.shape
    t = h.reshape(-1, D)
    T = t.shape[0]
    g_prob = jax.nn.softmax((t @ w_group + b_group).astype(jnp.float32), axis=-1)
    g_p, g_idx = lax.top_k(g_prob, 1)
    e_logits = (t @ w_router + b_router).astype(jnp.float32).reshape(T, N_GROUPS, EXPERTS_PER_GROUP)
    in_group = jnp.take_along_axis(e_logits, g_idx[:, :, None], axis=1)[:, 0]
    e_p, e_local = lax.top_k(jax.nn.softmax(in_group, axis=-1), TOPK_IN_GROUP)
    e_p = e_p / jnp.sum(e_p, axis=-1, keepdims=True)
    weights = g_p * e_p
    expert_ids = g_idx * EXPERTS_PER_GROUP + e_local

    A = T * TOPK_IN_GROUP
    flat_e = expert_ids.reshape(-1).astype(jnp.int32)
    flat_tok = jnp.repeat(jnp.arange(T, dtype=jnp.int32), TOPK_IN_GROUP)
    flat_w = weights.reshape(-1)
    order = jnp.argsort(flat_e)
    se = flat_e[order]
    counts = jnp.bincount(flat_e, length=N_EXPERTS)
    starts = jnp.cumsum(counts) - counts
    padded = ((counts + MOE_ROW_BLOCK - 1) // MOE_ROW_BLOCK) * MOE_ROW_BLOCK
    pends = jnp.cumsum(padded)
    pstarts = pends - padded
    dest = pstarts[se] + (jnp.arange(A, dtype=jnp.int32) - starts[se])
    n_blocks = -(-A // MOE_ROW_BLOCK) + N_EXPERTS
    P = n_blocks * MOE_ROW_BLOCK
    row_tok = jnp.zeros((P,), jnp.int32).at[dest].set(flat_tok[order])
    row_w = jnp.zeros((P,), jnp.float32).at[dest].set(flat_w[order])
    block_e = jnp.minimum(jnp.searchsorted(pends, jnp.arange(n_blocks) * MOE_ROW_BLOCK, side='right'),
                          N_EXPERTS - 1).astype(jnp.int32)

    def expert_block(args):
        tok, w, e = args
        xb = t[tok]
        hid = jax.nn.silu(xb @ w_gate[e]) * (xb @ w_up[e])
        return ((hid @ w_down[e]) * w[:, None]).astype(t.dtype)

    ys = lax.map(expert_block, (row_tok.reshape(n_blocks, MOE_ROW_BLOCK),
                                row_w.reshape(n_blocks, MOE_ROW_BLOCK), block_e))
    out = jnp.zeros((T, D), t.dtype).at[row_tok].add(ys.reshape(P, D))
    return out.reshape(B, S, D)


def setup_inputs(seed: int = 0) -> dict:
    key = jax.random.key(seed)
    ks = jax.random.split(key, 21)
    f32 = jnp.float32
    n = lambda k, shape, scale: jax.random.normal(k, shape, f32) * scale
    x = jax.random.normal(ks[0], (BATCH, SEQ, D_MODEL), f32)
    offsets = jax.random.randint(ks[1], (BATCH, 1), 0, 2048, dtype=jnp.int32)
    positions = (offsets + jnp.arange(SEQ, dtype=jnp.int32)[None, :]).astype(jnp.int32)
    return {
        "x": x,
        "positions": positions,
        "w_in": n(ks[2], (DEPTH, D_MODEL, IN_WIDTH), D_MODEL ** -0.5),
        "g_q_lora": 1.0 + n(ks[3], (DEPTH, MLA_Q_LORA), 0.02),
        "w_q_b": n(ks[4], (DEPTH, MLA_Q_LORA, MLA_HEADS * (MLA_NOPE_DIM + MLA_ROPE_DIM)), MLA_Q_LORA ** -0.5),
        "g_kv_lora": 1.0 + n(ks[5], (DEPTH, MLA_KV_LORA), 0.02),
        "w_kv_b": n(ks[6], (DEPTH, MLA_KV_LORA, MLA_HEADS * (MLA_NOPE_DIM + MLA_V_DIM)), MLA_KV_LORA ** -0.5),
        "w_o_a": n(ks[7], (DEPTH, MLA_HEADS * MLA_V_DIM, D_MODEL), (MLA_HEADS * MLA_V_DIM) ** -0.5),
        "w_o_b": n(ks[8], (DEPTH, DSA_HEADS * DSA_HEAD_DIM, D_MODEL), (DSA_HEADS * DSA_HEAD_DIM) ** -0.5),
        "w_out": n(ks[9], (DEPTH, D_MODEL, D_MODEL), DEEPNORM_BETA * D_MODEL ** -0.5),
        "ln1_g": 1.0 + n(ks[10], (DEPTH, D_MODEL), 0.02),
        "ln1_b": n(ks[11], (DEPTH, D_MODEL), 0.02),
        "w_group": n(ks[12], (DEPTH, D_MODEL, N_GROUPS), D_MODEL ** -0.5),
        "b_group": n(ks[13], (DEPTH, N_GROUPS), 0.01),
        "w_router": n(ks[14], (DEPTH, D_MODEL, N_EXPERTS), D_MODEL ** -0.5),
        "b_router": n(ks[15], (DEPTH, N_EXPERTS), 0.01),
        "w_e_gate": n(ks[16], (DEPTH, N_EXPERTS, D_MODEL, D_EXPERT), D_MODEL ** -0.5),
        "w_e_up": n(ks[17], (DEPTH, N_EXPERTS, D_MODEL, D_EXPERT), D_MODEL ** -0.5),
        "w_e_down": n(ks[18], (DEPTH, N_EXPERTS, D_EXPERT, D_MODEL), DEEPNORM_BETA * D_EXPERT ** -0.5),
        "ln2_g": 1.0 + n(ks[19], (DEPTH, D_MODEL), 0.02),
        "ln2_b": n(ks[20], (DEPTH, D_MODEL), 0.02),
    }


def reference(x, positions, w_in, g_q_lora, w_q_b, g_kv_lora, w_kv_b, w_o_a, w_o_b, w_out,
              ln1_g, ln1_b, w_group, b_group, w_router, b_router, w_e_gate, w_e_up, w_e_down,
              ln2_g, ln2_b):
    ropes = (_rope_tables(positions, MLA_ROPE_DIM),
             _rope_tables(positions, DSA_ROPE_DIM),
             _rope_tables(positions, IDX_ROPE_DIM))
    h = x
    for l in range(DEPTH):
        mix = _hybrid_mixer(h, positions, ropes, w_in[l], g_q_lora[l], w_q_b[l], g_kv_lora[l],
                            w_kv_b[l], w_o_a[l], w_o_b[l], w_out[l])
        h = _layer_norm(DEEPNORM_ALPHA * h + mix, ln1_g[l], ln1_b[l])
        ff = _hierarchical_moe(h, w_group[l], b_group[l], w_router[l], b_router[l],
                               w_e_gate[l], w_e_up[l], w_e_down[l])
        h = _layer_norm(DEEPNORM_ALPHA * h + ff, ln2_g[l], ln2_b[l])
    return h
```

```cpp
#include <hip/hip_runtime.h>
#include <cstdio>
#include <cstdint>

typedef unsigned short bf16_t;
typedef float f32x4 __attribute__((ext_vector_type(4)));
typedef unsigned u32x4 __attribute__((ext_vector_type(4)));
typedef unsigned u32x2 __attribute__((ext_vector_type(2)));

constexpr int T = 8192, D = 2048, S = 4096, NB = 2, DEPTH = 2;
constexpr int INW = 9360, INP = 9472;
constexpr int NE = 64, FE = 512;
constexpr int NTHREADS = 512;
constexpr int LDS_BYTES = 147456;
constexpr float ALPHA = 1.41421356237309515f;
constexpr int ECAP = 8192;
constexpr int PMAX = 32768;

constexpr size_t al256(size_t x) { return (x + 255) & ~(size_t)255; }
constexpr size_t XCD_BAR_BYTES = 16384;
constexpr size_t WS_BAR = 0;
constexpr size_t WS_CNT = WS_BAR + XCD_BAR_BYTES;
constexpr size_t WS_CTL_END = WS_CNT + al256(DEPTH * 64 * 4);
constexpr size_t WS_SSQ = WS_CTL_END;
constexpr size_t WS_ROPE = WS_SSQ + al256((size_t)T * 16 * 4);
constexpr size_t WS_XB = WS_ROPE + al256((size_t)T * 112 * 4);
constexpr size_t WS_H2F = WS_XB + al256((size_t)T * D * 2);
constexpr size_t WS_CQ = WS_H2F + al256((size_t)T * D * 4);
constexpr size_t WS_CKV = WS_CQ + al256((size_t)T * 512 * 2);
constexpr size_t WS_QB = WS_CKV + al256((size_t)T * 512 * 2);
constexpr size_t WS_KB = WS_QB + al256((size_t)T * 1024 * 2);
constexpr size_t WS_VB = WS_KB + al256((size_t)T * 1024 * 2);
constexpr size_t WS_QI = WS_VB + al256((size_t)T * 1024 * 2);
constexpr size_t WS_KI = WS_QI + al256((size_t)T * 1024 * 2);
constexpr size_t WS_WI = WS_KI + al256((size_t)T * 64 * 2);
constexpr size_t WS_GA = WS_WI + al256((size_t)T * 16 * 4);
constexpr size_t WS_GB = WS_GA + al256((size_t)T * D * 2);
constexpr size_t WS_QA = WS_GB + al256((size_t)T * D * 2);
constexpr size_t WS_KA = WS_QA + al256((size_t)T * 1536 * 2);
constexpr size_t WS_VA = WS_KA + al256((size_t)T * 1536 * 2);
constexpr size_t WS_MASK = WS_VA + al256((size_t)T * 1024 * 2);
constexpr size_t WS_OA = WS_MASK + al256((size_t)T * 128 * 4);
constexpr size_t WS_OB = WS_OA + al256((size_t)T * 1024 * 2);
constexpr size_t WS_YT = WS_OB + al256((size_t)T * 1024 * 2);
constexpr size_t WS_Y = WS_YT + al256((size_t)T * D * 4);
constexpr size_t WS_V1 = WS_Y + al256((size_t)T * D * 2);
constexpr size_t WS_H1F = WS_V1 + al256((size_t)T * D * 4);
constexpr size_t WS_H1B = WS_H1F + al256((size_t)T * D * 4);
constexpr size_t WS_TOKE = WS_H1B + al256((size_t)T * D * 2);
constexpr size_t WS_TOKW = WS_TOKE + al256((size_t)T * 2 * 4);
constexpr size_t WS_TOKS = WS_TOKW + al256((size_t)T * 2 * 4);
constexpr size_t WS_LIST = WS_TOKS + al256((size_t)T * 2 * 4);
constexpr size_t WS_HID = WS_LIST + al256((size_t)NE * ECAP * 4);
constexpr size_t WS_YE = WS_HID + al256((size_t)PMAX * FE * 2);
constexpr size_t WS_END = WS_YE + al256((size_t)PMAX * D * 2);

static_assert(WS_KB == WS_QB + (size_t)T * 1024 * 2 && WS_VB == WS_KB + (size_t)T * 1024 * 2 && WS_GB == WS_GA + (size_t)T * D * 2, "QB|KB|VB and GA|GB must be consecutive");
struct Params {
    const float* x; const int* pos;
    const float *w_in, *g_q, *w_qb, *g_kv, *w_kvb, *w_oa, *w_ob, *w_out, *ln1g, *ln1b, *w_group, *b_group, *w_router, *b_router, *w_eg, *w_eu, *w_ed, *ln2g, *ln2b;
    float* out; unsigned char* ws;
};

__device__ __forceinline__ float bf2f(bf16_t v) { return __uint_as_float((unsigned)v << 16); }
__device__ __forceinline__ bf16_t f2bf(float f) { unsigned u = __float_as_uint(f); u += 0x7fffu + ((u >> 16) & 1u); return (bf16_t)(u >> 16); }
__device__ __forceinline__ unsigned pk2(float a, float b) { return (unsigned)f2bf(a) | ((unsigned)f2bf(b) << 16); }
__device__ __forceinline__ void st4bf(bf16_t* p, f32x4 v) { u32x2 w; w.x = pk2(v[0], v[1]); w.y = pk2(v[2], v[3]); *(u32x2*)p = w; }
__device__ __forceinline__ float wave_sum(float v) {
#pragma unroll
    for (int o = 32; o >= 1; o >>= 1) v += __shfl_xor(v, o);
    return v;
}
__device__ __forceinline__ float wave_max(float v) {
#pragma unroll
    for (int o = 32; o >= 1; o >>= 1) v = fmaxf(v, __shfl_xor(v, o));
    return v;
}
__device__ __forceinline__ int block_sum_int(int v, int* red) {
#pragma unroll
    for (int o = 32; o >= 1; o >>= 1) v += __shfl_xor(v, o);
    if ((threadIdx.x & 63) == 0) red[threadIdx.x >> 6] = v;
    __syncthreads();
    int t = 0;
#pragma unroll
    for (int i = 0; i < 8; ++i) t += red[i];
    __syncthreads();
    return t;
}
__device__ __forceinline__ f32x4 rot4(f32x4 v, float c0, float s0, float c1, float s1) { f32x4 o; o[0] = v[0] * c0 - v[1] * s0; o[1] = v[1] * c0 + v[0] * s0; o[2] = v[2] * c1 - v[3] * s1; o[3] = v[3] * c1 + v[2] * s1; return o; }

#define XB_TMO      128
#define XB_XCNT(j)  (256  + 64 * (j))
#define XB_XSUB(j)  (1280 + 64 * (j))
#define XB_XGEN(j)  (2304 + 64 * (j))
#define XB_TOP      3328
#define XB_TOPGEN   3392
#define XCD_BAR_WORDS 3456
#define XB_SPIN_CAP (1u << 22)
#define LAS __attribute__((address_space(3)))
__device__ __forceinline__ unsigned xb_ld(unsigned* p)              { return __hip_atomic_load(p, __ATOMIC_RELAXED, __HIP_MEMORY_SCOPE_AGENT); }
__device__ __forceinline__ unsigned xb_add(unsigned* p, unsigned v) { return __hip_atomic_fetch_add(p, v, __ATOMIC_RELAXED, __HIP_MEMORY_SCOPE_AGENT); }
__device__ __forceinline__ unsigned xb_xcc_id() { return (unsigned)__builtin_amdgcn_s_getreg((3 << 11) | 20) & 0xFu; }
#define XB_SPIN(cond, bar) do { unsigned _sp = 0; while (cond) { __builtin_amdgcn_s_sleep(1); \
    if ((++_sp & 255u) == 0u) { if (xb_ld(&(bar)[XB_TMO])) break; if (_sp > XB_SPIN_CAP) { atomicAdd(&(bar)[XB_TMO], 1u); break; } } } } while (0)
struct XcdBarrier { unsigned* bar; unsigned x; volatile LAS unsigned* st; };
__device__ __forceinline__ XcdBarrier xcd_barrier_post(unsigned* bar, volatile LAS unsigned* st) {
    XcdBarrier b; b.bar = bar; b.x = xb_xcc_id(); b.st = st;
    if (threadIdx.x == 0) (void)xb_add(&bar[XB_XCNT(b.x)], 1u);
    return b;
}
__device__ __forceinline__ void xcd_barrier_complete(unsigned* bar, unsigned x, unsigned& nloc, unsigned& nx) {
    const unsigned G = gridDim.x * gridDim.y * gridDim.z;
    unsigned sum, cnt, mine, sp = 0u;
    for (;;) {
        sum = 0u; cnt = 0u; mine = 0u;
#pragma unroll
        for (unsigned j = 0; j < 16; ++j) { const unsigned c = xb_ld(&bar[XB_XCNT(j)]); sum += c; cnt += (c > 0u) ? 1u : 0u; mine = (j == x) ? c : mine; }
        if (sum == G) break;
        __builtin_amdgcn_s_sleep(1);
        if ((++sp & 255u) == 0u) { if (xb_ld(&bar[XB_TMO])) break; if (sp > XB_SPIN_CAP) { atomicAdd(&bar[XB_TMO], 1u); break; } }
    }
    nloc = mine > 0u ? mine : 1u; nx = cnt > 0u ? cnt : 1u;
}
__device__ __forceinline__ void xcd_barrier(const XcdBarrier& b) {
    asm volatile("s_waitcnt vmcnt(0)" ::: "memory");
    __syncthreads();
    if (threadIdx.x == 0) {
        unsigned* bar = b.bar;
        __builtin_amdgcn_s_waitcnt(0);
        unsigned nloc = b.st[0], nx = b.st[1];
        if (nloc == 0u) { xcd_barrier_complete(bar, b.x, nloc, nx); b.st[0] = nloc; b.st[1] = nx; }
        const unsigned old = xb_add(&bar[XB_XSUB(b.x)], 1u);
        const unsigned gen = old / nloc;
        if (old + 1u == (gen + 1u) * nloc) {
            __builtin_amdgcn_fence(__ATOMIC_RELEASE, "agent");
            asm volatile("s_waitcnt vmcnt(0)" ::: "memory");
            const unsigned og = xb_add(&bar[XB_TOP], 1u);
            const unsigned tg = og / nx;
            if (og + 1u == (tg + 1u) * nx) xb_add(&bar[XB_TOPGEN], 1u);
            else XB_SPIN(xb_ld(&bar[XB_TOPGEN]) == tg, bar);
            __builtin_amdgcn_fence(__ATOMIC_ACQUIRE, "agent");
            xb_add(&bar[XB_XGEN(b.x)], 1u);
            asm volatile("s_waitcnt vmcnt(0)" ::: "memory");
        } else {
            XB_SPIN(xb_ld(&bar[XB_XGEN(b.x)]) == gen, bar);
            __builtin_amdgcn_fence(__ATOMIC_ACQUIRE, "agent");
            asm volatile("s_waitcnt vmcnt(0)" ::: "memory");
        }
    }
    __syncthreads();
}

template <class Epi>
__device__ __forceinline__ void ngemm(float* lds, const bf16_t* A, int lda, int M, const float* W, int ldw, int N, int K, const Epi& E) {
    float* As = lds;
    float* Ws = lds + 32 * 132;
    const int tid = threadIdx.x, ty = tid >> 4, tx = tid & 15;
    const int ntn = N / 64, ntiles = (M / 128) * ntn;
    for (int tile = blockIdx.x; tile < ntiles; tile += gridDim.x) {
        const int tm = tile / ntn, tn = tile % ntn;
        f32x4 acc0 = {0.f, 0.f, 0.f, 0.f}, acc1 = acc0, acc2 = acc0, acc3 = acc0;
        const int ar = tid >> 2, akq = (tid & 3) * 8;
        const int wk = tid >> 4, wn4 = (tid & 15) * 4;
        const int sc0 = E.src(tn * 64 + wn4), sc1 = E.src(tn * 64 + wn4 + 1), sc2 = E.src(tn * 64 + wn4 + 2), sc3 = E.src(tn * 64 + wn4 + 3);
        const bf16_t* ap = A + (size_t)(tm * 128 + ar) * lda + akq;
        for (int k0 = 0; k0 < K; k0 += 32) {
            __syncthreads();
            { const u32x4 raw = *(const u32x4*)(ap + k0);
              float* dst = As + akq * 132 + ar; const int kb = k0 + akq;
              dst[0 * 132] = __uint_as_float(raw.x << 16) * E.kscale(kb);             dst[1 * 132] = __uint_as_float(raw.x & 0xffff0000u) * E.kscale(kb + 1);
              dst[2 * 132] = __uint_as_float(raw.y << 16) * E.kscale(kb + 2);         dst[3 * 132] = __uint_as_float(raw.y & 0xffff0000u) * E.kscale(kb + 3);
              dst[4 * 132] = __uint_as_float(raw.z << 16) * E.kscale(kb + 4);         dst[5 * 132] = __uint_as_float(raw.z & 0xffff0000u) * E.kscale(kb + 5);
              dst[6 * 132] = __uint_as_float(raw.w << 16) * E.kscale(kb + 6);         dst[7 * 132] = __uint_as_float(raw.w & 0xffff0000u) * E.kscale(kb + 7); }
            { const float* wrow = W + (size_t)(k0 + wk) * ldw; f32x4 wv;
              wv[0] = sc0 >= 0 ? wrow[sc0] : 0.f; wv[1] = sc1 >= 0 ? wrow[sc1] : 0.f; wv[2] = sc2 >= 0 ? wrow[sc2] : 0.f; wv[3] = sc3 >= 0 ? wrow[sc3] : 0.f;
              *(f32x4*)(Ws + wk * 64 + wn4) = wv; }
            __syncthreads();
#pragma unroll 8
            for (int kk = 0; kk < 32; ++kk) {
                const f32x4 a = *(const f32x4*)(As + kk * 132 + ty * 4);
                const f32x4 w = *(const f32x4*)(Ws + kk * 64 + tx * 4);
                acc0 += a[0] * w; acc1 += a[1] * w; acc2 += a[2] * w; acc3 += a[3] * w;
            }
        }
        const int r0 = tm * 128 + ty * 4, c0 = tn * 64 + tx * 4;
        E.apply4(r0, c0, acc0); E.apply4(r0 + 1, c0, acc1); E.apply4(r0 + 2, c0, acc2); E.apply4(r0 + 3, c0, acc3);
    }
    __syncthreads();
}

__device__ __forceinline__ f32x4 bf4(u32x2 g) { f32x4 o; o[0] = __uint_as_float(g.x << 16); o[1] = __uint_as_float(g.x & 0xffff0000u); o[2] = __uint_as_float(g.y << 16); o[3] = __uint_as_float(g.y & 0xffff0000u); return o; }
struct EpiIn {
    bf16_t *CQ, *CKV, *QB, *KB, *VB, *QI, *GA, *GB, *KA, *KI; float *WI, *part; const float *cM, *sM, *cD, *sD, *cI, *sI;
    __device__ __forceinline__ float kscale(int) const { return 1.f; }
    __device__ __forceinline__ int src(int n) const {
        if (n < 1024) return n;
        if (n < 4096) { const int seg = (n - 1024) >> 10, c = (n - 1024) & 1023, d = c & 127; int od = d; if (seg < 2 && d < 32) od = (d >> 1) + (d & 1) * 16; return 1088 + seg * 1024 + (c & ~127) + od; }
        if (n < 5120) { const int c = n - 4096, d = c & 63; const int od = d < 16 ? (d >> 1) + (d & 1) * 8 : d; return 4160 + (c & ~63) + od; }
        if (n < 7168) return 5264 + (n - 5120);
        if (n < 9216) return 7312 + (n - 7168);
        if (n < 9280) { const int d = n - 9216; return 1024 + (d >> 1) + (d & 1) * 32; }
        if (n < 9344) { const int d = n - 9280; const int od = d < 16 ? (d >> 1) + (d & 1) * 8 : d; return 5184 + od; }
        if (n < 9360) return 5248 + (n - 9344);
        return -1;
    }
    __device__ __forceinline__ void apply4(int t, int n, f32x4 v) const {
        if (n < 1024) {
            if (n < 512) st4bf(CQ + (size_t)t * 512 + n, v); else st4bf(CKV + (size_t)t * 512 + (n - 512), v);
            float sq = v[0] * v[0] + v[1] * v[1] + v[2] * v[2] + v[3] * v[3];
            sq += __shfl_xor(sq, 1); sq += __shfl_xor(sq, 2); sq += __shfl_xor(sq, 4); sq += __shfl_xor(sq, 8);
            if ((threadIdx.x & 15) == 0) part[(size_t)t * 16 + (n >> 6)] = sq;
        }
        else if (n < 4096) {
            const int seg = (n - 1024) >> 10, c = (n - 1024) & 1023, d = c & 127;
            if (seg < 2 && d < 32) { const int i0 = t * 16 + (d >> 1); v = rot4(v, cD[i0], sD[i0], cD[i0 + 1], sD[i0 + 1]); }
            st4bf(QB + (size_t)seg * ((size_t)T * 1024) + (size_t)t * 1024 + c, v);
        } else if (n < 5120) {
            const int c = n - 4096, d = c & 63;
            if (d < 16) { const int i0 = t * 8 + (d >> 1); v = rot4(v, cI[i0], sI[i0], cI[i0 + 1], sI[i0 + 1]); }
            st4bf(QI + (size_t)t * 1024 + c, v);
        } else if (n < 9216) {
            f32x4 o; o[0] = 1.f / (1.f + __expf(-v[0])); o[1] = 1.f / (1.f + __expf(-v[1])); o[2] = 1.f / (1.f + __expf(-v[2])); o[3] = 1.f / (1.f + __expf(-v[3]));
            const int gs = (n - 5120) >> 11; st4bf(GA + (size_t)gs * ((size_t)T * D) + (size_t)t * D + ((n - 5120) & 2047), o);
        } else if (n < 9280) {
            const int d = n - 9216, i0 = t * 32 + (d >> 1);
            v = rot4(v, cM[i0], sM[i0], cM[i0 + 1], sM[i0 + 1]);
#pragma unroll
            for (int h = 0; h < 8; ++h) st4bf(KA + (size_t)t * 1536 + h * 192 + 128 + d, v);
        } else if (n < 9344) {
            const int d = n - 9280;
            if (d < 16) { const int i0 = t * 8 + (d >> 1); v = rot4(v, cI[i0], sI[i0], cI[i0 + 1], sI[i0 + 1]); }
            st4bf(KI + (size_t)t * 64 + d, v);
        } else if (n < 9360) {
            *(f32x4*)(WI + (size_t)t * 16 + (n - 9344)) = v * 0.03125f;
        }
    }
};
struct EpiQA {
    bf16_t* QA; const float *part, *g, *cM, *sM;
    __device__ __forceinline__ float kscale(int k) const { return g[k]; }
    __device__ __forceinline__ int src(int n) const { const int h = n / 192, d = n - h * 192; if (d < 128) return n; const int dd = d - 128; return h * 192 + 128 + (dd >> 1) + (dd & 1) * 32; }
    __device__ __forceinline__ void apply4(int t, int n, f32x4 v) const {
        const f32x4 pa = *(const f32x4*)(part + (size_t)t * 16), pb = *(const f32x4*)(part + (size_t)t * 16 + 4);
        v = v * rsqrtf((((pa[0] + pa[1]) + (pa[2] + pa[3])) + ((pb[0] + pb[1]) + (pb[2] + pb[3]))) * (1.f / 512.f) + 1e-6f);
        const int h = n / 192, d = n - h * 192;
        if (d >= 128) { const int i0 = t * 32 + ((d - 128) >> 1); v = rot4(v, cM[i0], sM[i0], cM[i0 + 1], sM[i0 + 1]); }
        st4bf(QA + (size_t)t * 1536 + n, v);
    }
};
struct EpiKV {
    bf16_t *KA, *VA; const float *part, *g;
    __device__ __forceinline__ float kscale(int k) const { return g[k]; }
    __device__ __forceinline__ int src(int n) const { return n; }
    __device__ __forceinline__ void apply4(int t, int n, f32x4 v) const {
        const f32x4 pa = *(const f32x4*)(part + (size_t)t * 16 + 8), pb = *(const f32x4*)(part + (size_t)t * 16 + 12);
        v = v * rsqrtf((((pa[0] + pa[1]) + (pa[2] + pa[3])) + ((pb[0] + pb[1]) + (pb[2] + pb[3]))) * (1.f / 512.f) + 1e-6f);
        const int h = n >> 8, d = n & 255;
        if (d < 128) st4bf(KA + (size_t)t * 1536 + h * 192 + d, v); else st4bf(VA + (size_t)t * 1024 + h * 128 + (d - 128), v);
    }
};
struct EpiYA {
    float* YT; const bf16_t* GA;
    __device__ __forceinline__ float kscale(int) const { return 1.f; }
    __device__ __forceinline__ int src(int n) const { return n; }
    __device__ __forceinline__ void apply4(int t, int n, f32x4 v) const {
        *(f32x4*)(YT + (size_t)t * D + n) = v * bf4(*(const u32x2*)(GA + (size_t)t * D + n));
    }
};
struct EpiYB {
    const float* YT; const bf16_t* GB; bf16_t* Y;
    __device__ __forceinline__ float kscale(int) const { return 1.f; }
    __device__ __forceinline__ int src(int n) const { return n; }
    __device__ __forceinline__ void apply4(int t, int n, f32x4 v) const {
        const f32x4 y = *(const f32x4*)(YT + (size_t)t * D + n);
        st4bf(Y + (size_t)t * D + n, y + v * bf4(*(const u32x2*)(GB + (size_t)t * D + n)));
    }
};
struct EpiOut {
    const float* hin; float* V1;
    __device__ __forceinline__ float kscale(int) const { return 1.f; }
    __device__ __forceinline__ int src(int n) const { return n; }
    __device__ __forceinline__ void apply4(int t, int n, f32x4 v) const {
        const f32x4 h = *(const f32x4*)(hin + (size_t)t * D + n);
        *(f32x4*)(V1 + (size_t)t * D + n) = h * ALPHA + v;
    }
};

__device__ __forceinline__ void p_prologue(const Params& p) {
    float* rope = (float*)(p.ws + WS_ROPE);
    float *cM = rope, *sM = rope + T * 32, *cD = rope + T * 64, *sD = rope + T * 80, *cI = rope + T * 96, *sI = rope + T * 104;
    const int gtid = blockIdx.x * NTHREADS + threadIdx.x, gstride = gridDim.x * NTHREADS;
    for (int idx = gtid; idx < T * 56; idx += gstride) {
        const int t = idx / 56, j = idx - t * 56;
        int rot, i; float *ct, *st; int w;
        if (j < 32) { rot = 64; i = j; ct = cM; st = sM; w = 32; } else if (j < 48) { rot = 32; i = j - 32; ct = cD; st = sD; w = 16; } else { rot = 16; i = j - 48; ct = cI; st = sI; w = 8; }
        const float inv = exp2f(-((float)(2 * i) / (float)rot) * 18.931568569324174f);
        const float ang = (float)p.pos[t] * inv;
        double rev = (double)ang * 0.15915494309189535; rev -= rint(rev);
        const float r = (float)(rev * 6.283185307179586);
        ct[t * w + i] = __cosf(r); st[t * w + i] = __sinf(r);
    }
    bf16_t* XB = (bf16_t*)(p.ws + WS_XB);
    for (size_t i = (size_t)gtid * 4; i < (size_t)T * D; i += (size_t)gstride * 4) {
        st4bf(XB + i, *(const f32x4*)(p.x + i));
    }
}

__device__ __forceinline__ unsigned f2key(float f) { const unsigned u = __float_as_uint(f); return (u & 0x80000000u) ? ~u : (u | 0x80000000u); }
__device__ __forceinline__ void p_index(float* lds, const Params& p) {
    const bf16_t* QI = (const bf16_t*)(p.ws + WS_QI); const bf16_t* KI = (const bf16_t*)(p.ws + WS_KI); const float* WI = (const float*)(p.ws + WS_WI);
    unsigned* MASK = (unsigned*)(p.ws + WS_MASK);
    float* qs = lds; float* wsc = lds + 1024; float* sc = lds + 1040; int* red = (int*)(lds + 1040 + 4096);
    const int tid = threadIdx.x, lane = tid & 63, wv = tid >> 6;
    for (int t = blockIdx.x; t < T; t += gridDim.x) {
        const int b = t >> 12, ti = t & 4095, nk = ti + 1;
        __syncthreads();
        for (int i = tid; i < 1024; i += NTHREADS) qs[i] = bf2f(QI[(size_t)t * 1024 + i]);
        if (tid < 16) wsc[tid] = WI[(size_t)t * 16 + tid];
        __syncthreads();
        for (int s = tid; s < nk; s += NTHREADS) {
            const bf16_t* kr = KI + (size_t)(b * S + s) * 64;
            float score = 0.f;
#pragma unroll 1
            for (int h = 0; h < 16; ++h) {
                asm volatile("" ::: "memory");
                float dot = 0.f;
#pragma unroll
                for (int c = 0; c < 8; ++c) {
                    const u32x4 raw = *(const u32x4*)(kr + c * 8);
                    const f32x4 q0 = *(const f32x4*)(qs + h * 64 + c * 8), q1 = *(const f32x4*)(qs + h * 64 + c * 8 + 4);
                    dot = fmaf(q0[0], __uint_as_float(raw.x << 16), dot); dot = fmaf(q0[1], __uint_as_float(raw.x & 0xffff0000u), dot);
                    dot = fmaf(q0[2], __uint_as_float(raw.y << 16), dot); dot = fmaf(q0[3], __uint_as_float(raw.y & 0xffff0000u), dot);
                    dot = fmaf(q1[0], __uint_as_float(raw.z << 16), dot); dot = fmaf(q1[1], __uint_as_float(raw.z & 0xffff0000u), dot);
                    dot = fmaf(q1[2], __uint_as_float(raw.w << 16), dot); dot = fmaf(q1[3], __uint_as_float(raw.w & 0xffff0000u), dot);
                }
                score = fmaf(wsc[h], fmaxf(dot, 0.f), score);
            }
            sc[s] = score;
        }
        __syncthreads();
        unsigned k0 = 0u, k1 = 0u, k2 = 0u, k3 = 0u, k4 = 0u, k5 = 0u, k6 = 0u, k7 = 0u;
        if (tid < nk) k0 = f2key(sc[tid]);
        if (tid + 512 < nk) k1 = f2key(sc[tid + 512]);
        if (tid + 1024 < nk) k2 = f2key(sc[tid + 1024]);
        if (tid + 1536 < nk) k3 = f2key(sc[tid + 1536]);
        if (tid + 2048 < nk) k4 = f2key(sc[tid + 2048]);
        if (tid + 2560 < nk) k5 = f2key(sc[tid + 2560]);
        if (tid + 3072 < nk) k6 = f2key(sc[tid + 3072]);
        if (tid + 3584 < nk) k7 = f2key(sc[tid + 3584]);
        unsigned res = 0u;
        if (nk > 256) {
#pragma unroll 1
            for (int bit = 31; bit >= 0; --bit) {
                const unsigned cand = res | (1u << bit);
                const int c = (k0 >= cand) + (k1 >= cand) + (k2 >= cand) + (k3 >= cand) + (k4 >= cand) + (k5 >= cand) + (k6 >= cand) + (k7 >= cand);
                if (block_sum_int(c, red) >= 256) res = cand;
            }
        }
        unsigned* mw = MASK + (size_t)t * 128 + 2 * wv;
#define MASK_OUT(j, kj) do { const unsigned long long bal = __ballot((tid + 512 * (j) < nk) && ((kj) >= res)); if (lane == 0) { mw[16 * (j)] = (unsigned)bal; mw[16 * (j) + 1] = (unsigned)(bal >> 32); } } while (0)
        MASK_OUT(0, k0); MASK_OUT(1, k1); MASK_OUT(2, k2); MASK_OUT(3, k3); MASK_OUT(4, k4); MASK_OUT(5, k5); MASK_OUT(6, k6); MASK_OUT(7, k7);
#undef MASK_OUT
    }
    __syncthreads();
}

template <int DQK, bool MASKED>
__device__ __forceinline__ void nattn(float* lds, const bf16_t* Q, const bf16_t* Kp, int ldk, const bf16_t* Vp, const unsigned* mask, bf16_t* O, float scale) {
    float* qs = lds; float* scb = lds + 8 * 192;
    const int tid = threadIdx.x, lane = tid & 63, h = tid >> 6;
    float* sc = scb + h * 4096;
    for (int t = blockIdx.x; t < T; t += gridDim.x) {
        const int b = t >> 12, ti = t & 4095, nk = ti + 1;
        __syncthreads();
        for (int i = tid; i < 8 * DQK; i += NTHREADS) qs[i] = bf2f(Q[(size_t)t * (8 * DQK) + i]);
        __syncthreads();
        const float* q = qs + h * DQK;
        float mx = -__builtin_inff();
        for (int s0 = 0; s0 < nk; s0 += 64) {
            const int s = s0 + lane; float v = -__builtin_inff();
            bool on = s < nk;
            if (MASKED && on) on = (mask[(size_t)t * 128 + (s >> 5)] >> (s & 31)) & 1u;
            if (on) {
                const bf16_t* kr = Kp + (size_t)(b * S + s) * ldk + h * DQK;
                float dot = 0.f;
#pragma unroll 4
                for (int c = 0; c < DQK / 8; ++c) { const u32x4 raw = *(const u32x4*)(kr + c * 8); const unsigned w[4] = {raw.x, raw.y, raw.z, raw.w};
#pragma unroll
                    for (int j = 0; j < 4; ++j) { dot = fmaf(q[c * 8 + 2 * j], __uint_as_float(w[j] << 16), dot); dot = fmaf(q[c * 8 + 2 * j + 1], __uint_as_float(w[j] & 0xffff0000u), dot); } }
                v = dot * scale;
            }
            if (s < nk) sc[s] = v;
            mx = fmaxf(mx, v);
        }
        mx = wave_max(mx);
        __syncthreads();
        float sum = 0.f;
        for (int s = lane; s < nk; s += 64) { const float pz = __expf(sc[s] - mx); sc[s] = pz; sum += pz; }
        sum = wave_sum(sum);
        __syncthreads();
        float a0 = 0.f, a1 = 0.f;
        const bf16_t* vb = Vp + (size_t)(b * S) * 1024 + h * 128 + lane * 2;
        for (int s = 0; s < nk; ++s) {
            const float pz = sc[s];
            if (pz != 0.f) { const unsigned w = *(const unsigned*)(vb + (size_t)s * 1024); a0 = fmaf(pz, __uint_as_float(w << 16), a0); a1 = fmaf(pz, __uint_as_float(w & 0xffff0000u), a1); }
        }
        const float inv = 1.f / sum;
        *(unsigned*)(O + (size_t)t * 1024 + h * 128 + lane * 2) = pk2(a0 * inv, a1 * inv);
    }
    __syncthreads();
}

__device__ __forceinline__ void p_ln1_route(float* lds, const Params& p, int l) {
    const float* V1 = (const float*)(p.ws + WS_V1); float* H1F = (float*)(p.ws + WS_H1F); bf16_t* H1B = (bf16_t*)(p.ws + WS_H1B);
    unsigned* cnt = (unsigned*)(p.ws + WS_CNT) + l * 64; int* LIST = (int*)(p.ws + WS_LIST);
    int* TOKE = (int*)(p.ws + WS_TOKE); float* TOKW = (float*)(p.ws + WS_TOKW); int* TOKS = (int*)(p.ws + WS_TOKS);
    const float* g = p.ln1g + (size_t)l * D; const float* bb = p.ln1b + (size_t)l * D;
    const float* wr = p.w_router + (size_t)l * D * 64; const float* wg = p.w_group + (size_t)l * D * 8;
    const float* br = p.b_router + l * 64; const float* bg = p.b_group + l * 8;
    const int tid = threadIdx.x, lane = tid & 63, wv = tid >> 6;
    float* lg = lds + wv * 80;
    for (int t0 = blockIdx.x * 8; t0 < T; t0 += gridDim.x * 8) {
        const int t = t0 + wv;
        float s1 = 0.f;
#pragma unroll 4
        for (int j = 0; j < 32; ++j) s1 += V1[(size_t)t * D + lane + 64 * j];
        const float mean = wave_sum(s1) * (1.f / D);
        float s2 = 0.f;
#pragma unroll 4
        for (int j = 0; j < 32; ++j) { const float d = V1[(size_t)t * D + lane + 64 * j] - mean; s2 += d * d; }
        const float rstd = rsqrtf(wave_sum(s2) * (1.f / D) + 1e-5f);
        float acc[72];
#pragma unroll
        for (int e = 0; e < 72; ++e) acc[e] = 0.f;
#pragma unroll 1
        for (int j = 0; j < 32; ++j) {
            const int k = lane + 64 * j;
            const float hk = (V1[(size_t)t * D + k] - mean) * rstd * g[k] + bb[k];
            H1F[(size_t)t * D + k] = hk; H1B[(size_t)t * D + k] = f2bf(hk);
            const float* wrow = wr + (size_t)k * 64;
#pragma unroll
            for (int e4 = 0; e4 < 16; ++e4) { const f32x4 w = *(const f32x4*)(wrow + e4 * 4);
                acc[e4 * 4] = fmaf(hk, w[0], acc[e4 * 4]); acc[e4 * 4 + 1] = fmaf(hk, w[1], acc[e4 * 4 + 1]); acc[e4 * 4 + 2] = fmaf(hk, w[2], acc[e4 * 4 + 2]); acc[e4 * 4 + 3] = fmaf(hk, w[3], acc[e4 * 4 + 3]); }
            const float* grow = wg + (size_t)k * 8;
            const f32x4 w0 = *(const f32x4*)grow, w1 = *(const f32x4*)(grow + 4);
            acc[64] = fmaf(hk, w0[0], acc[64]); acc[65] = fmaf(hk, w0[1], acc[65]); acc[66] = fmaf(hk, w0[2], acc[66]); acc[67] = fmaf(hk, w0[3], acc[67]);
            acc[68] = fmaf(hk, w1[0], acc[68]); acc[69] = fmaf(hk, w1[1], acc[69]); acc[70] = fmaf(hk, w1[2], acc[70]); acc[71] = fmaf(hk, w1[3], acc[71]);
        }
#pragma unroll
        for (int e = 0; e < 72; ++e) { const float r = wave_sum(acc[e]); if (lane == 0) lg[e] = r; }
        __syncthreads();
        if (lane == 0) {
            float gl[8]; float gmax = -__builtin_inff(); int gi = 0;
#pragma unroll
            for (int i = 0; i < 8; ++i) { gl[i] = lg[64 + i] + bg[i]; if (gl[i] > gmax) { gmax = gl[i]; gi = i; } }
            float gs = 0.f;
#pragma unroll
            for (int i = 0; i < 8; ++i) gs += __expf(gl[i] - gmax);
            const float gp = 1.f / gs;
            float el[8]; float emax = -__builtin_inff(); int e1 = 0;
#pragma unroll
            for (int i = 0; i < 8; ++i) { el[i] = lg[gi * 8 + i] + br[gi * 8 + i]; if (el[i] > emax) { emax = el[i]; e1 = i; } }
            float e2max = -__builtin_inff(); int e2 = 0;
#pragma unroll
            for (int i = 0; i < 8; ++i) { if (i != e1 && el[i] > e2max) { e2max = el[i]; e2 = i; } }
            const float p1 = 1.f, p2 = __expf(e2max - emax);
            const float wa = gp * p1 / (p1 + p2), wb = gp * p2 / (p1 + p2);
            const int ea = gi * 8 + e1, eb = gi * 8 + e2;
            const int sa = (int)atomicAdd(cnt + ea, 1u), sb = (int)atomicAdd(cnt + eb, 1u);
            LIST[(size_t)ea * ECAP + sa] = t; LIST[(size_t)eb * ECAP + sb] = t;
            TOKE[t * 2] = ea; TOKE[t * 2 + 1] = eb; TOKW[t * 2] = wa; TOKW[t * 2 + 1] = wb; TOKS[t * 2] = sa; TOKS[t * 2 + 1] = sb;
        }
        __syncthreads();
    }
}

__device__ __forceinline__ void moe_tables(int* tab, const unsigned* cnt, int items_per_rb) {
    if (threadIdx.x == 0) { int a = 0, bsum = 0; for (int e = 0; e < 64; ++e) { tab[e] = a; tab[80 + e] = bsum; const int c = (int)cnt[e]; a += ((c + 127) / 128) * items_per_rb; bsum += ((c + 255) / 256) * 256; } tab[64] = a; tab[80 + 64] = bsum; }
    __syncthreads();
}
__device__ __forceinline__ void p_moe1(float* lds, const Params& p, int l) {
    const unsigned* cnt = (const unsigned*)(p.ws + WS_CNT) + l * 64; const int* LIST = (const int*)(p.ws + WS_LIST);
    const bf16_t* H1B = (const bf16_t*)(p.ws + WS_H1B); bf16_t* HID = (bf16_t*)(p.ws + WS_HID);
    float* As = lds; float* Wg = lds + 32 * 132; float* Wu = Wg + 32 * 64; int* tab = (int*)(Wu + 32 * 64);
    __syncthreads();
    moe_tables(tab, cnt, 8);
    const int tid = threadIdx.x, ty = tid >> 4, tx = tid & 15;
    const int total = tab[64];
    for (int item = blockIdx.x; item < total; item += gridDim.x) {
        int e = 0; while (tab[e + 1] <= item) ++e;
        const int local = item - tab[e], rb = local >> 3, ct = local & 7, ce = (int)cnt[e], base = tab[80 + e];
        const float* wgp = p.w_eg + ((size_t)(l * 64 + e) * D) * FE + ct * 64;
        const float* wup = p.w_eu + ((size_t)(l * 64 + e) * D) * FE + ct * 64;
        const f32x4 z4 = {0.f, 0.f, 0.f, 0.f};
        f32x4 ag0 = z4, ag1 = z4, ag2 = z4, ag3 = z4, au0 = z4, au1 = z4, au2 = z4, au3 = z4;
        const int ar = tid >> 2, akq = (tid & 3) * 8, wk = tid >> 4, wn4 = (tid & 15) * 4;
        const int ai = rb * 128 + ar; const int tok = ai < ce ? LIST[(size_t)e * ECAP + ai] : -1;
        const bf16_t* ap = H1B + (size_t)(tok < 0 ? 0 : tok) * D + akq;
        for (int k0 = 0; k0 < D; k0 += 32) {
            __syncthreads();
            { u32x4 raw = *(const u32x4*)(ap + k0); if (tok < 0) raw = (u32x4){0u, 0u, 0u, 0u};
              float* dst = As + akq * 132 + ar;
              dst[0 * 132] = __uint_as_float(raw.x << 16); dst[1 * 132] = __uint_as_float(raw.x & 0xffff0000u); dst[2 * 132] = __uint_as_float(raw.y << 16); dst[3 * 132] = __uint_as_float(raw.y & 0xffff0000u);
              dst[4 * 132] = __uint_as_float(raw.z << 16); dst[5 * 132] = __uint_as_float(raw.z & 0xffff0000u); dst[6 * 132] = __uint_as_float(raw.w << 16); dst[7 * 132] = __uint_as_float(raw.w & 0xffff0000u); }
            *(f32x4*)(Wg + wk * 64 + wn4) = *(const f32x4*)(wgp + (size_t)(k0 + wk) * FE + wn4);
            *(f32x4*)(Wu + wk * 64 + wn4) = *(const f32x4*)(wup + (size_t)(k0 + wk) * FE + wn4);
            __syncthreads();
#pragma unroll 4
            for (int kk = 0; kk < 32; ++kk) {
                const f32x4 a = *(const f32x4*)(As + kk * 132 + ty * 4);
                const f32x4 g4 = *(const f32x4*)(Wg + kk * 64 + tx * 4);
                const f32x4 u4 = *(const f32x4*)(Wu + kk * 64 + tx * 4);
                ag0 += a[0] * g4; ag1 += a[1] * g4; ag2 += a[2] * g4; ag3 += a[3] * g4;
                au0 += a[0] * u4; au1 += a[1] * u4; au2 += a[2] * u4; au3 += a[3] * u4;
            }
        }
#define MOE1_OUT(i, G_, U_) do { const int ri = rb * 128 + ty * 4 + (i); if (ri < ce) { f32x4 o; \
            o[0] = G_[0] / (1.f + __expf(-G_[0])) * U_[0]; o[1] = G_[1] / (1.f + __expf(-G_[1])) * U_[1]; o[2] = G_[2] / (1.f + __expf(-G_[2])) * U_[2]; o[3] = G_[3] / (1.f + __expf(-G_[3])) * U_[3]; \
            st4bf(HID + (size_t)(base + ri) * FE + ct * 64 + tx * 4, o); } } while (0)
        MOE1_OUT(0, ag0, au0); MOE1_OUT(1, ag1, au1); MOE1_OUT(2, ag2, au2); MOE1_OUT(3, ag3, au3);
#undef MOE1_OUT
    }
    __syncthreads();
}
__device__ __forceinline__ void p_moe2(float* lds, const Params& p, int l) {
    const unsigned* cnt = (const unsigned*)(p.ws + WS_CNT) + l * 64;
    const bf16_t* HID = (const bf16_t*)(p.ws + WS_HID); bf16_t* YE = (bf16_t*)(p.ws + WS_YE);
    float* As = lds; float* Ws = lds + 32 * 132; int* tab = (int*)(Ws + 32 * 64 * 2);
    __syncthreads();
    moe_tables(tab, cnt, 32);
    const int tid = threadIdx.x, ty = tid >> 4, tx = tid & 15;
    const int total = tab[64];
    for (int item = blockIdx.x; item < total; item += gridDim.x) {
        int e = 0; while (tab[e + 1] <= item) ++e;
        const int local = item - tab[e], rb = local >> 5, ct = local & 31, ce = (int)cnt[e], base = tab[80 + e];
        const float* wdp = p.w_ed + ((size_t)(l * 64 + e) * FE) * D + ct * 64;
        f32x4 acc0 = {0.f, 0.f, 0.f, 0.f}, acc1 = acc0, acc2 = acc0, acc3 = acc0;
        const int ar = tid >> 2, akq = (tid & 3) * 8, wk = tid >> 4, wn4 = (tid & 15) * 4;
        const int ai = rb * 128 + ar; const bool av = ai < ce;
        const bf16_t* ap = HID + (size_t)(base + (av ? ai : 0)) * FE + akq;
        for (int k0 = 0; k0 < FE; k0 += 32) {
            __syncthreads();
            { u32x4 raw = *(const u32x4*)(ap + k0); if (!av) raw = (u32x4){0u, 0u, 0u, 0u};
              float* dst = As + akq * 132 + ar;
              dst[0 * 132] = __uint_as_float(raw.x << 16); dst[1 * 132] = __uint_as_float(raw.x & 0xffff0000u); dst[2 * 132] = __uint_as_float(raw.y << 16); dst[3 * 132] = __uint_as_float(raw.y & 0xffff0000u);
              dst[4 * 132] = __uint_as_float(raw.z << 16); dst[5 * 132] = __uint_as_float(raw.z & 0xffff0000u); dst[6 * 132] = __uint_as_float(raw.w << 16); dst[7 * 132] = __uint_as_float(raw.w & 0xffff0000u); }
            *(f32x4*)(Ws + wk * 64 + wn4) = *(const f32x4*)(wdp + (size_t)(k0 + wk) * D + wn4);
            __syncthreads();
#pragma unroll 8
            for (int kk = 0; kk < 32; ++kk) {
                const f32x4 a = *(const f32x4*)(As + kk * 132 + ty * 4);
                const f32x4 w = *(const f32x4*)(Ws + kk * 64 + tx * 4);
                acc0 += a[0] * w; acc1 += a[1] * w; acc2 += a[2] * w; acc3 += a[3] * w;
            }
        }
        { const int ri = rb * 128 + ty * 4; bf16_t* yo = YE + (size_t)(base + ri) * D + ct * 64 + tx * 4;
          if (ri < ce) st4bf(yo, acc0); if (ri + 1 < ce) st4bf(yo + D, acc1); if (ri + 2 < ce) st4bf(yo + 2 * D, acc2); if (ri + 3 < ce) st4bf(yo + 3 * D, acc3); }
    }
    __syncthreads();
}
__device__ __forceinline__ void p_ln2(float* lds, const Params& p, int l) {
    const unsigned* cnt = (const unsigned*)(p.ws + WS_CNT) + l * 64;
    const float* H1F = (const float*)(p.ws + WS_H1F); const bf16_t* YE = (const bf16_t*)(p.ws + WS_YE);
    const int* TOKE = (const int*)(p.ws + WS_TOKE); const float* TOKW = (const float*)(p.ws + WS_TOKW); const int* TOKS = (const int*)(p.ws + WS_TOKS);
    float* outF = (l == DEPTH - 1) ? p.out : (float*)(p.ws + WS_H2F); bf16_t* XB = (bf16_t*)(p.ws + WS_XB);
    const float* g = p.ln2g + (size_t)l * D; const float* bb = p.ln2b + (size_t)l * D;
    int* tab = (int*)lds;
    __syncthreads();
    moe_tables(tab, cnt, 1);
    const int tid = threadIdx.x, lane = tid & 63, wv = tid >> 6;
    for (int t0 = blockIdx.x * 8; t0 < T; t0 += gridDim.x * 8) {
        const int t = t0 + wv;
        const int r0 = tab[80 + TOKE[t * 2]] + TOKS[t * 2], r1 = tab[80 + TOKE[t * 2 + 1]] + TOKS[t * 2 + 1];
        const float w0 = TOKW[t * 2], w1 = TOKW[t * 2 + 1];
        const float* hrow = H1F + (size_t)t * D; const bf16_t* y0 = YE + (size_t)r0 * D; const bf16_t* y1 = YE + (size_t)r1 * D;
        float s1 = 0.f;
#pragma unroll 4
        for (int j = 0; j < 32; ++j) { const int k = lane + 64 * j; s1 += ALPHA * hrow[k] + w0 * bf2f(y0[k]) + w1 * bf2f(y1[k]); }
        const float mean = wave_sum(s1) * (1.f / D);
        float s2 = 0.f;
#pragma unroll 4
        for (int j = 0; j < 32; ++j) { const int k = lane + 64 * j; const float d = ALPHA * hrow[k] + w0 * bf2f(y0[k]) + w1 * bf2f(y1[k]) - mean; s2 += d * d; }
        const float rstd = rsqrtf(wave_sum(s2) * (1.f / D) + 1e-5f);
#pragma unroll 4
        for (int j = 0; j < 32; ++j) { const int k = lane + 64 * j; const float v = ALPHA * hrow[k] + w0 * bf2f(y0[k]) + w1 * bf2f(y1[k]);
            const float o = (v - mean) * rstd * g[k] + bb[k];
            outF[(size_t)t * D + k] = o; if (l != DEPTH - 1) XB[(size_t)t * D + k] = f2bf(o); }
    }
    __syncthreads();
}

constexpr int NPH = 10;
#ifndef PH_MASK
#define PH_MASK 0x3ff
#endif
#define PHON(k) ((PH_MASK >> (k)) & 1)
__global__ void __launch_bounds__(NTHREADS, 2) hybrid_fwd(Params p, int ph_lo, int ph_hi) {
    extern __shared__ __attribute__((aligned(16))) unsigned char lds_raw[];
    float* lds = (float*)lds_raw;
    volatile LAS unsigned* xbw = (volatile LAS unsigned*)(lds_raw + LDS_BYTES - 16);
    if (threadIdx.x == 0) { xbw[0] = 0u; xbw[1] = 0u; xbw[2] = 0u; xbw[3] = 0u; }
    __syncthreads();
    XcdBarrier bar; bar.bar = (unsigned*)(p.ws + WS_BAR); bar.x = 0; bar.st = xbw;
    if (ph_lo < ph_hi) bar = xcd_barrier_post((unsigned*)(p.ws + WS_BAR), xbw);
#define IN(ph) ((ph) >= ph_lo && (ph) <= ph_hi)
#define GRID_BAR(ph) do { if ((ph) >= ph_lo && (ph) < ph_hi) xcd_barrier(bar); } while (0)
    unsigned char* ws = p.ws;
    float* rope = (float*)(ws + WS_ROPE);
    const float *cM = rope, *sM = rope + T * 32, *cD = rope + T * 64, *sD = rope + T * 80, *cI = rope + T * 96, *sI = rope + T * 104;
    for (int l = 0; l < DEPTH; ++l) {
        const int pb = l * NPH;
        float* part = (float*)(ws + WS_SSQ);
        if (PHON(0) && IN(pb + 0)) { if (l == 0) p_prologue(p); }
        GRID_BAR(pb + 0);
        if (PHON(1) && IN(pb + 1)) {
            EpiIn E; E.CQ = (bf16_t*)(ws + WS_CQ); E.CKV = (bf16_t*)(ws + WS_CKV); E.QB = (bf16_t*)(ws + WS_QB); E.KB = (bf16_t*)(ws + WS_KB); E.VB = (bf16_t*)(ws + WS_VB);
            E.QI = (bf16_t*)(ws + WS_QI); E.GA = (bf16_t*)(ws + WS_GA); E.GB = (bf16_t*)(ws + WS_GB); E.KA = (bf16_t*)(ws + WS_KA); E.KI = (bf16_t*)(ws + WS_KI);
            E.WI = (float*)(ws + WS_WI); E.part = part; E.cM = cM; E.sM = sM; E.cD = cD; E.sD = sD; E.cI = cI; E.sI = sI;
            ngemm(lds, (const bf16_t*)(ws + WS_XB), D, T, p.w_in + (size_t)l * D * INW, INW, INP, D, E);
        }
        GRID_BAR(pb + 1);
        if (PHON(2) && IN(pb + 2)) {
            { EpiQA E; E.QA = (bf16_t*)(ws + WS_QA); E.part = part; E.g = p.g_q + l * 512; E.cM = cM; E.sM = sM;
              ngemm(lds, (const bf16_t*)(ws + WS_CQ), 512, T, p.w_qb + (size_t)l * 512 * 1536, 1536, 1536, 512, E); }
            { EpiKV E; E.KA = (bf16_t*)(ws + WS_KA); E.VA = (bf16_t*)(ws + WS_VA); E.part = part; E.g = p.g_kv + l * 512;
              ngemm(lds, (const bf16_t*)(ws + WS_CKV), 512, T, p.w_kvb + (size_t)l * 512 * 2048, 2048, 2048, 512, E); }
            p_index(lds, p);
        }
        GRID_BAR(pb + 2);
        if (PHON(3) && IN(pb + 3)) {
            nattn<192, false>(lds, (const bf16_t*)(ws + WS_QA), (const bf16_t*)(ws + WS_KA), 1536, (const bf16_t*)(ws + WS_VA), nullptr, (bf16_t*)(ws + WS_OA), 0.07216878364870322f);
            nattn<128, true>(lds, (const bf16_t*)(ws + WS_QB), (const bf16_t*)(ws + WS_KB), 1024, (const bf16_t*)(ws + WS_VB), (const unsigned*)(ws + WS_MASK), (bf16_t*)(ws + WS_OB), 0.08838834764831845f);
        }
        GRID_BAR(pb + 3);
        if (PHON(4) && IN(pb + 4)) {
            { EpiYA E; E.YT = (float*)(ws + WS_YT); E.GA = (const bf16_t*)(ws + WS_GA);
              ngemm(lds, (const bf16_t*)(ws + WS_OA), 1024, T, p.w_oa + (size_t)l * 1024 * D, D, D, 1024, E); }
            { EpiYB E; E.YT = (const float*)(ws + WS_YT); E.GB = (const bf16_t*)(ws + WS_GB); E.Y = (bf16_t*)(ws + WS_Y);
              ngemm(lds, (const bf16_t*)(ws + WS_OB), 1024, T, p.w_ob + (size_t)l * 1024 * D, D, D, 1024, E); }
        }
        GRID_BAR(pb + 4);
        if (PHON(5) && IN(pb + 5)) {
            EpiOut E; E.hin = (l == 0) ? p.x : (const float*)(ws + WS_H2F); E.V1 = (float*)(ws + WS_V1);
            ngemm(lds, (const bf16_t*)(ws + WS_Y), D, T, p.w_out + (size_t)l * D * D, D, D, D, E);
        }
        GRID_BAR(pb + 5);
        if (PHON(6) && IN(pb + 6)) p_ln1_route(lds, p, l);
        GRID_BAR(pb + 6);
        if (PHON(7) && IN(pb + 7)) p_moe1(lds, p, l);
        GRID_BAR(pb + 7);
        if (PHON(8) && IN(pb + 8)) p_moe2(lds, p, l);
        GRID_BAR(pb + 8);
        if (PHON(9) && IN(pb + 9)) p_ln2(lds, p, l);
        GRID_BAR(pb + 9);
    }
}

#ifndef MK_ONE_LAUNCH
#define MK_ONE_LAUNCH 0
#endif
extern "C" void kernel_launch(void* const* d_in, const int* in_sizes, int n_in, void* d_out, int out_size, void* d_ws, size_t ws_size, hipStream_t stream) {
    static int grid = 0;
    if (!grid) {
        if (n_in != 21 || in_sizes[0] != T * D || out_size != T * D || ws_size < WS_END) {
            fprintf(stderr, "kernel_launch: unexpected shapes (n_in %d, in0 %d, out %d, ws %zu, need %zu); nothing launched\n", n_in, n_in > 0 ? in_sizes[0] : -1, out_size, ws_size, (size_t)WS_END);
            grid = -1; return; }
        int dev = 0, cus = 0, per_cu = 0;
        hipGetDevice(&dev); hipDeviceGetAttribute(&cus, hipDeviceAttributeMultiprocessorCount, dev);
        if (hipFuncSetAttribute((const void*)hybrid_fwd, hipFuncAttributeMaxDynamicSharedMemorySize, LDS_BYTES) != hipSuccess) { fprintf(stderr, "kernel_launch: hipFuncSetAttribute failed\n"); grid = -1; return; }
        hipOccupancyMaxActiveBlocksPerMultiprocessor(&per_cu, (const void*)hybrid_fwd, NTHREADS, LDS_BYTES);
        if (per_cu < 1) fprintf(stderr, "kernel_launch: occupancy query reports %d blocks per CU\n", per_cu);
        grid = cus > 0 ? cus : 256;
    }
    if (grid < 0) return;
    hipMemsetAsync((char*)d_ws, 0, WS_CTL_END, stream);
    Params p{};
    p.x = (const float*)d_in[0]; p.pos = (const int*)d_in[1];
    p.w_in = (const float*)d_in[2]; p.g_q = (const float*)d_in[3]; p.w_qb = (const float*)d_in[4]; p.g_kv = (const float*)d_in[5]; p.w_kvb = (const float*)d_in[6];
    p.w_oa = (const float*)d_in[7]; p.w_ob = (const float*)d_in[8]; p.w_out = (const float*)d_in[9]; p.ln1g = (const float*)d_in[10]; p.ln1b = (const float*)d_in[11];
    p.w_group = (const float*)d_in[12]; p.b_group = (const float*)d_in[13]; p.w_router = (const float*)d_in[14]; p.b_router = (const float*)d_in[15];
    p.w_eg = (const float*)d_in[16]; p.w_eu = (const float*)d_in[17]; p.w_ed = (const float*)d_in[18]; p.ln2g = (const float*)d_in[19]; p.ln2b = (const float*)d_in[20];
    p.out = (float*)d_out; p.ws = (unsigned char*)d_ws;
#if MK_ONE_LAUNCH
    hipLaunchKernelGGL(hybrid_fwd, dim3(grid), dim3(NTHREADS), LDS_BYTES, stream, p, 0, DEPTH * NPH - 1);
#else
    for (int ph = 0; ph < DEPTH * NPH; ++ph) { if (ph == NPH) continue; hipLaunchKernelGGL(hybrid_fwd, dim3(grid), dim3(NTHREADS), LDS_BYTES, stream, p, ph, ph); }
#endif
}
```

```cpp
#include <hip/hip_runtime.h>
#include <cstdio>
#include <cstdint>

typedef unsigned short bf16_t;
typedef float f32x4 __attribute__((ext_vector_type(4)));
typedef unsigned u32x4 __attribute__((ext_vector_type(4)));
typedef unsigned u32x2 __attribute__((ext_vector_type(2)));

constexpr int T = 8192, D = 2048, S = 4096, NB = 2, DEPTH = 2;
constexpr int INW = 9360, INP = 9472;
constexpr int NE = 64, FE = 512;
constexpr int NTHREADS = 512;
constexpr int LDS_BYTES = 147456;
constexpr float ALPHA = 1.41421356237309515f;
constexpr int ECAP = 8192;
constexpr int PMAX = 32768;

constexpr size_t al256(size_t x) { return (x + 255) & ~(size_t)255; }
constexpr size_t XCD_BAR_BYTES = 16384;
constexpr size_t WS_BAR = 0;
constexpr size_t WS_CNT = WS_BAR + XCD_BAR_BYTES;
constexpr size_t WS_CTL_END = WS_CNT + al256(DEPTH * 64 * 4);
constexpr size_t WS_SSQ = WS_CTL_END;
constexpr size_t WS_ROPE = WS_SSQ + al256((size_t)T * 16 * 4);
constexpr size_t WS_XB = WS_ROPE + al256((size_t)T * 112 * 4);
constexpr size_t WS_H2F = WS_XB + al256((size_t)T * D * 2);
constexpr size_t WS_CQ = WS_H2F + al256((size_t)T * D * 4);
constexpr size_t WS_CKV = WS_CQ + al256((size_t)T * 512 * 2);
constexpr size_t WS_QB = WS_CKV + al256((size_t)T * 512 * 2);
constexpr size_t WS_KB = WS_QB + al256((size_t)T * 1024 * 2);
constexpr size_t WS_VB = WS_KB + al256((size_t)T * 1024 * 2);
constexpr size_t WS_QI = WS_VB + al256((size_t)T * 1024 * 2);
constexpr size_t WS_KI = WS_QI + al256((size_t)T * 1024 * 2);
constexpr size_t WS_WI = WS_KI + al256((size_t)T * 64 * 2);
constexpr size_t WS_GA = WS_WI + al256((size_t)T * 16 * 4);
constexpr size_t WS_GB = WS_GA + al256((size_t)T * D * 2);
constexpr size_t WS_QA = WS_GB + al256((size_t)T * D * 2);
constexpr size_t WS_KA = WS_QA + al256((size_t)T * 1536 * 2);
constexpr size_t WS_VA = WS_KA + al256((size_t)T * 1536 * 2);
constexpr size_t WS_MASK = WS_VA + al256((size_t)T * 1024 * 2);
constexpr size_t WS_OA = WS_MASK + al256((size_t)T * 128 * 4);
constexpr size_t WS_OB = WS_OA + al256((size_t)T * 1024 * 2);
constexpr size_t WS_YT = WS_OB + al256((size_t)T * 1024 * 2);
constexpr size_t WS_Y = WS_YT + al256((size_t)T * D * 4);
constexpr size_t WS_V1 = WS_Y + al256((size_t)T * D * 2);
constexpr size_t WS_H1F = WS_V1 + al256((size_t)T * D * 4);
constexpr size_t WS_H1B = WS_H1F + al256((size_t)T * D * 4);
constexpr size_t WS_TOKE = WS_H1B + al256((size_t)T * D * 2);
constexpr size_t WS_TOKW = WS_TOKE + al256((size_t)T * 2 * 4);
constexpr size_t WS_TOKS = WS_TOKW + al256((size_t)T * 2 * 4);
constexpr size_t WS_LIST = WS_TOKS + al256((size_t)T * 2 * 4);
constexpr size_t WS_HID = WS_LIST + al256((size_t)NE * ECAP * 4);
constexpr size_t WS_YE = WS_HID + al256((size_t)PMAX * FE * 2);
constexpr size_t WS_END = WS_YE + al256((size_t)PMAX * D * 2);

static_assert(WS_KB == WS_QB + (size_t)T * 1024 * 2 && WS_VB == WS_KB + (size_t)T * 1024 * 2 && WS_GB == WS_GA + (size_t)T * D * 2, "QB|KB|VB and GA|GB must be consecutive");
struct Params {
    const float* x; const int* pos;
    const float *w_in, *g_q, *w_qb, *g_kv, *w_kvb, *w_oa, *w_ob, *w_out, *ln1g, *ln1b, *w_group, *b_group, *w_router, *b_router, *w_eg, *w_eu, *w_ed, *ln2g, *ln2b;
    float* out; unsigned char* ws;
};

__device__ __forceinline__ float bf2f(bf16_t v) { return __uint_as_float((unsigned)v << 16); }
__device__ __forceinline__ bf16_t f2bf(float f) { unsigned u = __float_as_uint(f); u += 0x7fffu + ((u >> 16) & 1u); return (bf16_t)(u >> 16); }
__device__ __forceinline__ unsigned pk2(float a, float b) { return (unsigned)f2bf(a) | ((unsigned)f2bf(b) << 16); }
__device__ __forceinline__ void st4bf(bf16_t* p, f32x4 v) { u32x2 w; w.x = pk2(v[0], v[1]); w.y = pk2(v[2], v[3]); *(u32x2*)p = w; }
__device__ __forceinline__ float wave_sum(float v) {
#pragma unroll
    for (int o = 32; o >= 1; o >>= 1) v += __shfl_xor(v, o);
    return v;
}
__device__ __forceinline__ float wave_max(float v) {
#pragma unroll
    for (int o = 32; o >= 1; o >>= 1) v = fmaxf(v, __shfl_xor(v, o));
    return v;
}
__device__ __forceinline__ int block_sum_int(int v, int* red) {
#pragma unroll
    for (int o = 32; o >= 1; o >>= 1) v += __shfl_xor(v, o);
    if ((threadIdx.x & 63) == 0) red[threadIdx.x >> 6] = v;
    __syncthreads();
    int t = 0;
#pragma unroll
    for (int i = 0; i < 8; ++i) t += red[i];
    __syncthreads();
    return t;
}
__device__ __forceinline__ f32x4 rot4(f32x4 v, float c0, float s0, float c1, float s1) { f32x4 o; o[0] = v[0] * c0 - v[1] * s0; o[1] = v[1] * c0 + v[0] * s0; o[2] = v[2] * c1 - v[3] * s1; o[3] = v[3] * c1 + v[2] * s1; return o; }

#define XB_TMO      128
#define XB_XCNT(j)  (256  + 64 * (j))
#define XB_XSUB(j)  (1280 + 64 * (j))
#define XB_XGEN(j)  (2304 + 64 * (j))
#define XB_TOP      3328
#define XB_TOPGEN   3392
#define XCD_BAR_WORDS 3456
#define XB_SPIN_CAP (1u << 22)
#define LAS __attribute__((address_space(3)))
__device__ __forceinline__ unsigned xb_ld(unsigned* p)              { return __hip_atomic_load(p, __ATOMIC_RELAXED, __HIP_MEMORY_SCOPE_AGENT); }
__device__ __forceinline__ unsigned xb_add(unsigned* p, unsigned v) { return __hip_atomic_fetch_add(p, v, __ATOMIC_RELAXED, __HIP_MEMORY_SCOPE_AGENT); }
__device__ __forceinline__ unsigned xb_xcc_id() { return (unsigned)__builtin_amdgcn_s_getreg((3 << 11) | 20) & 0xFu; }
#define XB_SPIN(cond, bar) do { unsigned _sp = 0; while (cond) { __builtin_amdgcn_s_sleep(1); \
    if ((++_sp & 255u) == 0u) { if (xb_ld(&(bar)[XB_TMO])) break; if (_sp > XB_SPIN_CAP) { atomicAdd(&(bar)[XB_TMO], 1u); break; } } } } while (0)
struct XcdBarrier { unsigned* bar; unsigned x; volatile LAS unsigned* st; };
__device__ __forceinline__ XcdBarrier xcd_barrier_post(unsigned* bar, volatile LAS unsigned* st) {
    XcdBarrier b; b.bar = bar; b.x = xb_xcc_id(); b.st = st;
    if (threadIdx.x == 0) (void)xb_add(&bar[XB_XCNT(b.x)], 1u);
    return b;
}
__device__ __forceinline__ void xcd_barrier_complete(unsigned* bar, unsigned x, unsigned& nloc, unsigned& nx) {
    const unsigned G = gridDim.x * gridDim.y * gridDim.z;
    unsigned sum, cnt, mine, sp = 0u;
    for (;;) {
        sum = 0u; cnt = 0u; mine = 0u;
#pragma unroll
        for (unsigned j = 0; j < 16; ++j) { const unsigned c = xb_ld(&bar[XB_XCNT(j)]); sum += c; cnt += (c > 0u) ? 1u : 0u; mine = (j == x) ? c : mine; }
        if (sum == G) break;
        __builtin_amdgcn_s_sleep(1);
        if ((++sp & 255u) == 0u) { if (xb_ld(&bar[XB_TMO])) break; if (sp > XB_SPIN_CAP) { atomicAdd(&bar[XB_TMO], 1u); break; } }
    }
    nloc = mine > 0u ? mine : 1u; nx = cnt > 0u ? cnt : 1u;
}
__device__ __forceinline__ void xcd_barrier(const XcdBarrier& b) {
    asm volatile("s_waitcnt vmcnt(0)" ::: "memory");
    __syncthreads();
    if (threadIdx.x == 0) {
        unsigned* bar = b.bar;
        __builtin_amdgcn_s_waitcnt(0);
        unsigned nloc = b.st[0], nx = b.st[1];
        if (nloc == 0u) { xcd_barrier_complete(bar, b.x, nloc, nx); b.st[0] = nloc; b.st[1] = nx; }
        const unsigned old = xb_add(&bar[XB_XSUB(b.x)], 1u);
        const unsigned gen = old / nloc;
        if (old + 1u == (gen + 1u) * nloc) {
            __builtin_amdgcn_fence(__ATOMIC_RELEASE, "agent");
            asm volatile("s_waitcnt vmcnt(0)" ::: "memory");
            const unsigned og = xb_add(&bar[XB_TOP], 1u);
            const unsigned tg = og / nx;
            if (og + 1u == (tg + 1u) * nx) xb_add(&bar[XB_TOPGEN], 1u);
            else XB_SPIN(xb_ld(&bar[XB_TOPGEN]) == tg, bar);
            __builtin_amdgcn_fence(__ATOMIC_ACQUIRE, "agent");
            xb_add(&bar[XB_XGEN(b.x)], 1u);
            asm volatile("s_waitcnt vmcnt(0)" ::: "memory");
        } else {
            XB_SPIN(xb_ld(&bar[XB_XGEN(b.x)]) == gen, bar);
            __builtin_amdgcn_fence(__ATOMIC_ACQUIRE, "agent");
            asm volatile("s_waitcnt vmcnt(0)" ::: "memory");
        }
    }
    __syncthreads();
}

template <class Epi>
__device__ __forceinline__ void ngemm(float* lds, const bf16_t* A, int lda, int M, const float* W, int ldw, int N, int K, const Epi& E) {
    float* As = lds;
    float* Ws = lds + 32 * 132;
    const int tid = threadIdx.x, ty = tid >> 4, tx = tid & 15;
    const int ntn = N / 64, ntiles = (M / 128) * ntn;
    for (int tile = blockIdx.x; tile < ntiles; tile += gridDim.x) {
        const int tm = tile / ntn, tn = tile % ntn;
        f32x4 acc0 = {0.f, 0.f, 0.f, 0.f}, acc1 = acc0, acc2 = acc0, acc3 = acc0;
        const int ar = tid >> 2, akq = (tid & 3) * 8;
        const int wk = tid >> 4, wn4 = (tid & 15) * 4;
        const int sc0 = E.src(tn * 64 + wn4), sc1 = E.src(tn * 64 + wn4 + 1), sc2 = E.src(tn * 64 + wn4 + 2), sc3 = E.src(tn * 64 + wn4 + 3);
        const bf16_t* ap = A + (size_t)(tm * 128 + ar) * lda + akq;
        for (int k0 = 0; k0 < K; k0 += 32) {
            __syncthreads();
            { const u32x4 raw = *(const u32x4*)(ap + k0);
              float* dst = As + akq * 132 + ar; const int kb = k0 + akq;
              dst[0 * 132] = __uint_as_float(raw.x << 16) * E.kscale(kb);             dst[1 * 132] = __uint_as_float(raw.x & 0xffff0000u) * E.kscale(kb + 1);
              dst[2 * 132] = __uint_as_float(raw.y << 16) * E.kscale(kb + 2);         dst[3 * 132] = __uint_as_float(raw.y & 0xffff0000u) * E.kscale(kb + 3);
              dst[4 * 132] = __uint_as_float(raw.z << 16) * E.kscale(kb + 4);         dst[5 * 132] = __uint_as_float(raw.z & 0xffff0000u) * E.kscale(kb + 5);
              dst[6 * 132] = __uint_as_float(raw.w << 16) * E.kscale(kb + 6);         dst[7 * 132] = __uint_as_float(raw.w & 0xffff0000u) * E.kscale(kb + 7); }
            { const float* wrow = W + (size_t)(k0 + wk) * ldw; f32x4 wv;
              wv[0] = sc0 >= 0 ? wrow[sc0] : 0.f; wv[1] = sc1 >= 0 ? wrow[sc1] : 0.f; wv[2] = sc2 >= 0 ? wrow[sc2] : 0.f; wv[3] = sc3 >= 0 ? wrow[sc3] : 0.f;
              *(f32x4*)(Ws + wk * 64 + wn4) = wv; }
            __syncthreads();
#pragma unroll 8
            for (int kk = 0; kk < 32; ++kk) {
                const f32x4 a = *(const f32x4*)(As + kk * 132 + ty * 4);
                const f32x4 w = *(const f32x4*)(Ws + kk * 64 + tx * 4);
                acc0 += a[0] * w; acc1 += a[1] * w; acc2 += a[2] * w; acc3 += a[3] * w;
            }
        }
        const int r0 = tm * 128 + ty * 4, c0 = tn * 64 + tx * 4;
        E.apply4(r0, c0, acc0); E.apply4(r0 + 1, c0, acc1); E.apply4(r0 + 2, c0, acc2); E.apply4(r0 + 3, c0, acc3);
    }
    __syncthreads();
}

__device__ __forceinline__ f32x4 bf4(u32x2 g) { f32x4 o; o[0] = __uint_as_float(g.x << 16); o[1] = __uint_as_float(g.x & 0xffff0000u); o[2] = __uint_as_float(g.y << 16); o[3] = __uint_as_float(g.y & 0xffff0000u); return o; }
struct EpiIn {
    bf16_t *CQ, *CKV, *QB, *KB, *VB, *QI, *GA, *GB, *KA, *KI; float *WI, *part; const float *cM, *sM, *cD, *sD, *cI, *sI;
    __device__ __forceinline__ float kscale(int) const { return 1.f; }
    __device__ __forceinline__ int src(int n) const {
        if (n < 1024) return n;
        if (n < 4096) { const int seg = (n - 1024) >> 10, c = (n - 1024) & 1023, d = c & 127; int od = d; if (seg < 2 && d < 32) od = (d >> 1) + (d & 1) * 16; return 1088 + seg * 1024 + (c & ~127) + od; }
        if (n < 5120) { const int c = n - 4096, d = c & 63; const int od = d < 16 ? (d >> 1) + (d & 1) * 8 : d; return 4160 + (c & ~63) + od; }
        if (n < 7168) return 5264 + (n - 5120);
        if (n < 9216) return 7312 + (n - 7168);
        if (n < 9280) { const int d = n - 9216; return 1024 + (d >> 1) + (d & 1) * 32; }
        if (n < 9344) { const int d = n - 9280; const int od = d < 16 ? (d >> 1) + (d & 1) * 8 : d; return 5184 + od; }
        if (n < 9360) return 5248 + (n - 9344);
        return -1;
    }
    __device__ __forceinline__ void apply4(int t, int n, f32x4 v) const {
        if (n < 1024) {
            if (n < 512) st4bf(CQ + (size_t)t * 512 + n, v); else st4bf(CKV + (size_t)t * 512 + (n - 512), v);
            float sq = v[0] * v[0] + v[1] * v[1] + v[2] * v[2] + v[3] * v[3];
            sq += __shfl_xor(sq, 1); sq += __shfl_xor(sq, 2); sq += __shfl_xor(sq, 4); sq += __shfl_xor(sq, 8);
            if ((threadIdx.x & 15) == 0) part[(size_t)t * 16 + (n >> 6)] = sq;
        }
        else if (n < 4096) {
            const int seg = (n - 1024) >> 10, c = (n - 1024) & 1023, d = c & 127;
            if (seg < 2 && d < 32) { const int i0 = t * 16 + (d >> 1); v = rot4(v, cD[i0], sD[i0], cD[i0 + 1], sD[i0 + 1]); }
            st4bf(QB + (size_t)seg * ((size_t)T * 1024) + (size_t)t * 1024 + c, v);
        } else if (n < 5120) {
            const int c = n - 4096, d = c & 63;
            if (d < 16) { const int i0 = t * 8 + (d >> 1); v = rot4(v, cI[i0], sI[i0], cI[i0 + 1], sI[i0 + 1]); }
            st4bf(QI + (size_t)t * 1024 + c, v);
        } else if (n < 9216) {
            f32x4 o; o[0] = 1.f / (1.f + __expf(-v[0])); o[1] = 1.f / (1.f + __expf(-v[1])); o[2] = 1.f / (1.f + __expf(-v[2])); o[3] = 1.f / (1.f + __expf(-v[3]));
            const int gs = (n - 5120) >> 11; st4bf(GA + (size_t)gs * ((size_t)T * D) + (size_t)t * D + ((n - 5120) & 2047), o);
        } else if (n < 9280) {
            const int d = n - 9216, i0 = t * 32 + (d >> 1);
            v = rot4(v, cM[i0], sM[i0], cM[i0 + 1], sM[i0 + 1]);
#pragma unroll
            for (int h = 0; h < 8; ++h) st4bf(KA + (size_t)t * 1536 + h * 192 + 128 + d, v);
        } else if (n < 9344) {
            const int d = n - 9280;
            if (d < 16) { const int i0 = t * 8 + (d >> 1); v = rot4(v, cI[i0], sI[i0], cI[i0 + 1], sI[i0 + 1]); }
            st4bf(KI + (size_t)t * 64 + d, v);
        } else if (n < 9360) {
            *(f32x4*)(WI + (size_t)t * 16 + (n - 9344)) = v * 0.03125f;
        }
    }
};
struct EpiQA {
    bf16_t* QA; const float *part, *g, *cM, *sM;
    __device__ __forceinline__ float kscale(int k) const { return g[k]; }
    __device__ __forceinline__ int src(int n) const { const int h = n / 192, d = n - h * 192; if (d < 128) return n; const int dd = d - 128; return h * 192 + 128 + (dd >> 1) + (dd & 1) * 32; }
    __device__ __forceinline__ void apply4(int t, int n, f32x4 v) const {
        const f32x4 pa = *(const f32x4*)(part + (size_t)t * 16), pb = *(const f32x4*)(part + (size_t)t * 16 + 4);
        v = v * rsqrtf((((pa[0] + pa[1]) + (pa[2] + pa[3])) + ((pb[0] + pb[1]) + (pb[2] + pb[3]))) * (1.f / 512.f) + 1e-6f);
        const int h = n / 192, d = n - h * 192;
        if (d >= 128) { const int i0 = t * 32 + ((d - 128) >> 1); v = rot4(v, cM[i0], sM[i0], cM[i0 + 1], sM[i0 + 1]); }
        st4bf(QA + (size_t)t * 1536 + n, v);
    }
};
struct EpiKV {
    bf16_t *KA, *VA; const float *part, *g;
    __device__ __forceinline__ float kscale(int k) const { return g[k]; }
    __device__ __forceinline__ int src(int n) const { return n; }
    __device__ __forceinline__ void apply4(int t, int n, f32x4 v) const {
        const f32x4 pa = *(const f32x4*)(part + (size_t)t * 16 + 8), pb = *(const f32x4*)(part + (size_t)t * 16 + 12);
        v = v * rsqrtf((((pa[0] + pa[1]) + (pa[2] + pa[3])) + ((pb[0] + pb[1]) + (pb[2] + pb[3]))) * (1.f / 512.f) + 1e-6f);
        const int h = n >> 8, d = n & 255;
        if (d < 128) st4bf(KA + (size_t)t * 1536 + h * 192 + d, v); else st4bf(VA + (size_t)t * 1024 + h * 128 + (d - 128), v);
    }
};
struct EpiYA {
    float* YT; const bf16_t* GA;
    __device__ __forceinline__ float kscale(int) const { return 1.f; }
    __device__ __forceinline__ int src(int n) const { return n; }
    __device__ __forceinline__ void apply4(int t, int n, f32x4 v) const {
        *(f32x4*)(YT + (size_t)t * D + n) = v * bf4(*(const u32x2*)(GA + (size_t)t * D + n));
    }
};
struct EpiYB {
    const float* YT; const bf16_t* GB; bf16_t* Y;
    __device__ __forceinline__ float kscale(int) const { return 1.f; }
    __device__ __forceinline__ int src(int n) const { return n; }
    __device__ __forceinline__ void apply4(int t, int n, f32x4 v) const {
        const f32x4 y = *(const f32x4*)(YT + (size_t)t * D + n);
        st4bf(Y + (size_t)t * D + n, y + v * bf4(*(const u32x2*)(GB + (size_t)t * D + n)));
    }
};
struct EpiOut {
    const float* hin; float* V1;
    __device__ __forceinline__ float kscale(int) const { return 1.f; }
    __device__ __forceinline__ int src(int n) const { return n; }
    __device__ __forceinline__ void apply4(int t, int n, f32x4 v) const {
        const f32x4 h = *(const f32x4*)(hin + (size_t)t * D + n);
        *(f32x4*)(V1 + (size_t)t * D + n) = h * ALPHA + v;
    }
};

__device__ __forceinline__ void p_prologue(const Params& p) {
    float* rope = (float*)(p.ws + WS_ROPE);
    float *cM = rope, *sM = rope + T * 32, *cD = rope + T * 64, *sD = rope + T * 80, *cI = rope + T * 96, *sI = rope + T * 104;
    const int gtid = blockIdx.x * NTHREADS + threadIdx.x, gstride = gridDim.x * NTHREADS;
    for (int idx = gtid; idx < T * 56; idx += gstride) {
        const int t = idx / 56, j = idx - t * 56;
        int rot, i; float *ct, *st; int w;
        if (j < 32) { rot = 64; i = j; ct = cM; st = sM; w = 32; } else if (j < 48) { rot = 32; i = j - 32; ct = cD; st = sD; w = 16; } else { rot = 16; i = j - 48; ct = cI; st = sI; w = 8; }
        const float inv = exp2f(-((float)(2 * i) / (float)rot) * 18.931568569324174f);
        const float ang = (float)p.pos[t] * inv;
        double rev = (double)ang * 0.15915494309189535; rev -= rint(rev);
        const float r = (float)(rev * 6.283185307179586);
        ct[t * w + i] = __cosf(r); st[t * w + i] = __sinf(r);
    }
    bf16_t* XB = (bf16_t*)(p.ws + WS_XB);
    for (size_t i = (size_t)gtid * 4; i < (size_t)T * D; i += (size_t)gstride * 4) {
        st4bf(XB + i, *(const f32x4*)(p.x + i));
    }
}

__device__ __forceinline__ unsigned f2key(float f) { const unsigned u = __float_as_uint(f); return (u & 0x80000000u) ? ~u : (u | 0x80000000u); }
__device__ __forceinline__ void p_index(float* lds, const Params& p) {
    const bf16_t* QI = (const bf16_t*)(p.ws + WS_QI); const bf16_t* KI = (const bf16_t*)(p.ws + WS_KI); const float* WI = (const float*)(p.ws + WS_WI);
    unsigned* MASK = (unsigned*)(p.ws + WS_MASK);
    float* qs = lds; float* wsc = lds + 1024; float* sc = lds + 1040; int* red = (int*)(lds + 1040 + 4096);
    const int tid = threadIdx.x, lane = tid & 63, wv = tid >> 6;
    for (int t = blockIdx.x; t < T; t += gridDim.x) {
        const int b = t >> 12, ti = t & 4095, nk = ti + 1;
        __syncthreads();
        for (int i = tid; i < 1024; i += NTHREADS) qs[i] = bf2f(QI[(size_t)t * 1024 + i]);
        if (tid < 16) wsc[tid] = WI[(size_t)t * 16 + tid];
        __syncthreads();
        for (int s = tid; s < nk; s += NTHREADS) {
            const bf16_t* kr = KI + (size_t)(b * S + s) * 64;
            float score = 0.f;
#pragma unroll 1
            for (int h = 0; h < 16; ++h) {
                asm volatile("" ::: "memory");
                float dot = 0.f;
#pragma unroll
                for (int c = 0; c < 8; ++c) {
                    const u32x4 raw = *(const u32x4*)(kr + c * 8);
                    const f32x4 q0 = *(const f32x4*)(qs + h * 64 + c * 8), q1 = *(const f32x4*)(qs + h * 64 + c * 8 + 4);
                    dot = fmaf(q0[0], __uint_as_float(raw.x << 16), dot); dot = fmaf(q0[1], __uint_as_float(raw.x & 0xffff0000u), dot);
                    dot = fmaf(q0[2], __uint_as_float(raw.y << 16), dot); dot = fmaf(q0[3], __uint_as_float(raw.y & 0xffff0000u), dot);
                    dot = fmaf(q1[0], __uint_as_float(raw.z << 16), dot); dot = fmaf(q1[1], __uint_as_float(raw.z & 0xffff0000u), dot);
                    dot = fmaf(q1[2], __uint_as_float(raw.w << 16), dot); dot = fmaf(q1[3], __uint_as_float(raw.w & 0xffff0000u), dot);
                }
                score = fmaf(wsc[h], fmaxf(dot, 0.f), score);
            }
            sc[s] = score;
        }
        __syncthreads();
        unsigned k0 = 0u, k1 = 0u, k2 = 0u, k3 = 0u, k4 = 0u, k5 = 0u, k6 = 0u, k7 = 0u;
        if (tid < nk) k0 = f2key(sc[tid]);
        if (tid + 512 < nk) k1 = f2key(sc[tid + 512]);
        if (tid + 1024 < nk) k2 = f2key(sc[tid + 1024]);
        if (tid + 1536 < nk) k3 = f2key(sc[tid + 1536]);
        if (tid + 2048 < nk) k4 = f2key(sc[tid + 2048]);
        if (tid + 2560 < nk) k5 = f2key(sc[tid + 2560]);
        if (tid + 3072 < nk) k6 = f2key(sc[tid + 3072]);
        if (tid + 3584 < nk) k7 = f2key(sc[tid + 3584]);
        unsigned res = 0u;
        if (nk > 256) {
#pragma unroll 1
            for (int bit = 31; bit >= 0; --bit) {
                const unsigned cand = res | (1u << bit);
                const int c = (k0 >= cand) + (k1 >= cand) + (k2 >= cand) + (k3 >= cand) + (k4 >= cand) + (k5 >= cand) + (k6 >= cand) + (k7 >= cand);
                if (block_sum_int(c, red) >= 256) res = cand;
            }
        }
        unsigned* mw = MASK + (size_t)t * 128 + 2 * wv;
#define MASK_OUT(j, kj) do { const unsigned long long bal = __ballot((tid + 512 * (j) < nk) && ((kj) >= res)); if (lane == 0) { mw[16 * (j)] = (unsigned)bal; mw[16 * (j) + 1] = (unsigned)(bal >> 32); } } while (0)
        MASK_OUT(0, k0); MASK_OUT(1, k1); MASK_OUT(2, k2); MASK_OUT(3, k3); MASK_OUT(4, k4); MASK_OUT(5, k5); MASK_OUT(6, k6); MASK_OUT(7, k7);
#undef MASK_OUT
    }
    __syncthreads();
}

template <int DQK, bool MASKED>
__device__ __forceinline__ void nattn(float* lds, const bf16_t* Q, const bf16_t* Kp, int ldk, const bf16_t* Vp, const unsigned* mask, bf16_t* O, float scale) {
    float* qs = lds; float* scb = lds + 8 * 192;
    const int tid = threadIdx.x, lane = tid & 63, h = tid >> 6;
    float* sc = scb + h * 4096;
    for (int t = blockIdx.x; t < T; t += gridDim.x) {
        const int b = t >> 12, ti = t & 4095, nk = ti + 1;
        __syncthreads();
        for (int i = tid; i < 8 * DQK; i += NTHREADS) qs[i] = bf2f(Q[(size_t)t * (8 * DQK) + i]);
        __syncthreads();
        const float* q = qs + h * DQK;
        float mx = -__builtin_inff();
        for (int s0 = 0; s0 < nk; s0 += 64) {
            const int s = s0 + lane; float v = -__builtin_inff();
            bool on = s < nk;
            if (MASKED && on) on = (mask[(size_t)t * 128 + (s >> 5)] >> (s & 31)) & 1u;
            if (on) {
                const bf16_t* kr = Kp + (size_t)(b * S + s) * ldk + h * DQK;
                float dot = 0.f;
#pragma unroll 4
                for (int c = 0; c < DQK / 8; ++c) { const u32x4 raw = *(const u32x4*)(kr + c * 8); const unsigned w[4] = {raw.x, raw.y, raw.z, raw.w};
#pragma unroll
                    for (int j = 0; j < 4; ++j) { dot = fmaf(q[c * 8 + 2 * j], __uint_as_float(w[j] << 16), dot); dot = fmaf(q[c * 8 + 2 * j + 1], __uint_as_float(w[j] & 0xffff0000u), dot); } }
                v = dot * scale;
            }
            if (s < nk) sc[s] = v;
            mx = fmaxf(mx, v);
        }
        mx = wave_max(mx);
        __syncthreads();
        float sum = 0.f;
        for (int s = lane; s < nk; s += 64) { const float pz = __expf(sc[s] - mx); sc[s] = pz; sum += pz; }
        sum = wave_sum(sum);
        __syncthreads();
        float a0 = 0.f, a1 = 0.f;
        const bf16_t* vb = Vp + (size_t)(b * S) * 1024 + h * 128 + lane * 2;
        for (int s = 0; s < nk; ++s) {
            const float pz = sc[s];
            if (pz != 0.f) { const unsigned w = *(const unsigned*)(vb + (size_t)s * 1024); a0 = fmaf(pz, __uint_as_float(w << 16), a0); a1 = fmaf(pz, __uint_as_float(w & 0xffff0000u), a1); }
        }
        const float inv = 1.f / sum;
        *(unsigned*)(O + (size_t)t * 1024 + h * 128 + lane * 2) = pk2(a0 * inv, a1 * inv);
    }
    __syncthreads();
}

__device__ __forceinline__ void p_ln1_route(float* lds, const Params& p, int l) {
    const float* V1 = (const float*)(p.ws + WS_V1); float* H1F = (float*)(p.ws + WS_H1F); bf16_t* H1B = (bf16_t*)(p.ws + WS_H1B);
    unsigned* cnt = (unsigned*)(p.ws + WS_CNT) + l * 64; int* LIST = (int*)(p.ws + WS_LIST);
    int* TOKE = (int*)(p.ws + WS_TOKE); float* TOKW = (float*)(p.ws + WS_TOKW); int* TOKS = (int*)(p.ws + WS_TOKS);
    const float* g = p.ln1g + (size_t)l * D; const float* bb = p.ln1b + (size_t)l * D;
    const float* wr = p.w_router + (size_t)l * D * 64; const float* wg = p.w_group + (size_t)l * D * 8;
    const float* br = p.b_router + l * 64; const float* bg = p.b_group + l * 8;
    const int tid = threadIdx.x, lane = tid & 63, wv = tid >> 6;
    float* lg = lds + wv * 80;
    for (int t0 = blockIdx.x * 8; t0 < T; t0 += gridDim.x * 8) {
        const int t = t0 + wv;
        float s1 = 0.f;
#pragma unroll 4
        for (int j = 0; j < 32; ++j) s1 += V1[(size_t)t * D + lane + 64 * j];
        const float mean = wave_sum(s1) * (1.f / D);
        float s2 = 0.f;
#pragma unroll 4
        for (int j = 0; j < 32; ++j) { const float d = V1[(size_t)t * D + lane + 64 * j] - mean; s2 += d * d; }
        const float rstd = rsqrtf(wave_sum(s2) * (1.f / D) + 1e-5f);
        float acc[72];
#pragma unroll
        for (int e = 0; e < 72; ++e) acc[e] = 0.f;
#pragma unroll 1
        for (int j = 0; j < 32; ++j) {
            const int k = lane + 64 * j;
            const float hk = (V1[(size_t)t * D + k] - mean) * rstd * g[k] + bb[k];
            H1F[(size_t)t * D + k] = hk; H1B[(size_t)t * D + k] = f2bf(hk);
            const float* wrow = wr + (size_t)k * 64;
#pragma unroll
            for (int e4 = 0; e4 < 16; ++e4) { const f32x4 w = *(const f32x4*)(wrow + e4 * 4);
                acc[e4 * 4] = fmaf(hk, w[0], acc[e4 * 4]); acc[e4 * 4 + 1] = fmaf(hk, w[1], acc[e4 * 4 + 1]); acc[e4 * 4 + 2] = fmaf(hk, w[2], acc[e4 * 4 + 2]); acc[e4 * 4 + 3] = fmaf(hk, w[3], acc[e4 * 4 + 3]); }
            const float* grow = wg + (size_t)k * 8;
            const f32x4 w0 = *(const f32x4*)grow, w1 = *(const f32x4*)(grow + 4);
            acc[64] = fmaf(hk, w0[0], acc[64]); acc[65] = fmaf(hk, w0[1], acc[65]); acc[66] = fmaf(hk, w0[2], acc[66]); acc[67] = fmaf(hk, w0[3], acc[67]);
            acc[68] = fmaf(hk, w1[0], acc[68]); acc[69] = fmaf(hk, w1[1], acc[69]); acc[70] = fmaf(hk, w1[2], acc[70]); acc[71] = fmaf(hk, w1[3], acc[71]);
        }
#pragma unroll
        for (int e = 0; e < 72; ++e) { const float r = wave_sum(acc[e]); if (lane == 0) lg[e] = r; }
        __syncthreads();
        if (lane == 0) {
            float gl[8]; float gmax = -__builtin_inff(); int gi = 0;
#pragma unroll
            for (int i = 0; i < 8; ++i) { gl[i] = lg[64 + i] + bg[i]; if (gl[i] > gmax) { gmax = gl[i]; gi = i; } }
            float gs = 0.f;
#pragma unroll
            for (int i = 0; i < 8; ++i) gs += __expf(gl[i] - gmax);
            const float gp = 1.f / gs;
            float el[8]; float emax = -__builtin_inff(); int e1 = 0;
#pragma unroll
            for (int i = 0; i < 8; ++i) { el[i] = lg[gi * 8 + i] + br[gi * 8 + i]; if (el[i] > emax) { emax = el[i]; e1 = i; } }
            float e2max = -__builtin_inff(); int e2 = 0;
#pragma unroll
            for (int i = 0; i < 8; ++i) { if (i != e1 && el[i] > e2max) { e2max = el[i]; e2 = i; } }
            const float p1 = 1.f, p2 = __expf(e2max - emax);
            const float wa = gp * p1 / (p1 + p2), wb = gp * p2 / (p1 + p2);
            const int ea = gi * 8 + e1, eb = gi * 8 + e2;
            const int sa = (int)atomicAdd(cnt + ea, 1u), sb = (int)atomicAdd(cnt + eb, 1u);
            LIST[(size_t)ea * ECAP + sa] = t; LIST[(size_t)eb * ECAP + sb] = t;
            TOKE[t * 2] = ea; TOKE[t * 2 + 1] = eb; TOKW[t * 2] = wa; TOKW[t * 2 + 1] = wb; TOKS[t * 2] = sa; TOKS[t * 2 + 1] = sb;
        }
        __syncthreads();
    }
}

__device__ __forceinline__ void moe_tables(int* tab, const unsigned* cnt, int items_per_rb) {
    if (threadIdx.x == 0) { int a = 0, bsum = 0; for (int e = 0; e < 64; ++e) { tab[e] = a; tab[80 + e] = bsum; const int c = (int)cnt[e]; a += ((c + 127) / 128) * items_per_rb; bsum += ((c + 255) / 256) * 256; } tab[64] = a; tab[80 + 64] = bsum; }
    __syncthreads();
}
__device__ __forceinline__ void p_moe1(float* lds, const Params& p, int l) {
    const unsigned* cnt = (const unsigned*)(p.ws + WS_CNT) + l * 64; const int* LIST = (const int*)(p.ws + WS_LIST);
    const bf16_t* H1B = (const bf16_t*)(p.ws + WS_H1B); bf16_t* HID = (bf16_t*)(p.ws + WS_HID);
    float* As = lds; float* Wg = lds + 32 * 132; float* Wu = Wg + 32 * 64; int* tab = (int*)(Wu + 32 * 64);
    __syncthreads();
    moe_tables(tab, cnt, 8);
    const int tid = threadIdx.x, ty = tid >> 4, tx = tid & 15;
    const int total = tab[64];
    for (int item = blockIdx.x; item < total; item += gridDim.x) {
        int e = 0; while (tab[e + 1] <= item) ++e;
        const int local = item - tab[e], rb = local >> 3, ct = local & 7, ce = (int)cnt[e], base = tab[80 + e];
        const float* wgp = p.w_eg + ((size_t)(l * 64 + e) * D) * FE + ct * 64;
        const float* wup = p.w_eu + ((size_t)(l * 64 + e) * D) * FE + ct * 64;
        const f32x4 z4 = {0.f, 0.f, 0.f, 0.f};
        f32x4 ag0 = z4, ag1 = z4, ag2 = z4, ag3 = z4, au0 = z4, au1 = z4, au2 = z4, au3 = z4;
        const int ar = tid >> 2, akq = (tid & 3) * 8, wk = tid >> 4, wn4 = (tid & 15) * 4;
        const int ai = rb * 128 + ar; const int tok = ai < ce ? LIST[(size_t)e * ECAP + ai] : -1;
        const bf16_t* ap = H1B + (size_t)(tok < 0 ? 0 : tok) * D + akq;
        for (int k0 = 0; k0 < D; k0 += 32) {
            __syncthreads();
            { u32x4 raw = *(const u32x4*)(ap + k0); if (tok < 0) raw = (u32x4){0u, 0u, 0u, 0u};
              float* dst = As + akq * 132 + ar;
              dst[0 * 132] = __uint_as_float(raw.x << 16); dst[1 * 132] = __uint_as_float(raw.x & 0xffff0000u); dst[2 * 132] = __uint_as_float(raw.y << 16); dst[3 * 132] = __uint_as_float(raw.y & 0xffff0000u);
              dst[4 * 132] = __uint_as_float(raw.z << 16); dst[5 * 132] = __uint_as_float(raw.z & 0xffff0000u); dst[6 * 132] = __uint_as_float(raw.w << 16); dst[7 * 132] = __uint_as_float(raw.w & 0xffff0000u); }
            *(f32x4*)(Wg + wk * 64 + wn4) = *(const f32x4*)(wgp + (size_t)(k0 + wk) * FE + wn4);
            *(f32x4*)(Wu + wk * 64 + wn4) = *(const f32x4*)(wup + (size_t)(k0 + wk) * FE + wn4);
            __syncthreads();
#pragma unroll 4
            for (int kk = 0; kk < 32; ++kk) {
                const f32x4 a = *(const f32x4*)(As + kk * 132 + ty * 4);
                const f32x4 g4 = *(const f32x4*)(Wg + kk * 64 + tx * 4);
                const f32x4 u4 = *(const f32x4*)(Wu + kk * 64 + tx * 4);
                ag0 += a[0] * g4; ag1 += a[1] * g4; ag2 += a[2] * g4; ag3 += a[3] * g4;
                au0 += a[0] * u4; au1 += a[1] * u4; au2 += a[2] * u4; au3 += a[3] * u4;
            }
        }
#define MOE1_OUT(i, G_, U_) do { const int ri = rb * 128 + ty * 4 + (i); if (ri < ce) { f32x4 o; \
            o[0] = G_[0] / (1.f + __expf(-G_[0])) * U_[0]; o[1] = G_[1] / (1.f + __expf(-G_[1])) * U_[1]; o[2] = G_[2] / (1.f + __expf(-G_[2])) * U_[2]; o[3] = G_[3] / (1.f + __expf(-G_[3])) * U_[3]; \
            st4bf(HID + (size_t)(base + ri) * FE + ct * 64 + tx * 4, o); } } while (0)
        MOE1_OUT(0, ag0, au0); MOE1_OUT(1, ag1, au1); MOE1_OUT(2, ag2, au2); MOE1_OUT(3, ag3, au3);
#undef MOE1_OUT
    }
    __syncthreads();
}
__device__ __forceinline__ void p_moe2(float* lds, const Params& p, int l) {
    const unsigned* cnt = (const unsigned*)(p.ws + WS_CNT) + l * 64;
    const bf16_t* HID = (const bf16_t*)(p.ws + WS_HID); bf16_t* YE = (bf16_t*)(p.ws + WS_YE);
    float* As = lds; float* Ws = lds + 32 * 132; int* tab = (int*)(Ws + 32 * 64 * 2);
    __syncthreads();
    moe_tables(tab, cnt, 32);
    const int tid = threadIdx.x, ty = tid >> 4, tx = tid & 15;
    const int total = tab[64];
    for (int item = blockIdx.x; item < total; item += gridDim.x) {
        int e = 0; while (tab[e + 1] <= item) ++e;
        const int local = item - tab[e], rb = local >> 5, ct = local & 31, ce = (int)cnt[e], base = tab[80 + e];
        const float* wdp = p.w_ed + ((size_t)(l * 64 + e) * FE) * D + ct * 64;
        f32x4 acc0 = {0.f, 0.f, 0.f, 0.f}, acc1 = acc0, acc2 = acc0, acc3 = acc0;
        const int ar = tid >> 2, akq = (tid & 3) * 8, wk = tid >> 4, wn4 = (tid & 15) * 4;
        const int ai = rb * 128 + ar; const bool av = ai < ce;
        const bf16_t* ap = HID + (size_t)(base + (av ? ai : 0)) * FE + akq;
        for (int k0 = 0; k0 < FE; k0 += 32) {
            __syncthreads();
            { u32x4 raw = *(const u32x4*)(ap + k0); if (!av) raw = (u32x4){0u, 0u, 0u, 0u};
              float* dst = As + akq * 132 + ar;
              dst[0 * 132] = __uint_as_float(raw.x << 16); dst[1 * 132] = __uint_as_float(raw.x & 0xffff0000u); dst[2 * 132] = __uint_as_float(raw.y << 16); dst[3 * 132] = __uint_as_float(raw.y & 0xffff0000u);
              dst[4 * 132] = __uint_as_float(raw.z << 16); dst[5 * 132] = __uint_as_float(raw.z & 0xffff0000u); dst[6 * 132] = __uint_as_float(raw.w << 16); dst[7 * 132] = __uint_as_float(raw.w & 0xffff0000u); }
            *(f32x4*)(Ws + wk * 64 + wn4) = *(const f32x4*)(wdp + (size_t)(k0 + wk) * D + wn4);
            __syncthreads();
#pragma unroll 8
            for (int kk = 0; kk < 32; ++kk) {
                const f32x4 a = *(const f32x4*)(As + kk * 132 + ty * 4);
                const f32x4 w = *(const f32x4*)(Ws + kk * 64 + tx * 4);
                acc0 += a[0] * w; acc1 += a[1] * w; acc2 += a[2] * w; acc3 += a[3] * w;
            }
        }
        { const int ri = rb * 128 + ty * 4; bf16_t* yo = YE + (size_t)(base + ri) * D + ct * 64 + tx * 4;
          if (ri < ce) st4bf(yo, acc0); if (ri + 1 < ce) st4bf(yo + D, acc1); if (ri + 2 < ce) st4bf(yo + 2 * D, acc2); if (ri + 3 < ce) st4bf(yo + 3 * D, acc3); }
    }
    __syncthreads();
}
__device__ __forceinline__ void p_ln2(float* lds, const Params& p, int l) {
    const unsigned* cnt = (const unsigned*)(p.ws + WS_CNT) + l * 64;
    const float* H1F = (const float*)(p.ws + WS_H1F); const bf16_t* YE = (const bf16_t*)(p.ws + WS_YE);
    const int* TOKE = (const int*)(p.ws + WS_TOKE); const float* TOKW = (const float*)(p.ws + WS_TOKW); const int* TOKS = (const int*)(p.ws + WS_TOKS);
    float* outF = (l == DEPTH - 1) ? p.out : (float*)(p.ws + WS_H2F); bf16_t* XB = (bf16_t*)(p.ws + WS_XB);
    const float* g = p.ln2g + (size_t)l * D; const float* bb = p.ln2b + (size_t)l * D;
    int* tab = (int*)lds;
    __syncthreads();
    moe_tables(tab, cnt, 1);
    const int tid = threadIdx.x, lane = tid & 63, wv = tid >> 6;
    for (int t0 = blockIdx.x * 8; t0 < T; t0 += gridDim.x * 8) {
        const int t = t0 + wv;
        const int r0 = tab[80 + TOKE[t * 2]] + TOKS[t * 2], r1 = tab[80 + TOKE[t * 2 + 1]] + TOKS[t * 2 + 1];
        const float w0 = TOKW[t * 2], w1 = TOKW[t * 2 + 1];
        const float* hrow = H1F + (size_t)t * D; const bf16_t* y0 = YE + (size_t)r0 * D; const bf16_t* y1 = YE + (size_t)r1 * D;
        float s1 = 0.f;
#pragma unroll 4
        for (int j = 0; j < 32; ++j) { const int k = lane + 64 * j; s1 += ALPHA * hrow[k] + w0 * bf2f(y0[k]) + w1 * bf2f(y1[k]); }
        const float mean = wave_sum(s1) * (1.f / D);
        float s2 = 0.f;
#pragma unroll 4
        for (int j = 0; j < 32; ++j) { const int k = lane + 64 * j; const float d = ALPHA * hrow[k] + w0 * bf2f(y0[k]) + w1 * bf2f(y1[k]) - mean; s2 += d * d; }
        const float rstd = rsqrtf(wave_sum(s2) * (1.f / D) + 1e-5f);
#pragma unroll 4
        for (int j = 0; j < 32; ++j) { const int k = lane + 64 * j; const float v = ALPHA * hrow[k] + w0 * bf2f(y0[k]) + w1 * bf2f(y1[k]);
            const float o = (v - mean) * rstd * g[k] + bb[k];
            outF[(size_t)t * D + k] = o; if (l != DEPTH - 1) XB[(size_t)t * D + k] = f2bf(o); }
    }
    __syncthreads();
}

constexpr int NPH = 10;
#ifndef PH_MASK
#define PH_MASK 0x3ff
#endif
#define PHON(k) ((PH_MASK >> (k)) & 1)
__global__ void __launch_bounds__(NTHREADS, 2) hybrid_fwd(Params p, int ph_lo, int ph_hi) {
    extern __shared__ __attribute__((aligned(16))) unsigned char lds_raw[];
    float* lds = (float*)lds_raw;
    volatile LAS unsigned* xbw = (volatile LAS unsigned*)(lds_raw + LDS_BYTES - 16);
    if (threadIdx.x == 0) { xbw[0] = 0u; xbw[1] = 0u; xbw[2] = 0u; xbw[3] = 0u; }
    __syncthreads();
    XcdBarrier bar; bar.bar = (unsigned*)(p.ws + WS_BAR); bar.x = 0; bar.st = xbw;
    if (ph_lo < ph_hi) bar = xcd_barrier_post((unsigned*)(p.ws + WS_BAR), xbw);
#define IN(ph) ((ph) >= ph_lo && (ph) <= ph_hi)
#define GRID_BAR(ph) do { if ((ph) >= ph_lo && (ph) < ph_hi) xcd_barrier(bar); } while (0)
    unsigned char* ws = p.ws;
    float* rope = (float*)(ws + WS_ROPE);
    const float *cM = rope, *sM = rope + T * 32, *cD = rope + T * 64, *sD = rope + T * 80, *cI = rope + T * 96, *sI = rope + T * 104;
    for (int l = 0; l < DEPTH; ++l) {
        const int pb = l * NPH;
        float* part = (float*)(ws + WS_SSQ);
        if (PHON(0) && IN(pb + 0)) { if (l == 0) p_prologue(p); }
        GRID_BAR(pb + 0);
        if (PHON(1) && IN(pb + 1)) {
            EpiIn E; E.CQ = (bf16_t*)(ws + WS_CQ); E.CKV = (bf16_t*)(ws + WS_CKV); E.QB = (bf16_t*)(ws + WS_QB); E.KB = (bf16_t*)(ws + WS_KB); E.VB = (bf16_t*)(ws + WS_VB);
            E.QI = (bf16_t*)(ws + WS_QI); E.GA = (bf16_t*)(ws + WS_GA); E.GB = (bf16_t*)(ws + WS_GB); E.KA = (bf16_t*)(ws + WS_KA); E.KI = (bf16_t*)(ws + WS_KI);
            E.WI = (float*)(ws + WS_WI); E.part = part; E.cM = cM; E.sM = sM; E.cD = cD; E.sD = sD; E.cI = cI; E.sI = sI;
            ngemm(lds, (const bf16_t*)(ws + WS_XB), D, T, p.w_in + (size_t)l * D * INW, INW, INP, D, E);
        }
        GRID_BAR(pb + 1);
        if (PHON(2) && IN(pb + 2)) {
            { EpiQA E; E.QA = (bf16_t*)(ws + WS_QA); E.part = part; E.g = p.g_q + l * 512; E.cM = cM; E.sM = sM;
              ngemm(lds, (const bf16_t*)(ws + WS_CQ), 512, T, p.w_qb + (size_t)l * 512 * 1536, 1536, 1536, 512, E); }
            { EpiKV E; E.KA = (bf16_t*)(ws + WS_KA); E.VA = (bf16_t*)(ws + WS_VA); E.part = part; E.g = p.g_kv + l * 512;
              ngemm(lds, (const bf16_t*)(ws + WS_CKV), 512, T, p.w_kvb + (size_t)l * 512 * 2048, 2048, 2048, 512, E); }
            p_index(lds, p);
        }
        GRID_BAR(pb + 2);
        if (PHON(3) && IN(pb + 3)) {
            nattn<192, false>(lds, (const bf16_t*)(ws + WS_QA), (const bf16_t*)(ws + WS_KA), 1536, (const bf16_t*)(ws + WS_VA), nullptr, (bf16_t*)(ws + WS_OA), 0.07216878364870322f);
            nattn<128, true>(lds, (const bf16_t*)(ws + WS_QB), (const bf16_t*)(ws + WS_KB), 1024, (const bf16_t*)(ws + WS_VB), (const unsigned*)(ws + WS_MASK), (bf16_t*)(ws + WS_OB), 0.08838834764831845f);
        }
        GRID_BAR(pb + 3);
        if (PHON(4) && IN(pb + 4)) {
            { EpiYA E; E.YT = (float*)(ws + WS_YT); E.GA = (const bf16_t*)(ws + WS_GA);
              ngemm(lds, (const bf16_t*)(ws + WS_OA), 1024, T, p.w_oa + (size_t)l * 1024 * D, D, D, 1024, E); }
            { EpiYB E; E.YT = (const float*)(ws + WS_YT); E.GB = (const bf16_t*)(ws + WS_GB); E.Y = (bf16_t*)(ws + WS_Y);
              ngemm(lds, (const bf16_t*)(ws + WS_OB), 1024, T, p.w_ob + (size_t)l * 1024 * D, D, D, 1024, E); }
        }
        GRID_BAR(pb + 4);
        if (PHON(5) && IN(pb + 5)) {
            EpiOut E; E.hin = (l == 0) ? p.x : (const float*)(ws + WS_H2F); E.V1 = (float*)(ws + WS_V1);
            ngemm(lds, (const bf16_t*)(ws + WS_Y), D, T, p.w_out + (size_t)l * D * D, D, D, D, E);
        }
        GRID_BAR(pb + 5);
        if (PHON(6) && IN(pb + 6)) p_ln1_route(lds, p, l);
        GRID_BAR(pb + 6);
        if (PHON(7) && IN(pb + 7)) p_moe1(lds, p, l);
        GRID_BAR(pb + 7);
        if (PHON(8) && IN(pb + 8)) p_moe2(lds, p, l);
        GRID_BAR(pb + 8);
        if (PHON(9) && IN(pb + 9)) p_ln2(lds, p, l);
        GRID_BAR(pb + 9);
    }
}

#ifndef MK_ONE_LAUNCH
#define MK_ONE_LAUNCH 1
#endif
extern "C" void kernel_launch(void* const* d_in, const int* in_sizes, int n_in, void* d_out, int out_size, void* d_ws, size_t ws_size, hipStream_t stream) {
    static int grid = 0;
    if (!grid) {
        if (n_in != 21 || in_sizes[0] != T * D || out_size != T * D || ws_size < WS_END) {
            fprintf(stderr, "kernel_launch: unexpected shapes (n_in %d, in0 %d, out %d, ws %zu, need %zu); nothing launched\n", n_in, n_in > 0 ? in_sizes[0] : -1, out_size, ws_size, (size_t)WS_END);
            grid = -1; return; }
        int dev = 0, cus = 0, per_cu = 0;
        hipGetDevice(&dev); hipDeviceGetAttribute(&cus, hipDeviceAttributeMultiprocessorCount, dev);
        if (hipFuncSetAttribute((const void*)hybrid_fwd, hipFuncAttributeMaxDynamicSharedMemorySize, LDS_BYTES) != hipSuccess) { fprintf(stderr, "kernel_launch: hipFuncSetAttribute failed\n"); grid = -1; return; }
        hipOccupancyMaxActiveBlocksPerMultiprocessor(&per_cu, (const void*)hybrid_fwd, NTHREADS, LDS_BYTES);
        if (per_cu < 1) fprintf(stderr, "kernel_launch: occupancy query reports %d blocks per CU\n", per_cu);
        grid = cus > 0 ? cus : 256;
    }
    if (grid < 0) return;
    hipMemsetAsync((char*)d_ws, 0, WS_CTL_END, stream);
    Params p{};
    p.x = (const float*)d_in[0]; p.pos = (const int*)d_in[1];
    p.w_in = (const float*)d_in[2]; p.g_q = (const float*)d_in[3]; p.w_qb = (const float*)d_in[4]; p.g_kv = (const float*)d_in[5]; p.w_kvb = (const float*)d_in[6];
    p.w_oa = (const float*)d_in[7]; p.w_ob = (const float*)d_in[8]; p.w_out = (const float*)d_in[9]; p.ln1g = (const float*)d_in[10]; p.ln1b = (const float*)d_in[11];
    p.w_group = (const float*)d_in[12]; p.b_group = (const float*)d_in[13]; p.w_router = (const float*)d_in[14]; p.b_router = (const float*)d_in[15];
    p.w_eg = (const float*)d_in[16]; p.w_eu = (const float*)d_in[17]; p.w_ed = (const float*)d_in[18]; p.ln2g = (const float*)d_in[19]; p.ln2b = (const float*)d_in[20];
    p.out = (float*)d_out; p.ws = (unsigned char*)d_ws;
#if MK_ONE_LAUNCH
    hipLaunchKernelGGL(hybrid_fwd, dim3(grid), dim3(NTHREADS), LDS_BYTES, stream, p, 0, DEPTH * NPH - 1);
#else
    for (int ph = 0; ph < DEPTH * NPH; ++ph) { if (ph == NPH) continue; hipLaunchKernelGGL(hybrid_fwd, dim3(grid), dim3(NTHREADS), LDS_BYTES, stream, p, ph, ph); }
#endif
}
```

```cpp
#include <hip/hip_runtime.h>
#include <cstdio>
#include <cstdint>

typedef unsigned short bf16_t;
typedef float f32x4 __attribute__((ext_vector_type(4)));
typedef unsigned u32x4 __attribute__((ext_vector_type(4)));
typedef unsigned u32x2 __attribute__((ext_vector_type(2)));

constexpr int T = 8192, D = 2048, S = 4096, NB = 2, DEPTH = 2;
constexpr int INW = 9360, INP = 9472;
constexpr int NE = 64, FE = 512;
constexpr int NTHREADS = 512;
constexpr int LDS_BYTES = 147456;
constexpr float ALPHA = 1.41421356237309515f;
constexpr int ECAP = 8192;
constexpr int PMAX = 32768;

constexpr size_t al256(size_t x) { return (x + 255) & ~(size_t)255; }
constexpr size_t XCD_BAR_BYTES = 16384;
constexpr size_t WS_BAR = 0;
constexpr size_t WS_CNT = WS_BAR + XCD_BAR_BYTES;
constexpr size_t WS_CTL_END = WS_CNT + al256(DEPTH * 64 * 4);
constexpr size_t WS_SSQ = WS_CTL_END;
constexpr size_t WS_ROPE = WS_SSQ + al256((size_t)T * 32 * 4);
constexpr size_t WS_XB = WS_ROPE + al256((size_t)T * 112 * 4);
constexpr size_t WS_H2F = WS_XB + al256((size_t)T * D * 2);
constexpr size_t WS_CQ = WS_H2F + al256((size_t)T * D * 4);
constexpr size_t WS_CKV = WS_CQ + al256((size_t)T * 512 * 2);
constexpr size_t WS_QB = WS_CKV + al256((size_t)T * 512 * 2);
constexpr size_t WS_KB = WS_QB + al256((size_t)T * 1024 * 2);
constexpr size_t WS_VB = WS_KB + al256((size_t)T * 1024 * 2);
constexpr size_t WS_QI = WS_VB + al256((size_t)T * 1024 * 2);
constexpr size_t WS_KI = WS_QI + al256((size_t)T * 1024 * 2);
constexpr size_t WS_WI = WS_KI + al256((size_t)T * 64 * 2);
constexpr size_t WS_GA = WS_WI + al256((size_t)T * 16 * 4);
constexpr size_t WS_GB = WS_GA + al256((size_t)T * D * 2);
constexpr size_t WS_QA = WS_GB + al256((size_t)T * D * 2);
constexpr size_t WS_KA = WS_QA + al256((size_t)T * 1536 * 2);
constexpr size_t WS_VA = WS_KA + al256((size_t)T * 1536 * 2);
constexpr size_t WS_MASK = WS_VA + al256((size_t)T * 1024 * 2);
constexpr size_t WS_OA = WS_MASK + al256((size_t)T * 128 * 4);
constexpr size_t WS_OB = WS_OA + al256((size_t)T * 1024 * 2);
constexpr size_t WS_YT = WS_OB + al256((size_t)T * 1024 * 2);
constexpr size_t WS_Y = WS_YT + al256((size_t)T * D * 4);
constexpr size_t WS_V1 = WS_Y + al256((size_t)T * D * 2);
constexpr size_t WS_H1F = WS_V1 + al256((size_t)T * D * 4);
constexpr size_t WS_H1B = WS_H1F + al256((size_t)T * D * 4);
constexpr size_t WS_TOKE = WS_H1B + al256((size_t)T * D * 2);
constexpr size_t WS_TOKW = WS_TOKE + al256((size_t)T * 2 * 4);
constexpr size_t WS_TOKS = WS_TOKW + al256((size_t)T * 2 * 4);
constexpr size_t WS_LIST = WS_TOKS + al256((size_t)T * 2 * 4);
constexpr size_t WS_HID = WS_LIST + al256((size_t)NE * ECAP * 4);
constexpr size_t WS_YE = WS_HID + al256((size_t)PMAX * FE * 2);
constexpr size_t WS_WIN_T = WS_YE + al256((size_t)PMAX * D * 2);
constexpr size_t WS_WQB_T = WS_WIN_T + al256((size_t)DEPTH * INP * D * 2);
constexpr size_t WS_WKVB_T = WS_WQB_T + al256((size_t)DEPTH * 1536 * 512 * 2);
constexpr size_t WS_WOA_T = WS_WKVB_T + al256((size_t)DEPTH * 2048 * 512 * 2);
constexpr size_t WS_WOB_T = WS_WOA_T + al256((size_t)DEPTH * D * 1024 * 2);
constexpr size_t WS_WOUT_T = WS_WOB_T + al256((size_t)DEPTH * D * 1024 * 2);
constexpr size_t WS_END = WS_WOUT_T + al256((size_t)DEPTH * D * D * 2);
static_assert(WS_CKV == WS_CQ + (size_t)T * 512 * 2, "CQ|CKV must be consecutive");

static_assert(WS_KB == WS_QB + (size_t)T * 1024 * 2 && WS_VB == WS_KB + (size_t)T * 1024 * 2 && WS_GB == WS_GA + (size_t)T * D * 2, "QB|KB|VB and GA|GB must be consecutive");
struct Params {
    const float* x; const int* pos;
    const float *w_in, *g_q, *w_qb, *g_kv, *w_kvb, *w_oa, *w_ob, *w_out, *ln1g, *ln1b, *w_group, *b_group, *w_router, *b_router, *w_eg, *w_eu, *w_ed, *ln2g, *ln2b;
    float* out; unsigned char* ws;
};

__device__ __forceinline__ float bf2f(bf16_t v) { return __uint_as_float((unsigned)v << 16); }
__device__ __forceinline__ bf16_t f2bf(float f) { unsigned u = __float_as_uint(f); u += 0x7fffu + ((u >> 16) & 1u); return (bf16_t)(u >> 16); }
__device__ __forceinline__ unsigned pk2(float a, float b) { return (unsigned)f2bf(a) | ((unsigned)f2bf(b) << 16); }
__device__ __forceinline__ void st4bf(bf16_t* p, f32x4 v) { u32x2 w; w.x = pk2(v[0], v[1]); w.y = pk2(v[2], v[3]); *(u32x2*)p = w; }
__device__ __forceinline__ float wave_sum(float v) {
#pragma unroll
    for (int o = 32; o >= 1; o >>= 1) v += __shfl_xor(v, o);
    return v;
}
__device__ __forceinline__ float wave_max(float v) {
#pragma unroll
    for (int o = 32; o >= 1; o >>= 1) v = fmaxf(v, __shfl_xor(v, o));
    return v;
}
__device__ __forceinline__ int block_sum_int(int v, int* red) {
#pragma unroll
    for (int o = 32; o >= 1; o >>= 1) v += __shfl_xor(v, o);
    if ((threadIdx.x & 63) == 0) red[threadIdx.x >> 6] = v;
    __syncthreads();
    int t = 0;
#pragma unroll
    for (int i = 0; i < 8; ++i) t += red[i];
    __syncthreads();
    return t;
}
__device__ __forceinline__ f32x4 rot4(f32x4 v, float c0, float s0, float c1, float s1) { f32x4 o; o[0] = v[0] * c0 - v[1] * s0; o[1] = v[1] * c0 + v[0] * s0; o[2] = v[2] * c1 - v[3] * s1; o[3] = v[3] * c1 + v[2] * s1; return o; }

#define XB_TMO      128
#define XB_XCNT(j)  (256  + 64 * (j))
#define XB_XSUB(j)  (1280 + 64 * (j))
#define XB_XGEN(j)  (2304 + 64 * (j))
#define XB_TOP      3328
#define XB_TOPGEN   3392
#define XCD_BAR_WORDS 3456
#define XB_SPIN_CAP (1u << 22)
#define LAS __attribute__((address_space(3)))
__device__ __forceinline__ unsigned xb_ld(unsigned* p)              { return __hip_atomic_load(p, __ATOMIC_RELAXED, __HIP_MEMORY_SCOPE_AGENT); }
__device__ __forceinline__ unsigned xb_add(unsigned* p, unsigned v) { return __hip_atomic_fetch_add(p, v, __ATOMIC_RELAXED, __HIP_MEMORY_SCOPE_AGENT); }
__device__ __forceinline__ unsigned xb_xcc_id() { return (unsigned)__builtin_amdgcn_s_getreg((3 << 11) | 20) & 0xFu; }
#define XB_SPIN(cond, bar) do { unsigned _sp = 0; while (cond) { __builtin_amdgcn_s_sleep(1); \
    if ((++_sp & 255u) == 0u) { if (xb_ld(&(bar)[XB_TMO])) break; if (_sp > XB_SPIN_CAP) { atomicAdd(&(bar)[XB_TMO], 1u); break; } } } } while (0)
struct XcdBarrier { unsigned* bar; unsigned x; volatile LAS unsigned* st; };
__device__ __forceinline__ XcdBarrier xcd_barrier_post(unsigned* bar, volatile LAS unsigned* st) {
    XcdBarrier b; b.bar = bar; b.x = xb_xcc_id(); b.st = st;
    if (threadIdx.x == 0) (void)xb_add(&bar[XB_XCNT(b.x)], 1u);
    return b;
}
__device__ __forceinline__ void xcd_barrier_complete(unsigned* bar, unsigned x, unsigned& nloc, unsigned& nx) {
    const unsigned G = gridDim.x * gridDim.y * gridDim.z;
    unsigned sum, cnt, mine, sp = 0u;
    for (;;) {
        sum = 0u; cnt = 0u; mine = 0u;
#pragma unroll
        for (unsigned j = 0; j < 16; ++j) { const unsigned c = xb_ld(&bar[XB_XCNT(j)]); sum += c; cnt += (c > 0u) ? 1u : 0u; mine = (j == x) ? c : mine; }
        if (sum == G) break;
        __builtin_amdgcn_s_sleep(1);
        if ((++sp & 255u) == 0u) { if (xb_ld(&bar[XB_TMO])) break; if (sp > XB_SPIN_CAP) { atomicAdd(&bar[XB_TMO], 1u); break; } }
    }
    nloc = mine > 0u ? mine : 1u; nx = cnt > 0u ? cnt : 1u;
}
__device__ __forceinline__ void xcd_barrier(const XcdBarrier& b) {
    asm volatile("s_waitcnt vmcnt(0)" ::: "memory");
    __syncthreads();
    if (threadIdx.x == 0) {
        unsigned* bar = b.bar;
        __builtin_amdgcn_s_waitcnt(0);
        unsigned nloc = b.st[0], nx = b.st[1];
        if (nloc == 0u) { xcd_barrier_complete(bar, b.x, nloc, nx); b.st[0] = nloc; b.st[1] = nx; }
        const unsigned old = xb_add(&bar[XB_XSUB(b.x)], 1u);
        const unsigned gen = old / nloc;
        if (old + 1u == (gen + 1u) * nloc) {
            __builtin_amdgcn_fence(__ATOMIC_RELEASE, "agent");
            asm volatile("s_waitcnt vmcnt(0)" ::: "memory");
            const unsigned og = xb_add(&bar[XB_TOP], 1u);
            const unsigned tg = og / nx;
            if (og + 1u == (tg + 1u) * nx) xb_add(&bar[XB_TOPGEN], 1u);
            else XB_SPIN(xb_ld(&bar[XB_TOPGEN]) == tg, bar);
            __builtin_amdgcn_fence(__ATOMIC_ACQUIRE, "agent");
            xb_add(&bar[XB_XGEN(b.x)], 1u);
            asm volatile("s_waitcnt vmcnt(0)" ::: "memory");
        } else {
            XB_SPIN(xb_ld(&bar[XB_XGEN(b.x)]) == gen, bar);
            __builtin_amdgcn_fence(__ATOMIC_ACQUIRE, "agent");
            asm volatile("s_waitcnt vmcnt(0)" ::: "memory");
        }
    }
    __syncthreads();
}

__device__ __forceinline__ int opaque_tid() { int t = threadIdx.x; asm volatile("" : "+v"(t)); return t; }
namespace pg8 {
#define PG8_LAS __attribute__((address_space(3)))
typedef unsigned short bf16_t;
typedef short bf16x8 __attribute__((ext_vector_type(8)));
typedef float f32x4 __attribute__((ext_vector_type(4)));
typedef unsigned u32x4 __attribute__((ext_vector_type(4)));
constexpr int BM = 256, BK = 64, HALF = 128, HTB = HALF * BK * 2  , STAGE_BYTES = 8 * HTB, NXCD = 8, WGM = 8;

__host__ __device__ __forceinline__ int lds_byte(int r, int c) { const int st = (r >> 4) * 2 + (c >> 5), rr = r & 15, cc = c & 31, ob = rr * 64 + cc * 2; return st * 1024 + (ob ^ (((ob >> 9) & 1) << 5)); }
__host__ __device__ __forceinline__ void stage_rc(int b, int& R, int& C) { const int st = b / 1024, sb = b % 1024, swz = sb ^ (((sb >> 9) & 1) << 5); R = (st >> 1) * 16 + swz / 64; C = (st & 1) * 32 + (swz % 64) / 2; }
__host__ __device__ __forceinline__ int perm32(int rho) { const int n = rho >> 4, i = rho & 15; return 8 * (i >> 2) + 4 * n + (i & 3); }

struct Unit { int pm, pn; };
struct Gemm { const bf16_t* A; const bf16_t* Bt; int M, N, K; };

struct StaticOrder {
    int nM, nN, nwg, G, c;
    __host__ __device__ void init(int M, int N, int G_, int c_) { nM = M / BM; nN = N / BM; nwg = nM * nN; G = G_; c = c_; }
    __host__ __device__ bool next(int i, Unit& u) const {
        const long L = (long)i * G + c; if (L >= nwg) return false;
        int wgid = (int)L; { const int q = nwg / NXCD, r = nwg % NXCD, xcd = wgid % NXCD, off = wgid / NXCD; wgid = (xcd < r ? xcd * (q + 1) : r * (q + 1) + (xcd - r) * q) + off; }
        const int nig = WGM * nN, gid = wgid / nig, fm = gid * WGM, gsz = (nM - fm) < WGM ? (nM - fm) : WGM;
        u.pm = fm + ((wgid % nig) % gsz); u.pn = (wgid % nig) / gsz; return true;
    }
    __device__ __forceinline__ void a_ready(const Unit&) const {}
    __device__ __forceinline__ void done(const Unit&) const {}
};

__device__ __forceinline__ unsigned cvt_pk_bf16(float lo, float hi) { unsigned r; asm volatile("v_cvt_pk_bf16_f32 %0, %1, %2" : "=v"(r) : "v"(lo), "v"(hi)); return r; }
template <class Epi, class Sched, bool ALIGN_EPI = false, bool SP2 = false>
__device__ __forceinline__ void gemm_phase(PG8_LAS unsigned char* lds, const Gemm g, const Sched& S, const Epi& E) {
    const int tid = opaque_tid(), wid = __builtin_amdgcn_readfirstlane(tid >> 6), lane = tid & 63, wr = wid >> 2, wc = wid & 3, fr = lane & 15, fq = lane >> 4;
    const int K = g.K, nt = K / BK;
    unsigned voffA[2], voffB[2];
#pragma unroll
    for (int i = 0; i < 2; ++i) { int R, C; stage_rc(tid * 16 + i * 8192, R, C); const int Rb = Epi::PERM ? ((R & ~31) + perm32(R & 31)) : R;
        voffA[i] = (unsigned)(R * K + C) * 2u; voffB[i] = (unsigned)(Rb * K + C) * 2u; }
    const size_t kstep = (size_t)(BK * 2);
    const size_t hstep = (size_t)HALF * K * 2;
    const size_t tstep = 2 * hstep;
    const unsigned ldsw = (unsigned)wid * 1024u;
    const int aoff = lds_byte(wr * 64 + fr, fq * 8), boff = lds_byte(wc * 32 + fr, fq * 8);
#define PG8_SA(b, h) (((b) * 2 + (h)) * HTB)
#define PG8_SB(b, h) ((4 + (b) * 2 + (h)) * HTB)
#define PG8_STAGE(bufoff, gbase, voff) do { _Pragma("unroll") for (int _i = 0; _i < 2; ++_i) \
        __builtin_amdgcn_global_load_lds((const unsigned*)((const char*)(gbase) + (voff)[_i]), (PG8_LAS unsigned*)(lds + (bufoff) + ldsw + _i * 8192), 16, 0, 0); } while (0)
#define PG8_LDA(dst, b, h) do { _Pragma("unroll") for (int m = 0; m < 4; ++m) _Pragma("unroll") for (int k = 0; k < 2; ++k) dst[m][k] = *(const PG8_LAS bf16x8*)(lds + PG8_SA(b, h) + aoff + m * 2048 + k * 1024); } while (0)
#define PG8_LDB(dst, b, h) do { _Pragma("unroll") for (int n = 0; n < 2; ++n) _Pragma("unroll") for (int k = 0; k < 2; ++k) dst[n][k] = *(const PG8_LAS bf16x8*)(lds + PG8_SB(b, h) + boff + n * 2048 + k * 1024); } while (0)
#define PG8_MMA(ai, bj, At, Bt) do { __builtin_amdgcn_s_setprio(1); _Pragma("unroll") for (int m = 0; m < 4; ++m) _Pragma("unroll") for (int n = 0; n < 2; ++n) _Pragma("unroll") for (int k = 0; k < 2; ++k) \
        acc[ai][bj][m][n] = __builtin_amdgcn_mfma_f32_16x16x32_bf16(Bt[n][k], At[m][k], acc[ai][bj][m][n], 0, 0, 0); __builtin_amdgcn_s_setprio(0); } while (0)
#define PG8_WAIT_V(n) asm volatile("s_waitcnt vmcnt(" #n ")" ::: "memory")
#define PG8_WAIT_L(n) asm volatile("s_waitcnt lgkmcnt(" #n ")" ::: "memory")
#define PG8_BAR __builtin_amdgcn_s_barrier()
#define PG8_SCHED __builtin_amdgcn_sched_barrier(0)
    Unit cur, nxt; int ui = 0;
    if (!S.next(0, cur)) return;
    f32x4 acc[2][2][4][2];
#pragma unroll
    for (int a = 0; a < 2; ++a)
#pragma unroll
        for (int b = 0; b < 2; ++b)
#pragma unroll
            for (int m = 0; m < 4; ++m)
#pragma unroll
                for (int n = 0; n < 2; ++n) acc[a][b][m][n] = (f32x4){0.f, 0.f, 0.f, 0.f};
    bf16x8 At[4][2], B0[2][2], B1[2][2];
    const char* cA = (const char*)g.A + (size_t)cur.pm * tstep; const char* cB = (const char*)g.Bt + (size_t)cur.pn * tstep;
    S.a_ready(cur);
    if constexpr (SP2) {
        PG8_STAGE(PG8_SB(0, 0), cB, voffB); PG8_STAGE(PG8_SB(0, 1), cB + hstep, voffB); PG8_STAGE(PG8_SA(0, 0), cA, voffA); PG8_STAGE(PG8_SA(0, 1), cA + hstep, voffA);
        if (wr == 1) PG8_BAR;
        PG8_WAIT_V(2); PG8_BAR;
        PG8_STAGE(PG8_SB(1, 0), cB + kstep, voffB); PG8_STAGE(PG8_SA(1, 0), cA + kstep, voffA); PG8_STAGE(PG8_SB(1, 1), cB + hstep + kstep, voffB);
        PG8_WAIT_V(6); PG8_BAR;
    } else {
        PG8_STAGE(PG8_SB(0, 0), cB, voffB); PG8_STAGE(PG8_SA(0, 0), cA, voffA); PG8_STAGE(PG8_SB(0, 1), cB + hstep, voffB); PG8_STAGE(PG8_SA(0, 1), cA + hstep, voffA);
        if (wr == 1) PG8_BAR;
        PG8_WAIT_V(4); PG8_BAR;
        PG8_STAGE(PG8_SB(1, 0), cB + kstep, voffB); PG8_STAGE(PG8_SA(1, 0), cA + kstep, voffA); PG8_STAGE(PG8_SB(1, 1), cB + hstep + kstep, voffB);
        PG8_WAIT_V(6); PG8_BAR;
    }
    for (;;) {
        const bool has_next = S.next(ui + 1, nxt);
        const char* nA = has_next ? (const char*)g.A + (size_t)nxt.pm * tstep : cA; const char* nB = has_next ? (const char*)g.Bt + (size_t)nxt.pn * tstep : cB;
        for (int t = 0; t < nt; t += 2) {
            const bool last = (t == nt - 2);
            const char* a1 = cA + (size_t)(t + 1) * kstep;
            const char* a2 = last ? nA : cA + (size_t)(t + 2) * kstep; const char* b2 = last ? nB : cB + (size_t)(t + 2) * kstep;
            const char* a3 = a2 + kstep; const char* b3 = b2 + kstep;
            if (last && has_next) S.a_ready(nxt);
            if constexpr (SP2) {
            PG8_LDB(B0, 0, 0); PG8_LDB(B1, 0, 1); PG8_SCHED; PG8_LDA(At, 0, 0); PG8_STAGE(PG8_SA(1, 1), a1 + hstep, voffA);
            PG8_WAIT_V(8); PG8_WAIT_L(0); PG8_BAR; PG8_MMA(0, 0, At, B0); PG8_MMA(0, 1, At, B1); PG8_BAR; PG8_SCHED;
            PG8_LDA(At, 0, 1); PG8_STAGE(PG8_SB(0, 0), b2, voffB); PG8_STAGE(PG8_SB(0, 1), b2 + hstep, voffB); PG8_STAGE(PG8_SA(0, 0), a2, voffA);
            PG8_WAIT_V(8); PG8_WAIT_L(0); PG8_BAR; PG8_MMA(1, 0, At, B0); PG8_MMA(1, 1, At, B1); PG8_BAR; PG8_SCHED;
            PG8_LDB(B0, 1, 0); PG8_LDB(B1, 1, 1); PG8_SCHED; PG8_LDA(At, 1, 0); PG8_STAGE(PG8_SA(0, 1), a2 + hstep, voffA);
            PG8_WAIT_V(8); PG8_WAIT_L(0); PG8_BAR; PG8_MMA(0, 0, At, B0); PG8_MMA(0, 1, At, B1); PG8_BAR; PG8_SCHED;
            PG8_LDA(At, 1, 1); PG8_STAGE(PG8_SB(1, 0), b3, voffB); PG8_STAGE(PG8_SB(1, 1), b3 + hstep, voffB); PG8_STAGE(PG8_SA(1, 0), a3, voffA);
            PG8_WAIT_V(8); PG8_WAIT_L(0); PG8_BAR; PG8_MMA(1, 0, At, B0); PG8_MMA(1, 1, At, B1); PG8_BAR; PG8_SCHED;
            } else {
            PG8_LDB(B0, 0, 0); PG8_SCHED; PG8_LDA(At, 0, 0); PG8_STAGE(PG8_SA(1, 1), a1 + hstep, voffA);
            PG8_WAIT_L(8); PG8_BAR; PG8_WAIT_L(0); PG8_MMA(0, 0, At, B0); PG8_BAR; PG8_SCHED;
            PG8_LDB(B1, 0, 1); PG8_STAGE(PG8_SB(0, 0), b2, voffB);
            PG8_BAR; PG8_WAIT_L(0); PG8_MMA(0, 1, At, B1); PG8_BAR;
            PG8_LDA(At, 0, 1); PG8_STAGE(PG8_SA(0, 0), a2, voffA);
            PG8_BAR; PG8_WAIT_L(0); PG8_MMA(1, 0, At, B0); PG8_BAR; PG8_SCHED;
            PG8_STAGE(PG8_SB(0, 1), b2 + hstep, voffB);
            PG8_WAIT_V(6); PG8_BAR; PG8_MMA(1, 1, At, B1); PG8_BAR;
            PG8_LDB(B0, 1, 0); PG8_SCHED; PG8_LDA(At, 1, 0); PG8_STAGE(PG8_SA(0, 1), a2 + hstep, voffA);
            PG8_WAIT_L(8); PG8_BAR; PG8_WAIT_L(0); PG8_MMA(0, 0, At, B0); PG8_BAR; PG8_SCHED;
            PG8_LDB(B1, 1, 1); PG8_STAGE(PG8_SB(1, 0), b3, voffB);
            PG8_BAR; PG8_WAIT_L(0); PG8_MMA(0, 1, At, B1); PG8_BAR;
            PG8_LDA(At, 1, 1); PG8_STAGE(PG8_SA(1, 0), a3, voffA);
            PG8_BAR; PG8_WAIT_L(0); PG8_MMA(1, 0, At, B0); PG8_BAR; PG8_SCHED;
            PG8_STAGE(PG8_SB(1, 1), b3 + hstep, voffB);
            PG8_WAIT_V(6); PG8_BAR; PG8_MMA(1, 1, At, B1); PG8_BAR;
            }
        }
        if constexpr (ALIGN_EPI) { if (wr == 0) PG8_BAR; }
        if constexpr (!Epi::AFTER_DRAIN) { E(acc, cur, wr, wc, fr, fq); S.done(cur); }
        if (!has_next) break;
#pragma unroll
        for (int a = 0; a < 2; ++a)
#pragma unroll
            for (int b = 0; b < 2; ++b)
#pragma unroll
                for (int m = 0; m < 4; ++m)
#pragma unroll
                    for (int n = 0; n < 2; ++n) acc[a][b][m][n] = (f32x4){0.f, 0.f, 0.f, 0.f};
        cur = nxt; cA = nA; cB = nB; ++ui;
        if constexpr (ALIGN_EPI) { if (wr == 1) PG8_BAR; }
    }
    PG8_WAIT_V(0);
    if constexpr (!ALIGN_EPI) { if (wr == 0) PG8_BAR; }
    PG8_BAR;
    if constexpr (Epi::AFTER_DRAIN) { E.fused(acc, cur, wr, wc, fr, fq, lds, wid, lane); S.done(cur); }
#undef PG8_SA
#undef PG8_SB
#undef PG8_STAGE
#undef PG8_LDA
#undef PG8_LDB
#undef PG8_MMA
#undef PG8_WAIT_V
#undef PG8_WAIT_L
#undef PG8_BAR
#undef PG8_SCHED
}
}

__device__ __forceinline__ unsigned pkbf(float lo, float hi) { return pg8::cvt_pk_bf16(lo, hi); }
__device__ __forceinline__ void st8bf(bf16_t* p, f32x4 a, f32x4 b) { u32x4 w; w.x = pkbf(a[0], a[1]); w.y = pkbf(a[2], a[3]); w.z = pkbf(b[0], b[1]); w.w = pkbf(b[2], b[3]); *(u32x4*)p = w; }
__device__ __forceinline__ f32x4 bflo(u32x4 g) { f32x4 o; o[0] = __uint_as_float(g.x << 16); o[1] = __uint_as_float(g.x & 0xffff0000u); o[2] = __uint_as_float(g.y << 16); o[3] = __uint_as_float(g.y & 0xffff0000u); return o; }
__device__ __forceinline__ f32x4 bfhi(u32x4 g) { f32x4 o; o[0] = __uint_as_float(g.z << 16); o[1] = __uint_as_float(g.z & 0xffff0000u); o[2] = __uint_as_float(g.w << 16); o[3] = __uint_as_float(g.w & 0xffff0000u); return o; }
__device__ __forceinline__ void rot8(f32x4& a, f32x4& b, f32x4 c, f32x4 s) {
    const f32x4 x = a, y = b;
    a[0] = x[0] * c[0] - x[1] * s[0]; a[1] = x[1] * c[0] + x[0] * s[0]; a[2] = x[2] * c[1] - x[3] * s[1]; a[3] = x[3] * c[1] + x[2] * s[1];
    b[0] = y[0] * c[2] - y[1] * s[2]; b[1] = y[1] * c[2] + y[0] * s[2]; b[2] = y[2] * c[3] - y[3] * s[3]; b[3] = y[3] * c[3] + y[2] * s[3];
}
__device__ __forceinline__ f32x4 sig4(f32x4 v) { f32x4 o; o[0] = 1.f / (1.f + __expf(-v[0])); o[1] = 1.f / (1.f + __expf(-v[1])); o[2] = 1.f / (1.f + __expf(-v[2])); o[3] = 1.f / (1.f + __expf(-v[3])); return o; }
__host__ __device__ __forceinline__ int src_in(int n) {
    if (n < 1024) return n;
    if (n < 4096) { const int seg = (n - 1024) >> 10, c = (n - 1024) & 1023, d = c & 127; int od = d; if (seg < 2 && d < 32) od = (d >> 1) + (d & 1) * 16; return 1088 + seg * 1024 + (c & ~127) + od; }
    if (n < 5120) { const int c = n - 4096, d = c & 63; const int od = d < 16 ? (d >> 1) + (d & 1) * 8 : d; return 4160 + (c & ~63) + od; }
    if (n < 7168) return 5264 + (n - 5120);
    if (n < 9216) return 7312 + (n - 7168);
    if (n < 9280) { const int d = n - 9216; return 1024 + (d >> 1) + (d & 1) * 32; }
    if (n < 9344) { const int d = n - 9280; const int od = d < 16 ? (d >> 1) + (d & 1) * 8 : d; return 5184 + od; }
    if (n < 9360) return 5248 + (n - 9344);
    return -1;
}
__host__ __device__ __forceinline__ int src_qa(int n) { const int h = n / 192, d = n - h * 192; if (d < 128) return n; const int dd = d - 128; return h * 192 + 128 + (dd >> 1) + (dd & 1) * 32; }

struct EpiIn {
    static constexpr bool PERM = true, AFTER_DRAIN = false;
    unsigned char* ws;
    __device__ __forceinline__ void operator()(const f32x4 (&acc)[2][2][4][2], const pg8::Unit& u, int wr, int wc, int fr, int fq) const {
        const int row0 = u.pm * 256 + wr * 64 + fr, cu = wc * 32 + 8 * fq, pn = u.pn;
        bf16_t* const CQ = (bf16_t*)(ws + WS_CQ); bf16_t* const QB = (bf16_t*)(ws + WS_QB); bf16_t* const QI = (bf16_t*)(ws + WS_QI); bf16_t* const GA = (bf16_t*)(ws + WS_GA);
        bf16_t* const KA = (bf16_t*)(ws + WS_KA); bf16_t* const KI = (bf16_t*)(ws + WS_KI); float* const WI = (float*)(ws + WS_WI); float* const part = (float*)(ws + WS_SSQ);
        const float* const cM = (const float*)(ws + WS_ROPE); const float* const sM = cM + T * 32; const float* const cD = cM + T * 64; const float* const sD = cM + T * 80; const float* const cI = cM + T * 96; const float* const sI = cM + T * 104;
#define EPI_ROWS(BODY) _Pragma("unroll") for (int ai = 0; ai < 2; ++ai) _Pragma("unroll") for (int m = 0; m < 4; ++m) { const int t = row0 + ai * 128 + m * 16; \
            _Pragma("unroll") for (int bj = 0; bj < 2; ++bj) { f32x4 a = acc[ai][bj][m][0], b = acc[ai][bj][m][1]; BODY } }
        if (pn < 4) {
            bf16_t* const dst = CQ + (size_t)(pn >> 1) * ((size_t)T * 512) + (pn & 1) * 256 + cu;
            EPI_ROWS(
                st8bf(dst + (size_t)t * 512 + bj * 128, a, b);
                float sq = ((a[0] * a[0] + a[1] * a[1]) + (a[2] * a[2] + a[3] * a[3])) + ((b[0] * b[0] + b[1] * b[1]) + (b[2] * b[2] + b[3] * b[3]));
                sq += __shfl_xor(sq, 16); sq += __shfl_xor(sq, 32);
                if (fq == 0) part[(size_t)t * 32 + pn * 8 + bj * 4 + wc] = sq; )
        } else if (pn < 16) {
            const int seg = (pn - 4) >> 2; const bool rot = seg < 2 && wc == 0;
            bf16_t* const dst = QB + (size_t)seg * ((size_t)T * 1024) + ((pn - 4) & 3) * 256 + cu;
            EPI_ROWS(
                if (rot) rot8(a, b, *(const f32x4*)(cD + (size_t)t * 16 + 4 * fq), *(const f32x4*)(sD + (size_t)t * 16 + 4 * fq));
                st8bf(dst + (size_t)t * 1024 + bj * 128, a, b); )
        } else if (pn < 20) {
            const bool rot = (wc & 1) == 0 && fq < 2;
            bf16_t* const dst = QI + (pn - 16) * 256 + cu;
            EPI_ROWS(
                if (rot) rot8(a, b, *(const f32x4*)(cI + (size_t)t * 8 + 4 * fq), *(const f32x4*)(sI + (size_t)t * 8 + 4 * fq));
                st8bf(dst + (size_t)t * 1024 + bj * 128, a, b); )
        } else if (pn < 36) {
            bf16_t* const dst = GA + (size_t)((pn - 20) >> 3) * ((size_t)T * D) + ((pn - 20) & 7) * 256 + cu;
            EPI_ROWS( st8bf(dst + (size_t)t * D + bj * 128, sig4(a), sig4(b)); )
        } else {
            EPI_ROWS(
                if (bj == 0) {
                    if (wc < 2) {
                        rot8(a, b, *(const f32x4*)(cM + (size_t)t * 32 + (cu >> 1)), *(const f32x4*)(sM + (size_t)t * 32 + (cu >> 1)));
                        _Pragma("unroll") for (int h = 0; h < 8; ++h) st8bf(KA + (size_t)t * 1536 + h * 192 + 128 + cu, a, b);
                    } else {
                        const int d = cu - 64;
                        if (d < 16) rot8(a, b, *(const f32x4*)(cI + (size_t)t * 8 + (d >> 1)), *(const f32x4*)(sI + (size_t)t * 8 + (d >> 1)));
                        st8bf(KI + (size_t)t * 64 + d, a, b);
                    }
                } else if (cu < 16) {
                    *(f32x4*)(WI + (size_t)t * 16 + cu) = a * 0.03125f; *(f32x4*)(WI + (size_t)t * 16 + cu + 4) = b * 0.03125f;
                } )
        }
#undef EPI_ROWS
    }
};
__device__ __forceinline__ float rms_from_part(const float* pp) {
    const f32x4 p0 = *(const f32x4*)pp, p1 = *(const f32x4*)(pp + 4), p2 = *(const f32x4*)(pp + 8), p3 = *(const f32x4*)(pp + 12);
    const float s = (((p0[0] + p0[1]) + (p0[2] + p0[3])) + ((p1[0] + p1[1]) + (p1[2] + p1[3]))) + (((p2[0] + p2[1]) + (p2[2] + p2[3])) + ((p3[0] + p3[1]) + (p3[2] + p3[3])));
    return rsqrtf(s * (1.f / 512.f) + 1e-6f);
}
struct EpiQA {
    static constexpr bool PERM = true, AFTER_DRAIN = false;
    unsigned char* ws;
    __device__ __forceinline__ void operator()(const f32x4 (&acc)[2][2][4][2], const pg8::Unit& u, int wr, int wc, int fr, int fq) const {
        const int row0 = u.pm * 256 + wr * 64 + fr, cu = wc * 32 + 8 * fq;
        bf16_t* const QA = (bf16_t*)(ws + WS_QA); const float* const part = (const float*)(ws + WS_SSQ); const float* const cM = (const float*)(ws + WS_ROPE); const float* const sM = cM + T * 32;
#pragma unroll
        for (int ai = 0; ai < 2; ++ai)
#pragma unroll
            for (int m = 0; m < 4; ++m) {
                const int t = row0 + ai * 128 + m * 16;
                const float r = rms_from_part(part + (size_t)t * 32);
#pragma unroll
                for (int bj = 0; bj < 2; ++bj) {
                    const int n = u.pn * 256 + bj * 128 + cu, h = n / 192, d = n - h * 192;
                    f32x4 a = acc[ai][bj][m][0] * r, b = acc[ai][bj][m][1] * r;
                    if (d >= 128) rot8(a, b, *(const f32x4*)(cM + (size_t)t * 32 + ((d - 128) >> 1)), *(const f32x4*)(sM + (size_t)t * 32 + ((d - 128) >> 1)));
                    st8bf(QA + (size_t)t * 1536 + n, a, b);
                }
            }
    }
};
struct EpiKV {
    static constexpr bool PERM = true, AFTER_DRAIN = false;
    unsigned char* ws;
    __device__ __forceinline__ void operator()(const f32x4 (&acc)[2][2][4][2], const pg8::Unit& u, int wr, int wc, int fr, int fq) const {
        const int row0 = u.pm * 256 + wr * 64 + fr, cu = wc * 32 + 8 * fq;
        bf16_t* const KA = (bf16_t*)(ws + WS_KA); bf16_t* const VA = (bf16_t*)(ws + WS_VA); const float* const part = (const float*)(ws + WS_SSQ);
#pragma unroll
        for (int ai = 0; ai < 2; ++ai)
#pragma unroll
            for (int m = 0; m < 4; ++m) {
                const int t = row0 + ai * 128 + m * 16;
                const float r = rms_from_part(part + (size_t)t * 32 + 16);
                st8bf(KA + (size_t)t * 1536 + u.pn * 192 + cu, acc[ai][0][m][0] * r, acc[ai][0][m][1] * r);
                st8bf(VA + (size_t)t * 1024 + u.pn * 128 + cu, acc[ai][1][m][0] * r, acc[ai][1][m][1] * r);
            }
    }
};
struct EpiYA {
    static constexpr bool PERM = true, AFTER_DRAIN = false;
    unsigned char* ws;
    __device__ __forceinline__ void operator()(const f32x4 (&acc)[2][2][4][2], const pg8::Unit& u, int wr, int wc, int fr, int fq) const {
        const int row0 = u.pm * 256 + wr * 64 + fr, col0 = u.pn * 256 + wc * 32 + 8 * fq;
        float* const YT = (float*)(ws + WS_YT); const bf16_t* const GA = (const bf16_t*)(ws + WS_GA);
#pragma unroll
        for (int ai = 0; ai < 2; ++ai)
#pragma unroll
            for (int m = 0; m < 4; ++m)
#pragma unroll
                for (int bj = 0; bj < 2; ++bj) {
                    const size_t o = (size_t)(row0 + ai * 128 + m * 16) * D + col0 + bj * 128;
                    const u32x4 g = *(const u32x4*)(GA + o);
                    *(f32x4*)(YT + o) = acc[ai][bj][m][0] * bflo(g); *(f32x4*)(YT + o + 4) = acc[ai][bj][m][1] * bfhi(g);
                }
    }
};
struct EpiYB {
    static constexpr bool PERM = true, AFTER_DRAIN = false;
    unsigned char* ws;
    __device__ __forceinline__ void operator()(const f32x4 (&acc)[2][2][4][2], const pg8::Unit& u, int wr, int wc, int fr, int fq) const {
        const int row0 = u.pm * 256 + wr * 64 + fr, col0 = u.pn * 256 + wc * 32 + 8 * fq;
        const float* const YT = (const float*)(ws + WS_YT); const bf16_t* const GB = (const bf16_t*)(ws + WS_GB); bf16_t* const Y = (bf16_t*)(ws + WS_Y);
#pragma unroll
        for (int ai = 0; ai < 2; ++ai)
#pragma unroll
            for (int m = 0; m < 4; ++m)
#pragma unroll
                for (int bj = 0; bj < 2; ++bj) {
                    const size_t o = (size_t)(row0 + ai * 128 + m * 16) * D + col0 + bj * 128;
                    const u32x4 g = *(const u32x4*)(GB + o);
                    const f32x4 y0 = *(const f32x4*)(YT + o), y1 = *(const f32x4*)(YT + o + 4);
                    st8bf(Y + o, y0 + acc[ai][bj][m][0] * bflo(g), y1 + acc[ai][bj][m][1] * bfhi(g));
                }
    }
};
struct EpiOut {
    static constexpr bool PERM = true, AFTER_DRAIN = false;
    const float* hin; float* V1;
    __device__ __forceinline__ void operator()(const f32x4 (&acc)[2][2][4][2], const pg8::Unit& u, int wr, int wc, int fr, int fq) const {
        const int row0 = u.pm * 256 + wr * 64 + fr, col0 = u.pn * 256 + wc * 32 + 8 * fq;
#pragma unroll
        for (int ai = 0; ai < 2; ++ai)
#pragma unroll
            for (int m = 0; m < 4; ++m)
#pragma unroll
                for (int bj = 0; bj < 2; ++bj) {
                    const size_t o = (size_t)(row0 + ai * 128 + m * 16) * D + col0 + bj * 128;
                    const f32x4 h0 = *(const f32x4*)(hin + o), h1 = *(const f32x4*)(hin + o + 4);
                    *(f32x4*)(V1 + o) = h0 * ALPHA + acc[ai][bj][m][0]; *(f32x4*)(V1 + o + 4) = h1 * ALPHA + acc[ai][bj][m][1];
                }
    }
};

#define LDS_WAIT() asm volatile("s_waitcnt lgkmcnt(0)" ::: "memory")
template <int MAP>
__device__ __forceinline__ void transpose_item(const float* W, int ldw, int K, int N, const float* kscale, bf16_t* WT, LAS float* scr, int item, int lane) {
    const int nblk = N / 32, kb = item / nblk, nb = item % nblk, k0 = 64 * kb, n0 = 32 * nb;
    const int n = n0 + (lane & 31);
    const int sc = MAP == 0 ? n : (MAP == 1 ? src_in(n) : src_qa(n));
#pragma unroll 8
    for (int i = 0; i < 32; ++i) { const int kk = 2 * i + (lane >> 5);
        float v = sc >= 0 ? W[(size_t)(k0 + kk) * ldw + sc] : 0.f; if (kscale) v *= kscale[k0 + kk];
        scr[kk * 33 + (lane & 31)] = v; }
    LDS_WAIT(); asm volatile("" ::: "memory");
    const int c = lane & 7;
#pragma unroll
    for (int j = 0; j < 4; ++j) { const int nn = (lane >> 3) + 8 * j; const LAS float* sp = scr + (8 * c) * 33 + nn;
        u32x4 o; o.x = pkbf(sp[0 * 33], sp[1 * 33]); o.y = pkbf(sp[2 * 33], sp[3 * 33]); o.z = pkbf(sp[4 * 33], sp[5 * 33]); o.w = pkbf(sp[6 * 33], sp[7 * 33]);
        *(u32x4*)(WT + (size_t)(n0 + nn) * K + k0 + 8 * c) = o; }
    LDS_WAIT(); asm volatile("" ::: "memory");
}
__device__ __forceinline__ void p_prologue(LAS unsigned char* ldsb, const Params& p) {
    float* rope = (float*)(p.ws + WS_ROPE);
    float *cM = rope, *sM = rope + T * 32, *cD = rope + T * 64, *sD = rope + T * 80, *cI = rope + T * 96, *sI = rope + T * 104;
    const int gtid = blockIdx.x * NTHREADS + threadIdx.x, gstride = gridDim.x * NTHREADS;
    for (int idx = gtid; idx < T * 56; idx += gstride) {
        const int t = idx / 56, j = idx - t * 56;
        int rot, i; float *ct, *st; int w;
        if (j < 32) { rot = 64; i = j; ct = cM; st = sM; w = 32; } else if (j < 48) { rot = 32; i = j - 32; ct = cD; st = sD; w = 16; } else { rot = 16; i = j - 48; ct = cI; st = sI; w = 8; }
        const float inv = exp2f(-((float)(2 * i) / (float)rot) * 18.931568569324174f);
        const float ang = (float)p.pos[t] * inv;
        double rev = (double)ang * 0.15915494309189535; rev -= rint(rev);
        const float r = (float)(rev * 6.283185307179586);
        ct[t * w + i] = __cosf(r); st[t * w + i] = __sinf(r);
    }
    bf16_t* XB = (bf16_t*)(p.ws + WS_XB);
    for (size_t i = (size_t)gtid * 4; i < (size_t)T * D; i += (size_t)gstride * 4) st4bf(XB + i, *(const f32x4*)(p.x + i));
    const int wave = threadIdx.x >> 6, lane = threadIdx.x & 63;
    LAS float* scr = (LAS float*)(ldsb + wave * 16384);
    const int gw = blockIdx.x * 8 + wave, NGW = gridDim.x * 8;
    constexpr int I_IN = (D / 64) * (INP / 32), I_QB = (512 / 64) * (1536 / 32), I_KV = (512 / 64) * (2048 / 32), I_O = (1024 / 64) * (D / 32), I_OUT = (D / 64) * (D / 32);
    constexpr int I_LAYER = I_IN + I_QB + I_KV + 2 * I_O + I_OUT;
    for (int it = gw; it < DEPTH * I_LAYER; it += NGW) {
        const int l = it / I_LAYER; int r = it - l * I_LAYER;
        if (r < I_IN) { transpose_item<1>(p.w_in + (size_t)l * D * INW, INW, D, INP, nullptr, (bf16_t*)(p.ws + WS_WIN_T) + (size_t)l * INP * D, scr, r, lane); continue; } r -= I_IN;
        if (r < I_QB) { transpose_item<2>(p.w_qb + (size_t)l * 512 * 1536, 1536, 512, 1536, p.g_q + l * 512, (bf16_t*)(p.ws + WS_WQB_T) + (size_t)l * 1536 * 512, scr, r, lane); continue; } r -= I_QB;
        if (r < I_KV) { transpose_item<0>(p.w_kvb + (size_t)l * 512 * 2048, 2048, 512, 2048, p.g_kv + l * 512, (bf16_t*)(p.ws + WS_WKVB_T) + (size_t)l * 2048 * 512, scr, r, lane); continue; } r -= I_KV;
        if (r < I_O) { transpose_item<0>(p.w_oa + (size_t)l * 1024 * D, D, 1024, D, nullptr, (bf16_t*)(p.ws + WS_WOA_T) + (size_t)l * D * 1024, scr, r, lane); continue; } r -= I_O;
        if (r < I_O) { transpose_item<0>(p.w_ob + (size_t)l * 1024 * D, D, 1024, D, nullptr, (bf16_t*)(p.ws + WS_WOB_T) + (size_t)l * D * 1024, scr, r, lane); continue; } r -= I_O;
        transpose_item<0>(p.w_out + (size_t)l * D * D, D, D, D, nullptr, (bf16_t*)(p.ws + WS_WOUT_T) + (size_t)l * D * D, scr, r, lane);
    }
    __syncthreads();
}

__device__ __forceinline__ unsigned f2key(float f) { const unsigned u = __float_as_uint(f); return (u & 0x80000000u) ? ~u : (u | 0x80000000u); }
__device__ __forceinline__ void p_index(float* lds, const Params& p) {
    const bf16_t* QI = (const bf16_t*)(p.ws + WS_QI); const bf16_t* KI = (const bf16_t*)(p.ws + WS_KI); const float* WI = (const float*)(p.ws + WS_WI);
    unsigned* MASK = (unsigned*)(p.ws + WS_MASK);
    float* qs = lds; float* wsc = lds + 1024; float* sc = lds + 1040; int* red = (int*)(lds + 1040 + 4096);
    const int tid = opaque_tid(), lane = tid & 63, wv = tid >> 6;
    for (int t = blockIdx.x; t < T; t += gridDim.x) {
        const int b = t >> 12, ti = t & 4095, nk = ti + 1;
        __syncthreads();
        for (int i = tid; i < 1024; i += NTHREADS) qs[i] = bf2f(QI[(size_t)t * 1024 + i]);
        if (tid < 16) wsc[tid] = WI[(size_t)t * 16 + tid];
        __syncthreads();
        for (int s = tid; s < nk; s += NTHREADS) {
            const bf16_t* kr = KI + (size_t)(b * S + s) * 64;
            float score = 0.f;
#pragma unroll 1
            for (int h = 0; h < 16; ++h) {
                asm volatile("" ::: "memory");
                float dot = 0.f;
#pragma unroll
                for (int c = 0; c < 8; ++c) {
                    const u32x4 raw = *(const u32x4*)(kr + c * 8);
                    const f32x4 q0 = *(const f32x4*)(qs + h * 64 + c * 8), q1 = *(const f32x4*)(qs + h * 64 + c * 8 + 4);
                    dot = fmaf(q0[0], __uint_as_float(raw.x << 16), dot); dot = fmaf(q0[1], __uint_as_float(raw.x & 0xffff0000u), dot);
                    dot = fmaf(q0[2], __uint_as_float(raw.y << 16), dot); dot = fmaf(q0[3], __uint_as_float(raw.y & 0xffff0000u), dot);
                    dot = fmaf(q1[0], __uint_as_float(raw.z << 16), dot); dot = fmaf(q1[1], __uint_as_float(raw.z & 0xffff0000u), dot);
                    dot = fmaf(q1[2], __uint_as_float(raw.w << 16), dot); dot = fmaf(q1[3], __uint_as_float(raw.w & 0xffff0000u), dot);
                }
                score = fmaf(wsc[h], fmaxf(dot, 0.f), score);
            }
            sc[s] = score;
        }
        __syncthreads();
        unsigned k0 = 0u, k1 = 0u, k2 = 0u, k3 = 0u, k4 = 0u, k5 = 0u, k6 = 0u, k7 = 0u;
        if (tid < nk) k0 = f2key(sc[tid]);
        if (tid + 512 < nk) k1 = f2key(sc[tid + 512]);
        if (tid + 1024 < nk) k2 = f2key(sc[tid + 1024]);
        if (tid + 1536 < nk) k3 = f2key(sc[tid + 1536]);
        if (tid + 2048 < nk) k4 = f2key(sc[tid + 2048]);
        if (tid + 2560 < nk) k5 = f2key(sc[tid + 2560]);
        if (tid + 3072 < nk) k6 = f2key(sc[tid + 3072]);
        if (tid + 3584 < nk) k7 = f2key(sc[tid + 3584]);
        unsigned res = 0u;
        if (nk > 256) {
#pragma unroll 1
            for (int bit = 31; bit >= 0; --bit) {
                const unsigned cand = res | (1u << bit);
                const int c = (k0 >= cand) + (k1 >= cand) + (k2 >= cand) + (k3 >= cand) + (k4 >= cand) + (k5 >= cand) + (k6 >= cand) + (k7 >= cand);
                if (block_sum_int(c, red) >= 256) res = cand;
            }
        }
        unsigned* mw = MASK + (size_t)t * 128 + 2 * wv;
#define MASK_OUT(j, kj) do { const unsigned long long bal = __ballot((tid + 512 * (j) < nk) && ((kj) >= res)); if (lane == 0) { mw[16 * (j)] = (unsigned)bal; mw[16 * (j) + 1] = (unsigned)(bal >> 32); } } while (0)
        MASK_OUT(0, k0); MASK_OUT(1, k1); MASK_OUT(2, k2); MASK_OUT(3, k3); MASK_OUT(4, k4); MASK_OUT(5, k5); MASK_OUT(6, k6); MASK_OUT(7, k7);
#undef MASK_OUT
    }
    __syncthreads();
}

template <int DQK, bool MASKED>
__device__ __forceinline__ void nattn(float* lds, const bf16_t* Q, const bf16_t* Kp, int ldk, const bf16_t* Vp, const unsigned* mask, bf16_t* O, float scale) {
    float* qs = lds; float* scb = lds + 8 * 192;
    const int tid = opaque_tid(), lane = tid & 63, h = tid >> 6;
    float* sc = scb + h * 4096;
    for (int t = blockIdx.x; t < T; t += gridDim.x) {
        const int b = t >> 12, ti = t & 4095, nk = ti + 1;
        __syncthreads();
        for (int i = tid; i < 8 * DQK; i += NTHREADS) qs[i] = bf2f(Q[(size_t)t * (8 * DQK) + i]);
        __syncthreads();
        const float* q = qs + h * DQK;
        float mx = -__builtin_inff();
        for (int s0 = 0; s0 < nk; s0 += 64) {
            const int s = s0 + lane; float v = -__builtin_inff();
            bool on = s < nk;
            if (MASKED && on) on = (mask[(size_t)t * 128 + (s >> 5)] >> (s & 31)) & 1u;
            if (on) {
                const bf16_t* kr = Kp + (size_t)(b * S + s) * ldk + h * DQK;
                float dot = 0.f;
#pragma unroll 4
                for (int c = 0; c < DQK / 8; ++c) { const u32x4 raw = *(const u32x4*)(kr + c * 8); const unsigned w[4] = {raw.x, raw.y, raw.z, raw.w};
#pragma unroll
                    for (int j = 0; j < 4; ++j) { dot = fmaf(q[c * 8 + 2 * j], __uint_as_float(w[j] << 16), dot); dot = fmaf(q[c * 8 + 2 * j + 1], __uint_as_float(w[j] & 0xffff0000u), dot); } }
                v = dot * scale;
            }
            if (s < nk) sc[s] = v;
            mx = fmaxf(mx, v);
        }
        mx = wave_max(mx);
        __syncthreads();
        float sum = 0.f;
        for (int s = lane; s < nk; s += 64) { const float pz = __expf(sc[s] - mx); sc[s] = pz; sum += pz; }
        sum = wave_sum(sum);
        __syncthreads();
        float a0 = 0.f, a1 = 0.f;
        const bf16_t* vb = Vp + (size_t)(b * S) * 1024 + h * 128 + lane * 2;
        for (int s = 0; s < nk; ++s) {
            const float pz = sc[s];
            if (pz != 0.f) { const unsigned w = *(const unsigned*)(vb + (size_t)s * 1024); a0 = fmaf(pz, __uint_as_float(w << 16), a0); a1 = fmaf(pz, __uint_as_float(w & 0xffff0000u), a1); }
        }
        const float inv = 1.f / sum;
        *(unsigned*)(O + (size_t)t * 1024 + h * 128 + lane * 2) = pk2(a0 * inv, a1 * inv);
    }
    __syncthreads();
}

__device__ __forceinline__ void p_ln1_route(float* lds, const Params& p, int l) {
    const float* V1 = (const float*)(p.ws + WS_V1); float* H1F = (float*)(p.ws + WS_H1F); bf16_t* H1B = (bf16_t*)(p.ws + WS_H1B);
    unsigned* cnt = (unsigned*)(p.ws + WS_CNT) + l * 64; int* LIST = (int*)(p.ws + WS_LIST);
    int* TOKE = (int*)(p.ws + WS_TOKE); float* TOKW = (float*)(p.ws + WS_TOKW); int* TOKS = (int*)(p.ws + WS_TOKS);
    const float* g = p.ln1g + (size_t)l * D; const float* bb = p.ln1b + (size_t)l * D;
    const float* wr = p.w_router + (size_t)l * D * 64; const float* wg = p.w_group + (size_t)l * D * 8;
    const float* br = p.b_router + l * 64; const float* bg = p.b_group + l * 8;
    const int tid = opaque_tid(), lane = tid & 63, wv = tid >> 6;
    float* lg = lds + wv * 80;
    for (int t0 = blockIdx.x * 8; t0 < T; t0 += gridDim.x * 8) {
        const int t = t0 + wv;
        float s1 = 0.f;
#pragma unroll 4
        for (int j = 0; j < 32; ++j) s1 += V1[(size_t)t * D + lane + 64 * j];
        const float mean = wave_sum(s1) * (1.f / D);
        float s2 = 0.f;
#pragma unroll 4
        for (int j = 0; j < 32; ++j) { const float d = V1[(size_t)t * D + lane + 64 * j] - mean; s2 += d * d; }
        const float rstd = rsqrtf(wave_sum(s2) * (1.f / D) + 1e-5f);
        float acc[72];
#pragma unroll
        for (int e = 0; e < 72; ++e) acc[e] = 0.f;
#pragma unroll 1
        for (int j = 0; j < 32; ++j) {
            const int k = lane + 64 * j;
            const float hk = (V1[(size_t)t * D + k] - mean) * rstd * g[k] + bb[k];
            H1F[(size_t)t * D + k] = hk; H1B[(size_t)t * D + k] = f2bf(hk);
            const float* wrow = wr + (size_t)k * 64;
#pragma unroll
            for (int e4 = 0; e4 < 16; ++e4) { const f32x4 w = *(const f32x4*)(wrow + e4 * 4);
                acc[e4 * 4] = fmaf(hk, w[0], acc[e4 * 4]); acc[e4 * 4 + 1] = fmaf(hk, w[1], acc[e4 * 4 + 1]); acc[e4 * 4 + 2] = fmaf(hk, w[2], acc[e4 * 4 + 2]); acc[e4 * 4 + 3] = fmaf(hk, w[3], acc[e4 * 4 + 3]); }
            const float* grow = wg + (size_t)k * 8;
            const f32x4 w0 = *(const f32x4*)grow, w1 = *(const f32x4*)(grow + 4);
            acc[64] = fmaf(hk, w0[0], acc[64]); acc[65] = fmaf(hk, w0[1], acc[65]); acc[66] = fmaf(hk, w0[2], acc[66]); acc[67] = fmaf(hk, w0[3], acc[67]);
            acc[68] = fmaf(hk, w1[0], acc[68]); acc[69] = fmaf(hk, w1[1], acc[69]); acc[70] = fmaf(hk, w1[2], acc[70]); acc[71] = fmaf(hk, w1[3], acc[71]);
        }
#pragma unroll
        for (int e = 0; e < 72; ++e) { const float r = wave_sum(acc[e]); if (lane == 0) lg[e] = r; }
        __syncthreads();
        if (lane == 0) {
            float gl[8]; float gmax = -__builtin_inff(); int gi = 0;
#pragma unroll
            for (int i = 0; i < 8; ++i) { gl[i] = lg[64 + i] + bg[i]; if (gl[i] > gmax) { gmax = gl[i]; gi = i; } }
            float gs = 0.f;
#pragma unroll
            for (int i = 0; i < 8; ++i) gs += __expf(gl[i] - gmax);
            const float gp = 1.f / gs;
            float el[8]; float emax = -__builtin_inff(); int e1 = 0;
#pragma unroll
            for (int i = 0; i < 8; ++i) { el[i] = lg[gi * 8 + i] + br[gi * 8 + i]; if (el[i] > emax) { emax = el[i]; e1 = i; } }
            float e2max = -__builtin_inff(); int e2 = 0;
#pragma unroll
            for (int i = 0; i < 8; ++i) { if (i != e1 && el[i] > e2max) { e2max = el[i]; e2 = i; } }
            const float p1 = 1.f, p2 = __expf(e2max - emax);
            const float wa = gp * p1 / (p1 + p2), wb = gp * p2 / (p1 + p2);
            const int ea = gi * 8 + e1, eb = gi * 8 + e2;
            const int sa = (int)atomicAdd(cnt + ea, 1u), sb = (int)atomicAdd(cnt + eb, 1u);
            LIST[(size_t)ea * ECAP + sa] = t; LIST[(size_t)eb * ECAP + sb] = t;
            TOKE[t * 2] = ea; TOKE[t * 2 + 1] = eb; TOKW[t * 2] = wa; TOKW[t * 2 + 1] = wb; TOKS[t * 2] = sa; TOKS[t * 2 + 1] = sb;
        }
        __syncthreads();
    }
}

__device__ __forceinline__ void moe_tables(int* tab, const unsigned* cnt, int items_per_rb) {
    if (threadIdx.x == 0) { int a = 0, bsum = 0; for (int e = 0; e < 64; ++e) { tab[e] = a; tab[80 + e] = bsum; const int c = (int)cnt[e]; a += ((c + 127) / 128) * items_per_rb; bsum += ((c + 255) / 256) * 256; } tab[64] = a; tab[80 + 64] = bsum; }
    __syncthreads();
}
__device__ __forceinline__ void p_moe1(float* lds, const Params& p, int l) {
    const unsigned* cnt = (const unsigned*)(p.ws + WS_CNT) + l * 64; const int* LIST = (const int*)(p.ws + WS_LIST);
    const bf16_t* H1B = (const bf16_t*)(p.ws + WS_H1B); bf16_t* HID = (bf16_t*)(p.ws + WS_HID);
    float* As = lds; float* Wg = lds + 32 * 132; float* Wu = Wg + 32 * 64; int* tab = (int*)(Wu + 32 * 64);
    __syncthreads();
    moe_tables(tab, cnt, 8);
    const int tid = opaque_tid(), ty = tid >> 4, tx = tid & 15;
    const int total = tab[64];
    for (int item = blockIdx.x; item < total; item += gridDim.x) {
        int e = 0; while (tab[e + 1] <= item) ++e;
        const int local = item - tab[e], rb = local >> 3, ct = local & 7, ce = (int)cnt[e], base = tab[80 + e];
        const float* wgp = p.w_eg + ((size_t)(l * 64 + e) * D) * FE + ct * 64;
        const float* wup = p.w_eu + ((size_t)(l * 64 + e) * D) * FE + ct * 64;
        const f32x4 z4 = {0.f, 0.f, 0.f, 0.f};
        f32x4 ag0 = z4, ag1 = z4, ag2 = z4, ag3 = z4, au0 = z4, au1 = z4, au2 = z4, au3 = z4;
        const int ar = tid >> 2, akq = (tid & 3) * 8, wk = tid >> 4, wn4 = (tid & 15) * 4;
        const int ai = rb * 128 + ar; const int tok = ai < ce ? LIST[(size_t)e * ECAP + ai] : -1;
        const bf16_t* ap = H1B + (size_t)(tok < 0 ? 0 : tok) * D + akq;
        for (int k0 = 0; k0 < D; k0 += 32) {
            __syncthreads();
            { u32x4 raw = *(const u32x4*)(ap + k0); if (tok < 0) raw = (u32x4){0u, 0u, 0u, 0u};
              float* dst = As + akq * 132 + ar;
              dst[0 * 132] = __uint_as_float(raw.x << 16); dst[1 * 132] = __uint_as_float(raw.x & 0xffff0000u); dst[2 * 132] = __uint_as_float(raw.y << 16); dst[3 * 132] = __uint_as_float(raw.y & 0xffff0000u);
              dst[4 * 132] = __uint_as_float(raw.z << 16); dst[5 * 132] = __uint_as_float(raw.z & 0xffff0000u); dst[6 * 132] = __uint_as_float(raw.w << 16); dst[7 * 132] = __uint_as_float(raw.w & 0xffff0000u); }
            *(f32x4*)(Wg + wk * 64 + wn4) = *(const f32x4*)(wgp + (size_t)(k0 + wk) * FE + wn4);
            *(f32x4*)(Wu + wk * 64 + wn4) = *(const f32x4*)(wup + (size_t)(k0 + wk) * FE + wn4);
            __syncthreads();
#pragma unroll 4
            for (int kk = 0; kk < 32; ++kk) {
                const f32x4 a = *(const f32x4*)(As + kk * 132 + ty * 4);
                const f32x4 g4 = *(const f32x4*)(Wg + kk * 64 + tx * 4);
                const f32x4 u4 = *(const f32x4*)(Wu + kk * 64 + tx * 4);
                ag0 += a[0] * g4; ag1 += a[1] * g4; ag2 += a[2] * g4; ag3 += a[3] * g4;
                au0 += a[0] * u4; au1 += a[1] * u4; au2 += a[2] * u4; au3 += a[3] * u4;
            }
        }
#define MOE1_OUT(i, G_, U_) do { const int ri = rb * 128 + ty * 4 + (i); if (ri < ce) { f32x4 o; \
            o[0] = G_[0] / (1.f + __expf(-G_[0])) * U_[0]; o[1] = G_[1] / (1.f + __expf(-G_[1])) * U_[1]; o[2] = G_[2] / (1.f + __expf(-G_[2])) * U_[2]; o[3] = G_[3] / (1.f + __expf(-G_[3])) * U_[3]; \
            st4bf(HID + (size_t)(base + ri) * FE + ct * 64 + tx * 4, o); } } while (0)
        MOE1_OUT(0, ag0, au0); MOE1_OUT(1, ag1, au1); MOE1_OUT(2, ag2, au2); MOE1_OUT(3, ag3, au3);
#undef MOE1_OUT
    }
    __syncthreads();
}
__device__ __forceinline__ void p_moe2(float* lds, const Params& p, int l) {
    const unsigned* cnt = (const unsigned*)(p.ws + WS_CNT) + l * 64;
    const bf16_t* HID = (const bf16_t*)(p.ws + WS_HID); bf16_t* YE = (bf16_t*)(p.ws + WS_YE);
    float* As = lds; float* Ws = lds + 32 * 132; int* tab = (int*)(Ws + 32 * 64 * 2);
    __syncthreads();
    moe_tables(tab, cnt, 32);
    const int tid = opaque_tid(), ty = tid >> 4, tx = tid & 15;
    const int total = tab[64];
    for (int item = blockIdx.x; item < total; item += gridDim.x) {
        int e = 0; while (tab[e + 1] <= item) ++e;
        const int local = item - tab[e], rb = local >> 5, ct = local & 31, ce = (int)cnt[e], base = tab[80 + e];
        const float* wdp = p.w_ed + ((size_t)(l * 64 + e) * FE) * D + ct * 64;
        f32x4 acc0 = {0.f, 0.f, 0.f, 0.f}, acc1 = acc0, acc2 = acc0, acc3 = acc0;
        const int ar = tid >> 2, akq = (tid & 3) * 8, wk = tid >> 4, wn4 = (tid & 15) * 4;
        const int ai = rb * 128 + ar; const bool av = ai < ce;
        const bf16_t* ap = HID + (size_t)(base + (av ? ai : 0)) * FE + akq;
        for (int k0 = 0; k0 < FE; k0 += 32) {
            __syncthreads();
            { u32x4 raw = *(const u32x4*)(ap + k0); if (!av) raw = (u32x4){0u, 0u, 0u, 0u};
              float* dst = As + akq * 132 + ar;
              dst[0 * 132] = __uint_as_float(raw.x << 16); dst[1 * 132] = __uint_as_float(raw.x & 0xffff0000u); dst[2 * 132] = __uint_as_float(raw.y << 16); dst[3 * 132] = __uint_as_float(raw.y & 0xffff0000u);
              dst[4 * 132] = __uint_as_float(raw.z << 16); dst[5 * 132] = __uint_as_float(raw.z & 0xffff0000u); dst[6 * 132] = __uint_as_float(raw.w << 16); dst[7 * 132] = __uint_as_float(raw.w & 0xffff0000u); }
            *(f32x4*)(Ws + wk * 64 + wn4) = *(const f32x4*)(wdp + (size_t)(k0 + wk) * D + wn4);
            __syncthreads();
#pragma unroll 8
            for (int kk = 0; kk < 32; ++kk) {
                const f32x4 a = *(const f32x4*)(As + kk * 132 + ty * 4);
                const f32x4 w = *(const f32x4*)(Ws + kk * 64 + tx * 4);
                acc0 += a[0] * w; acc1 += a[1] * w; acc2 += a[2] * w; acc3 += a[3] * w;
            }
        }
        { const int ri = rb * 128 + ty * 4; bf16_t* yo = YE + (size_t)(base + ri) * D + ct * 64 + tx * 4;
          if (ri < ce) st4bf(yo, acc0); if (ri + 1 < ce) st4bf(yo + D, acc1); if (ri + 2 < ce) st4bf(yo + 2 * D, acc2); if (ri + 3 < ce) st4bf(yo + 3 * D, acc3); }
    }
    __syncthreads();
}
__device__ __forceinline__ void p_ln2(float* lds, const Params& p, int l) {
    const unsigned* cnt = (const unsigned*)(p.ws + WS_CNT) + l * 64;
    const float* H1F = (const float*)(p.ws + WS_H1F); const bf16_t* YE = (const bf16_t*)(p.ws + WS_YE);
    const int* TOKE = (const int*)(p.ws + WS_TOKE); const float* TOKW = (const float*)(p.ws + WS_TOKW); const int* TOKS = (const int*)(p.ws + WS_TOKS);
    float* outF = (l == DEPTH - 1) ? p.out : (float*)(p.ws + WS_H2F); bf16_t* XB = (bf16_t*)(p.ws + WS_XB);
    const float* g = p.ln2g + (size_t)l * D; const float* bb = p.ln2b + (size_t)l * D;
    int* tab = (int*)lds;
    __syncthreads();
    moe_tables(tab, cnt, 1);
    const int tid = opaque_tid(), lane = tid & 63, wv = tid >> 6;
    for (int t0 = blockIdx.x * 8; t0 < T; t0 += gridDim.x * 8) {
        const int t = t0 + wv;
        const int r0 = tab[80 + TOKE[t * 2]] + TOKS[t * 2], r1 = tab[80 + TOKE[t * 2 + 1]] + TOKS[t * 2 + 1];
        const float w0 = TOKW[t * 2], w1 = TOKW[t * 2 + 1];
        const float* hrow = H1F + (size_t)t * D; const bf16_t* y0 = YE + (size_t)r0 * D; const bf16_t* y1 = YE + (size_t)r1 * D;
        float s1 = 0.f;
#pragma unroll 4
        for (int j = 0; j < 32; ++j) { const int k = lane + 64 * j; s1 += ALPHA * hrow[k] + w0 * bf2f(y0[k]) + w1 * bf2f(y1[k]); }
        const float mean = wave_sum(s1) * (1.f / D);
        float s2 = 0.f;
#pragma unroll 4
        for (int j = 0; j < 32; ++j) { const int k = lane + 64 * j; const float d = ALPHA * hrow[k] + w0 * bf2f(y0[k]) + w1 * bf2f(y1[k]) - mean; s2 += d * d; }
        const float rstd = rsqrtf(wave_sum(s2) * (1.f / D) + 1e-5f);
#pragma unroll 4
        for (int j = 0; j < 32; ++j) { const int k = lane + 64 * j; const float v = ALPHA * hrow[k] + w0 * bf2f(y0[k]) + w1 * bf2f(y1[k]);
            const float o = (v - mean) * rstd * g[k] + bb[k];
            outF[(size_t)t * D + k] = o; if (l != DEPTH - 1) XB[(size_t)t * D + k] = f2bf(o); }
    }
    __syncthreads();
}

constexpr int NPH = 9;
#ifndef PH_MASK
#define PH_MASK 0x3ff
#endif
#define PHON(k) ((PH_MASK >> (k)) & 1)
typedef const Params __attribute__((address_space(4))) CParams;
#define KP(field) ({ CParams* _k = kp; asm volatile("" : "+s"(_k)); _k->field; })
__global__ void __launch_bounds__(NTHREADS, 2) hybrid_fwd(Params p_unused, int ph_lo, int ph_hi) {
    extern __shared__ __attribute__((aligned(16))) unsigned char lds_raw[];
    float* lds = (float*)lds_raw;
    LAS unsigned char* ldsb = (LAS unsigned char*)lds_raw;
    CParams* kp = (CParams*)__builtin_amdgcn_kernarg_segment_ptr();
    unsigned char* const ws0 = KP(ws);
    volatile LAS unsigned* xbw = (volatile LAS unsigned*)(lds_raw + LDS_BYTES - 16);
    if (threadIdx.x == 0) { xbw[0] = 0u; xbw[1] = 0u; xbw[2] = 0u; xbw[3] = 0u; }
    __syncthreads();
    XcdBarrier bar; bar.bar = (unsigned*)(ws0 + WS_BAR); bar.x = 0; bar.st = xbw;
    if (ph_lo < ph_hi) bar = xcd_barrier_post((unsigned*)(ws0 + WS_BAR), xbw);
#define IN(ph) ((ph) >= ph_lo && (ph) <= ph_hi)
#define GRID_BAR(ph) do { if ((ph) >= ph_lo && (ph) < ph_hi) xcd_barrier(bar); } while (0)
    if (PHON(0) && IN(0)) { unsigned char* ws = ws0; asm volatile("" : "+s"(ws)); { Params q; q.ws = ws; q.x = KP(x); q.pos = KP(pos); q.w_in = KP(w_in); q.g_q = KP(g_q); q.w_qb = KP(w_qb); q.g_kv = KP(g_kv); q.w_kvb = KP(w_kvb);
        q.w_oa = KP(w_oa); q.w_ob = KP(w_ob); q.w_out = KP(w_out); p_prologue(ldsb, q); } }
    GRID_BAR(0);
    for (int l = 0; l < DEPTH; ++l) {
        const int pb = l * NPH;
        if (PHON(1) && IN(pb + 1)) { unsigned char* ws = ws0; asm volatile("" : "+s"(ws));
            EpiIn E; E.ws = ws;
            pg8::Gemm g{(const bf16_t*)(ws + WS_XB), (const bf16_t*)(ws + WS_WIN_T) + (size_t)l * INP * D, T, INP, D}; pg8::StaticOrder SO; SO.init(T, INP, (int)gridDim.x, (int)blockIdx.x);
            pg8::gemm_phase<EpiIn, pg8::StaticOrder, true, true>(ldsb, g, SO, E);
        }
        GRID_BAR(pb + 1);
        if (PHON(2) && IN(pb + 2)) { unsigned char* ws = ws0; asm volatile("" : "+s"(ws));
            { EpiQA E; E.ws = ws;
              pg8::Gemm g{(const bf16_t*)(ws + WS_CQ), (const bf16_t*)(ws + WS_WQB_T) + (size_t)l * 1536 * 512, T, 1536, 512}; pg8::StaticOrder SO; SO.init(T, 1536, (int)gridDim.x, (int)blockIdx.x);
              pg8::gemm_phase<EpiQA, pg8::StaticOrder, true, true>(ldsb, g, SO, E); }
            { EpiKV E; E.ws = ws;
              pg8::Gemm g{(const bf16_t*)(ws + WS_CKV), (const bf16_t*)(ws + WS_WKVB_T) + (size_t)l * 2048 * 512, T, 2048, 512}; pg8::StaticOrder SO; SO.init(T, 2048, (int)gridDim.x, (int)blockIdx.x);
              pg8::gemm_phase<EpiKV, pg8::StaticOrder, true, true>(ldsb, g, SO, E); }
            { Params q; q.ws = ws; p_index(lds, q); }
        }
        GRID_BAR(pb + 2);
        if (PHON(3) && IN(pb + 3)) { unsigned char* ws = ws0; asm volatile("" : "+s"(ws));
            nattn<192, false>(lds, (const bf16_t*)(ws + WS_QA), (const bf16_t*)(ws + WS_KA), 1536, (const bf16_t*)(ws + WS_VA), nullptr, (bf16_t*)(ws + WS_OA), 0.07216878364870322f);
            nattn<128, true>(lds, (const bf16_t*)(ws + WS_QB), (const bf16_t*)(ws + WS_KB), 1024, (const bf16_t*)(ws + WS_VB), (const unsigned*)(ws + WS_MASK), (bf16_t*)(ws + WS_OB), 0.08838834764831845f);
        }
        GRID_BAR(pb + 3);
        if (PHON(4) && IN(pb + 4)) { unsigned char* ws = ws0; asm volatile("" : "+s"(ws));
            pg8::StaticOrder SO; SO.init(T, D, (int)gridDim.x, (int)blockIdx.x);
            { EpiYA E; E.ws = ws;
              pg8::Gemm g{(const bf16_t*)(ws + WS_OA), (const bf16_t*)(ws + WS_WOA_T) + (size_t)l * D * 1024, T, D, 1024};
              pg8::gemm_phase<EpiYA, pg8::StaticOrder, true, true>(ldsb, g, SO, E); }
            { EpiYB E; E.ws = ws;
              pg8::Gemm g{(const bf16_t*)(ws + WS_OB), (const bf16_t*)(ws + WS_WOB_T) + (size_t)l * D * 1024, T, D, 1024};
              pg8::gemm_phase<EpiYB, pg8::StaticOrder, true, true>(ldsb, g, SO, E); }
        }
        GRID_BAR(pb + 4);
        if (PHON(5) && IN(pb + 5)) { unsigned char* ws = ws0; asm volatile("" : "+s"(ws));
            EpiOut E; E.hin = (l == 0) ? KP(x) : (const float*)(ws + WS_H2F); E.V1 = (float*)(ws + WS_V1);
            pg8::Gemm g{(const bf16_t*)(ws + WS_Y), (const bf16_t*)(ws + WS_WOUT_T) + (size_t)l * D * D, T, D, D}; pg8::StaticOrder SO; SO.init(T, D, (int)gridDim.x, (int)blockIdx.x);
            pg8::gemm_phase<EpiOut, pg8::StaticOrder, true, true>(ldsb, g, SO, E);
        }
        GRID_BAR(pb + 5);
        if (PHON(6) && IN(pb + 6)) { unsigned char* ws = ws0; asm volatile("" : "+s"(ws)); Params q; q.ws = ws; q.ln1g = KP(ln1g); q.ln1b = KP(ln1b); q.w_router = KP(w_router); q.w_group = KP(w_group); q.b_router = KP(b_router); q.b_group = KP(b_group); p_ln1_route(lds, q, l); }
        GRID_BAR(pb + 6);
        if (PHON(7) && IN(pb + 7)) { unsigned char* ws = ws0; asm volatile("" : "+s"(ws)); Params q; q.ws = ws; q.w_eg = KP(w_eg); q.w_eu = KP(w_eu); p_moe1(lds, q, l); }
        GRID_BAR(pb + 7);
        if (PHON(8) && IN(pb + 8)) { unsigned char* ws = ws0; asm volatile("" : "+s"(ws)); Params q; q.ws = ws; q.w_ed = KP(w_ed); p_moe2(lds, q, l); }
        GRID_BAR(pb + 8);
        if (PHON(9) && IN(pb + 9)) { unsigned char* ws = ws0; asm volatile("" : "+s"(ws)); Params q; q.ws = ws; q.ln2g = KP(ln2g); q.ln2b = KP(ln2b); q.out = KP(out); p_ln2(lds, q, l); }
        GRID_BAR(pb + 9);
    }
}

#ifndef MK_ONE_LAUNCH
#define MK_ONE_LAUNCH 1
#endif
extern "C" void kernel_launch(void* const* d_in, const int* in_sizes, int n_in, void* d_out, int out_size, void* d_ws, size_t ws_size, hipStream_t stream) {
    static int grid = 0;
    if (!grid) {
        if (n_in != 21 || in_sizes[0] != T * D || out_size != T * D || ws_size < WS_END) {
            fprintf(stderr, "kernel_launch: unexpected shapes (n_in %d, in0 %d, out %d, ws %zu, need %zu); nothing launched\n", n_in, n_in > 0 ? in_sizes[0] : -1, out_size, ws_size, (size_t)WS_END);
            grid = -1; return; }
        int dev = 0, cus = 0, per_cu = 0;
        hipGetDevice(&dev); hipDeviceGetAttribute(&cus, hipDeviceAttributeMultiprocessorCount, dev);
        if (hipFuncSetAttribute((const void*)hybrid_fwd, hipFuncAttributeMaxDynamicSharedMemorySize, LDS_BYTES) != hipSuccess) { fprintf(stderr, "kernel_launch: hipFuncSetAttribute failed\n"); grid = -1; return; }
        hipOccupancyMaxActiveBlocksPerMultiprocessor(&per_cu, (const void*)hybrid_fwd, NTHREADS, LDS_BYTES);
        if (per_cu < 1) fprintf(stderr, "kernel_launch: occupancy query reports %d blocks per CU\n", per_cu);
        grid = cus > 0 ? cus : 256;
    }
    if (grid < 0) return;
    hipMemsetAsync((char*)d_ws, 0, WS_CTL_END, stream);
    Params p{};
    p.x = (const float*)d_in[0]; p.pos = (const int*)d_in[1];
    p.w_in = (const float*)d_in[2]; p.g_q = (const float*)d_in[3]; p.w_qb = (const float*)d_in[4]; p.g_kv = (const float*)d_in[5]; p.w_kvb = (const float*)d_in[6];
    p.w_oa = (const float*)d_in[7]; p.w_ob = (const float*)d_in[8]; p.w_out = (const float*)d_in[9]; p.ln1g = (const float*)d_in[10]; p.ln1b = (const float*)d_in[11];
    p.w_group = (const float*)d_in[12]; p.b_group = (const float*)d_in[13]; p.w_router = (const float*)d_in[14]; p.b_router = (const float*)d_in[15];
    p.w_eg = (const float*)d_in[16]; p.w_eu = (const float*)d_in[17]; p.w_ed = (const float*)d_in[18]; p.ln2g = (const float*)d_in[19]; p.ln2b = (const float*)d_in[20];
    p.out = (float*)d_out; p.ws = (unsigned char*)d_ws;
#if MK_ONE_LAUNCH
    hipLaunchKernelGGL(hybrid_fwd, dim3(grid), dim3(NTHREADS), LDS_BYTES, stream, p, 0, DEPTH * NPH);
#else
    for (int ph = 0; ph <= DEPTH * NPH; ++ph) hipLaunchKernelGGL(hybrid_fwd, dim3(grid), dim3(NTHREADS), LDS_BYTES, stream, p, ph, ph);
#endif
}
```

```cpp
#include <hip/hip_runtime.h>
#include <cstdio>
#include <cstdint>

typedef unsigned short bf16_t;
typedef float f32x4 __attribute__((ext_vector_type(4)));
typedef unsigned u32x4 __attribute__((ext_vector_type(4)));
typedef unsigned u32x2 __attribute__((ext_vector_type(2)));

constexpr int T = 8192, D = 2048, S = 4096, NB = 2, DEPTH = 2;
constexpr int INW = 9360, INP = 9472;
constexpr int NE = 64, FE = 512;
constexpr int NTHREADS = 512;
constexpr int LDS_BYTES = 147456;
constexpr float ALPHA = 1.41421356237309515f;
constexpr int ECAP = 8192;
constexpr int PMAX = 32768;

constexpr size_t al256(size_t x) { return (x + 255) & ~(size_t)255; }
constexpr size_t XCD_BAR_BYTES = 16384;
constexpr size_t WS_BAR = 0;
constexpr size_t WS_CNT = WS_BAR + XCD_BAR_BYTES;
constexpr size_t WS_CTL_END = WS_CNT + al256(DEPTH * 64 * 4);
constexpr size_t WS_SSQ = WS_CTL_END;
constexpr size_t WS_ROPE = WS_SSQ + al256((size_t)T * 32 * 4);
constexpr size_t WS_XB = WS_ROPE + al256((size_t)T * 112 * 4);
constexpr size_t WS_H2F = WS_XB + al256((size_t)T * D * 2);
constexpr size_t WS_CQ = WS_H2F + al256((size_t)T * D * 4);
constexpr size_t WS_CKV = WS_CQ + al256((size_t)T * 512 * 2);
constexpr size_t WS_QB = WS_CKV + al256((size_t)T * 512 * 2);
constexpr size_t WS_KB = WS_QB + al256((size_t)T * 1024 * 2);
constexpr size_t WS_VB = WS_KB + al256((size_t)T * 1024 * 2);
constexpr size_t WS_QI = WS_VB + al256((size_t)T * 1024 * 2);
constexpr size_t WS_KI = WS_QI + al256((size_t)T * 1024 * 2);
constexpr size_t WS_WI = WS_KI + al256((size_t)T * 64 * 2);
constexpr size_t WS_GA = WS_WI + al256((size_t)T * 16 * 4);
constexpr size_t WS_GB = WS_GA + al256((size_t)T * D * 2);
constexpr size_t WS_QA = WS_GB + al256((size_t)T * D * 2);
constexpr size_t WS_KA = WS_QA + al256((size_t)T * 1536 * 2);
constexpr size_t WS_VA = WS_KA + al256((size_t)T * 1536 * 2);
constexpr size_t WS_MASK = WS_VA + al256((size_t)T * 1024 * 2);
constexpr size_t WS_OA = WS_MASK + al256((size_t)T * 128 * 4);
constexpr size_t WS_OB = WS_OA + al256((size_t)T * 1024 * 2);
constexpr size_t WS_YT = WS_OB + al256((size_t)T * 1024 * 2);
constexpr size_t WS_Y = WS_YT + al256((size_t)T * D * 4);
constexpr size_t WS_V1 = WS_Y + al256((size_t)T * D * 2);
constexpr size_t WS_H1F = WS_V1 + al256((size_t)T * D * 4);
constexpr size_t WS_H1B = WS_H1F + al256((size_t)T * D * 4);
constexpr size_t WS_TOKE = WS_H1B + al256((size_t)T * D * 2);
constexpr size_t WS_TOKW = WS_TOKE + al256((size_t)T * 2 * 4);
constexpr size_t WS_TOKS = WS_TOKW + al256((size_t)T * 2 * 4);
constexpr size_t WS_LIST = WS_TOKS + al256((size_t)T * 2 * 4);
constexpr size_t WS_HID = WS_LIST + al256((size_t)NE * ECAP * 4);
constexpr size_t WS_YE = WS_HID + al256((size_t)PMAX * FE * 2);
constexpr size_t WS_WIN_T = WS_YE + al256((size_t)PMAX * D * 2);
constexpr size_t WS_WQB_T = WS_WIN_T + al256((size_t)DEPTH * INP * D * 2);
constexpr size_t WS_WKVB_T = WS_WQB_T + al256((size_t)DEPTH * 1536 * 512 * 2);
constexpr size_t WS_WOA_T = WS_WKVB_T + al256((size_t)DEPTH * 2048 * 512 * 2);
constexpr size_t WS_WOB_T = WS_WOA_T + al256((size_t)DEPTH * D * 1024 * 2);
constexpr size_t WS_WOUT_T = WS_WOB_T + al256((size_t)DEPTH * D * 1024 * 2);
constexpr size_t WS_END = WS_WOUT_T + al256((size_t)DEPTH * D * D * 2);
static_assert(WS_CKV == WS_CQ + (size_t)T * 512 * 2, "CQ|CKV must be consecutive");

static_assert(WS_KB == WS_QB + (size_t)T * 1024 * 2 && WS_VB == WS_KB + (size_t)T * 1024 * 2 && WS_GB == WS_GA + (size_t)T * D * 2, "QB|KB|VB and GA|GB must be consecutive");
struct Params {
    const float* x; const int* pos;
    const float *w_in, *g_q, *w_qb, *g_kv, *w_kvb, *w_oa, *w_ob, *w_out, *ln1g, *ln1b, *w_group, *b_group, *w_router, *b_router, *w_eg, *w_eu, *w_ed, *ln2g, *ln2b;
    float* out; unsigned char* ws;
};

__device__ __forceinline__ float bf2f(bf16_t v) { return __uint_as_float((unsigned)v << 16); }
__device__ __forceinline__ bf16_t f2bf(float f) { unsigned u = __float_as_uint(f); u += 0x7fffu + ((u >> 16) & 1u); return (bf16_t)(u >> 16); }
__device__ __forceinline__ unsigned pk2(float a, float b) { return (unsigned)f2bf(a) | ((unsigned)f2bf(b) << 16); }
__device__ __forceinline__ void st4bf(bf16_t* p, f32x4 v) { u32x2 w; w.x = pk2(v[0], v[1]); w.y = pk2(v[2], v[3]); *(u32x2*)p = w; }
__device__ __forceinline__ float wave_sum(float v) {
#pragma unroll
    for (int o = 32; o >= 1; o >>= 1) v += __shfl_xor(v, o);
    return v;
}
__device__ __forceinline__ float wave_max(float v) {
#pragma unroll
    for (int o = 32; o >= 1; o >>= 1) v = fmaxf(v, __shfl_xor(v, o));
    return v;
}
__device__ __forceinline__ int block_sum_int(int v, int* red) {
#pragma unroll
    for (int o = 32; o >= 1; o >>= 1) v += __shfl_xor(v, o);
    if ((threadIdx.x & 63) == 0) red[threadIdx.x >> 6] = v;
    __syncthreads();
    int t = 0;
#pragma unroll
    for (int i = 0; i < 8; ++i) t += red[i];
    __syncthreads();
    return t;
}
__device__ __forceinline__ f32x4 rot4(f32x4 v, float c0, float s0, float c1, float s1) { f32x4 o; o[0] = v[0] * c0 - v[1] * s0; o[1] = v[1] * c0 + v[0] * s0; o[2] = v[2] * c1 - v[3] * s1; o[3] = v[3] * c1 + v[2] * s1; return o; }

#define XB_TMO      128
#define XB_XCNT(j)  (256  + 64 * (j))
#define XB_XSUB(j)  (1280 + 64 * (j))
#define XB_XGEN(j)  (2304 + 64 * (j))
#define XB_TOP      3328
#define XB_TOPGEN   3392
#define XCD_BAR_WORDS 3456
#define XB_SPIN_CAP (1u << 22)
#define LAS __attribute__((address_space(3)))
__device__ __forceinline__ unsigned xb_ld(unsigned* p)              { return __hip_atomic_load(p, __ATOMIC_RELAXED, __HIP_MEMORY_SCOPE_AGENT); }
__device__ __forceinline__ unsigned xb_add(unsigned* p, unsigned v) { return __hip_atomic_fetch_add(p, v, __ATOMIC_RELAXED, __HIP_MEMORY_SCOPE_AGENT); }
__device__ __forceinline__ unsigned xb_xcc_id() { return (unsigned)__builtin_amdgcn_s_getreg((3 << 11) | 20) & 0xFu; }
#define XB_SPIN(cond, bar) do { unsigned _sp = 0; while (cond) { __builtin_amdgcn_s_sleep(1); \
    if ((++_sp & 255u) == 0u) { if (xb_ld(&(bar)[XB_TMO])) break; if (_sp > XB_SPIN_CAP) { atomicAdd(&(bar)[XB_TMO], 1u); break; } } } } while (0)
struct XcdBarrier { unsigned* bar; unsigned x; volatile LAS unsigned* st; };
__device__ __forceinline__ XcdBarrier xcd_barrier_post(unsigned* bar, volatile LAS unsigned* st) {
    XcdBarrier b; b.bar = bar; b.x = xb_xcc_id(); b.st = st;
    if (threadIdx.x == 0) (void)xb_add(&bar[XB_XCNT(b.x)], 1u);
    return b;
}
__device__ __forceinline__ void xcd_barrier_complete(unsigned* bar, unsigned x, unsigned& nloc, unsigned& nx) {
    const unsigned G = gridDim.x * gridDim.y * gridDim.z;
    unsigned sum, cnt, mine, sp = 0u;
    for (;;) {
        sum = 0u; cnt = 0u; mine = 0u;
#pragma unroll
        for (unsigned j = 0; j < 16; ++j) { const unsigned c = xb_ld(&bar[XB_XCNT(j)]); sum += c; cnt += (c > 0u) ? 1u : 0u; mine = (j == x) ? c : mine; }
        if (sum == G) break;
        __builtin_amdgcn_s_sleep(1);
        if ((++sp & 255u) == 0u) { if (xb_ld(&bar[XB_TMO])) break; if (sp > XB_SPIN_CAP) { atomicAdd(&bar[XB_TMO], 1u); break; } }
    }
    nloc = mine > 0u ? mine : 1u; nx = cnt > 0u ? cnt : 1u;
}
__device__ __forceinline__ void xcd_barrier(const XcdBarrier& b) {
    asm volatile("s_waitcnt vmcnt(0)" ::: "memory");
    __syncthreads();
    if (threadIdx.x == 0) {
        unsigned* bar = b.bar;
        __builtin_amdgcn_s_waitcnt(0);
        unsigned nloc = b.st[0], nx = b.st[1];
        if (nloc == 0u) { xcd_barrier_complete(bar, b.x, nloc, nx); b.st[0] = nloc; b.st[1] = nx; }
        const unsigned old = xb_add(&bar[XB_XSUB(b.x)], 1u);
        const unsigned gen = old / nloc;
        if (old + 1u == (gen + 1u) * nloc) {
            __builtin_amdgcn_fence(__ATOMIC_RELEASE, "agent");
            asm volatile("s_waitcnt vmcnt(0)" ::: "memory");
            const unsigned og = xb_add(&bar[XB_TOP], 1u);
            const unsigned tg = og / nx;
            if (og + 1u == (tg + 1u) * nx) xb_add(&bar[XB_TOPGEN], 1u);
            else XB_SPIN(xb_ld(&bar[XB_TOPGEN]) == tg, bar);
            __builtin_amdgcn_fence(__ATOMIC_ACQUIRE, "agent");
            xb_add(&bar[XB_XGEN(b.x)], 1u);
            asm volatile("s_waitcnt vmcnt(0)" ::: "memory");
        } else {
            XB_SPIN(xb_ld(&bar[XB_XGEN(b.x)]) == gen, bar);
            __builtin_amdgcn_fence(__ATOMIC_ACQUIRE, "agent");
            asm volatile("s_waitcnt vmcnt(0)" ::: "memory");
        }
    }
    __syncthreads();
}

__device__ __forceinline__ int opaque_tid() { int t = threadIdx.x; asm volatile("" : "+v"(t)); return t; }
namespace pg8 {
#define PG8_LAS __attribute__((address_space(3)))
typedef unsigned short bf16_t;
typedef short bf16x8 __attribute__((ext_vector_type(8)));
typedef float f32x4 __attribute__((ext_vector_type(4)));
typedef unsigned u32x4 __attribute__((ext_vector_type(4)));
constexpr int BM = 256, BK = 64, HALF = 128, HTB = HALF * BK * 2  , STAGE_BYTES = 8 * HTB, NXCD = 8, WGM = 8;

__host__ __device__ __forceinline__ int lds_byte(int r, int c) { const int st = (r >> 4) * 2 + (c >> 5), rr = r & 15, cc = c & 31, ob = rr * 64 + cc * 2; return st * 1024 + (ob ^ (((ob >> 9) & 1) << 5)); }
__host__ __device__ __forceinline__ void stage_rc(int b, int& R, int& C) { const int st = b / 1024, sb = b % 1024, swz = sb ^ (((sb >> 9) & 1) << 5); R = (st >> 1) * 16 + swz / 64; C = (st & 1) * 32 + (swz % 64) / 2; }
__host__ __device__ __forceinline__ int perm32(int rho) { const int n = rho >> 4, i = rho & 15; return 8 * (i >> 2) + 4 * n + (i & 3); }

struct Unit { int pm, pn; };
struct Gemm { const bf16_t* A; const bf16_t* Bt; int M, N, K; };

struct StaticOrder {
    int nM, nN, nwg, G, c;
    __host__ __device__ void init(int M, int N, int G_, int c_) { nM = M / BM; nN = N / BM; nwg = nM * nN; G = G_; c = c_; }
    __host__ __device__ bool next(int i, Unit& u) const {
        const long L = (long)i * G + c; if (L >= nwg) return false;
        int wgid = (int)L; { const int q = nwg / NXCD, r = nwg % NXCD, xcd = wgid % NXCD, off = wgid / NXCD; wgid = (xcd < r ? xcd * (q + 1) : r * (q + 1) + (xcd - r) * q) + off; }
        const int nig = WGM * nN, gid = wgid / nig, fm = gid * WGM, gsz = (nM - fm) < WGM ? (nM - fm) : WGM;
        u.pm = fm + ((wgid % nig) % gsz); u.pn = (wgid % nig) / gsz; return true;
    }
    __device__ __forceinline__ void a_ready(const Unit&) const {}
    __device__ __forceinline__ void done(const Unit&) const {}
};

__device__ __forceinline__ unsigned cvt_pk_bf16(float lo, float hi) { unsigned r; asm volatile("v_cvt_pk_bf16_f32 %0, %1, %2" : "=v"(r) : "v"(lo), "v"(hi)); return r; }
template <class Epi, class Sched, bool ALIGN_EPI = false, bool SP2 = false>
__device__ __forceinline__ void gemm_phase(PG8_LAS unsigned char* lds, const Gemm g, const Sched& S, const Epi& E) {
    const int tid = opaque_tid(), wid = __builtin_amdgcn_readfirstlane(tid >> 6), lane = tid & 63, wr = wid >> 2, wc = wid & 3, fr = lane & 15, fq = lane >> 4;
    const int K = g.K, nt = K / BK;
    unsigned voffA[2], voffB[2];
#pragma unroll
    for (int i = 0; i < 2; ++i) { int R, C; stage_rc(tid * 16 + i * 8192, R, C); const int Rb = Epi::PERM ? ((R & ~31) + perm32(R & 31)) : R;
        voffA[i] = (unsigned)(R * K + C) * 2u; voffB[i] = (unsigned)(Rb * K + C) * 2u; }
    const size_t kstep = (size_t)(BK * 2);
    const size_t hstep = (size_t)HALF * K * 2;
    const size_t tstep = 2 * hstep;
    const unsigned ldsw = (unsigned)wid * 1024u;
    const int aoff = lds_byte(wr * 64 + fr, fq * 8), boff = lds_byte(wc * 32 + fr, fq * 8);
#define PG8_SA(b, h) (((b) * 2 + (h)) * HTB)
#define PG8_SB(b, h) ((4 + (b) * 2 + (h)) * HTB)
#define PG8_STAGE(bufoff, gbase, voff) do { _Pragma("unroll") for (int _i = 0; _i < 2; ++_i) \
        __builtin_amdgcn_global_load_lds((const unsigned*)((const char*)(gbase) + (voff)[_i]), (PG8_LAS unsigned*)(lds + (bufoff) + ldsw + _i * 8192), 16, 0, 0); } while (0)
#define PG8_LDA(dst, b, h) do { _Pragma("unroll") for (int m = 0; m < 4; ++m) _Pragma("unroll") for (int k = 0; k < 2; ++k) dst[m][k] = *(const PG8_LAS bf16x8*)(lds + PG8_SA(b, h) + aoff + m * 2048 + k * 1024); } while (0)
#define PG8_LDB(dst, b, h) do { _Pragma("unroll") for (int n = 0; n < 2; ++n) _Pragma("unroll") for (int k = 0; k < 2; ++k) dst[n][k] = *(const PG8_LAS bf16x8*)(lds + PG8_SB(b, h) + boff + n * 2048 + k * 1024); } while (0)
#define PG8_MMA(ai, bj, At, Bt) do { __builtin_amdgcn_s_setprio(1); _Pragma("unroll") for (int m = 0; m < 4; ++m) _Pragma("unroll") for (int n = 0; n < 2; ++n) _Pragma("unroll") for (int k = 0; k < 2; ++k) \
        acc[ai][bj][m][n] = __builtin_amdgcn_mfma_f32_16x16x32_bf16(Bt[n][k], At[m][k], acc[ai][bj][m][n], 0, 0, 0); __builtin_amdgcn_s_setprio(0); } while (0)
#define PG8_WAIT_V(n) asm volatile("s_waitcnt vmcnt(" #n ")" ::: "memory")
#define PG8_WAIT_L(n) asm volatile("s_waitcnt lgkmcnt(" #n ")" ::: "memory")
#define PG8_BAR __builtin_amdgcn_s_barrier()
#define PG8_SCHED __builtin_amdgcn_sched_barrier(0)
    Unit cur, nxt; int ui = 0;
    if (!S.next(0, cur)) return;
    f32x4 acc[2][2][4][2];
#pragma unroll
    for (int a = 0; a < 2; ++a)
#pragma unroll
        for (int b = 0; b < 2; ++b)
#pragma unroll
            for (int m = 0; m < 4; ++m)
#pragma unroll
                for (int n = 0; n < 2; ++n) acc[a][b][m][n] = (f32x4){0.f, 0.f, 0.f, 0.f};
    bf16x8 At[4][2], B0[2][2], B1[2][2];
    const char* cA = (const char*)g.A + (size_t)cur.pm * tstep; const char* cB = (const char*)g.Bt + (size_t)cur.pn * tstep;
    S.a_ready(cur);
    if constexpr (SP2) {
        PG8_STAGE(PG8_SB(0, 0), cB, voffB); PG8_STAGE(PG8_SB(0, 1), cB + hstep, voffB); PG8_STAGE(PG8_SA(0, 0), cA, voffA); PG8_STAGE(PG8_SA(0, 1), cA + hstep, voffA);
        if (wr == 1) PG8_BAR;
        PG8_WAIT_V(2); PG8_BAR;
        PG8_STAGE(PG8_SB(1, 0), cB + kstep, voffB); PG8_STAGE(PG8_SA(1, 0), cA + kstep, voffA); PG8_STAGE(PG8_SB(1, 1), cB + hstep + kstep, voffB);
        PG8_WAIT_V(6); PG8_BAR;
    } else {
        PG8_STAGE(PG8_SB(0, 0), cB, voffB); PG8_STAGE(PG8_SA(0, 0), cA, voffA); PG8_STAGE(PG8_SB(0, 1), cB + hstep, voffB); PG8_STAGE(PG8_SA(0, 1), cA + hstep, voffA);
        if (wr == 1) PG8_BAR;
        PG8_WAIT_V(4); PG8_BAR;
        PG8_STAGE(PG8_SB(1, 0), cB + kstep, voffB); PG8_STAGE(PG8_SA(1, 0), cA + kstep, voffA); PG8_STAGE(PG8_SB(1, 1), cB + hstep + kstep, voffB);
        PG8_WAIT_V(6); PG8_BAR;
    }
    for (;;) {
        const bool has_next = S.next(ui + 1, nxt);
        const char* nA = has_next ? (const char*)g.A + (size_t)nxt.pm * tstep : cA; const char* nB = has_next ? (const char*)g.Bt + (size_t)nxt.pn * tstep : cB;
        for (int t = 0; t < nt; t += 2) {
            const bool last = (t == nt - 2);
            const char* a1 = cA + (size_t)(t + 1) * kstep;
            const char* a2 = last ? nA : cA + (size_t)(t + 2) * kstep; const char* b2 = last ? nB : cB + (size_t)(t + 2) * kstep;
            const char* a3 = a2 + kstep; const char* b3 = b2 + kstep;
            if (last && has_next) S.a_ready(nxt);
            if constexpr (SP2) {
            PG8_LDB(B0, 0, 0); PG8_LDB(B1, 0, 1); PG8_SCHED; PG8_LDA(At, 0, 0); PG8_STAGE(PG8_SA(1, 1), a1 + hstep, voffA);
            PG8_WAIT_V(8); PG8_WAIT_L(0); PG8_BAR; PG8_MMA(0, 0, At, B0); PG8_MMA(0, 1, At, B1); PG8_BAR; PG8_SCHED;
            PG8_LDA(At, 0, 1); PG8_STAGE(PG8_SB(0, 0), b2, voffB); PG8_STAGE(PG8_SB(0, 1), b2 + hstep, voffB); PG8_STAGE(PG8_SA(0, 0), a2, voffA);
            PG8_WAIT_V(8); PG8_WAIT_L(0); PG8_BAR; PG8_MMA(1, 0, At, B0); PG8_MMA(1, 1, At, B1); PG8_BAR; PG8_SCHED;
            PG8_LDB(B0, 1, 0); PG8_LDB(B1, 1, 1); PG8_SCHED; PG8_LDA(At, 1, 0); PG8_STAGE(PG8_SA(0, 1), a2 + hstep, voffA);
            PG8_WAIT_V(8); PG8_WAIT_L(0); PG8_BAR; PG8_MMA(0, 0, At, B0); PG8_MMA(0, 1, At, B1); PG8_BAR; PG8_SCHED;
            PG8_LDA(At, 1, 1); PG8_STAGE(PG8_SB(1, 0), b3, voffB); PG8_STAGE(PG8_SB(1, 1), b3 + hstep, voffB); PG8_STAGE(PG8_SA(1, 0), a3, voffA);
            PG8_WAIT_V(8); PG8_WAIT_L(0); PG8_BAR; PG8_MMA(1, 0, At, B0); PG8_MMA(1, 1, At, B1); PG8_BAR; PG8_SCHED;
            } else {
            PG8_LDB(B0, 0, 0); PG8_SCHED; PG8_LDA(At, 0, 0); PG8_STAGE(PG8_SA(1, 1), a1 + hstep, voffA);
            PG8_WAIT_L(8); PG8_BAR; PG8_WAIT_L(0); PG8_MMA(0, 0, At, B0); PG8_BAR; PG8_SCHED;
            PG8_LDB(B1, 0, 1); PG8_STAGE(PG8_SB(0, 0), b2, voffB);
            PG8_BAR; PG8_WAIT_L(0); PG8_MMA(0, 1, At, B1); PG8_BAR;
            PG8_LDA(At, 0, 1); PG8_STAGE(PG8_SA(0, 0), a2, voffA);
            PG8_BAR; PG8_WAIT_L(0); PG8_MMA(1, 0, At, B0); PG8_BAR; PG8_SCHED;
            PG8_STAGE(PG8_SB(0, 1), b2 + hstep, voffB);
            PG8_WAIT_V(6); PG8_BAR; PG8_MMA(1, 1, At, B1); PG8_BAR;
            PG8_LDB(B0, 1, 0); PG8_SCHED; PG8_LDA(At, 1, 0); PG8_STAGE(PG8_SA(0, 1), a2 + hstep, voffA);
            PG8_WAIT_L(8); PG8_BAR; PG8_WAIT_L(0); PG8_MMA(0, 0, At, B0); PG8_BAR; PG8_SCHED;
            PG8_LDB(B1, 1, 1); PG8_STAGE(PG8_SB(1, 0), b3, voffB);
            PG8_BAR; PG8_WAIT_L(0); PG8_MMA(0, 1, At, B1); PG8_BAR;
            PG8_LDA(At, 1, 1); PG8_STAGE(PG8_SA(1, 0), a3, voffA);
            PG8_BAR; PG8_WAIT_L(0); PG8_MMA(1, 0, At, B0); PG8_BAR; PG8_SCHED;
            PG8_STAGE(PG8_SB(1, 1), b3 + hstep, voffB);
            PG8_WAIT_V(6); PG8_BAR; PG8_MMA(1, 1, At, B1); PG8_BAR;
            }
        }
        if constexpr (ALIGN_EPI) { if (wr == 0) PG8_BAR; }
        if constexpr (!Epi::AFTER_DRAIN) { E(acc, cur, wr, wc, fr, fq); S.done(cur); }
        if (!has_next) break;
#pragma unroll
        for (int a = 0; a < 2; ++a)
#pragma unroll
            for (int b = 0; b < 2; ++b)
#pragma unroll
                for (int m = 0; m < 4; ++m)
#pragma unroll
                    for (int n = 0; n < 2; ++n) acc[a][b][m][n] = (f32x4){0.f, 0.f, 0.f, 0.f};
        cur = nxt; cA = nA; cB = nB; ++ui;
        if constexpr (ALIGN_EPI) { if (wr == 1) PG8_BAR; }
    }
    PG8_WAIT_V(0);
    if constexpr (!ALIGN_EPI) { if (wr == 0) PG8_BAR; }
    PG8_BAR;
    if constexpr (Epi::AFTER_DRAIN) { E.fused(acc, cur, wr, wc, fr, fq, lds, wid, lane); S.done(cur); }
#undef PG8_SA
#undef PG8_SB
#undef PG8_STAGE
#undef PG8_LDA
#undef PG8_LDB
#undef PG8_MMA
#undef PG8_WAIT_V
#undef PG8_WAIT_L
#undef PG8_BAR
#undef PG8_SCHED
}
}

__device__ __forceinline__ unsigned pkbf(float lo, float hi) { return pg8::cvt_pk_bf16(lo, hi); }
__device__ __forceinline__ void st8bf(bf16_t* p, f32x4 a, f32x4 b) { u32x4 w; w.x = pkbf(a[0], a[1]); w.y = pkbf(a[2], a[3]); w.z = pkbf(b[0], b[1]); w.w = pkbf(b[2], b[3]); *(u32x4*)p = w; }
__device__ __forceinline__ f32x4 bflo(u32x4 g) { f32x4 o; o[0] = __uint_as_float(g.x << 16); o[1] = __uint_as_float(g.x & 0xffff0000u); o[2] = __uint_as_float(g.y << 16); o[3] = __uint_as_float(g.y & 0xffff0000u); return o; }
__device__ __forceinline__ f32x4 bfhi(u32x4 g) { f32x4 o; o[0] = __uint_as_float(g.z << 16); o[1] = __uint_as_float(g.z & 0xffff0000u); o[2] = __uint_as_float(g.w << 16); o[3] = __uint_as_float(g.w & 0xffff0000u); return o; }
__device__ __forceinline__ void rot8(f32x4& a, f32x4& b, f32x4 c, f32x4 s) {
    const f32x4 x = a, y = b;
    a[0] = x[0] * c[0] - x[1] * s[0]; a[1] = x[1] * c[0] + x[0] * s[0]; a[2] = x[2] * c[1] - x[3] * s[1]; a[3] = x[3] * c[1] + x[2] * s[1];
    b[0] = y[0] * c[2] - y[1] * s[2]; b[1] = y[1] * c[2] + y[0] * s[2]; b[2] = y[2] * c[3] - y[3] * s[3]; b[3] = y[3] * c[3] + y[2] * s[3];
}
__device__ __forceinline__ f32x4 sig4(f32x4 v) { f32x4 o; o[0] = 1.f / (1.f + __expf(-v[0])); o[1] = 1.f / (1.f + __expf(-v[1])); o[2] = 1.f / (1.f + __expf(-v[2])); o[3] = 1.f / (1.f + __expf(-v[3])); return o; }
__host__ __device__ __forceinline__ int src_in(int n) {
    if (n < 1024) return n;
    if (n < 4096) { const int seg = (n - 1024) >> 10, c = (n - 1024) & 1023, d = c & 127; int od = d; if (seg < 2 && d < 32) od = (d >> 1) + (d & 1) * 16; return 1088 + seg * 1024 + (c & ~127) + od; }
    if (n < 5120) { const int c = n - 4096, d = c & 63; const int od = d < 16 ? (d >> 1) + (d & 1) * 8 : d; return 4160 + (c & ~63) + od; }
    if (n < 7168) return 5264 + (n - 5120);
    if (n < 9216) return 7312 + (n - 7168);
    if (n < 9280) { const int d = n - 9216; return 1024 + (d >> 1) + (d & 1) * 32; }
    if (n < 9344) { const int d = n - 9280; const int od = d < 16 ? (d >> 1) + (d & 1) * 8 : d; return 5184 + od; }
    if (n < 9360) return 5248 + (n - 9344);
    return -1;
}
__host__ __device__ __forceinline__ int src_qa(int n) { const int h = n / 192, d = n - h * 192; if (d < 128) return n; const int dd = d - 128; return h * 192 + 128 + (dd >> 1) + (dd & 1) * 32; }

struct EpiIn {
    static constexpr bool PERM = true, AFTER_DRAIN = false;
    unsigned char* ws;
    __device__ __forceinline__ void operator()(const f32x4 (&acc)[2][2][4][2], const pg8::Unit& u, int wr, int wc, int fr, int fq) const {
        const int row0 = u.pm * 256 + wr * 64 + fr, cu = wc * 32 + 8 * fq, pn = u.pn;
        bf16_t* const CQ = (bf16_t*)(ws + WS_CQ); bf16_t* const QB = (bf16_t*)(ws + WS_QB); bf16_t* const QI = (bf16_t*)(ws + WS_QI); bf16_t* const GA = (bf16_t*)(ws + WS_GA);
        bf16_t* const KA = (bf16_t*)(ws + WS_KA); bf16_t* const KI = (bf16_t*)(ws + WS_KI); float* const WI = (float*)(ws + WS_WI); float* const part = (float*)(ws + WS_SSQ);
        const float* const cM = (const float*)(ws + WS_ROPE); const float* const sM = cM + T * 32; const float* const cD = cM + T * 64; const float* const sD = cM + T * 80; const float* const cI = cM + T * 96; const float* const sI = cM + T * 104;
#define EPI_ROWS(BODY) _Pragma("unroll") for (int ai = 0; ai < 2; ++ai) _Pragma("unroll") for (int m = 0; m < 4; ++m) { const int t = row0 + ai * 128 + m * 16; \
            _Pragma("unroll") for (int bj = 0; bj < 2; ++bj) { f32x4 a = acc[ai][bj][m][0], b = acc[ai][bj][m][1]; BODY } }
        if (pn < 4) {
            bf16_t* const dst = CQ + (size_t)(pn >> 1) * ((size_t)T * 512) + (pn & 1) * 256 + cu;
            EPI_ROWS(
                st8bf(dst + (size_t)t * 512 + bj * 128, a, b);
                float sq = ((a[0] * a[0] + a[1] * a[1]) + (a[2] * a[2] + a[3] * a[3])) + ((b[0] * b[0] + b[1] * b[1]) + (b[2] * b[2] + b[3] * b[3]));
                sq += __shfl_xor(sq, 16); sq += __shfl_xor(sq, 32);
                if (fq == 0) part[(size_t)t * 32 + pn * 8 + bj * 4 + wc] = sq; )
        } else if (pn < 16) {
            const int seg = (pn - 4) >> 2; const bool rot = seg < 2 && wc == 0;
            bf16_t* const dst = QB + (size_t)seg * ((size_t)T * 1024) + ((pn - 4) & 3) * 256 + cu;
            EPI_ROWS(
                if (rot) rot8(a, b, *(const f32x4*)(cD + (size_t)t * 16 + 4 * fq), *(const f32x4*)(sD + (size_t)t * 16 + 4 * fq));
                st8bf(dst + (size_t)t * 1024 + bj * 128, a, b); )
        } else if (pn < 20) {
            const bool rot = (wc & 1) == 0 && fq < 2;
            bf16_t* const dst = QI + (pn - 16) * 256 + cu;
            EPI_ROWS(
                if (rot) rot8(a, b, *(const f32x4*)(cI + (size_t)t * 8 + 4 * fq), *(const f32x4*)(sI + (size_t)t * 8 + 4 * fq));
                st8bf(dst + (size_t)t * 1024 + bj * 128, a, b); )
        } else if (pn < 36) {
            bf16_t* const dst = GA + (size_t)((pn - 20) >> 3) * ((size_t)T * D) + ((pn - 20) & 7) * 256 + cu;
            EPI_ROWS( st8bf(dst + (size_t)t * D + bj * 128, sig4(a), sig4(b)); )
        } else {
            EPI_ROWS(
                if (bj == 0) {
                    if (wc < 2) {
                        rot8(a, b, *(const f32x4*)(cM + (size_t)t * 32 + (cu >> 1)), *(const f32x4*)(sM + (size_t)t * 32 + (cu >> 1)));
                        _Pragma("unroll") for (int h = 0; h < 8; ++h) st8bf(KA + (size_t)t * 1536 + h * 192 + 128 + cu, a, b);
                    } else {
                        const int d = cu - 64;
                        if (d < 16) rot8(a, b, *(const f32x4*)(cI + (size_t)t * 8 + (d >> 1)), *(const f32x4*)(sI + (size_t)t * 8 + (d >> 1)));
                        st8bf(KI + (size_t)t * 64 + d, a, b);
                    }
                } else if (cu < 16) {
                    *(f32x4*)(WI + (size_t)t * 16 + cu) = a * 0.03125f; *(f32x4*)(WI + (size_t)t * 16 + cu + 4) = b * 0.03125f;
                } )
        }
#undef EPI_ROWS
    }
};
__device__ __forceinline__ float rms_from_part(const float* pp) {
    const f32x4 p0 = *(const f32x4*)pp, p1 = *(const f32x4*)(pp + 4), p2 = *(const f32x4*)(pp + 8), p3 = *(const f32x4*)(pp + 12);
    const float s = (((p0[0] + p0[1]) + (p0[2] + p0[3])) + ((p1[0] + p1[1]) + (p1[2] + p1[3]))) + (((p2[0] + p2[1]) + (p2[2] + p2[3])) + ((p3[0] + p3[1]) + (p3[2] + p3[3])));
    return rsqrtf(s * (1.f / 512.f) + 1e-6f);
}
struct EpiQA {
    static constexpr bool PERM = true, AFTER_DRAIN = false;
    unsigned char* ws;
    __device__ __forceinline__ void operator()(const f32x4 (&acc)[2][2][4][2], const pg8::Unit& u, int wr, int wc, int fr, int fq) const {
        const int row0 = u.pm * 256 + wr * 64 + fr, cu = wc * 32 + 8 * fq;
        bf16_t* const QA = (bf16_t*)(ws + WS_QA); const float* const part = (const float*)(ws + WS_SSQ); const float* const cM = (const float*)(ws + WS_ROPE); const float* const sM = cM + T * 32;
#pragma unroll
        for (int ai = 0; ai < 2; ++ai)
#pragma unroll
            for (int m = 0; m < 4; ++m) {
                const int t = row0 + ai * 128 + m * 16;
                const float r = rms_from_part(part + (size_t)t * 32);
#pragma unroll
                for (int bj = 0; bj < 2; ++bj) {
                    const int n = u.pn * 256 + bj * 128 + cu, h = n / 192, d = n - h * 192;
                    f32x4 a = acc[ai][bj][m][0] * r, b = acc[ai][bj][m][1] * r;
                    if (d >= 128) rot8(a, b, *(const f32x4*)(cM + (size_t)t * 32 + ((d - 128) >> 1)), *(const f32x4*)(sM + (size_t)t * 32 + ((d - 128) >> 1)));
                    st8bf(QA + (size_t)t * 1536 + n, a, b);
                }
            }
    }
};
struct EpiKV {
    static constexpr bool PERM = true, AFTER_DRAIN = false;
    unsigned char* ws;
    __device__ __forceinline__ void operator()(const f32x4 (&acc)[2][2][4][2], const pg8::Unit& u, int wr, int wc, int fr, int fq) const {
        const int row0 = u.pm * 256 + wr * 64 + fr, cu = wc * 32 + 8 * fq;
        bf16_t* const KA = (bf16_t*)(ws + WS_KA); bf16_t* const VA = (bf16_t*)(ws + WS_VA); const float* const part = (const float*)(ws + WS_SSQ);
#pragma unroll
        for (int ai = 0; ai < 2; ++ai)
#pragma unroll
            for (int m = 0; m < 4; ++m) {
                const int t = row0 + ai * 128 + m * 16;
                const float r = rms_from_part(part + (size_t)t * 32 + 16);
                st8bf(KA + (size_t)t * 1536 + u.pn * 192 + cu, acc[ai][0][m][0] * r, acc[ai][0][m][1] * r);
                st8bf(VA + (size_t)t * 1024 + u.pn * 128 + cu, acc[ai][1][m][0] * r, acc[ai][1][m][1] * r);
            }
    }
};
struct EpiYA {
    static constexpr bool PERM = true, AFTER_DRAIN = false;
    unsigned char* ws;
    __device__ __forceinline__ void operator()(const f32x4 (&acc)[2][2][4][2], const pg8::Unit& u, int wr, int wc, int fr, int fq) const {
        const int row0 = u.pm * 256 + wr * 64 + fr, col0 = u.pn * 256 + wc * 32 + 8 * fq;
        float* const YT = (float*)(ws + WS_YT); const bf16_t* const GA = (const bf16_t*)(ws + WS_GA);
#pragma unroll
        for (int ai = 0; ai < 2; ++ai)
#pragma unroll
            for (int m = 0; m < 4; ++m)
#pragma unroll
                for (int bj = 0; bj < 2; ++bj) {
                    const size_t o = (size_t)(row0 + ai * 128 + m * 16) * D + col0 + bj * 128;
                    const u32x4 g = *(const u32x4*)(GA + o);
                    *(f32x4*)(YT + o) = acc[ai][bj][m][0] * bflo(g); *(f32x4*)(YT + o + 4) = acc[ai][bj][m][1] * bfhi(g);
                }
    }
};
struct EpiYB {
    static constexpr bool PERM = true, AFTER_DRAIN = false;
    unsigned char* ws;
    __device__ __forceinline__ void operator()(const f32x4 (&acc)[2][2][4][2], const pg8::Unit& u, int wr, int wc, int fr, int fq) const {
        const int row0 = u.pm * 256 + wr * 64 + fr, col0 = u.pn * 256 + wc * 32 + 8 * fq;
        const float* const YT = (const float*)(ws + WS_YT); const bf16_t* const GB = (const bf16_t*)(ws + WS_GB); bf16_t* const Y = (bf16_t*)(ws + WS_Y);
#pragma unroll
        for (int ai = 0; ai < 2; ++ai)
#pragma unroll
            for (int m = 0; m < 4; ++m)
#pragma unroll
                for (int bj = 0; bj < 2; ++bj) {
                    const size_t o = (size_t)(row0 + ai * 128 + m * 16) * D + col0 + bj * 128;
                    const u32x4 g = *(const u32x4*)(GB + o);
                    const f32x4 y0 = *(const f32x4*)(YT + o), y1 = *(const f32x4*)(YT + o + 4);
                    st8bf(Y + o, y0 + acc[ai][bj][m][0] * bflo(g), y1 + acc[ai][bj][m][1] * bfhi(g));
                }
    }
};
struct EpiOut {
    static constexpr bool PERM = true, AFTER_DRAIN = false;
    const float* hin; float* V1;
    __device__ __forceinline__ void operator()(const f32x4 (&acc)[2][2][4][2], const pg8::Unit& u, int wr, int wc, int fr, int fq) const {
        const int row0 = u.pm * 256 + wr * 64 + fr, col0 = u.pn * 256 + wc * 32 + 8 * fq;
#pragma unroll
        for (int ai = 0; ai < 2; ++ai)
#pragma unroll
            for (int m = 0; m < 4; ++m)
#pragma unroll
                for (int bj = 0; bj < 2; ++bj) {
                    const size_t o = (size_t)(row0 + ai * 128 + m * 16) * D + col0 + bj * 128;
                    const f32x4 h0 = *(const f32x4*)(hin + o), h1 = *(const f32x4*)(hin + o + 4);
                    *(f32x4*)(V1 + o) = h0 * ALPHA + acc[ai][bj][m][0]; *(f32x4*)(V1 + o + 4) = h1 * ALPHA + acc[ai][bj][m][1];
                }
    }
};

#define LDS_WAIT() asm volatile("s_waitcnt lgkmcnt(0)" ::: "memory")
template <int MAP>
__device__ __forceinline__ void transpose_item(const float* W, int ldw, int K, int N, const float* kscale, bf16_t* WT, LAS float* scr, int item, int lane) {
    const int nblk = N / 32, kb = item / nblk, nb = item % nblk, k0 = 64 * kb, n0 = 32 * nb;
    const int n = n0 + (lane & 31);
    const int sc = MAP == 0 ? n : (MAP == 1 ? src_in(n) : src_qa(n));
#pragma unroll 8
    for (int i = 0; i < 32; ++i) { const int kk = 2 * i + (lane >> 5);
        float v = sc >= 0 ? W[(size_t)(k0 + kk) * ldw + sc] : 0.f; if (kscale) v *= kscale[k0 + kk];
        scr[kk * 33 + (lane & 31)] = v; }
    LDS_WAIT(); asm volatile("" ::: "memory");
    const int c = lane & 7;
#pragma unroll
    for (int j = 0; j < 4; ++j) { const int nn = (lane >> 3) + 8 * j; const LAS float* sp = scr + (8 * c) * 33 + nn;
        u32x4 o; o.x = pkbf(sp[0 * 33], sp[1 * 33]); o.y = pkbf(sp[2 * 33], sp[3 * 33]); o.z = pkbf(sp[4 * 33], sp[5 * 33]); o.w = pkbf(sp[6 * 33], sp[7 * 33]);
        *(u32x4*)(WT + (size_t)(n0 + nn) * K + k0 + 8 * c) = o; }
    LDS_WAIT(); asm volatile("" ::: "memory");
}
__device__ __forceinline__ void p_prologue(LAS unsigned char* ldsb, const Params& p) {
    float* rope = (float*)(p.ws + WS_ROPE);
    float *cM = rope, *sM = rope + T * 32, *cD = rope + T * 64, *sD = rope + T * 80, *cI = rope + T * 96, *sI = rope + T * 104;
    const int gtid = blockIdx.x * NTHREADS + threadIdx.x, gstride = gridDim.x * NTHREADS;
    for (int idx = gtid; idx < T * 56; idx += gstride) {
        const int t = idx / 56, j = idx - t * 56;
        int rot, i; float *ct, *st; int w;
        if (j < 32) { rot = 64; i = j; ct = cM; st = sM; w = 32; } else if (j < 48) { rot = 32; i = j - 32; ct = cD; st = sD; w = 16; } else { rot = 16; i = j - 48; ct = cI; st = sI; w = 8; }
        const float inv = exp2f(-((float)(2 * i) / (float)rot) * 18.931568569324174f);
        const float ang = (float)p.pos[t] * inv;
        double rev = (double)ang * 0.15915494309189535; rev -= rint(rev);
        const float r = (float)(rev * 6.283185307179586);
        ct[t * w + i] = __cosf(r); st[t * w + i] = __sinf(r);
    }
    bf16_t* XB = (bf16_t*)(p.ws + WS_XB);
    for (size_t i = (size_t)gtid * 4; i < (size_t)T * D; i += (size_t)gstride * 4) st4bf(XB + i, *(const f32x4*)(p.x + i));
    const int wave = threadIdx.x >> 6, lane = threadIdx.x & 63;
    LAS float* scr = (LAS float*)(ldsb + wave * 16384);
    const int gw = blockIdx.x * 8 + wave, NGW = gridDim.x * 8;
    constexpr int I_IN = (D / 64) * (INP / 32), I_QB = (512 / 64) * (1536 / 32), I_KV = (512 / 64) * (2048 / 32), I_O = (1024 / 64) * (D / 32), I_OUT = (D / 64) * (D / 32);
    constexpr int I_LAYER = I_IN + I_QB + I_KV + 2 * I_O + I_OUT;
    for (int it = gw; it < DEPTH * I_LAYER; it += NGW) {
        const int l = it / I_LAYER; int r = it - l * I_LAYER;
        if (r < I_IN) { transpose_item<1>(p.w_in + (size_t)l * D * INW, INW, D, INP, nullptr, (bf16_t*)(p.ws + WS_WIN_T) + (size_t)l * INP * D, scr, r, lane); continue; } r -= I_IN;
        if (r < I_QB) { transpose_item<2>(p.w_qb + (size_t)l * 512 * 1536, 1536, 512, 1536, p.g_q + l * 512, (bf16_t*)(p.ws + WS_WQB_T) + (size_t)l * 1536 * 512, scr, r, lane); continue; } r -= I_QB;
        if (r < I_KV) { transpose_item<0>(p.w_kvb + (size_t)l * 512 * 2048, 2048, 512, 2048, p.g_kv + l * 512, (bf16_t*)(p.ws + WS_WKVB_T) + (size_t)l * 2048 * 512, scr, r, lane); continue; } r -= I_KV;
        if (r < I_O) { transpose_item<0>(p.w_oa + (size_t)l * 1024 * D, D, 1024, D, nullptr, (bf16_t*)(p.ws + WS_WOA_T) + (size_t)l * D * 1024, scr, r, lane); continue; } r -= I_O;
        if (r < I_O) { transpose_item<0>(p.w_ob + (size_t)l * 1024 * D, D, 1024, D, nullptr, (bf16_t*)(p.ws + WS_WOB_T) + (size_t)l * D * 1024, scr, r, lane); continue; } r -= I_O;
        transpose_item<0>(p.w_out + (size_t)l * D * D, D, D, D, nullptr, (bf16_t*)(p.ws + WS_WOUT_T) + (size_t)l * D * D, scr, r, lane);
    }
    __syncthreads();
}

__device__ __forceinline__ unsigned f2key(float f) { const unsigned u = __float_as_uint(f); return (u & 0x80000000u) ? ~u : (u | 0x80000000u); }
__device__ __forceinline__ void p_index(float* lds, const Params& p) {
    const bf16_t* QI = (const bf16_t*)(p.ws + WS_QI); const bf16_t* KI = (const bf16_t*)(p.ws + WS_KI); const float* WI = (const float*)(p.ws + WS_WI);
    unsigned* MASK = (unsigned*)(p.ws + WS_MASK);
    float* qs = lds; float* wsc = lds + 1024; float* sc = lds + 1040; int* red = (int*)(lds + 1040 + 4096);
    const int tid = opaque_tid(), lane = tid & 63, wv = tid >> 6;
    for (int t = blockIdx.x; t < T; t += gridDim.x) {
        const int b = t >> 12, ti = t & 4095, nk = ti + 1;
        __syncthreads();
        for (int i = tid; i < 1024; i += NTHREADS) qs[i] = bf2f(QI[(size_t)t * 1024 + i]);
        if (tid < 16) wsc[tid] = WI[(size_t)t * 16 + tid];
        __syncthreads();
        for (int s = tid; s < nk; s += NTHREADS) {
            const bf16_t* kr = KI + (size_t)(b * S + s) * 64;
            float score = 0.f;
#pragma unroll 1
            for (int h = 0; h < 16; ++h) {
                asm volatile("" ::: "memory");
                float dot = 0.f;
#pragma unroll
                for (int c = 0; c < 8; ++c) {
                    const u32x4 raw = *(const u32x4*)(kr + c * 8);
                    const f32x4 q0 = *(const f32x4*)(qs + h * 64 + c * 8), q1 = *(const f32x4*)(qs + h * 64 + c * 8 + 4);
                    dot = fmaf(q0[0], __uint_as_float(raw.x << 16), dot); dot = fmaf(q0[1], __uint_as_float(raw.x & 0xffff0000u), dot);
                    dot = fmaf(q0[2], __uint_as_float(raw.y << 16), dot); dot = fmaf(q0[3], __uint_as_float(raw.y & 0xffff0000u), dot);
                    dot = fmaf(q1[0], __uint_as_float(raw.z << 16), dot); dot = fmaf(q1[1], __uint_as_float(raw.z & 0xffff0000u), dot);
                    dot = fmaf(q1[2], __uint_as_float(raw.w << 16), dot); dot = fmaf(q1[3], __uint_as_float(raw.w & 0xffff0000u), dot);
                }
                score = fmaf(wsc[h], fmaxf(dot, 0.f), score);
            }
            sc[s] = score;
        }
        __syncthreads();
        unsigned k0 = 0u, k1 = 0u, k2 = 0u, k3 = 0u, k4 = 0u, k5 = 0u, k6 = 0u, k7 = 0u;
        if (tid < nk) k0 = f2key(sc[tid]);
        if (tid + 512 < nk) k1 = f2key(sc[tid + 512]);
        if (tid + 1024 < nk) k2 = f2key(sc[tid + 1024]);
        if (tid + 1536 < nk) k3 = f2key(sc[tid + 1536]);
        if (tid + 2048 < nk) k4 = f2key(sc[tid + 2048]);
        if (tid + 2560 < nk) k5 = f2key(sc[tid + 2560]);
        if (tid + 3072 < nk) k6 = f2key(sc[tid + 3072]);
        if (tid + 3584 < nk) k7 = f2key(sc[tid + 3584]);
        unsigned res = 0u;
        if (nk > 256) {
#pragma unroll 1
            for (int bit = 31; bit >= 0; --bit) {
                const unsigned cand = res | (1u << bit);
                const int c = (k0 >= cand) + (k1 >= cand) + (k2 >= cand) + (k3 >= cand) + (k4 >= cand) + (k5 >= cand) + (k6 >= cand) + (k7 >= cand);
                if (block_sum_int(c, red) >= 256) res = cand;
            }
        }
        unsigned* mw = MASK + (size_t)t * 128 + 2 * wv;
#define MASK_OUT(j, kj) do { const unsigned long long bal = __ballot((tid + 512 * (j) < nk) && ((kj) >= res)); if (lane == 0) { mw[16 * (j)] = (unsigned)bal; mw[16 * (j) + 1] = (unsigned)(bal >> 32); } } while (0)
        MASK_OUT(0, k0); MASK_OUT(1, k1); MASK_OUT(2, k2); MASK_OUT(3, k3); MASK_OUT(4, k4); MASK_OUT(5, k5); MASK_OUT(6, k6); MASK_OUT(7, k7);
#undef MASK_OUT
    }
    __syncthreads();
}

typedef short bf16x8 __attribute__((ext_vector_type(8)));
typedef short s16x4 __attribute__((ext_vector_type(4)));
typedef float f32x16 __attribute__((ext_vector_type(16)));
template <int DQK, bool MASKED>
__device__ __forceinline__ void attn_unit(LAS unsigned char* ldsb, const bf16_t* Qg, int ldq, const bf16_t* Kg, int ldk, const bf16_t* Vg, int ldv, const unsigned* maskg, bf16_t* Og, int ldo, int qb, float sl2) {
    constexpr int CPR = DQK / 8, KBYTES = 64 * DQK * 2, VBYTES = 64 * 128 * 2, NKI = CPR * 64 / 512, ND = DQK / 16;
    constexpr int VOFF = 2 * KBYTES;
    const int tid = opaque_tid(), lane = tid & 63, wv = __builtin_amdgcn_readfirstlane(tid >> 6), r32 = lane & 31, hi = lane >> 5;
    const int NT = 4 * qb + 4, q0 = qb * 256 + wv * 32;
    const float NEG = -__builtin_inff();
    bf16x8 qr[ND];
#pragma unroll
    for (int d0 = 0; d0 < ND; ++d0) qr[d0] = *(const bf16x8*)(Qg + (size_t)(q0 + r32) * ldq + 16 * d0 + 8 * hi);
    const bf16_t* ksrc[NKI]; const bf16_t* vsrc[2];
#pragma unroll
    for (int i = 0; i < NKI; ++i) { const int g = i * 512 + tid, row = g / CPR, cp = g - row * CPR; const int ch = cp ^ (DQK == 128 ? (row & 15) : ((row >> 1) & 7)); ksrc[i] = Kg + (size_t)row * ldk + ch * 8; }
#pragma unroll
    for (int i = 0; i < 2; ++i) { const int g = i * 512 + tid, row = g >> 4, c16 = g & 15; const int blk = (c16 >> 2) ^ (row & 3); vsrc[i] = Vg + (size_t)row * ldv + (blk * 4 + (c16 & 3)) * 8; }
#define AT_STAGE(t_, buf_) do { \
        _Pragma("unroll") for (int i_ = 0; i_ < NKI; ++i_) __builtin_amdgcn_global_load_lds((const unsigned*)(ksrc[i_] + (size_t)(t_) * 64 * ldk), (LAS unsigned*)(ldsb + (buf_) * KBYTES + (i_ * 512 + wv * 64) * 16), 16, 0, 0); \
        _Pragma("unroll") for (int i_ = 0; i_ < 2; ++i_) __builtin_amdgcn_global_load_lds((const unsigned*)(vsrc[i_] + (size_t)(t_) * 64 * ldv), (LAS unsigned*)(ldsb + VOFF + (buf_) * VBYTES + (i_ * 512 + wv * 64) * 16), 16, 0, 0); } while (0)
    const int ksw = (DQK == 128 ? (r32 & 15) : ((r32 >> 1) & 7)) ^ hi;
    const unsigned krow = (unsigned)(size_t)ldsb + (unsigned)r32 * (DQK * 2);
    const int vq = (lane >> 2) & 3, vp = lane & 3, vg = lane >> 4;
    const unsigned vrow = (unsigned)(size_t)ldsb + VOFF + (unsigned)(4 * (vg >> 1) + vq) * 256 + (vg & 1) * 32 + vp * 8;
    float m_run = -1e30f, l_run = 0.f;
    f32x16 oT[4];
#pragma unroll
    for (int d0 = 0; d0 < 4; ++d0)
#pragma unroll
        for (int r = 0; r < 16; ++r) oT[d0][r] = 0.f;
    u32x2 mw_cur = {0u, 0u}, mw_nxt = {0u, 0u};
    const unsigned* mrow = MASKED ? maskg + (size_t)(q0 + r32) * 128 : nullptr;
    if (MASKED) mw_cur = *(const u32x2*)mrow;
    AT_STAGE(0, 0);
    asm volatile("s_waitcnt vmcnt(0)" ::: "memory");
    __builtin_amdgcn_s_barrier();
#define TRRD(dst, addr, off) asm volatile("ds_read_b64_tr_b16 %0, %1 offset:%2" : "=&v"(dst) : "v"(addr), "i"(off) : "memory")
#define AT_STEP(t_, buf_) do { \
        const int t = (t_); \
        if (t + 1 < NT) { if (MASKED) mw_nxt = *(const u32x2*)(mrow + 2 * (t + 1)); AT_STAGE(t + 1, (buf_) ^ 1); } \
        if (t * 64 <= q0 + 31) {                                    \
            int kx = ksw; asm volatile("" : "+v"(kx)); \
            f32x16 p0, p1; \
            _Pragma("unroll") for (int r = 0; r < 16; ++r) { p0[r] = 0.f; p1[r] = 0.f; } \
            _Pragma("unroll") for (int d0 = 0; d0 < ND; ++d0) { \
                const unsigned ka = krow + (buf_) * KBYTES + ((unsigned)((2 * d0) ^ kx) << 4); \
                const bf16x8 a0 = *(const LAS bf16x8*)(size_t)ka; const bf16x8 a1 = *(const LAS bf16x8*)(size_t)(ka + 32 * DQK * 2); \
                p0 = __builtin_amdgcn_mfma_f32_32x32x16_bf16(a0, qr[d0], p0, 0, 0, 0); \
                p1 = __builtin_amdgcn_mfma_f32_32x32x16_bf16(a1, qr[d0], p1, 0, 0, 0); } \
            if (MASKED) { \
                _Pragma("unroll") for (int r = 0; r < 16; ++r) { const int c = (r & 3) + 8 * (r >> 2) + 4 * hi; \
                    if (!((mw_cur.x >> c) & 1u)) p0[r] = NEG; if (!((mw_cur.y >> c) & 1u)) p1[r] = NEG; } \
            } else if (t * 64 + 63 > q0) {                          \
                const int dq = q0 + r32 - t * 64 - 4 * hi; \
                _Pragma("unroll") for (int r = 0; r < 16; ++r) { const int c = (r & 3) + 8 * (r >> 2); if (c > dq) p0[r] = NEG; if (c + 32 > dq) p1[r] = NEG; } \
            } \
            float mx = p0[0]; \
            _Pragma("unroll") for (int r = 1; r < 16; ++r) mx = fmaxf(mx, p0[r]); \
            _Pragma("unroll") for (int r = 0; r < 16; ++r) mx = fmaxf(mx, p1[r]); \
            { auto rr = __builtin_amdgcn_permlane32_swap(__float_as_uint(mx), __float_as_uint(mx), false, false); mx = fmaxf(__uint_as_float(rr[0]), __uint_as_float(rr[1])); } \
            const float mnew = fmaxf(m_run, mx); \
            const float alpha = __builtin_amdgcn_exp2f((m_run - mnew) * sl2); \
            m_run = mnew; const float mb = -mnew * sl2; \
            float ps = 0.f; \
            _Pragma("unroll") for (int r = 0; r < 16; ++r) { p0[r] = __builtin_amdgcn_exp2f(fmaf(p0[r], sl2, mb)); ps += p0[r]; } \
            _Pragma("unroll") for (int r = 0; r < 16; ++r) { p1[r] = __builtin_amdgcn_exp2f(fmaf(p1[r], sl2, mb)); ps += p1[r]; } \
            l_run = l_run * alpha + ps; \
            if (__any(alpha != 1.f)) { \
                _Pragma("unroll") for (int d0 = 0; d0 < 4; ++d0) _Pragma("unroll") for (int r = 0; r < 16; ++r) oT[d0][r] *= alpha; } \
            bf16x8 pb[4];                                            \
            { u32x4 w; \
              w.x = pkbf(p0[0], p0[1]); w.y = pkbf(p0[2], p0[3]); w.z = pkbf(p0[4], p0[5]); w.w = pkbf(p0[6], p0[7]); pb[0] = *reinterpret_cast<bf16x8*>(&w); \
              w.x = pkbf(p0[8], p0[9]); w.y = pkbf(p0[10], p0[11]); w.z = pkbf(p0[12], p0[13]); w.w = pkbf(p0[14], p0[15]); pb[1] = *reinterpret_cast<bf16x8*>(&w); \
              w.x = pkbf(p1[0], p1[1]); w.y = pkbf(p1[2], p1[3]); w.z = pkbf(p1[4], p1[5]); w.w = pkbf(p1[6], p1[7]); pb[2] = *reinterpret_cast<bf16x8*>(&w); \
              w.x = pkbf(p1[8], p1[9]); w.y = pkbf(p1[10], p1[11]); w.z = pkbf(p1[12], p1[13]); w.w = pkbf(p1[14], p1[15]); pb[3] = *reinterpret_cast<bf16x8*>(&w); } \
            int vx = vq; asm volatile("" : "+v"(vx)); \
            _Pragma("unroll") for (int d0 = 0; d0 < 4; ++d0) { \
                const unsigned va = vrow + (buf_) * VBYTES + ((unsigned)(d0 ^ vx) << 6); \
                s16x4 l0, h0, l1, h1, l2, h2, l3, h3; \
                TRRD(l0, va, 0); TRRD(h0, va, 2048); TRRD(l1, va, 4096); TRRD(h1, va, 6144); TRRD(l2, va, 8192); TRRD(h2, va, 10240); TRRD(l3, va, 12288); TRRD(h3, va, 14336); \
                asm volatile("s_waitcnt lgkmcnt(0)" ::: "memory"); __builtin_amdgcn_sched_barrier(0); \
                oT[d0] = __builtin_amdgcn_mfma_f32_32x32x16_bf16((bf16x8){l0[0], l0[1], l0[2], l0[3], h0[0], h0[1], h0[2], h0[3]}, pb[0], oT[d0], 0, 0, 0); \
                oT[d0] = __builtin_amdgcn_mfma_f32_32x32x16_bf16((bf16x8){l1[0], l1[1], l1[2], l1[3], h1[0], h1[1], h1[2], h1[3]}, pb[1], oT[d0], 0, 0, 0); \
                oT[d0] = __builtin_amdgcn_mfma_f32_32x32x16_bf16((bf16x8){l2[0], l2[1], l2[2], l2[3], h2[0], h2[1], h2[2], h2[3]}, pb[2], oT[d0], 0, 0, 0); \
                oT[d0] = __builtin_amdgcn_mfma_f32_32x32x16_bf16((bf16x8){l3[0], l3[1], l3[2], l3[3], h3[0], h3[1], h3[2], h3[3]}, pb[3], oT[d0], 0, 0, 0); } \
        } \
        if (MASKED) mw_cur = mw_nxt; \
        asm volatile("s_waitcnt vmcnt(0)" ::: "memory"); \
        asm volatile("s_waitcnt lgkmcnt(0)" ::: "memory"); \
        __builtin_amdgcn_s_barrier(); } while (0)
    for (int tt = 0; tt < NT; tt += 2) { AT_STEP(tt, 0); AT_STEP(tt + 1, 1); }
#undef AT_STEP
#undef AT_STAGE
#undef TRRD
    { auto rr = __builtin_amdgcn_permlane32_swap(__float_as_uint(l_run), __float_as_uint(l_run), false, false); l_run = __uint_as_float(rr[0]) + __uint_as_float(rr[1]); }
    const float inv = 1.f / l_run;
    bf16_t* orow = Og + (size_t)(q0 + r32) * ldo + 4 * hi;
#pragma unroll
    for (int d0 = 0; d0 < 4; ++d0)
#pragma unroll
        for (int rq = 0; rq < 4; ++rq) { u32x2 w; w.x = pkbf(oT[d0][4 * rq] * inv, oT[d0][4 * rq + 1] * inv); w.y = pkbf(oT[d0][4 * rq + 2] * inv, oT[d0][4 * rq + 3] * inv);
            *(u32x2*)(orow + 32 * d0 + 8 * rq) = w; }
}
__device__ __forceinline__ void p_attn(LAS unsigned char* ldsb, unsigned char* ws) {
    const bf16_t* QA = (const bf16_t*)(ws + WS_QA); const bf16_t* KA = (const bf16_t*)(ws + WS_KA); const bf16_t* VA = (const bf16_t*)(ws + WS_VA); bf16_t* OA = (bf16_t*)(ws + WS_OA);
    const bf16_t* QB = (const bf16_t*)(ws + WS_QB); const bf16_t* KB = (const bf16_t*)(ws + WS_KB); const bf16_t* VB = (const bf16_t*)(ws + WS_VB); bf16_t* OB = (bf16_t*)(ws + WS_OB);
    const unsigned* MASK = (const unsigned*)(ws + WS_MASK);
    for (int w = blockIdx.x; w < 256; w += gridDim.x) {
        const int bh = (w & 7) * 2 + ((w >> 3) & 1), i = w >> 4, b = bh >> 3, h = bh & 7;
        const size_t r0 = (size_t)b * S;
        attn_unit<192, false>(ldsb, QA + r0 * 1536 + h * 192, 1536, KA + r0 * 1536 + h * 192, 1536, VA + r0 * 1024 + h * 128, 1024, nullptr, OA + r0 * 1024 + h * 128, 1024, i, 0.07216878364870322f * 1.4426950408889634f);
        attn_unit<128, true>(ldsb, QB + r0 * 1024 + h * 128, 1024, KB + r0 * 1024 + h * 128, 1024, VB + r0 * 1024 + h * 128, 1024, MASK + r0 * 128, OB + r0 * 1024 + h * 128, 1024, 15 - i, 0.08838834764831845f * 1.4426950408889634f);
    }
}

template <int DQK, bool MASKED>
__device__ __forceinline__ void nattn(float* lds, const bf16_t* Q, const bf16_t* Kp, int ldk, const bf16_t* Vp, const unsigned* mask, bf16_t* O, float scale) {
    float* qs = lds; float* scb = lds + 8 * 192;
    const int tid = opaque_tid(), lane = tid & 63, h = tid >> 6;
    float* sc = scb + h * 4096;
    for (int t = blockIdx.x; t < T; t += gridDim.x) {
        const int b = t >> 12, ti = t & 4095, nk = ti + 1;
        __syncthreads();
        for (int i = tid; i < 8 * DQK; i += NTHREADS) qs[i] = bf2f(Q[(size_t)t * (8 * DQK) + i]);
        __syncthreads();
        const float* q = qs + h * DQK;
        float mx = -__builtin_inff();
        for (int s0 = 0; s0 < nk; s0 += 64) {
            const int s = s0 + lane; float v = -__builtin_inff();
            bool on = s < nk;
            if (MASKED && on) on = (mask[(size_t)t * 128 + (s >> 5)] >> (s & 31)) & 1u;
            if (on) {
                const bf16_t* kr = Kp + (size_t)(b * S + s) * ldk + h * DQK;
                float dot = 0.f;
#pragma unroll 4
                for (int c = 0; c < DQK / 8; ++c) { const u32x4 raw = *(const u32x4*)(kr + c * 8); const unsigned w[4] = {raw.x, raw.y, raw.z, raw.w};
#pragma unroll
                    for (int j = 0; j < 4; ++j) { dot = fmaf(q[c * 8 + 2 * j], __uint_as_float(w[j] << 16), dot); dot = fmaf(q[c * 8 + 2 * j + 1], __uint_as_float(w[j] & 0xffff0000u), dot); } }
                v = dot * scale;
            }
            if (s < nk) sc[s] = v;
            mx = fmaxf(mx, v);
        }
        mx = wave_max(mx);
        __syncthreads();
        float sum = 0.f;
        for (int s = lane; s < nk; s += 64) { const float pz = __expf(sc[s] - mx); sc[s] = pz; sum += pz; }
        sum = wave_sum(sum);
        __syncthreads();
        float a0 = 0.f, a1 = 0.f;
        const bf16_t* vb = Vp + (size_t)(b * S) * 1024 + h * 128 + lane * 2;
        for (int s = 0; s < nk; ++s) {
            const float pz = sc[s];
            if (pz != 0.f) { const unsigned w = *(const unsigned*)(vb + (size_t)s * 1024); a0 = fmaf(pz, __uint_as_float(w << 16), a0); a1 = fmaf(pz, __uint_as_float(w & 0xffff0000u), a1); }
        }
        const float inv = 1.f / sum;
        *(unsigned*)(O + (size_t)t * 1024 + h * 128 + lane * 2) = pk2(a0 * inv, a1 * inv);
    }
    __syncthreads();
}

__device__ __forceinline__ void p_ln1_route(float* lds, const Params& p, int l) {
    const float* V1 = (const float*)(p.ws + WS_V1); float* H1F = (float*)(p.ws + WS_H1F); bf16_t* H1B = (bf16_t*)(p.ws + WS_H1B);
    unsigned* cnt = (unsigned*)(p.ws + WS_CNT) + l * 64; int* LIST = (int*)(p.ws + WS_LIST);
    int* TOKE = (int*)(p.ws + WS_TOKE); float* TOKW = (float*)(p.ws + WS_TOKW); int* TOKS = (int*)(p.ws + WS_TOKS);
    const float* g = p.ln1g + (size_t)l * D; const float* bb = p.ln1b + (size_t)l * D;
    const float* wr = p.w_router + (size_t)l * D * 64; const float* wg = p.w_group + (size_t)l * D * 8;
    const float* br = p.b_router + l * 64; const float* bg = p.b_group + l * 8;
    const int tid = opaque_tid(), lane = tid & 63, wv = tid >> 6;
    float* lg = lds + wv * 80;
    for (int t0 = blockIdx.x * 8; t0 < T; t0 += gridDim.x * 8) {
        const int t = t0 + wv;
        float s1 = 0.f;
#pragma unroll 4
        for (int j = 0; j < 32; ++j) s1 += V1[(size_t)t * D + lane + 64 * j];
        const float mean = wave_sum(s1) * (1.f / D);
        float s2 = 0.f;
#pragma unroll 4
        for (int j = 0; j < 32; ++j) { const float d = V1[(size_t)t * D + lane + 64 * j] - mean; s2 += d * d; }
        const float rstd = rsqrtf(wave_sum(s2) * (1.f / D) + 1e-5f);
        float acc[72];
#pragma unroll
        for (int e = 0; e < 72; ++e) acc[e] = 0.f;
#pragma unroll 1
        for (int j = 0; j < 32; ++j) {
            const int k = lane + 64 * j;
            const float hk = (V1[(size_t)t * D + k] - mean) * rstd * g[k] + bb[k];
            H1F[(size_t)t * D + k] = hk; H1B[(size_t)t * D + k] = f2bf(hk);
            const float* wrow = wr + (size_t)k * 64;
#pragma unroll
            for (int e4 = 0; e4 < 16; ++e4) { const f32x4 w = *(const f32x4*)(wrow + e4 * 4);
                acc[e4 * 4] = fmaf(hk, w[0], acc[e4 * 4]); acc[e4 * 4 + 1] = fmaf(hk, w[1], acc[e4 * 4 + 1]); acc[e4 * 4 + 2] = fmaf(hk, w[2], acc[e4 * 4 + 2]); acc[e4 * 4 + 3] = fmaf(hk, w[3], acc[e4 * 4 + 3]); }
            const float* grow = wg + (size_t)k * 8;
            const f32x4 w0 = *(const f32x4*)grow, w1 = *(const f32x4*)(grow + 4);
            acc[64] = fmaf(hk, w0[0], acc[64]); acc[65] = fmaf(hk, w0[1], acc[65]); acc[66] = fmaf(hk, w0[2], acc[66]); acc[67] = fmaf(hk, w0[3], acc[67]);
            acc[68] = fmaf(hk, w1[0], acc[68]); acc[69] = fmaf(hk, w1[1], acc[69]); acc[70] = fmaf(hk, w1[2], acc[70]); acc[71] = fmaf(hk, w1[3], acc[71]);
        }
#pragma unroll
        for (int e = 0; e < 72; ++e) { const float r = wave_sum(acc[e]); if (lane == 0) lg[e] = r; }
        __syncthreads();
        if (lane == 0) {
            float gl[8]; float gmax = -__builtin_inff(); int gi = 0;
#pragma unroll
            for (int i = 0; i < 8; ++i) { gl[i] = lg[64 + i] + bg[i]; if (gl[i] > gmax) { gmax = gl[i]; gi = i; } }
            float gs = 0.f;
#pragma unroll
            for (int i = 0; i < 8; ++i) gs += __expf(gl[i] - gmax);
            const float gp = 1.f / gs;
            float el[8]; float emax = -__builtin_inff(); int e1 = 0;
#pragma unroll
            for (int i = 0; i < 8; ++i) { el[i] = lg[gi * 8 + i] + br[gi * 8 + i]; if (el[i] > emax) { emax = el[i]; e1 = i; } }
            float e2max = -__builtin_inff(); int e2 = 0;
#pragma unroll
            for (int i = 0; i < 8; ++i) { if (i != e1 && el[i] > e2max) { e2max = el[i]; e2 = i; } }
            const float p1 = 1.f, p2 = __expf(e2max - emax);
            const float wa = gp * p1 / (p1 + p2), wb = gp * p2 / (p1 + p2);
            const int ea = gi * 8 + e1, eb = gi * 8 + e2;
            const int sa = (int)atomicAdd(cnt + ea, 1u), sb = (int)atomicAdd(cnt + eb, 1u);
            LIST[(size_t)ea * ECAP + sa] = t; LIST[(size_t)eb * ECAP + sb] = t;
            TOKE[t * 2] = ea; TOKE[t * 2 + 1] = eb; TOKW[t * 2] = wa; TOKW[t * 2 + 1] = wb; TOKS[t * 2] = sa; TOKS[t * 2 + 1] = sb;
        }
        __syncthreads();
    }
}

__device__ __forceinline__ void moe_tables(int* tab, const unsigned* cnt, int items_per_rb) {
    if (threadIdx.x == 0) { int a = 0, bsum = 0; for (int e = 0; e < 64; ++e) { tab[e] = a; tab[80 + e] = bsum; const int c = (int)cnt[e]; a += ((c + 127) / 128) * items_per_rb; bsum += ((c + 255) / 256) * 256; } tab[64] = a; tab[80 + 64] = bsum; }
    __syncthreads();
}
__device__ __forceinline__ void p_moe1(float* lds, const Params& p, int l) {
    const unsigned* cnt = (const unsigned*)(p.ws + WS_CNT) + l * 64; const int* LIST = (const int*)(p.ws + WS_LIST);
    const bf16_t* H1B = (const bf16_t*)(p.ws + WS_H1B); bf16_t* HID = (bf16_t*)(p.ws + WS_HID);
    float* As = lds; float* Wg = lds + 32 * 132; float* Wu = Wg + 32 * 64; int* tab = (int*)(Wu + 32 * 64);
    __syncthreads();
    moe_tables(tab, cnt, 8);
    const int tid = opaque_tid(), ty = tid >> 4, tx = tid & 15;
    const int total = tab[64];
    for (int item = blockIdx.x; item < total; item += gridDim.x) {
        int e = 0; while (tab[e + 1] <= item) ++e;
        const int local = item - tab[e], rb = local >> 3, ct = local & 7, ce = (int)cnt[e], base = tab[80 + e];
        const float* wgp = p.w_eg + ((size_t)(l * 64 + e) * D) * FE + ct * 64;
        const float* wup = p.w_eu + ((size_t)(l * 64 + e) * D) * FE + ct * 64;
        const f32x4 z4 = {0.f, 0.f, 0.f, 0.f};
        f32x4 ag0 = z4, ag1 = z4, ag2 = z4, ag3 = z4, au0 = z4, au1 = z4, au2 = z4, au3 = z4;
        const int ar = tid >> 2, akq = (tid & 3) * 8, wk = tid >> 4, wn4 = (tid & 15) * 4;
        const int ai = rb * 128 + ar; const int tok = ai < ce ? LIST[(size_t)e * ECAP + ai] : -1;
        const bf16_t* ap = H1B + (size_t)(tok < 0 ? 0 : tok) * D + akq;
        for (int k0 = 0; k0 < D; k0 += 32) {
            __syncthreads();
            { u32x4 raw = *(const u32x4*)(ap + k0); if (tok < 0) raw = (u32x4){0u, 0u, 0u, 0u};
              float* dst = As + akq * 132 + ar;
              dst[0 * 132] = __uint_as_float(raw.x << 16); dst[1 * 132] = __uint_as_float(raw.x & 0xffff0000u); dst[2 * 132] = __uint_as_float(raw.y << 16); dst[3 * 132] = __uint_as_float(raw.y & 0xffff0000u);
              dst[4 * 132] = __uint_as_float(raw.z << 16); dst[5 * 132] = __uint_as_float(raw.z & 0xffff0000u); dst[6 * 132] = __uint_as_float(raw.w << 16); dst[7 * 132] = __uint_as_float(raw.w & 0xffff0000u); }
            *(f32x4*)(Wg + wk * 64 + wn4) = *(const f32x4*)(wgp + (size_t)(k0 + wk) * FE + wn4);
            *(f32x4*)(Wu + wk * 64 + wn4) = *(const f32x4*)(wup + (size_t)(k0 + wk) * FE + wn4);
            __syncthreads();
#pragma unroll 4
            for (int kk = 0; kk < 32; ++kk) {
                const f32x4 a = *(const f32x4*)(As + kk * 132 + ty * 4);
                const f32x4 g4 = *(const f32x4*)(Wg + kk * 64 + tx * 4);
                const f32x4 u4 = *(const f32x4*)(Wu + kk * 64 + tx * 4);
                ag0 += a[0] * g4; ag1 += a[1] * g4; ag2 += a[2] * g4; ag3 += a[3] * g4;
                au0 += a[0] * u4; au1 += a[1] * u4; au2 += a[2] * u4; au3 += a[3] * u4;
            }
        }
#define MOE1_OUT(i, G_, U_) do { const int ri = rb * 128 + ty * 4 + (i); if (ri < ce) { f32x4 o; \
            o[0] = G_[0] / (1.f + __expf(-G_[0])) * U_[0]; o[1] = G_[1] / (1.f + __expf(-G_[1])) * U_[1]; o[2] = G_[2] / (1.f + __expf(-G_[2])) * U_[2]; o[3] = G_[3] / (1.f + __expf(-G_[3])) * U_[3]; \
            st4bf(HID + (size_t)(base + ri) * FE + ct * 64 + tx * 4, o); } } while (0)
        MOE1_OUT(0, ag0, au0); MOE1_OUT(1, ag1, au1); MOE1_OUT(2, ag2, au2); MOE1_OUT(3, ag3, au3);
#undef MOE1_OUT
    }
    __syncthreads();
}
__device__ __forceinline__ void p_moe2(float* lds, const Params& p, int l) {
    const unsigned* cnt = (const unsigned*)(p.ws + WS_CNT) + l * 64;
    const bf16_t* HID = (const bf16_t*)(p.ws + WS_HID); bf16_t* YE = (bf16_t*)(p.ws + WS_YE);
    float* As = lds; float* Ws = lds + 32 * 132; int* tab = (int*)(Ws + 32 * 64 * 2);
    __syncthreads();
    moe_tables(tab, cnt, 32);
    const int tid = opaque_tid(), ty = tid >> 4, tx = tid & 15;
    const int total = tab[64];
    for (int item = blockIdx.x; item < total; item += gridDim.x) {
        int e = 0; while (tab[e + 1] <= item) ++e;
        const int local = item - tab[e], rb = local >> 5, ct = local & 31, ce = (int)cnt[e], base = tab[80 + e];
        const float* wdp = p.w_ed + ((size_t)(l * 64 + e) * FE) * D + ct * 64;
        f32x4 acc0 = {0.f, 0.f, 0.f, 0.f}, acc1 = acc0, acc2 = acc0, acc3 = acc0;
        const int ar = tid >> 2, akq = (tid & 3) * 8, wk = tid >> 4, wn4 = (tid & 15) * 4;
        const int ai = rb * 128 + ar; const bool av = ai < ce;
        const bf16_t* ap = HID + (size_t)(base + (av ? ai : 0)) * FE + akq;
        for (int k0 = 0; k0 < FE; k0 += 32) {
            __syncthreads();
            { u32x4 raw = *(const u32x4*)(ap + k0); if (!av) raw = (u32x4){0u, 0u, 0u, 0u};
              float* dst = As + akq * 132 + ar;
              dst[0 * 132] = __uint_as_float(raw.x << 16); dst[1 * 132] = __uint_as_float(raw.x & 0xffff0000u); dst[2 * 132] = __uint_as_float(raw.y << 16); dst[3 * 132] = __uint_as_float(raw.y & 0xffff0000u);
              dst[4 * 132] = __uint_as_float(raw.z << 16); dst[5 * 132] = __uint_as_float(raw.z & 0xffff0000u); dst[6 * 132] = __uint_as_float(raw.w << 16); dst[7 * 132] = __uint_as_float(raw.w & 0xffff0000u); }
            *(f32x4*)(Ws + wk * 64 + wn4) = *(const f32x4*)(wdp + (size_t)(k0 + wk) * D + wn4);
            __syncthreads();
#pragma unroll 8
            for (int kk = 0; kk < 32; ++kk) {
                const f32x4 a = *(const f32x4*)(As + kk * 132 + ty * 4);
                const f32x4 w = *(const f32x4*)(Ws + kk * 64 + tx * 4);
                acc0 += a[0] * w; acc1 += a[1] * w; acc2 += a[2] * w; acc3 += a[3] * w;
            }
        }
        { const int ri = rb * 128 + ty * 4; bf16_t* yo = YE + (size_t)(base + ri) * D + ct * 64 + tx * 4;
          if (ri < ce) st4bf(yo, acc0); if (ri + 1 < ce) st4bf(yo + D, acc1); if (ri + 2 < ce) st4bf(yo + 2 * D, acc2); if (ri + 3 < ce) st4bf(yo + 3 * D, acc3); }
    }
    __syncthreads();
}
__device__ __forceinline__ void p_ln2(float* lds, const Params& p, int l) {
    const unsigned* cnt = (const unsigned*)(p.ws + WS_CNT) + l * 64;
    const float* H1F = (const float*)(p.ws + WS_H1F); const bf16_t* YE = (const bf16_t*)(p.ws + WS_YE);
    const int* TOKE = (const int*)(p.ws + WS_TOKE); const float* TOKW = (const float*)(p.ws + WS_TOKW); const int* TOKS = (const int*)(p.ws + WS_TOKS);
    float* outF = (l == DEPTH - 1) ? p.out : (float*)(p.ws + WS_H2F); bf16_t* XB = (bf16_t*)(p.ws + WS_XB);
    const float* g = p.ln2g + (size_t)l * D; const float* bb = p.ln2b + (size_t)l * D;
    int* tab = (int*)lds;
    __syncthreads();
    moe_tables(tab, cnt, 1);
    const int tid = opaque_tid(), lane = tid & 63, wv = tid >> 6;
    for (int t0 = blockIdx.x * 8; t0 < T; t0 += gridDim.x * 8) {
        const int t = t0 + wv;
        const int r0 = tab[80 + TOKE[t * 2]] + TOKS[t * 2], r1 = tab[80 + TOKE[t * 2 + 1]] + TOKS[t * 2 + 1];
        const float w0 = TOKW[t * 2], w1 = TOKW[t * 2 + 1];
        const float* hrow = H1F + (size_t)t * D; const bf16_t* y0 = YE + (size_t)r0 * D; const bf16_t* y1 = YE + (size_t)r1 * D;
        float s1 = 0.f;
#pragma unroll 4
        for (int j = 0; j < 32; ++j) { const int k = lane + 64 * j; s1 += ALPHA * hrow[k] + w0 * bf2f(y0[k]) + w1 * bf2f(y1[k]); }
        const float mean = wave_sum(s1) * (1.f / D);
        float s2 = 0.f;
#pragma unroll 4
        for (int j = 0; j < 32; ++j) { const int k = lane + 64 * j; const float d = ALPHA * hrow[k] + w0 * bf2f(y0[k]) + w1 * bf2f(y1[k]) - mean; s2 += d * d; }
        const float rstd = rsqrtf(wave_sum(s2) * (1.f / D) + 1e-5f);
#pragma unroll 4
        for (int j = 0; j < 32; ++j) { const int k = lane + 64 * j; const float v = ALPHA * hrow[k] + w0 * bf2f(y0[k]) + w1 * bf2f(y1[k]);
            const float o = (v - mean) * rstd * g[k] + bb[k];
            outF[(size_t)t * D + k] = o; if (l != DEPTH - 1) XB[(size_t)t * D + k] = f2bf(o); }
    }
    __syncthreads();
}

constexpr int NPH = 9;
#ifndef PH_MASK
#define PH_MASK 0x3ff
#endif
#define PHON(k) ((PH_MASK >> (k)) & 1)
typedef const Params __attribute__((address_space(4))) CParams;
#define KP(field) ({ CParams* _k = kp; asm volatile("" : "+s"(_k)); _k->field; })
__global__ void __launch_bounds__(NTHREADS, 2) hybrid_fwd(Params p_unused, int ph_lo, int ph_hi) {
    extern __shared__ __attribute__((aligned(16))) unsigned char lds_raw[];
    float* lds = (float*)lds_raw;
    LAS unsigned char* ldsb = (LAS unsigned char*)lds_raw;
    CParams* kp = (CParams*)__builtin_amdgcn_kernarg_segment_ptr();
    unsigned char* const ws0 = KP(ws);
    volatile LAS unsigned* xbw = (volatile LAS unsigned*)(lds_raw + LDS_BYTES - 16);
    if (threadIdx.x == 0) { xbw[0] = 0u; xbw[1] = 0u; xbw[2] = 0u; xbw[3] = 0u; }
    __syncthreads();
    XcdBarrier bar; bar.bar = (unsigned*)(ws0 + WS_BAR); bar.x = 0; bar.st = xbw;
    if (ph_lo < ph_hi) bar = xcd_barrier_post((unsigned*)(ws0 + WS_BAR), xbw);
#define IN(ph) ((ph) >= ph_lo && (ph) <= ph_hi)
#define GRID_BAR(ph) do { if ((ph) >= ph_lo && (ph) < ph_hi) xcd_barrier(bar); } while (0)
    if (PHON(0) && IN(0)) { unsigned char* ws = ws0; asm volatile("" : "+s"(ws)); { Params q; q.ws = ws; q.x = KP(x); q.pos = KP(pos); q.w_in = KP(w_in); q.g_q = KP(g_q); q.w_qb = KP(w_qb); q.g_kv = KP(g_kv); q.w_kvb = KP(w_kvb);
        q.w_oa = KP(w_oa); q.w_ob = KP(w_ob); q.w_out = KP(w_out); p_prologue(ldsb, q); } }
    GRID_BAR(0);
    for (int l = 0; l < DEPTH; ++l) {
        const int pb = l * NPH;
        if (PHON(1) && IN(pb + 1)) { unsigned char* ws = ws0; asm volatile("" : "+s"(ws));
            EpiIn E; E.ws = ws;
            pg8::Gemm g{(const bf16_t*)(ws + WS_XB), (const bf16_t*)(ws + WS_WIN_T) + (size_t)l * INP * D, T, INP, D}; pg8::StaticOrder SO; SO.init(T, INP, (int)gridDim.x, (int)blockIdx.x);
            pg8::gemm_phase<EpiIn, pg8::StaticOrder, true, true>(ldsb, g, SO, E);
        }
        GRID_BAR(pb + 1);
        if (PHON(2) && IN(pb + 2)) { unsigned char* ws = ws0; asm volatile("" : "+s"(ws));
            { EpiQA E; E.ws = ws;
              pg8::Gemm g{(const bf16_t*)(ws + WS_CQ), (const bf16_t*)(ws + WS_WQB_T) + (size_t)l * 1536 * 512, T, 1536, 512}; pg8::StaticOrder SO; SO.init(T, 1536, (int)gridDim.x, (int)blockIdx.x);
              pg8::gemm_phase<EpiQA, pg8::StaticOrder, true, true>(ldsb, g, SO, E); }
            { EpiKV E; E.ws = ws;
              pg8::Gemm g{(const bf16_t*)(ws + WS_CKV), (const bf16_t*)(ws + WS_WKVB_T) + (size_t)l * 2048 * 512, T, 2048, 512}; pg8::StaticOrder SO; SO.init(T, 2048, (int)gridDim.x, (int)blockIdx.x);
              pg8::gemm_phase<EpiKV, pg8::StaticOrder, true, true>(ldsb, g, SO, E); }
            { Params q; q.ws = ws; p_index(lds, q); }
        }
        GRID_BAR(pb + 2);
        if (PHON(3) && IN(pb + 3)) { unsigned char* ws = ws0; asm volatile("" : "+s"(ws));
            p_attn(ldsb, ws);
        }
        GRID_BAR(pb + 3);
        if (PHON(4) && IN(pb + 4)) { unsigned char* ws = ws0; asm volatile("" : "+s"(ws));
            pg8::StaticOrder SO; SO.init(T, D, (int)gridDim.x, (int)blockIdx.x);
            { EpiYA E; E.ws = ws;
              pg8::Gemm g{(const bf16_t*)(ws + WS_OA), (const bf16_t*)(ws + WS_WOA_T) + (size_t)l * D * 1024, T, D, 1024};
              pg8::gemm_phase<EpiYA, pg8::StaticOrder, true, true>(ldsb, g, SO, E); }
            { EpiYB E; E.ws = ws;
              pg8::Gemm g{(const bf16_t*)(ws + WS_OB), (const bf16_t*)(ws + WS_WOB_T) + (size_t)l * D * 1024, T, D, 1024};
              pg8::gemm_phase<EpiYB, pg8::StaticOrder, true, true>(ldsb, g, SO, E); }
        }
        GRID_BAR(pb + 4);
        if (PHON(5) && IN(pb + 5)) { unsigned char* ws = ws0; asm volatile("" : "+s"(ws));
            EpiOut E; E.hin = (l == 0) ? KP(x) : (const float*)(ws + WS_H2F); E.V1 = (float*)(ws + WS_V1);
            pg8::Gemm g{(const bf16_t*)(ws + WS_Y), (const bf16_t*)(ws + WS_WOUT_T) + (size_t)l * D * D, T, D, D}; pg8::StaticOrder SO; SO.init(T, D, (int)gridDim.x, (int)blockIdx.x);
            pg8::gemm_phase<EpiOut, pg8::StaticOrder, true, true>(ldsb, g, SO, E);
        }
        GRID_BAR(pb + 5);
        if (PHON(6) && IN(pb + 6)) { unsigned char* ws = ws0; asm volatile("" : "+s"(ws)); Params q; q.ws = ws; q.ln1g = KP(ln1g); q.ln1b = KP(ln1b); q.w_router = KP(w_router); q.w_group = KP(w_group); q.b_router = KP(b_router); q.b_group = KP(b_group); p_ln1_route(lds, q, l); }
        GRID_BAR(pb + 6);
        if (PHON(7) && IN(pb + 7)) { unsigned char* ws = ws0; asm volatile("" : "+s"(ws)); Params q; q.ws = ws; q.w_eg = KP(w_eg); q.w_eu = KP(w_eu); p_moe1(lds, q, l); }
        GRID_BAR(pb + 7);
        if (PHON(8) && IN(pb + 8)) { unsigned char* ws = ws0; asm volatile("" : "+s"(ws)); Params q; q.ws = ws; q.w_ed = KP(w_ed); p_moe2(lds, q, l); }
        GRID_BAR(pb + 8);
        if (PHON(9) && IN(pb + 9)) { unsigned char* ws = ws0; asm volatile("" : "+s"(ws)); Params q; q.ws = ws; q.ln2g = KP(ln2g); q.ln2b = KP(ln2b); q.out = KP(out); p_ln2(lds, q, l); }
        GRID_BAR(pb + 9);
    }
}

#ifndef MK_ONE_LAUNCH
#define MK_ONE_LAUNCH 1
#endif
extern "C" void kernel_launch(void* const* d_in, const int* in_sizes, int n_in, void* d_out, int out_size, void* d_ws, size_t ws_size, hipStream_t stream) {
    static int grid = 0;
    if (!grid) {
        if (n_in != 21 || in_sizes[0] != T * D || out_size != T * D || ws_size < WS_END) {
            fprintf(stderr, "kernel_launch: unexpected shapes (n_in %d, in0 %d, out %d, ws %zu, need %zu); nothing launched\n", n_in, n_in > 0 ? in_sizes[0] : -1, out_size, ws_size, (size_t)WS_END);
            grid = -1; return; }
        int dev = 0, cus = 0, per_cu = 0;
        hipGetDevice(&dev); hipDeviceGetAttribute(&cus, hipDeviceAttributeMultiprocessorCount, dev);
        if (hipFuncSetAttribute((const void*)hybrid_fwd, hipFuncAttributeMaxDynamicSharedMemorySize, LDS_BYTES) != hipSuccess) { fprintf(stderr, "kernel_launch: hipFuncSetAttribute failed\n"); grid = -1; return; }
        hipOccupancyMaxActiveBlocksPerMultiprocessor(&per_cu, (const void*)hybrid_fwd, NTHREADS, LDS_BYTES);
        if (per_cu < 1) fprintf(stderr, "kernel_launch: occupancy query reports %d blocks per CU\n", per_cu);
        grid = cus > 0 ? cus : 256;
    }
    if (grid < 0) return;
    hipMemsetAsync((char*)d_ws, 0, WS_CTL_END, stream);
    Params p{};
    p.x = (const float*)d_in[0]; p.pos = (const int*)d_in[1];
    p.w_in = (const float*)d_in[2]; p.g_q = (const float*)d_in[3]; p.w_qb = (const float*)d_in[4]; p.g_kv = (const float*)d_in[5]; p.w_kvb = (const float*)d_in[6];
    p.w_oa = (const float*)d_in[7]; p.w_ob = (const float*)d_in[8]; p.w_out = (const float*)d_in[9]; p.ln1g = (const float*)d_in[10]; p.ln1b = (const float*)d_in[11];
    p.w_group = (const float*)d_in[12]; p.b_group = (const float*)d_in[13]; p.w_router = (const float*)d_in[14]; p.b_router = (const float*)d_in[15];
    p.w_eg = (const float*)d_in[16]; p.w_eu = (const float*)d_in[17]; p.w_ed = (const float*)d_in[18]; p.ln2g = (const float*)d_in[19]; p.ln2b = (const float*)d_in[20];
    p.out = (float*)d_out; p.ws = (unsigned char*)d_ws;
#if MK_ONE_LAUNCH
    hipLaunchKernelGGL(hybrid_fwd, dim3(grid), dim3(NTHREADS), LDS_BYTES, stream, p, 0, DEPTH * NPH);
#else
    for (int ph = 0; ph <= DEPTH * NPH; ++ph) hipLaunchKernelGGL(hybrid_fwd, dim3(grid), dim3(NTHREADS), LDS_BYTES, stream, p, ph, ph);
#endif
}
```

```cpp
#include <hip/hip_runtime.h>
#include <cstdio>
#include <cstdint>

typedef unsigned short bf16_t;
typedef float f32x4 __attribute__((ext_vector_type(4)));
typedef unsigned u32x4 __attribute__((ext_vector_type(4)));
typedef unsigned u32x2 __attribute__((ext_vector_type(2)));

constexpr int T = 8192, D = 2048, S = 4096, NB = 2, DEPTH = 2;
constexpr int INW = 9360, INP = 9472;
constexpr int NE = 64, FE = 512;
constexpr int NTHREADS = 512;
constexpr int LDS_BYTES = 147456;
constexpr float ALPHA = 1.41421356237309515f;
constexpr int ECAP = 8192;
constexpr int PMAX = 32768;

constexpr size_t al256(size_t x) { return (x + 255) & ~(size_t)255; }
constexpr size_t XCD_BAR_BYTES = 16384;
constexpr size_t WS_BAR = 0;
constexpr size_t WS_CNT = WS_BAR + XCD_BAR_BYTES;
constexpr size_t WS_CTL_END = WS_CNT + al256(DEPTH * 64 * 4);
constexpr size_t WS_SSQ = WS_CTL_END;
constexpr size_t WS_ROPE = WS_SSQ + al256((size_t)T * 32 * 4);
constexpr size_t WS_XB = WS_ROPE + al256((size_t)T * 112 * 4);
constexpr size_t WS_H2F = WS_XB + al256((size_t)T * D * 2);
constexpr size_t WS_CQ = WS_H2F + al256((size_t)T * D * 4);
constexpr size_t WS_CKV = WS_CQ + al256((size_t)T * 512 * 2);
constexpr size_t WS_QB = WS_CKV + al256((size_t)T * 512 * 2);
constexpr size_t WS_KB = WS_QB + al256((size_t)T * 1024 * 2);
constexpr size_t WS_VB = WS_KB + al256((size_t)T * 1024 * 2);
constexpr size_t WS_QI = WS_VB + al256((size_t)T * 1024 * 2);
constexpr size_t WS_KI = WS_QI + al256((size_t)T * 1024 * 2);
constexpr size_t WS_WI = WS_KI + al256((size_t)T * 64 * 2);
constexpr size_t WS_GA = WS_WI + al256((size_t)T * 16 * 4);
constexpr size_t WS_GB = WS_GA + al256((size_t)T * D * 2);
constexpr size_t WS_QA = WS_GB + al256((size_t)T * D * 2);
constexpr size_t WS_KA = WS_QA + al256((size_t)T * 1536 * 2);
constexpr size_t WS_VA = WS_KA + al256((size_t)T * 1536 * 2);
constexpr size_t WS_MASK = WS_VA + al256((size_t)T * 1024 * 2);
constexpr size_t WS_OA = WS_MASK + al256((size_t)T * 128 * 4);
constexpr size_t WS_OB = WS_OA + al256((size_t)T * 1024 * 2);
constexpr size_t WS_YT = WS_OB + al256((size_t)T * 1024 * 2);
constexpr size_t WS_Y = WS_YT + al256((size_t)T * D * 4);
constexpr size_t WS_V1 = WS_Y + al256((size_t)T * D * 2);
constexpr size_t WS_H1F = WS_V1 + al256((size_t)T * D * 4);
constexpr size_t WS_H1B = WS_H1F + al256((size_t)T * D * 4);
constexpr size_t WS_TOKE = WS_H1B + al256((size_t)T * D * 2);
constexpr size_t WS_TOKW = WS_TOKE + al256((size_t)T * 2 * 4);
constexpr size_t WS_TOKS = WS_TOKW + al256((size_t)T * 2 * 4);
constexpr size_t WS_LIST = WS_TOKS + al256((size_t)T * 2 * 4);
constexpr size_t WS_HID = WS_LIST + al256((size_t)NE * ECAP * 4);
constexpr size_t WS_YE = WS_HID + al256((size_t)PMAX * FE * 2);
constexpr size_t WS_SCORE = WS_YE + al256((size_t)PMAX * D * 2);
constexpr size_t WS_WIN_T = WS_SCORE + al256((size_t)T * 4096 * 4);
constexpr size_t WS_WQB_T = WS_WIN_T + al256((size_t)DEPTH * INP * D * 2);
constexpr size_t WS_WKVB_T = WS_WQB_T + al256((size_t)DEPTH * 1536 * 512 * 2);
constexpr size_t WS_WOA_T = WS_WKVB_T + al256((size_t)DEPTH * 2048 * 512 * 2);
constexpr size_t WS_WOB_T = WS_WOA_T + al256((size_t)DEPTH * D * 1024 * 2);
constexpr size_t WS_WOUT_T = WS_WOB_T + al256((size_t)DEPTH * D * 1024 * 2);
constexpr size_t WS_END = WS_WOUT_T + al256((size_t)DEPTH * D * D * 2);
static_assert(WS_CKV == WS_CQ + (size_t)T * 512 * 2, "CQ|CKV must be consecutive");

static_assert(WS_KB == WS_QB + (size_t)T * 1024 * 2 && WS_VB == WS_KB + (size_t)T * 1024 * 2 && WS_GB == WS_GA + (size_t)T * D * 2, "QB|KB|VB and GA|GB must be consecutive");
struct Params {
    const float* x; const int* pos;
    const float *w_in, *g_q, *w_qb, *g_kv, *w_kvb, *w_oa, *w_ob, *w_out, *ln1g, *ln1b, *w_group, *b_group, *w_router, *b_router, *w_eg, *w_eu, *w_ed, *ln2g, *ln2b;
    float* out; unsigned char* ws;
};

__device__ __forceinline__ float bf2f(bf16_t v) { return __uint_as_float((unsigned)v << 16); }
__device__ __forceinline__ bf16_t f2bf(float f) { unsigned u = __float_as_uint(f); u += 0x7fffu + ((u >> 16) & 1u); return (bf16_t)(u >> 16); }
__device__ __forceinline__ unsigned pk2(float a, float b) { return (unsigned)f2bf(a) | ((unsigned)f2bf(b) << 16); }
__device__ __forceinline__ void st4bf(bf16_t* p, f32x4 v) { u32x2 w; w.x = pk2(v[0], v[1]); w.y = pk2(v[2], v[3]); *(u32x2*)p = w; }
__device__ __forceinline__ float wave_sum(float v) {
#pragma unroll
    for (int o = 32; o >= 1; o >>= 1) v += __shfl_xor(v, o);
    return v;
}
__device__ __forceinline__ float wave_max(float v) {
#pragma unroll
    for (int o = 32; o >= 1; o >>= 1) v = fmaxf(v, __shfl_xor(v, o));
    return v;
}
__device__ __forceinline__ int block_sum_int(int v, int* red) {
#pragma unroll
    for (int o = 32; o >= 1; o >>= 1) v += __shfl_xor(v, o);
    if ((threadIdx.x & 63) == 0) red[threadIdx.x >> 6] = v;
    __syncthreads();
    int t = 0;
#pragma unroll
    for (int i = 0; i < 8; ++i) t += red[i];
    __syncthreads();
    return t;
}
__device__ __forceinline__ f32x4 rot4(f32x4 v, float c0, float s0, float c1, float s1) { f32x4 o; o[0] = v[0] * c0 - v[1] * s0; o[1] = v[1] * c0 + v[0] * s0; o[2] = v[2] * c1 - v[3] * s1; o[3] = v[3] * c1 + v[2] * s1; return o; }

#define XB_TMO      128
#define XB_XCNT(j)  (256  + 64 * (j))
#define XB_XSUB(j)  (1280 + 64 * (j))
#define XB_XGEN(j)  (2304 + 64 * (j))
#define XB_TOP      3328
#define XB_TOPGEN   3392
#define XCD_BAR_WORDS 3456
#define XB_SPIN_CAP (1u << 22)
#define LAS __attribute__((address_space(3)))
__device__ __forceinline__ unsigned xb_ld(unsigned* p)              { return __hip_atomic_load(p, __ATOMIC_RELAXED, __HIP_MEMORY_SCOPE_AGENT); }
__device__ __forceinline__ unsigned xb_add(unsigned* p, unsigned v) { return __hip_atomic_fetch_add(p, v, __ATOMIC_RELAXED, __HIP_MEMORY_SCOPE_AGENT); }
__device__ __forceinline__ unsigned xb_xcc_id() { return (unsigned)__builtin_amdgcn_s_getreg((3 << 11) | 20) & 0xFu; }
#define XB_SPIN(cond, bar) do { unsigned _sp = 0; while (cond) { __builtin_amdgcn_s_sleep(1); \
    if ((++_sp & 255u) == 0u) { if (xb_ld(&(bar)[XB_TMO])) break; if (_sp > XB_SPIN_CAP) { atomicAdd(&(bar)[XB_TMO], 1u); break; } } } } while (0)
struct XcdBarrier { unsigned* bar; unsigned x; volatile LAS unsigned* st; };
__device__ __forceinline__ XcdBarrier xcd_barrier_post(unsigned* bar, volatile LAS unsigned* st) {
    XcdBarrier b; b.bar = bar; b.x = xb_xcc_id(); b.st = st;
    if (threadIdx.x == 0) (void)xb_add(&bar[XB_XCNT(b.x)], 1u);
    return b;
}
__device__ __forceinline__ void xcd_barrier_complete(unsigned* bar, unsigned x, unsigned& nloc, unsigned& nx) {
    const unsigned G = gridDim.x * gridDim.y * gridDim.z;
    unsigned sum, cnt, mine, sp = 0u;
    for (;;) {
        sum = 0u; cnt = 0u; mine = 0u;
#pragma unroll
        for (unsigned j = 0; j < 16; ++j) { const unsigned c = xb_ld(&bar[XB_XCNT(j)]); sum += c; cnt += (c > 0u) ? 1u : 0u; mine = (j == x) ? c : mine; }
        if (sum == G) break;
        __builtin_amdgcn_s_sleep(1);
        if ((++sp & 255u) == 0u) { if (xb_ld(&bar[XB_TMO])) break; if (sp > XB_SPIN_CAP) { atomicAdd(&bar[XB_TMO], 1u); break; } }
    }
    nloc = mine > 0u ? mine : 1u; nx = cnt > 0u ? cnt : 1u;
}
__device__ __forceinline__ void xcd_barrier(const XcdBarrier& b) {
    asm volatile("s_waitcnt vmcnt(0)" ::: "memory");
    __syncthreads();
    if (threadIdx.x == 0) {
        unsigned* bar = b.bar;
        __builtin_amdgcn_s_waitcnt(0);
        unsigned nloc = b.st[0], nx = b.st[1];
        if (nloc == 0u) { xcd_barrier_complete(bar, b.x, nloc, nx); b.st[0] = nloc; b.st[1] = nx; }
        const unsigned old = xb_add(&bar[XB_XSUB(b.x)], 1u);
        const unsigned gen = old / nloc;
        if (old + 1u == (gen + 1u) * nloc) {
            __builtin_amdgcn_fence(__ATOMIC_RELEASE, "agent");
            asm volatile("s_waitcnt vmcnt(0)" ::: "memory");
            const unsigned og = xb_add(&bar[XB_TOP], 1u);
            const unsigned tg = og / nx;
            if (og + 1u == (tg + 1u) * nx) xb_add(&bar[XB_TOPGEN], 1u);
            else XB_SPIN(xb_ld(&bar[XB_TOPGEN]) == tg, bar);
            __builtin_amdgcn_fence(__ATOMIC_ACQUIRE, "agent");
            xb_add(&bar[XB_XGEN(b.x)], 1u);
            asm volatile("s_waitcnt vmcnt(0)" ::: "memory");
        } else {
            XB_SPIN(xb_ld(&bar[XB_XGEN(b.x)]) == gen, bar);
            __builtin_amdgcn_fence(__ATOMIC_ACQUIRE, "agent");
            asm volatile("s_waitcnt vmcnt(0)" ::: "memory");
        }
    }
    __syncthreads();
}

__device__ __forceinline__ int opaque_tid() { int t = threadIdx.x; asm volatile("" : "+v"(t)); return t; }
namespace pg8 {
#define PG8_LAS __attribute__((address_space(3)))
typedef unsigned short bf16_t;
typedef short bf16x8 __attribute__((ext_vector_type(8)));
typedef float f32x4 __attribute__((ext_vector_type(4)));
typedef unsigned u32x4 __attribute__((ext_vector_type(4)));
constexpr int BM = 256, BK = 64, HALF = 128, HTB = HALF * BK * 2  , STAGE_BYTES = 8 * HTB, NXCD = 8, WGM = 8;

__host__ __device__ __forceinline__ int lds_byte(int r, int c) { const int st = (r >> 4) * 2 + (c >> 5), rr = r & 15, cc = c & 31, ob = rr * 64 + cc * 2; return st * 1024 + (ob ^ (((ob >> 9) & 1) << 5)); }
__host__ __device__ __forceinline__ void stage_rc(int b, int& R, int& C) { const int st = b / 1024, sb = b % 1024, swz = sb ^ (((sb >> 9) & 1) << 5); R = (st >> 1) * 16 + swz / 64; C = (st & 1) * 32 + (swz % 64) / 2; }
__host__ __device__ __forceinline__ int perm32(int rho) { const int n = rho >> 4, i = rho & 15; return 8 * (i >> 2) + 4 * n + (i & 3); }

struct Unit { int pm, pn; };
struct Gemm { const bf16_t* A; const bf16_t* Bt; int M, N, K; };

struct StaticOrder {
    int nM, nN, nwg, G, c;
    __host__ __device__ void init(int M, int N, int G_, int c_) { nM = M / BM; nN = N / BM; nwg = nM * nN; G = G_; c = c_; }
    __host__ __device__ bool next(int i, Unit& u) const {
        const long L = (long)i * G + c; if (L >= nwg) return false;
        int wgid = (int)L; { const int q = nwg / NXCD, r = nwg % NXCD, xcd = wgid % NXCD, off = wgid / NXCD; wgid = (xcd < r ? xcd * (q + 1) : r * (q + 1) + (xcd - r) * q) + off; }
        const int nig = WGM * nN, gid = wgid / nig, fm = gid * WGM, gsz = (nM - fm) < WGM ? (nM - fm) : WGM;
        u.pm = fm + ((wgid % nig) % gsz); u.pn = (wgid % nig) / gsz; return true;
    }
    __device__ __forceinline__ void a_ready(const Unit&) const {}
    __device__ __forceinline__ void done(const Unit&) const {}
};

__device__ __forceinline__ unsigned cvt_pk_bf16(float lo, float hi) { unsigned r; asm volatile("v_cvt_pk_bf16_f32 %0, %1, %2" : "=v"(r) : "v"(lo), "v"(hi)); return r; }
template <class Epi, class Sched, bool ALIGN_EPI = false, bool SP2 = false>
__device__ __forceinline__ void gemm_phase(PG8_LAS unsigned char* lds, const Gemm g, const Sched& S, const Epi& E) {
    const int tid = opaque_tid(), wid = __builtin_amdgcn_readfirstlane(tid >> 6), lane = tid & 63, wr = wid >> 2, wc = wid & 3, fr = lane & 15, fq = lane >> 4;
    const int K = g.K, nt = K / BK;
    unsigned voffA[2], voffB[2];
#pragma unroll
    for (int i = 0; i < 2; ++i) { int R, C; stage_rc(tid * 16 + i * 8192, R, C); const int Rb = Epi::PERM ? ((R & ~31) + perm32(R & 31)) : R;
        voffA[i] = (unsigned)(R * K + C) * 2u; voffB[i] = (unsigned)(Rb * K + C) * 2u; }
    const size_t kstep = (size_t)(BK * 2);
    const size_t hstep = (size_t)HALF * K * 2;
    const size_t tstep = 2 * hstep;
    const unsigned ldsw = (unsigned)wid * 1024u;
    const int aoff = lds_byte(wr * 64 + fr, fq * 8), boff = lds_byte(wc * 32 + fr, fq * 8);
#define PG8_SA(b, h) (((b) * 2 + (h)) * HTB)
#define PG8_SB(b, h) ((4 + (b) * 2 + (h)) * HTB)
#define PG8_STAGE(bufoff, gbase, voff) do { _Pragma("unroll") for (int _i = 0; _i < 2; ++_i) \
        __builtin_amdgcn_global_load_lds((const unsigned*)((const char*)(gbase) + (voff)[_i]), (PG8_LAS unsigned*)(lds + (bufoff) + ldsw + _i * 8192), 16, 0, 0); } while (0)
#define PG8_LDA(dst, b, h) do { _Pragma("unroll") for (int m = 0; m < 4; ++m) _Pragma("unroll") for (int k = 0; k < 2; ++k) dst[m][k] = *(const PG8_LAS bf16x8*)(lds + PG8_SA(b, h) + aoff + m * 2048 + k * 1024); } while (0)
#define PG8_LDB(dst, b, h) do { _Pragma("unroll") for (int n = 0; n < 2; ++n) _Pragma("unroll") for (int k = 0; k < 2; ++k) dst[n][k] = *(const PG8_LAS bf16x8*)(lds + PG8_SB(b, h) + boff + n * 2048 + k * 1024); } while (0)
#define PG8_MMA(ai, bj, At, Bt) do { __builtin_amdgcn_s_setprio(1); _Pragma("unroll") for (int m = 0; m < 4; ++m) _Pragma("unroll") for (int n = 0; n < 2; ++n) _Pragma("unroll") for (int k = 0; k < 2; ++k) \
        acc[ai][bj][m][n] = __builtin_amdgcn_mfma_f32_16x16x32_bf16(Bt[n][k], At[m][k], acc[ai][bj][m][n], 0, 0, 0); __builtin_amdgcn_s_setprio(0); } while (0)
#define PG8_WAIT_V(n) asm volatile("s_waitcnt vmcnt(" #n ")" ::: "memory")
#define PG8_WAIT_L(n) asm volatile("s_waitcnt lgkmcnt(" #n ")" ::: "memory")
#define PG8_BAR __builtin_amdgcn_s_barrier()
#define PG8_SCHED __builtin_amdgcn_sched_barrier(0)
    Unit cur, nxt; int ui = 0;
    if (!S.next(0, cur)) return;
    f32x4 acc[2][2][4][2];
#pragma unroll
    for (int a = 0; a < 2; ++a)
#pragma unroll
        for (int b = 0; b < 2; ++b)
#pragma unroll
            for (int m = 0; m < 4; ++m)
#pragma unroll
                for (int n = 0; n < 2; ++n) acc[a][b][m][n] = (f32x4){0.f, 0.f, 0.f, 0.f};
    bf16x8 At[4][2], B0[2][2], B1[2][2];
    const char* cA = (const char*)g.A + (size_t)cur.pm * tstep; const char* cB = (const char*)g.Bt + (size_t)cur.pn * tstep;
    S.a_ready(cur);
    if constexpr (SP2) {
        PG8_STAGE(PG8_SB(0, 0), cB, voffB); PG8_STAGE(PG8_SB(0, 1), cB + hstep, voffB); PG8_STAGE(PG8_SA(0, 0), cA, voffA); PG8_STAGE(PG8_SA(0, 1), cA + hstep, voffA);
        if (wr == 1) PG8_BAR;
        PG8_WAIT_V(2); PG8_BAR;
        PG8_STAGE(PG8_SB(1, 0), cB + kstep, voffB); PG8_STAGE(PG8_SA(1, 0), cA + kstep, voffA); PG8_STAGE(PG8_SB(1, 1), cB + hstep + kstep, voffB);
        PG8_WAIT_V(6); PG8_BAR;
    } else {
        PG8_STAGE(PG8_SB(0, 0), cB, voffB); PG8_STAGE(PG8_SA(0, 0), cA, voffA); PG8_STAGE(PG8_SB(0, 1), cB + hstep, voffB); PG8_STAGE(PG8_SA(0, 1), cA + hstep, voffA);
        if (wr == 1) PG8_BAR;
        PG8_WAIT_V(4); PG8_BAR;
        PG8_STAGE(PG8_SB(1, 0), cB + kstep, voffB); PG8_STAGE(PG8_SA(1, 0), cA + kstep, voffA); PG8_STAGE(PG8_SB(1, 1), cB + hstep + kstep, voffB);
        PG8_WAIT_V(6); PG8_BAR;
    }
    for (;;) {
        const bool has_next = S.next(ui + 1, nxt);
        const char* nA = has_next ? (const char*)g.A + (size_t)nxt.pm * tstep : cA; const char* nB = has_next ? (const char*)g.Bt + (size_t)nxt.pn * tstep : cB;
        for (int t = 0; t < nt; t += 2) {
            const bool last = (t == nt - 2);
            const char* a1 = cA + (size_t)(t + 1) * kstep;
            const char* a2 = last ? nA : cA + (size_t)(t + 2) * kstep; const char* b2 = last ? nB : cB + (size_t)(t + 2) * kstep;
            const char* a3 = a2 + kstep; const char* b3 = b2 + kstep;
            if (last && has_next) S.a_ready(nxt);
            if constexpr (SP2) {
            PG8_LDB(B0, 0, 0); PG8_LDB(B1, 0, 1); PG8_SCHED; PG8_LDA(At, 0, 0); PG8_STAGE(PG8_SA(1, 1), a1 + hstep, voffA);
            PG8_WAIT_V(8); PG8_WAIT_L(0); PG8_BAR; PG8_MMA(0, 0, At, B0); PG8_MMA(0, 1, At, B1); PG8_BAR; PG8_SCHED;
            PG8_LDA(At, 0, 1); PG8_STAGE(PG8_SB(0, 0), b2, voffB); PG8_STAGE(PG8_SB(0, 1), b2 + hstep, voffB); PG8_STAGE(PG8_SA(0, 0), a2, voffA);
            PG8_WAIT_V(8); PG8_WAIT_L(0); PG8_BAR; PG8_MMA(1, 0, At, B0); PG8_MMA(1, 1, At, B1); PG8_BAR; PG8_SCHED;
            PG8_LDB(B0, 1, 0); PG8_LDB(B1, 1, 1); PG8_SCHED; PG8_LDA(At, 1, 0); PG8_STAGE(PG8_SA(0, 1), a2 + hstep, voffA);
            PG8_WAIT_V(8); PG8_WAIT_L(0); PG8_BAR; PG8_MMA(0, 0, At, B0); PG8_MMA(0, 1, At, B1); PG8_BAR; PG8_SCHED;
            PG8_LDA(At, 1, 1); PG8_STAGE(PG8_SB(1, 0), b3, voffB); PG8_STAGE(PG8_SB(1, 1), b3 + hstep, voffB); PG8_STAGE(PG8_SA(1, 0), a3, voffA);
            PG8_WAIT_V(8); PG8_WAIT_L(0); PG8_BAR; PG8_MMA(1, 0, At, B0); PG8_MMA(1, 1, At, B1); PG8_BAR; PG8_SCHED;
            } else {
            PG8_LDB(B0, 0, 0); PG8_SCHED; PG8_LDA(At, 0, 0); PG8_STAGE(PG8_SA(1, 1), a1 + hstep, voffA);
            PG8_WAIT_L(8); PG8_BAR; PG8_WAIT_L(0); PG8_MMA(0, 0, At, B0); PG8_BAR; PG8_SCHED;
            PG8_LDB(B1, 0, 1); PG8_STAGE(PG8_SB(0, 0), b2, voffB);
            PG8_BAR; PG8_WAIT_L(0); PG8_MMA(0, 1, At, B1); PG8_BAR;
            PG8_LDA(At, 0, 1); PG8_STAGE(PG8_SA(0, 0), a2, voffA);
            PG8_BAR; PG8_WAIT_L(0); PG8_MMA(1, 0, At, B0); PG8_BAR; PG8_SCHED;
            PG8_STAGE(PG8_SB(0, 1), b2 + hstep, voffB);
            PG8_WAIT_V(6); PG8_BAR; PG8_MMA(1, 1, At, B1); PG8_BAR;
            PG8_LDB(B0, 1, 0); PG8_SCHED; PG8_LDA(At, 1, 0); PG8_STAGE(PG8_SA(0, 1), a2 + hstep, voffA);
            PG8_WAIT_L(8); PG8_BAR; PG8_WAIT_L(0); PG8_MMA(0, 0, At, B0); PG8_BAR; PG8_SCHED;
            PG8_LDB(B1, 1, 1); PG8_STAGE(PG8_SB(1, 0), b3, voffB);
            PG8_BAR; PG8_WAIT_L(0); PG8_MMA(0, 1, At, B1); PG8_BAR;
            PG8_LDA(At, 1, 1); PG8_STAGE(PG8_SA(1, 0), a3, voffA);
            PG8_BAR; PG8_WAIT_L(0); PG8_MMA(1, 0, At, B0); PG8_BAR; PG8_SCHED;
            PG8_STAGE(PG8_SB(1, 1), b3 + hstep, voffB);
            PG8_WAIT_V(6); PG8_BAR; PG8_MMA(1, 1, At, B1); PG8_BAR;
            }
        }
        if constexpr (ALIGN_EPI) { if (wr == 0) PG8_BAR; }
        if constexpr (!Epi::AFTER_DRAIN) { E(acc, cur, wr, wc, fr, fq); S.done(cur); }
        if (!has_next) break;
#pragma unroll
        for (int a = 0; a < 2; ++a)
#pragma unroll
            for (int b = 0; b < 2; ++b)
#pragma unroll
                for (int m = 0; m < 4; ++m)
#pragma unroll
                    for (int n = 0; n < 2; ++n) acc[a][b][m][n] = (f32x4){0.f, 0.f, 0.f, 0.f};
        cur = nxt; cA = nA; cB = nB; ++ui;
        if constexpr (ALIGN_EPI) { if (wr == 1) PG8_BAR; }
    }
    PG8_WAIT_V(0);
    if constexpr (!ALIGN_EPI) { if (wr == 0) PG8_BAR; }
    PG8_BAR;
    if constexpr (Epi::AFTER_DRAIN) { E.fused(acc, cur, wr, wc, fr, fq, lds, wid, lane); S.done(cur); }
#undef PG8_SA
#undef PG8_SB
#undef PG8_STAGE
#undef PG8_LDA
#undef PG8_LDB
#undef PG8_MMA
#undef PG8_WAIT_V
#undef PG8_WAIT_L
#undef PG8_BAR
#undef PG8_SCHED
}
}

__device__ __forceinline__ unsigned pkbf(float lo, float hi) { return pg8::cvt_pk_bf16(lo, hi); }
__device__ __forceinline__ void st8bf(bf16_t* p, f32x4 a, f32x4 b) { u32x4 w; w.x = pkbf(a[0], a[1]); w.y = pkbf(a[2], a[3]); w.z = pkbf(b[0], b[1]); w.w = pkbf(b[2], b[3]); *(u32x4*)p = w; }
__device__ __forceinline__ f32x4 bflo(u32x4 g) { f32x4 o; o[0] = __uint_as_float(g.x << 16); o[1] = __uint_as_float(g.x & 0xffff0000u); o[2] = __uint_as_float(g.y << 16); o[3] = __uint_as_float(g.y & 0xffff0000u); return o; }
__device__ __forceinline__ f32x4 bfhi(u32x4 g) { f32x4 o; o[0] = __uint_as_float(g.z << 16); o[1] = __uint_as_float(g.z & 0xffff0000u); o[2] = __uint_as_float(g.w << 16); o[3] = __uint_as_float(g.w & 0xffff0000u); return o; }
__device__ __forceinline__ void rot8(f32x4& a, f32x4& b, f32x4 c, f32x4 s) {
    const f32x4 x = a, y = b;
    a[0] = x[0] * c[0] - x[1] * s[0]; a[1] = x[1] * c[0] + x[0] * s[0]; a[2] = x[2] * c[1] - x[3] * s[1]; a[3] = x[3] * c[1] + x[2] * s[1];
    b[0] = y[0] * c[2] - y[1] * s[2]; b[1] = y[1] * c[2] + y[0] * s[2]; b[2] = y[2] * c[3] - y[3] * s[3]; b[3] = y[3] * c[3] + y[2] * s[3];
}
__device__ __forceinline__ f32x4 sig4(f32x4 v) { f32x4 o; o[0] = 1.f / (1.f + __expf(-v[0])); o[1] = 1.f / (1.f + __expf(-v[1])); o[2] = 1.f / (1.f + __expf(-v[2])); o[3] = 1.f / (1.f + __expf(-v[3])); return o; }
__host__ __device__ __forceinline__ int src_in(int n) {
    if (n < 1024) return n;
    if (n < 4096) { const int seg = (n - 1024) >> 10, c = (n - 1024) & 1023, d = c & 127; int od = d; if (seg < 2 && d < 32) od = (d >> 1) + (d & 1) * 16; return 1088 + seg * 1024 + (c & ~127) + od; }
    if (n < 5120) { const int c = n - 4096, d = c & 63; const int od = d < 16 ? (d >> 1) + (d & 1) * 8 : d; return 4160 + (c & ~63) + od; }
    if (n < 7168) return 5264 + (n - 5120);
    if (n < 9216) return 7312 + (n - 7168);
    if (n < 9280) { const int d = n - 9216; return 1024 + (d >> 1) + (d & 1) * 32; }
    if (n < 9344) { const int d = n - 9280; const int od = d < 16 ? (d >> 1) + (d & 1) * 8 : d; return 5184 + od; }
    if (n < 9360) return 5248 + (n - 9344);
    return -1;
}
__host__ __device__ __forceinline__ int src_qa(int n) { const int h = n / 192, d = n - h * 192; if (d < 128) return n; const int dd = d - 128; return h * 192 + 128 + (dd >> 1) + (dd & 1) * 32; }

struct EpiIn {
    static constexpr bool PERM = true, AFTER_DRAIN = false;
    unsigned char* ws;
    __device__ __forceinline__ void operator()(const f32x4 (&acc)[2][2][4][2], const pg8::Unit& u, int wr, int wc, int fr, int fq) const {
        const int row0 = u.pm * 256 + wr * 64 + fr, cu = wc * 32 + 8 * fq, pn = u.pn;
        bf16_t* const CQ = (bf16_t*)(ws + WS_CQ); bf16_t* const QB = (bf16_t*)(ws + WS_QB); bf16_t* const QI = (bf16_t*)(ws + WS_QI); bf16_t* const GA = (bf16_t*)(ws + WS_GA);
        bf16_t* const KA = (bf16_t*)(ws + WS_KA); bf16_t* const KI = (bf16_t*)(ws + WS_KI); float* const WI = (float*)(ws + WS_WI); float* const part = (float*)(ws + WS_SSQ);
        const float* const cM = (const float*)(ws + WS_ROPE); const float* const sM = cM + T * 32; const float* const cD = cM + T * 64; const float* const sD = cM + T * 80; const float* const cI = cM + T * 96; const float* const sI = cM + T * 104;
#define EPI_ROWS(BODY) _Pragma("unroll") for (int ai = 0; ai < 2; ++ai) _Pragma("unroll") for (int m = 0; m < 4; ++m) { const int t = row0 + ai * 128 + m * 16; \
            _Pragma("unroll") for (int bj = 0; bj < 2; ++bj) { f32x4 a = acc[ai][bj][m][0], b = acc[ai][bj][m][1]; BODY } }
        if (pn < 4) {
            bf16_t* const dst = CQ + (size_t)(pn >> 1) * ((size_t)T * 512) + (pn & 1) * 256 + cu;
            EPI_ROWS(
                st8bf(dst + (size_t)t * 512 + bj * 128, a, b);
                float sq = ((a[0] * a[0] + a[1] * a[1]) + (a[2] * a[2] + a[3] * a[3])) + ((b[0] * b[0] + b[1] * b[1]) + (b[2] * b[2] + b[3] * b[3]));
                sq += __shfl_xor(sq, 16); sq += __shfl_xor(sq, 32);
                if (fq == 0) part[(size_t)t * 32 + pn * 8 + bj * 4 + wc] = sq; )
        } else if (pn < 16) {
            const int seg = (pn - 4) >> 2; const bool rot = seg < 2 && wc == 0;
            bf16_t* const dst = QB + (size_t)seg * ((size_t)T * 1024) + ((pn - 4) & 3) * 256 + cu;
            EPI_ROWS(
                if (rot) rot8(a, b, *(const f32x4*)(cD + (size_t)t * 16 + 4 * fq), *(const f32x4*)(sD + (size_t)t * 16 + 4 * fq));
                st8bf(dst + (size_t)t * 1024 + bj * 128, a, b); )
        } else if (pn < 20) {
            const bool rot = (wc & 1) == 0 && fq < 2;
            bf16_t* const dst = QI + (pn - 16) * 256 + cu;
            EPI_ROWS(
                if (rot) rot8(a, b, *(const f32x4*)(cI + (size_t)t * 8 + 4 * fq), *(const f32x4*)(sI + (size_t)t * 8 + 4 * fq));
                st8bf(dst + (size_t)t * 1024 + bj * 128, a, b); )
        } else if (pn < 36) {
            bf16_t* const dst = GA + (size_t)((pn - 20) >> 3) * ((size_t)T * D) + ((pn - 20) & 7) * 256 + cu;
            EPI_ROWS( st8bf(dst + (size_t)t * D + bj * 128, sig4(a), sig4(b)); )
        } else {
            EPI_ROWS(
                if (bj == 0) {
                    if (wc < 2) {
                        rot8(a, b, *(const f32x4*)(cM + (size_t)t * 32 + (cu >> 1)), *(const f32x4*)(sM + (size_t)t * 32 + (cu >> 1)));
                        _Pragma("unroll") for (int h = 0; h < 8; ++h) st8bf(KA + (size_t)t * 1536 + h * 192 + 128 + cu, a, b);
                    } else {
                        const int d = cu - 64;
                        if (d < 16) rot8(a, b, *(const f32x4*)(cI + (size_t)t * 8 + (d >> 1)), *(const f32x4*)(sI + (size_t)t * 8 + (d >> 1)));
                        st8bf(KI + (size_t)t * 64 + d, a, b);
                    }
                } else if (cu < 16) {
                    *(f32x4*)(WI + (size_t)t * 16 + cu) = a * 0.03125f; *(f32x4*)(WI + (size_t)t * 16 + cu + 4) = b * 0.03125f;
                } )
        }
#undef EPI_ROWS
    }
};
__device__ __forceinline__ float rms_from_part(const float* pp) {
    const f32x4 p0 = *(const f32x4*)pp, p1 = *(const f32x4*)(pp + 4), p2 = *(const f32x4*)(pp + 8), p3 = *(const f32x4*)(pp + 12);
    const float s = (((p0[0] + p0[1]) + (p0[2] + p0[3])) + ((p1[0] + p1[1]) + (p1[2] + p1[3]))) + (((p2[0] + p2[1]) + (p2[2] + p2[3])) + ((p3[0] + p3[1]) + (p3[2] + p3[3])));
    return rsqrtf(s * (1.f / 512.f) + 1e-6f);
}
struct EpiQA {
    static constexpr bool PERM = true, AFTER_DRAIN = false;
    unsigned char* ws;
    __device__ __forceinline__ void operator()(const f32x4 (&acc)[2][2][4][2], const pg8::Unit& u, int wr, int wc, int fr, int fq) const {
        const int row0 = u.pm * 256 + wr * 64 + fr, cu = wc * 32 + 8 * fq;
        bf16_t* const QA = (bf16_t*)(ws + WS_QA); const float* const part = (const float*)(ws + WS_SSQ); const float* const cM = (const float*)(ws + WS_ROPE); const float* const sM = cM + T * 32;
#pragma unroll
        for (int ai = 0; ai < 2; ++ai)
#pragma unroll
            for (int m = 0; m < 4; ++m) {
                const int t = row0 + ai * 128 + m * 16;
                const float r = rms_from_part(part + (size_t)t * 32);
#pragma unroll
                for (int bj = 0; bj < 2; ++bj) {
                    const int n = u.pn * 256 + bj * 128 + cu, h = n / 192, d = n - h * 192;
                    f32x4 a = acc[ai][bj][m][0] * r, b = acc[ai][bj][m][1] * r;
                    if (d >= 128) rot8(a, b, *(const f32x4*)(cM + (size_t)t * 32 + ((d - 128) >> 1)), *(const f32x4*)(sM + (size_t)t * 32 + ((d - 128) >> 1)));
                    st8bf(QA + (size_t)t * 1536 + n, a, b);
                }
            }
    }
};
struct EpiKV {
    static constexpr bool PERM = true, AFTER_DRAIN = false;
    unsigned char* ws;
    __device__ __forceinline__ void operator()(const f32x4 (&acc)[2][2][4][2], const pg8::Unit& u, int wr, int wc, int fr, int fq) const {
        const int row0 = u.pm * 256 + wr * 64 + fr, cu = wc * 32 + 8 * fq;
        bf16_t* const KA = (bf16_t*)(ws + WS_KA); bf16_t* const VA = (bf16_t*)(ws + WS_VA); const float* const part = (const float*)(ws + WS_SSQ);
#pragma unroll
        for (int ai = 0; ai < 2; ++ai)
#pragma unroll
            for (int m = 0; m < 4; ++m) {
                const int t = row0 + ai * 128 + m * 16;
                const float r = rms_from_part(part + (size_t)t * 32 + 16);
                st8bf(KA + (size_t)t * 1536 + u.pn * 192 + cu, acc[ai][0][m][0] * r, acc[ai][0][m][1] * r);
                st8bf(VA + (size_t)t * 1024 + u.pn * 128 + cu, acc[ai][1][m][0] * r, acc[ai][1][m][1] * r);
            }
    }
};
struct EpiYA {
    static constexpr bool PERM = true, AFTER_DRAIN = false;
    unsigned char* ws;
    __device__ __forceinline__ void operator()(const f32x4 (&acc)[2][2][4][2], const pg8::Unit& u, int wr, int wc, int fr, int fq) const {
        const int row0 = u.pm * 256 + wr * 64 + fr, col0 = u.pn * 256 + wc * 32 + 8 * fq;
        float* const YT = (float*)(ws + WS_YT); const bf16_t* const GA = (const bf16_t*)(ws + WS_GA);
#pragma unroll
        for (int ai = 0; ai < 2; ++ai)
#pragma unroll
            for (int m = 0; m < 4; ++m)
#pragma unroll
                for (int bj = 0; bj < 2; ++bj) {
                    const size_t o = (size_t)(row0 + ai * 128 + m * 16) * D + col0 + bj * 128;
                    const u32x4 g = *(const u32x4*)(GA + o);
                    *(f32x4*)(YT + o) = acc[ai][bj][m][0] * bflo(g); *(f32x4*)(YT + o + 4) = acc[ai][bj][m][1] * bfhi(g);
                }
    }
};
struct EpiYB {
    static constexpr bool PERM = true, AFTER_DRAIN = false;
    unsigned char* ws;
    __device__ __forceinline__ void operator()(const f32x4 (&acc)[2][2][4][2], const pg8::Unit& u, int wr, int wc, int fr, int fq) const {
        const int row0 = u.pm * 256 + wr * 64 + fr, col0 = u.pn * 256 + wc * 32 + 8 * fq;
        const float* const YT = (const float*)(ws + WS_YT); const bf16_t* const GB = (const bf16_t*)(ws + WS_GB); bf16_t* const Y = (bf16_t*)(ws + WS_Y);
#pragma unroll
        for (int ai = 0; ai < 2; ++ai)
#pragma unroll
            for (int m = 0; m < 4; ++m)
#pragma unroll
                for (int bj = 0; bj < 2; ++bj) {
                    const size_t o = (size_t)(row0 + ai * 128 + m * 16) * D + col0 + bj * 128;
                    const u32x4 g = *(const u32x4*)(GB + o);
                    const f32x4 y0 = *(const f32x4*)(YT + o), y1 = *(const f32x4*)(YT + o + 4);
                    st8bf(Y + o, y0 + acc[ai][bj][m][0] * bflo(g), y1 + acc[ai][bj][m][1] * bfhi(g));
                }
    }
};
struct EpiOut {
    static constexpr bool PERM = true, AFTER_DRAIN = false;
    const float* hin; float* V1;
    __device__ __forceinline__ void operator()(const f32x4 (&acc)[2][2][4][2], const pg8::Unit& u, int wr, int wc, int fr, int fq) const {
        const int row0 = u.pm * 256 + wr * 64 + fr, col0 = u.pn * 256 + wc * 32 + 8 * fq;
#pragma unroll
        for (int ai = 0; ai < 2; ++ai)
#pragma unroll
            for (int m = 0; m < 4; ++m)
#pragma unroll
                for (int bj = 0; bj < 2; ++bj) {
                    const size_t o = (size_t)(row0 + ai * 128 + m * 16) * D + col0 + bj * 128;
                    const f32x4 h0 = *(const f32x4*)(hin + o), h1 = *(const f32x4*)(hin + o + 4);
                    *(f32x4*)(V1 + o) = h0 * ALPHA + acc[ai][bj][m][0]; *(f32x4*)(V1 + o + 4) = h1 * ALPHA + acc[ai][bj][m][1];
                }
    }
};

#define LDS_WAIT() asm volatile("s_waitcnt lgkmcnt(0)" ::: "memory")
template <int MAP>
__device__ __forceinline__ void transpose_item(const float* W, int ldw, int K, int N, const float* kscale, bf16_t* WT, LAS float* scr, int item, int lane) {
    const int nblk = N / 32, kb = item / nblk, nb = item % nblk, k0 = 64 * kb, n0 = 32 * nb;
    const int n = n0 + (lane & 31);
    const int sc = MAP == 0 ? n : (MAP == 1 ? src_in(n) : src_qa(n));
#pragma unroll 8
    for (int i = 0; i < 32; ++i) { const int kk = 2 * i + (lane >> 5);
        float v = sc >= 0 ? W[(size_t)(k0 + kk) * ldw + sc] : 0.f; if (kscale) v *= kscale[k0 + kk];
        scr[kk * 33 + (lane & 31)] = v; }
    LDS_WAIT(); asm volatile("" ::: "memory");
    const int c = lane & 7;
#pragma unroll
    for (int j = 0; j < 4; ++j) { const int nn = (lane >> 3) + 8 * j; const LAS float* sp = scr + (8 * c) * 33 + nn;
        u32x4 o; o.x = pkbf(sp[0 * 33], sp[1 * 33]); o.y = pkbf(sp[2 * 33], sp[3 * 33]); o.z = pkbf(sp[4 * 33], sp[5 * 33]); o.w = pkbf(sp[6 * 33], sp[7 * 33]);
        *(u32x4*)(WT + (size_t)(n0 + nn) * K + k0 + 8 * c) = o; }
    LDS_WAIT(); asm volatile("" ::: "memory");
}
__device__ __forceinline__ void p_prologue(LAS unsigned char* ldsb, const Params& p) {
    float* rope = (float*)(p.ws + WS_ROPE);
    float *cM = rope, *sM = rope + T * 32, *cD = rope + T * 64, *sD = rope + T * 80, *cI = rope + T * 96, *sI = rope + T * 104;
    const int gtid = blockIdx.x * NTHREADS + threadIdx.x, gstride = gridDim.x * NTHREADS;
    for (int idx = gtid; idx < T * 56; idx += gstride) {
        const int t = idx / 56, j = idx - t * 56;
        int rot, i; float *ct, *st; int w;
        if (j < 32) { rot = 64; i = j; ct = cM; st = sM; w = 32; } else if (j < 48) { rot = 32; i = j - 32; ct = cD; st = sD; w = 16; } else { rot = 16; i = j - 48; ct = cI; st = sI; w = 8; }
        const float inv = exp2f(-((float)(2 * i) / (float)rot) * 18.931568569324174f);
        const float ang = (float)p.pos[t] * inv;
        double rev = (double)ang * 0.15915494309189535; rev -= rint(rev);
        const float r = (float)(rev * 6.283185307179586);
        ct[t * w + i] = __cosf(r); st[t * w + i] = __sinf(r);
    }
    bf16_t* XB = (bf16_t*)(p.ws + WS_XB);
    for (size_t i = (size_t)gtid * 4; i < (size_t)T * D; i += (size_t)gstride * 4) st4bf(XB + i, *(const f32x4*)(p.x + i));
    const int wave = threadIdx.x >> 6, lane = threadIdx.x & 63;
    LAS float* scr = (LAS float*)(ldsb + wave * 16384);
    const int gw = blockIdx.x * 8 + wave, NGW = gridDim.x * 8;
    constexpr int I_IN = (D / 64) * (INP / 32), I_QB = (512 / 64) * (1536 / 32), I_KV = (512 / 64) * (2048 / 32), I_O = (1024 / 64) * (D / 32), I_OUT = (D / 64) * (D / 32);
    constexpr int I_LAYER = I_IN + I_QB + I_KV + 2 * I_O + I_OUT;
    for (int it = gw; it < DEPTH * I_LAYER; it += NGW) {
        const int l = it / I_LAYER; int r = it - l * I_LAYER;
        if (r < I_IN) { transpose_item<1>(p.w_in + (size_t)l * D * INW, INW, D, INP, nullptr, (bf16_t*)(p.ws + WS_WIN_T) + (size_t)l * INP * D, scr, r, lane); continue; } r -= I_IN;
        if (r < I_QB) { transpose_item<2>(p.w_qb + (size_t)l * 512 * 1536, 1536, 512, 1536, p.g_q + l * 512, (bf16_t*)(p.ws + WS_WQB_T) + (size_t)l * 1536 * 512, scr, r, lane); continue; } r -= I_QB;
        if (r < I_KV) { transpose_item<0>(p.w_kvb + (size_t)l * 512 * 2048, 2048, 512, 2048, p.g_kv + l * 512, (bf16_t*)(p.ws + WS_WKVB_T) + (size_t)l * 2048 * 512, scr, r, lane); continue; } r -= I_KV;
        if (r < I_O) { transpose_item<0>(p.w_oa + (size_t)l * 1024 * D, D, 1024, D, nullptr, (bf16_t*)(p.ws + WS_WOA_T) + (size_t)l * D * 1024, scr, r, lane); continue; } r -= I_O;
        if (r < I_O) { transpose_item<0>(p.w_ob + (size_t)l * 1024 * D, D, 1024, D, nullptr, (bf16_t*)(p.ws + WS_WOB_T) + (size_t)l * D * 1024, scr, r, lane); continue; } r -= I_O;
        transpose_item<0>(p.w_out + (size_t)l * D * D, D, D, D, nullptr, (bf16_t*)(p.ws + WS_WOUT_T) + (size_t)l * D * D, scr, r, lane);
    }
    __syncthreads();
}

__device__ __forceinline__ unsigned f2key(float f) { const unsigned u = __float_as_uint(f); return (u & 0x80000000u) ? ~u : (u | 0x80000000u); }
__device__ __forceinline__ void p_index(float* lds, const Params& p) {
    const bf16_t* QI = (const bf16_t*)(p.ws + WS_QI); const bf16_t* KI = (const bf16_t*)(p.ws + WS_KI); const float* WI = (const float*)(p.ws + WS_WI);
    unsigned* MASK = (unsigned*)(p.ws + WS_MASK);
    float* qs = lds; float* wsc = lds + 1024; float* sc = lds + 1040; int* red = (int*)(lds + 1040 + 4096);
    const int tid = opaque_tid(), lane = tid & 63, wv = tid >> 6;
    for (int t = blockIdx.x; t < T; t += gridDim.x) {
        const int b = t >> 12, ti = t & 4095, nk = ti + 1;
        __syncthreads();
        for (int i = tid; i < 1024; i += NTHREADS) qs[i] = bf2f(QI[(size_t)t * 1024 + i]);
        if (tid < 16) wsc[tid] = WI[(size_t)t * 16 + tid];
        __syncthreads();
        for (int s = tid; s < nk; s += NTHREADS) {
            const bf16_t* kr = KI + (size_t)(b * S + s) * 64;
            float score = 0.f;
#pragma unroll 1
            for (int h = 0; h < 16; ++h) {
                asm volatile("" ::: "memory");
                float dot = 0.f;
#pragma unroll
                for (int c = 0; c < 8; ++c) {
                    const u32x4 raw = *(const u32x4*)(kr + c * 8);
                    const f32x4 q0 = *(const f32x4*)(qs + h * 64 + c * 8), q1 = *(const f32x4*)(qs + h * 64 + c * 8 + 4);
                    dot = fmaf(q0[0], __uint_as_float(raw.x << 16), dot); dot = fmaf(q0[1], __uint_as_float(raw.x & 0xffff0000u), dot);
                    dot = fmaf(q0[2], __uint_as_float(raw.y << 16), dot); dot = fmaf(q0[3], __uint_as_float(raw.y & 0xffff0000u), dot);
                    dot = fmaf(q1[0], __uint_as_float(raw.z << 16), dot); dot = fmaf(q1[1], __uint_as_float(raw.z & 0xffff0000u), dot);
                    dot = fmaf(q1[2], __uint_as_float(raw.w << 16), dot); dot = fmaf(q1[3], __uint_as_float(raw.w & 0xffff0000u), dot);
                }
                score = fmaf(wsc[h], fmaxf(dot, 0.f), score);
            }
            sc[s] = score;
        }
        __syncthreads();
        unsigned k0 = 0u, k1 = 0u, k2 = 0u, k3 = 0u, k4 = 0u, k5 = 0u, k6 = 0u, k7 = 0u;
        if (tid < nk) k0 = f2key(sc[tid]);
        if (tid + 512 < nk) k1 = f2key(sc[tid + 512]);
        if (tid + 1024 < nk) k2 = f2key(sc[tid + 1024]);
        if (tid + 1536 < nk) k3 = f2key(sc[tid + 1536]);
        if (tid + 2048 < nk) k4 = f2key(sc[tid + 2048]);
        if (tid + 2560 < nk) k5 = f2key(sc[tid + 2560]);
        if (tid + 3072 < nk) k6 = f2key(sc[tid + 3072]);
        if (tid + 3584 < nk) k7 = f2key(sc[tid + 3584]);
        unsigned res = 0u;
        if (nk > 256) {
#pragma unroll 1
            for (int bit = 31; bit >= 0; --bit) {
                const unsigned cand = res | (1u << bit);
                const int c = (k0 >= cand) + (k1 >= cand) + (k2 >= cand) + (k3 >= cand) + (k4 >= cand) + (k5 >= cand) + (k6 >= cand) + (k7 >= cand);
                if (block_sum_int(c, red) >= 256) res = cand;
            }
        }
        unsigned* mw = MASK + (size_t)t * 128 + 2 * wv;
#define MASK_OUT(j, kj) do { const unsigned long long bal = __ballot((tid + 512 * (j) < nk) && ((kj) >= res)); if (lane == 0) { mw[16 * (j)] = (unsigned)bal; mw[16 * (j) + 1] = (unsigned)(bal >> 32); } } while (0)
        MASK_OUT(0, k0); MASK_OUT(1, k1); MASK_OUT(2, k2); MASK_OUT(3, k3); MASK_OUT(4, k4); MASK_OUT(5, k5); MASK_OUT(6, k6); MASK_OUT(7, k7);
#undef MASK_OUT
    }
    __syncthreads();
}

typedef short bf16x8 __attribute__((ext_vector_type(8)));
typedef short s16x4 __attribute__((ext_vector_type(4)));
typedef float f32x16 __attribute__((ext_vector_type(16)));
__device__ __forceinline__ void p_score(LAS unsigned char* ldsb, unsigned char* ws) {
    const bf16_t* QI = (const bf16_t*)(ws + WS_QI); const bf16_t* KI = (const bf16_t*)(ws + WS_KI); const float* WI = (const float*)(ws + WS_WI);
    unsigned* SC = (unsigned*)(ws + WS_SCORE);
    const int tid = opaque_tid(), lane = tid & 63, wv = __builtin_amdgcn_readfirstlane(tid >> 6), r32 = lane & 31, hi = lane >> 5;
    const int ksw = ((r32 >> 1) & 7) ^ hi;
    const unsigned krow = (unsigned)(size_t)ldsb + (unsigned)r32 * 128u;
    for (int item = blockIdx.x; item < 544; item += gridDim.x) {
        const int b = item / 272; int r = item - b * 272, qb = 0;
        while (r >= 2 * qb + 2) { r -= 2 * qb + 2; ++qb; }
        const int kc = r, q0 = qb * 256 + wv * 32;
        __builtin_amdgcn_s_barrier();
#pragma unroll
        for (int i = 0; i < 2; ++i) { const int g = i * 512 + tid, row = g >> 3, ch = (g & 7) ^ ((row >> 1) & 7);
            __builtin_amdgcn_global_load_lds((const unsigned*)(KI + (size_t)(b * S + kc * 128 + row) * 64 + ch * 8), (LAS unsigned*)(ldsb + (i * 512 + wv * 64) * 16), 16, 0, 0); }
        asm volatile("s_waitcnt vmcnt(0)" ::: "memory");
        __builtin_amdgcn_s_barrier();
        if (kc * 128 <= q0 + 31) {
            const size_t t = (size_t)b * S + q0 + r32;
            bf16x8 ka[4][4];
#pragma unroll
            for (int kb = 0; kb < 4; ++kb)
#pragma unroll
                for (int d0 = 0; d0 < 4; ++d0) ka[kb][d0] = *(const LAS bf16x8*)(size_t)(krow + kb * 4096 + ((unsigned)((2 * d0) ^ ksw) << 4));
            f32x16 acc[4];
#pragma unroll
            for (int kb = 0; kb < 4; ++kb)
#pragma unroll
                for (int rr = 0; rr < 16; ++rr) acc[kb][rr] = 0.f;
            const bf16_t* qrow = QI + t * 1024 + 8 * hi; const float* wrow = WI + t * 16;
            bf16x8 qf[4]; float wh = wrow[0];
#pragma unroll
            for (int d0 = 0; d0 < 4; ++d0) qf[d0] = *(const bf16x8*)(qrow + 16 * d0);
#pragma unroll 1
            for (int h = 0; h < 16; ++h) {
                const int hn = (h + 1) & 15;
                bf16x8 qn[4]; const float wn = wrow[hn];
#pragma unroll
                for (int d0 = 0; d0 < 4; ++d0) qn[d0] = *(const bf16x8*)(qrow + hn * 64 + 16 * d0);
#pragma unroll
                for (int kb = 0; kb < 4; ++kb) {
                    f32x16 pz;
#pragma unroll
                    for (int rr = 0; rr < 16; ++rr) pz[rr] = 0.f;
#pragma unroll
                    for (int d0 = 0; d0 < 4; ++d0) pz = __builtin_amdgcn_mfma_f32_32x32x16_bf16(ka[kb][d0], qf[d0], pz, 0, 0, 0);
#pragma unroll
                    for (int rr = 0; rr < 16; ++rr) acc[kb][rr] = fmaf(wh, fmaxf(pz[rr], 0.f), acc[kb][rr]);
                }
#pragma unroll
                for (int d0 = 0; d0 < 4; ++d0) qf[d0] = qn[d0];
                wh = wn;
            }
            const int dq = q0 + r32 - kc * 128 - 4 * hi;
            unsigned* srow = SC + t * 4096 + kc * 128 + 4 * hi;
#pragma unroll
            for (int kb = 0; kb < 4; ++kb)
#pragma unroll
                for (int rq = 0; rq < 4; ++rq) { u32x4 o; const int c0 = 32 * kb + 8 * rq;
                    o.x = (c0 <= dq) ? f2key(acc[kb][4 * rq]) : 0u; o.y = (c0 + 1 <= dq) ? f2key(acc[kb][4 * rq + 1]) : 0u;
                    o.z = (c0 + 2 <= dq) ? f2key(acc[kb][4 * rq + 2]) : 0u; o.w = (c0 + 3 <= dq) ? f2key(acc[kb][4 * rq + 3]) : 0u;
                    *(u32x4*)(srow + c0) = o; }
        }
    }
    __builtin_amdgcn_s_barrier();
}
__device__ __forceinline__ void p_select(unsigned char* ws) {
    const unsigned* SC = (const unsigned*)(ws + WS_SCORE); unsigned* MASK = (unsigned*)(ws + WS_MASK);
    const int tid = opaque_tid(), lane = tid & 63, wv = tid >> 6;
    for (int t = blockIdx.x * 8 + wv; t < T; t += gridDim.x * 8) {
        const int ti = t & 4095, nq = (ti >> 8) + 1;
        const unsigned* row = SC + (size_t)t * 4096 + 4 * lane;
        u32x4 k[16];
#pragma unroll
        for (int j = 0; j < 16; ++j) { k[j] = (u32x4){0u, 0u, 0u, 0u};
            if (j < nq) { k[j] = *(const u32x4*)(row + 256 * j);
                const int p0 = 256 * j + 4 * lane; if (p0 > ti) k[j].x = 0u; if (p0 + 1 > ti) k[j].y = 0u; if (p0 + 2 > ti) k[j].z = 0u; if (p0 + 3 > ti) k[j].w = 0u; } }
        unsigned res = 1u;
        if (ti >= 256) {
            res = 0u;
#pragma unroll 1
            for (int bit = 31; bit >= 0; --bit) {
                const unsigned cand = res | (1u << bit);
                int c = 0;
#pragma unroll
                for (int j = 0; j < 16; ++j) c += (int)(k[j].x >= cand) + (int)(k[j].y >= cand) + (int)(k[j].z >= cand) + (int)(k[j].w >= cand);
#pragma unroll
                for (int o = 32; o >= 1; o >>= 1) c += __shfl_xor(c, o);
                if (c >= 256) res = cand;
            }
        }
        unsigned* mrow = MASK + (size_t)t * 128 + (lane >> 3);
#pragma unroll
        for (int j = 0; j < 16; ++j) {
            unsigned nib = (unsigned)(k[j].x >= res) | ((unsigned)(k[j].y >= res) << 1) | ((unsigned)(k[j].z >= res) << 2) | ((unsigned)(k[j].w >= res) << 3);
            nib <<= 4 * (lane & 7);
            nib |= __shfl_xor(nib, 1); nib |= __shfl_xor(nib, 2); nib |= __shfl_xor(nib, 4);
            if ((lane & 7) == 0) mrow[8 * j] = nib;
        }
    }
}

template <int DQK, bool MASKED>
__device__ __forceinline__ void attn_unit(LAS unsigned char* ldsb, const bf16_t* Qg, int ldq, const bf16_t* Kg, int ldk, const bf16_t* Vg, int ldv, const unsigned* maskg, bf16_t* Og, int ldo, int qb, float sl2) {
    constexpr int CPR = DQK / 8, KBYTES = 64 * DQK * 2, VBYTES = 64 * 128 * 2, NKI = CPR * 64 / 512, ND = DQK / 16;
    constexpr int VOFF = 2 * KBYTES;
    const int tid = opaque_tid(), lane = tid & 63, wv = __builtin_amdgcn_readfirstlane(tid >> 6), r32 = lane & 31, hi = lane >> 5;
    const int NT = 4 * qb + 4, q0 = qb * 256 + wv * 32;
    const float NEG = -__builtin_inff();
    bf16x8 qr[ND];
#pragma unroll
    for (int d0 = 0; d0 < ND; ++d0) qr[d0] = *(const bf16x8*)(Qg + (size_t)(q0 + r32) * ldq + 16 * d0 + 8 * hi);
    const bf16_t* ksrc[NKI]; const bf16_t* vsrc[2];
#pragma unroll
    for (int i = 0; i < NKI; ++i) { const int g = i * 512 + tid, row = g / CPR, cp = g - row * CPR; const int ch = cp ^ (DQK == 128 ? (row & 15) : ((row >> 1) & 7)); ksrc[i] = Kg + (size_t)row * ldk + ch * 8; }
#pragma unroll
    for (int i = 0; i < 2; ++i) { const int g = i * 512 + tid, row = g >> 4, c16 = g & 15; const int blk = (c16 >> 2) ^ (row & 3); vsrc[i] = Vg + (size_t)row * ldv + (blk * 4 + (c16 & 3)) * 8; }
#define AT_STAGE(t_, buf_) do { \
        _Pragma("unroll") for (int i_ = 0; i_ < NKI; ++i_) __builtin_amdgcn_global_load_lds((const unsigned*)(ksrc[i_] + (size_t)(t_) * 64 * ldk), (LAS unsigned*)(ldsb + (buf_) * KBYTES + (i_ * 512 + wv * 64) * 16), 16, 0, 0); \
        _Pragma("unroll") for (int i_ = 0; i_ < 2; ++i_) __builtin_amdgcn_global_load_lds((const unsigned*)(vsrc[i_] + (size_t)(t_) * 64 * ldv), (LAS unsigned*)(ldsb + VOFF + (buf_) * VBYTES + (i_ * 512 + wv * 64) * 16), 16, 0, 0); } while (0)
    const int ksw = (DQK == 128 ? (r32 & 15) : ((r32 >> 1) & 7)) ^ hi;
    const unsigned krow = (unsigned)(size_t)ldsb + (unsigned)r32 * (DQK * 2);
    const int vq = (lane >> 2) & 3, vp = lane & 3, vg = lane >> 4;
    const unsigned vrow = (unsigned)(size_t)ldsb + VOFF + (unsigned)(4 * (vg >> 1) + vq) * 256 + (vg & 1) * 32 + vp * 8;
    float m_run = -1e30f, l_run = 0.f;
    f32x16 oT[4];
#pragma unroll
    for (int d0 = 0; d0 < 4; ++d0)
#pragma unroll
        for (int r = 0; r < 16; ++r) oT[d0][r] = 0.f;
    u32x2 mw_cur = {0u, 0u}, mw_nxt = {0u, 0u};
    const unsigned* mrow = MASKED ? maskg + (size_t)(q0 + r32) * 128 : nullptr;
    if (MASKED) mw_cur = *(const u32x2*)mrow;
    AT_STAGE(0, 0);
    asm volatile("s_waitcnt vmcnt(0)" ::: "memory");
    __builtin_amdgcn_s_barrier();
#define TRRD(dst, addr, off) asm volatile("ds_read_b64_tr_b16 %0, %1 offset:%2" : "=&v"(dst) : "v"(addr), "i"(off) : "memory")
#define AT_STEP(t_, buf_) do { \
        const int t = (t_); \
        if (t + 1 < NT) { if (MASKED) mw_nxt = *(const u32x2*)(mrow + 2 * (t + 1)); AT_STAGE(t + 1, (buf_) ^ 1); } \
        if (t * 64 <= q0 + 31) {                                    \
            int kx = ksw; asm volatile("" : "+v"(kx)); \
            f32x16 p0, p1; \
            _Pragma("unroll") for (int r = 0; r < 16; ++r) { p0[r] = 0.f; p1[r] = 0.f; } \
            _Pragma("unroll") for (int d0 = 0; d0 < ND; ++d0) { \
                const unsigned ka = krow + (buf_) * KBYTES + ((unsigned)((2 * d0) ^ kx) << 4); \
                const bf16x8 a0 = *(const LAS bf16x8*)(size_t)ka; const bf16x8 a1 = *(const LAS bf16x8*)(size_t)(ka + 32 * DQK * 2); \
                p0 = __builtin_amdgcn_mfma_f32_32x32x16_bf16(a0, qr[d0], p0, 0, 0, 0); \
                p1 = __builtin_amdgcn_mfma_f32_32x32x16_bf16(a1, qr[d0], p1, 0, 0, 0); } \
            if (MASKED) { \
                _Pragma("unroll") for (int r = 0; r < 16; ++r) { const int c = (r & 3) + 8 * (r >> 2) + 4 * hi; \
                    if (!((mw_cur.x >> c) & 1u)) p0[r] = NEG; if (!((mw_cur.y >> c) & 1u)) p1[r] = NEG; } \
            } else if (t * 64 + 63 > q0) {                          \
                const int dq = q0 + r32 - t * 64 - 4 * hi; \
                _Pragma("unroll") for (int r = 0; r < 16; ++r) { const int c = (r & 3) + 8 * (r >> 2); if (c > dq) p0[r] = NEG; if (c + 32 > dq) p1[r] = NEG; } \
            } \
            float mx = p0[0]; \
            _Pragma("unroll") for (int r = 1; r < 16; ++r) mx = fmaxf(mx, p0[r]); \
            _Pragma("unroll") for (int r = 0; r < 16; ++r) mx = fmaxf(mx, p1[r]); \
            { auto rr = __builtin_amdgcn_permlane32_swap(__float_as_uint(mx), __float_as_uint(mx), false, false); mx = fmaxf(__uint_as_float(rr[0]), __uint_as_float(rr[1])); } \
            const float mnew = fmaxf(m_run, mx); \
            const float alpha = __builtin_amdgcn_exp2f((m_run - mnew) * sl2); \
            m_run = mnew; const float mb = -mnew * sl2; \
            float ps = 0.f; \
            _Pragma("unroll") for (int r = 0; r < 16; ++r) { p0[r] = __builtin_amdgcn_exp2f(fmaf(p0[r], sl2, mb)); ps += p0[r]; } \
            _Pragma("unroll") for (int r = 0; r < 16; ++r) { p1[r] = __builtin_amdgcn_exp2f(fmaf(p1[r], sl2, mb)); ps += p1[r]; } \
            l_run = l_run * alpha + ps; \
            if (__any(alpha != 1.f)) { \
                _Pragma("unroll") for (int d0 = 0; d0 < 4; ++d0) _Pragma("unroll") for (int r = 0; r < 16; ++r) oT[d0][r] *= alpha; } \
            bf16x8 pb[4];                                            \
            { u32x4 w; \
              w.x = pkbf(p0[0], p0[1]); w.y = pkbf(p0[2], p0[3]); w.z = pkbf(p0[4], p0[5]); w.w = pkbf(p0[6], p0[7]); pb[0] = *reinterpret_cast<bf16x8*>(&w); \
              w.x = pkbf(p0[8], p0[9]); w.y = pkbf(p0[10], p0[11]); w.z = pkbf(p0[12], p0[13]); w.w = pkbf(p0[14], p0[15]); pb[1] = *reinterpret_cast<bf16x8*>(&w); \
              w.x = pkbf(p1[0], p1[1]); w.y = pkbf(p1[2], p1[3]); w.z = pkbf(p1[4], p1[5]); w.w = pkbf(p1[6], p1[7]); pb[2] = *reinterpret_cast<bf16x8*>(&w); \
              w.x = pkbf(p1[8], p1[9]); w.y = pkbf(p1[10], p1[11]); w.z = pkbf(p1[12], p1[13]); w.w = pkbf(p1[14], p1[15]); pb[3] = *reinterpret_cast<bf16x8*>(&w); } \
            int vx = vq; asm volatile("" : "+v"(vx)); \
            _Pragma("unroll") for (int d0 = 0; d0 < 4; ++d0) { \
                const unsigned va = vrow + (buf_) * VBYTES + ((unsigned)(d0 ^ vx) << 6); \
                s16x4 l0, h0, l1, h1, l2, h2, l3, h3; \
                TRRD(l0, va, 0); TRRD(h0, va, 2048); TRRD(l1, va, 4096); TRRD(h1, va, 6144); TRRD(l2, va, 8192); TRRD(h2, va, 10240); TRRD(l3, va, 12288); TRRD(h3, va, 14336); \
                asm volatile("s_waitcnt lgkmcnt(0)" ::: "memory"); __builtin_amdgcn_sched_barrier(0); \
                oT[d0] = __builtin_amdgcn_mfma_f32_32x32x16_bf16((bf16x8){l0[0], l0[1], l0[2], l0[3], h0[0], h0[1], h0[2], h0[3]}, pb[0], oT[d0], 0, 0, 0); \
                oT[d0] = __builtin_amdgcn_mfma_f32_32x32x16_bf16((bf16x8){l1[0], l1[1], l1[2], l1[3], h1[0], h1[1], h1[2], h1[3]}, pb[1], oT[d0], 0, 0, 0); \
                oT[d0] = __builtin_amdgcn_mfma_f32_32x32x16_bf16((bf16x8){l2[0], l2[1], l2[2], l2[3], h2[0], h2[1], h2[2], h2[3]}, pb[2], oT[d0], 0, 0, 0); \
                oT[d0] = __builtin_amdgcn_mfma_f32_32x32x16_bf16((bf16x8){l3[0], l3[1], l3[2], l3[3], h3[0], h3[1], h3[2], h3[3]}, pb[3], oT[d0], 0, 0, 0); } \
        } \
        if (MASKED) mw_cur = mw_nxt; \
        asm volatile("s_waitcnt vmcnt(0)" ::: "memory"); \
        asm volatile("s_waitcnt lgkmcnt(0)" ::: "memory"); \
        __builtin_amdgcn_s_barrier(); } while (0)
    for (int tt = 0; tt < NT; tt += 2) { AT_STEP(tt, 0); AT_STEP(tt + 1, 1); }
#undef AT_STEP
#undef AT_STAGE
#undef TRRD
    { auto rr = __builtin_amdgcn_permlane32_swap(__float_as_uint(l_run), __float_as_uint(l_run), false, false); l_run = __uint_as_float(rr[0]) + __uint_as_float(rr[1]); }
    const float inv = 1.f / l_run;
    bf16_t* orow = Og + (size_t)(q0 + r32) * ldo + 4 * hi;
#pragma unroll
    for (int d0 = 0; d0 < 4; ++d0)
#pragma unroll
        for (int rq = 0; rq < 4; ++rq) { u32x2 w; w.x = pkbf(oT[d0][4 * rq] * inv, oT[d0][4 * rq + 1] * inv); w.y = pkbf(oT[d0][4 * rq + 2] * inv, oT[d0][4 * rq + 3] * inv);
            *(u32x2*)(orow + 32 * d0 + 8 * rq) = w; }
}
__device__ __forceinline__ void p_attn(LAS unsigned char* ldsb, unsigned char* ws) {
    const bf16_t* QA = (const bf16_t*)(ws + WS_QA); const bf16_t* KA = (const bf16_t*)(ws + WS_KA); const bf16_t* VA = (const bf16_t*)(ws + WS_VA); bf16_t* OA = (bf16_t*)(ws + WS_OA);
    const bf16_t* QB = (const bf16_t*)(ws + WS_QB); const bf16_t* KB = (const bf16_t*)(ws + WS_KB); const bf16_t* VB = (const bf16_t*)(ws + WS_VB); bf16_t* OB = (bf16_t*)(ws + WS_OB);
    const unsigned* MASK = (const unsigned*)(ws + WS_MASK);
    for (int w = blockIdx.x; w < 256; w += gridDim.x) {
        const int bh = (w & 7) * 2 + ((w >> 3) & 1), i = w >> 4, b = bh >> 3, h = bh & 7;
        const size_t r0 = (size_t)b * S;
        attn_unit<192, false>(ldsb, QA + r0 * 1536 + h * 192, 1536, KA + r0 * 1536 + h * 192, 1536, VA + r0 * 1024 + h * 128, 1024, nullptr, OA + r0 * 1024 + h * 128, 1024, i, 0.07216878364870322f * 1.4426950408889634f);
        attn_unit<128, true>(ldsb, QB + r0 * 1024 + h * 128, 1024, KB + r0 * 1024 + h * 128, 1024, VB + r0 * 1024 + h * 128, 1024, MASK + r0 * 128, OB + r0 * 1024 + h * 128, 1024, 15 - i, 0.08838834764831845f * 1.4426950408889634f);
    }
}

template <int DQK, bool MASKED>
__device__ __forceinline__ void nattn(float* lds, const bf16_t* Q, const bf16_t* Kp, int ldk, const bf16_t* Vp, const unsigned* mask, bf16_t* O, float scale) {
    float* qs = lds; float* scb = lds + 8 * 192;
    const int tid = opaque_tid(), lane = tid & 63, h = tid >> 6;
    float* sc = scb + h * 4096;
    for (int t = blockIdx.x; t < T; t += gridDim.x) {
        const int b = t >> 12, ti = t & 4095, nk = ti + 1;
        __syncthreads();
        for (int i = tid; i < 8 * DQK; i += NTHREADS) qs[i] = bf2f(Q[(size_t)t * (8 * DQK) + i]);
        __syncthreads();
        const float* q = qs + h * DQK;
        float mx = -__builtin_inff();
        for (int s0 = 0; s0 < nk; s0 += 64) {
            const int s = s0 + lane; float v = -__builtin_inff();
            bool on = s < nk;
            if (MASKED && on) on = (mask[(size_t)t * 128 + (s >> 5)] >> (s & 31)) & 1u;
            if (on) {
                const bf16_t* kr = Kp + (size_t)(b * S + s) * ldk + h * DQK;
                float dot = 0.f;
#pragma unroll 4
                for (int c = 0; c < DQK / 8; ++c) { const u32x4 raw = *(const u32x4*)(kr + c * 8); const unsigned w[4] = {raw.x, raw.y, raw.z, raw.w};
#pragma unroll
                    for (int j = 0; j < 4; ++j) { dot = fmaf(q[c * 8 + 2 * j], __uint_as_float(w[j] << 16), dot); dot = fmaf(q[c * 8 + 2 * j + 1], __uint_as_float(w[j] & 0xffff0000u), dot); } }
                v = dot * scale;
            }
            if (s < nk) sc[s] = v;
            mx = fmaxf(mx, v);
        }
        mx = wave_max(mx);
        __syncthreads();
        float sum = 0.f;
        for (int s = lane; s < nk; s += 64) { const float pz = __expf(sc[s] - mx); sc[s] = pz; sum += pz; }
        sum = wave_sum(sum);
        __syncthreads();
        float a0 = 0.f, a1 = 0.f;
        const bf16_t* vb = Vp + (size_t)(b * S) * 1024 + h * 128 + lane * 2;
        for (int s = 0; s < nk; ++s) {
            const float pz = sc[s];
            if (pz != 0.f) { const unsigned w = *(const unsigned*)(vb + (size_t)s * 1024); a0 = fmaf(pz, __uint_as_float(w << 16), a0); a1 = fmaf(pz, __uint_as_float(w & 0xffff0000u), a1); }
        }
        const float inv = 1.f / sum;
        *(unsigned*)(O + (size_t)t * 1024 + h * 128 + lane * 2) = pk2(a0 * inv, a1 * inv);
    }
    __syncthreads();
}

__device__ __forceinline__ void p_ln1_route(float* lds, const Params& p, int l) {
    const float* V1 = (const float*)(p.ws + WS_V1); float* H1F = (float*)(p.ws + WS_H1F); bf16_t* H1B = (bf16_t*)(p.ws + WS_H1B);
    unsigned* cnt = (unsigned*)(p.ws + WS_CNT) + l * 64; int* LIST = (int*)(p.ws + WS_LIST);
    int* TOKE = (int*)(p.ws + WS_TOKE); float* TOKW = (float*)(p.ws + WS_TOKW); int* TOKS = (int*)(p.ws + WS_TOKS);
    const float* g = p.ln1g + (size_t)l * D; const float* bb = p.ln1b + (size_t)l * D;
    const float* wr = p.w_router + (size_t)l * D * 64; const float* wg = p.w_group + (size_t)l * D * 8;
    const float* br = p.b_router + l * 64; const float* bg = p.b_group + l * 8;
    const int tid = opaque_tid(), lane = tid & 63, wv = tid >> 6;
    float* lg = lds + wv * 80;
    for (int t0 = blockIdx.x * 8; t0 < T; t0 += gridDim.x * 8) {
        const int t = t0 + wv;
        float s1 = 0.f;
#pragma unroll 4
        for (int j = 0; j < 32; ++j) s1 += V1[(size_t)t * D + lane + 64 * j];
        const float mean = wave_sum(s1) * (1.f / D);
        float s2 = 0.f;
#pragma unroll 4
        for (int j = 0; j < 32; ++j) { const float d = V1[(size_t)t * D + lane + 64 * j] - mean; s2 += d * d; }
        const float rstd = rsqrtf(wave_sum(s2) * (1.f / D) + 1e-5f);
        float acc[72];
#pragma unroll
        for (int e = 0; e < 72; ++e) acc[e] = 0.f;
#pragma unroll 1
        for (int j = 0; j < 32; ++j) {
            const int k = lane + 64 * j;
            const float hk = (V1[(size_t)t * D + k] - mean) * rstd * g[k] + bb[k];
            H1F[(size_t)t * D + k] = hk; H1B[(size_t)t * D + k] = f2bf(hk);
            const float* wrow = wr + (size_t)k * 64;
#pragma unroll
            for (int e4 = 0; e4 < 16; ++e4) { const f32x4 w = *(const f32x4*)(wrow + e4 * 4);
                acc[e4 * 4] = fmaf(hk, w[0], acc[e4 * 4]); acc[e4 * 4 + 1] = fmaf(hk, w[1], acc[e4 * 4 + 1]); acc[e4 * 4 + 2] = fmaf(hk, w[2], acc[e4 * 4 + 2]); acc[e4 * 4 + 3] = fmaf(hk, w[3], acc[e4 * 4 + 3]); }
            const float* grow = wg + (size_t)k * 8;
            const f32x4 w0 = *(const f32x4*)grow, w1 = *(const f32x4*)(grow + 4);
            acc[64] = fmaf(hk, w0[0], acc[64]); acc[65] = fmaf(hk, w0[1], acc[65]); acc[66] = fmaf(hk, w0[2], acc[66]); acc[67] = fmaf(hk, w0[3], acc[67]);
            acc[68] = fmaf(hk, w1[0], acc[68]); acc[69] = fmaf(hk, w1[1], acc[69]); acc[70] = fmaf(hk, w1[2], acc[70]); acc[71] = fmaf(hk, w1[3], acc[71]);
        }
#pragma unroll
        for (int e = 0; e < 72; ++e) { const float r = wave_sum(acc[e]); if (lane == 0) lg[e] = r; }
        __syncthreads();
        if (lane == 0) {
            float gl[8]; float gmax = -__builtin_inff(); int gi = 0;
#pragma unroll
            for (int i = 0; i < 8; ++i) { gl[i] = lg[64 + i] + bg[i]; if (gl[i] > gmax) { gmax = gl[i]; gi = i; } }
            float gs = 0.f;
#pragma unroll
            for (int i = 0; i < 8; ++i) gs += __expf(gl[i] - gmax);
            const float gp = 1.f / gs;
            float el[8]; float emax = -__builtin_inff(); int e1 = 0;
#pragma unroll
            for (int i = 0; i < 8; ++i) { el[i] = lg[gi * 8 + i] + br[gi * 8 + i]; if (el[i] > emax) { emax = el[i]; e1 = i; } }
            float e2max = -__builtin_inff(); int e2 = 0;
#pragma unroll
            for (int i = 0; i < 8; ++i) { if (i != e1 && el[i] > e2max) { e2max = el[i]; e2 = i; } }
            const float p1 = 1.f, p2 = __expf(e2max - emax);
            const float wa = gp * p1 / (p1 + p2), wb = gp * p2 / (p1 + p2);
            const int ea = gi * 8 + e1, eb = gi * 8 + e2;
            const int sa = (int)atomicAdd(cnt + ea, 1u), sb = (int)atomicAdd(cnt + eb, 1u);
            LIST[(size_t)ea * ECAP + sa] = t; LIST[(size_t)eb * ECAP + sb] = t;
            TOKE[t * 2] = ea; TOKE[t * 2 + 1] = eb; TOKW[t * 2] = wa; TOKW[t * 2 + 1] = wb; TOKS[t * 2] = sa; TOKS[t * 2 + 1] = sb;
        }
        __syncthreads();
    }
}

__device__ __forceinline__ void moe_tables(int* tab, const unsigned* cnt, int items_per_rb) {
    if (threadIdx.x == 0) { int a = 0, bsum = 0; for (int e = 0; e < 64; ++e) { tab[e] = a; tab[80 + e] = bsum; const int c = (int)cnt[e]; a += ((c + 127) / 128) * items_per_rb; bsum += ((c + 255) / 256) * 256; } tab[64] = a; tab[80 + 64] = bsum; }
    __syncthreads();
}
__device__ __forceinline__ void p_moe1(float* lds, const Params& p, int l) {
    const unsigned* cnt = (const unsigned*)(p.ws + WS_CNT) + l * 64; const int* LIST = (const int*)(p.ws + WS_LIST);
    const bf16_t* H1B = (const bf16_t*)(p.ws + WS_H1B); bf16_t* HID = (bf16_t*)(p.ws + WS_HID);
    float* As = lds; float* Wg = lds + 32 * 132; float* Wu = Wg + 32 * 64; int* tab = (int*)(Wu + 32 * 64);
    __syncthreads();
    moe_tables(tab, cnt, 8);
    const int tid = opaque_tid(), ty = tid >> 4, tx = tid & 15;
    const int total = tab[64];
    for (int item = blockIdx.x; item < total; item += gridDim.x) {
        int e = 0; while (tab[e + 1] <= item) ++e;
        const int local = item - tab[e], rb = local >> 3, ct = local & 7, ce = (int)cnt[e], base = tab[80 + e];
        const float* wgp = p.w_eg + ((size_t)(l * 64 + e) * D) * FE + ct * 64;
        const float* wup = p.w_eu + ((size_t)(l * 64 + e) * D) * FE + ct * 64;
        const f32x4 z4 = {0.f, 0.f, 0.f, 0.f};
        f32x4 ag0 = z4, ag1 = z4, ag2 = z4, ag3 = z4, au0 = z4, au1 = z4, au2 = z4, au3 = z4;
        const int ar = tid >> 2, akq = (tid & 3) * 8, wk = tid >> 4, wn4 = (tid & 15) * 4;
        const int ai = rb * 128 + ar; const int tok = ai < ce ? LIST[(size_t)e * ECAP + ai] : -1;
        const bf16_t* ap = H1B + (size_t)(tok < 0 ? 0 : tok) * D + akq;
        for (int k0 = 0; k0 < D; k0 += 32) {
            __syncthreads();
            { u32x4 raw = *(const u32x4*)(ap + k0); if (tok < 0) raw = (u32x4){0u, 0u, 0u, 0u};
              float* dst = As + akq * 132 + ar;
              dst[0 * 132] = __uint_as_float(raw.x << 16); dst[1 * 132] = __uint_as_float(raw.x & 0xffff0000u); dst[2 * 132] = __uint_as_float(raw.y << 16); dst[3 * 132] = __uint_as_float(raw.y & 0xffff0000u);
              dst[4 * 132] = __uint_as_float(raw.z << 16); dst[5 * 132] = __uint_as_float(raw.z & 0xffff0000u); dst[6 * 132] = __uint_as_float(raw.w << 16); dst[7 * 132] = __uint_as_float(raw.w & 0xffff0000u); }
            *(f32x4*)(Wg + wk * 64 + wn4) = *(const f32x4*)(wgp + (size_t)(k0 + wk) * FE + wn4);
            *(f32x4*)(Wu + wk * 64 + wn4) = *(const f32x4*)(wup + (size_t)(k0 + wk) * FE + wn4);
            __syncthreads();
#pragma unroll 4
            for (int kk = 0; kk < 32; ++kk) {
                const f32x4 a = *(const f32x4*)(As + kk * 132 + ty * 4);
                const f32x4 g4 = *(const f32x4*)(Wg + kk * 64 + tx * 4);
                const f32x4 u4 = *(const f32x4*)(Wu + kk * 64 + tx * 4);
                ag0 += a[0] * g4; ag1 += a[1] * g4; ag2 += a[2] * g4; ag3 += a[3] * g4;
                au0 += a[0] * u4; au1 += a[1] * u4; au2 += a[2] * u4; au3 += a[3] * u4;
            }
        }
#define MOE1_OUT(i, G_, U_) do { const int ri = rb * 128 + ty * 4 + (i); if (ri < ce) { f32x4 o; \
            o[0] = G_[0] / (1.f + __expf(-G_[0])) * U_[0]; o[1] = G_[1] / (1.f + __expf(-G_[1])) * U_[1]; o[2] = G_[2] / (1.f + __expf(-G_[2])) * U_[2]; o[3] = G_[3] / (1.f + __expf(-G_[3])) * U_[3]; \
            st4bf(HID + (size_t)(base + ri) * FE + ct * 64 + tx * 4, o); } } while (0)
        MOE1_OUT(0, ag0, au0); MOE1_OUT(1, ag1, au1); MOE1_OUT(2, ag2, au2); MOE1_OUT(3, ag3, au3);
#undef MOE1_OUT
    }
    __syncthreads();
}
__device__ __forceinline__ void p_moe2(float* lds, const Params& p, int l) {
    const unsigned* cnt = (const unsigned*)(p.ws + WS_CNT) + l * 64;
    const bf16_t* HID = (const bf16_t*)(p.ws + WS_HID); bf16_t* YE = (bf16_t*)(p.ws + WS_YE);
    float* As = lds; float* Ws = lds + 32 * 132; int* tab = (int*)(Ws + 32 * 64 * 2);
    __syncthreads();
    moe_tables(tab, cnt, 32);
    const int tid = opaque_tid(), ty = tid >> 4, tx = tid & 15;
    const int total = tab[64];
    for (int item = blockIdx.x; item < total; item += gridDim.x) {
        int e = 0; while (tab[e + 1] <= item) ++e;
        const int local = item - tab[e], rb = local >> 5, ct = local & 31, ce = (int)cnt[e], base = tab[80 + e];
        const float* wdp = p.w_ed + ((size_t)(l * 64 + e) * FE) * D + ct * 64;
        f32x4 acc0 = {0.f, 0.f, 0.f, 0.f}, acc1 = acc0, acc2 = acc0, acc3 = acc0;
        const int ar = tid >> 2, akq = (tid & 3) * 8, wk = tid >> 4, wn4 = (tid & 15) * 4;
        const int ai = rb * 128 + ar; const bool av = ai < ce;
        const bf16_t* ap = HID + (size_t)(base + (av ? ai : 0)) * FE + akq;
        for (int k0 = 0; k0 < FE; k0 += 32) {
            __syncthreads();
            { u32x4 raw = *(const u32x4*)(ap + k0); if (!av) raw = (u32x4){0u, 0u, 0u, 0u};
              float* dst = As + akq * 132 + ar;
              dst[0 * 132] = __uint_as_float(raw.x << 16); dst[1 * 132] = __uint_as_float(raw.x & 0xffff0000u); dst[2 * 132] = __uint_as_float(raw.y << 16); dst[3 * 132] = __uint_as_float(raw.y & 0xffff0000u);
              dst[4 * 132] = __uint_as_float(raw.z << 16); dst[5 * 132] = __uint_as_float(raw.z & 0xffff0000u); dst[6 * 132] = __uint_as_float(raw.w << 16); dst[7 * 132] = __uint_as_float(raw.w & 0xffff0000u); }
            *(f32x4*)(Ws + wk * 64 + wn4) = *(const f32x4*)(wdp + (size_t)(k0 + wk) * D + wn4);
            __syncthreads();
#pragma unroll 8
            for (int kk = 0; kk < 32; ++kk) {
                const f32x4 a = *(const f32x4*)(As + kk * 132 + ty * 4);
                const f32x4 w = *(const f32x4*)(Ws + kk * 64 + tx * 4);
                acc0 += a[0] * w; acc1 += a[1] * w; acc2 += a[2] * w; acc3 += a[3] * w;
            }
        }
        { const int ri = rb * 128 + ty * 4; bf16_t* yo = YE + (size_t)(base + ri) * D + ct * 64 + tx * 4;
          if (ri < ce) st4bf(yo, acc0); if (ri + 1 < ce) st4bf(yo + D, acc1); if (ri + 2 < ce) st4bf(yo + 2 * D, acc2); if (ri + 3 < ce) st4bf(yo + 3 * D, acc3); }
    }
    __syncthreads();
}
__device__ __forceinline__ void p_ln2(float* lds, const Params& p, int l) {
    const unsigned* cnt = (const unsigned*)(p.ws + WS_CNT) + l * 64;
    const float* H1F = (const float*)(p.ws + WS_H1F); const bf16_t* YE = (const bf16_t*)(p.ws + WS_YE);
    const int* TOKE = (const int*)(p.ws + WS_TOKE); const float* TOKW = (const float*)(p.ws + WS_TOKW); const int* TOKS = (const int*)(p.ws + WS_TOKS);
    float* outF = (l == DEPTH - 1) ? p.out : (float*)(p.ws + WS_H2F); bf16_t* XB = (bf16_t*)(p.ws + WS_XB);
    const float* g = p.ln2g + (size_t)l * D; const float* bb = p.ln2b + (size_t)l * D;
    int* tab = (int*)lds;
    __syncthreads();
    moe_tables(tab, cnt, 1);
    const int tid = opaque_tid(), lane = tid & 63, wv = tid >> 6;
    for (int t0 = blockIdx.x * 8; t0 < T; t0 += gridDim.x * 8) {
        const int t = t0 + wv;
        const int r0 = tab[80 + TOKE[t * 2]] + TOKS[t * 2], r1 = tab[80 + TOKE[t * 2 + 1]] + TOKS[t * 2 + 1];
        const float w0 = TOKW[t * 2], w1 = TOKW[t * 2 + 1];
        const float* hrow = H1F + (size_t)t * D; const bf16_t* y0 = YE + (size_t)r0 * D; const bf16_t* y1 = YE + (size_t)r1 * D;
        float s1 = 0.f;
#pragma unroll 4
        for (int j = 0; j < 32; ++j) { const int k = lane + 64 * j; s1 += ALPHA * hrow[k] + w0 * bf2f(y0[k]) + w1 * bf2f(y1[k]); }
        const float mean = wave_sum(s1) * (1.f / D);
        float s2 = 0.f;
#pragma unroll 4
        for (int j = 0; j < 32; ++j) { const int k = lane + 64 * j; const float d = ALPHA * hrow[k] + w0 * bf2f(y0[k]) + w1 * bf2f(y1[k]) - mean; s2 += d * d; }
        const float rstd = rsqrtf(wave_sum(s2) * (1.f / D) + 1e-5f);
#pragma unroll 4
        for (int j = 0; j < 32; ++j) { const int k = lane + 64 * j; const float v = ALPHA * hrow[k] + w0 * bf2f(y0[k]) + w1 * bf2f(y1[k]);
            const float o = (v - mean) * rstd * g[k] + bb[k];
            outF[(size_t)t * D + k] = o; if (l != DEPTH - 1) XB[(size_t)t * D + k] = f2bf(o); }
    }
    __syncthreads();
}

constexpr int NPH = 10;
#ifndef PH_MASK
#define PH_MASK 0x7ff
#endif
#define PHON(k) ((PH_MASK >> (k)) & 1)
typedef const Params __attribute__((address_space(4))) CParams;
#define KP(field) ({ CParams* _k = kp; asm volatile("" : "+s"(_k)); _k->field; })
__global__ void __launch_bounds__(NTHREADS, 2) hybrid_fwd(Params p_unused, int ph_lo, int ph_hi) {
    extern __shared__ __attribute__((aligned(16))) unsigned char lds_raw[];
    float* lds = (float*)lds_raw;
    LAS unsigned char* ldsb = (LAS unsigned char*)lds_raw;
    CParams* kp = (CParams*)__builtin_amdgcn_kernarg_segment_ptr();
    unsigned char* const ws0 = KP(ws);
    volatile LAS unsigned* xbw = (volatile LAS unsigned*)(lds_raw + LDS_BYTES - 16);
    if (threadIdx.x == 0) { xbw[0] = 0u; xbw[1] = 0u; xbw[2] = 0u; xbw[3] = 0u; }
    __syncthreads();
    XcdBarrier bar; bar.bar = (unsigned*)(ws0 + WS_BAR); bar.x = 0; bar.st = xbw;
    if (ph_lo < ph_hi) bar = xcd_barrier_post((unsigned*)(ws0 + WS_BAR), xbw);
#define IN(ph) ((ph) >= ph_lo && (ph) <= ph_hi)
#define GRID_BAR(ph) do { if ((ph) >= ph_lo && (ph) < ph_hi) xcd_barrier(bar); } while (0)
    if (PHON(0) && IN(0)) { unsigned char* ws = ws0; asm volatile("" : "+s"(ws)); { Params q; q.ws = ws; q.x = KP(x); q.pos = KP(pos); q.w_in = KP(w_in); q.g_q = KP(g_q); q.w_qb = KP(w_qb); q.g_kv = KP(g_kv); q.w_kvb = KP(w_kvb);
        q.w_oa = KP(w_oa); q.w_ob = KP(w_ob); q.w_out = KP(w_out); p_prologue(ldsb, q); } }
    GRID_BAR(0);
    for (int l = 0; l < DEPTH; ++l) {
        const int pb = l * NPH;
        if (PHON(1) && IN(pb + 1)) { unsigned char* ws = ws0; asm volatile("" : "+s"(ws));
            EpiIn E; E.ws = ws;
            pg8::Gemm g{(const bf16_t*)(ws + WS_XB), (const bf16_t*)(ws + WS_WIN_T) + (size_t)l * INP * D, T, INP, D}; pg8::StaticOrder SO; SO.init(T, INP, (int)gridDim.x, (int)blockIdx.x);
            pg8::gemm_phase<EpiIn, pg8::StaticOrder, true, true>(ldsb, g, SO, E);
        }
        GRID_BAR(pb + 1);
        if (PHON(2) && IN(pb + 2)) { unsigned char* ws = ws0; asm volatile("" : "+s"(ws));
            { EpiQA E; E.ws = ws;
              pg8::Gemm g{(const bf16_t*)(ws + WS_CQ), (const bf16_t*)(ws + WS_WQB_T) + (size_t)l * 1536 * 512, T, 1536, 512}; pg8::StaticOrder SO; SO.init(T, 1536, (int)gridDim.x, (int)blockIdx.x);
              pg8::gemm_phase<EpiQA, pg8::StaticOrder, true, true>(ldsb, g, SO, E); }
            { EpiKV E; E.ws = ws;
              pg8::Gemm g{(const bf16_t*)(ws + WS_CKV), (const bf16_t*)(ws + WS_WKVB_T) + (size_t)l * 2048 * 512, T, 2048, 512}; pg8::StaticOrder SO; SO.init(T, 2048, (int)gridDim.x, (int)blockIdx.x);
              pg8::gemm_phase<EpiKV, pg8::StaticOrder, true, true>(ldsb, g, SO, E); }
            p_score(ldsb, ws);
        }
        GRID_BAR(pb + 2);
        if (PHON(3) && IN(pb + 3)) { unsigned char* ws = ws0; asm volatile("" : "+s"(ws)); p_select(ws); }
        GRID_BAR(pb + 3);
        if (PHON(4) && IN(pb + 4)) { unsigned char* ws = ws0; asm volatile("" : "+s"(ws));
            p_attn(ldsb, ws);
        }
        GRID_BAR(pb + 4);
        if (PHON(5) && IN(pb + 5)) { unsigned char* ws = ws0; asm volatile("" : "+s"(ws));
            pg8::StaticOrder SO; SO.init(T, D, (int)gridDim.x, (int)blockIdx.x);
            { EpiYA E; E.ws = ws;
              pg8::Gemm g{(const bf16_t*)(ws + WS_OA), (const bf16_t*)(ws + WS_WOA_T) + (size_t)l * D * 1024, T, D, 1024};
              pg8::gemm_phase<EpiYA, pg8::StaticOrder, true, true>(ldsb, g, SO, E); }
            { EpiYB E; E.ws = ws;
              pg8::Gemm g{(const bf16_t*)(ws + WS_OB), (const bf16_t*)(ws + WS_WOB_T) + (size_t)l * D * 1024, T, D, 1024};
              pg8::gemm_phase<EpiYB, pg8::StaticOrder, true, true>(ldsb, g, SO, E); }
        }
        GRID_BAR(pb + 5);
        if (PHON(6) && IN(pb + 6)) { unsigned char* ws = ws0; asm volatile("" : "+s"(ws));
            EpiOut E; E.hin = (l == 0) ? KP(x) : (const float*)(ws + WS_H2F); E.V1 = (float*)(ws + WS_V1);
            pg8::Gemm g{(const bf16_t*)(ws + WS_Y), (const bf16_t*)(ws + WS_WOUT_T) + (size_t)l * D * D, T, D, D}; pg8::StaticOrder SO; SO.init(T, D, (int)gridDim.x, (int)blockIdx.x);
            pg8::gemm_phase<EpiOut, pg8::StaticOrder, true, true>(ldsb, g, SO, E);
        }
        GRID_BAR(pb + 6);
        if (PHON(7) && IN(pb + 7)) { unsigned char* ws = ws0; asm volatile("" : "+s"(ws)); Params q; q.ws = ws; q.ln1g = KP(ln1g); q.ln1b = KP(ln1b); q.w_router = KP(w_router); q.w_group = KP(w_group); q.b_router = KP(b_router); q.b_group = KP(b_group); p_ln1_route(lds, q, l); }
        GRID_BAR(pb + 7);
        if (PHON(8) && IN(pb + 8)) { unsigned char* ws = ws0; asm volatile("" : "+s"(ws)); Params q; q.ws = ws; q.w_eg = KP(w_eg); q.w_eu = KP(w_eu); p_moe1(lds, q, l); }
        GRID_BAR(pb + 8);
        if (PHON(9) && IN(pb + 9)) { unsigned char* ws = ws0; asm volatile("" : "+s"(ws)); Params q; q.ws = ws; q.w_ed = KP(w_ed); p_moe2(lds, q, l); }
        GRID_BAR(pb + 9);
        if (PHON(10) && IN(pb + 10)) { unsigned char* ws = ws0; asm volatile("" : "+s"(ws)); Params q; q.ws = ws; q.ln2g = KP(ln2g); q.ln2b = KP(ln2b); q.out = KP(out); p_ln2(lds, q, l); }
        GRID_BAR(pb + 10);
    }
}

#ifndef MK_ONE_LAUNCH
#define MK_ONE_LAUNCH 1
#endif
extern "C" void kernel_launch(void* const* d_in, const int* in_sizes, int n_in, void* d_out, int out_size, void* d_ws, size_t ws_size, hipStream_t stream) {
    static int grid = 0;
    if (!grid) {
        if (n_in != 21 || in_sizes[0] != T * D || out_size != T * D || ws_size < WS_END) {
            fprintf(stderr, "kernel_launch: unexpected shapes (n_in %d, in0 %d, out %d, ws %zu, need %zu); nothing launched\n", n_in, n_in > 0 ? in_sizes[0] : -1, out_size, ws_size, (size_t)WS_END);
            grid = -1; return; }
        int dev = 0, cus = 0, per_cu = 0;
        hipGetDevice(&dev); hipDeviceGetAttribute(&cus, hipDeviceAttributeMultiprocessorCount, dev);
        if (hipFuncSetAttribute((const void*)hybrid_fwd, hipFuncAttributeMaxDynamicSharedMemorySize, LDS_BYTES) != hipSuccess) { fprintf(stderr, "kernel_launch: hipFuncSetAttribute failed\n"); grid = -1; return; }
        hipOccupancyMaxActiveBlocksPerMultiprocessor(&per_cu, (const void*)hybrid_fwd, NTHREADS, LDS_BYTES);
        if (per_cu < 1) fprintf(stderr, "kernel_launch: occupancy query reports %d blocks per CU\n", per_cu);
        grid = cus > 0 ? cus : 256;
    }
    if (grid < 0) return;
    hipMemsetAsync((char*)d_ws, 0, WS_CTL_END, stream);
    Params p{};
    p.x = (const float*)d_in[0]; p.pos = (const int*)d_in[1];
    p.w_in = (const float*)d_in[2]; p.g_q = (const float*)d_in[3]; p.w_qb = (const float*)d_in[4]; p.g_kv = (const float*)d_in[5]; p.w_kvb = (const float*)d_in[6];
    p.w_oa = (const float*)d_in[7]; p.w_ob = (const float*)d_in[8]; p.w_out = (const float*)d_in[9]; p.ln1g = (const float*)d_in[10]; p.ln1b = (const float*)d_in[11];
    p.w_group = (const float*)d_in[12]; p.b_group = (const float*)d_in[13]; p.w_router = (const float*)d_in[14]; p.b_router = (const float*)d_in[15];
    p.w_eg = (const float*)d_in[16]; p.w_eu = (const float*)d_in[17]; p.w_ed = (const float*)d_in[18]; p.ln2g = (const float*)d_in[19]; p.ln2b = (const float*)d_in[20];
    p.out = (float*)d_out; p.ws = (unsigned char*)d_ws;
#if MK_ONE_LAUNCH
    hipLaunchKernelGGL(hybrid_fwd, dim3(grid), dim3(NTHREADS), LDS_BYTES, stream, p, 0, DEPTH * NPH);
#else
    for (int ph = 0; ph <= DEPTH * NPH; ++ph) hipLaunchKernelGGL(hybrid_fwd, dim3(grid), dim3(NTHREADS), LDS_BYTES, stream, p, ph, ph);
#endif
}
```

```cpp
#include <hip/hip_runtime.h>
#include <cstdio>
#include <cstdint>

typedef unsigned short bf16_t;
typedef float f32x4 __attribute__((ext_vector_type(4)));
typedef unsigned u32x4 __attribute__((ext_vector_type(4)));
typedef unsigned u32x2 __attribute__((ext_vector_type(2)));

constexpr int T = 8192, D = 2048, S = 4096, NB = 2, DEPTH = 2;
constexpr int INW = 9360, INP = 9472;
constexpr int NE = 64, FE = 512;
constexpr int NTHREADS = 512;
constexpr int LDS_BYTES = 147456;
constexpr float ALPHA = 1.41421356237309515f;
constexpr int ECAP = 8192;
constexpr int PMAX = 32768;

constexpr size_t al256(size_t x) { return (x + 255) & ~(size_t)255; }
constexpr size_t XCD_BAR_BYTES = 16384;
constexpr size_t WS_BAR = 0;
constexpr size_t WS_CNT = WS_BAR + XCD_BAR_BYTES;
constexpr size_t WS_CTL_END = WS_CNT + al256(DEPTH * 64 * 4);
constexpr size_t WS_SSQ = WS_CTL_END;
constexpr size_t WS_ROPE = WS_SSQ + al256((size_t)T * 32 * 4);
constexpr size_t WS_XB = WS_ROPE + al256((size_t)T * 112 * 4);
constexpr size_t WS_H2F = WS_XB + al256((size_t)T * D * 2);
constexpr size_t WS_CQ = WS_H2F + al256((size_t)T * D * 4);
constexpr size_t WS_CKV = WS_CQ + al256((size_t)T * 512 * 2);
constexpr size_t WS_QB = WS_CKV + al256((size_t)T * 512 * 2);
constexpr size_t WS_KB = WS_QB + al256((size_t)T * 1024 * 2);
constexpr size_t WS_VB = WS_KB + al256((size_t)T * 1024 * 2);
constexpr size_t WS_QI = WS_VB + al256((size_t)T * 1024 * 2);
constexpr size_t WS_KI = WS_QI + al256((size_t)T * 1024 * 2);
constexpr size_t WS_WI = WS_KI + al256((size_t)T * 64 * 2);
constexpr size_t WS_GA = WS_WI + al256((size_t)T * 16 * 4);
constexpr size_t WS_GB = WS_GA + al256((size_t)T * D * 2);
constexpr size_t WS_QA = WS_GB + al256((size_t)T * D * 2);
constexpr size_t WS_KA = WS_QA + al256((size_t)T * 1536 * 2);
constexpr size_t WS_VA = WS_KA + al256((size_t)T * 1536 * 2);
constexpr size_t WS_MASK = WS_VA + al256((size_t)T * 1024 * 2);
constexpr size_t WS_OA = WS_MASK + al256((size_t)T * 128 * 4);
constexpr size_t WS_OB = WS_OA + al256((size_t)T * 1024 * 2);
constexpr size_t WS_YT = WS_OB + al256((size_t)T * 1024 * 2);
constexpr size_t WS_Y = WS_YT + al256((size_t)T * D * 4);
constexpr size_t WS_V1 = WS_Y + al256((size_t)T * D * 2);
constexpr size_t WS_H1F = WS_V1 + al256((size_t)T * D * 4);
constexpr size_t WS_H1B = WS_H1F + al256((size_t)T * D * 4);
constexpr size_t WS_TOKE = WS_H1B + al256((size_t)T * D * 2);
constexpr size_t WS_TOKW = WS_TOKE + al256((size_t)T * 2 * 4);
constexpr size_t WS_TOKS = WS_TOKW + al256((size_t)T * 2 * 4);
constexpr size_t WS_LIST = WS_TOKS + al256((size_t)T * 2 * 4);
constexpr size_t WS_HID = WS_LIST + al256((size_t)NE * ECAP * 4);
constexpr size_t WS_YE = WS_HID + al256((size_t)PMAX * FE * 2);
constexpr size_t WS_SCORE = WS_YE + al256((size_t)PMAX * D * 2);
constexpr size_t WS_WIN_T = WS_SCORE + al256((size_t)T * 4096 * 4);
constexpr size_t WS_WQB_T = WS_WIN_T + al256((size_t)DEPTH * INP * D * 2);
constexpr size_t WS_WKVB_T = WS_WQB_T + al256((size_t)DEPTH * 1536 * 512 * 2);
constexpr size_t WS_WOA_T = WS_WKVB_T + al256((size_t)DEPTH * 2048 * 512 * 2);
constexpr size_t WS_WOB_T = WS_WOA_T + al256((size_t)DEPTH * D * 1024 * 2);
constexpr size_t WS_WOUT_T = WS_WOB_T + al256((size_t)DEPTH * D * 1024 * 2);
constexpr size_t WS_END = WS_WOUT_T + al256((size_t)DEPTH * D * D * 2);
static_assert(WS_CKV == WS_CQ + (size_t)T * 512 * 2, "CQ|CKV must be consecutive");

static_assert(WS_KB == WS_QB + (size_t)T * 1024 * 2 && WS_VB == WS_KB + (size_t)T * 1024 * 2 && WS_GB == WS_GA + (size_t)T * D * 2, "QB|KB|VB and GA|GB must be consecutive");
struct Params {
    const float* x; const int* pos;
    const float *w_in, *g_q, *w_qb, *g_kv, *w_kvb, *w_oa, *w_ob, *w_out, *ln1g, *ln1b, *w_group, *b_group, *w_router, *b_router, *w_eg, *w_eu, *w_ed, *ln2g, *ln2b;
    float* out; unsigned char* ws;
};

__device__ __forceinline__ float bf2f(bf16_t v) { return __uint_as_float((unsigned)v << 16); }
__device__ __forceinline__ bf16_t f2bf(float f) { unsigned u = __float_as_uint(f); u += 0x7fffu + ((u >> 16) & 1u); return (bf16_t)(u >> 16); }
__device__ __forceinline__ unsigned pk2(float a, float b) { return (unsigned)f2bf(a) | ((unsigned)f2bf(b) << 16); }
__device__ __forceinline__ void st4bf(bf16_t* p, f32x4 v) { u32x2 w; w.x = pk2(v[0], v[1]); w.y = pk2(v[2], v[3]); *(u32x2*)p = w; }
__device__ __forceinline__ float wave_sum(float v) {
#pragma unroll
    for (int o = 32; o >= 1; o >>= 1) v += __shfl_xor(v, o);
    return v;
}
__device__ __forceinline__ float wave_max(float v) {
#pragma unroll
    for (int o = 32; o >= 1; o >>= 1) v = fmaxf(v, __shfl_xor(v, o));
    return v;
}
__device__ __forceinline__ int block_sum_int(int v, int* red) {
#pragma unroll
    for (int o = 32; o >= 1; o >>= 1) v += __shfl_xor(v, o);
    if ((threadIdx.x & 63) == 0) red[threadIdx.x >> 6] = v;
    __syncthreads();
    int t = 0;
#pragma unroll
    for (int i = 0; i < 8; ++i) t += red[i];
    __syncthreads();
    return t;
}
__device__ __forceinline__ f32x4 rot4(f32x4 v, float c0, float s0, float c1, float s1) { f32x4 o; o[0] = v[0] * c0 - v[1] * s0; o[1] = v[1] * c0 + v[0] * s0; o[2] = v[2] * c1 - v[3] * s1; o[3] = v[3] * c1 + v[2] * s1; return o; }

#define XB_TMO      128
#define XB_XCNT(j)  (256  + 64 * (j))
#define XB_XSUB(j)  (1280 + 64 * (j))
#define XB_XGEN(j)  (2304 + 64 * (j))
#define XB_TOP      3328
#define XB_TOPGEN   3392
#define XCD_BAR_WORDS 3456
#define XB_SPIN_CAP (1u << 22)
#define LAS __attribute__((address_space(3)))
__device__ __forceinline__ unsigned xb_ld(unsigned* p)              { return __hip_atomic_load(p, __ATOMIC_RELAXED, __HIP_MEMORY_SCOPE_AGENT); }
__device__ __forceinline__ unsigned xb_add(unsigned* p, unsigned v) { return __hip_atomic_fetch_add(p, v, __ATOMIC_RELAXED, __HIP_MEMORY_SCOPE_AGENT); }
__device__ __forceinline__ unsigned xb_xcc_id() { return (unsigned)__builtin_amdgcn_s_getreg((3 << 11) | 20) & 0xFu; }
#define XB_SPIN(cond, bar) do { unsigned _sp = 0; while (cond) { __builtin_amdgcn_s_sleep(1); \
    if ((++_sp & 255u) == 0u) { if (xb_ld(&(bar)[XB_TMO])) break; if (_sp > XB_SPIN_CAP) { atomicAdd(&(bar)[XB_TMO], 1u); break; } } } } while (0)
struct XcdBarrier { unsigned* bar; unsigned x; volatile LAS unsigned* st; };
__device__ __forceinline__ XcdBarrier xcd_barrier_post(unsigned* bar, volatile LAS unsigned* st) {
    XcdBarrier b; b.bar = bar; b.x = xb_xcc_id(); b.st = st;
    if (threadIdx.x == 0) (void)xb_add(&bar[XB_XCNT(b.x)], 1u);
    return b;
}
__device__ __forceinline__ void xcd_barrier_complete(unsigned* bar, unsigned x, unsigned& nloc, unsigned& nx) {
    const unsigned G = gridDim.x * gridDim.y * gridDim.z;
    unsigned sum, cnt, mine, sp = 0u;
    for (;;) {
        sum = 0u; cnt = 0u; mine = 0u;
#pragma unroll
        for (unsigned j = 0; j < 16; ++j) { const unsigned c = xb_ld(&bar[XB_XCNT(j)]); sum += c; cnt += (c > 0u) ? 1u : 0u; mine = (j == x) ? c : mine; }
        if (sum == G) break;
        __builtin_amdgcn_s_sleep(1);
        if ((++sp & 255u) == 0u) { if (xb_ld(&bar[XB_TMO])) break; if (sp > XB_SPIN_CAP) { atomicAdd(&bar[XB_TMO], 1u); break; } }
    }
    nloc = mine > 0u ? mine : 1u; nx = cnt > 0u ? cnt : 1u;
}
__device__ __forceinline__ void xcd_barrier(const XcdBarrier& b) {
    asm volatile("s_waitcnt vmcnt(0)" ::: "memory");
    __syncthreads();
    if (threadIdx.x == 0) {
        unsigned* bar = b.bar;
        __builtin_amdgcn_s_waitcnt(0);
        unsigned nloc = b.st[0], nx = b.st[1];
        if (nloc == 0u) { xcd_barrier_complete(bar, b.x, nloc, nx); b.st[0] = nloc; b.st[1] = nx; }
        const unsigned old = xb_add(&bar[XB_XSUB(b.x)], 1u);
        const unsigned gen = old / nloc;
        if (old + 1u == (gen + 1u) * nloc) {
            __builtin_amdgcn_fence(__ATOMIC_RELEASE, "agent");
            asm volatile("s_waitcnt vmcnt(0)" ::: "memory");
            const unsigned og = xb_add(&bar[XB_TOP], 1u);
            const unsigned tg = og / nx;
            if (og + 1u == (tg + 1u) * nx) xb_add(&bar[XB_TOPGEN], 1u);
            else XB_SPIN(xb_ld(&bar[XB_TOPGEN]) == tg, bar);
            __builtin_amdgcn_fence(__ATOMIC_ACQUIRE, "agent");
            xb_add(&bar[XB_XGEN(b.x)], 1u);
            asm volatile("s_waitcnt vmcnt(0)" ::: "memory");
        } else {
            XB_SPIN(xb_ld(&bar[XB_XGEN(b.x)]) == gen, bar);
            __builtin_amdgcn_fence(__ATOMIC_ACQUIRE, "agent");
            asm volatile("s_waitcnt vmcnt(0)" ::: "memory");
        }
    }
    __syncthreads();
}

__device__ __forceinline__ int opaque_tid() { int t = threadIdx.x; asm volatile("" : "+v"(t)); return t; }
namespace pg8 {
#define PG8_LAS __attribute__((address_space(3)))
typedef unsigned short bf16_t;
typedef short bf16x8 __attribute__((ext_vector_type(8)));
typedef float f32x4 __attribute__((ext_vector_type(4)));
typedef unsigned u32x4 __attribute__((ext_vector_type(4)));
constexpr int BM = 256, BK = 64, HALF = 128, HTB = HALF * BK * 2  , STAGE_BYTES = 8 * HTB, NXCD = 8, WGM = 8;

__host__ __device__ __forceinline__ int lds_byte(int r, int c) { const int st = (r >> 4) * 2 + (c >> 5), rr = r & 15, cc = c & 31, ob = rr * 64 + cc * 2; return st * 1024 + (ob ^ (((ob >> 9) & 1) << 5)); }
__host__ __device__ __forceinline__ void stage_rc(int b, int& R, int& C) { const int st = b / 1024, sb = b % 1024, swz = sb ^ (((sb >> 9) & 1) << 5); R = (st >> 1) * 16 + swz / 64; C = (st & 1) * 32 + (swz % 64) / 2; }
__host__ __device__ __forceinline__ int perm32(int rho) { const int n = rho >> 4, i = rho & 15; return 8 * (i >> 2) + 4 * n + (i & 3); }

struct Unit { int pm, pn; };
struct Gemm { const bf16_t* A; const bf16_t* Bt; int M, N, K; };

struct StaticOrder {
    int nM, nN, nwg, G, c;
    __host__ __device__ void init(int M, int N, int G_, int c_) { nM = M / BM; nN = N / BM; nwg = nM * nN; G = G_; c = c_; }
    __host__ __device__ bool next(int i, Unit& u) const {
        const long L = (long)i * G + c; if (L >= nwg) return false;
        int wgid = (int)L; { const int q = nwg / NXCD, r = nwg % NXCD, xcd = wgid % NXCD, off = wgid / NXCD; wgid = (xcd < r ? xcd * (q + 1) : r * (q + 1) + (xcd - r) * q) + off; }
        const int nig = WGM * nN, gid = wgid / nig, fm = gid * WGM, gsz = (nM - fm) < WGM ? (nM - fm) : WGM;
        u.pm = fm + ((wgid % nig) % gsz); u.pn = (wgid % nig) / gsz; return true;
    }
    __device__ __forceinline__ void a_ready(const Unit&) const {}
    __device__ __forceinline__ void done(const Unit&) const {}
};

__device__ __forceinline__ unsigned cvt_pk_bf16(float lo, float hi) { unsigned r; asm volatile("v_cvt_pk_bf16_f32 %0, %1, %2" : "=v"(r) : "v"(lo), "v"(hi)); return r; }
template <class Epi, class Sched, bool ALIGN_EPI = false, bool SP2 = false>
__device__ __forceinline__ void gemm_phase(PG8_LAS unsigned char* lds, const Gemm g, const Sched& S, const Epi& E) {
    const int tid = opaque_tid(), wid = __builtin_amdgcn_readfirstlane(tid >> 6), lane = tid & 63, wr = wid >> 2, wc = wid & 3, fr = lane & 15, fq = lane >> 4;
    const int K = g.K, nt = K / BK;
    unsigned voffA[2], voffB[2];
#pragma unroll
    for (int i = 0; i < 2; ++i) { int R, C; stage_rc(tid * 16 + i * 8192, R, C); const int Rb = Epi::PERM ? ((R & ~31) + perm32(R & 31)) : R;
        voffA[i] = (unsigned)(R * K + C) * 2u; voffB[i] = (unsigned)(Rb * K + C) * 2u; }
    const size_t kstep = (size_t)(BK * 2);
    const size_t hstep = (size_t)HALF * K * 2;
    const size_t tstep = 2 * hstep;
    const unsigned ldsw = (unsigned)wid * 1024u;
    const int aoff = lds_byte(wr * 64 + fr, fq * 8), boff = lds_byte(wc * 32 + fr, fq * 8);
#define PG8_SA(b, h) (((b) * 2 + (h)) * HTB)
#define PG8_SB(b, h) ((4 + (b) * 2 + (h)) * HTB)
#define PG8_STAGE(bufoff, gbase, voff) do { _Pragma("unroll") for (int _i = 0; _i < 2; ++_i) \
        __builtin_amdgcn_global_load_lds((const unsigned*)((const char*)(gbase) + (voff)[_i]), (PG8_LAS unsigned*)(lds + (bufoff) + ldsw + _i * 8192), 16, 0, 0); } while (0)
#define PG8_LDA(dst, b, h) do { _Pragma("unroll") for (int m = 0; m < 4; ++m) _Pragma("unroll") for (int k = 0; k < 2; ++k) dst[m][k] = *(const PG8_LAS bf16x8*)(lds + PG8_SA(b, h) + aoff + m * 2048 + k * 1024); } while (0)
#define PG8_LDB(dst, b, h) do { _Pragma("unroll") for (int n = 0; n < 2; ++n) _Pragma("unroll") for (int k = 0; k < 2; ++k) dst[n][k] = *(const PG8_LAS bf16x8*)(lds + PG8_SB(b, h) + boff + n * 2048 + k * 1024); } while (0)
#define PG8_MMA(ai, bj, At, Bt) do { __builtin_amdgcn_s_setprio(1); _Pragma("unroll") for (int m = 0; m < 4; ++m) _Pragma("unroll") for (int n = 0; n < 2; ++n) _Pragma("unroll") for (int k = 0; k < 2; ++k) \
        acc[ai][bj][m][n] = __builtin_amdgcn_mfma_f32_16x16x32_bf16(Bt[n][k], At[m][k], acc[ai][bj][m][n], 0, 0, 0); __builtin_amdgcn_s_setprio(0); } while (0)
#define PG8_WAIT_V(n) asm volatile("s_waitcnt vmcnt(" #n ")" ::: "memory")
#define PG8_WAIT_L(n) asm volatile("s_waitcnt lgkmcnt(" #n ")" ::: "memory")
#define PG8_BAR __builtin_amdgcn_s_barrier()
#define PG8_SCHED __builtin_amdgcn_sched_barrier(0)
    Unit cur, nxt; int ui = 0;
    if (!S.next(0, cur)) return;
    f32x4 acc[2][2][4][2];
#pragma unroll
    for (int a = 0; a < 2; ++a)
#pragma unroll
        for (int b = 0; b < 2; ++b)
#pragma unroll
            for (int m = 0; m < 4; ++m)
#pragma unroll
                for (int n = 0; n < 2; ++n) acc[a][b][m][n] = (f32x4){0.f, 0.f, 0.f, 0.f};
    bf16x8 At[4][2], B0[2][2], B1[2][2];
    const char* cA = (const char*)g.A + (size_t)cur.pm * tstep; const char* cB = (const char*)g.Bt + (size_t)cur.pn * tstep;
    S.a_ready(cur);
    if constexpr (SP2) {
        PG8_STAGE(PG8_SB(0, 0), cB, voffB); PG8_STAGE(PG8_SB(0, 1), cB + hstep, voffB); PG8_STAGE(PG8_SA(0, 0), cA, voffA); PG8_STAGE(PG8_SA(0, 1), cA + hstep, voffA);
        if (wr == 1) PG8_BAR;
        PG8_WAIT_V(2); PG8_BAR;
        PG8_STAGE(PG8_SB(1, 0), cB + kstep, voffB); PG8_STAGE(PG8_SA(1, 0), cA + kstep, voffA); PG8_STAGE(PG8_SB(1, 1), cB + hstep + kstep, voffB);
        PG8_WAIT_V(6); PG8_BAR;
    } else {
        PG8_STAGE(PG8_SB(0, 0), cB, voffB); PG8_STAGE(PG8_SA(0, 0), cA, voffA); PG8_STAGE(PG8_SB(0, 1), cB + hstep, voffB); PG8_STAGE(PG8_SA(0, 1), cA + hstep, voffA);
        if (wr == 1) PG8_BAR;
        PG8_WAIT_V(4); PG8_BAR;
        PG8_STAGE(PG8_SB(1, 0), cB + kstep, voffB); PG8_STAGE(PG8_SA(1, 0), cA + kstep, voffA); PG8_STAGE(PG8_SB(1, 1), cB + hstep + kstep, voffB);
        PG8_WAIT_V(6); PG8_BAR;
    }
    for (;;) {
        const bool has_next = S.next(ui + 1, nxt);
        const char* nA = has_next ? (const char*)g.A + (size_t)nxt.pm * tstep : cA; const char* nB = has_next ? (const char*)g.Bt + (size_t)nxt.pn * tstep : cB;
        for (int t = 0; t < nt; t += 2) {
            const bool last = (t == nt - 2);
            const char* a1 = cA + (size_t)(t + 1) * kstep;
            const char* a2 = last ? nA : cA + (size_t)(t + 2) * kstep; const char* b2 = last ? nB : cB + (size_t)(t + 2) * kstep;
            const char* a3 = a2 + kstep; const char* b3 = b2 + kstep;
            if (last && has_next) S.a_ready(nxt);
            if constexpr (SP2) {
            PG8_LDB(B0, 0, 0); PG8_LDB(B1, 0, 1); PG8_SCHED; PG8_LDA(At, 0, 0); PG8_STAGE(PG8_SA(1, 1), a1 + hstep, voffA);
            PG8_WAIT_V(8); PG8_WAIT_L(0); PG8_BAR; PG8_MMA(0, 0, At, B0); PG8_MMA(0, 1, At, B1); PG8_BAR; PG8_SCHED;
            PG8_LDA(At, 0, 1); PG8_STAGE(PG8_SB(0, 0), b2, voffB); PG8_STAGE(PG8_SB(0, 1), b2 + hstep, voffB); PG8_STAGE(PG8_SA(0, 0), a2, voffA);
            PG8_WAIT_V(8); PG8_WAIT_L(0); PG8_BAR; PG8_MMA(1, 0, At, B0); PG8_MMA(1, 1, At, B1); PG8_BAR; PG8_SCHED;
            PG8_LDB(B0, 1, 0); PG8_LDB(B1, 1, 1); PG8_SCHED; PG8_LDA(At, 1, 0); PG8_STAGE(PG8_SA(0, 1), a2 + hstep, voffA);
            PG8_WAIT_V(8); PG8_WAIT_L(0); PG8_BAR; PG8_MMA(0, 0, At, B0); PG8_MMA(0, 1, At, B1); PG8_BAR; PG8_SCHED;
            PG8_LDA(At, 1, 1); PG8_STAGE(PG8_SB(1, 0), b3, voffB); PG8_STAGE(PG8_SB(1, 1), b3 + hstep, voffB); PG8_STAGE(PG8_SA(1, 0), a3, voffA);
            PG8_WAIT_V(8); PG8_WAIT_L(0); PG8_BAR; PG8_MMA(1, 0, At, B0); PG8_MMA(1, 1, At, B1); PG8_BAR; PG8_SCHED;
            } else {
            PG8_LDB(B0, 0, 0); PG8_SCHED; PG8_LDA(At, 0, 0); PG8_STAGE(PG8_SA(1, 1), a1 + hstep, voffA);
            PG8_WAIT_L(8); PG8_BAR; PG8_WAIT_L(0); PG8_MMA(0, 0, At, B0); PG8_BAR; PG8_SCHED;
            PG8_LDB(B1, 0, 1); PG8_STAGE(PG8_SB(0, 0), b2, voffB);
            PG8_BAR; PG8_WAIT_L(0); PG8_MMA(0, 1, At, B1); PG8_BAR;
            PG8_LDA(At, 0, 1); PG8_STAGE(PG8_SA(0, 0), a2, voffA);
            PG8_BAR; PG8_WAIT_L(0); PG8_MMA(1, 0, At, B0); PG8_BAR; PG8_SCHED;
            PG8_STAGE(PG8_SB(0, 1), b2 + hstep, voffB);
            PG8_WAIT_V(6); PG8_BAR; PG8_MMA(1, 1, At, B1); PG8_BAR;
            PG8_LDB(B0, 1, 0); PG8_SCHED; PG8_LDA(At, 1, 0); PG8_STAGE(PG8_SA(0, 1), a2 + hstep, voffA);
            PG8_WAIT_L(8); PG8_BAR; PG8_WAIT_L(0); PG8_MMA(0, 0, At, B0); PG8_BAR; PG8_SCHED;
            PG8_LDB(B1, 1, 1); PG8_STAGE(PG8_SB(1, 0), b3, voffB);
            PG8_BAR; PG8_WAIT_L(0); PG8_MMA(0, 1, At, B1); PG8_BAR;
            PG8_LDA(At, 1, 1); PG8_STAGE(PG8_SA(1, 0), a3, voffA);
            PG8_BAR; PG8_WAIT_L(0); PG8_MMA(1, 0, At, B0); PG8_BAR; PG8_SCHED;
            PG8_STAGE(PG8_SB(1, 1), b3 + hstep, voffB);
            PG8_WAIT_V(6); PG8_BAR; PG8_MMA(1, 1, At, B1); PG8_BAR;
            }
        }
        if constexpr (ALIGN_EPI) { if (wr == 0) PG8_BAR; }
        if constexpr (!Epi::AFTER_DRAIN) { E(acc, cur, wr, wc, fr, fq); S.done(cur); }
        if (!has_next) break;
#pragma unroll
        for (int a = 0; a < 2; ++a)
#pragma unroll
            for (int b = 0; b < 2; ++b)
#pragma unroll
                for (int m = 0; m < 4; ++m)
#pragma unroll
                    for (int n = 0; n < 2; ++n) acc[a][b][m][n] = (f32x4){0.f, 0.f, 0.f, 0.f};
        cur = nxt; cA = nA; cB = nB; ++ui;
        if constexpr (ALIGN_EPI) { if (wr == 1) PG8_BAR; }
    }
    PG8_WAIT_V(0);
    if constexpr (!ALIGN_EPI) { if (wr == 0) PG8_BAR; }
    PG8_BAR;
    if constexpr (Epi::AFTER_DRAIN) { E.fused(acc, cur, wr, wc, fr, fq, lds, wid, lane); S.done(cur); }
#undef PG8_SA
#undef PG8_SB
#undef PG8_STAGE
#undef PG8_LDA
#undef PG8_LDB
#undef PG8_MMA
#undef PG8_WAIT_V
#undef PG8_WAIT_L
#undef PG8_BAR
#undef PG8_SCHED
}
}

__device__ __forceinline__ unsigned pkbf(float lo, float hi) { return pg8::cvt_pk_bf16(lo, hi); }
__device__ __forceinline__ void st8bf(bf16_t* p, f32x4 a, f32x4 b) { u32x4 w; w.x = pkbf(a[0], a[1]); w.y = pkbf(a[2], a[3]); w.z = pkbf(b[0], b[1]); w.w = pkbf(b[2], b[3]); *(u32x4*)p = w; }
__device__ __forceinline__ f32x4 bflo(u32x4 g) { f32x4 o; o[0] = __uint_as_float(g.x << 16); o[1] = __uint_as_float(g.x & 0xffff0000u); o[2] = __uint_as_float(g.y << 16); o[3] = __uint_as_float(g.y & 0xffff0000u); return o; }
__device__ __forceinline__ f32x4 bfhi(u32x4 g) { f32x4 o; o[0] = __uint_as_float(g.z << 16); o[1] = __uint_as_float(g.z & 0xffff0000u); o[2] = __uint_as_float(g.w << 16); o[3] = __uint_as_float(g.w & 0xffff0000u); return o; }
__device__ __forceinline__ void rot8(f32x4& a, f32x4& b, f32x4 c, f32x4 s) {
    const f32x4 x = a, y = b;
    a[0] = x[0] * c[0] - x[1] * s[0]; a[1] = x[1] * c[0] + x[0] * s[0]; a[2] = x[2] * c[1] - x[3] * s[1]; a[3] = x[3] * c[1] + x[2] * s[1];
    b[0] = y[0] * c[2] - y[1] * s[2]; b[1] = y[1] * c[2] + y[0] * s[2]; b[2] = y[2] * c[3] - y[3] * s[3]; b[3] = y[3] * c[3] + y[2] * s[3];
}
__device__ __forceinline__ f32x4 sig4(f32x4 v) { f32x4 o; o[0] = 1.f / (1.f + __expf(-v[0])); o[1] = 1.f / (1.f + __expf(-v[1])); o[2] = 1.f / (1.f + __expf(-v[2])); o[3] = 1.f / (1.f + __expf(-v[3])); return o; }
__host__ __device__ __forceinline__ int src_in(int n) {
    if (n < 1024) return n;
    if (n < 4096) { const int seg = (n - 1024) >> 10, c = (n - 1024) & 1023, d = c & 127; int od = d; if (seg < 2 && d < 32) od = (d >> 1) + (d & 1) * 16; return 1088 + seg * 1024 + (c & ~127) + od; }
    if (n < 5120) { const int c = n - 4096, d = c & 63; const int od = d < 16 ? (d >> 1) + (d & 1) * 8 : d; return 4160 + (c & ~63) + od; }
    if (n < 7168) return 5264 + (n - 5120);
    if (n < 9216) return 7312 + (n - 7168);
    if (n < 9280) { const int d = n - 9216; return 1024 + (d >> 1) + (d & 1) * 32; }
    if (n < 9344) { const int d = n - 9280; const int od = d < 16 ? (d >> 1) + (d & 1) * 8 : d; return 5184 + od; }
    if (n < 9360) return 5248 + (n - 9344);
    return -1;
}
__host__ __device__ __forceinline__ int src_qa(int n) { const int h = n / 192, d = n - h * 192; if (d < 128) return n; const int dd = d - 128; return h * 192 + 128 + (dd >> 1) + (dd & 1) * 32; }

struct EpiIn {
    static constexpr bool PERM = true, AFTER_DRAIN = false;
    unsigned char* ws;
    __device__ __forceinline__ void operator()(const f32x4 (&acc)[2][2][4][2], const pg8::Unit& u, int wr, int wc, int fr, int fq) const {
        const int row0 = u.pm * 256 + wr * 64 + fr, cu = wc * 32 + 8 * fq, pn = u.pn;
        bf16_t* const CQ = (bf16_t*)(ws + WS_CQ); bf16_t* const QB = (bf16_t*)(ws + WS_QB); bf16_t* const QI = (bf16_t*)(ws + WS_QI); bf16_t* const GA = (bf16_t*)(ws + WS_GA);
        bf16_t* const KA = (bf16_t*)(ws + WS_KA); bf16_t* const KI = (bf16_t*)(ws + WS_KI); float* const WI = (float*)(ws + WS_WI); float* const part = (float*)(ws + WS_SSQ);
        const float* const cM = (const float*)(ws + WS_ROPE); const float* const sM = cM + T * 32; const float* const cD = cM + T * 64; const float* const sD = cM + T * 80; const float* const cI = cM + T * 96; const float* const sI = cM + T * 104;
#define EPI_ROWS(BODY) _Pragma("unroll") for (int ai = 0; ai < 2; ++ai) _Pragma("unroll") for (int m = 0; m < 4; ++m) { const int t = row0 + ai * 128 + m * 16; \
            _Pragma("unroll") for (int bj = 0; bj < 2; ++bj) { f32x4 a = acc[ai][bj][m][0], b = acc[ai][bj][m][1]; BODY } }
        if (pn < 4) {
            bf16_t* const dst = CQ + (size_t)(pn >> 1) * ((size_t)T * 512) + (pn & 1) * 256 + cu;
            EPI_ROWS(
                st8bf(dst + (size_t)t * 512 + bj * 128, a, b);
                float sq = ((a[0] * a[0] + a[1] * a[1]) + (a[2] * a[2] + a[3] * a[3])) + ((b[0] * b[0] + b[1] * b[1]) + (b[2] * b[2] + b[3] * b[3]));
                sq += __shfl_xor(sq, 16); sq += __shfl_xor(sq, 32);
                if (fq == 0) part[(size_t)t * 32 + pn * 8 + bj * 4 + wc] = sq; )
        } else if (pn < 16) {
            const int seg = (pn - 4) >> 2; const bool rot = seg < 2 && wc == 0;
            bf16_t* const dst = QB + (size_t)seg * ((size_t)T * 1024) + ((pn - 4) & 3) * 256 + cu;
            EPI_ROWS(
                if (rot) rot8(a, b, *(const f32x4*)(cD + (size_t)t * 16 + 4 * fq), *(const f32x4*)(sD + (size_t)t * 16 + 4 * fq));
                st8bf(dst + (size_t)t * 1024 + bj * 128, a, b); )
        } else if (pn < 20) {
            const bool rot = (wc & 1) == 0 && fq < 2;
            bf16_t* const dst = QI + (pn - 16) * 256 + cu;
            EPI_ROWS(
                if (rot) rot8(a, b, *(const f32x4*)(cI + (size_t)t * 8 + 4 * fq), *(const f32x4*)(sI + (size_t)t * 8 + 4 * fq));
                st8bf(dst + (size_t)t * 1024 + bj * 128, a, b); )
        } else if (pn < 36) {
            bf16_t* const dst = GA + (size_t)((pn - 20) >> 3) * ((size_t)T * D) + ((pn - 20) & 7) * 256 + cu;
            EPI_ROWS( st8bf(dst + (size_t)t * D + bj * 128, sig4(a), sig4(b)); )
        } else {
            EPI_ROWS(
                if (bj == 0) {
                    if (wc < 2) {
                        rot8(a, b, *(const f32x4*)(cM + (size_t)t * 32 + (cu >> 1)), *(const f32x4*)(sM + (size_t)t * 32 + (cu >> 1)));
                        _Pragma("unroll") for (int h = 0; h < 8; ++h) st8bf(KA + (size_t)t * 1536 + h * 192 + 128 + cu, a, b);
                    } else {
                        const int d = cu - 64;
                        if (d < 16) rot8(a, b, *(const f32x4*)(cI + (size_t)t * 8 + (d >> 1)), *(const f32x4*)(sI + (size_t)t * 8 + (d >> 1)));
                        st8bf(KI + (size_t)t * 64 + d, a, b);
                    }
                } else if (cu < 16) {
                    *(f32x4*)(WI + (size_t)t * 16 + cu) = a * 0.03125f; *(f32x4*)(WI + (size_t)t * 16 + cu + 4) = b * 0.03125f;
                } )
        }
#undef EPI_ROWS
    }
};
__device__ __forceinline__ float rms_from_part(const float* pp) {
    const f32x4 p0 = *(const f32x4*)pp, p1 = *(const f32x4*)(pp + 4), p2 = *(const f32x4*)(pp + 8), p3 = *(const f32x4*)(pp + 12);
    const float s = (((p0[0] + p0[1]) + (p0[2] + p0[3])) + ((p1[0] + p1[1]) + (p1[2] + p1[3]))) + (((p2[0] + p2[1]) + (p2[2] + p2[3])) + ((p3[0] + p3[1]) + (p3[2] + p3[3])));
    return rsqrtf(s * (1.f / 512.f) + 1e-6f);
}
struct EpiQA {
    static constexpr bool PERM = true, AFTER_DRAIN = false;
    unsigned char* ws;
    __device__ __forceinline__ void operator()(const f32x4 (&acc)[2][2][4][2], const pg8::Unit& u, int wr, int wc, int fr, int fq) const {
        const int row0 = u.pm * 256 + wr * 64 + fr, cu = wc * 32 + 8 * fq;
        bf16_t* const QA = (bf16_t*)(ws + WS_QA); const float* const part = (const float*)(ws + WS_SSQ); const float* const cM = (const float*)(ws + WS_ROPE); const float* const sM = cM + T * 32;
#pragma unroll
        for (int ai = 0; ai < 2; ++ai)
#pragma unroll
            for (int m = 0; m < 4; ++m) {
                const int t = row0 + ai * 128 + m * 16;
                const float r = rms_from_part(part + (size_t)t * 32);
#pragma unroll
                for (int bj = 0; bj < 2; ++bj) {
                    const int n = u.pn * 256 + bj * 128 + cu, h = n / 192, d = n - h * 192;
                    f32x4 a = acc[ai][bj][m][0] * r, b = acc[ai][bj][m][1] * r;
                    if (d >= 128) rot8(a, b, *(const f32x4*)(cM + (size_t)t * 32 + ((d - 128) >> 1)), *(const f32x4*)(sM + (size_t)t * 32 + ((d - 128) >> 1)));
                    st8bf(QA + (size_t)t * 1536 + n, a, b);
                }
            }
    }
};
struct EpiKV {
    static constexpr bool PERM = true, AFTER_DRAIN = false;
    unsigned char* ws;
    __device__ __forceinline__ void operator()(const f32x4 (&acc)[2][2][4][2], const pg8::Unit& u, int wr, int wc, int fr, int fq) const {
        const int row0 = u.pm * 256 + wr * 64 + fr, cu = wc * 32 + 8 * fq;
        bf16_t* const KA = (bf16_t*)(ws + WS_KA); bf16_t* const VA = (bf16_t*)(ws + WS_VA); const float* const part = (const float*)(ws + WS_SSQ);
#pragma unroll
        for (int ai = 0; ai < 2; ++ai)
#pragma unroll
            for (int m = 0; m < 4; ++m) {
                const int t = row0 + ai * 128 + m * 16;
                const float r = rms_from_part(part + (size_t)t * 32 + 16);
                st8bf(KA + (size_t)t * 1536 + u.pn * 192 + cu, acc[ai][0][m][0] * r, acc[ai][0][m][1] * r);
                st8bf(VA + (size_t)t * 1024 + u.pn * 128 + cu, acc[ai][1][m][0] * r, acc[ai][1][m][1] * r);
            }
    }
};
struct EpiYA {
    static constexpr bool PERM = true, AFTER_DRAIN = false;
    unsigned char* ws;
    __device__ __forceinline__ void operator()(const f32x4 (&acc)[2][2][4][2], const pg8::Unit& u, int wr, int wc, int fr, int fq) const {
        const int row0 = u.pm * 256 + wr * 64 + fr, col0 = u.pn * 256 + wc * 32 + 8 * fq;
        float* const YT = (float*)(ws + WS_YT); const bf16_t* const GA = (const bf16_t*)(ws + WS_GA);
#pragma unroll
        for (int ai = 0; ai < 2; ++ai)
#pragma unroll
            for (int m = 0; m < 4; ++m)
#pragma unroll
                for (int bj = 0; bj < 2; ++bj) {
                    const size_t o = (size_t)(row0 + ai * 128 + m * 16) * D + col0 + bj * 128;
                    const u32x4 g = *(const u32x4*)(GA + o);
                    *(f32x4*)(YT + o) = acc[ai][bj][m][0] * bflo(g); *(f32x4*)(YT + o + 4) = acc[ai][bj][m][1] * bfhi(g);
                }
    }
};
struct EpiYB {
    static constexpr bool PERM = true, AFTER_DRAIN = false;
    unsigned char* ws;
    __device__ __forceinline__ void operator()(const f32x4 (&acc)[2][2][4][2], const pg8::Unit& u, int wr, int wc, int fr, int fq) const {
        const int row0 = u.pm * 256 + wr * 64 + fr, col0 = u.pn * 256 + wc * 32 + 8 * fq;
        const float* const YT = (const float*)(ws + WS_YT); const bf16_t* const GB = (const bf16_t*)(ws + WS_GB); bf16_t* const Y = (bf16_t*)(ws + WS_Y);
#pragma unroll
        for (int ai = 0; ai < 2; ++ai)
#pragma unroll
            for (int m = 0; m < 4; ++m)
#pragma unroll
                for (int bj = 0; bj < 2; ++bj) {
                    const size_t o = (size_t)(row0 + ai * 128 + m * 16) * D + col0 + bj * 128;
                    const u32x4 g = *(const u32x4*)(GB + o);
                    const f32x4 y0 = *(const f32x4*)(YT + o), y1 = *(const f32x4*)(YT + o + 4);
                    st8bf(Y + o, y0 + acc[ai][bj][m][0] * bflo(g), y1 + acc[ai][bj][m][1] * bfhi(g));
                }
    }
};
struct EpiOut {
    static constexpr bool PERM = true, AFTER_DRAIN = false;
    const float* hin; float* V1;
    __device__ __forceinline__ void operator()(const f32x4 (&acc)[2][2][4][2], const pg8::Unit& u, int wr, int wc, int fr, int fq) const {
        const int row0 = u.pm * 256 + wr * 64 + fr, col0 = u.pn * 256 + wc * 32 + 8 * fq;
#pragma unroll
        for (int ai = 0; ai < 2; ++ai)
#pragma unroll
            for (int m = 0; m < 4; ++m)
#pragma unroll
                for (int bj = 0; bj < 2; ++bj) {
                    const size_t o = (size_t)(row0 + ai * 128 + m * 16) * D + col0 + bj * 128;
                    const f32x4 h0 = *(const f32x4*)(hin + o), h1 = *(const f32x4*)(hin + o + 4);
                    *(f32x4*)(V1 + o) = h0 * ALPHA + acc[ai][bj][m][0]; *(f32x4*)(V1 + o + 4) = h1 * ALPHA + acc[ai][bj][m][1];
                }
    }
};

#define LDS_WAIT() asm volatile("s_waitcnt lgkmcnt(0)" ::: "memory")
template <int MAP>
__device__ __forceinline__ void transpose_item(const float* W, int ldw, int K, int N, const float* kscale, bf16_t* WT, LAS float* scr, int item, int lane) {
    const int nblk = N / 32, kb = item / nblk, nb = item % nblk, k0 = 64 * kb, n0 = 32 * nb;
    const int n = n0 + (lane & 31);
    const int sc = MAP == 0 ? n : (MAP == 1 ? src_in(n) : src_qa(n));
#pragma unroll 8
    for (int i = 0; i < 32; ++i) { const int kk = 2 * i + (lane >> 5);
        float v = sc >= 0 ? W[(size_t)(k0 + kk) * ldw + sc] : 0.f; if (kscale) v *= kscale[k0 + kk];
        scr[kk * 33 + (lane & 31)] = v; }
    LDS_WAIT(); asm volatile("" ::: "memory");
    const int c = lane & 7;
#pragma unroll
    for (int j = 0; j < 4; ++j) { const int nn = (lane >> 3) + 8 * j; const LAS float* sp = scr + (8 * c) * 33 + nn;
        u32x4 o; o.x = pkbf(sp[0 * 33], sp[1 * 33]); o.y = pkbf(sp[2 * 33], sp[3 * 33]); o.z = pkbf(sp[4 * 33], sp[5 * 33]); o.w = pkbf(sp[6 * 33], sp[7 * 33]);
        *(u32x4*)(WT + (size_t)(n0 + nn) * K + k0 + 8 * c) = o; }
    LDS_WAIT(); asm volatile("" ::: "memory");
}
__device__ __forceinline__ void p_prologue(LAS unsigned char* ldsb, const Params& p) {
    float* rope = (float*)(p.ws + WS_ROPE);
    float *cM = rope, *sM = rope + T * 32, *cD = rope + T * 64, *sD = rope + T * 80, *cI = rope + T * 96, *sI = rope + T * 104;
    const int gtid = blockIdx.x * NTHREADS + threadIdx.x, gstride = gridDim.x * NTHREADS;
    for (int idx = gtid; idx < T * 56; idx += gstride) {
        const int t = idx / 56, j = idx - t * 56;
        int rot, i; float *ct, *st; int w;
        if (j < 32) { rot = 64; i = j; ct = cM; st = sM; w = 32; } else if (j < 48) { rot = 32; i = j - 32; ct = cD; st = sD; w = 16; } else { rot = 16; i = j - 48; ct = cI; st = sI; w = 8; }
        const float inv = exp2f(-((float)(2 * i) / (float)rot) * 18.931568569324174f);
        const float ang = (float)p.pos[t] * inv;
        double rev = (double)ang * 0.15915494309189535; rev -= rint(rev);
        const float r = (float)(rev * 6.283185307179586);
        ct[t * w + i] = __cosf(r); st[t * w + i] = __sinf(r);
    }
    bf16_t* XB = (bf16_t*)(p.ws + WS_XB);
    for (size_t i = (size_t)gtid * 4; i < (size_t)T * D; i += (size_t)gstride * 4) st4bf(XB + i, *(const f32x4*)(p.x + i));
    const int wave = threadIdx.x >> 6, lane = threadIdx.x & 63;
    LAS float* scr = (LAS float*)(ldsb + wave * 16384);
    const int gw = blockIdx.x * 8 + wave, NGW = gridDim.x * 8;
    constexpr int I_IN = (D / 64) * (INP / 32), I_QB = (512 / 64) * (1536 / 32), I_KV = (512 / 64) * (2048 / 32), I_O = (1024 / 64) * (D / 32), I_OUT = (D / 64) * (D / 32);
    constexpr int I_LAYER = I_IN + I_QB + I_KV + 2 * I_O + I_OUT;
    for (int it = gw; it < DEPTH * I_LAYER; it += NGW) {
        const int l = it / I_LAYER; int r = it - l * I_LAYER;
        if (r < I_IN) { transpose_item<1>(p.w_in + (size_t)l * D * INW, INW, D, INP, nullptr, (bf16_t*)(p.ws + WS_WIN_T) + (size_t)l * INP * D, scr, r, lane); continue; } r -= I_IN;
        if (r < I_QB) { transpose_item<2>(p.w_qb + (size_t)l * 512 * 1536, 1536, 512, 1536, p.g_q + l * 512, (bf16_t*)(p.ws + WS_WQB_T) + (size_t)l * 1536 * 512, scr, r, lane); continue; } r -= I_QB;
        if (r < I_KV) { transpose_item<0>(p.w_kvb + (size_t)l * 512 * 2048, 2048, 512, 2048, p.g_kv + l * 512, (bf16_t*)(p.ws + WS_WKVB_T) + (size_t)l * 2048 * 512, scr, r, lane); continue; } r -= I_KV;
        if (r < I_O) { transpose_item<0>(p.w_oa + (size_t)l * 1024 * D, D, 1024, D, nullptr, (bf16_t*)(p.ws + WS_WOA_T) + (size_t)l * D * 1024, scr, r, lane); continue; } r -= I_O;
        if (r < I_O) { transpose_item<0>(p.w_ob + (size_t)l * 1024 * D, D, 1024, D, nullptr, (bf16_t*)(p.ws + WS_WOB_T) + (size_t)l * D * 1024, scr, r, lane); continue; } r -= I_O;
        transpose_item<0>(p.w_out + (size_t)l * D * D, D, D, D, nullptr, (bf16_t*)(p.ws + WS_WOUT_T) + (size_t)l * D * D, scr, r, lane);
    }
    __syncthreads();
}

__device__ __forceinline__ unsigned f2key(float f) { const unsigned u = __float_as_uint(f); return (u & 0x80000000u) ? ~u : (u | 0x80000000u); }
__device__ __forceinline__ void p_index(float* lds, const Params& p) {
    const bf16_t* QI = (const bf16_t*)(p.ws + WS_QI); const bf16_t* KI = (const bf16_t*)(p.ws + WS_KI); const float* WI = (const float*)(p.ws + WS_WI);
    unsigned* MASK = (unsigned*)(p.ws + WS_MASK);
    float* qs = lds; float* wsc = lds + 1024; float* sc = lds + 1040; int* red = (int*)(lds + 1040 + 4096);
    const int tid = opaque_tid(), lane = tid & 63, wv = tid >> 6;
    for (int t = blockIdx.x; t < T; t += gridDim.x) {
        const int b = t >> 12, ti = t & 4095, nk = ti + 1;
        __syncthreads();
        for (int i = tid; i < 1024; i += NTHREADS) qs[i] = bf2f(QI[(size_t)t * 1024 + i]);
        if (tid < 16) wsc[tid] = WI[(size_t)t * 16 + tid];
        __syncthreads();
        for (int s = tid; s < nk; s += NTHREADS) {
            const bf16_t* kr = KI + (size_t)(b * S + s) * 64;
            float score = 0.f;
#pragma unroll 1
            for (int h = 0; h < 16; ++h) {
                asm volatile("" ::: "memory");
                float dot = 0.f;
#pragma unroll
                for (int c = 0; c < 8; ++c) {
                    const u32x4 raw = *(const u32x4*)(kr + c * 8);
                    const f32x4 q0 = *(const f32x4*)(qs + h * 64 + c * 8), q1 = *(const f32x4*)(qs + h * 64 + c * 8 + 4);
                    dot = fmaf(q0[0], __uint_as_float(raw.x << 16), dot); dot = fmaf(q0[1], __uint_as_float(raw.x & 0xffff0000u), dot);
                    dot = fmaf(q0[2], __uint_as_float(raw.y << 16), dot); dot = fmaf(q0[3], __uint_as_float(raw.y & 0xffff0000u), dot);
                    dot = fmaf(q1[0], __uint_as_float(raw.z << 16), dot); dot = fmaf(q1[1], __uint_as_float(raw.z & 0xffff0000u), dot);
                    dot = fmaf(q1[2], __uint_as_float(raw.w << 16), dot); dot = fmaf(q1[3], __uint_as_float(raw.w & 0xffff0000u), dot);
                }
                score = fmaf(wsc[h], fmaxf(dot, 0.f), score);
            }
            sc[s] = score;
        }
        __syncthreads();
        unsigned k0 = 0u, k1 = 0u, k2 = 0u, k3 = 0u, k4 = 0u, k5 = 0u, k6 = 0u, k7 = 0u;
        if (tid < nk) k0 = f2key(sc[tid]);
        if (tid + 512 < nk) k1 = f2key(sc[tid + 512]);
        if (tid + 1024 < nk) k2 = f2key(sc[tid + 1024]);
        if (tid + 1536 < nk) k3 = f2key(sc[tid + 1536]);
        if (tid + 2048 < nk) k4 = f2key(sc[tid + 2048]);
        if (tid + 2560 < nk) k5 = f2key(sc[tid + 2560]);
        if (tid + 3072 < nk) k6 = f2key(sc[tid + 3072]);
        if (tid + 3584 < nk) k7 = f2key(sc[tid + 3584]);
        unsigned res = 0u;
        if (nk > 256) {
#pragma unroll 1
            for (int bit = 31; bit >= 0; --bit) {
                const unsigned cand = res | (1u << bit);
                const int c = (k0 >= cand) + (k1 >= cand) + (k2 >= cand) + (k3 >= cand) + (k4 >= cand) + (k5 >= cand) + (k6 >= cand) + (k7 >= cand);
                if (block_sum_int(c, red) >= 256) res = cand;
            }
        }
        unsigned* mw = MASK + (size_t)t * 128 + 2 * wv;
#define MASK_OUT(j, kj) do { const unsigned long long bal = __ballot((tid + 512 * (j) < nk) && ((kj) >= res)); if (lane == 0) { mw[16 * (j)] = (unsigned)bal; mw[16 * (j) + 1] = (unsigned)(bal >> 32); } } while (0)
        MASK_OUT(0, k0); MASK_OUT(1, k1); MASK_OUT(2, k2); MASK_OUT(3, k3); MASK_OUT(4, k4); MASK_OUT(5, k5); MASK_OUT(6, k6); MASK_OUT(7, k7);
#undef MASK_OUT
    }
    __syncthreads();
}

typedef short bf16x8 __attribute__((ext_vector_type(8)));
typedef short s16x4 __attribute__((ext_vector_type(4)));
typedef float f32x16 __attribute__((ext_vector_type(16)));
__device__ __forceinline__ void p_score(LAS unsigned char* ldsb, unsigned char* ws) {
    const bf16_t* QI = (const bf16_t*)(ws + WS_QI); const bf16_t* KI = (const bf16_t*)(ws + WS_KI); const float* WI = (const float*)(ws + WS_WI);
    unsigned* SC = (unsigned*)(ws + WS_SCORE);
    const int tid = opaque_tid(), lane = tid & 63, wv = __builtin_amdgcn_readfirstlane(tid >> 6), r32 = lane & 31, hi = lane >> 5;
    const int ksw = ((r32 >> 1) & 7) ^ hi;
    const unsigned krow = (unsigned)(size_t)ldsb + (unsigned)r32 * 128u;
    for (int item = blockIdx.x; item < 544; item += gridDim.x) {
        const int b = item / 272; int r = item - b * 272, qb = 0;
        while (r >= 2 * qb + 2) { r -= 2 * qb + 2; ++qb; }
        const int kc = r, q0 = qb * 256 + wv * 32;
        __builtin_amdgcn_s_barrier();
#pragma unroll
        for (int i = 0; i < 2; ++i) { const int g = i * 512 + tid, row = g >> 3, ch = (g & 7) ^ ((row >> 1) & 7);
            __builtin_amdgcn_global_load_lds((const unsigned*)(KI + (size_t)(b * S + kc * 128 + row) * 64 + ch * 8), (LAS unsigned*)(ldsb + (i * 512 + wv * 64) * 16), 16, 0, 0); }
        asm volatile("s_waitcnt vmcnt(0)" ::: "memory");
        __builtin_amdgcn_s_barrier();
        if (kc * 128 <= q0 + 31) {
            const size_t t = (size_t)b * S + q0 + r32;
            bf16x8 ka[4][4];
#pragma unroll
            for (int kb = 0; kb < 4; ++kb)
#pragma unroll
                for (int d0 = 0; d0 < 4; ++d0) ka[kb][d0] = *(const LAS bf16x8*)(size_t)(krow + kb * 4096 + ((unsigned)((2 * d0) ^ ksw) << 4));
            f32x16 acc[4];
#pragma unroll
            for (int kb = 0; kb < 4; ++kb)
#pragma unroll
                for (int rr = 0; rr < 16; ++rr) acc[kb][rr] = 0.f;
            const bf16_t* qrow = QI + t * 1024 + 8 * hi; const float* wrow = WI + t * 16;
            bf16x8 qf[4]; float wh = wrow[0];
#pragma unroll
            for (int d0 = 0; d0 < 4; ++d0) qf[d0] = *(const bf16x8*)(qrow + 16 * d0);
#pragma unroll 1
            for (int h = 0; h < 16; ++h) {
                const int hn = (h + 1) & 15;
                bf16x8 qn[4]; const float wn = wrow[hn];
#pragma unroll
                for (int d0 = 0; d0 < 4; ++d0) qn[d0] = *(const bf16x8*)(qrow + hn * 64 + 16 * d0);
#pragma unroll
                for (int kb = 0; kb < 4; ++kb) {
                    f32x16 pz;
#pragma unroll
                    for (int rr = 0; rr < 16; ++rr) pz[rr] = 0.f;
#pragma unroll
                    for (int d0 = 0; d0 < 4; ++d0) pz = __builtin_amdgcn_mfma_f32_32x32x16_bf16(ka[kb][d0], qf[d0], pz, 0, 0, 0);
#pragma unroll
                    for (int rr = 0; rr < 16; ++rr) acc[kb][rr] = fmaf(wh, fmaxf(pz[rr], 0.f), acc[kb][rr]);
                }
#pragma unroll
                for (int d0 = 0; d0 < 4; ++d0) qf[d0] = qn[d0];
                wh = wn;
            }
            const int dq = q0 + r32 - kc * 128 - 4 * hi;
            unsigned* srow = SC + t * 4096 + kc * 128 + 4 * hi;
#pragma unroll
            for (int kb = 0; kb < 4; ++kb)
#pragma unroll
                for (int rq = 0; rq < 4; ++rq) { u32x4 o; const int c0 = 32 * kb + 8 * rq;
                    o.x = (c0 <= dq) ? f2key(acc[kb][4 * rq]) : 0u; o.y = (c0 + 1 <= dq) ? f2key(acc[kb][4 * rq + 1]) : 0u;
                    o.z = (c0 + 2 <= dq) ? f2key(acc[kb][4 * rq + 2]) : 0u; o.w = (c0 + 3 <= dq) ? f2key(acc[kb][4 * rq + 3]) : 0u;
                    *(u32x4*)(srow + c0) = o; }
        }
    }
    __builtin_amdgcn_s_barrier();
}
__device__ __forceinline__ void p_select(unsigned char* ws) {
    const unsigned* SC = (const unsigned*)(ws + WS_SCORE); unsigned* MASK = (unsigned*)(ws + WS_MASK);
    const int tid = opaque_tid(), lane = tid & 63, wv = tid >> 6;
    for (int t = blockIdx.x * 8 + wv; t < T; t += gridDim.x * 8) {
        const int ti = t & 4095, nq = (ti >> 8) + 1;
        const unsigned* row = SC + (size_t)t * 4096 + 4 * lane;
        u32x4 k[16];
#pragma unroll
        for (int j = 0; j < 16; ++j) { k[j] = (u32x4){0u, 0u, 0u, 0u};
            if (j < nq) { k[j] = *(const u32x4*)(row + 256 * j);
                const int p0 = 256 * j + 4 * lane; if (p0 > ti) k[j].x = 0u; if (p0 + 1 > ti) k[j].y = 0u; if (p0 + 2 > ti) k[j].z = 0u; if (p0 + 3 > ti) k[j].w = 0u; } }
        unsigned res = 1u;
        if (ti >= 256) {
            res = 0u;
#pragma unroll 1
            for (int bit = 31; bit >= 0; --bit) {
                const unsigned cand = res | (1u << bit);
                int c = 0;
#pragma unroll
                for (int j = 0; j < 16; ++j) c += (int)(k[j].x >= cand) + (int)(k[j].y >= cand) + (int)(k[j].z >= cand) + (int)(k[j].w >= cand);
#pragma unroll
                for (int o = 32; o >= 1; o >>= 1) c += __shfl_xor(c, o);
                if (c >= 256) res = cand;
            }
        }
        unsigned* mrow = MASK + (size_t)t * 128 + (lane >> 3);
#pragma unroll
        for (int j = 0; j < 16; ++j) {
            unsigned nib = (unsigned)(k[j].x >= res) | ((unsigned)(k[j].y >= res) << 1) | ((unsigned)(k[j].z >= res) << 2) | ((unsigned)(k[j].w >= res) << 3);
            nib <<= 4 * (lane & 7);
            nib |= __shfl_xor(nib, 1); nib |= __shfl_xor(nib, 2); nib |= __shfl_xor(nib, 4);
            if ((lane & 7) == 0) mrow[8 * j] = nib;
        }
    }
}

template <int DQK, bool MASKED>
__device__ __forceinline__ void attn_unit(LAS unsigned char* ldsb, const bf16_t* Qg, int ldq, const bf16_t* Kg, int ldk, const bf16_t* Vg, int ldv, const unsigned* maskg, bf16_t* Og, int ldo, int qb, float sl2) {
    constexpr int CPR = DQK / 8, KBYTES = 64 * DQK * 2, VBYTES = 64 * 128 * 2, NKI = CPR * 64 / 512, ND = DQK / 16;
    constexpr int VOFF = 2 * KBYTES;
    const int tid = opaque_tid(), lane = tid & 63, wv = __builtin_amdgcn_readfirstlane(tid >> 6), r32 = lane & 31, hi = lane >> 5;
    const int NT = 4 * qb + 4, q0 = qb * 256 + wv * 32;
    const float NEG = -__builtin_inff();
    bf16x8 qr[ND];
#pragma unroll
    for (int d0 = 0; d0 < ND; ++d0) qr[d0] = *(const bf16x8*)(Qg + (size_t)(q0 + r32) * ldq + 16 * d0 + 8 * hi);
    const bf16_t* ksrc[NKI]; const bf16_t* vsrc[2];
#pragma unroll
    for (int i = 0; i < NKI; ++i) { const int g = i * 512 + tid, row = g / CPR, cp = g - row * CPR; const int ch = cp ^ (DQK == 128 ? (row & 15) : ((row >> 1) & 7)); ksrc[i] = Kg + (size_t)row * ldk + ch * 8; }
#pragma unroll
    for (int i = 0; i < 2; ++i) { const int g = i * 512 + tid, row = g >> 4, c16 = g & 15; const int blk = (c16 >> 2) ^ (row & 3); vsrc[i] = Vg + (size_t)row * ldv + (blk * 4 + (c16 & 3)) * 8; }
#define AT_STAGE(t_, buf_) do { \
        _Pragma("unroll") for (int i_ = 0; i_ < NKI; ++i_) __builtin_amdgcn_global_load_lds((const unsigned*)(ksrc[i_] + (size_t)(t_) * 64 * ldk), (LAS unsigned*)(ldsb + (buf_) * KBYTES + (i_ * 512 + wv * 64) * 16), 16, 0, 0); \
        _Pragma("unroll") for (int i_ = 0; i_ < 2; ++i_) __builtin_amdgcn_global_load_lds((const unsigned*)(vsrc[i_] + (size_t)(t_) * 64 * ldv), (LAS unsigned*)(ldsb + VOFF + (buf_) * VBYTES + (i_ * 512 + wv * 64) * 16), 16, 0, 0); } while (0)
    const int ksw = (DQK == 128 ? (r32 & 15) : ((r32 >> 1) & 7)) ^ hi;
    const unsigned krow = (unsigned)(size_t)ldsb + (unsigned)r32 * (DQK * 2);
    const int vq = (lane >> 2) & 3, vp = lane & 3, vg = lane >> 4;
    const unsigned vrow = (unsigned)(size_t)ldsb + VOFF + (unsigned)(4 * (vg >> 1) + vq) * 256 + (vg & 1) * 32 + vp * 8;
    float m_run = -1e30f, l_run = 0.f;
    f32x16 oT[4];
#pragma unroll
    for (int d0 = 0; d0 < 4; ++d0)
#pragma unroll
        for (int r = 0; r < 16; ++r) oT[d0][r] = 0.f;
    u32x2 mw_cur = {0u, 0u}, mw_nxt = {0u, 0u};
    const unsigned* mrow = MASKED ? maskg + (size_t)(q0 + r32) * 128 : nullptr;
    if (MASKED) mw_cur = *(const u32x2*)mrow;
    AT_STAGE(0, 0);
    asm volatile("s_waitcnt vmcnt(0)" ::: "memory");
    __builtin_amdgcn_s_barrier();
#define TRRD(dst, addr, off) asm volatile("ds_read_b64_tr_b16 %0, %1 offset:%2" : "=&v"(dst) : "v"(addr), "i"(off) : "memory")
#define AT_STEP(t_, buf_) do { \
        const int t = (t_); \
        if (t + 1 < NT) { if (MASKED) mw_nxt = *(const u32x2*)(mrow + 2 * (t + 1)); AT_STAGE(t + 1, (buf_) ^ 1); } \
        if (t * 64 <= q0 + 31) {                                    \
            int kx = ksw; asm volatile("" : "+v"(kx)); \
            f32x16 p0, p1; \
            _Pragma("unroll") for (int r = 0; r < 16; ++r) { p0[r] = 0.f; p1[r] = 0.f; } \
            _Pragma("unroll") for (int d0 = 0; d0 < ND; ++d0) { \
                const unsigned ka = krow + (buf_) * KBYTES + ((unsigned)((2 * d0) ^ kx) << 4); \
                const bf16x8 a0 = *(const LAS bf16x8*)(size_t)ka; const bf16x8 a1 = *(const LAS bf16x8*)(size_t)(ka + 32 * DQK * 2); \
                p0 = __builtin_amdgcn_mfma_f32_32x32x16_bf16(a0, qr[d0], p0, 0, 0, 0); \
                p1 = __builtin_amdgcn_mfma_f32_32x32x16_bf16(a1, qr[d0], p1, 0, 0, 0); } \
            if (MASKED) { \
                _Pragma("unroll") for (int r = 0; r < 16; ++r) { const int c = (r & 3) + 8 * (r >> 2) + 4 * hi; \
                    if (!((mw_cur.x >> c) & 1u)) p0[r] = NEG; if (!((mw_cur.y >> c) & 1u)) p1[r] = NEG; } \
            } else if (t * 64 + 63 > q0) {                          \
                const int dq = q0 + r32 - t * 64 - 4 * hi; \
                _Pragma("unroll") for (int r = 0; r < 16; ++r) { const int c = (r & 3) + 8 * (r >> 2); if (c > dq) p0[r] = NEG; if (c + 32 > dq) p1[r] = NEG; } \
            } \
            float mx = p0[0]; \
            _Pragma("unroll") for (int r = 1; r < 16; ++r) mx = fmaxf(mx, p0[r]); \
            _Pragma("unroll") for (int r = 0; r < 16; ++r) mx = fmaxf(mx, p1[r]); \
            { auto rr = __builtin_amdgcn_permlane32_swap(__float_as_uint(mx), __float_as_uint(mx), false, false); mx = fmaxf(__uint_as_float(rr[0]), __uint_as_float(rr[1])); } \
            const float mnew = fmaxf(m_run, mx); \
            const float alpha = __builtin_amdgcn_exp2f((m_run - mnew) * sl2); \
            m_run = mnew; const float mb = -mnew * sl2; \
            float ps = 0.f; \
            _Pragma("unroll") for (int r = 0; r < 16; ++r) { p0[r] = __builtin_amdgcn_exp2f(fmaf(p0[r], sl2, mb)); ps += p0[r]; } \
            _Pragma("unroll") for (int r = 0; r < 16; ++r) { p1[r] = __builtin_amdgcn_exp2f(fmaf(p1[r], sl2, mb)); ps += p1[r]; } \
            l_run = l_run * alpha + ps; \
            if (__any(alpha != 1.f)) { \
                _Pragma("unroll") for (int d0 = 0; d0 < 4; ++d0) _Pragma("unroll") for (int r = 0; r < 16; ++r) oT[d0][r] *= alpha; } \
            bf16x8 pb[4];                                            \
            { u32x4 w; \
              w.x = pkbf(p0[0], p0[1]); w.y = pkbf(p0[2], p0[3]); w.z = pkbf(p0[4], p0[5]); w.w = pkbf(p0[6], p0[7]); pb[0] = *reinterpret_cast<bf16x8*>(&w); \
              w.x = pkbf(p0[8], p0[9]); w.y = pkbf(p0[10], p0[11]); w.z = pkbf(p0[12], p0[13]); w.w = pkbf(p0[14], p0[15]); pb[1] = *reinterpret_cast<bf16x8*>(&w); \
              w.x = pkbf(p1[0], p1[1]); w.y = pkbf(p1[2], p1[3]); w.z = pkbf(p1[4], p1[5]); w.w = pkbf(p1[6], p1[7]); pb[2] = *reinterpret_cast<bf16x8*>(&w); \
              w.x = pkbf(p1[8], p1[9]); w.y = pkbf(p1[10], p1[11]); w.z = pkbf(p1[12], p1[13]); w.w = pkbf(p1[14], p1[15]); pb[3] = *reinterpret_cast<bf16x8*>(&w); } \
            int vx = vq; asm volatile("" : "+v"(vx)); \
            _Pragma("unroll") for (int d0 = 0; d0 < 4; ++d0) { \
                const unsigned va = vrow + (buf_) * VBYTES + ((unsigned)(d0 ^ vx) << 6); \
                s16x4 l0, h0, l1, h1, l2, h2, l3, h3; \
                TRRD(l0, va, 0); TRRD(h0, va, 2048); TRRD(l1, va, 4096); TRRD(h1, va, 6144); TRRD(l2, va, 8192); TRRD(h2, va, 10240); TRRD(l3, va, 12288); TRRD(h3, va, 14336); \
                asm volatile("s_waitcnt lgkmcnt(0)" ::: "memory"); __builtin_amdgcn_sched_barrier(0); \
                oT[d0] = __builtin_amdgcn_mfma_f32_32x32x16_bf16((bf16x8){l0[0], l0[1], l0[2], l0[3], h0[0], h0[1], h0[2], h0[3]}, pb[0], oT[d0], 0, 0, 0); \
                oT[d0] = __builtin_amdgcn_mfma_f32_32x32x16_bf16((bf16x8){l1[0], l1[1], l1[2], l1[3], h1[0], h1[1], h1[2], h1[3]}, pb[1], oT[d0], 0, 0, 0); \
                oT[d0] = __builtin_amdgcn_mfma_f32_32x32x16_bf16((bf16x8){l2[0], l2[1], l2[2], l2[3], h2[0], h2[1], h2[2], h2[3]}, pb[2], oT[d0], 0, 0, 0); \
                oT[d0] = __builtin_amdgcn_mfma_f32_32x32x16_bf16((bf16x8){l3[0], l3[1], l3[2], l3[3], h3[0], h3[1], h3[2], h3[3]}, pb[3], oT[d0], 0, 0, 0); } \
        } \
        if (MASKED) mw_cur = mw_nxt; \
        asm volatile("s_waitcnt vmcnt(0)" ::: "memory"); \
        asm volatile("s_waitcnt lgkmcnt(0)" ::: "memory"); \
        __builtin_amdgcn_s_barrier(); } while (0)
    for (int tt = 0; tt < NT; tt += 2) { AT_STEP(tt, 0); AT_STEP(tt + 1, 1); }
#undef AT_STEP
#undef AT_STAGE
#undef TRRD
    { auto rr = __builtin_amdgcn_permlane32_swap(__float_as_uint(l_run), __float_as_uint(l_run), false, false); l_run = __uint_as_float(rr[0]) + __uint_as_float(rr[1]); }
    const float inv = 1.f / l_run;
    bf16_t* orow = Og + (size_t)(q0 + r32) * ldo + 4 * hi;
#pragma unroll
    for (int d0 = 0; d0 < 4; ++d0)
#pragma unroll
        for (int rq = 0; rq < 4; ++rq) { u32x2 w; w.x = pkbf(oT[d0][4 * rq] * inv, oT[d0][4 * rq + 1] * inv); w.y = pkbf(oT[d0][4 * rq + 2] * inv, oT[d0][4 * rq + 3] * inv);
            *(u32x2*)(orow + 32 * d0 + 8 * rq) = w; }
}
__device__ __forceinline__ void p_attn(LAS unsigned char* ldsb, unsigned char* ws) {
    const bf16_t* QA = (const bf16_t*)(ws + WS_QA); const bf16_t* KA = (const bf16_t*)(ws + WS_KA); const bf16_t* VA = (const bf16_t*)(ws + WS_VA); bf16_t* OA = (bf16_t*)(ws + WS_OA);
    const bf16_t* QB = (const bf16_t*)(ws + WS_QB); const bf16_t* KB = (const bf16_t*)(ws + WS_KB); const bf16_t* VB = (const bf16_t*)(ws + WS_VB); bf16_t* OB = (bf16_t*)(ws + WS_OB);
    const unsigned* MASK = (const unsigned*)(ws + WS_MASK);
    for (int w = blockIdx.x; w < 256; w += gridDim.x) {
        const int bh = (w & 7) * 2 + ((w >> 3) & 1), i = w >> 4, b = bh >> 3, h = bh & 7;
        const size_t r0 = (size_t)b * S;
        attn_unit<192, false>(ldsb, QA + r0 * 1536 + h * 192, 1536, KA + r0 * 1536 + h * 192, 1536, VA + r0 * 1024 + h * 128, 1024, nullptr, OA + r0 * 1024 + h * 128, 1024, i, 0.07216878364870322f * 1.4426950408889634f);
        attn_unit<128, true>(ldsb, QB + r0 * 1024 + h * 128, 1024, KB + r0 * 1024 + h * 128, 1024, VB + r0 * 1024 + h * 128, 1024, MASK + r0 * 128, OB + r0 * 1024 + h * 128, 1024, 15 - i, 0.08838834764831845f * 1.4426950408889634f);
    }
}

template <int DQK, bool MASKED>
__device__ __forceinline__ void nattn(float* lds, const bf16_t* Q, const bf16_t* Kp, int ldk, const bf16_t* Vp, const unsigned* mask, bf16_t* O, float scale) {
    float* qs = lds; float* scb = lds + 8 * 192;
    const int tid = opaque_tid(), lane = tid & 63, h = tid >> 6;
    float* sc = scb + h * 4096;
    for (int t = blockIdx.x; t < T; t += gridDim.x) {
        const int b = t >> 12, ti = t & 4095, nk = ti + 1;
        __syncthreads();
        for (int i = tid; i < 8 * DQK; i += NTHREADS) qs[i] = bf2f(Q[(size_t)t * (8 * DQK) + i]);
        __syncthreads();
        const float* q = qs + h * DQK;
        float mx = -__builtin_inff();
        for (int s0 = 0; s0 < nk; s0 += 64) {
            const int s = s0 + lane; float v = -__builtin_inff();
            bool on = s < nk;
            if (MASKED && on) on = (mask[(size_t)t * 128 + (s >> 5)] >> (s & 31)) & 1u;
            if (on) {
                const bf16_t* kr = Kp + (size_t)(b * S + s) * ldk + h * DQK;
                float dot = 0.f;
#pragma unroll 4
                for (int c = 0; c < DQK / 8; ++c) { const u32x4 raw = *(const u32x4*)(kr + c * 8); const unsigned w[4] = {raw.x, raw.y, raw.z, raw.w};
#pragma unroll
                    for (int j = 0; j < 4; ++j) { dot = fmaf(q[c * 8 + 2 * j], __uint_as_float(w[j] << 16), dot); dot = fmaf(q[c * 8 + 2 * j + 1], __uint_as_float(w[j] & 0xffff0000u), dot); } }
                v = dot * scale;
            }
            if (s < nk) sc[s] = v;
            mx = fmaxf(mx, v);
        }
        mx = wave_max(mx);
        __syncthreads();
        float sum = 0.f;
        for (int s = lane; s < nk; s += 64) { const float pz = __expf(sc[s] - mx); sc[s] = pz; sum += pz; }
        sum = wave_sum(sum);
        __syncthreads();
        float a0 = 0.f, a1 = 0.f;
        const bf16_t* vb = Vp + (size_t)(b * S) * 1024 + h * 128 + lane * 2;
        for (int s = 0; s < nk; ++s) {
            const float pz = sc[s];
            if (pz != 0.f) { const unsigned w = *(const unsigned*)(vb + (size_t)s * 1024); a0 = fmaf(pz, __uint_as_float(w << 16), a0); a1 = fmaf(pz, __uint_as_float(w & 0xffff0000u), a1); }
        }
        const float inv = 1.f / sum;
        *(unsigned*)(O + (size_t)t * 1024 + h * 128 + lane * 2) = pk2(a0 * inv, a1 * inv);
    }
    __syncthreads();
}

__device__ __forceinline__ void p_ln1_route(float* lds, const Params& p, int l) {
    const float* V1 = (const float*)(p.ws + WS_V1); float* H1F = (float*)(p.ws + WS_H1F); bf16_t* H1B = (bf16_t*)(p.ws + WS_H1B);
    unsigned* cnt = (unsigned*)(p.ws + WS_CNT) + l * 64; int* LIST = (int*)(p.ws + WS_LIST);
    int* TOKE = (int*)(p.ws + WS_TOKE); float* TOKW = (float*)(p.ws + WS_TOKW); int* TOKS = (int*)(p.ws + WS_TOKS);
    const float* g = p.ln1g + (size_t)l * D; const float* bb = p.ln1b + (size_t)l * D;
    const float* wr = p.w_router + (size_t)l * D * 64; const float* wg = p.w_group + (size_t)l * D * 8;
    const float* br = p.b_router + l * 64; const float* bg = p.b_group + l * 8;
    const int tid = opaque_tid(), lane = tid & 63, wv = tid >> 6;
    float* lg = lds + wv * 80;
    for (int t0 = blockIdx.x * 8; t0 < T; t0 += gridDim.x * 8) {
        const int t = t0 + wv;
        float s1 = 0.f;
#pragma unroll 4
        for (int j = 0; j < 32; ++j) s1 += V1[(size_t)t * D + lane + 64 * j];
        const float mean = wave_sum(s1) * (1.f / D);
        float s2 = 0.f;
#pragma unroll 4
        for (int j = 0; j < 32; ++j) { const float d = V1[(size_t)t * D + lane + 64 * j] - mean; s2 += d * d; }
        const float rstd = rsqrtf(wave_sum(s2) * (1.f / D) + 1e-5f);
        float acc[72];
#pragma unroll
        for (int e = 0; e < 72; ++e) acc[e] = 0.f;
#pragma unroll 1
        for (int j = 0; j < 32; ++j) {
            const int k = lane + 64 * j;
            const float hk = (V1[(size_t)t * D + k] - mean) * rstd * g[k] + bb[k];
            H1F[(size_t)t * D + k] = hk; H1B[(size_t)t * D + k] = f2bf(hk);
            const float* wrow = wr + (size_t)k * 64;
#pragma unroll
            for (int e4 = 0; e4 < 16; ++e4) { const f32x4 w = *(const f32x4*)(wrow + e4 * 4);
                acc[e4 * 4] = fmaf(hk, w[0], acc[e4 * 4]); acc[e4 * 4 + 1] = fmaf(hk, w[1], acc[e4 * 4 + 1]); acc[e4 * 4 + 2] = fmaf(hk, w[2], acc[e4 * 4 + 2]); acc[e4 * 4 + 3] = fmaf(hk, w[3], acc[e4 * 4 + 3]); }
            const float* grow = wg + (size_t)k * 8;
            const f32x4 w0 = *(const f32x4*)grow, w1 = *(const f32x4*)(grow + 4);
            acc[64] = fmaf(hk, w0[0], acc[64]); acc[65] = fmaf(hk, w0[1], acc[65]); acc[66] = fmaf(hk, w0[2], acc[66]); acc[67] = fmaf(hk, w0[3], acc[67]);
            acc[68] = fmaf(hk, w1[0], acc[68]); acc[69] = fmaf(hk, w1[1], acc[69]); acc[70] = fmaf(hk, w1[2], acc[70]); acc[71] = fmaf(hk, w1[3], acc[71]);
        }
#pragma unroll
        for (int e = 0; e < 72; ++e) { const float r = wave_sum(acc[e]); if (lane == 0) lg[e] = r; }
        __syncthreads();
        if (lane == 0) {
            float gl[8]; float gmax = -__builtin_inff(); int gi = 0;
#pragma unroll
            for (int i = 0; i < 8; ++i) { gl[i] = lg[64 + i] + bg[i]; if (gl[i] > gmax) { gmax = gl[i]; gi = i; } }
            float gs = 0.f;
#pragma unroll
            for (int i = 0; i < 8; ++i) gs += __expf(gl[i] - gmax);
            const float gp = 1.f / gs;
            float el[8]; float emax = -__builtin_inff(); int e1 = 0;
#pragma unroll
            for (int i = 0; i < 8; ++i) { el[i] = lg[gi * 8 + i] + br[gi * 8 + i]; if (el[i] > emax) { emax = el[i]; e1 = i; } }
            float e2max = -__builtin_inff(); int e2 = 0;
#pragma unroll
            for (int i = 0; i < 8; ++i) { if (i != e1 && el[i] > e2max) { e2max = el[i]; e2 = i; } }
            const float p1 = 1.f, p2 = __expf(e2max - emax);
            const float wa = gp * p1 / (p1 + p2), wb = gp * p2 / (p1 + p2);
            const int ea = gi * 8 + e1, eb = gi * 8 + e2;
            const int sa = (int)atomicAdd(cnt + ea, 1u), sb = (int)atomicAdd(cnt + eb, 1u);
            LIST[(size_t)ea * ECAP + sa] = t; LIST[(size_t)eb * ECAP + sb] = t;
            TOKE[t * 2] = ea; TOKE[t * 2 + 1] = eb; TOKW[t * 2] = wa; TOKW[t * 2 + 1] = wb; TOKS[t * 2] = sa; TOKS[t * 2 + 1] = sb;
        }
        __syncthreads();
    }
}

__device__ __forceinline__ void moe_tables(int* tab, const unsigned* cnt, int items_per_rb) {
    if (threadIdx.x == 0) { int a = 0, bsum = 0; for (int e = 0; e < 64; ++e) { tab[e] = a; tab[80 + e] = bsum; const int c = (int)cnt[e]; a += ((c + 127) / 128) * items_per_rb; bsum += ((c + 255) / 256) * 256; } tab[64] = a; tab[80 + 64] = bsum; }
    __syncthreads();
}
__device__ __forceinline__ void p_moe1(float* lds, const Params& p, int l) {
    const unsigned* cnt = (const unsigned*)(p.ws + WS_CNT) + l * 64; const int* LIST = (const int*)(p.ws + WS_LIST);
    const bf16_t* H1B = (const bf16_t*)(p.ws + WS_H1B); bf16_t* HID = (bf16_t*)(p.ws + WS_HID);
    float* As = lds; float* Wg = lds + 32 * 132; float* Wu = Wg + 32 * 64; int* tab = (int*)(Wu + 32 * 64);
    __syncthreads();
    moe_tables(tab, cnt, 8);
    const int tid = opaque_tid(), ty = tid >> 4, tx = tid & 15;
    const int total = tab[64];
    for (int item = blockIdx.x; item < total; item += gridDim.x) {
        int e = 0; while (tab[e + 1] <= item) ++e;
        const int local = item - tab[e], rb = local >> 3, ct = local & 7, ce = (int)cnt[e], base = tab[80 + e];
        const float* wgp = p.w_eg + ((size_t)(l * 64 + e) * D) * FE + ct * 64;
        const float* wup = p.w_eu + ((size_t)(l * 64 + e) * D) * FE + ct * 64;
        const f32x4 z4 = {0.f, 0.f, 0.f, 0.f};
        f32x4 ag0 = z4, ag1 = z4, ag2 = z4, ag3 = z4, au0 = z4, au1 = z4, au2 = z4, au3 = z4;
        const int ar = tid >> 2, akq = (tid & 3) * 8, wk = tid >> 4, wn4 = (tid & 15) * 4;
        const int ai = rb * 128 + ar; const int tok = ai < ce ? LIST[(size_t)e * ECAP + ai] : -1;
        const bf16_t* ap = H1B + (size_t)(tok < 0 ? 0 : tok) * D + akq;
        for (int k0 = 0; k0 < D; k0 += 32) {
            __syncthreads();
            { u32x4 raw = *(const u32x4*)(ap + k0); if (tok < 0) raw = (u32x4){0u, 0u, 0u, 0u};
              float* dst = As + akq * 132 + ar;
              dst[0 * 132] = __uint_as_float(raw.x << 16); dst[1 * 132] = __uint_as_float(raw.x & 0xffff0000u); dst[2 * 132] = __uint_as_float(raw.y << 16); dst[3 * 132] = __uint_as_float(raw.y & 0xffff0000u);
              dst[4 * 132] = __uint_as_float(raw.z << 16); dst[5 * 132] = __uint_as_float(raw.z & 0xffff0000u); dst[6 * 132] = __uint_as_float(raw.w << 16); dst[7 * 132] = __uint_as_float(raw.w & 0xffff0000u); }
            *(f32x4*)(Wg + wk * 64 + wn4) = *(const f32x4*)(wgp + (size_t)(k0 + wk) * FE + wn4);
            *(f32x4*)(Wu + wk * 64 + wn4) = *(const f32x4*)(wup + (size_t)(k0 + wk) * FE + wn4);
            __syncthreads();
#pragma unroll 4
            for (int kk = 0; kk < 32; ++kk) {
                const f32x4 a = *(const f32x4*)(As + kk * 132 + ty * 4);
                const f32x4 g4 = *(const f32x4*)(Wg + kk * 64 + tx * 4);
                const f32x4 u4 = *(const f32x4*)(Wu + kk * 64 + tx * 4);
                ag0 += a[0] * g4; ag1 += a[1] * g4; ag2 += a[2] * g4; ag3 += a[3] * g4;
                au0 += a[0] * u4; au1 += a[1] * u4; au2 += a[2] * u4; au3 += a[3] * u4;
            }
        }
#define MOE1_OUT(i, G_, U_) do { const int ri = rb * 128 + ty * 4 + (i); if (ri < ce) { f32x4 o; \
            o[0] = G_[0] / (1.f + __expf(-G_[0])) * U_[0]; o[1] = G_[1] / (1.f + __expf(-G_[1])) * U_[1]; o[2] = G_[2] / (1.f + __expf(-G_[2])) * U_[2]; o[3] = G_[3] / (1.f + __expf(-G_[3])) * U_[3]; \
            st4bf(HID + (size_t)(base + ri) * FE + ct * 64 + tx * 4, o); } } while (0)
        MOE1_OUT(0, ag0, au0); MOE1_OUT(1, ag1, au1); MOE1_OUT(2, ag2, au2); MOE1_OUT(3, ag3, au3);
#undef MOE1_OUT
    }
    __syncthreads();
}
__device__ __forceinline__ void p_moe2(float* lds, const Params& p, int l) {
    const unsigned* cnt = (const unsigned*)(p.ws + WS_CNT) + l * 64;
    const bf16_t* HID = (const bf16_t*)(p.ws + WS_HID); bf16_t* YE = (bf16_t*)(p.ws + WS_YE);
    float* As = lds; float* Ws = lds + 32 * 132; int* tab = (int*)(Ws + 32 * 64 * 2);
    __syncthreads();
    moe_tables(tab, cnt, 32);
    const int tid = opaque_tid(), ty = tid >> 4, tx = tid & 15;
    const int total = tab[64];
    for (int item = blockIdx.x; item < total; item += gridDim.x) {
        int e = 0; while (tab[e + 1] <= item) ++e;
        const int local = item - tab[e], rb = local >> 5, ct = local & 31, ce = (int)cnt[e], base = tab[80 + e];
        const float* wdp = p.w_ed + ((size_t)(l * 64 + e) * FE) * D + ct * 64;
        f32x4 acc0 = {0.f, 0.f, 0.f, 0.f}, acc1 = acc0, acc2 = acc0, acc3 = acc0;
        const int ar = tid >> 2, akq = (tid & 3) * 8, wk = tid >> 4, wn4 = (tid & 15) * 4;
        const int ai = rb * 128 + ar; const bool av = ai < ce;
        const bf16_t* ap = HID + (size_t)(base + (av ? ai : 0)) * FE + akq;
        for (int k0 = 0; k0 < FE; k0 += 32) {
            __syncthreads();
            { u32x4 raw = *(const u32x4*)(ap + k0); if (!av) raw = (u32x4){0u, 0u, 0u, 0u};
              float* dst = As + akq * 132 + ar;
              dst[0 * 132] = __uint_as_float(raw.x << 16); dst[1 * 132] = __uint_as_float(raw.x & 0xffff0000u); dst[2 * 132] = __uint_as_float(raw.y << 16); dst[3 * 132] = __uint_as_float(raw.y & 0xffff0000u);
              dst[4 * 132] = __uint_as_float(raw.z << 16); dst[5 * 132] = __uint_as_float(raw.z & 0xffff0000u); dst[6 * 132] = __uint_as_float(raw.w << 16); dst[7 * 132] = __uint_as_float(raw.w & 0xffff0000u); }
            *(f32x4*)(Ws + wk * 64 + wn4) = *(const f32x4*)(wdp + (size_t)(k0 + wk) * D + wn4);
            __syncthreads();
#pragma unroll 8
            for (int kk = 0; kk < 32; ++kk) {
                const f32x4 a = *(const f32x4*)(As + kk * 132 + ty * 4);
                const f32x4 w = *(const f32x4*)(Ws + kk * 64 + tx * 4);
                acc0 += a[0] * w; acc1 += a[1] * w; acc2 += a[2] * w; acc3 += a[3] * w;
            }
        }
        { const int ri = rb * 128 + ty * 4; bf16_t* yo = YE + (size_t)(base + ri) * D + ct * 64 + tx * 4;
          if (ri < ce) st4bf(yo, acc0); if (ri + 1 < ce) st4bf(yo + D, acc1); if (ri + 2 < ce) st4bf(yo + 2 * D, acc2); if (ri + 3 < ce) st4bf(yo + 3 * D, acc3); }
    }
    __syncthreads();
}
template <bool GATED>
__device__ __forceinline__ void moe_gemm(LAS unsigned char* ldsb, const int* tab, const unsigned* cnt, const int* LIST, const bf16_t* Asrc, const float* W0, const float* W1, bf16_t* Out) {
    constexpr int K = GATED ? D : FE, NT = K / 64, NCT = GATED ? FE / 64 : D / 128, LDW = GATED ? FE : D, LDO = GATED ? FE : D;
    constexpr int ABYTES = 256 * 128, BOFF = 2 * ABYTES, BBYTES = 64 * 256;
    const int tid = opaque_tid(), lane = tid & 63, wv = __builtin_amdgcn_readfirstlane(tid >> 6), wm = wv >> 1, wn = wv & 1, l15 = lane & 15, kq = lane >> 4;
    const int total = tab[64];
    const unsigned lbase = (unsigned)(size_t)ldsb;
    const int arow = wm * 64 + l15;
    const unsigned afr = lbase + (unsigned)arow * 128u; const int asw = ((arow >> 1) & 7) ^ kq;
    const int bq = (lane >> 2) & 3, bp = lane & 3, bkey = bq | ((kq & 1) << 2);
    const unsigned bfr = lbase + BOFF + (unsigned)(8 * kq + bq) * 256u + 8u * bp;
    unsigned bb[4];
#pragma unroll
    for (int j = 0; j < 4; ++j) { const int np = GATED ? ((j >> 1) * 4 + 2 * wn + (j & 1)) : (4 * wn + j); bb[j] = bfr + ((unsigned)(np ^ bkey) << 5); }
    const int sa_r = tid >> 3, sa_c = tid & 7;
    const int sb_k = tid >> 5, sb_n = 4 * (tid & 31);
    for (int item = blockIdx.x; item < total; item += gridDim.x) {
        int e = 0; while (tab[e + 1] <= item) ++e;
        const int local = item - tab[e], ct = local / tab[160 + e], rb = local - ct * tab[160 + e];
        const int ce = (int)cnt[e], base = tab[80 + e];
        unsigned aoff[4];
#pragma unroll
        for (int i = 0; i < 4; ++i) { const int r = rb * 256 + i * 64 + sa_r;
            if (GATED) { const int tok = r < ce ? LIST[(size_t)e * ECAP + r] : 0; aoff[i] = (unsigned)tok * (unsigned)(K * 2) + sa_c * 16; }
            else aoff[i] = (unsigned)(base + r) * (unsigned)(K * 2) + sa_c * 16; }
        const float* wp = (GATED ? (sb_n < 64 ? W0 : W1) : W0) + (size_t)e * K * LDW + (size_t)sb_k * LDW + (GATED ? ct * 64 + (sb_n & 63) : ct * 128 + sb_n);
        f32x4 acc[4][4];
#pragma unroll
        for (int m = 0; m < 4; ++m)
#pragma unroll
            for (int n = 0; n < 4; ++n) acc[m][n] = (f32x4){0.f, 0.f, 0.f, 0.f};
        u32x4 ra0[4], ra1[4]; f32x4 rb0[4], rb1[4];
#define MG_LOAD(RA, RB, t_) do { _Pragma("unroll") for (int i = 0; i < 4; ++i) { RA[i] = *(const u32x4*)((const unsigned char*)Asrc + aoff[i] + (t_) * 128); \
            RB[i] = *(const f32x4*)(wp + (size_t)((t_) * 64 + 16 * i) * LDW); } } while (0)
#define MG_WRITE(RA, RB, buf_) do { _Pragma("unroll") for (int i = 0; i < 4; ++i) { const int r = i * 64 + sa_r; \
            *(LAS u32x4*)(ldsb + (buf_) * ABYTES + r * 128 + ((sa_c ^ ((r >> 1) & 7)) << 4)) = RA[i]; \
            const int k = sb_k + 16 * i; u32x2 w; w.x = pkbf(RB[i][0], RB[i][1]); w.y = pkbf(RB[i][2], RB[i][3]); \
            *(LAS u32x2*)(ldsb + BOFF + (buf_) * BBYTES + k * 256 + ((((sb_n >> 4) ^ ((k & 3) | (((k >> 3) & 1) << 2)))) << 5) + (sb_n & 15) * 2) = w; } } while (0)
#define TRRD(dst, addr, off) asm volatile("ds_read_b64_tr_b16 %0, %1 offset:%2" : "=&v"(dst) : "v"(addr), "i"(off) : "memory")
#define MG_COMPUTE(buf_) do { \
            _Pragma("unroll") for (int kk = 0; kk < 2; ++kk) { \
                bf16x8 af[4]; \
                _Pragma("unroll") for (int m = 0; m < 4; ++m) af[m] = *(const LAS bf16x8*)(size_t)(afr + (buf_) * ABYTES + m * 2048 + ((unsigned)((4 * kk) ^ asw) << 4)); \
                s16x4 b0l, b0h, b1l, b1h, b2l, b2h, b3l, b3h; \
                TRRD(b0l, bb[0], (buf_) * BBYTES + kk * 8192); TRRD(b0h, bb[0], (buf_) * BBYTES + kk * 8192 + 1024); \
                TRRD(b1l, bb[1], (buf_) * BBYTES + kk * 8192); TRRD(b1h, bb[1], (buf_) * BBYTES + kk * 8192 + 1024); \
                TRRD(b2l, bb[2], (buf_) * BBYTES + kk * 8192); TRRD(b2h, bb[2], (buf_) * BBYTES + kk * 8192 + 1024); \
                TRRD(b3l, bb[3], (buf_) * BBYTES + kk * 8192); TRRD(b3h, bb[3], (buf_) * BBYTES + kk * 8192 + 1024); \
                asm volatile("s_waitcnt lgkmcnt(0)" ::: "memory"); __builtin_amdgcn_sched_barrier(0); \
                const bf16x8 bf0 = {b0l[0], b0l[1], b0l[2], b0l[3], b0h[0], b0h[1], b0h[2], b0h[3]}, bf1 = {b1l[0], b1l[1], b1l[2], b1l[3], b1h[0], b1h[1], b1h[2], b1h[3]}; \
                const bf16x8 bf2 = {b2l[0], b2l[1], b2l[2], b2l[3], b2h[0], b2h[1], b2h[2], b2h[3]}, bf3 = {b3l[0], b3l[1], b3l[2], b3l[3], b3h[0], b3h[1], b3h[2], b3h[3]}; \
                _Pragma("unroll") for (int m = 0; m < 4; ++m) { \
                    acc[m][0] = __builtin_amdgcn_mfma_f32_16x16x32_bf16(af[m], bf0, acc[m][0], 0, 0, 0); acc[m][1] = __builtin_amdgcn_mfma_f32_16x16x32_bf16(af[m], bf1, acc[m][1], 0, 0, 0); \
                    acc[m][2] = __builtin_amdgcn_mfma_f32_16x16x32_bf16(af[m], bf2, acc[m][2], 0, 0, 0); acc[m][3] = __builtin_amdgcn_mfma_f32_16x16x32_bf16(af[m], bf3, acc[m][3], 0, 0, 0); } } } while (0)
        __syncthreads();
        MG_LOAD(ra0, rb0, 0); MG_LOAD(ra1, rb1, 1);
        MG_WRITE(ra0, rb0, 0);
        __syncthreads();
#pragma unroll 1
        for (int t = 0; t < NT; t += 2) {
            if (t + 2 < NT) MG_LOAD(ra0, rb0, t + 2);
            MG_COMPUTE(0);
            MG_WRITE(ra1, rb1, 1);
            __syncthreads();
            if (t + 3 < NT) MG_LOAD(ra1, rb1, t + 3);
            MG_COMPUTE(1);
            if (t + 2 < NT) MG_WRITE(ra0, rb0, 0);
            __syncthreads();
        }
#undef MG_LOAD
#undef MG_WRITE
#undef MG_COMPUTE
#undef TRRD
#pragma unroll
        for (int m = 0; m < 4; ++m)
#pragma unroll
            for (int g = 0; g < 4; ++g) {
                const int r = rb * 256 + wm * 64 + 16 * m + 4 * kq + g;
                if (r < ce) {
                    if (GATED) {
#pragma unroll
                        for (int j = 0; j < 2; ++j) { const float gv = acc[m][j][g], uv = acc[m][2 + j][g];
                            Out[(size_t)(base + r) * LDO + ct * 64 + 32 * wn + 16 * j + l15] = f2bf(gv / (1.f + __expf(-gv)) * uv); }
                    } else {
#pragma unroll
                        for (int n = 0; n < 4; ++n) Out[(size_t)(base + r) * LDO + ct * 128 + 64 * wn + 16 * n + l15] = f2bf(acc[m][n][g]);
                    }
                }
            }
    }
    __syncthreads();
}
__device__ __forceinline__ void moe_tables256(int* tab, const unsigned* cnt, int ncol_tiles) {
    if (threadIdx.x == 0) { int a = 0, bsum = 0; for (int e = 0; e < 64; ++e) { tab[e] = a; tab[80 + e] = bsum; const int c = (int)cnt[e], nrb = (c + 255) / 256; tab[160 + e] = nrb > 0 ? nrb : 1; a += nrb * ncol_tiles; bsum += nrb * 256; } tab[64] = a; tab[80 + 64] = bsum; }
    __syncthreads();
}
__device__ __forceinline__ void p_moe1_mfma(LAS unsigned char* ldsb, unsigned char* ws, const float* w_eg, const float* w_eu, int l) {
    const unsigned* cnt = (const unsigned*)(ws + WS_CNT) + l * 64;
    int* tab = (int*)((unsigned char*)ldsb + 100 * 1024);
    __syncthreads();
    moe_tables256(tab, cnt, FE / 64);
    moe_gemm<true>(ldsb, tab, cnt, (const int*)(ws + WS_LIST), (const bf16_t*)(ws + WS_H1B), w_eg + (size_t)l * NE * D * FE, w_eu + (size_t)l * NE * D * FE, (bf16_t*)(ws + WS_HID));
}
__device__ __forceinline__ void p_moe2_mfma(LAS unsigned char* ldsb, unsigned char* ws, const float* w_ed, int l) {
    const unsigned* cnt = (const unsigned*)(ws + WS_CNT) + l * 64;
    int* tab = (int*)((unsigned char*)ldsb + 100 * 1024);
    __syncthreads();
    moe_tables256(tab, cnt, D / 128);
    moe_gemm<false>(ldsb, tab, cnt, nullptr, (const bf16_t*)(ws + WS_HID), w_ed + (size_t)l * NE * FE * D, nullptr, (bf16_t*)(ws + WS_YE));
}

__device__ __forceinline__ void p_ln2(float* lds, const Params& p, int l) {
    const unsigned* cnt = (const unsigned*)(p.ws + WS_CNT) + l * 64;
    const float* H1F = (const float*)(p.ws + WS_H1F); const bf16_t* YE = (const bf16_t*)(p.ws + WS_YE);
    const int* TOKE = (const int*)(p.ws + WS_TOKE); const float* TOKW = (const float*)(p.ws + WS_TOKW); const int* TOKS = (const int*)(p.ws + WS_TOKS);
    float* outF = (l == DEPTH - 1) ? p.out : (float*)(p.ws + WS_H2F); bf16_t* XB = (bf16_t*)(p.ws + WS_XB);
    const float* g = p.ln2g + (size_t)l * D; const float* bb = p.ln2b + (size_t)l * D;
    int* tab = (int*)lds;
    __syncthreads();
    moe_tables(tab, cnt, 1);
    const int tid = opaque_tid(), lane = tid & 63, wv = tid >> 6;
    for (int t0 = blockIdx.x * 8; t0 < T; t0 += gridDim.x * 8) {
        const int t = t0 + wv;
        const int r0 = tab[80 + TOKE[t * 2]] + TOKS[t * 2], r1 = tab[80 + TOKE[t * 2 + 1]] + TOKS[t * 2 + 1];
        const float w0 = TOKW[t * 2], w1 = TOKW[t * 2 + 1];
        const float* hrow = H1F + (size_t)t * D; const bf16_t* y0 = YE + (size_t)r0 * D; const bf16_t* y1 = YE + (size_t)r1 * D;
        float s1 = 0.f;
#pragma unroll 4
        for (int j = 0; j < 32; ++j) { const int k = lane + 64 * j; s1 += ALPHA * hrow[k] + w0 * bf2f(y0[k]) + w1 * bf2f(y1[k]); }
        const float mean = wave_sum(s1) * (1.f / D);
        float s2 = 0.f;
#pragma unroll 4
        for (int j = 0; j < 32; ++j) { const int k = lane + 64 * j; const float d = ALPHA * hrow[k] + w0 * bf2f(y0[k]) + w1 * bf2f(y1[k]) - mean; s2 += d * d; }
        const float rstd = rsqrtf(wave_sum(s2) * (1.f / D) + 1e-5f);
#pragma unroll 4
        for (int j = 0; j < 32; ++j) { const int k = lane + 64 * j; const float v = ALPHA * hrow[k] + w0 * bf2f(y0[k]) + w1 * bf2f(y1[k]);
            const float o = (v - mean) * rstd * g[k] + bb[k];
            outF[(size_t)t * D + k] = o; if (l != DEPTH - 1) XB[(size_t)t * D + k] = f2bf(o); }
    }
    __syncthreads();
}

constexpr int NPH = 10;
#ifndef PH_MASK
#define PH_MASK 0x7ff
#endif
#define PHON(k) ((PH_MASK >> (k)) & 1)
typedef const Params __attribute__((address_space(4))) CParams;
#define KP(field) ({ CParams* _k = kp; asm volatile("" : "+s"(_k)); _k->field; })
__global__ void __launch_bounds__(NTHREADS, 2) hybrid_fwd(Params p_unused, int ph_lo, int ph_hi) {
    extern __shared__ __attribute__((aligned(16))) unsigned char lds_raw[];
    float* lds = (float*)lds_raw;
    LAS unsigned char* ldsb = (LAS unsigned char*)lds_raw;
    CParams* kp = (CParams*)__builtin_amdgcn_kernarg_segment_ptr();
    unsigned char* const ws0 = KP(ws);
    volatile LAS unsigned* xbw = (volatile LAS unsigned*)(lds_raw + LDS_BYTES - 16);
    if (threadIdx.x == 0) { xbw[0] = 0u; xbw[1] = 0u; xbw[2] = 0u; xbw[3] = 0u; }
    __syncthreads();
    XcdBarrier bar; bar.bar = (unsigned*)(ws0 + WS_BAR); bar.x = 0; bar.st = xbw;
    if (ph_lo < ph_hi) bar = xcd_barrier_post((unsigned*)(ws0 + WS_BAR), xbw);
#define IN(ph) ((ph) >= ph_lo && (ph) <= ph_hi)
#define GRID_BAR(ph) do { if ((ph) >= ph_lo && (ph) < ph_hi) xcd_barrier(bar); } while (0)
    if (PHON(0) && IN(0)) { unsigned char* ws = ws0; asm volatile("" : "+s"(ws)); { Params q; q.ws = ws; q.x = KP(x); q.pos = KP(pos); q.w_in = KP(w_in); q.g_q = KP(g_q); q.w_qb = KP(w_qb); q.g_kv = KP(g_kv); q.w_kvb = KP(w_kvb);
        q.w_oa = KP(w_oa); q.w_ob = KP(w_ob); q.w_out = KP(w_out); p_prologue(ldsb, q); } }
    GRID_BAR(0);
    for (int l = 0; l < DEPTH; ++l) {
        const int pb = l * NPH;
        if (PHON(1) && IN(pb + 1)) { unsigned char* ws = ws0; asm volatile("" : "+s"(ws));
            EpiIn E; E.ws = ws;
            pg8::Gemm g{(const bf16_t*)(ws + WS_XB), (const bf16_t*)(ws + WS_WIN_T) + (size_t)l * INP * D, T, INP, D}; pg8::StaticOrder SO; SO.init(T, INP, (int)gridDim.x, (int)blockIdx.x);
            pg8::gemm_phase<EpiIn, pg8::StaticOrder, true, true>(ldsb, g, SO, E);
        }
        GRID_BAR(pb + 1);
        if (PHON(2) && IN(pb + 2)) { unsigned char* ws = ws0; asm volatile("" : "+s"(ws));
            { EpiQA E; E.ws = ws;
              pg8::Gemm g{(const bf16_t*)(ws + WS_CQ), (const bf16_t*)(ws + WS_WQB_T) + (size_t)l * 1536 * 512, T, 1536, 512}; pg8::StaticOrder SO; SO.init(T, 1536, (int)gridDim.x, (int)blockIdx.x);
              pg8::gemm_phase<EpiQA, pg8::StaticOrder, true, true>(ldsb, g, SO, E); }
            { EpiKV E; E.ws = ws;
              pg8::Gemm g{(const bf16_t*)(ws + WS_CKV), (const bf16_t*)(ws + WS_WKVB_T) + (size_t)l * 2048 * 512, T, 2048, 512}; pg8::StaticOrder SO; SO.init(T, 2048, (int)gridDim.x, (int)blockIdx.x);
              pg8::gemm_phase<EpiKV, pg8::StaticOrder, true, true>(ldsb, g, SO, E); }
            p_score(ldsb, ws);
        }
        GRID_BAR(pb + 2);
        if (PHON(3) && IN(pb + 3)) { unsigned char* ws = ws0; asm volatile("" : "+s"(ws)); p_select(ws); }
        GRID_BAR(pb + 3);
        if (PHON(4) && IN(pb + 4)) { unsigned char* ws = ws0; asm volatile("" : "+s"(ws));
            p_attn(ldsb, ws);
        }
        GRID_BAR(pb + 4);
        if (PHON(5) && IN(pb + 5)) { unsigned char* ws = ws0; asm volatile("" : "+s"(ws));
            pg8::StaticOrder SO; SO.init(T, D, (int)gridDim.x, (int)blockIdx.x);
            { EpiYA E; E.ws = ws;
              pg8::Gemm g{(const bf16_t*)(ws + WS_OA), (const bf16_t*)(ws + WS_WOA_T) + (size_t)l * D * 1024, T, D, 1024};
              pg8::gemm_phase<EpiYA, pg8::StaticOrder, true, true>(ldsb, g, SO, E); }
            { EpiYB E; E.ws = ws;
              pg8::Gemm g{(const bf16_t*)(ws + WS_OB), (const bf16_t*)(ws + WS_WOB_T) + (size_t)l * D * 1024, T, D, 1024};
              pg8::gemm_phase<EpiYB, pg8::StaticOrder, true, true>(ldsb, g, SO, E); }
        }
        GRID_BAR(pb + 5);
        if (PHON(6) && IN(pb + 6)) { unsigned char* ws = ws0; asm volatile("" : "+s"(ws));
            EpiOut E; E.hin = (l == 0) ? KP(x) : (const float*)(ws + WS_H2F); E.V1 = (float*)(ws + WS_V1);
            pg8::Gemm g{(const bf16_t*)(ws + WS_Y), (const bf16_t*)(ws + WS_WOUT_T) + (size_t)l * D * D, T, D, D}; pg8::StaticOrder SO; SO.init(T, D, (int)gridDim.x, (int)blockIdx.x);
            pg8::gemm_phase<EpiOut, pg8::StaticOrder, true, true>(ldsb, g, SO, E);
        }
        GRID_BAR(pb + 6);
        if (PHON(7) && IN(pb + 7)) { unsigned char* ws = ws0; asm volatile("" : "+s"(ws)); Params q; q.ws = ws; q.ln1g = KP(ln1g); q.ln1b = KP(ln1b); q.w_router = KP(w_router); q.w_group = KP(w_group); q.b_router = KP(b_router); q.b_group = KP(b_group); p_ln1_route(lds, q, l); }
        GRID_BAR(pb + 7);
        if (PHON(8) && IN(pb + 8)) { unsigned char* ws = ws0; asm volatile("" : "+s"(ws)); p_moe1_mfma(ldsb, ws, KP(w_eg), KP(w_eu), l); }
        GRID_BAR(pb + 8);
        if (PHON(9) && IN(pb + 9)) { unsigned char* ws = ws0; asm volatile("" : "+s"(ws)); p_moe2_mfma(ldsb, ws, KP(w_ed), l); }
        GRID_BAR(pb + 9);
        if (PHON(10) && IN(pb + 10)) { unsigned char* ws = ws0; asm volatile("" : "+s"(ws)); Params q; q.ws = ws; q.ln2g = KP(ln2g); q.ln2b = KP(ln2b); q.out = KP(out); p_ln2(lds, q, l); }
        GRID_BAR(pb + 10);
    }
}

#ifndef MK_ONE_LAUNCH
#define MK_ONE_LAUNCH 1
#endif
extern "C" void kernel_launch(void* const* d_in, const int* in_sizes, int n_in, void* d_out, int out_size, void* d_ws, size_t ws_size, hipStream_t stream) {
    static int grid = 0;
    if (!grid) {
        if (n_in != 21 || in_sizes[0] != T * D || out_size != T * D || ws_size < WS_END) {
            fprintf(stderr, "kernel_launch: unexpected shapes (n_in %d, in0 %d, out %d, ws %zu, need %zu); nothing launched\n", n_in, n_in > 0 ? in_sizes[0] : -1, out_size, ws_size, (size_t)WS_END);
            grid = -1; return; }
        int dev = 0, cus = 0, per_cu = 0;
        hipGetDevice(&dev); hipDeviceGetAttribute(&cus, hipDeviceAttributeMultiprocessorCount, dev);
        if (hipFuncSetAttribute((const void*)hybrid_fwd, hipFuncAttributeMaxDynamicSharedMemorySize, LDS_BYTES) != hipSuccess) { fprintf(stderr, "kernel_launch: hipFuncSetAttribute failed\n"); grid = -1; return; }
        hipOccupancyMaxActiveBlocksPerMultiprocessor(&per_cu, (const void*)hybrid_fwd, NTHREADS, LDS_BYTES);
        if (per_cu < 1) fprintf(stderr, "kernel_launch: occupancy query reports %d blocks per CU\n", per_cu);
        grid = cus > 0 ? cus : 256;
    }
    if (grid < 0) return;
    hipMemsetAsync((char*)d_ws, 0, WS_CTL_END, stream);
    Params p{};
    p.x = (const float*)d_in[0]; p.pos = (const int*)d_in[1];
    p.w_in = (const float*)d_in[2]; p.g_q = (const float*)d_in[3]; p.w_qb = (const float*)d_in[4]; p.g_kv = (const float*)d_in[5]; p.w_kvb = (const float*)d_in[6];
    p.w_oa = (const float*)d_in[7]; p.w_ob = (const float*)d_in[8]; p.w_out = (const float*)d_in[9]; p.ln1g = (const float*)d_in[10]; p.ln1b = (const float*)d_in[11];
    p.w_group = (const float*)d_in[12]; p.b_group = (const float*)d_in[13]; p.w_router = (const float*)d_in[14]; p.b_router = (const float*)d_in[15];
    p.w_eg = (const float*)d_in[16]; p.w_eu = (const float*)d_in[17]; p.w_ed = (const float*)d_in[18]; p.ln2g = (const float*)d_in[19]; p.ln2b = (const float*)d_in[20];
    p.out = (float*)d_out; p.ws = (unsigned char*)d_ws;
#if MK_ONE_LAUNCH
    hipLaunchKernelGGL(hybrid_fwd, dim3(grid), dim3(NTHREADS), LDS_BYTES, stream, p, 0, DEPTH * NPH);
#else
    for (int ph = 0; ph <= DEPTH * NPH; ++ph) hipLaunchKernelGGL(hybrid_fwd, dim3(grid), dim3(NTHREADS), LDS_BYTES, stream, p, ph, ph);
#endif
}
```

```cpp
#include <hip/hip_runtime.h>
#include <cstdio>
#include <cstdint>

typedef unsigned short bf16_t;
typedef float f32x4 __attribute__((ext_vector_type(4)));
typedef unsigned u32x4 __attribute__((ext_vector_type(4)));
typedef unsigned u32x2 __attribute__((ext_vector_type(2)));

constexpr int T = 8192, D = 2048, S = 4096, NB = 2, DEPTH = 2;
constexpr int INW = 9360, INP = 9472;
constexpr int NE = 64, FE = 512;
constexpr int NTHREADS = 512;
constexpr int LDS_BYTES = 147456;
constexpr float ALPHA = 1.41421356237309515f;
constexpr int ECAP = 8192;
constexpr int PMAX = 32768;

constexpr size_t al256(size_t x) { return (x + 255) & ~(size_t)255; }
constexpr size_t XCD_BAR_BYTES = 16384;
constexpr size_t WS_BAR = 0;
constexpr size_t WS_CNT = WS_BAR + XCD_BAR_BYTES;
constexpr size_t WS_CTL_END = WS_CNT + al256(DEPTH * 64 * 4);
constexpr size_t WS_SSQ = WS_CTL_END;
constexpr size_t WS_ROPE = WS_SSQ + al256((size_t)T * 32 * 4);
constexpr size_t WS_XB = WS_ROPE + al256((size_t)T * 112 * 4);
constexpr size_t WS_H2F = WS_XB + al256((size_t)T * D * 2);
constexpr size_t WS_CQ = WS_H2F + al256((size_t)T * D * 4);
constexpr size_t WS_CKV = WS_CQ + al256((size_t)T * 512 * 2);
constexpr size_t WS_QB = WS_CKV + al256((size_t)T * 512 * 2);
constexpr size_t WS_KB = WS_QB + al256((size_t)T * 1024 * 2);
constexpr size_t WS_VB = WS_KB + al256((size_t)T * 1024 * 2);
constexpr size_t WS_QI = WS_VB + al256((size_t)T * 1024 * 2);
constexpr size_t WS_KI = WS_QI + al256((size_t)T * 1024 * 2);
constexpr size_t WS_WI = WS_KI + al256((size_t)T * 64 * 2);
constexpr size_t WS_GA = WS_WI + al256((size_t)T * 16 * 4);
constexpr size_t WS_GB = WS_GA + al256((size_t)T * D * 2);
constexpr size_t WS_QA = WS_GB + al256((size_t)T * D * 2);
constexpr size_t WS_KA = WS_QA + al256((size_t)T * 1536 * 2);
constexpr size_t WS_VA = WS_KA + al256((size_t)T * 1536 * 2);
constexpr size_t WS_MASK = WS_VA + al256((size_t)T * 1024 * 2);
constexpr size_t WS_OA = WS_MASK + al256((size_t)T * 128 * 4);
constexpr size_t WS_OB = WS_OA + al256((size_t)T * 1024 * 2);
constexpr size_t WS_YT = WS_OB + al256((size_t)T * 1024 * 2);
constexpr size_t WS_Y = WS_YT + al256((size_t)T * D * 4);
constexpr size_t WS_V1 = WS_Y + al256((size_t)T * D * 2);
constexpr size_t WS_H1F = WS_V1 + al256((size_t)T * D * 4);
constexpr size_t WS_H1B = WS_H1F + al256((size_t)T * D * 4);
constexpr size_t WS_TOKE = WS_H1B + al256((size_t)T * D * 2);
constexpr size_t WS_TOKW = WS_TOKE + al256((size_t)T * 2 * 4);
constexpr size_t WS_TOKS = WS_TOKW + al256((size_t)T * 2 * 4);
constexpr size_t WS_LIST = WS_TOKS + al256((size_t)T * 2 * 4);
constexpr size_t WS_HID = WS_LIST + al256((size_t)NE * ECAP * 4);
constexpr size_t WS_YE = WS_HID + al256((size_t)PMAX * FE * 2);
constexpr size_t WS_SCORE = WS_YE + al256((size_t)PMAX * D * 2);
constexpr size_t WS_WIN_T = WS_SCORE + al256((size_t)T * 4096 * 4);
constexpr size_t WS_WQB_T = WS_WIN_T + al256((size_t)DEPTH * INP * D * 2);
constexpr size_t WS_WKVB_T = WS_WQB_T + al256((size_t)DEPTH * 1536 * 512 * 2);
constexpr size_t WS_WOA_T = WS_WKVB_T + al256((size_t)DEPTH * 2048 * 512 * 2);
constexpr size_t WS_WOB_T = WS_WOA_T + al256((size_t)DEPTH * D * 1024 * 2);
constexpr size_t WS_WOUT_T = WS_WOB_T + al256((size_t)DEPTH * D * 1024 * 2);
constexpr size_t WS_END = WS_WOUT_T + al256((size_t)DEPTH * D * D * 2);
static_assert(WS_CKV == WS_CQ + (size_t)T * 512 * 2, "CQ|CKV must be consecutive");

static_assert(WS_KB == WS_QB + (size_t)T * 1024 * 2 && WS_VB == WS_KB + (size_t)T * 1024 * 2 && WS_GB == WS_GA + (size_t)T * D * 2, "QB|KB|VB and GA|GB must be consecutive");
struct Params {
    const float* x; const int* pos;
    const float *w_in, *g_q, *w_qb, *g_kv, *w_kvb, *w_oa, *w_ob, *w_out, *ln1g, *ln1b, *w_group, *b_group, *w_router, *b_router, *w_eg, *w_eu, *w_ed, *ln2g, *ln2b;
    float* out; unsigned char* ws;
};

__device__ __forceinline__ float bf2f(bf16_t v) { return __uint_as_float((unsigned)v << 16); }
__device__ __forceinline__ bf16_t f2bf(float f) { unsigned u = __float_as_uint(f); u += 0x7fffu + ((u >> 16) & 1u); return (bf16_t)(u >> 16); }
__device__ __forceinline__ unsigned pk2(float a, float b) { return (unsigned)f2bf(a) | ((unsigned)f2bf(b) << 16); }
__device__ __forceinline__ void st4bf(bf16_t* p, f32x4 v) { u32x2 w; w.x = pk2(v[0], v[1]); w.y = pk2(v[2], v[3]); *(u32x2*)p = w; }
__device__ __forceinline__ float wave_sum(float v) {
#pragma unroll
    for (int o = 32; o >= 1; o >>= 1) v += __shfl_xor(v, o);
    return v;
}
__device__ __forceinline__ float wave_max(float v) {
#pragma unroll
    for (int o = 32; o >= 1; o >>= 1) v = fmaxf(v, __shfl_xor(v, o));
    return v;
}
__device__ __forceinline__ int block_sum_int(int v, int* red) {
#pragma unroll
    for (int o = 32; o >= 1; o >>= 1) v += __shfl_xor(v, o);
    if ((threadIdx.x & 63) == 0) red[threadIdx.x >> 6] = v;
    __syncthreads();
    int t = 0;
#pragma unroll
    for (int i = 0; i < 8; ++i) t += red[i];
    __syncthreads();
    return t;
}
__device__ __forceinline__ f32x4 rot4(f32x4 v, float c0, float s0, float c1, float s1) { f32x4 o; o[0] = v[0] * c0 - v[1] * s0; o[1] = v[1] * c0 + v[0] * s0; o[2] = v[2] * c1 - v[3] * s1; o[3] = v[3] * c1 + v[2] * s1; return o; }

#define XB_TMO      128
#define XB_XCNT(j)  (256  + 64 * (j))
#define XB_XSUB(j)  (1280 + 64 * (j))
#define XB_XGEN(j)  (2304 + 64 * (j))
#define XB_TOP      3328
#define XB_TOPGEN   3392
#define XCD_BAR_WORDS 3456
#define XB_SPIN_CAP (1u << 22)
#define LAS __attribute__((address_space(3)))
__device__ __forceinline__ unsigned xb_ld(unsigned* p)              { return __hip_atomic_load(p, __ATOMIC_RELAXED, __HIP_MEMORY_SCOPE_AGENT); }
__device__ __forceinline__ unsigned xb_add(unsigned* p, unsigned v) { return __hip_atomic_fetch_add(p, v, __ATOMIC_RELAXED, __HIP_MEMORY_SCOPE_AGENT); }
__device__ __forceinline__ unsigned xb_xcc_id() { return (unsigned)__builtin_amdgcn_s_getreg((3 << 11) | 20) & 0xFu; }
#define XB_SPIN(cond, bar) do { unsigned _sp = 0; while (cond) { __builtin_amdgcn_s_sleep(1); \
    if ((++_sp & 255u) == 0u) { if (xb_ld(&(bar)[XB_TMO])) break; if (_sp > XB_SPIN_CAP) { atomicAdd(&(bar)[XB_TMO], 1u); break; } } } } while (0)
struct XcdBarrier { unsigned* bar; unsigned x; volatile LAS unsigned* st; };
__device__ __forceinline__ XcdBarrier xcd_barrier_post(unsigned* bar, volatile LAS unsigned* st) {
    XcdBarrier b; b.bar = bar; b.x = xb_xcc_id(); b.st = st;
    if (threadIdx.x == 0) (void)xb_add(&bar[XB_XCNT(b.x)], 1u);
    return b;
}
__device__ __forceinline__ void xcd_barrier_complete(unsigned* bar, unsigned x, unsigned& nloc, unsigned& nx) {
    const unsigned G = gridDim.x * gridDim.y * gridDim.z;
    unsigned sum, cnt, mine, sp = 0u;
    for (;;) {
        sum = 0u; cnt = 0u; mine = 0u;
#pragma unroll
        for (unsigned j = 0; j < 16; ++j) { const unsigned c = xb_ld(&bar[XB_XCNT(j)]); sum += c; cnt += (c > 0u) ? 1u : 0u; mine = (j == x) ? c : mine; }
        if (sum == G) break;
        __builtin_amdgcn_s_sleep(1);
        if ((++sp & 255u) == 0u) { if (xb_ld(&bar[XB_TMO])) break; if (sp > XB_SPIN_CAP) { atomicAdd(&bar[XB_TMO], 1u); break; } }
    }
    nloc = mine > 0u ? mine : 1u; nx = cnt > 0u ? cnt : 1u;
}
__device__ __forceinline__ void xcd_barrier(const XcdBarrier& b) {
    asm volatile("s_waitcnt vmcnt(0)" ::: "memory");
    __syncthreads();
    if (threadIdx.x == 0) {
        unsigned* bar = b.bar;
        __builtin_amdgcn_s_waitcnt(0);
        unsigned nloc = b.st[0], nx = b.st[1];
        if (nloc == 0u) { xcd_barrier_complete(bar, b.x, nloc, nx); b.st[0] = nloc; b.st[1] = nx; }
        const unsigned old = xb_add(&bar[XB_XSUB(b.x)], 1u);
        const unsigned gen = old / nloc;
        if (old + 1u == (gen + 1u) * nloc) {
            __builtin_amdgcn_fence(__ATOMIC_RELEASE, "agent");
            asm volatile("s_waitcnt vmcnt(0)" ::: "memory");
            const unsigned og = xb_add(&bar[XB_TOP], 1u);
            const unsigned tg = og / nx;
            if (og + 1u == (tg + 1u) * nx) xb_add(&bar[XB_TOPGEN], 1u);
            else XB_SPIN(xb_ld(&bar[XB_TOPGEN]) == tg, bar);
            __builtin_amdgcn_fence(__ATOMIC_ACQUIRE, "agent");
            xb_add(&bar[XB_XGEN(b.x)], 1u);
            asm volatile("s_waitcnt vmcnt(0)" ::: "memory");
        } else {
            XB_SPIN(xb_ld(&bar[XB_XGEN(b.x)]) == gen, bar);
            __builtin_amdgcn_fence(__ATOMIC_ACQUIRE, "agent");
            asm volatile("s_waitcnt vmcnt(0)" ::: "memory");
        }
    }
    __syncthreads();
}

__device__ __forceinline__ int opaque_tid() { int t = threadIdx.x; asm volatile("" : "+v"(t)); return t; }
namespace pg8 {
#define PG8_LAS __attribute__((address_space(3)))
typedef unsigned short bf16_t;
typedef short bf16x8 __attribute__((ext_vector_type(8)));
typedef float f32x4 __attribute__((ext_vector_type(4)));
typedef unsigned u32x4 __attribute__((ext_vector_type(4)));
constexpr int BM = 256, BK = 64, HALF = 128, HTB = HALF * BK * 2  , STAGE_BYTES = 8 * HTB, NXCD = 8, WGM = 8;

__host__ __device__ __forceinline__ int lds_byte(int r, int c) { const int st = (r >> 4) * 2 + (c >> 5), rr = r & 15, cc = c & 31, ob = rr * 64 + cc * 2; return st * 1024 + (ob ^ (((ob >> 9) & 1) << 5)); }
__host__ __device__ __forceinline__ void stage_rc(int b, int& R, int& C) { const int st = b / 1024, sb = b % 1024, swz = sb ^ (((sb >> 9) & 1) << 5); R = (st >> 1) * 16 + swz / 64; C = (st & 1) * 32 + (swz % 64) / 2; }
__host__ __device__ __forceinline__ int perm32(int rho) { const int n = rho >> 4, i = rho & 15; return 8 * (i >> 2) + 4 * n + (i & 3); }

struct Unit { int pm, pn; };
struct Gemm { const bf16_t* A; const bf16_t* Bt; int M, N, K; };

struct StaticOrder {
    int nM, nN, nwg, G, c;
    __host__ __device__ void init(int M, int N, int G_, int c_) { nM = M / BM; nN = N / BM; nwg = nM * nN; G = G_; c = c_; }
    __host__ __device__ bool next(int i, Unit& u) const {
        const long L = (long)i * G + c; if (L >= nwg) return false;
        int wgid = (int)L; { const int q = nwg / NXCD, r = nwg % NXCD, xcd = wgid % NXCD, off = wgid / NXCD; wgid = (xcd < r ? xcd * (q + 1) : r * (q + 1) + (xcd - r) * q) + off; }
        const int nig = WGM * nN, gid = wgid / nig, fm = gid * WGM, gsz = (nM - fm) < WGM ? (nM - fm) : WGM;
        u.pm = fm + ((wgid % nig) % gsz); u.pn = (wgid % nig) / gsz; return true;
    }
    __device__ __forceinline__ void a_ready(const Unit&) const {}
    __device__ __forceinline__ void done(const Unit&) const {}
};

__device__ __forceinline__ unsigned cvt_pk_bf16(float lo, float hi) { unsigned r; asm volatile("v_cvt_pk_bf16_f32 %0, %1, %2" : "=v"(r) : "v"(lo), "v"(hi)); return r; }
template <class Epi, class Sched, bool ALIGN_EPI = false, bool SP2 = false>
__device__ __forceinline__ void gemm_phase(PG8_LAS unsigned char* lds, const Gemm g, const Sched& S, const Epi& E) {
    const int tid = opaque_tid(), wid = __builtin_amdgcn_readfirstlane(tid >> 6), lane = tid & 63, wr = wid >> 2, wc = wid & 3, fr = lane & 15, fq = lane >> 4;
    const int K = g.K, nt = K / BK;
    unsigned voffA[2], voffB[2];
#pragma unroll
    for (int i = 0; i < 2; ++i) { int R, C; stage_rc(tid * 16 + i * 8192, R, C); const int Rb = Epi::PERM ? ((R & ~31) + perm32(R & 31)) : R;
        voffA[i] = (unsigned)(R * K + C) * 2u; voffB[i] = (unsigned)(Rb * K + C) * 2u; }
    const size_t kstep = (size_t)(BK * 2);
    const size_t hstep = (size_t)HALF * K * 2;
    const size_t tstep = 2 * hstep;
    const unsigned ldsw = (unsigned)wid * 1024u;
    const int aoff = lds_byte(wr * 64 + fr, fq * 8), boff = lds_byte(wc * 32 + fr, fq * 8);
#define PG8_SA(b, h) (((b) * 2 + (h)) * HTB)
#define PG8_SB(b, h) ((4 + (b) * 2 + (h)) * HTB)
#define PG8_STAGE(bufoff, gbase, voff) do { _Pragma("unroll") for (int _i = 0; _i < 2; ++_i) \
        __builtin_amdgcn_global_load_lds((const unsigned*)((const char*)(gbase) + (voff)[_i]), (PG8_LAS unsigned*)(lds + (bufoff) + ldsw + _i * 8192), 16, 0, 0); } while (0)
#define PG8_LDA(dst, b, h) do { _Pragma("unroll") for (int m = 0; m < 4; ++m) _Pragma("unroll") for (int k = 0; k < 2; ++k) dst[m][k] = *(const PG8_LAS bf16x8*)(lds + PG8_SA(b, h) + aoff + m * 2048 + k * 1024); } while (0)
#define PG8_LDB(dst, b, h) do { _Pragma("unroll") for (int n = 0; n < 2; ++n) _Pragma("unroll") for (int k = 0; k < 2; ++k) dst[n][k] = *(const PG8_LAS bf16x8*)(lds + PG8_SB(b, h) + boff + n * 2048 + k * 1024); } while (0)
#define PG8_MMA(ai, bj, At, Bt) do { __builtin_amdgcn_s_setprio(1); _Pragma("unroll") for (int m = 0; m < 4; ++m) _Pragma("unroll") for (int n = 0; n < 2; ++n) _Pragma("unroll") for (int k = 0; k < 2; ++k) \
        acc[ai][bj][m][n] = __builtin_amdgcn_mfma_f32_16x16x32_bf16(Bt[n][k], At[m][k], acc[ai][bj][m][n], 0, 0, 0); __builtin_amdgcn_s_setprio(0); } while (0)
#define PG8_WAIT_V(n) asm volatile("s_waitcnt vmcnt(" #n ")" ::: "memory")
#define PG8_WAIT_L(n) asm volatile("s_waitcnt lgkmcnt(" #n ")" ::: "memory")
#define PG8_BAR __builtin_amdgcn_s_barrier()
#define PG8_SCHED __builtin_amdgcn_sched_barrier(0)
    Unit cur, nxt; int ui = 0;
    if (!S.next(0, cur)) return;
    f32x4 acc[2][2][4][2];
#pragma unroll
    for (int a = 0; a < 2; ++a)
#pragma unroll
        for (int b = 0; b < 2; ++b)
#pragma unroll
            for (int m = 0; m < 4; ++m)
#pragma unroll
                for (int n = 0; n < 2; ++n) acc[a][b][m][n] = (f32x4){0.f, 0.f, 0.f, 0.f};
    bf16x8 At[4][2], B0[2][2], B1[2][2];
    const char* cA = (const char*)g.A + (size_t)cur.pm * tstep; const char* cB = (const char*)g.Bt + (size_t)cur.pn * tstep;
    S.a_ready(cur);
    if constexpr (SP2) {
        PG8_STAGE(PG8_SB(0, 0), cB, voffB); PG8_STAGE(PG8_SB(0, 1), cB + hstep, voffB); PG8_STAGE(PG8_SA(0, 0), cA, voffA); PG8_STAGE(PG8_SA(0, 1), cA + hstep, voffA);
        if (wr == 1) PG8_BAR;
        PG8_WAIT_V(2); PG8_BAR;
        PG8_STAGE(PG8_SB(1, 0), cB + kstep, voffB); PG8_STAGE(PG8_SA(1, 0), cA + kstep, voffA); PG8_STAGE(PG8_SB(1, 1), cB + hstep + kstep, voffB);
        PG8_WAIT_V(6); PG8_BAR;
    } else {
        PG8_STAGE(PG8_SB(0, 0), cB, voffB); PG8_STAGE(PG8_SA(0, 0), cA, voffA); PG8_STAGE(PG8_SB(0, 1), cB + hstep, voffB); PG8_STAGE(PG8_SA(0, 1), cA + hstep, voffA);
        if (wr == 1) PG8_BAR;
        PG8_WAIT_V(4); PG8_BAR;
        PG8_STAGE(PG8_SB(1, 0), cB + kstep, voffB); PG8_STAGE(PG8_SA(1, 0), cA + kstep, voffA); PG8_STAGE(PG8_SB(1, 1), cB + hstep + kstep, voffB);
        PG8_WAIT_V(6); PG8_BAR;
    }
    for (;;) {
        const bool has_next = S.next(ui + 1, nxt);
        const char* nA = has_next ? (const char*)g.A + (size_t)nxt.pm * tstep : cA; const char* nB = has_next ? (const char*)g.Bt + (size_t)nxt.pn * tstep : cB;
        for (int t = 0; t < nt; t += 2) {
            const bool last = (t == nt - 2);
            const char* a1 = cA + (size_t)(t + 1) * kstep;
            const char* a2 = last ? nA : cA + (size_t)(t + 2) * kstep; const char* b2 = last ? nB : cB + (size_t)(t + 2) * kstep;
            const char* a3 = a2 + kstep; const char* b3 = b2 + kstep;
            if (last && has_next) S.a_ready(nxt);
            if constexpr (SP2) {
            PG8_LDB(B0, 0, 0); PG8_LDB(B1, 0, 1); PG8_SCHED; PG8_LDA(At, 0, 0); PG8_STAGE(PG8_SA(1, 1), a1 + hstep, voffA);
            PG8_WAIT_V(8); PG8_WAIT_L(0); PG8_BAR; PG8_MMA(0, 0, At, B0); PG8_MMA(0, 1, At, B1); PG8_BAR; PG8_SCHED;
            PG8_LDA(At, 0, 1); PG8_STAGE(PG8_SB(0, 0), b2, voffB); PG8_STAGE(PG8_SB(0, 1), b2 + hstep, voffB); PG8_STAGE(PG8_SA(0, 0), a2, voffA);
            PG8_WAIT_V(8); PG8_WAIT_L(0); PG8_BAR; PG8_MMA(1, 0, At, B0); PG8_MMA(1, 1, At, B1); PG8_BAR; PG8_SCHED;
            PG8_LDB(B0, 1, 0); PG8_LDB(B1, 1, 1); PG8_SCHED; PG8_LDA(At, 1, 0); PG8_STAGE(PG8_SA(0, 1), a2 + hstep, voffA);
            PG8_WAIT_V(8); PG8_WAIT_L(0); PG8_BAR; PG8_MMA(0, 0, At, B0); PG8_MMA(0, 1, At, B1); PG8_BAR; PG8_SCHED;
            PG8_LDA(At, 1, 1); PG8_STAGE(PG8_SB(1, 0), b3, voffB); PG8_STAGE(PG8_SB(1, 1), b3 + hstep, voffB); PG8_STAGE(PG8_SA(1, 0), a3, voffA);
            PG8_WAIT_V(8); PG8_WAIT_L(0); PG8_BAR; PG8_MMA(1, 0, At, B0); PG8_MMA(1, 1, At, B1); PG8_BAR; PG8_SCHED;
            } else {
            PG8_LDB(B0, 0, 0); PG8_SCHED; PG8_LDA(At, 0, 0); PG8_STAGE(PG8_SA(1, 1), a1 + hstep, voffA);
            PG8_WAIT_L(8); PG8_BAR; PG8_WAIT_L(0); PG8_MMA(0, 0, At, B0); PG8_BAR; PG8_SCHED;
            PG8_LDB(B1, 0, 1); PG8_STAGE(PG8_SB(0, 0), b2, voffB);
            PG8_BAR; PG8_WAIT_L(0); PG8_MMA(0, 1, At, B1); PG8_BAR;
            PG8_LDA(At, 0, 1); PG8_STAGE(PG8_SA(0, 0), a2, voffA);
            PG8_BAR; PG8_WAIT_L(0); PG8_MMA(1, 0, At, B0); PG8_BAR; PG8_SCHED;
            PG8_STAGE(PG8_SB(0, 1), b2 + hstep, voffB);
            PG8_WAIT_V(6); PG8_BAR; PG8_MMA(1, 1, At, B1); PG8_BAR;
            PG8_LDB(B0, 1, 0); PG8_SCHED; PG8_LDA(At, 1, 0); PG8_STAGE(PG8_SA(0, 1), a2 + hstep, voffA);
            PG8_WAIT_L(8); PG8_BAR; PG8_WAIT_L(0); PG8_MMA(0, 0, At, B0); PG8_BAR; PG8_SCHED;
            PG8_LDB(B1, 1, 1); PG8_STAGE(PG8_SB(1, 0), b3, voffB);
            PG8_BAR; PG8_WAIT_L(0); PG8_MMA(0, 1, At, B1); PG8_BAR;
            PG8_LDA(At, 1, 1); PG8_STAGE(PG8_SA(1, 0), a3, voffA);
            PG8_BAR; PG8_WAIT_L(0); PG8_MMA(1, 0, At, B0); PG8_BAR; PG8_SCHED;
            PG8_STAGE(PG8_SB(1, 1), b3 + hstep, voffB);
            PG8_WAIT_V(6); PG8_BAR; PG8_MMA(1, 1, At, B1); PG8_BAR;
            }
        }
        if constexpr (ALIGN_EPI) { if (wr == 0) PG8_BAR; }
        if constexpr (!Epi::AFTER_DRAIN) { E(acc, cur, wr, wc, fr, fq); S.done(cur); }
        if (!has_next) break;
#pragma unroll
        for (int a = 0; a < 2; ++a)
#pragma unroll
            for (int b = 0; b < 2; ++b)
#pragma unroll
                for (int m = 0; m < 4; ++m)
#pragma unroll
                    for (int n = 0; n < 2; ++n) acc[a][b][m][n] = (f32x4){0.f, 0.f, 0.f, 0.f};
        cur = nxt; cA = nA; cB = nB; ++ui;
        if constexpr (ALIGN_EPI) { if (wr == 1) PG8_BAR; }
    }
    PG8_WAIT_V(0);
    if constexpr (!ALIGN_EPI) { if (wr == 0) PG8_BAR; }
    PG8_BAR;
    if constexpr (Epi::AFTER_DRAIN) { E.fused(acc, cur, wr, wc, fr, fq, lds, wid, lane); S.done(cur); }
#undef PG8_SA
#undef PG8_SB
#undef PG8_STAGE
#undef PG8_LDA
#undef PG8_LDB
#undef PG8_MMA
#undef PG8_WAIT_V
#undef PG8_WAIT_L
#undef PG8_BAR
#undef PG8_SCHED
}
}

__device__ __forceinline__ unsigned pkbf(float lo, float hi) { return pg8::cvt_pk_bf16(lo, hi); }
__device__ __forceinline__ void st8bf(bf16_t* p, f32x4 a, f32x4 b) { u32x4 w; w.x = pkbf(a[0], a[1]); w.y = pkbf(a[2], a[3]); w.z = pkbf(b[0], b[1]); w.w = pkbf(b[2], b[3]); *(u32x4*)p = w; }
__device__ __forceinline__ f32x4 bflo(u32x4 g) { f32x4 o; o[0] = __uint_as_float(g.x << 16); o[1] = __uint_as_float(g.x & 0xffff0000u); o[2] = __uint_as_float(g.y << 16); o[3] = __uint_as_float(g.y & 0xffff0000u); return o; }
__device__ __forceinline__ f32x4 bfhi(u32x4 g) { f32x4 o; o[0] = __uint_as_float(g.z << 16); o[1] = __uint_as_float(g.z & 0xffff0000u); o[2] = __uint_as_float(g.w << 16); o[3] = __uint_as_float(g.w & 0xffff0000u); return o; }
__device__ __forceinline__ f32x4 bf4(u32x2 g) { f32x4 o; o[0] = __uint_as_float(g.x << 16); o[1] = __uint_as_float(g.x & 0xffff0000u); o[2] = __uint_as_float(g.y << 16); o[3] = __uint_as_float(g.y & 0xffff0000u); return o; }
__device__ __forceinline__ void rot8(f32x4& a, f32x4& b, f32x4 c, f32x4 s) {
    const f32x4 x = a, y = b;
    a[0] = x[0] * c[0] - x[1] * s[0]; a[1] = x[1] * c[0] + x[0] * s[0]; a[2] = x[2] * c[1] - x[3] * s[1]; a[3] = x[3] * c[1] + x[2] * s[1];
    b[0] = y[0] * c[2] - y[1] * s[2]; b[1] = y[1] * c[2] + y[0] * s[2]; b[2] = y[2] * c[3] - y[3] * s[3]; b[3] = y[3] * c[3] + y[2] * s[3];
}
__device__ __forceinline__ f32x4 sig4(f32x4 v) { f32x4 o; o[0] = 1.f / (1.f + __expf(-v[0])); o[1] = 1.f / (1.f + __expf(-v[1])); o[2] = 1.f / (1.f + __expf(-v[2])); o[3] = 1.f / (1.f + __expf(-v[3])); return o; }
__host__ __device__ __forceinline__ int src_in(int n) {
    if (n < 1024) return n;
    if (n < 4096) { const int seg = (n - 1024) >> 10, c = (n - 1024) & 1023, d = c & 127; int od = d; if (seg < 2 && d < 32) od = (d >> 1) + (d & 1) * 16; return 1088 + seg * 1024 + (c & ~127) + od; }
    if (n < 5120) { const int c = n - 4096, d = c & 63; const int od = d < 16 ? (d >> 1) + (d & 1) * 8 : d; return 4160 + (c & ~63) + od; }
    if (n < 7168) return 5264 + (n - 5120);
    if (n < 9216) return 7312 + (n - 7168);
    if (n < 9280) { const int d = n - 9216; return 1024 + (d >> 1) + (d & 1) * 32; }
    if (n < 9344) { const int d = n - 9280; const int od = d < 16 ? (d >> 1) + (d & 1) * 8 : d; return 5184 + od; }
    if (n < 9360) return 5248 + (n - 9344);
    return -1;
}
__host__ __device__ __forceinline__ int src_qa(int n) { const int h = n / 192, d = n - h * 192; if (d < 128) return n; const int dd = d - 128; return h * 192 + 128 + (dd >> 1) + (dd & 1) * 32; }

struct EpiIn {
    static constexpr bool PERM = true, AFTER_DRAIN = false;
    unsigned char* ws;
    __device__ __forceinline__ void operator()(const f32x4 (&acc)[2][2][4][2], const pg8::Unit& u, int wr, int wc, int fr, int fq) const {
        const int row0 = u.pm * 256 + wr * 64 + fr, cu = wc * 32 + 8 * fq, pn = u.pn;
        bf16_t* const CQ = (bf16_t*)(ws + WS_CQ); bf16_t* const QB = (bf16_t*)(ws + WS_QB); bf16_t* const QI = (bf16_t*)(ws + WS_QI); bf16_t* const GA = (bf16_t*)(ws + WS_GA);
        bf16_t* const KA = (bf16_t*)(ws + WS_KA); bf16_t* const KI = (bf16_t*)(ws + WS_KI); float* const WI = (float*)(ws + WS_WI); float* const part = (float*)(ws + WS_SSQ);
        const float* const cM = (const float*)(ws + WS_ROPE); const float* const sM = cM + T * 32; const float* const cD = cM + T * 64; const float* const sD = cM + T * 80; const float* const cI = cM + T * 96; const float* const sI = cM + T * 104;
#define EPI_ROWS(BODY) _Pragma("unroll") for (int ai = 0; ai < 2; ++ai) _Pragma("unroll") for (int m = 0; m < 4; ++m) { const int t = row0 + ai * 128 + m * 16; \
            _Pragma("unroll") for (int bj = 0; bj < 2; ++bj) { f32x4 a = acc[ai][bj][m][0], b = acc[ai][bj][m][1]; BODY } }
        if (pn < 4) {
            bf16_t* const dst = CQ + (size_t)(pn >> 1) * ((size_t)T * 512) + (pn & 1) * 256 + cu;
            EPI_ROWS(
                st8bf(dst + (size_t)t * 512 + bj * 128, a, b);
                float sq = ((a[0] * a[0] + a[1] * a[1]) + (a[2] * a[2] + a[3] * a[3])) + ((b[0] * b[0] + b[1] * b[1]) + (b[2] * b[2] + b[3] * b[3]));
                sq += __shfl_xor(sq, 16); sq += __shfl_xor(sq, 32);
                if (fq == 0) part[(size_t)t * 32 + pn * 8 + bj * 4 + wc] = sq; )
        } else if (pn < 16) {
            const int seg = (pn - 4) >> 2; const bool rot = seg < 2 && wc == 0;
            bf16_t* const dst = QB + (size_t)seg * ((size_t)T * 1024) + ((pn - 4) & 3) * 256 + cu;
            EPI_ROWS(
                if (rot) rot8(a, b, *(const f32x4*)(cD + (size_t)t * 16 + 4 * fq), *(const f32x4*)(sD + (size_t)t * 16 + 4 * fq));
                st8bf(dst + (size_t)t * 1024 + bj * 128, a, b); )
        } else if (pn < 20) {
            const bool rot = (wc & 1) == 0 && fq < 2;
            bf16_t* const dst = QI + (pn - 16) * 256 + cu;
            EPI_ROWS(
                if (rot) rot8(a, b, *(const f32x4*)(cI + (size_t)t * 8 + 4 * fq), *(const f32x4*)(sI + (size_t)t * 8 + 4 * fq));
                st8bf(dst + (size_t)t * 1024 + bj * 128, a, b); )
        } else if (pn < 36) {
            bf16_t* const dst = GA + (size_t)((pn - 20) >> 3) * ((size_t)T * D) + ((pn - 20) & 7) * 256 + cu;
            EPI_ROWS( st8bf(dst + (size_t)t * D + bj * 128, sig4(a), sig4(b)); )
        } else {
            EPI_ROWS(
                if (bj == 0) {
                    if (wc < 2) {
                        rot8(a, b, *(const f32x4*)(cM + (size_t)t * 32 + (cu >> 1)), *(const f32x4*)(sM + (size_t)t * 32 + (cu >> 1)));
                        _Pragma("unroll") for (int h = 0; h < 8; ++h) st8bf(KA + (size_t)t * 1536 + h * 192 + 128 + cu, a, b);
                    } else {
                        const int d = cu - 64;
                        if (d < 16) rot8(a, b, *(const f32x4*)(cI + (size_t)t * 8 + (d >> 1)), *(const f32x4*)(sI + (size_t)t * 8 + (d >> 1)));
                        st8bf(KI + (size_t)t * 64 + d, a, b);
                    }
                } else if (cu < 16) {
                    *(f32x4*)(WI + (size_t)t * 16 + cu) = a * 0.03125f; *(f32x4*)(WI + (size_t)t * 16 + cu + 4) = b * 0.03125f;
                } )
        }
#undef EPI_ROWS
    }
};
__device__ __forceinline__ float rms_from_part(const float* pp) {
    const f32x4 p0 = *(const f32x4*)pp, p1 = *(const f32x4*)(pp + 4), p2 = *(const f32x4*)(pp + 8), p3 = *(const f32x4*)(pp + 12);
    const float s = (((p0[0] + p0[1]) + (p0[2] + p0[3])) + ((p1[0] + p1[1]) + (p1[2] + p1[3]))) + (((p2[0] + p2[1]) + (p2[2] + p2[3])) + ((p3[0] + p3[1]) + (p3[2] + p3[3])));
    return rsqrtf(s * (1.f / 512.f) + 1e-6f);
}
struct EpiQA {
    static constexpr bool PERM = true, AFTER_DRAIN = false;
    unsigned char* ws;
    __device__ __forceinline__ void operator()(const f32x4 (&acc)[2][2][4][2], const pg8::Unit& u, int wr, int wc, int fr, int fq) const {
        const int row0 = u.pm * 256 + wr * 64 + fr, cu = wc * 32 + 8 * fq;
        bf16_t* const QA = (bf16_t*)(ws + WS_QA); const float* const part = (const float*)(ws + WS_SSQ); const float* const cM = (const float*)(ws + WS_ROPE); const float* const sM = cM + T * 32;
#pragma unroll
        for (int ai = 0; ai < 2; ++ai)
#pragma unroll
            for (int m = 0; m < 4; ++m) {
                const int t = row0 + ai * 128 + m * 16;
                const float r = rms_from_part(part + (size_t)t * 32);
#pragma unroll
                for (int bj = 0; bj < 2; ++bj) {
                    const int n = u.pn * 256 + bj * 128 + cu, h = n / 192, d = n - h * 192;
                    f32x4 a = acc[ai][bj][m][0] * r, b = acc[ai][bj][m][1] * r;
                    if (d >= 128) rot8(a, b, *(const f32x4*)(cM + (size_t)t * 32 + ((d - 128) >> 1)), *(const f32x4*)(sM + (size_t)t * 32 + ((d - 128) >> 1)));
                    st8bf(QA + (size_t)t * 1536 + n, a, b);
                }
            }
    }
};
struct EpiKV {
    static constexpr bool PERM = true, AFTER_DRAIN = false;
    unsigned char* ws;
    __device__ __forceinline__ void operator()(const f32x4 (&acc)[2][2][4][2], const pg8::Unit& u, int wr, int wc, int fr, int fq) const {
        const int row0 = u.pm * 256 + wr * 64 + fr, cu = wc * 32 + 8 * fq;
        bf16_t* const KA = (bf16_t*)(ws + WS_KA); bf16_t* const VA = (bf16_t*)(ws + WS_VA); const float* const part = (const float*)(ws + WS_SSQ);
#pragma unroll
        for (int ai = 0; ai < 2; ++ai)
#pragma unroll
            for (int m = 0; m < 4; ++m) {
                const int t = row0 + ai * 128 + m * 16;
                const float r = rms_from_part(part + (size_t)t * 32 + 16);
                st8bf(KA + (size_t)t * 1536 + u.pn * 192 + cu, acc[ai][0][m][0] * r, acc[ai][0][m][1] * r);
                st8bf(VA + (size_t)t * 1024 + u.pn * 128 + cu, acc[ai][1][m][0] * r, acc[ai][1][m][1] * r);
            }
    }
};
struct EpiYA {
    static constexpr bool PERM = true, AFTER_DRAIN = false;
    unsigned char* ws;
    __device__ __forceinline__ void operator()(const f32x4 (&acc)[2][2][4][2], const pg8::Unit& u, int wr, int wc, int fr, int fq) const {
        const int row0 = u.pm * 256 + wr * 64 + fr, col0 = u.pn * 256 + wc * 32 + 8 * fq;
        float* const YT = (float*)(ws + WS_YT); const bf16_t* const GA = (const bf16_t*)(ws + WS_GA);
#pragma unroll
        for (int ai = 0; ai < 2; ++ai)
#pragma unroll
            for (int m = 0; m < 4; ++m)
#pragma unroll
                for (int bj = 0; bj < 2; ++bj) {
                    const size_t o = (size_t)(row0 + ai * 128 + m * 16) * D + col0 + bj * 128;
                    const u32x4 g = *(const u32x4*)(GA + o);
                    *(f32x4*)(YT + o) = acc[ai][bj][m][0] * bflo(g); *(f32x4*)(YT + o + 4) = acc[ai][bj][m][1] * bfhi(g);
                }
    }
};
struct EpiYB {
    static constexpr bool PERM = true, AFTER_DRAIN = false;
    unsigned char* ws;
    __device__ __forceinline__ void operator()(const f32x4 (&acc)[2][2][4][2], const pg8::Unit& u, int wr, int wc, int fr, int fq) const {
        const int row0 = u.pm * 256 + wr * 64 + fr, col0 = u.pn * 256 + wc * 32 + 8 * fq;
        const float* const YT = (const float*)(ws + WS_YT); const bf16_t* const GB = (const bf16_t*)(ws + WS_GB); bf16_t* const Y = (bf16_t*)(ws + WS_Y);
#pragma unroll
        for (int ai = 0; ai < 2; ++ai)
#pragma unroll
            for (int m = 0; m < 4; ++m)
#pragma unroll
                for (int bj = 0; bj < 2; ++bj) {
                    const size_t o = (size_t)(row0 + ai * 128 + m * 16) * D + col0 + bj * 128;
                    const u32x4 g = *(const u32x4*)(GB + o);
                    const f32x4 y0 = *(const f32x4*)(YT + o), y1 = *(const f32x4*)(YT + o + 4);
                    st8bf(Y + o, y0 + acc[ai][bj][m][0] * bflo(g), y1 + acc[ai][bj][m][1] * bfhi(g));
                }
    }
};
struct EpiOut {
    static constexpr bool PERM = true, AFTER_DRAIN = false;
    const float* hin; float* V1;
    __device__ __forceinline__ void operator()(const f32x4 (&acc)[2][2][4][2], const pg8::Unit& u, int wr, int wc, int fr, int fq) const {
        const int row0 = u.pm * 256 + wr * 64 + fr, col0 = u.pn * 256 + wc * 32 + 8 * fq;
#pragma unroll
        for (int ai = 0; ai < 2; ++ai)
#pragma unroll
            for (int m = 0; m < 4; ++m)
#pragma unroll
                for (int bj = 0; bj < 2; ++bj) {
                    const size_t o = (size_t)(row0 + ai * 128 + m * 16) * D + col0 + bj * 128;
                    const f32x4 h0 = *(const f32x4*)(hin + o), h1 = *(const f32x4*)(hin + o + 4);
                    *(f32x4*)(V1 + o) = h0 * ALPHA + acc[ai][bj][m][0]; *(f32x4*)(V1 + o + 4) = h1 * ALPHA + acc[ai][bj][m][1];
                }
    }
};

#define LDS_WAIT() asm volatile("s_waitcnt lgkmcnt(0)" ::: "memory")
template <int MAP>
__device__ __forceinline__ void transpose_item(const float* W, int ldw, int K, int N, const float* kscale, bf16_t* WT, LAS float* scr, int item, int lane) {
    const int nblk = N / 32, kb = item / nblk, nb = item % nblk, k0 = 64 * kb, n0 = 32 * nb;
    const int n = n0 + (lane & 31);
    const int sc = MAP == 0 ? n : (MAP == 1 ? src_in(n) : src_qa(n));
#pragma unroll 8
    for (int i = 0; i < 32; ++i) { const int kk = 2 * i + (lane >> 5);
        float v = sc >= 0 ? W[(size_t)(k0 + kk) * ldw + sc] : 0.f; if (kscale) v *= kscale[k0 + kk];
        scr[kk * 33 + (lane & 31)] = v; }
    LDS_WAIT(); asm volatile("" ::: "memory");
    const int c = lane & 7;
#pragma unroll
    for (int j = 0; j < 4; ++j) { const int nn = (lane >> 3) + 8 * j; const LAS float* sp = scr + (8 * c) * 33 + nn;
        u32x4 o; o.x = pkbf(sp[0 * 33], sp[1 * 33]); o.y = pkbf(sp[2 * 33], sp[3 * 33]); o.z = pkbf(sp[4 * 33], sp[5 * 33]); o.w = pkbf(sp[6 * 33], sp[7 * 33]);
        *(u32x4*)(WT + (size_t)(n0 + nn) * K + k0 + 8 * c) = o; }
    LDS_WAIT(); asm volatile("" ::: "memory");
}
__device__ __forceinline__ void p_prologue(LAS unsigned char* ldsb, const Params& p) {
    float* rope = (float*)(p.ws + WS_ROPE);
    float *cM = rope, *sM = rope + T * 32, *cD = rope + T * 64, *sD = rope + T * 80, *cI = rope + T * 96, *sI = rope + T * 104;
    const int gtid = blockIdx.x * NTHREADS + threadIdx.x, gstride = gridDim.x * NTHREADS;
    for (int idx = gtid; idx < T * 56; idx += gstride) {
        const int t = idx / 56, j = idx - t * 56;
        int rot, i; float *ct, *st; int w;
        if (j < 32) { rot = 64; i = j; ct = cM; st = sM; w = 32; } else if (j < 48) { rot = 32; i = j - 32; ct = cD; st = sD; w = 16; } else { rot = 16; i = j - 48; ct = cI; st = sI; w = 8; }
        const float inv = exp2f(-((float)(2 * i) / (float)rot) * 18.931568569324174f);
        const float ang = (float)p.pos[t] * inv;
        double rev = (double)ang * 0.15915494309189535; rev -= rint(rev);
        const float r = (float)(rev * 6.283185307179586);
        ct[t * w + i] = __cosf(r); st[t * w + i] = __sinf(r);
    }
    bf16_t* XB = (bf16_t*)(p.ws + WS_XB);
    for (size_t i = (size_t)gtid * 4; i < (size_t)T * D; i += (size_t)gstride * 4) st4bf(XB + i, *(const f32x4*)(p.x + i));
    const int wave = threadIdx.x >> 6, lane = threadIdx.x & 63;
    LAS float* scr = (LAS float*)(ldsb + wave * 16384);
    const int gw = blockIdx.x * 8 + wave, NGW = gridDim.x * 8;
    constexpr int I_IN = (D / 64) * (INP / 32), I_QB = (512 / 64) * (1536 / 32), I_KV = (512 / 64) * (2048 / 32), I_O = (1024 / 64) * (D / 32), I_OUT = (D / 64) * (D / 32);
    constexpr int I_LAYER = I_IN + I_QB + I_KV + 2 * I_O + I_OUT;
    for (int it = gw; it < DEPTH * I_LAYER; it += NGW) {
        const int l = it / I_LAYER; int r = it - l * I_LAYER;
        if (r < I_IN) { transpose_item<1>(p.w_in + (size_t)l * D * INW, INW, D, INP, nullptr, (bf16_t*)(p.ws + WS_WIN_T) + (size_t)l * INP * D, scr, r, lane); continue; } r -= I_IN;
        if (r < I_QB) { transpose_item<2>(p.w_qb + (size_t)l * 512 * 1536, 1536, 512, 1536, p.g_q + l * 512, (bf16_t*)(p.ws + WS_WQB_T) + (size_t)l * 1536 * 512, scr, r, lane); continue; } r -= I_QB;
        if (r < I_KV) { transpose_item<0>(p.w_kvb + (size_t)l * 512 * 2048, 2048, 512, 2048, p.g_kv + l * 512, (bf16_t*)(p.ws + WS_WKVB_T) + (size_t)l * 2048 * 512, scr, r, lane); continue; } r -= I_KV;
        if (r < I_O) { transpose_item<0>(p.w_oa + (size_t)l * 1024 * D, D, 1024, D, nullptr, (bf16_t*)(p.ws + WS_WOA_T) + (size_t)l * D * 1024, scr, r, lane); continue; } r -= I_O;
        if (r < I_O) { transpose_item<0>(p.w_ob + (size_t)l * 1024 * D, D, 1024, D, nullptr, (bf16_t*)(p.ws + WS_WOB_T) + (size_t)l * D * 1024, scr, r, lane); continue; } r -= I_O;
        transpose_item<0>(p.w_out + (size_t)l * D * D, D, D, D, nullptr, (bf16_t*)(p.ws + WS_WOUT_T) + (size_t)l * D * D, scr, r, lane);
    }
    __syncthreads();
}

__device__ __forceinline__ unsigned f2key(float f) { const unsigned u = __float_as_uint(f); return (u & 0x80000000u) ? ~u : (u | 0x80000000u); }
__device__ __forceinline__ void p_index(float* lds, const Params& p) {
    const bf16_t* QI = (const bf16_t*)(p.ws + WS_QI); const bf16_t* KI = (const bf16_t*)(p.ws + WS_KI); const float* WI = (const float*)(p.ws + WS_WI);
    unsigned* MASK = (unsigned*)(p.ws + WS_MASK);
    float* qs = lds; float* wsc = lds + 1024; float* sc = lds + 1040; int* red = (int*)(lds + 1040 + 4096);
    const int tid = opaque_tid(), lane = tid & 63, wv = tid >> 6;
    for (int t = blockIdx.x; t < T; t += gridDim.x) {
        const int b = t >> 12, ti = t & 4095, nk = ti + 1;
        __syncthreads();
        for (int i = tid; i < 1024; i += NTHREADS) qs[i] = bf2f(QI[(size_t)t * 1024 + i]);
        if (tid < 16) wsc[tid] = WI[(size_t)t * 16 + tid];
        __syncthreads();
        for (int s = tid; s < nk; s += NTHREADS) {
            const bf16_t* kr = KI + (size_t)(b * S + s) * 64;
            float score = 0.f;
#pragma unroll 1
            for (int h = 0; h < 16; ++h) {
                asm volatile("" ::: "memory");
                float dot = 0.f;
#pragma unroll
                for (int c = 0; c < 8; ++c) {
                    const u32x4 raw = *(const u32x4*)(kr + c * 8);
                    const f32x4 q0 = *(const f32x4*)(qs + h * 64 + c * 8), q1 = *(const f32x4*)(qs + h * 64 + c * 8 + 4);
                    dot = fmaf(q0[0], __uint_as_float(raw.x << 16), dot); dot = fmaf(q0[1], __uint_as_float(raw.x & 0xffff0000u), dot);
                    dot = fmaf(q0[2], __uint_as_float(raw.y << 16), dot); dot = fmaf(q0[3], __uint_as_float(raw.y & 0xffff0000u), dot);
                    dot = fmaf(q1[0], __uint_as_float(raw.z << 16), dot); dot = fmaf(q1[1], __uint_as_float(raw.z & 0xffff0000u), dot);
                    dot = fmaf(q1[2], __uint_as_float(raw.w << 16), dot); dot = fmaf(q1[3], __uint_as_float(raw.w & 0xffff0000u), dot);
                }
                score = fmaf(wsc[h], fmaxf(dot, 0.f), score);
            }
            sc[s] = score;
        }
        __syncthreads();
        unsigned k0 = 0u, k1 = 0u, k2 = 0u, k3 = 0u, k4 = 0u, k5 = 0u, k6 = 0u, k7 = 0u;
        if (tid < nk) k0 = f2key(sc[tid]);
        if (tid + 512 < nk) k1 = f2key(sc[tid + 512]);
        if (tid + 1024 < nk) k2 = f2key(sc[tid + 1024]);
        if (tid + 1536 < nk) k3 = f2key(sc[tid + 1536]);
        if (tid + 2048 < nk) k4 = f2key(sc[tid + 2048]);
        if (tid + 2560 < nk) k5 = f2key(sc[tid + 2560]);
        if (tid + 3072 < nk) k6 = f2key(sc[tid + 3072]);
        if (tid + 3584 < nk) k7 = f2key(sc[tid + 3584]);
        unsigned res = 0u;
        if (nk > 256) {
#pragma unroll 1
            for (int bit = 31; bit >= 0; --bit) {
                const unsigned cand = res | (1u << bit);
                const int c = (k0 >= cand) + (k1 >= cand) + (k2 >= cand) + (k3 >= cand) + (k4 >= cand) + (k5 >= cand) + (k6 >= cand) + (k7 >= cand);
                if (block_sum_int(c, red) >= 256) res = cand;
            }
        }
        unsigned* mw = MASK + (size_t)t * 128 + 2 * wv;
#define MASK_OUT(j, kj) do { const unsigned long long bal = __ballot((tid + 512 * (j) < nk) && ((kj) >= res)); if (lane == 0) { mw[16 * (j)] = (unsigned)bal; mw[16 * (j) + 1] = (unsigned)(bal >> 32); } } while (0)
        MASK_OUT(0, k0); MASK_OUT(1, k1); MASK_OUT(2, k2); MASK_OUT(3, k3); MASK_OUT(4, k4); MASK_OUT(5, k5); MASK_OUT(6, k6); MASK_OUT(7, k7);
#undef MASK_OUT
    }
    __syncthreads();
}

typedef short bf16x8 __attribute__((ext_vector_type(8)));
typedef short s16x4 __attribute__((ext_vector_type(4)));
typedef float f32x16 __attribute__((ext_vector_type(16)));
__device__ __forceinline__ void p_score(LAS unsigned char* ldsb, unsigned char* ws) {
    const bf16_t* QI = (const bf16_t*)(ws + WS_QI); const bf16_t* KI = (const bf16_t*)(ws + WS_KI); const float* WI = (const float*)(ws + WS_WI);
    unsigned* SC = (unsigned*)(ws + WS_SCORE);
    const int tid = opaque_tid(), lane = tid & 63, wv = __builtin_amdgcn_readfirstlane(tid >> 6), r32 = lane & 31, hi = lane >> 5;
    const int ksw = ((r32 >> 1) & 7) ^ hi;
    const unsigned krow = (unsigned)(size_t)ldsb + (unsigned)r32 * 128u;
    for (int item = blockIdx.x; item < 544; item += gridDim.x) {
        const int b = item / 272; int r = item - b * 272, qb = 0;
        while (r >= 2 * qb + 2) { r -= 2 * qb + 2; ++qb; }
        const int kc = r, q0 = qb * 256 + wv * 32;
        __builtin_amdgcn_s_barrier();
#pragma unroll
        for (int i = 0; i < 2; ++i) { const int g = i * 512 + tid, row = g >> 3, ch = (g & 7) ^ ((row >> 1) & 7);
            __builtin_amdgcn_global_load_lds((const unsigned*)(KI + (size_t)(b * S + kc * 128 + row) * 64 + ch * 8), (LAS unsigned*)(ldsb + (i * 512 + wv * 64) * 16), 16, 0, 0); }
        asm volatile("s_waitcnt vmcnt(0)" ::: "memory");
        __builtin_amdgcn_s_barrier();
        if (kc * 128 <= q0 + 31) {
            const size_t t = (size_t)b * S + q0 + r32;
            bf16x8 ka[4][4];
#pragma unroll
            for (int kb = 0; kb < 4; ++kb)
#pragma unroll
                for (int d0 = 0; d0 < 4; ++d0) ka[kb][d0] = *(const LAS bf16x8*)(size_t)(krow + kb * 4096 + ((unsigned)((2 * d0) ^ ksw) << 4));
            f32x16 acc[4];
#pragma unroll
            for (int kb = 0; kb < 4; ++kb)
#pragma unroll
                for (int rr = 0; rr < 16; ++rr) acc[kb][rr] = 0.f;
            const bf16_t* qrow = QI + t * 1024 + 8 * hi; const float* wrow = WI + t * 16;
            bf16x8 qf[4]; float wh = wrow[0];
#pragma unroll
            for (int d0 = 0; d0 < 4; ++d0) qf[d0] = *(const bf16x8*)(qrow + 16 * d0);
#pragma unroll 1
            for (int h = 0; h < 16; ++h) {
                const int hn = (h + 1) & 15;
                bf16x8 qn[4]; const float wn = wrow[hn];
#pragma unroll
                for (int d0 = 0; d0 < 4; ++d0) qn[d0] = *(const bf16x8*)(qrow + hn * 64 + 16 * d0);
#pragma unroll
                for (int kb = 0; kb < 4; ++kb) {
                    f32x16 pz;
#pragma unroll
                    for (int rr = 0; rr < 16; ++rr) pz[rr] = 0.f;
#pragma unroll
                    for (int d0 = 0; d0 < 4; ++d0) pz = __builtin_amdgcn_mfma_f32_32x32x16_bf16(ka[kb][d0], qf[d0], pz, 0, 0, 0);
#pragma unroll
                    for (int rr = 0; rr < 16; ++rr) acc[kb][rr] = fmaf(wh, fmaxf(pz[rr], 0.f), acc[kb][rr]);
                }
#pragma unroll
                for (int d0 = 0; d0 < 4; ++d0) qf[d0] = qn[d0];
                wh = wn;
            }
            const int dq = q0 + r32 - kc * 128 - 4 * hi;
            unsigned* srow = SC + t * 4096 + kc * 128 + 4 * hi;
#pragma unroll
            for (int kb = 0; kb < 4; ++kb)
#pragma unroll
                for (int rq = 0; rq < 4; ++rq) { u32x4 o; const int c0 = 32 * kb + 8 * rq;
                    o.x = (c0 <= dq) ? f2key(acc[kb][4 * rq]) : 0u; o.y = (c0 + 1 <= dq) ? f2key(acc[kb][4 * rq + 1]) : 0u;
                    o.z = (c0 + 2 <= dq) ? f2key(acc[kb][4 * rq + 2]) : 0u; o.w = (c0 + 3 <= dq) ? f2key(acc[kb][4 * rq + 3]) : 0u;
                    *(u32x4*)(srow + c0) = o; }
        }
    }
    __builtin_amdgcn_s_barrier();
}
__device__ __forceinline__ void p_select(unsigned char* ws) {
    const unsigned* SC = (const unsigned*)(ws + WS_SCORE); unsigned* MASK = (unsigned*)(ws + WS_MASK);
    const int tid = opaque_tid(), lane = tid & 63, wv = tid >> 6;
    for (int t = blockIdx.x * 8 + wv; t < T; t += gridDim.x * 8) {
        const int ti = t & 4095, nq = (ti >> 8) + 1;
        const unsigned* row = SC + (size_t)t * 4096 + 4 * lane;
        u32x4 k[16];
#pragma unroll
        for (int j = 0; j < 16; ++j) { k[j] = (u32x4){0u, 0u, 0u, 0u};
            if (j < nq) { k[j] = *(const u32x4*)(row + 256 * j);
                const int p0 = 256 * j + 4 * lane; if (p0 > ti) k[j].x = 0u; if (p0 + 1 > ti) k[j].y = 0u; if (p0 + 2 > ti) k[j].z = 0u; if (p0 + 3 > ti) k[j].w = 0u; } }
        unsigned res = 1u;
        if (ti >= 256) {
            res = 0u;
#pragma unroll 1
            for (int bit = 31; bit >= 0; --bit) {
                const unsigned cand = res | (1u << bit);
                int c = 0;
#pragma unroll
                for (int j = 0; j < 16; ++j) c += (int)(k[j].x >= cand) + (int)(k[j].y >= cand) + (int)(k[j].z >= cand) + (int)(k[j].w >= cand);
#pragma unroll
                for (int o = 32; o >= 1; o >>= 1) c += __shfl_xor(c, o);
                if (c >= 256) res = cand;
            }
        }
        unsigned* mrow = MASK + (size_t)t * 128 + (lane >> 3);
#pragma unroll
        for (int j = 0; j < 16; ++j) {
            unsigned nib = (unsigned)(k[j].x >= res) | ((unsigned)(k[j].y >= res) << 1) | ((unsigned)(k[j].z >= res) << 2) | ((unsigned)(k[j].w >= res) << 3);
            nib <<= 4 * (lane & 7);
            nib |= __shfl_xor(nib, 1); nib |= __shfl_xor(nib, 2); nib |= __shfl_xor(nib, 4);
            if ((lane & 7) == 0) mrow[8 * j] = nib;
        }
    }
}

template <int DQK, bool MASKED>
__device__ __forceinline__ void attn_unit(LAS unsigned char* ldsb, const bf16_t* Qg, int ldq, const bf16_t* Kg, int ldk, const bf16_t* Vg, int ldv, const unsigned* maskg, bf16_t* Og, int ldo, int qb, float sl2) {
    constexpr int CPR = DQK / 8, KBYTES = 64 * DQK * 2, VBYTES = 64 * 128 * 2, NKI = CPR * 64 / 512, ND = DQK / 16;
    constexpr int VOFF = 2 * KBYTES;
    const int tid = opaque_tid(), lane = tid & 63, wv = __builtin_amdgcn_readfirstlane(tid >> 6), r32 = lane & 31, hi = lane >> 5;
    const int NT = 4 * qb + 4, q0 = qb * 256 + wv * 32;
    const float NEG = -__builtin_inff();
    bf16x8 qr[ND];
#pragma unroll
    for (int d0 = 0; d0 < ND; ++d0) qr[d0] = *(const bf16x8*)(Qg + (size_t)(q0 + r32) * ldq + 16 * d0 + 8 * hi);
    const bf16_t* ksrc[NKI]; const bf16_t* vsrc[2];
#pragma unroll
    for (int i = 0; i < NKI; ++i) { const int g = i * 512 + tid, row = g / CPR, cp = g - row * CPR; const int ch = cp ^ (DQK == 128 ? (row & 15) : ((row >> 1) & 7)); ksrc[i] = Kg + (size_t)row * ldk + ch * 8; }
#pragma unroll
    for (int i = 0; i < 2; ++i) { const int g = i * 512 + tid, row = g >> 4, c16 = g & 15; const int blk = (c16 >> 2) ^ (row & 3); vsrc[i] = Vg + (size_t)row * ldv + (blk * 4 + (c16 & 3)) * 8; }
#define AT_STAGE(t_, buf_) do { \
        _Pragma("unroll") for (int i_ = 0; i_ < NKI; ++i_) __builtin_amdgcn_global_load_lds((const unsigned*)(ksrc[i_] + (size_t)(t_) * 64 * ldk), (LAS unsigned*)(ldsb + (buf_) * KBYTES + (i_ * 512 + wv * 64) * 16), 16, 0, 0); \
        _Pragma("unroll") for (int i_ = 0; i_ < 2; ++i_) __builtin_amdgcn_global_load_lds((const unsigned*)(vsrc[i_] + (size_t)(t_) * 64 * ldv), (LAS unsigned*)(ldsb + VOFF + (buf_) * VBYTES + (i_ * 512 + wv * 64) * 16), 16, 0, 0); } while (0)
    const int ksw = (DQK == 128 ? (r32 & 15) : ((r32 >> 1) & 7)) ^ hi;
    const unsigned krow = (unsigned)(size_t)ldsb + (unsigned)r32 * (DQK * 2);
    const int vq = (lane >> 2) & 3, vp = lane & 3, vg = lane >> 4;
    const unsigned vrow = (unsigned)(size_t)ldsb + VOFF + (unsigned)(4 * (vg >> 1) + vq) * 256 + (vg & 1) * 32 + vp * 8;
    float m_run = -1e30f, l_run = 0.f;
    f32x16 oT[4];
#pragma unroll
    for (int d0 = 0; d0 < 4; ++d0)
#pragma unroll
        for (int r = 0; r < 16; ++r) oT[d0][r] = 0.f;
    u32x2 mw_cur = {0u, 0u}, mw_nxt = {0u, 0u};
    const unsigned* mrow = MASKED ? maskg + (size_t)(q0 + r32) * 128 : nullptr;
    if (MASKED) mw_cur = *(const u32x2*)mrow;
    AT_STAGE(0, 0);
    asm volatile("s_waitcnt vmcnt(0)" ::: "memory");
    __builtin_amdgcn_s_barrier();
#define TRRD(dst, addr, off) asm volatile("ds_read_b64_tr_b16 %0, %1 offset:%2" : "=&v"(dst) : "v"(addr), "i"(off) : "memory")
#define AT_STEP(t_, buf_) do { \
        const int t = (t_); \
        if (t + 1 < NT) { if (MASKED) mw_nxt = *(const u32x2*)(mrow + 2 * (t + 1)); AT_STAGE(t + 1, (buf_) ^ 1); } \
        if (t * 64 <= q0 + 31) {                                    \
            int kx = ksw; asm volatile("" : "+v"(kx)); \
            f32x16 p0, p1; \
            _Pragma("unroll") for (int r = 0; r < 16; ++r) { p0[r] = 0.f; p1[r] = 0.f; } \
            _Pragma("unroll") for (int d0 = 0; d0 < ND; ++d0) { \
                const unsigned ka = krow + (buf_) * KBYTES + ((unsigned)((2 * d0) ^ kx) << 4); \
                const bf16x8 a0 = *(const LAS bf16x8*)(size_t)ka; const bf16x8 a1 = *(const LAS bf16x8*)(size_t)(ka + 32 * DQK * 2); \
                p0 = __builtin_amdgcn_mfma_f32_32x32x16_bf16(a0, qr[d0], p0, 0, 0, 0); \
                p1 = __builtin_amdgcn_mfma_f32_32x32x16_bf16(a1, qr[d0], p1, 0, 0, 0); } \
            if (MASKED) { \
                _Pragma("unroll") for (int r = 0; r < 16; ++r) { const int c = (r & 3) + 8 * (r >> 2) + 4 * hi; \
                    if (!((mw_cur.x >> c) & 1u)) p0[r] = NEG; if (!((mw_cur.y >> c) & 1u)) p1[r] = NEG; } \
            } else if (t * 64 + 63 > q0) {                          \
                const int dq = q0 + r32 - t * 64 - 4 * hi; \
                _Pragma("unroll") for (int r = 0; r < 16; ++r) { const int c = (r & 3) + 8 * (r >> 2); if (c > dq) p0[r] = NEG; if (c + 32 > dq) p1[r] = NEG; } \
            } \
            float mx = p0[0]; \
            _Pragma("unroll") for (int r = 1; r < 16; ++r) mx = fmaxf(mx, p0[r]); \
            _Pragma("unroll") for (int r = 0; r < 16; ++r) mx = fmaxf(mx, p1[r]); \
            { auto rr = __builtin_amdgcn_permlane32_swap(__float_as_uint(mx), __float_as_uint(mx), false, false); mx = fmaxf(__uint_as_float(rr[0]), __uint_as_float(rr[1])); } \
            const float mnew = fmaxf(m_run, mx); \
            const float alpha = __builtin_amdgcn_exp2f((m_run - mnew) * sl2); \
            m_run = mnew; const float mb = -mnew * sl2; \
            float ps = 0.f; \
            _Pragma("unroll") for (int r = 0; r < 16; ++r) { p0[r] = __builtin_amdgcn_exp2f(fmaf(p0[r], sl2, mb)); ps += p0[r]; } \
            _Pragma("unroll") for (int r = 0; r < 16; ++r) { p1[r] = __builtin_amdgcn_exp2f(fmaf(p1[r], sl2, mb)); ps += p1[r]; } \
            l_run = l_run * alpha + ps; \
            if (__any(alpha != 1.f)) { \
                _Pragma("unroll") for (int d0 = 0; d0 < 4; ++d0) _Pragma("unroll") for (int r = 0; r < 16; ++r) oT[d0][r] *= alpha; } \
            bf16x8 pb[4];                                            \
            { u32x4 w; \
              w.x = pkbf(p0[0], p0[1]); w.y = pkbf(p0[2], p0[3]); w.z = pkbf(p0[4], p0[5]); w.w = pkbf(p0[6], p0[7]); pb[0] = *reinterpret_cast<bf16x8*>(&w); \
              w.x = pkbf(p0[8], p0[9]); w.y = pkbf(p0[10], p0[11]); w.z = pkbf(p0[12], p0[13]); w.w = pkbf(p0[14], p0[15]); pb[1] = *reinterpret_cast<bf16x8*>(&w); \
              w.x = pkbf(p1[0], p1[1]); w.y = pkbf(p1[2], p1[3]); w.z = pkbf(p1[4], p1[5]); w.w = pkbf(p1[6], p1[7]); pb[2] = *reinterpret_cast<bf16x8*>(&w); \
              w.x = pkbf(p1[8], p1[9]); w.y = pkbf(p1[10], p1[11]); w.z = pkbf(p1[12], p1[13]); w.w = pkbf(p1[14], p1[15]); pb[3] = *reinterpret_cast<bf16x8*>(&w); } \
            int vx = vq; asm volatile("" : "+v"(vx)); \
            _Pragma("unroll") for (int d0 = 0; d0 < 4; ++d0) { \
                const unsigned va = vrow + (buf_) * VBYTES + ((unsigned)(d0 ^ vx) << 6); \
                s16x4 l0, h0, l1, h1, l2, h2, l3, h3; \
                TRRD(l0, va, 0); TRRD(h0, va, 2048); TRRD(l1, va, 4096); TRRD(h1, va, 6144); TRRD(l2, va, 8192); TRRD(h2, va, 10240); TRRD(l3, va, 12288); TRRD(h3, va, 14336); \
                asm volatile("s_waitcnt lgkmcnt(0)" ::: "memory"); __builtin_amdgcn_sched_barrier(0); \
                oT[d0] = __builtin_amdgcn_mfma_f32_32x32x16_bf16((bf16x8){l0[0], l0[1], l0[2], l0[3], h0[0], h0[1], h0[2], h0[3]}, pb[0], oT[d0], 0, 0, 0); \
                oT[d0] = __builtin_amdgcn_mfma_f32_32x32x16_bf16((bf16x8){l1[0], l1[1], l1[2], l1[3], h1[0], h1[1], h1[2], h1[3]}, pb[1], oT[d0], 0, 0, 0); \
                oT[d0] = __builtin_amdgcn_mfma_f32_32x32x16_bf16((bf16x8){l2[0], l2[1], l2[2], l2[3], h2[0], h2[1], h2[2], h2[3]}, pb[2], oT[d0], 0, 0, 0); \
                oT[d0] = __builtin_amdgcn_mfma_f32_32x32x16_bf16((bf16x8){l3[0], l3[1], l3[2], l3[3], h3[0], h3[1], h3[2], h3[3]}, pb[3], oT[d0], 0, 0, 0); } \
        } \
        if (MASKED) mw_cur = mw_nxt; \
        asm volatile("s_waitcnt vmcnt(0)" ::: "memory"); \
        asm volatile("s_waitcnt lgkmcnt(0)" ::: "memory"); \
        __builtin_amdgcn_s_barrier(); } while (0)
    for (int tt = 0; tt < NT; tt += 2) { AT_STEP(tt, 0); AT_STEP(tt + 1, 1); }
#undef AT_STEP
#undef AT_STAGE
#undef TRRD
    { auto rr = __builtin_amdgcn_permlane32_swap(__float_as_uint(l_run), __float_as_uint(l_run), false, false); l_run = __uint_as_float(rr[0]) + __uint_as_float(rr[1]); }
    const float inv = 1.f / l_run;
    bf16_t* orow = Og + (size_t)(q0 + r32) * ldo + 4 * hi;
#pragma unroll
    for (int d0 = 0; d0 < 4; ++d0)
#pragma unroll
        for (int rq = 0; rq < 4; ++rq) { u32x2 w; w.x = pkbf(oT[d0][4 * rq] * inv, oT[d0][4 * rq + 1] * inv); w.y = pkbf(oT[d0][4 * rq + 2] * inv, oT[d0][4 * rq + 3] * inv);
            *(u32x2*)(orow + 32 * d0 + 8 * rq) = w; }
}
__device__ __forceinline__ void p_attn(LAS unsigned char* ldsb, unsigned char* ws) {
    const bf16_t* QA = (const bf16_t*)(ws + WS_QA); const bf16_t* KA = (const bf16_t*)(ws + WS_KA); const bf16_t* VA = (const bf16_t*)(ws + WS_VA); bf16_t* OA = (bf16_t*)(ws + WS_OA);
    const bf16_t* QB = (const bf16_t*)(ws + WS_QB); const bf16_t* KB = (const bf16_t*)(ws + WS_KB); const bf16_t* VB = (const bf16_t*)(ws + WS_VB); bf16_t* OB = (bf16_t*)(ws + WS_OB);
    const unsigned* MASK = (const unsigned*)(ws + WS_MASK);
    for (int w = blockIdx.x; w < 256; w += gridDim.x) {
        const int bh = (w & 7) * 2 + ((w >> 3) & 1), i = w >> 4, b = bh >> 3, h = bh & 7;
        const size_t r0 = (size_t)b * S;
        attn_unit<192, false>(ldsb, QA + r0 * 1536 + h * 192, 1536, KA + r0 * 1536 + h * 192, 1536, VA + r0 * 1024 + h * 128, 1024, nullptr, OA + r0 * 1024 + h * 128, 1024, i, 0.07216878364870322f * 1.4426950408889634f);
        attn_unit<128, true>(ldsb, QB + r0 * 1024 + h * 128, 1024, KB + r0 * 1024 + h * 128, 1024, VB + r0 * 1024 + h * 128, 1024, MASK + r0 * 128, OB + r0 * 1024 + h * 128, 1024, 15 - i, 0.08838834764831845f * 1.4426950408889634f);
    }
}

template <int DQK, bool MASKED>
__device__ __forceinline__ void nattn(float* lds, const bf16_t* Q, const bf16_t* Kp, int ldk, const bf16_t* Vp, const unsigned* mask, bf16_t* O, float scale) {
    float* qs = lds; float* scb = lds + 8 * 192;
    const int tid = opaque_tid(), lane = tid & 63, h = tid >> 6;
    float* sc = scb + h * 4096;
    for (int t = blockIdx.x; t < T; t += gridDim.x) {
        const int b = t >> 12, ti = t & 4095, nk = ti + 1;
        __syncthreads();
        for (int i = tid; i < 8 * DQK; i += NTHREADS) qs[i] = bf2f(Q[(size_t)t * (8 * DQK) + i]);
        __syncthreads();
        const float* q = qs + h * DQK;
        float mx = -__builtin_inff();
        for (int s0 = 0; s0 < nk; s0 += 64) {
            const int s = s0 + lane; float v = -__builtin_inff();
            bool on = s < nk;
            if (MASKED && on) on = (mask[(size_t)t * 128 + (s >> 5)] >> (s & 31)) & 1u;
            if (on) {
                const bf16_t* kr = Kp + (size_t)(b * S + s) * ldk + h * DQK;
                float dot = 0.f;
#pragma unroll 4
                for (int c = 0; c < DQK / 8; ++c) { const u32x4 raw = *(const u32x4*)(kr + c * 8); const unsigned w[4] = {raw.x, raw.y, raw.z, raw.w};
#pragma unroll
                    for (int j = 0; j < 4; ++j) { dot = fmaf(q[c * 8 + 2 * j], __uint_as_float(w[j] << 16), dot); dot = fmaf(q[c * 8 + 2 * j + 1], __uint_as_float(w[j] & 0xffff0000u), dot); } }
                v = dot * scale;
            }
            if (s < nk) sc[s] = v;
            mx = fmaxf(mx, v);
        }
        mx = wave_max(mx);
        __syncthreads();
        float sum = 0.f;
        for (int s = lane; s < nk; s += 64) { const float pz = __expf(sc[s] - mx); sc[s] = pz; sum += pz; }
        sum = wave_sum(sum);
        __syncthreads();
        float a0 = 0.f, a1 = 0.f;
        const bf16_t* vb = Vp + (size_t)(b * S) * 1024 + h * 128 + lane * 2;
        for (int s = 0; s < nk; ++s) {
            const float pz = sc[s];
            if (pz != 0.f) { const unsigned w = *(const unsigned*)(vb + (size_t)s * 1024); a0 = fmaf(pz, __uint_as_float(w << 16), a0); a1 = fmaf(pz, __uint_as_float(w & 0xffff0000u), a1); }
        }
        const float inv = 1.f / sum;
        *(unsigned*)(O + (size_t)t * 1024 + h * 128 + lane * 2) = pk2(a0 * inv, a1 * inv);
    }
    __syncthreads();
}

__device__ __forceinline__ void p_ln1_route(float* lds, const Params& p, int l) {
    const float* V1 = (const float*)(p.ws + WS_V1); float* H1F = (float*)(p.ws + WS_H1F); bf16_t* H1B = (bf16_t*)(p.ws + WS_H1B);
    unsigned* cnt = (unsigned*)(p.ws + WS_CNT) + l * 64; int* LIST = (int*)(p.ws + WS_LIST);
    int* TOKE = (int*)(p.ws + WS_TOKE); float* TOKW = (float*)(p.ws + WS_TOKW); int* TOKS = (int*)(p.ws + WS_TOKS);
    const float* g = p.ln1g + (size_t)l * D; const float* bb = p.ln1b + (size_t)l * D;
    const float* wr = p.w_router + (size_t)l * D * 64; const float* wg = p.w_group + (size_t)l * D * 8;
    const float* br = p.b_router + l * 64; const float* bg = p.b_group + l * 8;
    const int tid = opaque_tid(), lane = tid & 63, wv = tid >> 6;
    float* lg = lds + wv * 80;
    for (int t0 = blockIdx.x * 8; t0 < T; t0 += gridDim.x * 8) {
        const int t = t0 + wv;
        float s1 = 0.f;
#pragma unroll 4
        for (int j = 0; j < 32; ++j) s1 += V1[(size_t)t * D + lane + 64 * j];
        const float mean = wave_sum(s1) * (1.f / D);
        float s2 = 0.f;
#pragma unroll 4
        for (int j = 0; j < 32; ++j) { const float d = V1[(size_t)t * D + lane + 64 * j] - mean; s2 += d * d; }
        const float rstd = rsqrtf(wave_sum(s2) * (1.f / D) + 1e-5f);
        float acc[72];
#pragma unroll
        for (int e = 0; e < 72; ++e) acc[e] = 0.f;
#pragma unroll 1
        for (int j = 0; j < 32; ++j) {
            const int k = lane + 64 * j;
            const float hk = (V1[(size_t)t * D + k] - mean) * rstd * g[k] + bb[k];
            H1F[(size_t)t * D + k] = hk; H1B[(size_t)t * D + k] = f2bf(hk);
            const float* wrow = wr + (size_t)k * 64;
#pragma unroll
            for (int e4 = 0; e4 < 16; ++e4) { const f32x4 w = *(const f32x4*)(wrow + e4 * 4);
                acc[e4 * 4] = fmaf(hk, w[0], acc[e4 * 4]); acc[e4 * 4 + 1] = fmaf(hk, w[1], acc[e4 * 4 + 1]); acc[e4 * 4 + 2] = fmaf(hk, w[2], acc[e4 * 4 + 2]); acc[e4 * 4 + 3] = fmaf(hk, w[3], acc[e4 * 4 + 3]); }
            const float* grow = wg + (size_t)k * 8;
            const f32x4 w0 = *(const f32x4*)grow, w1 = *(const f32x4*)(grow + 4);
            acc[64] = fmaf(hk, w0[0], acc[64]); acc[65] = fmaf(hk, w0[1], acc[65]); acc[66] = fmaf(hk, w0[2], acc[66]); acc[67] = fmaf(hk, w0[3], acc[67]);
            acc[68] = fmaf(hk, w1[0], acc[68]); acc[69] = fmaf(hk, w1[1], acc[69]); acc[70] = fmaf(hk, w1[2], acc[70]); acc[71] = fmaf(hk, w1[3], acc[71]);
        }
#pragma unroll
        for (int e = 0; e < 72; ++e) { const float r = wave_sum(acc[e]); if (lane == 0) lg[e] = r; }
        __syncthreads();
        if (lane == 0) {
            float gl[8]; float gmax = -__builtin_inff(); int gi = 0;
#pragma unroll
            for (int i = 0; i < 8; ++i) { gl[i] = lg[64 + i] + bg[i]; if (gl[i] > gmax) { gmax = gl[i]; gi = i; } }
            float gs = 0.f;
#pragma unroll
            for (int i = 0; i < 8; ++i) gs += __expf(gl[i] - gmax);
            const float gp = 1.f / gs;
            float el[8]; float emax = -__builtin_inff(); int e1 = 0;
#pragma unroll
            for (int i = 0; i < 8; ++i) { el[i] = lg[gi * 8 + i] + br[gi * 8 + i]; if (el[i] > emax) { emax = el[i]; e1 = i; } }
            float e2max = -__builtin_inff(); int e2 = 0;
#pragma unroll
            for (int i = 0; i < 8; ++i) { if (i != e1 && el[i] > e2max) { e2max = el[i]; e2 = i; } }
            const float p1 = 1.f, p2 = __expf(e2max - emax);
            const float wa = gp * p1 / (p1 + p2), wb = gp * p2 / (p1 + p2);
            const int ea = gi * 8 + e1, eb = gi * 8 + e2;
            const int sa = (int)atomicAdd(cnt + ea, 1u), sb = (int)atomicAdd(cnt + eb, 1u);
            LIST[(size_t)ea * ECAP + sa] = t; LIST[(size_t)eb * ECAP + sb] = t;
            TOKE[t * 2] = ea; TOKE[t * 2 + 1] = eb; TOKW[t * 2] = wa; TOKW[t * 2 + 1] = wb; TOKS[t * 2] = sa; TOKS[t * 2 + 1] = sb;
        }
        __syncthreads();
    }
}

__device__ __forceinline__ void moe_tables(int* tab, const unsigned* cnt, int items_per_rb) {
    if (threadIdx.x == 0) { int a = 0, bsum = 0; for (int e = 0; e < 64; ++e) { tab[e] = a; tab[80 + e] = bsum; const int c = (int)cnt[e]; a += ((c + 127) / 128) * items_per_rb; bsum += ((c + 255) / 256) * 256; } tab[64] = a; tab[80 + 64] = bsum; }
    __syncthreads();
}
__device__ __forceinline__ void p_moe1(float* lds, const Params& p, int l) {
    const unsigned* cnt = (const unsigned*)(p.ws + WS_CNT) + l * 64; const int* LIST = (const int*)(p.ws + WS_LIST);
    const bf16_t* H1B = (const bf16_t*)(p.ws + WS_H1B); bf16_t* HID = (bf16_t*)(p.ws + WS_HID);
    float* As = lds; float* Wg = lds + 32 * 132; float* Wu = Wg + 32 * 64; int* tab = (int*)(Wu + 32 * 64);
    __syncthreads();
    moe_tables(tab, cnt, 8);
    const int tid = opaque_tid(), ty = tid >> 4, tx = tid & 15;
    const int total = tab[64];
    for (int item = blockIdx.x; item < total; item += gridDim.x) {
        int e = 0; while (tab[e + 1] <= item) ++e;
        const int local = item - tab[e], rb = local >> 3, ct = local & 7, ce = (int)cnt[e], base = tab[80 + e];
        const float* wgp = p.w_eg + ((size_t)(l * 64 + e) * D) * FE + ct * 64;
        const float* wup = p.w_eu + ((size_t)(l * 64 + e) * D) * FE + ct * 64;
        const f32x4 z4 = {0.f, 0.f, 0.f, 0.f};
        f32x4 ag0 = z4, ag1 = z4, ag2 = z4, ag3 = z4, au0 = z4, au1 = z4, au2 = z4, au3 = z4;
        const int ar = tid >> 2, akq = (tid & 3) * 8, wk = tid >> 4, wn4 = (tid & 15) * 4;
        const int ai = rb * 128 + ar; const int tok = ai < ce ? LIST[(size_t)e * ECAP + ai] : -1;
        const bf16_t* ap = H1B + (size_t)(tok < 0 ? 0 : tok) * D + akq;
        for (int k0 = 0; k0 < D; k0 += 32) {
            __syncthreads();
            { u32x4 raw = *(const u32x4*)(ap + k0); if (tok < 0) raw = (u32x4){0u, 0u, 0u, 0u};
              float* dst = As + akq * 132 + ar;
              dst[0 * 132] = __uint_as_float(raw.x << 16); dst[1 * 132] = __uint_as_float(raw.x & 0xffff0000u); dst[2 * 132] = __uint_as_float(raw.y << 16); dst[3 * 132] = __uint_as_float(raw.y & 0xffff0000u);
              dst[4 * 132] = __uint_as_float(raw.z << 16); dst[5 * 132] = __uint_as_float(raw.z & 0xffff0000u); dst[6 * 132] = __uint_as_float(raw.w << 16); dst[7 * 132] = __uint_as_float(raw.w & 0xffff0000u); }
            *(f32x4*)(Wg + wk * 64 + wn4) = *(const f32x4*)(wgp + (size_t)(k0 + wk) * FE + wn4);
            *(f32x4*)(Wu + wk * 64 + wn4) = *(const f32x4*)(wup + (size_t)(k0 + wk) * FE + wn4);
            __syncthreads();
#pragma unroll 4
            for (int kk = 0; kk < 32; ++kk) {
                const f32x4 a = *(const f32x4*)(As + kk * 132 + ty * 4);
                const f32x4 g4 = *(const f32x4*)(Wg + kk * 64 + tx * 4);
                const f32x4 u4 = *(const f32x4*)(Wu + kk * 64 + tx * 4);
                ag0 += a[0] * g4; ag1 += a[1] * g4; ag2 += a[2] * g4; ag3 += a[3] * g4;
                au0 += a[0] * u4; au1 += a[1] * u4; au2 += a[2] * u4; au3 += a[3] * u4;
            }
        }
#define MOE1_OUT(i, G_, U_) do { const int ri = rb * 128 + ty * 4 + (i); if (ri < ce) { f32x4 o; \
            o[0] = G_[0] / (1.f + __expf(-G_[0])) * U_[0]; o[1] = G_[1] / (1.f + __expf(-G_[1])) * U_[1]; o[2] = G_[2] / (1.f + __expf(-G_[2])) * U_[2]; o[3] = G_[3] / (1.f + __expf(-G_[3])) * U_[3]; \
            st4bf(HID + (size_t)(base + ri) * FE + ct * 64 + tx * 4, o); } } while (0)
        MOE1_OUT(0, ag0, au0); MOE1_OUT(1, ag1, au1); MOE1_OUT(2, ag2, au2); MOE1_OUT(3, ag3, au3);
#undef MOE1_OUT
    }
    __syncthreads();
}
__device__ __forceinline__ void p_moe2(float* lds, const Params& p, int l) {
    const unsigned* cnt = (const unsigned*)(p.ws + WS_CNT) + l * 64;
    const bf16_t* HID = (const bf16_t*)(p.ws + WS_HID); bf16_t* YE = (bf16_t*)(p.ws + WS_YE);
    float* As = lds; float* Ws = lds + 32 * 132; int* tab = (int*)(Ws + 32 * 64 * 2);
    __syncthreads();
    moe_tables(tab, cnt, 32);
    const int tid = opaque_tid(), ty = tid >> 4, tx = tid & 15;
    const int total = tab[64];
    for (int item = blockIdx.x; item < total; item += gridDim.x) {
        int e = 0; while (tab[e + 1] <= item) ++e;
        const int local = item - tab[e], rb = local >> 5, ct = local & 31, ce = (int)cnt[e], base = tab[80 + e];
        const float* wdp = p.w_ed + ((size_t)(l * 64 + e) * FE) * D + ct * 64;
        f32x4 acc0 = {0.f, 0.f, 0.f, 0.f}, acc1 = acc0, acc2 = acc0, acc3 = acc0;
        const int ar = tid >> 2, akq = (tid & 3) * 8, wk = tid >> 4, wn4 = (tid & 15) * 4;
        const int ai = rb * 128 + ar; const bool av = ai < ce;
        const bf16_t* ap = HID + (size_t)(base + (av ? ai : 0)) * FE + akq;
        for (int k0 = 0; k0 < FE; k0 += 32) {
            __syncthreads();
            { u32x4 raw = *(const u32x4*)(ap + k0); if (!av) raw = (u32x4){0u, 0u, 0u, 0u};
              float* dst = As + akq * 132 + ar;
              dst[0 * 132] = __uint_as_float(raw.x << 16); dst[1 * 132] = __uint_as_float(raw.x & 0xffff0000u); dst[2 * 132] = __uint_as_float(raw.y << 16); dst[3 * 132] = __uint_as_float(raw.y & 0xffff0000u);
              dst[4 * 132] = __uint_as_float(raw.z << 16); dst[5 * 132] = __uint_as_float(raw.z & 0xffff0000u); dst[6 * 132] = __uint_as_float(raw.w << 16); dst[7 * 132] = __uint_as_float(raw.w & 0xffff0000u); }
            *(f32x4*)(Ws + wk * 64 + wn4) = *(const f32x4*)(wdp + (size_t)(k0 + wk) * D + wn4);
            __syncthreads();
#pragma unroll 8
            for (int kk = 0; kk < 32; ++kk) {
                const f32x4 a = *(const f32x4*)(As + kk * 132 + ty * 4);
                const f32x4 w = *(const f32x4*)(Ws + kk * 64 + tx * 4);
                acc0 += a[0] * w; acc1 += a[1] * w; acc2 += a[2] * w; acc3 += a[3] * w;
            }
        }
        { const int ri = rb * 128 + ty * 4; bf16_t* yo = YE + (size_t)(base + ri) * D + ct * 64 + tx * 4;
          if (ri < ce) st4bf(yo, acc0); if (ri + 1 < ce) st4bf(yo + D, acc1); if (ri + 2 < ce) st4bf(yo + 2 * D, acc2); if (ri + 3 < ce) st4bf(yo + 3 * D, acc3); }
    }
    __syncthreads();
}
__device__ __forceinline__ void p_ln1_route2(LAS unsigned char* ldsb, unsigned char* ws, const float* g, const float* bb, const float* wr, const float* wg, const float* br, const float* bg, int l) {
    const float* V1 = (const float*)(ws + WS_V1); float* H1F = (float*)(ws + WS_H1F); bf16_t* H1B = (bf16_t*)(ws + WS_H1B);
    unsigned* cnt = (unsigned*)(ws + WS_CNT) + l * 64; int* LIST = (int*)(ws + WS_LIST);
    int* TOKE = (int*)(ws + WS_TOKE); float* TOKW = (float*)(ws + WS_TOKW); int* TOKS = (int*)(ws + WS_TOKS);
    const int tid = opaque_tid(), lane = tid & 63, wv = __builtin_amdgcn_readfirstlane(tid >> 6);
    LAS float* red = (LAS float*)ldsb;
    for (int unit = blockIdx.x; unit < T / 32; unit += gridDim.x) {
        const int t0 = unit * 32;
#pragma unroll 1
        for (int i = 0; i < 4; ++i) {
            const size_t ro = (size_t)(t0 + 4 * wv + i) * D + 4 * lane;
            f32x4 v[8]; float s1 = 0.f;
#pragma unroll
            for (int j = 0; j < 8; ++j) { v[j] = *(const f32x4*)(V1 + ro + 256 * j); s1 += (v[j][0] + v[j][1]) + (v[j][2] + v[j][3]); }
            const float mean = wave_sum(s1) * (1.f / D); float s2 = 0.f;
#pragma unroll
            for (int j = 0; j < 8; ++j) { v[j] = v[j] - mean; s2 += (v[j][0] * v[j][0] + v[j][1] * v[j][1]) + (v[j][2] * v[j][2] + v[j][3] * v[j][3]); }
            const float rstd = rsqrtf(wave_sum(s2) * (1.f / D) + 1e-5f);
#pragma unroll
            for (int j = 0; j < 8; ++j) { const f32x4 gg = *(const f32x4*)(g + 4 * lane + 256 * j), b4 = *(const f32x4*)(bb + 4 * lane + 256 * j);
                const f32x4 h = v[j] * rstd * gg + b4;
                *(f32x4*)(H1F + ro + 256 * j) = h; st4bf(H1B + ro + 256 * j, h); }
        }
        asm volatile("s_waitcnt vmcnt(0)" ::: "memory");
        __syncthreads();
        {
            f32x16 c0, c1, c2;
#pragma unroll
            for (int r = 0; r < 16; ++r) { c0[r] = 0.f; c1[r] = 0.f; c2[r] = 0.f; }
            const int j = lane & 31, kh = lane >> 5, kb = 256 * wv + 4 * kh;
            const float* hp = H1F + (size_t)(t0 + j) * D + kb;
            const float* wrp = wr + (size_t)kb * 64 + j;
            const float* wgp = wg + (size_t)kb * 8 + (j & 7);
            const bool gcol = j < 8;
#pragma unroll 2
            for (int it = 0; it < 32; ++it) {
                const f32x4 a = *(const f32x4*)(hp + 8 * it);
#pragma unroll
                for (int sidx = 0; sidx < 4; ++sidx) {
                    const float b0 = wrp[(size_t)(8 * it + sidx) * 64], b1 = wrp[(size_t)(8 * it + sidx) * 64 + 32];
                    float b2 = wgp[(size_t)(8 * it + sidx) * 8]; b2 = gcol ? b2 : 0.f;
                    c0 = __builtin_amdgcn_mfma_f32_32x32x2f32(a[sidx], b0, c0, 0, 0, 0);
                    c1 = __builtin_amdgcn_mfma_f32_32x32x2f32(a[sidx], b1, c1, 0, 0, 0);
                    c2 = __builtin_amdgcn_mfma_f32_32x32x2f32(a[sidx], b2, c2, 0, 0, 0);
                }
            }
#pragma unroll
            for (int r = 0; r < 16; ++r) { const int tr = (r & 3) + 8 * (r >> 2) + 4 * kh; LAS float* o = red + (wv * 32 + tr) * 96 + j; o[0] = c0[r]; o[32] = c1[r]; o[64] = c2[r]; }
        }
        __syncthreads();
        for (int idx = tid; idx < 32 * 72; idx += NTHREADS) { const int tk = idx / 72, c = idx - tk * 72;
            float sacc = 0.f;
#pragma unroll
            for (int w = 0; w < 8; ++w) sacc += red[(w * 32 + tk) * 96 + c];
            red[tk * 96 + c] = sacc; }
        __syncthreads();
        if (tid < 32) {
            const int t = t0 + tid; const LAS float* lg = red + tid * 96;
            float gl[8]; float gmax = -__builtin_inff(); int gi = 0;
#pragma unroll
            for (int i = 0; i < 8; ++i) { gl[i] = lg[64 + i] + bg[i]; if (gl[i] > gmax) { gmax = gl[i]; gi = i; } }
            float gs = 0.f;
#pragma unroll
            for (int i = 0; i < 8; ++i) gs += __expf(gl[i] - gmax);
            const float gp = 1.f / gs;
            float el[8]; float emax = -__builtin_inff(); int e1 = 0;
#pragma unroll
            for (int i = 0; i < 8; ++i) { el[i] = lg[gi * 8 + i] + br[gi * 8 + i]; if (el[i] > emax) { emax = el[i]; e1 = i; } }
            float e2max = -__builtin_inff(); int e2 = 0;
#pragma unroll
            for (int i = 0; i < 8; ++i) { if (i != e1 && el[i] > e2max) { e2max = el[i]; e2 = i; } }
            const float p2 = __expf(e2max - emax);
            const float wa = gp / (1.f + p2), wb = gp * p2 / (1.f + p2);
            const int ea = gi * 8 + e1, eb = gi * 8 + e2;
            const int sa = (int)atomicAdd(cnt + ea, 1u), sb = (int)atomicAdd(cnt + eb, 1u);
            LIST[(size_t)ea * ECAP + sa] = t; LIST[(size_t)eb * ECAP + sb] = t;
            TOKE[t * 2] = ea; TOKE[t * 2 + 1] = eb; TOKW[t * 2] = wa; TOKW[t * 2 + 1] = wb; TOKS[t * 2] = sa; TOKS[t * 2 + 1] = sb;
        }
        __syncthreads();
    }
}
__device__ __forceinline__ void p_ln2v2(LAS unsigned char* ldsb, unsigned char* ws, const float* g, const float* bb, float* outF, int l) {
    const unsigned* cnt = (const unsigned*)(ws + WS_CNT) + l * 64;
    const float* H1F = (const float*)(ws + WS_H1F); const bf16_t* YE = (const bf16_t*)(ws + WS_YE);
    const int* TOKE = (const int*)(ws + WS_TOKE); const float* TOKW = (const float*)(ws + WS_TOKW); const int* TOKS = (const int*)(ws + WS_TOKS);
    bf16_t* XB = (bf16_t*)(ws + WS_XB);
    int* tab = (int*)(unsigned char*)ldsb;
    __syncthreads();
    moe_tables(tab, cnt, 1);
    const int tid = opaque_tid(), lane = tid & 63, wv = tid >> 6;
    for (int t = blockIdx.x * 8 + wv; t < T; t += gridDim.x * 8) {
        const int r0 = tab[80 + TOKE[t * 2]] + TOKS[t * 2], r1 = tab[80 + TOKE[t * 2 + 1]] + TOKS[t * 2 + 1];
        const float w0 = TOKW[t * 2], w1 = TOKW[t * 2 + 1];
        const size_t ro = (size_t)t * D + 4 * lane;
        f32x4 v[8]; float s1 = 0.f;
#pragma unroll
        for (int j = 0; j < 8; ++j) { const f32x4 h = *(const f32x4*)(H1F + ro + 256 * j);
            const f32x4 y0 = bf4(*(const u32x2*)(YE + (size_t)r0 * D + 4 * lane + 256 * j)), y1 = bf4(*(const u32x2*)(YE + (size_t)r1 * D + 4 * lane + 256 * j));
            v[j] = h * ALPHA + y0 * w0 + y1 * w1; s1 += (v[j][0] + v[j][1]) + (v[j][2] + v[j][3]); }
        const float mean = wave_sum(s1) * (1.f / D); float s2 = 0.f;
#pragma unroll
        for (int j = 0; j < 8; ++j) { v[j] = v[j] - mean; s2 += (v[j][0] * v[j][0] + v[j][1] * v[j][1]) + (v[j][2] * v[j][2] + v[j][3] * v[j][3]); }
        const float rstd = rsqrtf(wave_sum(s2) * (1.f / D) + 1e-5f);
#pragma unroll
        for (int j = 0; j < 8; ++j) { const f32x4 gg = *(const f32x4*)(g + 4 * lane + 256 * j), b4 = *(const f32x4*)(bb + 4 * lane + 256 * j);
            const f32x4 o = v[j] * rstd * gg + b4;
            *(f32x4*)(outF + ro + 256 * j) = o; if (l != DEPTH - 1) st4bf(XB + ro + 256 * j, o); }
    }
    __syncthreads();
}

template <bool GATED>
__device__ __forceinline__ void moe_gemm(LAS unsigned char* ldsb, const int* tab, const unsigned* cnt, const int* LIST, const bf16_t* Asrc, const float* W0, const float* W1, bf16_t* Out) {
    constexpr int K = GATED ? D : FE, NT = K / 64, NCT = GATED ? FE / 64 : D / 128, LDW = GATED ? FE : D, LDO = GATED ? FE : D;
    constexpr int ABYTES = 256 * 128, BOFF = 2 * ABYTES, BBYTES = 64 * 256;
    const int tid = opaque_tid(), lane = tid & 63, wv = __builtin_amdgcn_readfirstlane(tid >> 6), wm = wv >> 1, wn = wv & 1, l15 = lane & 15, kq = lane >> 4;
    const int total = tab[64];
    const unsigned lbase = (unsigned)(size_t)ldsb;
    const int arow = wm * 64 + l15;
    const unsigned afr = lbase + (unsigned)arow * 128u; const int asw = ((arow >> 1) & 7) ^ kq;
    const int bq = (lane >> 2) & 3, bp = lane & 3, bkey = bq | ((kq & 1) << 2);
    const unsigned bfr = lbase + BOFF + (unsigned)(8 * kq + bq) * 256u + 8u * bp;
    unsigned bb[4];
#pragma unroll
    for (int j = 0; j < 4; ++j) { const int np = GATED ? ((j >> 1) * 4 + 2 * wn + (j & 1)) : (4 * wn + j); bb[j] = bfr + ((unsigned)(np ^ bkey) << 5); }
    const int sa_r = tid >> 3, sa_c = tid & 7;
    const int sb_k = tid >> 5, sb_n = 4 * (tid & 31);
    for (int item = blockIdx.x; item < total; item += gridDim.x) {
        int e = 0; while (tab[e + 1] <= item) ++e;
        const int local = item - tab[e], ct = local / tab[160 + e], rb = local - ct * tab[160 + e];
        const int ce = (int)cnt[e], base = tab[80 + e];
        unsigned aoff[4];
#pragma unroll
        for (int i = 0; i < 4; ++i) { const int r = rb * 256 + i * 64 + sa_r;
            if (GATED) { const int tok = r < ce ? LIST[(size_t)e * ECAP + r] : 0; aoff[i] = (unsigned)tok * (unsigned)(K * 2) + sa_c * 16; }
            else aoff[i] = (unsigned)(base + r) * (unsigned)(K * 2) + sa_c * 16; }
        const float* wp = (GATED ? (sb_n < 64 ? W0 : W1) : W0) + (size_t)e * K * LDW + (size_t)sb_k * LDW + (GATED ? ct * 64 + (sb_n & 63) : ct * 128 + sb_n);
        f32x4 acc[4][4];
#pragma unroll
        for (int m = 0; m < 4; ++m)
#pragma unroll
            for (int n = 0; n < 4; ++n) acc[m][n] = (f32x4){0.f, 0.f, 0.f, 0.f};
        u32x4 ra0[4], ra1[4]; f32x4 rb0[4], rb1[4];
#define MG_LOAD(RA, RB, t_) do { _Pragma("unroll") for (int i = 0; i < 4; ++i) { RA[i] = *(const u32x4*)((const unsigned char*)Asrc + aoff[i] + (t_) * 128); \
            RB[i] = *(const f32x4*)(wp + (size_t)((t_) * 64 + 16 * i) * LDW); } } while (0)
#define MG_WRITE(RA, RB, buf_) do { _Pragma("unroll") for (int i = 0; i < 4; ++i) { const int r = i * 64 + sa_r; \
            *(LAS u32x4*)(ldsb + (buf_) * ABYTES + r * 128 + ((sa_c ^ ((r >> 1) & 7)) << 4)) = RA[i]; \
            const int k = sb_k + 16 * i; u32x2 w; w.x = pkbf(RB[i][0], RB[i][1]); w.y = pkbf(RB[i][2], RB[i][3]); \
            *(LAS u32x2*)(ldsb + BOFF + (buf_) * BBYTES + k * 256 + ((((sb_n >> 4) ^ ((k & 3) | (((k >> 3) & 1) << 2)))) << 5) + (sb_n & 15) * 2) = w; } } while (0)
#define TRRD(dst, addr, off) asm volatile("ds_read_b64_tr_b16 %0, %1 offset:%2" : "=&v"(dst) : "v"(addr), "i"(off) : "memory")
#define MG_COMPUTE(buf_) do { \
            _Pragma("unroll") for (int kk = 0; kk < 2; ++kk) { \
                bf16x8 af[4]; \
                _Pragma("unroll") for (int m = 0; m < 4; ++m) af[m] = *(const LAS bf16x8*)(size_t)(afr + (buf_) * ABYTES + m * 2048 + ((unsigned)((4 * kk) ^ asw) << 4)); \
                s16x4 b0l, b0h, b1l, b1h, b2l, b2h, b3l, b3h; \
                TRRD(b0l, bb[0], (buf_) * BBYTES + kk * 8192); TRRD(b0h, bb[0], (buf_) * BBYTES + kk * 8192 + 1024); \
                TRRD(b1l, bb[1], (buf_) * BBYTES + kk * 8192); TRRD(b1h, bb[1], (buf_) * BBYTES + kk * 8192 + 1024); \
                TRRD(b2l, bb[2], (buf_) * BBYTES + kk * 8192); TRRD(b2h, bb[2], (buf_) * BBYTES + kk * 8192 + 1024); \
                TRRD(b3l, bb[3], (buf_) * BBYTES + kk * 8192); TRRD(b3h, bb[3], (buf_) * BBYTES + kk * 8192 + 1024); \
                asm volatile("s_waitcnt lgkmcnt(0)" ::: "memory"); __builtin_amdgcn_sched_barrier(0); \
                const bf16x8 bf0 = {b0l[0], b0l[1], b0l[2], b0l[3], b0h[0], b0h[1], b0h[2], b0h[3]}, bf1 = {b1l[0], b1l[1], b1l[2], b1l[3], b1h[0], b1h[1], b1h[2], b1h[3]}; \
                const bf16x8 bf2 = {b2l[0], b2l[1], b2l[2], b2l[3], b2h[0], b2h[1], b2h[2], b2h[3]}, bf3 = {b3l[0], b3l[1], b3l[2], b3l[3], b3h[0], b3h[1], b3h[2], b3h[3]}; \
                _Pragma("unroll") for (int m = 0; m < 4; ++m) { \
                    acc[m][0] = __builtin_amdgcn_mfma_f32_16x16x32_bf16(af[m], bf0, acc[m][0], 0, 0, 0); acc[m][1] = __builtin_amdgcn_mfma_f32_16x16x32_bf16(af[m], bf1, acc[m][1], 0, 0, 0); \
                    acc[m][2] = __builtin_amdgcn_mfma_f32_16x16x32_bf16(af[m], bf2, acc[m][2], 0, 0, 0); acc[m][3] = __builtin_amdgcn_mfma_f32_16x16x32_bf16(af[m], bf3, acc[m][3], 0, 0, 0); } } } while (0)
        __syncthreads();
        MG_LOAD(ra0, rb0, 0); MG_LOAD(ra1, rb1, 1);
        MG_WRITE(ra0, rb0, 0);
        __syncthreads();
#pragma unroll 1
        for (int t = 0; t < NT; t += 2) {
            if (t + 2 < NT) MG_LOAD(ra0, rb0, t + 2);
            MG_COMPUTE(0);
            MG_WRITE(ra1, rb1, 1);
            __syncthreads();
            if (t + 3 < NT) MG_LOAD(ra1, rb1, t + 3);
            MG_COMPUTE(1);
            if (t + 2 < NT) MG_WRITE(ra0, rb0, 0);
            __syncthreads();
        }
#undef MG_LOAD
#undef MG_WRITE
#undef MG_COMPUTE
#undef TRRD
#pragma unroll
        for (int m = 0; m < 4; ++m)
#pragma unroll
            for (int g = 0; g < 4; ++g) {
                const int r = rb * 256 + wm * 64 + 16 * m + 4 * kq + g;
                if (r < ce) {
                    if (GATED) {
#pragma unroll
                        for (int j = 0; j < 2; ++j) { const float gv = acc[m][j][g], uv = acc[m][2 + j][g];
                            Out[(size_t)(base + r) * LDO + ct * 64 + 32 * wn + 16 * j + l15] = f2bf(gv / (1.f + __expf(-gv)) * uv); }
                    } else {
#pragma unroll
                        for (int n = 0; n < 4; ++n) Out[(size_t)(base + r) * LDO + ct * 128 + 64 * wn + 16 * n + l15] = f2bf(acc[m][n][g]);
                    }
                }
            }
    }
    __syncthreads();
}
__device__ __forceinline__ void moe_tables256(int* tab, const unsigned* cnt, int ncol_tiles) {
    if (threadIdx.x == 0) { int a = 0, bsum = 0; for (int e = 0; e < 64; ++e) { tab[e] = a; tab[80 + e] = bsum; const int c = (int)cnt[e], nrb = (c + 255) / 256; tab[160 + e] = nrb > 0 ? nrb : 1; a += nrb * ncol_tiles; bsum += nrb * 256; } tab[64] = a; tab[80 + 64] = bsum; }
    __syncthreads();
}
__device__ __forceinline__ void p_moe1_mfma(LAS unsigned char* ldsb, unsigned char* ws, const float* w_eg, const float* w_eu, int l) {
    const unsigned* cnt = (const unsigned*)(ws + WS_CNT) + l * 64;
    int* tab = (int*)((unsigned char*)ldsb + 100 * 1024);
    __syncthreads();
    moe_tables256(tab, cnt, FE / 64);
    moe_gemm<true>(ldsb, tab, cnt, (const int*)(ws + WS_LIST), (const bf16_t*)(ws + WS_H1B), w_eg + (size_t)l * NE * D * FE, w_eu + (size_t)l * NE * D * FE, (bf16_t*)(ws + WS_HID));
}
__device__ __forceinline__ void p_moe2_mfma(LAS unsigned char* ldsb, unsigned char* ws, const float* w_ed, int l) {
    const unsigned* cnt = (const unsigned*)(ws + WS_CNT) + l * 64;
    int* tab = (int*)((unsigned char*)ldsb + 100 * 1024);
    __syncthreads();
    moe_tables256(tab, cnt, D / 128);
    moe_gemm<false>(ldsb, tab, cnt, nullptr, (const bf16_t*)(ws + WS_HID), w_ed + (size_t)l * NE * FE * D, nullptr, (bf16_t*)(ws + WS_YE));
}

__device__ __forceinline__ void p_ln2(float* lds, const Params& p, int l) {
    const unsigned* cnt = (const unsigned*)(p.ws + WS_CNT) + l * 64;
    const float* H1F = (const float*)(p.ws + WS_H1F); const bf16_t* YE = (const bf16_t*)(p.ws + WS_YE);
    const int* TOKE = (const int*)(p.ws + WS_TOKE); const float* TOKW = (const float*)(p.ws + WS_TOKW); const int* TOKS = (const int*)(p.ws + WS_TOKS);
    float* outF = (l == DEPTH - 1) ? p.out : (float*)(p.ws + WS_H2F); bf16_t* XB = (bf16_t*)(p.ws + WS_XB);
    const float* g = p.ln2g + (size_t)l * D; const float* bb = p.ln2b + (size_t)l * D;
    int* tab = (int*)lds;
    __syncthreads();
    moe_tables(tab, cnt, 1);
    const int tid = opaque_tid(), lane = tid & 63, wv = tid >> 6;
    for (int t0 = blockIdx.x * 8; t0 < T; t0 += gridDim.x * 8) {
        const int t = t0 + wv;
        const int r0 = tab[80 + TOKE[t * 2]] + TOKS[t * 2], r1 = tab[80 + TOKE[t * 2 + 1]] + TOKS[t * 2 + 1];
        const float w0 = TOKW[t * 2], w1 = TOKW[t * 2 + 1];
        const float* hrow = H1F + (size_t)t * D; const bf16_t* y0 = YE + (size_t)r0 * D; const bf16_t* y1 = YE + (size_t)r1 * D;
        float s1 = 0.f;
#pragma unroll 4
        for (int j = 0; j < 32; ++j) { const int k = lane + 64 * j; s1 += ALPHA * hrow[k] + w0 * bf2f(y0[k]) + w1 * bf2f(y1[k]); }
        const float mean = wave_sum(s1) * (1.f / D);
        float s2 = 0.f;
#pragma unroll 4
        for (int j = 0; j < 32; ++j) { const int k = lane + 64 * j; const float d = ALPHA * hrow[k] + w0 * bf2f(y0[k]) + w1 * bf2f(y1[k]) - mean; s2 += d * d; }
        const float rstd = rsqrtf(wave_sum(s2) * (1.f / D) + 1e-5f);
#pragma unroll 4
        for (int j = 0; j < 32; ++j) { const int k = lane + 64 * j; const float v = ALPHA * hrow[k] + w0 * bf2f(y0[k]) + w1 * bf2f(y1[k]);
            const float o = (v - mean) * rstd * g[k] + bb[k];
            outF[(size_t)t * D + k] = o; if (l != DEPTH - 1) XB[(size_t)t * D + k] = f2bf(o); }
    }
    __syncthreads();
}

constexpr int NPH = 10;
#ifndef PH_MASK
#define PH_MASK 0x7ff
#endif
#define PHON(k) ((PH_MASK >> (k)) & 1)
typedef const Params __attribute__((address_space(4))) CParams;
#define KP(field) ({ CParams* _k = kp; asm volatile("" : "+s"(_k)); _k->field; })
__global__ void __launch_bounds__(NTHREADS, 2) hybrid_fwd(Params p_unused, int ph_lo, int ph_hi) {
    extern __shared__ __attribute__((aligned(16))) unsigned char lds_raw[];
    float* lds = (float*)lds_raw;
    LAS unsigned char* ldsb = (LAS unsigned char*)lds_raw;
    CParams* kp = (CParams*)__builtin_amdgcn_kernarg_segment_ptr();
    unsigned char* const ws0 = KP(ws);
    volatile LAS unsigned* xbw = (volatile LAS unsigned*)(lds_raw + LDS_BYTES - 16);
    if (threadIdx.x == 0) { xbw[0] = 0u; xbw[1] = 0u; xbw[2] = 0u; xbw[3] = 0u; }
    __syncthreads();
    XcdBarrier bar; bar.bar = (unsigned*)(ws0 + WS_BAR); bar.x = 0; bar.st = xbw;
    if (ph_lo < ph_hi) bar = xcd_barrier_post((unsigned*)(ws0 + WS_BAR), xbw);
#define IN(ph) ((ph) >= ph_lo && (ph) <= ph_hi)
#define GRID_BAR(ph) do { if ((ph) >= ph_lo && (ph) < ph_hi) xcd_barrier(bar); } while (0)
    if (PHON(0) && IN(0)) { unsigned char* ws = ws0; asm volatile("" : "+s"(ws)); { Params q; q.ws = ws; q.x = KP(x); q.pos = KP(pos); q.w_in = KP(w_in); q.g_q = KP(g_q); q.w_qb = KP(w_qb); q.g_kv = KP(g_kv); q.w_kvb = KP(w_kvb);
        q.w_oa = KP(w_oa); q.w_ob = KP(w_ob); q.w_out = KP(w_out); p_prologue(ldsb, q); } }
    GRID_BAR(0);
    for (int l = 0; l < DEPTH; ++l) {
        const int pb = l * NPH;
        if (PHON(1) && IN(pb + 1)) { unsigned char* ws = ws0; asm volatile("" : "+s"(ws));
            EpiIn E; E.ws = ws;
            pg8::Gemm g{(const bf16_t*)(ws + WS_XB), (const bf16_t*)(ws + WS_WIN_T) + (size_t)l * INP * D, T, INP, D}; pg8::StaticOrder SO; SO.init(T, INP, (int)gridDim.x, (int)blockIdx.x);
            pg8::gemm_phase<EpiIn, pg8::StaticOrder, true, true>(ldsb, g, SO, E);
        }
        GRID_BAR(pb + 1);
        if (PHON(2) && IN(pb + 2)) { unsigned char* ws = ws0; asm volatile("" : "+s"(ws));
            { EpiQA E; E.ws = ws;
              pg8::Gemm g{(const bf16_t*)(ws + WS_CQ), (const bf16_t*)(ws + WS_WQB_T) + (size_t)l * 1536 * 512, T, 1536, 512}; pg8::StaticOrder SO; SO.init(T, 1536, (int)gridDim.x, (int)blockIdx.x);
              pg8::gemm_phase<EpiQA, pg8::StaticOrder, true, true>(ldsb, g, SO, E); }
            { EpiKV E; E.ws = ws;
              pg8::Gemm g{(const bf16_t*)(ws + WS_CKV), (const bf16_t*)(ws + WS_WKVB_T) + (size_t)l * 2048 * 512, T, 2048, 512}; pg8::StaticOrder SO; SO.init(T, 2048, (int)gridDim.x, (int)blockIdx.x);
              pg8::gemm_phase<EpiKV, pg8::StaticOrder, true, true>(ldsb, g, SO, E); }
            p_score(ldsb, ws);
        }
        GRID_BAR(pb + 2);
        if (PHON(3) && IN(pb + 3)) { unsigned char* ws = ws0; asm volatile("" : "+s"(ws)); p_select(ws); }
        GRID_BAR(pb + 3);
        if (PHON(4) && IN(pb + 4)) { unsigned char* ws = ws0; asm volatile("" : "+s"(ws));
            p_attn(ldsb, ws);
        }
        GRID_BAR(pb + 4);
        if (PHON(5) && IN(pb + 5)) { unsigned char* ws = ws0; asm volatile("" : "+s"(ws));
            pg8::StaticOrder SO; SO.init(T, D, (int)gridDim.x, (int)blockIdx.x);
            { EpiYA E; E.ws = ws;
              pg8::Gemm g{(const bf16_t*)(ws + WS_OA), (const bf16_t*)(ws + WS_WOA_T) + (size_t)l * D * 1024, T, D, 1024};
              pg8::gemm_phase<EpiYA, pg8::StaticOrder, true, true>(ldsb, g, SO, E); }
            { EpiYB E; E.ws = ws;
              pg8::Gemm g{(const bf16_t*)(ws + WS_OB), (const bf16_t*)(ws + WS_WOB_T) + (size_t)l * D * 1024, T, D, 1024};
              pg8::gemm_phase<EpiYB, pg8::StaticOrder, true, true>(ldsb, g, SO, E); }
        }
        GRID_BAR(pb + 5);
        if (PHON(6) && IN(pb + 6)) { unsigned char* ws = ws0; asm volatile("" : "+s"(ws));
            EpiOut E; E.hin = (l == 0) ? KP(x) : (const float*)(ws + WS_H2F); E.V1 = (float*)(ws + WS_V1);
            pg8::Gemm g{(const bf16_t*)(ws + WS_Y), (const bf16_t*)(ws + WS_WOUT_T) + (size_t)l * D * D, T, D, D}; pg8::StaticOrder SO; SO.init(T, D, (int)gridDim.x, (int)blockIdx.x);
            pg8::gemm_phase<EpiOut, pg8::StaticOrder, true, true>(ldsb, g, SO, E);
        }
        GRID_BAR(pb + 6);
        if (PHON(7) && IN(pb + 7)) { unsigned char* ws = ws0; asm volatile("" : "+s"(ws)); p_ln1_route2(ldsb, ws, KP(ln1g) + (size_t)l * D, KP(ln1b) + (size_t)l * D, KP(w_router) + (size_t)l * D * 64, KP(w_group) + (size_t)l * D * 8, KP(b_router) + l * 64, KP(b_group) + l * 8, l); }
        GRID_BAR(pb + 7);
        if (PHON(8) && IN(pb + 8)) { unsigned char* ws = ws0; asm volatile("" : "+s"(ws)); p_moe1_mfma(ldsb, ws, KP(w_eg), KP(w_eu), l); }
        GRID_BAR(pb + 8);
        if (PHON(9) && IN(pb + 9)) { unsigned char* ws = ws0; asm volatile("" : "+s"(ws)); p_moe2_mfma(ldsb, ws, KP(w_ed), l); }
        GRID_BAR(pb + 9);
        if (PHON(10) && IN(pb + 10)) { unsigned char* ws = ws0; asm volatile("" : "+s"(ws)); p_ln2v2(ldsb, ws, KP(ln2g) + (size_t)l * D, KP(ln2b) + (size_t)l * D, (l == DEPTH - 1) ? KP(out) : (float*)(ws + WS_H2F), l); }
        GRID_BAR(pb + 10);
    }
}

#ifndef MK_ONE_LAUNCH
#define MK_ONE_LAUNCH 1
#endif
extern "C" void kernel_launch(void* const* d_in, const int* in_sizes, int n_in, void* d_out, int out_size, void* d_ws, size_t ws_size, hipStream_t stream) {
    static int grid = 0;
    if (!grid) {
        if (n_in != 21 || in_sizes[0] != T * D || out_size != T * D || ws_size < WS_END) {
            fprintf(stderr, "kernel_launch: unexpected shapes (n_in %d, in0 %d, out %d, ws %zu, need %zu); nothing launched\n", n_in, n_in > 0 ? in_sizes[0] : -1, out_size, ws_size, (size_t)WS_END);
            grid = -1; return; }
        int dev = 0, cus = 0, per_cu = 0;
        hipGetDevice(&dev); hipDeviceGetAttribute(&cus, hipDeviceAttributeMultiprocessorCount, dev);
        if (hipFuncSetAttribute((const void*)hybrid_fwd, hipFuncAttributeMaxDynamicSharedMemorySize, LDS_BYTES) != hipSuccess) { fprintf(stderr, "kernel_launch: hipFuncSetAttribute failed\n"); grid = -1; return; }
        hipOccupancyMaxActiveBlocksPerMultiprocessor(&per_cu, (const void*)hybrid_fwd, NTHREADS, LDS_BYTES);
        if (per_cu < 1) fprintf(stderr, "kernel_launch: occupancy query reports %d blocks per CU\n", per_cu);
        grid = cus > 0 ? cus : 256;
    }
    if (grid < 0) return;
    hipMemsetAsync((char*)d_ws, 0, WS_CTL_END, stream);
    Params p{};
    p.x = (const float*)d_in[0]; p.pos = (const int*)d_in[1];
    p.w_in = (const float*)d_in[2]; p.g_q = (const float*)d_in[3]; p.w_qb = (const float*)d_in[4]; p.g_kv = (const float*)d_in[5]; p.w_kvb = (const float*)d_in[6];
    p.w_oa = (const float*)d_in[7]; p.w_ob = (const float*)d_in[8]; p.w_out = (const float*)d_in[9]; p.ln1g = (const float*)d_in[10]; p.ln1b = (const float*)d_in[11];
    p.w_group = (const float*)d_in[12]; p.b_group = (const float*)d_in[13]; p.w_router = (const float*)d_in[14]; p.b_router = (const float*)d_in[15];
    p.w_eg = (const float*)d_in[16]; p.w_eu = (const float*)d_in[17]; p.w_ed = (const float*)d_in[18]; p.ln2g = (const float*)d_in[19]; p.ln2b = (const float*)d_in[20];
    p.out = (float*)d_out; p.ws = (unsigned char*)d_ws;
#if MK_ONE_LAUNCH
    hipLaunchKernelGGL(hybrid_fwd, dim3(grid), dim3(NTHREADS), LDS_BYTES, stream, p, 0, DEPTH * NPH);
#else
    for (int ph = 0; ph <= DEPTH * NPH; ++ph) hipLaunchKernelGGL(hybrid_fwd, dim3(grid), dim3(NTHREADS), LDS_BYTES, stream, p, ph, ph);
#endif
}
```

```cpp
#include <hip/hip_runtime.h>
#include <cstdio>
#include <cstdint>

typedef unsigned short bf16_t;
typedef float f32x4 __attribute__((ext_vector_type(4)));
typedef unsigned u32x4 __attribute__((ext_vector_type(4)));
typedef unsigned u32x2 __attribute__((ext_vector_type(2)));

constexpr int T = 8192, D = 2048, S = 4096, NB = 2, DEPTH = 2;
constexpr int INW = 9360, INP = 9472;
constexpr int NE = 64, FE = 512;
constexpr int NTHREADS = 512;
constexpr int LDS_BYTES = 147456;
constexpr float ALPHA = 1.41421356237309515f;
constexpr int ECAP = 8192;
constexpr int PMAX = 36864;

constexpr size_t al256(size_t x) { return (x + 255) & ~(size_t)255; }
constexpr size_t XCD_BAR_BYTES = 16384;
constexpr size_t WS_BAR = 0;
constexpr size_t WS_CNT = WS_BAR + XCD_BAR_BYTES;
constexpr size_t WS_CTL_END = WS_CNT + al256(DEPTH * 64 * 4);
constexpr size_t WS_SSQ = WS_CTL_END;
constexpr size_t WS_ROPE = WS_SSQ + al256((size_t)T * 32 * 4);
constexpr size_t WS_XB = WS_ROPE + al256((size_t)T * 112 * 4);
constexpr size_t WS_H2F = WS_XB + al256((size_t)T * D * 2);
constexpr size_t WS_CQ = WS_H2F + al256((size_t)T * D * 4);
constexpr size_t WS_CKV = WS_CQ + al256((size_t)T * 512 * 2);
constexpr size_t WS_QB = WS_CKV + al256((size_t)T * 512 * 2);
constexpr size_t WS_KB = WS_QB + al256((size_t)T * 1024 * 2);
constexpr size_t WS_VB = WS_KB + al256((size_t)T * 1024 * 2);
constexpr size_t WS_QI = WS_VB + al256((size_t)T * 1024 * 2);
constexpr size_t WS_KI = WS_QI + al256((size_t)T * 1024 * 2);
constexpr size_t WS_WI = WS_KI + al256((size_t)T * 64 * 2);
constexpr size_t WS_GA = WS_WI + al256((size_t)T * 16 * 4);
constexpr size_t WS_GB = WS_GA + al256((size_t)T * D * 2);
constexpr size_t WS_QA = WS_GB + al256((size_t)T * D * 2);
constexpr size_t WS_KA = WS_QA + al256((size_t)T * 1536 * 2);
constexpr size_t WS_VA = WS_KA + al256((size_t)T * 1536 * 2);
constexpr size_t WS_MASK = WS_VA + al256((size_t)T * 1024 * 2);
constexpr size_t WS_OA = WS_MASK + al256((size_t)T * 128 * 4);
constexpr size_t WS_OB = WS_OA + al256((size_t)T * 1024 * 2);
constexpr size_t WS_YT = WS_OB + al256((size_t)T * 1024 * 2);
constexpr size_t WS_Y = WS_YT + al256((size_t)T * D * 4);
constexpr size_t WS_V1 = WS_Y + al256((size_t)T * D * 2);
constexpr size_t WS_H1F = WS_V1 + al256((size_t)T * D * 4);
constexpr size_t WS_H1B = WS_H1F + al256((size_t)T * D * 4);
constexpr size_t WS_TOKE = WS_H1B + al256((size_t)T * D * 2);
constexpr size_t WS_TOKW = WS_TOKE + al256((size_t)T * 2 * 4);
constexpr size_t WS_TOKS = WS_TOKW + al256((size_t)T * 2 * 4);
constexpr size_t WS_LIST = WS_TOKS + al256((size_t)T * 2 * 4);
constexpr size_t WS_HID = WS_LIST + al256((size_t)NE * ECAP * 4);
constexpr size_t WS_YE = WS_HID + al256((size_t)PMAX * FE * 2);
constexpr size_t WS_SCORE = WS_YE + al256((size_t)PMAX * D * 2);
constexpr size_t WS_WIN_T = WS_SCORE + al256((size_t)T * 4096 * 4);
constexpr size_t WS_WQB_T = WS_WIN_T + al256((size_t)DEPTH * INP * D * 2);
constexpr size_t WS_WKVB_T = WS_WQB_T + al256((size_t)DEPTH * 1536 * 512 * 2);
constexpr size_t WS_WOA_T = WS_WKVB_T + al256((size_t)DEPTH * 2048 * 512 * 2);
constexpr size_t WS_WOB_T = WS_WOA_T + al256((size_t)DEPTH * D * 1024 * 2);
constexpr size_t WS_WOUT_T = WS_WOB_T + al256((size_t)DEPTH * D * 1024 * 2);
constexpr size_t WS_END = WS_WOUT_T + al256((size_t)DEPTH * D * D * 2);
static_assert(WS_CKV == WS_CQ + (size_t)T * 512 * 2, "CQ|CKV must be consecutive");

static_assert(WS_KB == WS_QB + (size_t)T * 1024 * 2 && WS_VB == WS_KB + (size_t)T * 1024 * 2 && WS_GB == WS_GA + (size_t)T * D * 2, "QB|KB|VB and GA|GB must be consecutive");
struct Params {
    const float* x; const int* pos;
    const float *w_in, *g_q, *w_qb, *g_kv, *w_kvb, *w_oa, *w_ob, *w_out, *ln1g, *ln1b, *w_group, *b_group, *w_router, *b_router, *w_eg, *w_eu, *w_ed, *ln2g, *ln2b;
    float* out; unsigned char* ws;
};

__device__ __forceinline__ float bf2f(bf16_t v) { return __uint_as_float((unsigned)v << 16); }
__device__ __forceinline__ bf16_t f2bf(float f) { unsigned u = __float_as_uint(f); u += 0x7fffu + ((u >> 16) & 1u); return (bf16_t)(u >> 16); }
__device__ __forceinline__ unsigned pk2(float a, float b) { return (unsigned)f2bf(a) | ((unsigned)f2bf(b) << 16); }
__device__ __forceinline__ void st4bf(bf16_t* p, f32x4 v) { u32x2 w; w.x = pk2(v[0], v[1]); w.y = pk2(v[2], v[3]); *(u32x2*)p = w; }
__device__ __forceinline__ float wave_sum(float v) {
#pragma unroll
    for (int o = 32; o >= 1; o >>= 1) v += __shfl_xor(v, o);
    return v;
}
__device__ __forceinline__ float wave_max(float v) {
#pragma unroll
    for (int o = 32; o >= 1; o >>= 1) v = fmaxf(v, __shfl_xor(v, o));
    return v;
}
__device__ __forceinline__ int block_sum_int(int v, int* red) {
#pragma unroll
    for (int o = 32; o >= 1; o >>= 1) v += __shfl_xor(v, o);
    if ((threadIdx.x & 63) == 0) red[threadIdx.x >> 6] = v;
    __syncthreads();
    int t = 0;
#pragma unroll
    for (int i = 0; i < 8; ++i) t += red[i];
    __syncthreads();
    return t;
}
__device__ __forceinline__ f32x4 rot4(f32x4 v, float c0, float s0, float c1, float s1) { f32x4 o; o[0] = v[0] * c0 - v[1] * s0; o[1] = v[1] * c0 + v[0] * s0; o[2] = v[2] * c1 - v[3] * s1; o[3] = v[3] * c1 + v[2] * s1; return o; }

#define XB_TMO      128
#define XB_XCNT(j)  (256  + 64 * (j))
#define XB_XSUB(j)  (1280 + 64 * (j))
#define XB_XGEN(j)  (2304 + 64 * (j))
#define XB_TOP      3328
#define XB_TOPGEN   3392
#define XCD_BAR_WORDS 3456
#define XB_SPIN_CAP (1u << 22)
#define LAS __attribute__((address_space(3)))
__device__ __forceinline__ unsigned xb_ld(unsigned* p)              { return __hip_atomic_load(p, __ATOMIC_RELAXED, __HIP_MEMORY_SCOPE_AGENT); }
__device__ __forceinline__ unsigned xb_add(unsigned* p, unsigned v) { return __hip_atomic_fetch_add(p, v, __ATOMIC_RELAXED, __HIP_MEMORY_SCOPE_AGENT); }
__device__ __forceinline__ unsigned xb_xcc_id() { return (unsigned)__builtin_amdgcn_s_getreg((3 << 11) | 20) & 0xFu; }
#define XB_SPIN(cond, bar) do { unsigned _sp = 0; while (cond) { __builtin_amdgcn_s_sleep(1); \
    if ((++_sp & 255u) == 0u) { if (xb_ld(&(bar)[XB_TMO])) break; if (_sp > XB_SPIN_CAP) { atomicAdd(&(bar)[XB_TMO], 1u); break; } } } } while (0)
struct XcdBarrier { unsigned* bar; unsigned x; volatile LAS unsigned* st; };
__device__ __forceinline__ XcdBarrier xcd_barrier_post(unsigned* bar, volatile LAS unsigned* st) {
    XcdBarrier b; b.bar = bar; b.x = xb_xcc_id(); b.st = st;
    if (threadIdx.x == 0) (void)xb_add(&bar[XB_XCNT(b.x)], 1u);
    return b;
}
__device__ __forceinline__ void xcd_barrier_complete(unsigned* bar, unsigned x, unsigned& nloc, unsigned& nx) {
    const unsigned G = gridDim.x * gridDim.y * gridDim.z;
    unsigned sum, cnt, mine, sp = 0u;
    for (;;) {
        sum = 0u; cnt = 0u; mine = 0u;
#pragma unroll
        for (unsigned j = 0; j < 16; ++j) { const unsigned c = xb_ld(&bar[XB_XCNT(j)]); sum += c; cnt += (c > 0u) ? 1u : 0u; mine = (j == x) ? c : mine; }
        if (sum == G) break;
        __builtin_amdgcn_s_sleep(1);
        if ((++sp & 255u) == 0u) { if (xb_ld(&bar[XB_TMO])) break; if (sp > XB_SPIN_CAP) { atomicAdd(&bar[XB_TMO], 1u); break; } }
    }
    nloc = mine > 0u ? mine : 1u; nx = cnt > 0u ? cnt : 1u;
}
__device__ __forceinline__ void xcd_barrier(const XcdBarrier& b) {
    asm volatile("s_waitcnt vmcnt(0)" ::: "memory");
    __syncthreads();
    if (threadIdx.x == 0) {
        unsigned* bar = b.bar;
        __builtin_amdgcn_s_waitcnt(0);
        unsigned nloc = b.st[0], nx = b.st[1];
        if (nloc == 0u) { xcd_barrier_complete(bar, b.x, nloc, nx); b.st[0] = nloc; b.st[1] = nx; }
        const unsigned old = xb_add(&bar[XB_XSUB(b.x)], 1u);
        const unsigned gen = old / nloc;
        if (old + 1u == (gen + 1u) * nloc) {
            __builtin_amdgcn_fence(__ATOMIC_RELEASE, "agent");
            asm volatile("s_waitcnt vmcnt(0)" ::: "memory");
            const unsigned og = xb_add(&bar[XB_TOP], 1u);
            const unsigned tg = og / nx;
            if (og + 1u == (tg + 1u) * nx) xb_add(&bar[XB_TOPGEN], 1u);
            else XB_SPIN(xb_ld(&bar[XB_TOPGEN]) == tg, bar);
            __builtin_amdgcn_fence(__ATOMIC_ACQUIRE, "agent");
            xb_add(&bar[XB_XGEN(b.x)], 1u);
            asm volatile("s_waitcnt vmcnt(0)" ::: "memory");
        } else {
            XB_SPIN(xb_ld(&bar[XB_XGEN(b.x)]) == gen, bar);
            __builtin_amdgcn_fence(__ATOMIC_ACQUIRE, "agent");
            asm volatile("s_waitcnt vmcnt(0)" ::: "memory");
        }
    }
    __syncthreads();
}

__device__ __forceinline__ int opaque_tid() { int t = threadIdx.x; asm volatile("" : "+v"(t)); return t; }
namespace pg8 {
#define PG8_LAS __attribute__((address_space(3)))
typedef unsigned short bf16_t;
typedef short bf16x8 __attribute__((ext_vector_type(8)));
typedef float f32x4 __attribute__((ext_vector_type(4)));
typedef unsigned u32x4 __attribute__((ext_vector_type(4)));
constexpr int BM = 256, BK = 64, HALF = 128, HTB = HALF * BK * 2  , STAGE_BYTES = 8 * HTB, NXCD = 8, WGM = 8;

__host__ __device__ __forceinline__ int lds_byte(int r, int c) { const int st = (r >> 4) * 2 + (c >> 5), rr = r & 15, cc = c & 31, ob = rr * 64 + cc * 2; return st * 1024 + (ob ^ (((ob >> 9) & 1) << 5)); }
__host__ __device__ __forceinline__ void stage_rc(int b, int& R, int& C) { const int st = b / 1024, sb = b % 1024, swz = sb ^ (((sb >> 9) & 1) << 5); R = (st >> 1) * 16 + swz / 64; C = (st & 1) * 32 + (swz % 64) / 2; }
__host__ __device__ __forceinline__ int perm32(int rho) { const int n = rho >> 4, i = rho & 15; return 8 * (i >> 2) + 4 * n + (i & 3); }

struct Unit { int pm, pn; };
struct Gemm { const bf16_t* A; const bf16_t* Bt; int M, N, K; };

struct StaticOrder {
    int nM, nN, nwg, G, c;
    __host__ __device__ void init(int M, int N, int G_, int c_) { nM = M / BM; nN = N / BM; nwg = nM * nN; G = G_; c = c_; }
    __host__ __device__ bool next(int i, Unit& u) const {
        const long L = (long)i * G + c; if (L >= nwg) return false;
        int wgid = (int)L; { const int q = nwg / NXCD, r = nwg % NXCD, xcd = wgid % NXCD, off = wgid / NXCD; wgid = (xcd < r ? xcd * (q + 1) : r * (q + 1) + (xcd - r) * q) + off; }
        const int nig = WGM * nN, gid = wgid / nig, fm = gid * WGM, gsz = (nM - fm) < WGM ? (nM - fm) : WGM;
        u.pm = fm + ((wgid % nig) % gsz); u.pn = (wgid % nig) / gsz; return true;
    }
    __device__ __forceinline__ void a_ready(const Unit&) const {}
    __device__ __forceinline__ void done(const Unit&) const {}
};

__device__ __forceinline__ unsigned cvt_pk_bf16(float lo, float hi) { unsigned r; asm volatile("v_cvt_pk_bf16_f32 %0, %1, %2" : "=v"(r) : "v"(lo), "v"(hi)); return r; }
template <class Epi, class Sched, bool ALIGN_EPI = false, bool SP2 = false>
__device__ __forceinline__ void gemm_phase(PG8_LAS unsigned char* lds, const Gemm g, const Sched& S, const Epi& E) {
    const int tid = opaque_tid(), wid = __builtin_amdgcn_readfirstlane(tid >> 6), lane = tid & 63, wr = wid >> 2, wc = wid & 3, fr = lane & 15, fq = lane >> 4;
    const int K = g.K, nt = K / BK;
    unsigned voffA[2], voffB[2];
#pragma unroll
    for (int i = 0; i < 2; ++i) { int R, C; stage_rc(tid * 16 + i * 8192, R, C); const int Rb = Epi::PERM ? ((R & ~31) + perm32(R & 31)) : R;
        voffA[i] = (unsigned)(R * K + C) * 2u; voffB[i] = (unsigned)(Rb * K + C) * 2u; }
    const size_t kstep = (size_t)(BK * 2);
    const size_t hstep = (size_t)HALF * K * 2;
    const size_t tstep = 2 * hstep;
    const unsigned ldsw = (unsigned)wid * 1024u;
    const int aoff = lds_byte(wr * 64 + fr, fq * 8), boff = lds_byte(wc * 32 + fr, fq * 8);
#define PG8_SA(b, h) (((b) * 2 + (h)) * HTB)
#define PG8_SB(b, h) ((4 + (b) * 2 + (h)) * HTB)
#define PG8_STAGE(bufoff, gbase, voff) do { _Pragma("unroll") for (int _i = 0; _i < 2; ++_i) \
        __builtin_amdgcn_global_load_lds((const unsigned*)((const char*)(gbase) + (voff)[_i]), (PG8_LAS unsigned*)(lds + (bufoff) + ldsw + _i * 8192), 16, 0, 0); } while (0)
#define PG8_LDA(dst, b, h) do { _Pragma("unroll") for (int m = 0; m < 4; ++m) _Pragma("unroll") for (int k = 0; k < 2; ++k) dst[m][k] = *(const PG8_LAS bf16x8*)(lds + PG8_SA(b, h) + aoff + m * 2048 + k * 1024); } while (0)
#define PG8_LDB(dst, b, h) do { _Pragma("unroll") for (int n = 0; n < 2; ++n) _Pragma("unroll") for (int k = 0; k < 2; ++k) dst[n][k] = *(const PG8_LAS bf16x8*)(lds + PG8_SB(b, h) + boff + n * 2048 + k * 1024); } while (0)
#define PG8_MMA(ai, bj, At, Bt) do { __builtin_amdgcn_s_setprio(1); _Pragma("unroll") for (int m = 0; m < 4; ++m) _Pragma("unroll") for (int n = 0; n < 2; ++n) _Pragma("unroll") for (int k = 0; k < 2; ++k) \
        acc[ai][bj][m][n] = __builtin_amdgcn_mfma_f32_16x16x32_bf16(Bt[n][k], At[m][k], acc[ai][bj][m][n], 0, 0, 0); __builtin_amdgcn_s_setprio(0); } while (0)
#define PG8_WAIT_V(n) asm volatile("s_waitcnt vmcnt(" #n ")" ::: "memory")
#define PG8_WAIT_L(n) asm volatile("s_waitcnt lgkmcnt(" #n ")" ::: "memory")
#define PG8_BAR __builtin_amdgcn_s_barrier()
#define PG8_SCHED __builtin_amdgcn_sched_barrier(0)
    Unit cur, nxt; int ui = 0;
    if (!S.next(0, cur)) return;
    f32x4 acc[2][2][4][2];
#pragma unroll
    for (int a = 0; a < 2; ++a)
#pragma unroll
        for (int b = 0; b < 2; ++b)
#pragma unroll
            for (int m = 0; m < 4; ++m)
#pragma unroll
                for (int n = 0; n < 2; ++n) acc[a][b][m][n] = (f32x4){0.f, 0.f, 0.f, 0.f};
    bf16x8 At[4][2], B0[2][2], B1[2][2];
    const char* cA = (const char*)g.A + (size_t)cur.pm * tstep; const char* cB = (const char*)g.Bt + (size_t)cur.pn * tstep;
    S.a_ready(cur);
    if constexpr (SP2) {
        PG8_STAGE(PG8_SB(0, 0), cB, voffB); PG8_STAGE(PG8_SB(0, 1), cB + hstep, voffB); PG8_STAGE(PG8_SA(0, 0), cA, voffA); PG8_STAGE(PG8_SA(0, 1), cA + hstep, voffA);
        if (wr == 1) PG8_BAR;
        PG8_WAIT_V(2); PG8_BAR;
        PG8_STAGE(PG8_SB(1, 0), cB + kstep, voffB); PG8_STAGE(PG8_SA(1, 0), cA + kstep, voffA); PG8_STAGE(PG8_SB(1, 1), cB + hstep + kstep, voffB);
        PG8_WAIT_V(6); PG8_BAR;
    } else {
        PG8_STAGE(PG8_SB(0, 0), cB, voffB); PG8_STAGE(PG8_SA(0, 0), cA, voffA); PG8_STAGE(PG8_SB(0, 1), cB + hstep, voffB); PG8_STAGE(PG8_SA(0, 1), cA + hstep, voffA);
        if (wr == 1) PG8_BAR;
        PG8_WAIT_V(4); PG8_BAR;
        PG8_STAGE(PG8_SB(1, 0), cB + kstep, voffB); PG8_STAGE(PG8_SA(1, 0), cA + kstep, voffA); PG8_STAGE(PG8_SB(1, 1), cB + hstep + kstep, voffB);
        PG8_WAIT_V(6); PG8_BAR;
    }
    for (;;) {
        const bool has_next = S.next(ui + 1, nxt);
        const char* nA = has_next ? (const char*)g.A + (size_t)nxt.pm * tstep : cA; const char* nB = has_next ? (const char*)g.Bt + (size_t)nxt.pn * tstep : cB;
        for (int t = 0; t < nt; t += 2) {
            const bool last = (t == nt - 2);
            const char* a1 = cA + (size_t)(t + 1) * kstep;
            const char* a2 = last ? nA : cA + (size_t)(t + 2) * kstep; const char* b2 = last ? nB : cB + (size_t)(t + 2) * kstep;
            const char* a3 = a2 + kstep; const char* b3 = b2 + kstep;
            if (last && has_next) S.a_ready(nxt);
            if constexpr (SP2) {
            PG8_LDB(B0, 0, 0); PG8_LDB(B1, 0, 1); PG8_SCHED; PG8_LDA(At, 0, 0); PG8_STAGE(PG8_SA(1, 1), a1 + hstep, voffA);
            PG8_WAIT_V(8); PG8_WAIT_L(0); PG8_BAR; PG8_MMA(0, 0, At, B0); PG8_MMA(0, 1, At, B1); PG8_BAR; PG8_SCHED;
            PG8_LDA(At, 0, 1); PG8_STAGE(PG8_SB(0, 0), b2, voffB); PG8_STAGE(PG8_SB(0, 1), b2 + hstep, voffB); PG8_STAGE(PG8_SA(0, 0), a2, voffA);
            PG8_WAIT_V(8); PG8_WAIT_L(0); PG8_BAR; PG8_MMA(1, 0, At, B0); PG8_MMA(1, 1, At, B1); PG8_BAR; PG8_SCHED;
            PG8_LDB(B0, 1, 0); PG8_LDB(B1, 1, 1); PG8_SCHED; PG8_LDA(At, 1, 0); PG8_STAGE(PG8_SA(0, 1), a2 + hstep, voffA);
            PG8_WAIT_V(8); PG8_WAIT_L(0); PG8_BAR; PG8_MMA(0, 0, At, B0); PG8_MMA(0, 1, At, B1); PG8_BAR; PG8_SCHED;
            PG8_LDA(At, 1, 1); PG8_STAGE(PG8_SB(1, 0), b3, voffB); PG8_STAGE(PG8_SB(1, 1), b3 + hstep, voffB); PG8_STAGE(PG8_SA(1, 0), a3, voffA);
            PG8_WAIT_V(8); PG8_WAIT_L(0); PG8_BAR; PG8_MMA(1, 0, At, B0); PG8_MMA(1, 1, At, B1); PG8_BAR; PG8_SCHED;
            } else {
            PG8_LDB(B0, 0, 0); PG8_SCHED; PG8_LDA(At, 0, 0); PG8_STAGE(PG8_SA(1, 1), a1 + hstep, voffA);
            PG8_WAIT_L(8); PG8_BAR; PG8_WAIT_L(0); PG8_MMA(0, 0, At, B0); PG8_BAR; PG8_SCHED;
            PG8_LDB(B1, 0, 1); PG8_STAGE(PG8_SB(0, 0), b2, voffB);
            PG8_BAR; PG8_WAIT_L(0); PG8_MMA(0, 1, At, B1); PG8_BAR;
            PG8_LDA(At, 0, 1); PG8_STAGE(PG8_SA(0, 0), a2, voffA);
            PG8_BAR; PG8_WAIT_L(0); PG8_MMA(1, 0, At, B0); PG8_BAR; PG8_SCHED;
            PG8_STAGE(PG8_SB(0, 1), b2 + hstep, voffB);
            PG8_WAIT_V(6); PG8_BAR; PG8_MMA(1, 1, At, B1); PG8_BAR;
            PG8_LDB(B0, 1, 0); PG8_SCHED; PG8_LDA(At, 1, 0); PG8_STAGE(PG8_SA(0, 1), a2 + hstep, voffA);
            PG8_WAIT_L(8); PG8_BAR; PG8_WAIT_L(0); PG8_MMA(0, 0, At, B0); PG8_BAR; PG8_SCHED;
            PG8_LDB(B1, 1, 1); PG8_STAGE(PG8_SB(1, 0), b3, voffB);
            PG8_BAR; PG8_WAIT_L(0); PG8_MMA(0, 1, At, B1); PG8_BAR;
            PG8_LDA(At, 1, 1); PG8_STAGE(PG8_SA(1, 0), a3, voffA);
            PG8_BAR; PG8_WAIT_L(0); PG8_MMA(1, 0, At, B0); PG8_BAR; PG8_SCHED;
            PG8_STAGE(PG8_SB(1, 1), b3 + hstep, voffB);
            PG8_WAIT_V(6); PG8_BAR; PG8_MMA(1, 1, At, B1); PG8_BAR;
            }
        }
        if constexpr (ALIGN_EPI) { if (wr == 0) PG8_BAR; }
        if constexpr (!Epi::AFTER_DRAIN) { E(acc, cur, wr, wc, fr, fq); S.done(cur); }
        if (!has_next) break;
#pragma unroll
        for (int a = 0; a < 2; ++a)
#pragma unroll
            for (int b = 0; b < 2; ++b)
#pragma unroll
                for (int m = 0; m < 4; ++m)
#pragma unroll
                    for (int n = 0; n < 2; ++n) acc[a][b][m][n] = (f32x4){0.f, 0.f, 0.f, 0.f};
        cur = nxt; cA = nA; cB = nB; ++ui;
        if constexpr (ALIGN_EPI) { if (wr == 1) PG8_BAR; }
    }
    PG8_WAIT_V(0);
    if constexpr (!ALIGN_EPI) { if (wr == 0) PG8_BAR; }
    PG8_BAR;
    if constexpr (Epi::AFTER_DRAIN) { E.fused(acc, cur, wr, wc, fr, fq, lds, wid, lane); S.done(cur); }
#undef PG8_SA
#undef PG8_SB
#undef PG8_STAGE
#undef PG8_LDA
#undef PG8_LDB
#undef PG8_MMA
#undef PG8_WAIT_V
#undef PG8_WAIT_L
#undef PG8_BAR
#undef PG8_SCHED
}
}

__device__ __forceinline__ unsigned pkbf(float lo, float hi) { return pg8::cvt_pk_bf16(lo, hi); }
__device__ __forceinline__ void st8bf(bf16_t* p, f32x4 a, f32x4 b) { u32x4 w; w.x = pkbf(a[0], a[1]); w.y = pkbf(a[2], a[3]); w.z = pkbf(b[0], b[1]); w.w = pkbf(b[2], b[3]); *(u32x4*)p = w; }
__device__ __forceinline__ f32x4 bflo(u32x4 g) { f32x4 o; o[0] = __uint_as_float(g.x << 16); o[1] = __uint_as_float(g.x & 0xffff0000u); o[2] = __uint_as_float(g.y << 16); o[3] = __uint_as_float(g.y & 0xffff0000u); return o; }
__device__ __forceinline__ f32x4 bfhi(u32x4 g) { f32x4 o; o[0] = __uint_as_float(g.z << 16); o[1] = __uint_as_float(g.z & 0xffff0000u); o[2] = __uint_as_float(g.w << 16); o[3] = __uint_as_float(g.w & 0xffff0000u); return o; }
__device__ __forceinline__ f32x4 bf4(u32x2 g) { f32x4 o; o[0] = __uint_as_float(g.x << 16); o[1] = __uint_as_float(g.x & 0xffff0000u); o[2] = __uint_as_float(g.y << 16); o[3] = __uint_as_float(g.y & 0xffff0000u); return o; }
__device__ __forceinline__ void rot8(f32x4& a, f32x4& b, f32x4 c, f32x4 s) {
    const f32x4 x = a, y = b;
    a[0] = x[0] * c[0] - x[1] * s[0]; a[1] = x[1] * c[0] + x[0] * s[0]; a[2] = x[2] * c[1] - x[3] * s[1]; a[3] = x[3] * c[1] + x[2] * s[1];
    b[0] = y[0] * c[2] - y[1] * s[2]; b[1] = y[1] * c[2] + y[0] * s[2]; b[2] = y[2] * c[3] - y[3] * s[3]; b[3] = y[3] * c[3] + y[2] * s[3];
}
__device__ __forceinline__ f32x4 sig4(f32x4 v) { f32x4 o; o[0] = 1.f / (1.f + __expf(-v[0])); o[1] = 1.f / (1.f + __expf(-v[1])); o[2] = 1.f / (1.f + __expf(-v[2])); o[3] = 1.f / (1.f + __expf(-v[3])); return o; }
__host__ __device__ __forceinline__ int src_in(int n) {
    if (n < 1024) return n;
    if (n < 4096) { const int seg = (n - 1024) >> 10, c = (n - 1024) & 1023, d = c & 127; int od = d; if (seg < 2 && d < 32) od = (d >> 1) + (d & 1) * 16; return 1088 + seg * 1024 + (c & ~127) + od; }
    if (n < 5120) { const int c = n - 4096, d = c & 63; const int od = d < 16 ? (d >> 1) + (d & 1) * 8 : d; return 4160 + (c & ~63) + od; }
    if (n < 7168) return 5264 + (n - 5120);
    if (n < 9216) return 7312 + (n - 7168);
    if (n < 9280) { const int d = n - 9216; return 1024 + (d >> 1) + (d & 1) * 32; }
    if (n < 9344) { const int d = n - 9280; const int od = d < 16 ? (d >> 1) + (d & 1) * 8 : d; return 5184 + od; }
    if (n < 9360) return 5248 + (n - 9344);
    return -1;
}
__host__ __device__ __forceinline__ int src_qa(int n) { const int h = n / 192, d = n - h * 192; if (d < 128) return n; const int dd = d - 128; return h * 192 + 128 + (dd >> 1) + (dd & 1) * 32; }

struct EpiIn {
    static constexpr bool PERM = true, AFTER_DRAIN = false;
    unsigned char* ws;
    __device__ __forceinline__ void operator()(const f32x4 (&acc)[2][2][4][2], const pg8::Unit& u, int wr, int wc, int fr, int fq) const {
        const int row0 = u.pm * 256 + wr * 64 + fr, cu = wc * 32 + 8 * fq, pn = u.pn;
        bf16_t* const CQ = (bf16_t*)(ws + WS_CQ); bf16_t* const QB = (bf16_t*)(ws + WS_QB); bf16_t* const QI = (bf16_t*)(ws + WS_QI); bf16_t* const GA = (bf16_t*)(ws + WS_GA);
        bf16_t* const KA = (bf16_t*)(ws + WS_KA); bf16_t* const KI = (bf16_t*)(ws + WS_KI); float* const WI = (float*)(ws + WS_WI); float* const part = (float*)(ws + WS_SSQ);
        const float* const cM = (const float*)(ws + WS_ROPE); const float* const sM = cM + T * 32; const float* const cD = cM + T * 64; const float* const sD = cM + T * 80; const float* const cI = cM + T * 96; const float* const sI = cM + T * 104;
#define EPI_ROWS(BODY) _Pragma("unroll") for (int ai = 0; ai < 2; ++ai) _Pragma("unroll") for (int m = 0; m < 4; ++m) { const int t = row0 + ai * 128 + m * 16; \
            _Pragma("unroll") for (int bj = 0; bj < 2; ++bj) { f32x4 a = acc[ai][bj][m][0], b = acc[ai][bj][m][1]; BODY } }
        if (pn < 4) {
            bf16_t* const dst = CQ + (size_t)(pn >> 1) * ((size_t)T * 512) + (pn & 1) * 256 + cu;
            EPI_ROWS(
                st8bf(dst + (size_t)t * 512 + bj * 128, a, b);
                float sq = ((a[0] * a[0] + a[1] * a[1]) + (a[2] * a[2] + a[3] * a[3])) + ((b[0] * b[0] + b[1] * b[1]) + (b[2] * b[2] + b[3] * b[3]));
                sq += __shfl_xor(sq, 16); sq += __shfl_xor(sq, 32);
                if (fq == 0) part[(size_t)t * 32 + pn * 8 + bj * 4 + wc] = sq; )
        } else if (pn < 16) {
            const int seg = (pn - 4) >> 2; const bool rot = seg < 2 && wc == 0;
            bf16_t* const dst = QB + (size_t)seg * ((size_t)T * 1024) + ((pn - 4) & 3) * 256 + cu;
            EPI_ROWS(
                if (rot) rot8(a, b, *(const f32x4*)(cD + (size_t)t * 16 + 4 * fq), *(const f32x4*)(sD + (size_t)t * 16 + 4 * fq));
                st8bf(dst + (size_t)t * 1024 + bj * 128, a, b); )
        } else if (pn < 20) {
            const bool rot = (wc & 1) == 0 && fq < 2;
            bf16_t* const dst = QI + (pn - 16) * 256 + cu;
            EPI_ROWS(
                if (rot) rot8(a, b, *(const f32x4*)(cI + (size_t)t * 8 + 4 * fq), *(const f32x4*)(sI + (size_t)t * 8 + 4 * fq));
                st8bf(dst + (size_t)t * 1024 + bj * 128, a, b); )
        } else if (pn < 36) {
            bf16_t* const dst = GA + (size_t)((pn - 20) >> 3) * ((size_t)T * D) + ((pn - 20) & 7) * 256 + cu;
            EPI_ROWS( st8bf(dst + (size_t)t * D + bj * 128, sig4(a), sig4(b)); )
        } else {
            EPI_ROWS(
                if (bj == 0) {
                    if (wc < 2) {
                        rot8(a, b, *(const f32x4*)(cM + (size_t)t * 32 + (cu >> 1)), *(const f32x4*)(sM + (size_t)t * 32 + (cu >> 1)));
                        _Pragma("unroll") for (int h = 0; h < 8; ++h) st8bf(KA + (size_t)t * 1536 + h * 192 + 128 + cu, a, b);
                    } else {
                        const int d = cu - 64;
                        if (d < 16) rot8(a, b, *(const f32x4*)(cI + (size_t)t * 8 + (d >> 1)), *(const f32x4*)(sI + (size_t)t * 8 + (d >> 1)));
                        st8bf(KI + (size_t)t * 64 + d, a, b);
                    }
                } else if (cu < 16) {
                    *(f32x4*)(WI + (size_t)t * 16 + cu) = a * 0.03125f; *(f32x4*)(WI + (size_t)t * 16 + cu + 4) = b * 0.03125f;
                } )
        }
#undef EPI_ROWS
    }
};
__device__ __forceinline__ float rms_from_part(const float* pp) {
    const f32x4 p0 = *(const f32x4*)pp, p1 = *(const f32x4*)(pp + 4), p2 = *(const f32x4*)(pp + 8), p3 = *(const f32x4*)(pp + 12);
    const float s = (((p0[0] + p0[1]) + (p0[2] + p0[3])) + ((p1[0] + p1[1]) + (p1[2] + p1[3]))) + (((p2[0] + p2[1]) + (p2[2] + p2[3])) + ((p3[0] + p3[1]) + (p3[2] + p3[3])));
    return rsqrtf(s * (1.f / 512.f) + 1e-6f);
}
struct EpiQA {
    static constexpr bool PERM = true, AFTER_DRAIN = false;
    unsigned char* ws;
    __device__ __forceinline__ void operator()(const f32x4 (&acc)[2][2][4][2], const pg8::Unit& u, int wr, int wc, int fr, int fq) const {
        const int row0 = u.pm * 256 + wr * 64 + fr, cu = wc * 32 + 8 * fq;
        bf16_t* const QA = (bf16_t*)(ws + WS_QA); const float* const part = (const float*)(ws + WS_SSQ); const float* const cM = (const float*)(ws + WS_ROPE); const float* const sM = cM + T * 32;
#pragma unroll
        for (int ai = 0; ai < 2; ++ai)
#pragma unroll
            for (int m = 0; m < 4; ++m) {
                const int t = row0 + ai * 128 + m * 16;
                const float r = rms_from_part(part + (size_t)t * 32);
#pragma unroll
                for (int bj = 0; bj < 2; ++bj) {
                    const int n = u.pn * 256 + bj * 128 + cu, h = n / 192, d = n - h * 192;
                    f32x4 a = acc[ai][bj][m][0] * r, b = acc[ai][bj][m][1] * r;
                    if (d >= 128) rot8(a, b, *(const f32x4*)(cM + (size_t)t * 32 + ((d - 128) >> 1)), *(const f32x4*)(sM + (size_t)t * 32 + ((d - 128) >> 1)));
                    st8bf(QA + (size_t)t * 1536 + n, a, b);
                }
            }
    }
};
struct EpiKV {
    static constexpr bool PERM = true, AFTER_DRAIN = false;
    unsigned char* ws;
    __device__ __forceinline__ void operator()(const f32x4 (&acc)[2][2][4][2], const pg8::Unit& u, int wr, int wc, int fr, int fq) const {
        const int row0 = u.pm * 256 + wr * 64 + fr, cu = wc * 32 + 8 * fq;
        bf16_t* const KA = (bf16_t*)(ws + WS_KA); bf16_t* const VA = (bf16_t*)(ws + WS_VA); const float* const part = (const float*)(ws + WS_SSQ);
#pragma unroll
        for (int ai = 0; ai < 2; ++ai)
#pragma unroll
            for (int m = 0; m < 4; ++m) {
                const int t = row0 + ai * 128 + m * 16;
                const float r = rms_from_part(part + (size_t)t * 32 + 16);
                st8bf(KA + (size_t)t * 1536 + u.pn * 192 + cu, acc[ai][0][m][0] * r, acc[ai][0][m][1] * r);
                st8bf(VA + (size_t)t * 1024 + u.pn * 128 + cu, acc[ai][1][m][0] * r, acc[ai][1][m][1] * r);
            }
    }
};
struct EpiYA {
    static constexpr bool PERM = true, AFTER_DRAIN = false;
    unsigned char* ws;
    __device__ __forceinline__ void operator()(const f32x4 (&acc)[2][2][4][2], const pg8::Unit& u, int wr, int wc, int fr, int fq) const {
        const int row0 = u.pm * 256 + wr * 64 + fr, col0 = u.pn * 256 + wc * 32 + 8 * fq;
        float* const YT = (float*)(ws + WS_YT); const bf16_t* const GA = (const bf16_t*)(ws + WS_GA);
#pragma unroll
        for (int ai = 0; ai < 2; ++ai)
#pragma unroll
            for (int m = 0; m < 4; ++m)
#pragma unroll
                for (int bj = 0; bj < 2; ++bj) {
                    const size_t o = (size_t)(row0 + ai * 128 + m * 16) * D + col0 + bj * 128;
                    const u32x4 g = *(const u32x4*)(GA + o);
                    *(f32x4*)(YT + o) = acc[ai][bj][m][0] * bflo(g); *(f32x4*)(YT + o + 4) = acc[ai][bj][m][1] * bfhi(g);
                }
    }
};
struct EpiYB {
    static constexpr bool PERM = true, AFTER_DRAIN = false;
    unsigned char* ws;
    __device__ __forceinline__ void operator()(const f32x4 (&acc)[2][2][4][2], const pg8::Unit& u, int wr, int wc, int fr, int fq) const {
        const int row0 = u.pm * 256 + wr * 64 + fr, col0 = u.pn * 256 + wc * 32 + 8 * fq;
        const float* const YT = (const float*)(ws + WS_YT); const bf16_t* const GB = (const bf16_t*)(ws + WS_GB); bf16_t* const Y = (bf16_t*)(ws + WS_Y);
#pragma unroll
        for (int ai = 0; ai < 2; ++ai)
#pragma unroll
            for (int m = 0; m < 4; ++m)
#pragma unroll
                for (int bj = 0; bj < 2; ++bj) {
                    const size_t o = (size_t)(row0 + ai * 128 + m * 16) * D + col0 + bj * 128;
                    const u32x4 g = *(const u32x4*)(GB + o);
                    const f32x4 y0 = *(const f32x4*)(YT + o), y1 = *(const f32x4*)(YT + o + 4);
                    st8bf(Y + o, y0 + acc[ai][bj][m][0] * bflo(g), y1 + acc[ai][bj][m][1] * bfhi(g));
                }
    }
};
struct EpiOut {
    static constexpr bool PERM = true, AFTER_DRAIN = false;
    const float* hin; float* V1;
    __device__ __forceinline__ void operator()(const f32x4 (&acc)[2][2][4][2], const pg8::Unit& u, int wr, int wc, int fr, int fq) const {
        const int row0 = u.pm * 256 + wr * 64 + fr, col0 = u.pn * 256 + wc * 32 + 8 * fq;
#pragma unroll
        for (int ai = 0; ai < 2; ++ai)
#pragma unroll
            for (int m = 0; m < 4; ++m)
#pragma unroll
                for (int bj = 0; bj < 2; ++bj) {
                    const size_t o = (size_t)(row0 + ai * 128 + m * 16) * D + col0 + bj * 128;
                    const f32x4 h0 = *(const f32x4*)(hin + o), h1 = *(const f32x4*)(hin + o + 4);
                    *(f32x4*)(V1 + o) = h0 * ALPHA + acc[ai][bj][m][0]; *(f32x4*)(V1 + o + 4) = h1 * ALPHA + acc[ai][bj][m][1];
                }
    }
};

#define LDS_WAIT() asm volatile("s_waitcnt lgkmcnt(0)" ::: "memory")
template <int MAP>
__device__ __forceinline__ void transpose_item(const float* W, int ldw, int K, int N, const float* kscale, bf16_t* WT, LAS float* scr, int item, int lane) {
    const int nblk = N / 32, kb = item / nblk, nb = item % nblk, k0 = 64 * kb, n0 = 32 * nb;
    const int n = n0 + (lane & 31);
    const int sc = MAP == 0 ? n : (MAP == 1 ? src_in(n) : src_qa(n));
#pragma unroll 8
    for (int i = 0; i < 32; ++i) { const int kk = 2 * i + (lane >> 5);
        float v = sc >= 0 ? W[(size_t)(k0 + kk) * ldw + sc] : 0.f; if (kscale) v *= kscale[k0 + kk];
        scr[kk * 33 + (lane & 31)] = v; }
    LDS_WAIT(); asm volatile("" ::: "memory");
    const int c = lane & 7;
#pragma unroll
    for (int j = 0; j < 4; ++j) { const int nn = (lane >> 3) + 8 * j; const LAS float* sp = scr + (8 * c) * 33 + nn;
        u32x4 o; o.x = pkbf(sp[0 * 33], sp[1 * 33]); o.y = pkbf(sp[2 * 33], sp[3 * 33]); o.z = pkbf(sp[4 * 33], sp[5 * 33]); o.w = pkbf(sp[6 * 33], sp[7 * 33]);
        *(u32x4*)(WT + (size_t)(n0 + nn) * K + k0 + 8 * c) = o; }
    LDS_WAIT(); asm volatile("" ::: "memory");
}
__device__ __forceinline__ void p_prologue(LAS unsigned char* ldsb, const Params& p) {
    float* rope = (float*)(p.ws + WS_ROPE);
    float *cM = rope, *sM = rope + T * 32, *cD = rope + T * 64, *sD = rope + T * 80, *cI = rope + T * 96, *sI = rope + T * 104;
    const int gtid = blockIdx.x * NTHREADS + threadIdx.x, gstride = gridDim.x * NTHREADS;
    for (int idx = gtid; idx < T * 56; idx += gstride) {
        const int t = idx / 56, j = idx - t * 56;
        int rot, i; float *ct, *st; int w;
        if (j < 32) { rot = 64; i = j; ct = cM; st = sM; w = 32; } else if (j < 48) { rot = 32; i = j - 32; ct = cD; st = sD; w = 16; } else { rot = 16; i = j - 48; ct = cI; st = sI; w = 8; }
        const float inv = exp2f(-((float)(2 * i) / (float)rot) * 18.931568569324174f);
        const float ang = (float)p.pos[t] * inv;
        double rev = (double)ang * 0.15915494309189535; rev -= rint(rev);
        const float r = (float)(rev * 6.283185307179586);
        ct[t * w + i] = __cosf(r); st[t * w + i] = __sinf(r);
    }
    bf16_t* XB = (bf16_t*)(p.ws + WS_XB);
    for (size_t i = (size_t)gtid * 4; i < (size_t)T * D; i += (size_t)gstride * 4) st4bf(XB + i, *(const f32x4*)(p.x + i));
    const int wave = threadIdx.x >> 6, lane = threadIdx.x & 63;
    LAS float* scr = (LAS float*)(ldsb + wave * 16384);
    const int gw = blockIdx.x * 8 + wave, NGW = gridDim.x * 8;
    constexpr int I_IN = (D / 64) * (INP / 32), I_QB = (512 / 64) * (1536 / 32), I_KV = (512 / 64) * (2048 / 32), I_O = (1024 / 64) * (D / 32), I_OUT = (D / 64) * (D / 32);
    constexpr int I_LAYER = I_IN + I_QB + I_KV + 2 * I_O + I_OUT;
    for (int it = gw; it < DEPTH * I_LAYER; it += NGW) {
        const int l = it / I_LAYER; int r = it - l * I_LAYER;
        if (r < I_IN) { transpose_item<1>(p.w_in + (size_t)l * D * INW, INW, D, INP, nullptr, (bf16_t*)(p.ws + WS_WIN_T) + (size_t)l * INP * D, scr, r, lane); continue; } r -= I_IN;
        if (r < I_QB) { transpose_item<2>(p.w_qb + (size_t)l * 512 * 1536, 1536, 512, 1536, p.g_q + l * 512, (bf16_t*)(p.ws + WS_WQB_T) + (size_t)l * 1536 * 512, scr, r, lane); continue; } r -= I_QB;
        if (r < I_KV) { transpose_item<0>(p.w_kvb + (size_t)l * 512 * 2048, 2048, 512, 2048, p.g_kv + l * 512, (bf16_t*)(p.ws + WS_WKVB_T) + (size_t)l * 2048 * 512, scr, r, lane); continue; } r -= I_KV;
        if (r < I_O) { transpose_item<0>(p.w_oa + (size_t)l * 1024 * D, D, 1024, D, nullptr, (bf16_t*)(p.ws + WS_WOA_T) + (size_t)l * D * 1024, scr, r, lane); continue; } r -= I_O;
        if (r < I_O) { transpose_item<0>(p.w_ob + (size_t)l * 1024 * D, D, 1024, D, nullptr, (bf16_t*)(p.ws + WS_WOB_T) + (size_t)l * D * 1024, scr, r, lane); continue; } r -= I_O;
        transpose_item<0>(p.w_out + (size_t)l * D * D, D, D, D, nullptr, (bf16_t*)(p.ws + WS_WOUT_T) + (size_t)l * D * D, scr, r, lane);
    }
    __syncthreads();
}

__device__ __forceinline__ unsigned f2key(float f) { const unsigned u = __float_as_uint(f); return (u & 0x80000000u) ? ~u : (u | 0x80000000u); }
__device__ __forceinline__ void p_index(float* lds, const Params& p) {
    const bf16_t* QI = (const bf16_t*)(p.ws + WS_QI); const bf16_t* KI = (const bf16_t*)(p.ws + WS_KI); const float* WI = (const float*)(p.ws + WS_WI);
    unsigned* MASK = (unsigned*)(p.ws + WS_MASK);
    float* qs = lds; float* wsc = lds + 1024; float* sc = lds + 1040; int* red = (int*)(lds + 1040 + 4096);
    const int tid = opaque_tid(), lane = tid & 63, wv = tid >> 6;
    for (int t = blockIdx.x; t < T; t += gridDim.x) {
        const int b = t >> 12, ti = t & 4095, nk = ti + 1;
        __syncthreads();
        for (int i = tid; i < 1024; i += NTHREADS) qs[i] = bf2f(QI[(size_t)t * 1024 + i]);
        if (tid < 16) wsc[tid] = WI[(size_t)t * 16 + tid];
        __syncthreads();
        for (int s = tid; s < nk; s += NTHREADS) {
            const bf16_t* kr = KI + (size_t)(b * S + s) * 64;
            float score = 0.f;
#pragma unroll 1
            for (int h = 0; h < 16; ++h) {
                asm volatile("" ::: "memory");
                float dot = 0.f;
#pragma unroll
                for (int c = 0; c < 8; ++c) {
                    const u32x4 raw = *(const u32x4*)(kr + c * 8);
                    const f32x4 q0 = *(const f32x4*)(qs + h * 64 + c * 8), q1 = *(const f32x4*)(qs + h * 64 + c * 8 + 4);
                    dot = fmaf(q0[0], __uint_as_float(raw.x << 16), dot); dot = fmaf(q0[1], __uint_as_float(raw.x & 0xffff0000u), dot);
                    dot = fmaf(q0[2], __uint_as_float(raw.y << 16), dot); dot = fmaf(q0[3], __uint_as_float(raw.y & 0xffff0000u), dot);
                    dot = fmaf(q1[0], __uint_as_float(raw.z << 16), dot); dot = fmaf(q1[1], __uint_as_float(raw.z & 0xffff0000u), dot);
                    dot = fmaf(q1[2], __uint_as_float(raw.w << 16), dot); dot = fmaf(q1[3], __uint_as_float(raw.w & 0xffff0000u), dot);
                }
                score = fmaf(wsc[h], fmaxf(dot, 0.f), score);
            }
            sc[s] = score;
        }
        __syncthreads();
        unsigned k0 = 0u, k1 = 0u, k2 = 0u, k3 = 0u, k4 = 0u, k5 = 0u, k6 = 0u, k7 = 0u;
        if (tid < nk) k0 = f2key(sc[tid]);
        if (tid + 512 < nk) k1 = f2key(sc[tid + 512]);
        if (tid + 1024 < nk) k2 = f2key(sc[tid + 1024]);
        if (tid + 1536 < nk) k3 = f2key(sc[tid + 1536]);
        if (tid + 2048 < nk) k4 = f2key(sc[tid + 2048]);
        if (tid + 2560 < nk) k5 = f2key(sc[tid + 2560]);
        if (tid + 3072 < nk) k6 = f2key(sc[tid + 3072]);
        if (tid + 3584 < nk) k7 = f2key(sc[tid + 3584]);
        unsigned res = 0u;
        if (nk > 256) {
#pragma unroll 1
            for (int bit = 31; bit >= 0; --bit) {
                const unsigned cand = res | (1u << bit);
                const int c = (k0 >= cand) + (k1 >= cand) + (k2 >= cand) + (k3 >= cand) + (k4 >= cand) + (k5 >= cand) + (k6 >= cand) + (k7 >= cand);
                if (block_sum_int(c, red) >= 256) res = cand;
            }
        }
        unsigned* mw = MASK + (size_t)t * 128 + 2 * wv;
#define MASK_OUT(j, kj) do { const unsigned long long bal = __ballot((tid + 512 * (j) < nk) && ((kj) >= res)); if (lane == 0) { mw[16 * (j)] = (unsigned)bal; mw[16 * (j) + 1] = (unsigned)(bal >> 32); } } while (0)
        MASK_OUT(0, k0); MASK_OUT(1, k1); MASK_OUT(2, k2); MASK_OUT(3, k3); MASK_OUT(4, k4); MASK_OUT(5, k5); MASK_OUT(6, k6); MASK_OUT(7, k7);
#undef MASK_OUT
    }
    __syncthreads();
}

typedef short bf16x8 __attribute__((ext_vector_type(8)));
typedef short s16x4 __attribute__((ext_vector_type(4)));
typedef float f32x16 __attribute__((ext_vector_type(16)));
__device__ __forceinline__ void p_score(LAS unsigned char* ldsb, unsigned char* ws) {
    const bf16_t* QI = (const bf16_t*)(ws + WS_QI); const bf16_t* KI = (const bf16_t*)(ws + WS_KI); const float* WI = (const float*)(ws + WS_WI);
    unsigned* SC = (unsigned*)(ws + WS_SCORE);
    const int tid = opaque_tid(), lane = tid & 63, wv = __builtin_amdgcn_readfirstlane(tid >> 6), r32 = lane & 31, hi = lane >> 5;
    const int ksw = ((r32 >> 1) & 7) ^ hi;
    const unsigned krow = (unsigned)(size_t)ldsb + (unsigned)r32 * 128u;
    for (int item = blockIdx.x; item < 544; item += gridDim.x) {
        const int b = item / 272; int r = item - b * 272, qb = 0;
        while (r >= 2 * qb + 2) { r -= 2 * qb + 2; ++qb; }
        const int kc = r, q0 = qb * 256 + wv * 32;
        __builtin_amdgcn_s_barrier();
#pragma unroll
        for (int i = 0; i < 2; ++i) { const int g = i * 512 + tid, row = g >> 3, ch = (g & 7) ^ ((row >> 1) & 7);
            __builtin_amdgcn_global_load_lds((const unsigned*)(KI + (size_t)(b * S + kc * 128 + row) * 64 + ch * 8), (LAS unsigned*)(ldsb + (i * 512 + wv * 64) * 16), 16, 0, 0); }
        asm volatile("s_waitcnt vmcnt(0)" ::: "memory");
        __builtin_amdgcn_s_barrier();
        if (kc * 128 <= q0 + 31) {
            const size_t t = (size_t)b * S + q0 + r32;
            bf16x8 ka[4][4];
#pragma unroll
            for (int kb = 0; kb < 4; ++kb)
#pragma unroll
                for (int d0 = 0; d0 < 4; ++d0) ka[kb][d0] = *(const LAS bf16x8*)(size_t)(krow + kb * 4096 + ((unsigned)((2 * d0) ^ ksw) << 4));
            f32x16 acc[4];
#pragma unroll
            for (int kb = 0; kb < 4; ++kb)
#pragma unroll
                for (int rr = 0; rr < 16; ++rr) acc[kb][rr] = 0.f;
            const bf16_t* qrow = QI + t * 1024 + 8 * hi; const float* wrow = WI + t * 16;
            bf16x8 qf[4]; float wh = wrow[0];
#pragma unroll
            for (int d0 = 0; d0 < 4; ++d0) qf[d0] = *(const bf16x8*)(qrow + 16 * d0);
#pragma unroll 1
            for (int h = 0; h < 16; ++h) {
                const int hn = (h + 1) & 15;
                bf16x8 qn[4]; const float wn = wrow[hn];
#pragma unroll
                for (int d0 = 0; d0 < 4; ++d0) qn[d0] = *(const bf16x8*)(qrow + hn * 64 + 16 * d0);
#pragma unroll
                for (int kb = 0; kb < 4; ++kb) {
                    f32x16 pz;
#pragma unroll
                    for (int rr = 0; rr < 16; ++rr) pz[rr] = 0.f;
#pragma unroll
                    for (int d0 = 0; d0 < 4; ++d0) pz = __builtin_amdgcn_mfma_f32_32x32x16_bf16(ka[kb][d0], qf[d0], pz, 0, 0, 0);
#pragma unroll
                    for (int rr = 0; rr < 16; ++rr) acc[kb][rr] = fmaf(wh, fmaxf(pz[rr], 0.f), acc[kb][rr]);
                }
#pragma unroll
                for (int d0 = 0; d0 < 4; ++d0) qf[d0] = qn[d0];
                wh = wn;
            }
            const int dq = q0 + r32 - kc * 128 - 4 * hi;
            unsigned* srow = SC + t * 4096 + kc * 128 + 4 * hi;
#pragma unroll
            for (int kb = 0; kb < 4; ++kb)
#pragma unroll
                for (int rq = 0; rq < 4; ++rq) { u32x4 o; const int c0 = 32 * kb + 8 * rq;
                    o.x = (c0 <= dq) ? f2key(acc[kb][4 * rq]) : 0u; o.y = (c0 + 1 <= dq) ? f2key(acc[kb][4 * rq + 1]) : 0u;
                    o.z = (c0 + 2 <= dq) ? f2key(acc[kb][4 * rq + 2]) : 0u; o.w = (c0 + 3 <= dq) ? f2key(acc[kb][4 * rq + 3]) : 0u;
                    *(u32x4*)(srow + c0) = o; }
        }
    }
    __builtin_amdgcn_s_barrier();
}
__device__ __forceinline__ void p_select(unsigned char* ws) {
    const unsigned* SC = (const unsigned*)(ws + WS_SCORE); unsigned* MASK = (unsigned*)(ws + WS_MASK);
    const int tid = opaque_tid(), lane = tid & 63, wv = tid >> 6;
    for (int t = blockIdx.x * 8 + wv; t < T; t += gridDim.x * 8) {
        const int ti = t & 4095, nq = (ti >> 8) + 1;
        const unsigned* row = SC + (size_t)t * 4096 + 4 * lane;
        u32x4 k[16];
#pragma unroll
        for (int j = 0; j < 16; ++j) { k[j] = (u32x4){0u, 0u, 0u, 0u};
            if (j < nq) { k[j] = *(const u32x4*)(row + 256 * j);
                const int p0 = 256 * j + 4 * lane; if (p0 > ti) k[j].x = 0u; if (p0 + 1 > ti) k[j].y = 0u; if (p0 + 2 > ti) k[j].z = 0u; if (p0 + 3 > ti) k[j].w = 0u; } }
        unsigned res = 1u;
        if (ti >= 256) {
            res = 0u;
#pragma unroll 1
            for (int bit = 31; bit >= 0; --bit) {
                const unsigned cand = res | (1u << bit);
                int c = 0;
#pragma unroll
                for (int j = 0; j < 16; ++j) c += __popcll(__ballot(k[j].x >= cand)) + __popcll(__ballot(k[j].y >= cand)) + __popcll(__ballot(k[j].z >= cand)) + __popcll(__ballot(k[j].w >= cand));
                if (c >= 256) res = cand;
            }
        }
        unsigned* mrow = MASK + (size_t)t * 128 + (lane >> 3);
#pragma unroll
        for (int j = 0; j < 16; ++j) {
            unsigned nib = (unsigned)(k[j].x >= res) | ((unsigned)(k[j].y >= res) << 1) | ((unsigned)(k[j].z >= res) << 2) | ((unsigned)(k[j].w >= res) << 3);
            nib <<= 4 * (lane & 7);
            nib |= __shfl_xor(nib, 1); nib |= __shfl_xor(nib, 2); nib |= __shfl_xor(nib, 4);
            if ((lane & 7) == 0) mrow[8 * j] = nib;
        }
    }
}

template <int DQK, bool MASKED>
__device__ __forceinline__ void attn_unit(LAS unsigned char* ldsb, const bf16_t* Qg, int ldq, const bf16_t* Kg, int ldk, const bf16_t* Vg, int ldv, const unsigned* maskg, bf16_t* Og, int ldo, int qb, float sl2) {
    constexpr int CPR = DQK / 8, KBYTES = 64 * DQK * 2, VBYTES = 64 * 128 * 2, NKI = CPR * 64 / 512, ND = DQK / 16;
    constexpr int VOFF = 2 * KBYTES;
    const int tid = opaque_tid(), lane = tid & 63, wv = __builtin_amdgcn_readfirstlane(tid >> 6), r32 = lane & 31, hi = lane >> 5;
    const int NT = 4 * qb + 4, q0 = qb * 256 + wv * 32;
    const float NEG = -__builtin_inff();
    bf16x8 qr[ND];
#pragma unroll
    for (int d0 = 0; d0 < ND; ++d0) qr[d0] = *(const bf16x8*)(Qg + (size_t)(q0 + r32) * ldq + 16 * d0 + 8 * hi);
    const bf16_t* ksrc[NKI]; const bf16_t* vsrc[2];
#pragma unroll
    for (int i = 0; i < NKI; ++i) { const int g = i * 512 + tid, row = g / CPR, cp = g - row * CPR; const int ch = cp ^ (DQK == 128 ? (row & 15) : ((row >> 1) & 7)); ksrc[i] = Kg + (size_t)row * ldk + ch * 8; }
#pragma unroll
    for (int i = 0; i < 2; ++i) { const int g = i * 512 + tid, row = g >> 4, c16 = g & 15; const int blk = (c16 >> 2) ^ (row & 3); vsrc[i] = Vg + (size_t)row * ldv + (blk * 4 + (c16 & 3)) * 8; }
#define AT_STAGE(t_, buf_) do { \
        _Pragma("unroll") for (int i_ = 0; i_ < NKI; ++i_) __builtin_amdgcn_global_load_lds((const unsigned*)(ksrc[i_] + (size_t)(t_) * 64 * ldk), (LAS unsigned*)(ldsb + (buf_) * KBYTES + (i_ * 512 + wv * 64) * 16), 16, 0, 0); \
        _Pragma("unroll") for (int i_ = 0; i_ < 2; ++i_) __builtin_amdgcn_global_load_lds((const unsigned*)(vsrc[i_] + (size_t)(t_) * 64 * ldv), (LAS unsigned*)(ldsb + VOFF + (buf_) * VBYTES + (i_ * 512 + wv * 64) * 16), 16, 0, 0); } while (0)
    const int ksw = (DQK == 128 ? (r32 & 15) : ((r32 >> 1) & 7)) ^ hi;
    const unsigned krow = (unsigned)(size_t)ldsb + (unsigned)r32 * (DQK * 2);
    const int vq = (lane >> 2) & 3, vp = lane & 3, vg = lane >> 4;
    const unsigned vrow = (unsigned)(size_t)ldsb + VOFF + (unsigned)(4 * (vg >> 1) + vq) * 256 + (vg & 1) * 32 + vp * 8;
    float m_run = -1e30f, l_run = 0.f;
    f32x16 oT[4];
#pragma unroll
    for (int d0 = 0; d0 < 4; ++d0)
#pragma unroll
        for (int r = 0; r < 16; ++r) oT[d0][r] = 0.f;
    u32x2 mw_cur = {0u, 0u}, mw_nxt = {0u, 0u};
    const unsigned* mrow = MASKED ? maskg + (size_t)(q0 + r32) * 128 : nullptr;
    if (MASKED) mw_cur = *(const u32x2*)mrow;
    AT_STAGE(0, 0);
    asm volatile("s_waitcnt vmcnt(0)" ::: "memory");
    __builtin_amdgcn_s_barrier();
#define TRRD(dst, addr, off) asm volatile("ds_read_b64_tr_b16 %0, %1 offset:%2" : "=&v"(dst) : "v"(addr), "i"(off) : "memory")
#define AT_STEP(t_, buf_) do { \
        const int t = (t_); \
        if (t + 1 < NT) { if (MASKED) mw_nxt = *(const u32x2*)(mrow + 2 * (t + 1)); AT_STAGE(t + 1, (buf_) ^ 1); } \
        if (t * 64 <= q0 + 31) {                                    \
            int kx = ksw; asm volatile("" : "+v"(kx)); \
            f32x16 p0, p1; \
            _Pragma("unroll") for (int r = 0; r < 16; ++r) { p0[r] = 0.f; p1[r] = 0.f; } \
            _Pragma("unroll") for (int d0 = 0; d0 < ND; ++d0) { \
                const unsigned ka = krow + (buf_) * KBYTES + ((unsigned)((2 * d0) ^ kx) << 4); \
                const bf16x8 a0 = *(const LAS bf16x8*)(size_t)ka; const bf16x8 a1 = *(const LAS bf16x8*)(size_t)(ka + 32 * DQK * 2); \
                p0 = __builtin_amdgcn_mfma_f32_32x32x16_bf16(a0, qr[d0], p0, 0, 0, 0); \
                p1 = __builtin_amdgcn_mfma_f32_32x32x16_bf16(a1, qr[d0], p1, 0, 0, 0); } \
            if (MASKED) { \
                _Pragma("unroll") for (int r = 0; r < 16; ++r) { const int c = (r & 3) + 8 * (r >> 2) + 4 * hi; \
                    if (!((mw_cur.x >> c) & 1u)) p0[r] = NEG; if (!((mw_cur.y >> c) & 1u)) p1[r] = NEG; } \
            } else if (t * 64 + 63 > q0) {                          \
                const int dq = q0 + r32 - t * 64 - 4 * hi; \
                _Pragma("unroll") for (int r = 0; r < 16; ++r) { const int c = (r & 3) + 8 * (r >> 2); if (c > dq) p0[r] = NEG; if (c + 32 > dq) p1[r] = NEG; } \
            } \
            float mx = p0[0]; \
            _Pragma("unroll") for (int r = 1; r < 16; ++r) mx = fmaxf(mx, p0[r]); \
            _Pragma("unroll") for (int r = 0; r < 16; ++r) mx = fmaxf(mx, p1[r]); \
            { auto rr = __builtin_amdgcn_permlane32_swap(__float_as_uint(mx), __float_as_uint(mx), false, false); mx = fmaxf(__uint_as_float(rr[0]), __uint_as_float(rr[1])); } \
            const float mnew = fmaxf(m_run, mx); \
            const float alpha = __builtin_amdgcn_exp2f((m_run - mnew) * sl2); \
            m_run = mnew; const float mb = -mnew * sl2; \
            float ps = 0.f; \
            _Pragma("unroll") for (int r = 0; r < 16; ++r) { p0[r] = __builtin_amdgcn_exp2f(fmaf(p0[r], sl2, mb)); ps += p0[r]; } \
            _Pragma("unroll") for (int r = 0; r < 16; ++r) { p1[r] = __builtin_amdgcn_exp2f(fmaf(p1[r], sl2, mb)); ps += p1[r]; } \
            l_run = l_run * alpha + ps; \
            if (__any(alpha != 1.f)) { \
                _Pragma("unroll") for (int d0 = 0; d0 < 4; ++d0) _Pragma("unroll") for (int r = 0; r < 16; ++r) oT[d0][r] *= alpha; } \
            bf16x8 pb[4];                                            \
            { u32x4 w; \
              w.x = pkbf(p0[0], p0[1]); w.y = pkbf(p0[2], p0[3]); w.z = pkbf(p0[4], p0[5]); w.w = pkbf(p0[6], p0[7]); pb[0] = *reinterpret_cast<bf16x8*>(&w); \
              w.x = pkbf(p0[8], p0[9]); w.y = pkbf(p0[10], p0[11]); w.z = pkbf(p0[12], p0[13]); w.w = pkbf(p0[14], p0[15]); pb[1] = *reinterpret_cast<bf16x8*>(&w); \
              w.x = pkbf(p1[0], p1[1]); w.y = pkbf(p1[2], p1[3]); w.z = pkbf(p1[4], p1[5]); w.w = pkbf(p1[6], p1[7]); pb[2] = *reinterpret_cast<bf16x8*>(&w); \
              w.x = pkbf(p1[8], p1[9]); w.y = pkbf(p1[10], p1[11]); w.z = pkbf(p1[12], p1[13]); w.w = pkbf(p1[14], p1[15]); pb[3] = *reinterpret_cast<bf16x8*>(&w); } \
            int vx = vq; asm volatile("" : "+v"(vx)); \
            _Pragma("unroll") for (int d0 = 0; d0 < 4; ++d0) { \
                const unsigned va = vrow + (buf_) * VBYTES + ((unsigned)(d0 ^ vx) << 6); \
                s16x4 l0, h0, l1, h1, l2, h2, l3, h3; \
                TRRD(l0, va, 0); TRRD(h0, va, 2048); TRRD(l1, va, 4096); TRRD(h1, va, 6144); TRRD(l2, va, 8192); TRRD(h2, va, 10240); TRRD(l3, va, 12288); TRRD(h3, va, 14336); \
                asm volatile("s_waitcnt lgkmcnt(0)" ::: "memory"); __builtin_amdgcn_sched_barrier(0); \
                oT[d0] = __builtin_amdgcn_mfma_f32_32x32x16_bf16((bf16x8){l0[0], l0[1], l0[2], l0[3], h0[0], h0[1], h0[2], h0[3]}, pb[0], oT[d0], 0, 0, 0); \
                oT[d0] = __builtin_amdgcn_mfma_f32_32x32x16_bf16((bf16x8){l1[0], l1[1], l1[2], l1[3], h1[0], h1[1], h1[2], h1[3]}, pb[1], oT[d0], 0, 0, 0); \
                oT[d0] = __builtin_amdgcn_mfma_f32_32x32x16_bf16((bf16x8){l2[0], l2[1], l2[2], l2[3], h2[0], h2[1], h2[2], h2[3]}, pb[2], oT[d0], 0, 0, 0); \
                oT[d0] = __builtin_amdgcn_mfma_f32_32x32x16_bf16((bf16x8){l3[0], l3[1], l3[2], l3[3], h3[0], h3[1], h3[2], h3[3]}, pb[3], oT[d0], 0, 0, 0); } \
        } \
        if (MASKED) mw_cur = mw_nxt; \
        asm volatile("s_waitcnt vmcnt(0)" ::: "memory"); \
        asm volatile("s_waitcnt lgkmcnt(0)" ::: "memory"); \
        __builtin_amdgcn_s_barrier(); } while (0)
    for (int tt = 0; tt < NT; tt += 2) { AT_STEP(tt, 0); AT_STEP(tt + 1, 1); }
#undef AT_STEP
#undef AT_STAGE
#undef TRRD
    { auto rr = __builtin_amdgcn_permlane32_swap(__float_as_uint(l_run), __float_as_uint(l_run), false, false); l_run = __uint_as_float(rr[0]) + __uint_as_float(rr[1]); }
    const float inv = 1.f / l_run;
    bf16_t* orow = Og + (size_t)(q0 + r32) * ldo + 4 * hi;
#pragma unroll
    for (int d0 = 0; d0 < 4; ++d0)
#pragma unroll
        for (int rq = 0; rq < 4; ++rq) { u32x2 w; w.x = pkbf(oT[d0][4 * rq] * inv, oT[d0][4 * rq + 1] * inv); w.y = pkbf(oT[d0][4 * rq + 2] * inv, oT[d0][4 * rq + 3] * inv);
            *(u32x2*)(orow + 32 * d0 + 8 * rq) = w; }
}
__device__ __forceinline__ void p_attn(LAS unsigned char* ldsb, unsigned char* ws) {
    const bf16_t* QA = (const bf16_t*)(ws + WS_QA); const bf16_t* KA = (const bf16_t*)(ws + WS_KA); const bf16_t* VA = (const bf16_t*)(ws + WS_VA); bf16_t* OA = (bf16_t*)(ws + WS_OA);
    const bf16_t* QB = (const bf16_t*)(ws + WS_QB); const bf16_t* KB = (const bf16_t*)(ws + WS_KB); const bf16_t* VB = (const bf16_t*)(ws + WS_VB); bf16_t* OB = (bf16_t*)(ws + WS_OB);
    const unsigned* MASK = (const unsigned*)(ws + WS_MASK);
    for (int w = blockIdx.x; w < 256; w += gridDim.x) {
        const int bh = (w & 7) * 2 + ((w >> 3) & 1), i = w >> 4, b = bh >> 3, h = bh & 7;
        const size_t r0 = (size_t)b * S;
        attn_unit<192, false>(ldsb, QA + r0 * 1536 + h * 192, 1536, KA + r0 * 1536 + h * 192, 1536, VA + r0 * 1024 + h * 128, 1024, nullptr, OA + r0 * 1024 + h * 128, 1024, i, 0.07216878364870322f * 1.4426950408889634f);
        attn_unit<128, true>(ldsb, QB + r0 * 1024 + h * 128, 1024, KB + r0 * 1024 + h * 128, 1024, VB + r0 * 1024 + h * 128, 1024, MASK + r0 * 128, OB + r0 * 1024 + h * 128, 1024, 15 - i, 0.08838834764831845f * 1.4426950408889634f);
    }
}

template <int DQK, bool MASKED>
__device__ __forceinline__ void nattn(float* lds, const bf16_t* Q, const bf16_t* Kp, int ldk, const bf16_t* Vp, const unsigned* mask, bf16_t* O, float scale) {
    float* qs = lds; float* scb = lds + 8 * 192;
    const int tid = opaque_tid(), lane = tid & 63, h = tid >> 6;
    float* sc = scb + h * 4096;
    for (int t = blockIdx.x; t < T; t += gridDim.x) {
        const int b = t >> 12, ti = t & 4095, nk = ti + 1;
        __syncthreads();
        for (int i = tid; i < 8 * DQK; i += NTHREADS) qs[i] = bf2f(Q[(size_t)t * (8 * DQK) + i]);
        __syncthreads();
        const float* q = qs + h * DQK;
        float mx = -__builtin_inff();
        for (int s0 = 0; s0 < nk; s0 += 64) {
            const int s = s0 + lane; float v = -__builtin_inff();
            bool on = s < nk;
            if (MASKED && on) on = (mask[(size_t)t * 128 + (s >> 5)] >> (s & 31)) & 1u;
            if (on) {
                const bf16_t* kr = Kp + (size_t)(b * S + s) * ldk + h * DQK;
                float dot = 0.f;
#pragma unroll 4
                for (int c = 0; c < DQK / 8; ++c) { const u32x4 raw = *(const u32x4*)(kr + c * 8); const unsigned w[4] = {raw.x, raw.y, raw.z, raw.w};
#pragma unroll
                    for (int j = 0; j < 4; ++j) { dot = fmaf(q[c * 8 + 2 * j], __uint_as_float(w[j] << 16), dot); dot = fmaf(q[c * 8 + 2 * j + 1], __uint_as_float(w[j] & 0xffff0000u), dot); } }
                v = dot * scale;
            }
            if (s < nk) sc[s] = v;
            mx = fmaxf(mx, v);
        }
        mx = wave_max(mx);
        __syncthreads();
        float sum = 0.f;
        for (int s = lane; s < nk; s += 64) { const float pz = __expf(sc[s] - mx); sc[s] = pz; sum += pz; }
        sum = wave_sum(sum);
        __syncthreads();
        float a0 = 0.f, a1 = 0.f;
        const bf16_t* vb = Vp + (size_t)(b * S) * 1024 + h * 128 + lane * 2;
        for (int s = 0; s < nk; ++s) {
            const float pz = sc[s];
            if (pz != 0.f) { const unsigned w = *(const unsigned*)(vb + (size_t)s * 1024); a0 = fmaf(pz, __uint_as_float(w << 16), a0); a1 = fmaf(pz, __uint_as_float(w & 0xffff0000u), a1); }
        }
        const float inv = 1.f / sum;
        *(unsigned*)(O + (size_t)t * 1024 + h * 128 + lane * 2) = pk2(a0 * inv, a1 * inv);
    }
    __syncthreads();
}

__device__ __forceinline__ void p_ln1_route(float* lds, const Params& p, int l) {
    const float* V1 = (const float*)(p.ws + WS_V1); float* H1F = (float*)(p.ws + WS_H1F); bf16_t* H1B = (bf16_t*)(p.ws + WS_H1B);
    unsigned* cnt = (unsigned*)(p.ws + WS_CNT) + l * 64; int* LIST = (int*)(p.ws + WS_LIST);
    int* TOKE = (int*)(p.ws + WS_TOKE); float* TOKW = (float*)(p.ws + WS_TOKW); int* TOKS = (int*)(p.ws + WS_TOKS);
    const float* g = p.ln1g + (size_t)l * D; const float* bb = p.ln1b + (size_t)l * D;
    const float* wr = p.w_router + (size_t)l * D * 64; const float* wg = p.w_group + (size_t)l * D * 8;
    const float* br = p.b_router + l * 64; const float* bg = p.b_group + l * 8;
    const int tid = opaque_tid(), lane = tid & 63, wv = tid >> 6;
    float* lg = lds + wv * 80;
    for (int t0 = blockIdx.x * 8; t0 < T; t0 += gridDim.x * 8) {
        const int t = t0 + wv;
        float s1 = 0.f;
#pragma unroll 4
        for (int j = 0; j < 32; ++j) s1 += V1[(size_t)t * D + lane + 64 * j];
        const float mean = wave_sum(s1) * (1.f / D);
        float s2 = 0.f;
#pragma unroll 4
        for (int j = 0; j < 32; ++j) { const float d = V1[(size_t)t * D + lane + 64 * j] - mean; s2 += d * d; }
        const float rstd = rsqrtf(wave_sum(s2) * (1.f / D) + 1e-5f);
        float acc[72];
#pragma unroll
        for (int e = 0; e < 72; ++e) acc[e] = 0.f;
#pragma unroll 1
        for (int j = 0; j < 32; ++j) {
            const int k = lane + 64 * j;
            const float hk = (V1[(size_t)t * D + k] - mean) * rstd * g[k] + bb[k];
            H1F[(size_t)t * D + k] = hk; H1B[(size_t)t * D + k] = f2bf(hk);
            const float* wrow = wr + (size_t)k * 64;
#pragma unroll
            for (int e4 = 0; e4 < 16; ++e4) { const f32x4 w = *(const f32x4*)(wrow + e4 * 4);
                acc[e4 * 4] = fmaf(hk, w[0], acc[e4 * 4]); acc[e4 * 4 + 1] = fmaf(hk, w[1], acc[e4 * 4 + 1]); acc[e4 * 4 + 2] = fmaf(hk, w[2], acc[e4 * 4 + 2]); acc[e4 * 4 + 3] = fmaf(hk, w[3], acc[e4 * 4 + 3]); }
            const float* grow = wg + (size_t)k * 8;
            const f32x4 w0 = *(const f32x4*)grow, w1 = *(const f32x4*)(grow + 4);
            acc[64] = fmaf(hk, w0[0], acc[64]); acc[65] = fmaf(hk, w0[1], acc[65]); acc[66] = fmaf(hk, w0[2], acc[66]); acc[67] = fmaf(hk, w0[3], acc[67]);
            acc[68] = fmaf(hk, w1[0], acc[68]); acc[69] = fmaf(hk, w1[1], acc[69]); acc[70] = fmaf(hk, w1[2], acc[70]); acc[71] = fmaf(hk, w1[3], acc[71]);
        }
#pragma unroll
        for (int e = 0; e < 72; ++e) { const float r = wave_sum(acc[e]); if (lane == 0) lg[e] = r; }
        __syncthreads();
        if (lane == 0) {
            float gl[8]; float gmax = -__builtin_inff(); int gi = 0;
#pragma unroll
            for (int i = 0; i < 8; ++i) { gl[i] = lg[64 + i] + bg[i]; if (gl[i] > gmax) { gmax = gl[i]; gi = i; } }
            float gs = 0.f;
#pragma unroll
            for (int i = 0; i < 8; ++i) gs += __expf(gl[i] - gmax);
            const float gp = 1.f / gs;
            float el[8]; float emax = -__builtin_inff(); int e1 = 0;
#pragma unroll
            for (int i = 0; i < 8; ++i) { el[i] = lg[gi * 8 + i] + br[gi * 8 + i]; if (el[i] > emax) { emax = el[i]; e1 = i; } }
            float e2max = -__builtin_inff(); int e2 = 0;
#pragma unroll
            for (int i = 0; i < 8; ++i) { if (i != e1 && el[i] > e2max) { e2max = el[i]; e2 = i; } }
            const float p1 = 1.f, p2 = __expf(e2max - emax);
            const float wa = gp * p1 / (p1 + p2), wb = gp * p2 / (p1 + p2);
            const int ea = gi * 8 + e1, eb = gi * 8 + e2;
            const int sa = (int)atomicAdd(cnt + ea, 1u), sb = (int)atomicAdd(cnt + eb, 1u);
            LIST[(size_t)ea * ECAP + sa] = t; LIST[(size_t)eb * ECAP + sb] = t;
            TOKE[t * 2] = ea; TOKE[t * 2 + 1] = eb; TOKW[t * 2] = wa; TOKW[t * 2 + 1] = wb; TOKS[t * 2] = sa; TOKS[t * 2 + 1] = sb;
        }
        __syncthreads();
    }
}

__device__ __forceinline__ void moe_tables(int* tab, const unsigned* cnt, int items_per_rb) {
    if (threadIdx.x == 0) { int a = 0, bsum = 0; for (int e = 0; e < 64; ++e) { tab[e] = a; tab[80 + e] = bsum; const int c = (int)cnt[e]; a += ((c + 127) / 128) * items_per_rb; bsum += ((c + 255) / 256) * 256; } tab[64] = a; tab[80 + 64] = bsum; }
    __syncthreads();
}
__device__ __forceinline__ void p_moe1(float* lds, const Params& p, int l) {
    const unsigned* cnt = (const unsigned*)(p.ws + WS_CNT) + l * 64; const int* LIST = (const int*)(p.ws + WS_LIST);
    const bf16_t* H1B = (const bf16_t*)(p.ws + WS_H1B); bf16_t* HID = (bf16_t*)(p.ws + WS_HID);
    float* As = lds; float* Wg = lds + 32 * 132; float* Wu = Wg + 32 * 64; int* tab = (int*)(Wu + 32 * 64);
    __syncthreads();
    moe_tables(tab, cnt, 8);
    const int tid = opaque_tid(), ty = tid >> 4, tx = tid & 15;
    const int total = tab[64];
    for (int item = blockIdx.x; item < total; item += gridDim.x) {
        int e = 0; while (tab[e + 1] <= item) ++e;
        const int local = item - tab[e], rb = local >> 3, ct = local & 7, ce = (int)cnt[e], base = tab[80 + e];
        const float* wgp = p.w_eg + ((size_t)(l * 64 + e) * D) * FE + ct * 64;
        const float* wup = p.w_eu + ((size_t)(l * 64 + e) * D) * FE + ct * 64;
        const f32x4 z4 = {0.f, 0.f, 0.f, 0.f};
        f32x4 ag0 = z4, ag1 = z4, ag2 = z4, ag3 = z4, au0 = z4, au1 = z4, au2 = z4, au3 = z4;
        const int ar = tid >> 2, akq = (tid & 3) * 8, wk = tid >> 4, wn4 = (tid & 15) * 4;
        const int ai = rb * 128 + ar; const int tok = ai < ce ? LIST[(size_t)e * ECAP + ai] : -1;
        const bf16_t* ap = H1B + (size_t)(tok < 0 ? 0 : tok) * D + akq;
        for (int k0 = 0; k0 < D; k0 += 32) {
            __syncthreads();
            { u32x4 raw = *(const u32x4*)(ap + k0); if (tok < 0) raw = (u32x4){0u, 0u, 0u, 0u};
              float* dst = As + akq * 132 + ar;
              dst[0 * 132] = __uint_as_float(raw.x << 16); dst[1 * 132] = __uint_as_float(raw.x & 0xffff0000u); dst[2 * 132] = __uint_as_float(raw.y << 16); dst[3 * 132] = __uint_as_float(raw.y & 0xffff0000u);
              dst[4 * 132] = __uint_as_float(raw.z << 16); dst[5 * 132] = __uint_as_float(raw.z & 0xffff0000u); dst[6 * 132] = __uint_as_float(raw.w << 16); dst[7 * 132] = __uint_as_float(raw.w & 0xffff0000u); }
            *(f32x4*)(Wg + wk * 64 + wn4) = *(const f32x4*)(wgp + (size_t)(k0 + wk) * FE + wn4);
            *(f32x4*)(Wu + wk * 64 + wn4) = *(const f32x4*)(wup + (size_t)(k0 + wk) * FE + wn4);
            __syncthreads();
#pragma unroll 4
            for (int kk = 0; kk < 32; ++kk) {
                const f32x4 a = *(const f32x4*)(As + kk * 132 + ty * 4);
                const f32x4 g4 = *(const f32x4*)(Wg + kk * 64 + tx * 4);
                const f32x4 u4 = *(const f32x4*)(Wu + kk * 64 + tx * 4);
                ag0 += a[0] * g4; ag1 += a[1] * g4; ag2 += a[2] * g4; ag3 += a[3] * g4;
                au0 += a[0] * u4; au1 += a[1] * u4; au2 += a[2] * u4; au3 += a[3] * u4;
            }
        }
#define MOE1_OUT(i, G_, U_) do { const int ri = rb * 128 + ty * 4 + (i); if (ri < ce) { f32x4 o; \
            o[0] = G_[0] / (1.f + __expf(-G_[0])) * U_[0]; o[1] = G_[1] / (1.f + __expf(-G_[1])) * U_[1]; o[2] = G_[2] / (1.f + __expf(-G_[2])) * U_[2]; o[3] = G_[3] / (1.f + __expf(-G_[3])) * U_[3]; \
            st4bf(HID + (size_t)(base + ri) * FE + ct * 64 + tx * 4, o); } } while (0)
        MOE1_OUT(0, ag0, au0); MOE1_OUT(1, ag1, au1); MOE1_OUT(2, ag2, au2); MOE1_OUT(3, ag3, au3);
#undef MOE1_OUT
    }
    __syncthreads();
}
__device__ __forceinline__ void p_moe2(float* lds, const Params& p, int l) {
    const unsigned* cnt = (const unsigned*)(p.ws + WS_CNT) + l * 64;
    const bf16_t* HID = (const bf16_t*)(p.ws + WS_HID); bf16_t* YE = (bf16_t*)(p.ws + WS_YE);
    float* As = lds; float* Ws = lds + 32 * 132; int* tab = (int*)(Ws + 32 * 64 * 2);
    __syncthreads();
    moe_tables(tab, cnt, 32);
    const int tid = opaque_tid(), ty = tid >> 4, tx = tid & 15;
    const int total = tab[64];
    for (int item = blockIdx.x; item < total; item += gridDim.x) {
        int e = 0; while (tab[e + 1] <= item) ++e;
        const int local = item - tab[e], rb = local >> 5, ct = local & 31, ce = (int)cnt[e], base = tab[80 + e];
        const float* wdp = p.w_ed + ((size_t)(l * 64 + e) * FE) * D + ct * 64;
        f32x4 acc0 = {0.f, 0.f, 0.f, 0.f}, acc1 = acc0, acc2 = acc0, acc3 = acc0;
        const int ar = tid >> 2, akq = (tid & 3) * 8, wk = tid >> 4, wn4 = (tid & 15) * 4;
        const int ai = rb * 128 + ar; const bool av = ai < ce;
        const bf16_t* ap = HID + (size_t)(base + (av ? ai : 0)) * FE + akq;
        for (int k0 = 0; k0 < FE; k0 += 32) {
            __syncthreads();
            { u32x4 raw = *(const u32x4*)(ap + k0); if (!av) raw = (u32x4){0u, 0u, 0u, 0u};
              float* dst = As + akq * 132 + ar;
              dst[0 * 132] = __uint_as_float(raw.x << 16); dst[1 * 132] = __uint_as_float(raw.x & 0xffff0000u); dst[2 * 132] = __uint_as_float(raw.y << 16); dst[3 * 132] = __uint_as_float(raw.y & 0xffff0000u);
              dst[4 * 132] = __uint_as_float(raw.z << 16); dst[5 * 132] = __uint_as_float(raw.z & 0xffff0000u); dst[6 * 132] = __uint_as_float(raw.w << 16); dst[7 * 132] = __uint_as_float(raw.w & 0xffff0000u); }
            *(f32x4*)(Ws + wk * 64 + wn4) = *(const f32x4*)(wdp + (size_t)(k0 + wk) * D + wn4);
            __syncthreads();
#pragma unroll 8
            for (int kk = 0; kk < 32; ++kk) {
                const f32x4 a = *(const f32x4*)(As + kk * 132 + ty * 4);
                const f32x4 w = *(const f32x4*)(Ws + kk * 64 + tx * 4);
                acc0 += a[0] * w; acc1 += a[1] * w; acc2 += a[2] * w; acc3 += a[3] * w;
            }
        }
        { const int ri = rb * 128 + ty * 4; bf16_t* yo = YE + (size_t)(base + ri) * D + ct * 64 + tx * 4;
          if (ri < ce) st4bf(yo, acc0); if (ri + 1 < ce) st4bf(yo + D, acc1); if (ri + 2 < ce) st4bf(yo + 2 * D, acc2); if (ri + 3 < ce) st4bf(yo + 3 * D, acc3); }
    }
    __syncthreads();
}
__device__ __forceinline__ void moe_tables256(int* tab, const unsigned* cnt, int ncol_tiles) {
    if (threadIdx.x == 0) { int a = 0, bsum = 0; for (int e = 0; e < 64; ++e) { tab[e] = a; tab[80 + e] = bsum; const int c = (int)cnt[e], nrb = (c + 319) / 320; tab[160 + e] = nrb > 0 ? nrb : 1; a += nrb * ncol_tiles; bsum += nrb * 320; } tab[64] = a; tab[80 + 64] = bsum; }
    __syncthreads();
}
__device__ __forceinline__ void p_ln1_route2(LAS unsigned char* ldsb, unsigned char* ws, const float* g, const float* bb, const float* wr, const float* wg, const float* br, const float* bg, int l) {
    const float* V1 = (const float*)(ws + WS_V1); float* H1F = (float*)(ws + WS_H1F); bf16_t* H1B = (bf16_t*)(ws + WS_H1B);
    unsigned* cnt = (unsigned*)(ws + WS_CNT) + l * 64; int* LIST = (int*)(ws + WS_LIST);
    int* TOKE = (int*)(ws + WS_TOKE); float* TOKW = (float*)(ws + WS_TOKW); int* TOKS = (int*)(ws + WS_TOKS);
    const int tid = opaque_tid(), lane = tid & 63, wv = __builtin_amdgcn_readfirstlane(tid >> 6);
    LAS float* red = (LAS float*)ldsb;
    for (int unit = blockIdx.x; unit < T / 32; unit += gridDim.x) {
        const int t0 = unit * 32;
#pragma unroll 1
        for (int i = 0; i < 4; ++i) {
            const size_t ro = (size_t)(t0 + 4 * wv + i) * D + 4 * lane;
            f32x4 v[8]; float s1 = 0.f;
#pragma unroll
            for (int j = 0; j < 8; ++j) { v[j] = *(const f32x4*)(V1 + ro + 256 * j); s1 += (v[j][0] + v[j][1]) + (v[j][2] + v[j][3]); }
            const float mean = wave_sum(s1) * (1.f / D); float s2 = 0.f;
#pragma unroll
            for (int j = 0; j < 8; ++j) { v[j] = v[j] - mean; s2 += (v[j][0] * v[j][0] + v[j][1] * v[j][1]) + (v[j][2] * v[j][2] + v[j][3] * v[j][3]); }
            const float rstd = rsqrtf(wave_sum(s2) * (1.f / D) + 1e-5f);
#pragma unroll
            for (int j = 0; j < 8; ++j) { const f32x4 gg = *(const f32x4*)(g + 4 * lane + 256 * j), b4 = *(const f32x4*)(bb + 4 * lane + 256 * j);
                const f32x4 h = v[j] * rstd * gg + b4;
                *(f32x4*)(H1F + ro + 256 * j) = h; st4bf(H1B + ro + 256 * j, h); }
        }
        asm volatile("s_waitcnt vmcnt(0)" ::: "memory");
        __syncthreads();
        {
            f32x16 c0, c1, c2;
#pragma unroll
            for (int r = 0; r < 16; ++r) { c0[r] = 0.f; c1[r] = 0.f; c2[r] = 0.f; }
            const int j = lane & 31, kh = lane >> 5, kb = 256 * wv + 4 * kh;
            const float* hp = H1F + (size_t)(t0 + j) * D + kb;
            const float* wrp = wr + (size_t)kb * 64 + j;
            const float* wgp = wg + (size_t)kb * 8 + (j & 7);
            const bool gcol = j < 8;
#pragma unroll 2
            for (int it = 0; it < 32; ++it) {
                const f32x4 a = *(const f32x4*)(hp + 8 * it);
#pragma unroll
                for (int sidx = 0; sidx < 4; ++sidx) {
                    const float b0 = wrp[(size_t)(8 * it + sidx) * 64], b1 = wrp[(size_t)(8 * it + sidx) * 64 + 32];
                    float b2 = wgp[(size_t)(8 * it + sidx) * 8]; b2 = gcol ? b2 : 0.f;
                    c0 = __builtin_amdgcn_mfma_f32_32x32x2f32(a[sidx], b0, c0, 0, 0, 0);
                    c1 = __builtin_amdgcn_mfma_f32_32x32x2f32(a[sidx], b1, c1, 0, 0, 0);
                    c2 = __builtin_amdgcn_mfma_f32_32x32x2f32(a[sidx], b2, c2, 0, 0, 0);
                }
            }
#pragma unroll
            for (int r = 0; r < 16; ++r) { const int tr = (r & 3) + 8 * (r >> 2) + 4 * kh; LAS float* o = red + (wv * 32 + tr) * 96 + j; o[0] = c0[r]; o[32] = c1[r]; o[64] = c2[r]; }
        }
        __syncthreads();
        for (int idx = tid; idx < 32 * 72; idx += NTHREADS) { const int tk = idx / 72, c = idx - tk * 72;
            float sacc = 0.f;
#pragma unroll
            for (int w = 0; w < 8; ++w) sacc += red[(w * 32 + tk) * 96 + c];
            red[tk * 96 + c] = sacc; }
        __syncthreads();
        if (tid < 32) {
            const int t = t0 + tid; const LAS float* lg = red + tid * 96;
            float gl[8]; float gmax = -__builtin_inff(); int gi = 0;
#pragma unroll
            for (int i = 0; i < 8; ++i) { gl[i] = lg[64 + i] + bg[i]; if (gl[i] > gmax) { gmax = gl[i]; gi = i; } }
            float gs = 0.f;
#pragma unroll
            for (int i = 0; i < 8; ++i) gs += __expf(gl[i] - gmax);
            const float gp = 1.f / gs;
            float el[8]; float emax = -__builtin_inff(); int e1 = 0;
#pragma unroll
            for (int i = 0; i < 8; ++i) { el[i] = lg[gi * 8 + i] + br[gi * 8 + i]; if (el[i] > emax) { emax = el[i]; e1 = i; } }
            float e2max = -__builtin_inff(); int e2 = 0;
#pragma unroll
            for (int i = 0; i < 8; ++i) { if (i != e1 && el[i] > e2max) { e2max = el[i]; e2 = i; } }
            const float p2 = __expf(e2max - emax);
            const float wa = gp / (1.f + p2), wb = gp * p2 / (1.f + p2);
            const int ea = gi * 8 + e1, eb = gi * 8 + e2;
            const int sa = (int)atomicAdd(cnt + ea, 1u), sb = (int)atomicAdd(cnt + eb, 1u);
            LIST[(size_t)ea * ECAP + sa] = t; LIST[(size_t)eb * ECAP + sb] = t;
            TOKE[t * 2] = ea; TOKE[t * 2 + 1] = eb; TOKW[t * 2] = wa; TOKW[t * 2 + 1] = wb; TOKS[t * 2] = sa; TOKS[t * 2 + 1] = sb;
        }
        __syncthreads();
    }
}
__device__ __forceinline__ void p_ln2v2(LAS unsigned char* ldsb, unsigned char* ws, const float* g, const float* bb, float* outF, int l) {
    const unsigned* cnt = (const unsigned*)(ws + WS_CNT) + l * 64;
    const float* H1F = (const float*)(ws + WS_H1F); const bf16_t* YE = (const bf16_t*)(ws + WS_YE);
    const int* TOKE = (const int*)(ws + WS_TOKE); const float* TOKW = (const float*)(ws + WS_TOKW); const int* TOKS = (const int*)(ws + WS_TOKS);
    bf16_t* XB = (bf16_t*)(ws + WS_XB);
    int* tab = (int*)(unsigned char*)ldsb;
    __syncthreads();
    moe_tables256(tab, cnt, 1);
    const int tid = opaque_tid(), lane = tid & 63, wv = tid >> 6;
    for (int t = blockIdx.x * 8 + wv; t < T; t += gridDim.x * 8) {
        const int r0 = tab[80 + TOKE[t * 2]] + TOKS[t * 2], r1 = tab[80 + TOKE[t * 2 + 1]] + TOKS[t * 2 + 1];
        const float w0 = TOKW[t * 2], w1 = TOKW[t * 2 + 1];
        const size_t ro = (size_t)t * D + 4 * lane;
        f32x4 v[8]; float s1 = 0.f;
#pragma unroll
        for (int j = 0; j < 8; ++j) { const f32x4 h = *(const f32x4*)(H1F + ro + 256 * j);
            const f32x4 y0 = bf4(*(const u32x2*)(YE + (size_t)r0 * D + 4 * lane + 256 * j)), y1 = bf4(*(const u32x2*)(YE + (size_t)r1 * D + 4 * lane + 256 * j));
            v[j] = h * ALPHA + y0 * w0 + y1 * w1; s1 += (v[j][0] + v[j][1]) + (v[j][2] + v[j][3]); }
        const float mean = wave_sum(s1) * (1.f / D); float s2 = 0.f;
#pragma unroll
        for (int j = 0; j < 8; ++j) { v[j] = v[j] - mean; s2 += (v[j][0] * v[j][0] + v[j][1] * v[j][1]) + (v[j][2] * v[j][2] + v[j][3] * v[j][3]); }
        const float rstd = rsqrtf(wave_sum(s2) * (1.f / D) + 1e-5f);
#pragma unroll
        for (int j = 0; j < 8; ++j) { const f32x4 gg = *(const f32x4*)(g + 4 * lane + 256 * j), b4 = *(const f32x4*)(bb + 4 * lane + 256 * j);
            const f32x4 o = v[j] * rstd * gg + b4;
            *(f32x4*)(outF + ro + 256 * j) = o; if (l != DEPTH - 1) st4bf(XB + ro + 256 * j, o); }
    }
    __syncthreads();
}

template <bool GATED>
__device__ __forceinline__ void moe_gemm(LAS unsigned char* ldsb, const int* tab, const unsigned* cnt, const int* LIST, const bf16_t* Asrc, const float* W0, const float* W1, bf16_t* Out) {
    constexpr int K = GATED ? D : FE, NT = K / 64, NCT = GATED ? FE / 64 : D / 128, LDW = GATED ? FE : D, LDO = GATED ? FE : D;
    constexpr int RBLK = 320, MT = 5, NAG = RBLK * 8 / 512;
    constexpr int ABYTES = RBLK * 128, BOFF = 2 * ABYTES, BBYTES = 64 * 256;
    const int tid = opaque_tid(), lane = tid & 63, wv = __builtin_amdgcn_readfirstlane(tid >> 6), wm = wv >> 1, wn = wv & 1, l15 = lane & 15, kq = lane >> 4;
    const int total = tab[64];
    const unsigned lbase = (unsigned)(size_t)ldsb;
    const int arow = wm * (16 * MT) + l15;
    const unsigned afr = lbase + (unsigned)arow * 128u; const int asw = ((arow >> 1) & 7) ^ kq;
    const int bq = (lane >> 2) & 3, bp = lane & 3, bkey = bq | ((kq & 1) << 2);
    const unsigned bfr = lbase + BOFF + (unsigned)(8 * kq + bq) * 256u + 8u * bp;
    unsigned bb[4];
#pragma unroll
    for (int j = 0; j < 4; ++j) { const int np = GATED ? ((j >> 1) * 4 + 2 * wn + (j & 1)) : (4 * wn + j); bb[j] = bfr + ((unsigned)(np ^ bkey) << 5); }
    const int sa_r = tid >> 3, sa_c = tid & 7;
    const int sb_k = tid >> 5, sb_n = 4 * (tid & 31);
    for (int item = blockIdx.x; item < total; item += gridDim.x) {
        int e = 0; while (tab[e + 1] <= item) ++e;
        const int local = item - tab[e], ct = local / tab[160 + e], rb = local - ct * tab[160 + e];
        const int ce = (int)cnt[e], base = tab[80 + e];
        unsigned aoff[NAG];
#pragma unroll
        for (int i = 0; i < NAG; ++i) { const int r = rb * RBLK + i * 64 + sa_r;
            const int ch = sa_c ^ (((i * 64 + sa_r) >> 1) & 7);
            if (GATED) { const int tok = r < ce ? LIST[(size_t)e * ECAP + r] : 0; aoff[i] = (unsigned)tok * (unsigned)(K * 2) + ch * 16; }
            else aoff[i] = (unsigned)(base + r) * (unsigned)(K * 2) + ch * 16; }
        const float* wp = (GATED ? (sb_n < 64 ? W0 : W1) : W0) + (size_t)e * K * LDW + (size_t)sb_k * LDW + (GATED ? ct * 64 + (sb_n & 63) : ct * 128 + sb_n);
        f32x4 acc[MT][4];
#pragma unroll
        for (int m = 0; m < MT; ++m)
#pragma unroll
            for (int n = 0; n < 4; ++n) acc[m][n] = (f32x4){0.f, 0.f, 0.f, 0.f};
        f32x4 rb0[4], rb1[4];
#define MG_DMA_A(t_, buf_) do { _Pragma("unroll") for (int i = 0; i < NAG; ++i) \
            __builtin_amdgcn_global_load_lds((const unsigned*)((const unsigned char*)Asrc + aoff[i] + (t_) * 128), (LAS unsigned*)(ldsb + (buf_) * ABYTES + (i * 512 + wv * 64) * 16), 16, 0, 0); } while (0)
#define MG_LOAD_B(RB, t_) do { _Pragma("unroll") for (int i = 0; i < 4; ++i) asm volatile("global_load_dwordx4 %0, %1, off" : "=v"(RB[i]) : "v"(wp + (size_t)((t_) * 64 + 16 * i) * LDW) : "memory"); } while (0)
#define MG_WAIT_ALL(n_) asm volatile("s_waitcnt vmcnt(" #n_ ")" : "+v"(rb0[0]), "+v"(rb0[1]), "+v"(rb0[2]), "+v"(rb0[3]), "+v"(rb1[0]), "+v"(rb1[1]), "+v"(rb1[2]), "+v"(rb1[3]) :: "memory")
#define MG_WRITE_B(RB, buf_) do { _Pragma("unroll") for (int i = 0; i < 4; ++i) { const int k = sb_k + 16 * i; u32x2 w; w.x = pkbf(RB[i][0], RB[i][1]); w.y = pkbf(RB[i][2], RB[i][3]); \
            *(LAS u32x2*)(ldsb + BOFF + (buf_) * BBYTES + k * 256 + ((((sb_n >> 4) ^ ((k & 3) | (((k >> 3) & 1) << 2)))) << 5) + (sb_n & 15) * 2) = w; } } while (0)
#define TRRD(dst, addr, off) asm volatile("ds_read_b64_tr_b16 %0, %1 offset:%2" : "=&v"(dst) : "v"(addr), "i"(off) : "memory")
#define MG_COMPUTE(buf_) do { \
            _Pragma("unroll") for (int kk = 0; kk < 2; ++kk) { \
                s16x4 b0l, b0h, b1l, b1h, b2l, b2h, b3l, b3h; \
                TRRD(b0l, bb[0], (buf_) * BBYTES + kk * 8192); TRRD(b0h, bb[0], (buf_) * BBYTES + kk * 8192 + 1024); \
                TRRD(b1l, bb[1], (buf_) * BBYTES + kk * 8192); TRRD(b1h, bb[1], (buf_) * BBYTES + kk * 8192 + 1024); \
                TRRD(b2l, bb[2], (buf_) * BBYTES + kk * 8192); TRRD(b2h, bb[2], (buf_) * BBYTES + kk * 8192 + 1024); \
                TRRD(b3l, bb[3], (buf_) * BBYTES + kk * 8192); TRRD(b3h, bb[3], (buf_) * BBYTES + kk * 8192 + 1024); \
                asm volatile("s_waitcnt lgkmcnt(0)" ::: "memory"); __builtin_amdgcn_sched_barrier(0); \
                const bf16x8 bf0 = {b0l[0], b0l[1], b0l[2], b0l[3], b0h[0], b0h[1], b0h[2], b0h[3]}, bf1 = {b1l[0], b1l[1], b1l[2], b1l[3], b1h[0], b1h[1], b1h[2], b1h[3]}; \
                const bf16x8 bf2 = {b2l[0], b2l[1], b2l[2], b2l[3], b2h[0], b2h[1], b2h[2], b2h[3]}, bf3 = {b3l[0], b3l[1], b3l[2], b3l[3], b3h[0], b3h[1], b3h[2], b3h[3]}; \
                _Pragma("unroll") for (int m = 0; m < MT; ++m) { \
                    const bf16x8 af = *(const LAS bf16x8*)(size_t)(afr + (buf_) * ABYTES + m * 2048 + ((unsigned)((4 * kk) ^ asw) << 4)); \
                    acc[m][0] = __builtin_amdgcn_mfma_f32_16x16x32_bf16(af, bf0, acc[m][0], 0, 0, 0); acc[m][1] = __builtin_amdgcn_mfma_f32_16x16x32_bf16(af, bf1, acc[m][1], 0, 0, 0); \
                    acc[m][2] = __builtin_amdgcn_mfma_f32_16x16x32_bf16(af, bf2, acc[m][2], 0, 0, 0); acc[m][3] = __builtin_amdgcn_mfma_f32_16x16x32_bf16(af, bf3, acc[m][3], 0, 0, 0); } } } while (0)
        asm volatile("s_waitcnt lgkmcnt(0)" ::: "memory");
        __builtin_amdgcn_s_barrier();
        MG_DMA_A(0, 0); MG_LOAD_B(rb0, 0); MG_LOAD_B(rb1, 1);
        MG_WAIT_ALL(4);
        MG_WRITE_B(rb0, 0);
        asm volatile("s_waitcnt lgkmcnt(0)" ::: "memory");
        __builtin_amdgcn_s_barrier();
#pragma unroll 1
        for (int t = 0; t < NT; t += 2) {
            MG_DMA_A(t + 1, 1);
            { const int tb = (t + 2 < NT) ? t + 2 : NT - 1; MG_LOAD_B(rb0, tb); }
            MG_COMPUTE(0);
            MG_WAIT_ALL(4);
            MG_WRITE_B(rb1, 1);
            asm volatile("s_waitcnt lgkmcnt(0)" ::: "memory");
            __builtin_amdgcn_s_barrier();
            if (t + 2 < NT) { MG_DMA_A(t + 2, 0); }
            { const int tb = (t + 3 < NT) ? t + 3 : NT - 1; MG_LOAD_B(rb1, tb); }
            MG_COMPUTE(1);
            MG_WAIT_ALL(4);
            if (t + 2 < NT) { MG_WRITE_B(rb0, 0); }
            asm volatile("s_waitcnt lgkmcnt(0)" ::: "memory");
            __builtin_amdgcn_s_barrier();
        }
        MG_WAIT_ALL(0);
#undef MG_WAIT_ALL
#undef MG_DMA_A
#undef MG_LOAD_B
#undef MG_WRITE_B
#undef MG_COMPUTE
#undef TRRD
#pragma unroll
        for (int m = 0; m < MT; ++m)
#pragma unroll
            for (int g = 0; g < 4; ++g) {
                const int r = rb * RBLK + wm * (16 * MT) + 16 * m + 4 * kq + g;
                if (r < ce) {
                    if (GATED) {
#pragma unroll
                        for (int j = 0; j < 2; ++j) { const float gv = acc[m][j][g], uv = acc[m][2 + j][g];
                            Out[(size_t)(base + r) * LDO + ct * 64 + 32 * wn + 16 * j + l15] = f2bf(gv / (1.f + __expf(-gv)) * uv); }
                    } else {
#pragma unroll
                        for (int n = 0; n < 4; ++n) Out[(size_t)(base + r) * LDO + ct * 128 + 64 * wn + 16 * n + l15] = f2bf(acc[m][n][g]);
                    }
                }
            }
    }
    __syncthreads();
}
__device__ __forceinline__ void p_moe1_mfma(LAS unsigned char* ldsb, unsigned char* ws, const float* w_eg, const float* w_eu, int l) {
    const unsigned* cnt = (const unsigned*)(ws + WS_CNT) + l * 64;
    int* tab = (int*)((unsigned char*)ldsb + 132 * 1024);
    __syncthreads();
    moe_tables256(tab, cnt, FE / 64);
    moe_gemm<true>(ldsb, tab, cnt, (const int*)(ws + WS_LIST), (const bf16_t*)(ws + WS_H1B), w_eg + (size_t)l * NE * D * FE, w_eu + (size_t)l * NE * D * FE, (bf16_t*)(ws + WS_HID));
}
__device__ __forceinline__ void p_moe2_mfma(LAS unsigned char* ldsb, unsigned char* ws, const float* w_ed, int l) {
    const unsigned* cnt = (const unsigned*)(ws + WS_CNT) + l * 64;
    int* tab = (int*)((unsigned char*)ldsb + 132 * 1024);
    __syncthreads();
    moe_tables256(tab, cnt, D / 128);
    moe_gemm<false>(ldsb, tab, cnt, nullptr, (const bf16_t*)(ws + WS_HID), w_ed + (size_t)l * NE * FE * D, nullptr, (bf16_t*)(ws + WS_YE));
}

__device__ __forceinline__ void p_ln2(float* lds, const Params& p, int l) {
    const unsigned* cnt = (const unsigned*)(p.ws + WS_CNT) + l * 64;
    const float* H1F = (const float*)(p.ws + WS_H1F); const bf16_t* YE = (const bf16_t*)(p.ws + WS_YE);
    const int* TOKE = (const int*)(p.ws + WS_TOKE); const float* TOKW = (const float*)(p.ws + WS_TOKW); const int* TOKS = (const int*)(p.ws + WS_TOKS);
    float* outF = (l == DEPTH - 1) ? p.out : (float*)(p.ws + WS_H2F); bf16_t* XB = (bf16_t*)(p.ws + WS_XB);
    const float* g = p.ln2g + (size_t)l * D; const float* bb = p.ln2b + (size_t)l * D;
    int* tab = (int*)lds;
    __syncthreads();
    moe_tables(tab, cnt, 1);
    const int tid = opaque_tid(), lane = tid & 63, wv = tid >> 6;
    for (int t0 = blockIdx.x * 8; t0 < T; t0 += gridDim.x * 8) {
        const int t = t0 + wv;
        const int r0 = tab[80 + TOKE[t * 2]] + TOKS[t * 2], r1 = tab[80 + TOKE[t * 2 + 1]] + TOKS[t * 2 + 1];
        const float w0 = TOKW[t * 2], w1 = TOKW[t * 2 + 1];
        const float* hrow = H1F + (size_t)t * D; const bf16_t* y0 = YE + (size_t)r0 * D; const bf16_t* y1 = YE + (size_t)r1 * D;
        float s1 = 0.f;
#pragma unroll 4
        for (int j = 0; j < 32; ++j) { const int k = lane + 64 * j; s1 += ALPHA * hrow[k] + w0 * bf2f(y0[k]) + w1 * bf2f(y1[k]); }
        const float mean = wave_sum(s1) * (1.f / D);
        float s2 = 0.f;
#pragma unroll 4
        for (int j = 0; j < 32; ++j) { const int k = lane + 64 * j; const float d = ALPHA * hrow[k] + w0 * bf2f(y0[k]) + w1 * bf2f(y1[k]) - mean; s2 += d * d; }
        const float rstd = rsqrtf(wave_sum(s2) * (1.f / D) + 1e-5f);
#pragma unroll 4
        for (int j = 0; j < 32; ++j) { const int k = lane + 64 * j; const float v = ALPHA * hrow[k] + w0 * bf2f(y0[k]) + w1 * bf2f(y1[k]);
            const float o = (v - mean) * rstd * g[k] + bb[k];
            outF[(size_t)t * D + k] = o; if (l != DEPTH - 1) XB[(size_t)t * D + k] = f2bf(o); }
    }
    __syncthreads();
}

constexpr int NPH = 10;
#ifndef PH_MASK
#define PH_MASK 0x7ff
#endif
#define PHON(k) ((PH_MASK >> (k)) & 1)
#ifndef REP_PHASE
#define REP_PHASE -1
#endif
#define REPS(k) for (int rep_ = 0; rep_ < ((REP_PHASE == (k)) ? 2 : 1); ++rep_)
typedef const Params __attribute__((address_space(4))) CParams;
#define KP(field) ({ CParams* _k = kp; asm volatile("" : "+s"(_k)); _k->field; })
__global__ void __launch_bounds__(NTHREADS, 2) hybrid_fwd(Params p_unused, int ph_lo, int ph_hi) {
    extern __shared__ __attribute__((aligned(16))) unsigned char lds_raw[];
    float* lds = (float*)lds_raw;
    LAS unsigned char* ldsb = (LAS unsigned char*)lds_raw;
    CParams* kp = (CParams*)__builtin_amdgcn_kernarg_segment_ptr();
    unsigned char* const ws0 = KP(ws);
    volatile LAS unsigned* xbw = (volatile LAS unsigned*)(lds_raw + LDS_BYTES - 16);
    if (threadIdx.x == 0) { xbw[0] = 0u; xbw[1] = 0u; xbw[2] = 0u; xbw[3] = 0u; }
    __syncthreads();
    XcdBarrier bar; bar.bar = (unsigned*)(ws0 + WS_BAR); bar.x = 0; bar.st = xbw;
    if (ph_lo < ph_hi) bar = xcd_barrier_post((unsigned*)(ws0 + WS_BAR), xbw);
#define IN(ph) ((ph) >= ph_lo && (ph) <= ph_hi)
#define GRID_BAR(ph) do { if ((ph) >= ph_lo && (ph) < ph_hi) xcd_barrier(bar); } while (0)
    if (PHON(0) && IN(0)) REPS(0) { unsigned char* ws = ws0; asm volatile("" : "+s"(ws)); { Params q; q.ws = ws; q.x = KP(x); q.pos = KP(pos); q.w_in = KP(w_in); q.g_q = KP(g_q); q.w_qb = KP(w_qb); q.g_kv = KP(g_kv); q.w_kvb = KP(w_kvb);
        q.w_oa = KP(w_oa); q.w_ob = KP(w_ob); q.w_out = KP(w_out); p_prologue(ldsb, q); } }
    GRID_BAR(0);
    for (int l = 0; l < DEPTH; ++l) {
        const int pb = l * NPH;
        if (PHON(1) && IN(pb + 1)) REPS(1) { unsigned char* ws = ws0; asm volatile("" : "+s"(ws));
            EpiIn E; E.ws = ws;
            pg8::Gemm g{(const bf16_t*)(ws + WS_XB), (const bf16_t*)(ws + WS_WIN_T) + (size_t)l * INP * D, T, INP, D}; pg8::StaticOrder SO; SO.init(T, INP, (int)gridDim.x, (int)blockIdx.x);
            pg8::gemm_phase<EpiIn, pg8::StaticOrder, true, true>(ldsb, g, SO, E);
        }
        GRID_BAR(pb + 1);
        if (PHON(2) && IN(pb + 2)) REPS(2) { unsigned char* ws = ws0; asm volatile("" : "+s"(ws));
            { EpiQA E; E.ws = ws;
              pg8::Gemm g{(const bf16_t*)(ws + WS_CQ), (const bf16_t*)(ws + WS_WQB_T) + (size_t)l * 1536 * 512, T, 1536, 512}; pg8::StaticOrder SO; SO.init(T, 1536, (int)gridDim.x, (int)blockIdx.x);
              pg8::gemm_phase<EpiQA, pg8::StaticOrder, true, true>(ldsb, g, SO, E); }
            { EpiKV E; E.ws = ws;
              pg8::Gemm g{(const bf16_t*)(ws + WS_CKV), (const bf16_t*)(ws + WS_WKVB_T) + (size_t)l * 2048 * 512, T, 2048, 512}; pg8::StaticOrder SO; SO.init(T, 2048, (int)gridDim.x, (int)blockIdx.x);
              pg8::gemm_phase<EpiKV, pg8::StaticOrder, true, true>(ldsb, g, SO, E); }
            p_score(ldsb, ws);
        }
        GRID_BAR(pb + 2);
        if (PHON(3) && IN(pb + 3)) REPS(3) { unsigned char* ws = ws0; asm volatile("" : "+s"(ws)); p_select(ws); }
        GRID_BAR(pb + 3);
        if (PHON(4) && IN(pb + 4)) REPS(4) { unsigned char* ws = ws0; asm volatile("" : "+s"(ws));
            p_attn(ldsb, ws);
        }
        GRID_BAR(pb + 4);
        if (PHON(5) && IN(pb + 5)) REPS(5) { unsigned char* ws = ws0; asm volatile("" : "+s"(ws));
            pg8::StaticOrder SO; SO.init(T, D, (int)gridDim.x, (int)blockIdx.x);
            { EpiYA E; E.ws = ws;
              pg8::Gemm g{(const bf16_t*)(ws + WS_OA), (const bf16_t*)(ws + WS_WOA_T) + (size_t)l * D * 1024, T, D, 1024};
              pg8::gemm_phase<EpiYA, pg8::StaticOrder, true, true>(ldsb, g, SO, E); }
            { EpiYB E; E.ws = ws;
              pg8::Gemm g{(const bf16_t*)(ws + WS_OB), (const bf16_t*)(ws + WS_WOB_T) + (size_t)l * D * 1024, T, D, 1024};
              pg8::gemm_phase<EpiYB, pg8::StaticOrder, true, true>(ldsb, g, SO, E); }
        }
        GRID_BAR(pb + 5);
        if (PHON(6) && IN(pb + 6)) REPS(6) { unsigned char* ws = ws0; asm volatile("" : "+s"(ws));
            EpiOut E; E.hin = (l == 0) ? KP(x) : (const float*)(ws + WS_H2F); E.V1 = (float*)(ws + WS_V1);
            pg8::Gemm g{(const bf16_t*)(ws + WS_Y), (const bf16_t*)(ws + WS_WOUT_T) + (size_t)l * D * D, T, D, D}; pg8::StaticOrder SO; SO.init(T, D, (int)gridDim.x, (int)blockIdx.x);
            pg8::gemm_phase<EpiOut, pg8::StaticOrder, true, true>(ldsb, g, SO, E);
        }
        GRID_BAR(pb + 6);
        if (PHON(7) && IN(pb + 7)) REPS(7) { unsigned char* ws = ws0; asm volatile("" : "+s"(ws)); p_ln1_route2(ldsb, ws, KP(ln1g) + (size_t)l * D, KP(ln1b) + (size_t)l * D, KP(w_router) + (size_t)l * D * 64, KP(w_group) + (size_t)l * D * 8, KP(b_router) + l * 64, KP(b_group) + l * 8, l); }
        GRID_BAR(pb + 7);
        if (PHON(8) && IN(pb + 8)) REPS(8) { unsigned char* ws = ws0; asm volatile("" : "+s"(ws)); p_moe1_mfma(ldsb, ws, KP(w_eg), KP(w_eu), l); }
        GRID_BAR(pb + 8);
        if (PHON(9) && IN(pb + 9)) REPS(9) { unsigned char* ws = ws0; asm volatile("" : "+s"(ws)); p_moe2_mfma(ldsb, ws, KP(w_ed), l); }
        GRID_BAR(pb + 9);
        if (PHON(10) && IN(pb + 10)) REPS(10) { unsigned char* ws = ws0; asm volatile("" : "+s"(ws)); p_ln2v2(ldsb, ws, KP(ln2g) + (size_t)l * D, KP(ln2b) + (size_t)l * D, (l == DEPTH - 1) ? KP(out) : (float*)(ws + WS_H2F), l); }
        GRID_BAR(pb + 10);
    }
}

#ifndef MK_ONE_LAUNCH
#define MK_ONE_LAUNCH 1
#endif
extern "C" void kernel_launch(void* const* d_in, const int* in_sizes, int n_in, void* d_out, int out_size, void* d_ws, size_t ws_size, hipStream_t stream) {
    static int grid = 0;
    if (!grid) {
        if (n_in != 21 || in_sizes[0] != T * D || out_size != T * D || ws_size < WS_END) {
            fprintf(stderr, "kernel_launch: unexpected shapes (n_in %d, in0 %d, out %d, ws %zu, need %zu); nothing launched\n", n_in, n_in > 0 ? in_sizes[0] : -1, out_size, ws_size, (size_t)WS_END);
            grid = -1; return; }
        int dev = 0, cus = 0, per_cu = 0;
        hipGetDevice(&dev); hipDeviceGetAttribute(&cus, hipDeviceAttributeMultiprocessorCount, dev);
        if (hipFuncSetAttribute((const void*)hybrid_fwd, hipFuncAttributeMaxDynamicSharedMemorySize, LDS_BYTES) != hipSuccess) { fprintf(stderr, "kernel_launch: hipFuncSetAttribute failed\n"); grid = -1; return; }
        hipOccupancyMaxActiveBlocksPerMultiprocessor(&per_cu, (const void*)hybrid_fwd, NTHREADS, LDS_BYTES);
        if (per_cu < 1) fprintf(stderr, "kernel_launch: occupancy query reports %d blocks per CU\n", per_cu);
        grid = cus > 0 ? cus : 256;
    }
    if (grid < 0) return;
    hipMemsetAsync((char*)d_ws, 0, WS_CTL_END, stream);
    Params p{};
    p.x = (const float*)d_in[0]; p.pos = (const int*)d_in[1];
    p.w_in = (const float*)d_in[2]; p.g_q = (const float*)d_in[3]; p.w_qb = (const float*)d_in[4]; p.g_kv = (const float*)d_in[5]; p.w_kvb = (const float*)d_in[6];
    p.w_oa = (const float*)d_in[7]; p.w_ob = (const float*)d_in[8]; p.w_out = (const float*)d_in[9]; p.ln1g = (const float*)d_in[10]; p.ln1b = (const float*)d_in[11];
    p.w_group = (const float*)d_in[12]; p.b_group = (const float*)d_in[13]; p.w_router = (const float*)d_in[14]; p.b_router = (const float*)d_in[15];
    p.w_eg = (const float*)d_in[16]; p.w_eu = (const float*)d_in[17]; p.w_ed = (const float*)d_in[18]; p.ln2g = (const float*)d_in[19]; p.ln2b = (const float*)d_in[20];
    p.out = (float*)d_out; p.ws = (unsigned char*)d_ws;
#if MK_ONE_LAUNCH
    hipLaunchKernelGGL(hybrid_fwd, dim3(grid), dim3(NTHREADS), LDS_BYTES, stream, p, 0, DEPTH * NPH);
#else
    for (int ph = 0; ph <= DEPTH * NPH; ++ph) hipLaunchKernelGGL(hybrid_fwd, dim3(grid), dim3(NTHREADS), LDS_BYTES, stream, p, ph, ph);
#endif
}
```

```cpp
#include <hip/hip_runtime.h>
#include <cstdio>
#include <cstdint>

typedef unsigned short bf16_t;
typedef float f32x4 __attribute__((ext_vector_type(4)));
typedef unsigned u32x4 __attribute__((ext_vector_type(4)));
typedef unsigned u32x2 __attribute__((ext_vector_type(2)));

constexpr int T = 8192, D = 2048, S = 4096, NB = 2, DEPTH = 2;
constexpr int INW = 9360, INP = 9472;
constexpr int NE = 64, FE = 512;
constexpr int NTHREADS = 512;
constexpr int LDS_BYTES = 147456;
constexpr float ALPHA = 1.41421356237309515f;
constexpr int ECAP = 8192;
constexpr int PMAX = 36864;

constexpr size_t al256(size_t x) { return (x + 255) & ~(size_t)255; }
constexpr size_t XCD_BAR_BYTES = 16384;
constexpr size_t WS_BAR = 0;
constexpr size_t WS_CNT = WS_BAR + XCD_BAR_BYTES;
constexpr size_t WS_CTL_END = WS_CNT + al256(DEPTH * 64 * 4);
constexpr size_t WS_SSQ = WS_CTL_END;
constexpr size_t WS_ROPE = WS_SSQ + al256((size_t)T * 32 * 4);
constexpr size_t WS_XB = WS_ROPE + al256((size_t)T * 112 * 4);
constexpr size_t WS_H2F = WS_XB + al256((size_t)T * D * 2);
constexpr size_t WS_CQ = WS_H2F + al256((size_t)T * D * 4);
constexpr size_t WS_CKV = WS_CQ + al256((size_t)T * 512 * 2);
constexpr size_t WS_QB = WS_CKV + al256((size_t)T * 512 * 2);
constexpr size_t WS_KB = WS_QB + al256((size_t)T * 1024 * 2);
constexpr size_t WS_VB = WS_KB + al256((size_t)T * 1024 * 2);
constexpr size_t WS_QI = WS_VB + al256((size_t)T * 1024 * 2);
constexpr size_t WS_KI = WS_QI + al256((size_t)T * 1024 * 2);
constexpr size_t WS_WI = WS_KI + al256((size_t)T * 64 * 2);
constexpr size_t WS_GA = WS_WI + al256((size_t)T * 16 * 4);
constexpr size_t WS_GB = WS_GA + al256((size_t)T * D * 2);
constexpr size_t WS_QA = WS_GB + al256((size_t)T * D * 2);
constexpr size_t WS_KA = WS_QA + al256((size_t)T * 1536 * 2);
constexpr size_t WS_VA = WS_KA + al256((size_t)T * 1536 * 2);
constexpr size_t WS_MASK = WS_VA + al256((size_t)T * 1024 * 2);
constexpr size_t WS_OA = WS_MASK + al256((size_t)T * 128 * 4);
constexpr size_t WS_OB = WS_OA + al256((size_t)T * 1024 * 2);
constexpr size_t WS_YT = WS_OB + al256((size_t)T * 1024 * 2);
constexpr size_t WS_Y = WS_YT + al256((size_t)T * D * 4);
constexpr size_t WS_V1 = WS_Y + al256((size_t)T * D * 2);
constexpr size_t WS_H1F = WS_V1 + al256((size_t)T * D * 4);
constexpr size_t WS_H1B = WS_H1F + al256((size_t)T * D * 4);
constexpr size_t WS_TOKE = WS_H1B + al256((size_t)T * D * 2);
constexpr size_t WS_TOKW = WS_TOKE + al256((size_t)T * 2 * 4);
constexpr size_t WS_TOKS = WS_TOKW + al256((size_t)T * 2 * 4);
constexpr size_t WS_LIST = WS_TOKS + al256((size_t)T * 2 * 4);
constexpr size_t WS_HID = WS_LIST + al256((size_t)NE * ECAP * 4);
constexpr size_t WS_YE = WS_HID + al256((size_t)PMAX * FE * 2);
constexpr size_t WS_SCORE = WS_YE + al256((size_t)PMAX * D * 2);
constexpr size_t WS_WIN_T = WS_SCORE + al256((size_t)T * 4096 * 4);
constexpr size_t WS_WQB_T = WS_WIN_T + al256((size_t)DEPTH * INP * D * 2);
constexpr size_t WS_WKVB_T = WS_WQB_T + al256((size_t)DEPTH * 1536 * 512 * 2);
constexpr size_t WS_WOA_T = WS_WKVB_T + al256((size_t)DEPTH * 2048 * 512 * 2);
constexpr size_t WS_WOB_T = WS_WOA_T + al256((size_t)DEPTH * D * 1024 * 2);
constexpr size_t WS_WOUT_T = WS_WOB_T + al256((size_t)DEPTH * D * 1024 * 2);
constexpr size_t WS_END = WS_WOUT_T + al256((size_t)DEPTH * D * D * 2);
static_assert(WS_CKV == WS_CQ + (size_t)T * 512 * 2, "CQ|CKV must be consecutive");

static_assert(WS_KB == WS_QB + (size_t)T * 1024 * 2 && WS_VB == WS_KB + (size_t)T * 1024 * 2 && WS_GB == WS_GA + (size_t)T * D * 2, "QB|KB|VB and GA|GB must be consecutive");
struct Params {
    const float* x; const int* pos;
    const float *w_in, *g_q, *w_qb, *g_kv, *w_kvb, *w_oa, *w_ob, *w_out, *ln1g, *ln1b, *w_group, *b_group, *w_router, *b_router, *w_eg, *w_eu, *w_ed, *ln2g, *ln2b;
    float* out; unsigned char* ws;
};

__device__ __forceinline__ float bf2f(bf16_t v) { return __uint_as_float((unsigned)v << 16); }
__device__ __forceinline__ bf16_t f2bf(float f) { unsigned u = __float_as_uint(f); u += 0x7fffu + ((u >> 16) & 1u); return (bf16_t)(u >> 16); }
__device__ __forceinline__ unsigned pk2(float a, float b) { return (unsigned)f2bf(a) | ((unsigned)f2bf(b) << 16); }
__device__ __forceinline__ void st4bf(bf16_t* p, f32x4 v) { u32x2 w; w.x = pk2(v[0], v[1]); w.y = pk2(v[2], v[3]); *(u32x2*)p = w; }
__device__ __forceinline__ float wave_sum(float v) {
#pragma unroll
    for (int o = 32; o >= 1; o >>= 1) v += __shfl_xor(v, o);
    return v;
}
__device__ __forceinline__ float wave_max(float v) {
#pragma unroll
    for (int o = 32; o >= 1; o >>= 1) v = fmaxf(v, __shfl_xor(v, o));
    return v;
}
__device__ __forceinline__ int block_sum_int(int v, int* red) {
#pragma unroll
    for (int o = 32; o >= 1; o >>= 1) v += __shfl_xor(v, o);
    if ((threadIdx.x & 63) == 0) red[threadIdx.x >> 6] = v;
    __syncthreads();
    int t = 0;
#pragma unroll
    for (int i = 0; i < 8; ++i) t += red[i];
    __syncthreads();
    return t;
}
__device__ __forceinline__ f32x4 rot4(f32x4 v, float c0, float s0, float c1, float s1) { f32x4 o; o[0] = v[0] * c0 - v[1] * s0; o[1] = v[1] * c0 + v[0] * s0; o[2] = v[2] * c1 - v[3] * s1; o[3] = v[3] * c1 + v[2] * s1; return o; }

#define XB_TMO      128
#define XB_XCNT(j)  (256  + 64 * (j))
#define XB_XSUB(j)  (1280 + 64 * (j))
#define XB_XGEN(j)  (2304 + 64 * (j))
#define XB_TOP      3328
#define XB_TOPGEN   3392
#define XCD_BAR_WORDS 3456
#define XB_SPIN_CAP (1u << 22)
#define LAS __attribute__((address_space(3)))
__device__ __forceinline__ unsigned xb_ld(unsigned* p)              { return __hip_atomic_load(p, __ATOMIC_RELAXED, __HIP_MEMORY_SCOPE_AGENT); }
__device__ __forceinline__ unsigned xb_add(unsigned* p, unsigned v) { return __hip_atomic_fetch_add(p, v, __ATOMIC_RELAXED, __HIP_MEMORY_SCOPE_AGENT); }
__device__ __forceinline__ unsigned xb_xcc_id() { return (unsigned)__builtin_amdgcn_s_getreg((3 << 11) | 20) & 0xFu; }
#define XB_SPIN(cond, bar) do { unsigned _sp = 0; while (cond) { __builtin_amdgcn_s_sleep(1); \
    if ((++_sp & 255u) == 0u) { if (xb_ld(&(bar)[XB_TMO])) break; if (_sp > XB_SPIN_CAP) { atomicAdd(&(bar)[XB_TMO], 1u); break; } } } } while (0)
struct XcdBarrier { unsigned* bar; unsigned x; volatile LAS unsigned* st; };
__device__ __forceinline__ XcdBarrier xcd_barrier_post(unsigned* bar, volatile LAS unsigned* st) {
    XcdBarrier b; b.bar = bar; b.x = xb_xcc_id(); b.st = st;
    if (threadIdx.x == 0) (void)xb_add(&bar[XB_XCNT(b.x)], 1u);
    return b;
}
__device__ __forceinline__ void xcd_barrier_complete(unsigned* bar, unsigned x, unsigned& nloc, unsigned& nx) {
    const unsigned G = gridDim.x * gridDim.y * gridDim.z;
    unsigned sum, cnt, mine, sp = 0u;
    for (;;) {
        sum = 0u; cnt = 0u; mine = 0u;
#pragma unroll
        for (unsigned j = 0; j < 16; ++j) { const unsigned c = xb_ld(&bar[XB_XCNT(j)]); sum += c; cnt += (c > 0u) ? 1u : 0u; mine = (j == x) ? c : mine; }
        if (sum == G) break;
        __builtin_amdgcn_s_sleep(1);
        if ((++sp & 255u) == 0u) { if (xb_ld(&bar[XB_TMO])) break; if (sp > XB_SPIN_CAP) { atomicAdd(&bar[XB_TMO], 1u); break; } }
    }
    nloc = mine > 0u ? mine : 1u; nx = cnt > 0u ? cnt : 1u;
}
__device__ __forceinline__ void xcd_barrier(const XcdBarrier& b) {
    asm volatile("s_waitcnt vmcnt(0)" ::: "memory");
    __syncthreads();
    if (threadIdx.x == 0) {
        unsigned* bar = b.bar; asm volatile("" : "+s"(bar));
        __builtin_amdgcn_s_waitcnt(0);
        unsigned nloc = b.st[0], nx = b.st[1];
        unsigned bx = b.x; asm volatile("" : "+s"(bx));
        if (nloc == 0u) { xcd_barrier_complete(bar, bx, nloc, nx); b.st[0] = nloc; b.st[1] = nx; }
        const unsigned old = xb_add(&bar[XB_XSUB(bx)], 1u);
        const unsigned gen = old / nloc;
        if (old + 1u == (gen + 1u) * nloc) {
            __builtin_amdgcn_fence(__ATOMIC_RELEASE, "agent");
            asm volatile("s_waitcnt vmcnt(0)" ::: "memory");
            const unsigned og = xb_add(&bar[XB_TOP], 1u);
            const unsigned tg = og / nx;
            if (og + 1u == (tg + 1u) * nx) xb_add(&bar[XB_TOPGEN], 1u);
            else XB_SPIN(xb_ld(&bar[XB_TOPGEN]) == tg, bar);
            __builtin_amdgcn_fence(__ATOMIC_ACQUIRE, "agent");
            xb_add(&bar[XB_XGEN(bx)], 1u);
            asm volatile("s_waitcnt vmcnt(0)" ::: "memory");
        } else {
            XB_SPIN(xb_ld(&bar[XB_XGEN(bx)]) == gen, bar);
            __builtin_amdgcn_fence(__ATOMIC_ACQUIRE, "agent");
            asm volatile("s_waitcnt vmcnt(0)" ::: "memory");
        }
    }
    __syncthreads();
}

__device__ __forceinline__ int opaque_tid() { int t = threadIdx.x; asm volatile("" : "+v"(t)); return t; }
__device__ __forceinline__ int opaque_bid() { int b = blockIdx.x; asm volatile("" : "+s"(b)); return b; }
namespace pg8 {
#define PG8_LAS __attribute__((address_space(3)))
typedef unsigned short bf16_t;
typedef short bf16x8 __attribute__((ext_vector_type(8)));
typedef float f32x4 __attribute__((ext_vector_type(4)));
typedef unsigned u32x4 __attribute__((ext_vector_type(4)));
constexpr int BM = 256, BK = 64, HALF = 128, HTB = HALF * BK * 2  , STAGE_BYTES = 8 * HTB, NXCD = 8, WGM = 8;

__host__ __device__ __forceinline__ int lds_byte(int r, int c) { const int st = (r >> 4) * 2 + (c >> 5), rr = r & 15, cc = c & 31, ob = rr * 64 + cc * 2; return st * 1024 + (ob ^ (((ob >> 9) & 1) << 5)); }
__host__ __device__ __forceinline__ void stage_rc(int b, int& R, int& C) { const int st = b / 1024, sb = b % 1024, swz = sb ^ (((sb >> 9) & 1) << 5); R = (st >> 1) * 16 + swz / 64; C = (st & 1) * 32 + (swz % 64) / 2; }
__host__ __device__ __forceinline__ int perm32(int rho) { const int n = rho >> 4, i = rho & 15; return 8 * (i >> 2) + 4 * n + (i & 3); }

struct Unit { int pm, pn; };
struct Gemm { const bf16_t* A; const bf16_t* Bt; int M, N, K; };

struct StaticOrder {
    int nM, nN, nwg, G, c;
    __host__ __device__ void init(int M, int N, int G_, int c_) { nM = M / BM; nN = N / BM; nwg = nM * nN; G = G_; c = c_; }
    __host__ __device__ bool next(int i, Unit& u) const {
        const long L = (long)i * G + c; if (L >= nwg) return false;
        int wgid = (int)L; { const int q = nwg / NXCD, r = nwg % NXCD, xcd = wgid % NXCD, off = wgid / NXCD; wgid = (xcd < r ? xcd * (q + 1) : r * (q + 1) + (xcd - r) * q) + off; }
        const int nig = WGM * nN, gid = wgid / nig, fm = gid * WGM, gsz = (nM - fm) < WGM ? (nM - fm) : WGM;
        u.pm = fm + ((wgid % nig) % gsz); u.pn = (wgid % nig) / gsz; return true;
    }
    __device__ __forceinline__ void a_ready(const Unit&) const {}
    __device__ __forceinline__ void done(const Unit&) const {}
};

__device__ __forceinline__ unsigned cvt_pk_bf16(float lo, float hi) { unsigned r; asm volatile("v_cvt_pk_bf16_f32 %0, %1, %2" : "=v"(r) : "v"(lo), "v"(hi)); return r; }
template <class Epi, class Sched, bool ALIGN_EPI = false, bool SP2 = false>
__device__ __forceinline__ void gemm_phase(PG8_LAS unsigned char* lds, const Gemm g, const Sched& S, const Epi& E) {
    const int tid = opaque_tid(), wid = __builtin_amdgcn_readfirstlane(tid >> 6), lane = tid & 63, wr = wid >> 2, wc = wid & 3, fr = lane & 15, fq = lane >> 4;
    const int K = g.K, nt = K / BK;
    unsigned voffA[2], voffB[2];
#pragma unroll
    for (int i = 0; i < 2; ++i) { int R, C; stage_rc(tid * 16 + i * 8192, R, C); const int Rb = Epi::PERM ? ((R & ~31) + perm32(R & 31)) : R;
        voffA[i] = (unsigned)(R * K + C) * 2u; voffB[i] = (unsigned)(Rb * K + C) * 2u; }
    const size_t kstep = (size_t)(BK * 2);
    const size_t hstep = (size_t)HALF * K * 2;
    const size_t tstep = 2 * hstep;
    const unsigned ldsw = (unsigned)wid * 1024u;
    const int aoff = lds_byte(wr * 64 + fr, fq * 8), boff = lds_byte(wc * 32 + fr, fq * 8);
#define PG8_SA(b, h) (((b) * 2 + (h)) * HTB)
#define PG8_SB(b, h) ((4 + (b) * 2 + (h)) * HTB)
#define PG8_STAGE(bufoff, gbase, voff) do { _Pragma("unroll") for (int _i = 0; _i < 2; ++_i) \
        __builtin_amdgcn_global_load_lds((const unsigned*)((const char*)(gbase) + (voff)[_i]), (PG8_LAS unsigned*)(lds + (bufoff) + ldsw + _i * 8192), 16, 0, 0); } while (0)
#define PG8_LDA(dst, b, h) do { _Pragma("unroll") for (int m = 0; m < 4; ++m) _Pragma("unroll") for (int k = 0; k < 2; ++k) dst[m][k] = *(const PG8_LAS bf16x8*)(lds + PG8_SA(b, h) + aoff + m * 2048 + k * 1024); } while (0)
#define PG8_LDB(dst, b, h) do { _Pragma("unroll") for (int n = 0; n < 2; ++n) _Pragma("unroll") for (int k = 0; k < 2; ++k) dst[n][k] = *(const PG8_LAS bf16x8*)(lds + PG8_SB(b, h) + boff + n * 2048 + k * 1024); } while (0)
#define PG8_MMA(ai, bj, At, Bt) do { __builtin_amdgcn_s_setprio(1); _Pragma("unroll") for (int m = 0; m < 4; ++m) _Pragma("unroll") for (int n = 0; n < 2; ++n) _Pragma("unroll") for (int k = 0; k < 2; ++k) \
        acc[ai][bj][m][n] = __builtin_amdgcn_mfma_f32_16x16x32_bf16(Bt[n][k], At[m][k], acc[ai][bj][m][n], 0, 0, 0); __builtin_amdgcn_s_setprio(0); } while (0)
#define PG8_WAIT_V(n) asm volatile("s_waitcnt vmcnt(" #n ")" ::: "memory")
#define PG8_WAIT_L(n) asm volatile("s_waitcnt lgkmcnt(" #n ")" ::: "memory")
#define PG8_BAR __builtin_amdgcn_s_barrier()
#define PG8_SCHED __builtin_amdgcn_sched_barrier(0)
    Unit cur, nxt; int ui = 0;
    if (!S.next(0, cur)) return;
    f32x4 acc[2][2][4][2];
#pragma unroll
    for (int a = 0; a < 2; ++a)
#pragma unroll
        for (int b = 0; b < 2; ++b)
#pragma unroll
            for (int m = 0; m < 4; ++m)
#pragma unroll
                for (int n = 0; n < 2; ++n) acc[a][b][m][n] = (f32x4){0.f, 0.f, 0.f, 0.f};
    bf16x8 At[4][2], B0[2][2], B1[2][2];
    const char* cA = (const char*)g.A + (size_t)cur.pm * tstep; const char* cB = (const char*)g.Bt + (size_t)cur.pn * tstep;
    S.a_ready(cur);
    if constexpr (SP2) {
        PG8_STAGE(PG8_SB(0, 0), cB, voffB); PG8_STAGE(PG8_SB(0, 1), cB + hstep, voffB); PG8_STAGE(PG8_SA(0, 0), cA, voffA); PG8_STAGE(PG8_SA(0, 1), cA + hstep, voffA);
        if (wr == 1) PG8_BAR;
        PG8_WAIT_V(2); PG8_BAR;
        PG8_STAGE(PG8_SB(1, 0), cB + kstep, voffB); PG8_STAGE(PG8_SA(1, 0), cA + kstep, voffA); PG8_STAGE(PG8_SB(1, 1), cB + hstep + kstep, voffB);
        PG8_WAIT_V(6); PG8_BAR;
    } else {
        PG8_STAGE(PG8_SB(0, 0), cB, voffB); PG8_STAGE(PG8_SA(0, 0), cA, voffA); PG8_STAGE(PG8_SB(0, 1), cB + hstep, voffB); PG8_STAGE(PG8_SA(0, 1), cA + hstep, voffA);
        if (wr == 1) PG8_BAR;
        PG8_WAIT_V(4); PG8_BAR;
        PG8_STAGE(PG8_SB(1, 0), cB + kstep, voffB); PG8_STAGE(PG8_SA(1, 0), cA + kstep, voffA); PG8_STAGE(PG8_SB(1, 1), cB + hstep + kstep, voffB);
        PG8_WAIT_V(6); PG8_BAR;
    }
    for (;;) {
        const bool has_next = S.next(ui + 1, nxt);
        const char* nA = has_next ? (const char*)g.A + (size_t)nxt.pm * tstep : cA; const char* nB = has_next ? (const char*)g.Bt + (size_t)nxt.pn * tstep : cB;
        for (int t = 0; t < nt; t += 2) {
            const bool last = (t == nt - 2);
            const char* a1 = cA + (size_t)(t + 1) * kstep;
            const char* a2 = last ? nA : cA + (size_t)(t + 2) * kstep; const char* b2 = last ? nB : cB + (size_t)(t + 2) * kstep;
            const char* a3 = a2 + kstep; const char* b3 = b2 + kstep;
            if (last && has_next) S.a_ready(nxt);
            if constexpr (SP2) {
            PG8_LDB(B0, 0, 0); PG8_LDB(B1, 0, 1); PG8_SCHED; PG8_LDA(At, 0, 0); PG8_STAGE(PG8_SA(1, 1), a1 + hstep, voffA);
            PG8_WAIT_V(8); PG8_WAIT_L(0); PG8_BAR; PG8_MMA(0, 0, At, B0); PG8_MMA(0, 1, At, B1); PG8_BAR; PG8_SCHED;
            PG8_LDA(At, 0, 1); PG8_STAGE(PG8_SB(0, 0), b2, voffB); PG8_STAGE(PG8_SB(0, 1), b2 + hstep, voffB); PG8_STAGE(PG8_SA(0, 0), a2, voffA);
            PG8_WAIT_V(8); PG8_WAIT_L(0); PG8_BAR; PG8_MMA(1, 0, At, B0); PG8_MMA(1, 1, At, B1); PG8_BAR; PG8_SCHED;
            PG8_LDB(B0, 1, 0); PG8_LDB(B1, 1, 1); PG8_SCHED; PG8_LDA(At, 1, 0); PG8_STAGE(PG8_SA(0, 1), a2 + hstep, voffA);
            PG8_WAIT_V(8); PG8_WAIT_L(0); PG8_BAR; PG8_MMA(0, 0, At, B0); PG8_MMA(0, 1, At, B1); PG8_BAR; PG8_SCHED;
            PG8_LDA(At, 1, 1); PG8_STAGE(PG8_SB(1, 0), b3, voffB); PG8_STAGE(PG8_SB(1, 1), b3 + hstep, voffB); PG8_STAGE(PG8_SA(1, 0), a3, voffA);
            PG8_WAIT_V(8); PG8_WAIT_L(0); PG8_BAR; PG8_MMA(1, 0, At, B0); PG8_MMA(1, 1, At, B1); PG8_BAR; PG8_SCHED;
            } else {
            PG8_LDB(B0, 0, 0); PG8_SCHED; PG8_LDA(At, 0, 0); PG8_STAGE(PG8_SA(1, 1), a1 + hstep, voffA);
            PG8_WAIT_L(8); PG8_BAR; PG8_WAIT_L(0); PG8_MMA(0, 0, At, B0); PG8_BAR; PG8_SCHED;
            PG8_LDB(B1, 0, 1); PG8_STAGE(PG8_SB(0, 0), b2, voffB);
            PG8_BAR; PG8_WAIT_L(0); PG8_MMA(0, 1, At, B1); PG8_BAR;
            PG8_LDA(At, 0, 1); PG8_STAGE(PG8_SA(0, 0), a2, voffA);
            PG8_BAR; PG8_WAIT_L(0); PG8_MMA(1, 0, At, B0); PG8_BAR; PG8_SCHED;
            PG8_STAGE(PG8_SB(0, 1), b2 + hstep, voffB);
            PG8_WAIT_V(6); PG8_BAR; PG8_MMA(1, 1, At, B1); PG8_BAR;
            PG8_LDB(B0, 1, 0); PG8_SCHED; PG8_LDA(At, 1, 0); PG8_STAGE(PG8_SA(0, 1), a2 + hstep, voffA);
            PG8_WAIT_L(8); PG8_BAR; PG8_WAIT_L(0); PG8_MMA(0, 0, At, B0); PG8_BAR; PG8_SCHED;
            PG8_LDB(B1, 1, 1); PG8_STAGE(PG8_SB(1, 0), b3, voffB);
            PG8_BAR; PG8_WAIT_L(0); PG8_MMA(0, 1, At, B1); PG8_BAR;
            PG8_LDA(At, 1, 1); PG8_STAGE(PG8_SA(1, 0), a3, voffA);
            PG8_BAR; PG8_WAIT_L(0); PG8_MMA(1, 0, At, B0); PG8_BAR; PG8_SCHED;
            PG8_STAGE(PG8_SB(1, 1), b3 + hstep, voffB);
            PG8_WAIT_V(6); PG8_BAR; PG8_MMA(1, 1, At, B1); PG8_BAR;
            }
        }
        if constexpr (ALIGN_EPI) { if (wr == 0) PG8_BAR; }
        if constexpr (!Epi::AFTER_DRAIN) { E(acc, cur, wr, wc, fr, fq); S.done(cur); }
        if (!has_next) break;
#pragma unroll
        for (int a = 0; a < 2; ++a)
#pragma unroll
            for (int b = 0; b < 2; ++b)
#pragma unroll
                for (int m = 0; m < 4; ++m)
#pragma unroll
                    for (int n = 0; n < 2; ++n) acc[a][b][m][n] = (f32x4){0.f, 0.f, 0.f, 0.f};
        cur = nxt; cA = nA; cB = nB; ++ui;
        if constexpr (ALIGN_EPI) { if (wr == 1) PG8_BAR; }
    }
    PG8_WAIT_V(0);
    if constexpr (!ALIGN_EPI) { if (wr == 0) PG8_BAR; }
    PG8_BAR;
    if constexpr (Epi::AFTER_DRAIN) { E.fused(acc, cur, wr, wc, fr, fq, lds, wid, lane); S.done(cur); }
#undef PG8_SA
#undef PG8_SB
#undef PG8_STAGE
#undef PG8_LDA
#undef PG8_LDB
#undef PG8_MMA
#undef PG8_WAIT_V
#undef PG8_WAIT_L
#undef PG8_BAR
#undef PG8_SCHED
}
}

__device__ __forceinline__ unsigned pkbf(float lo, float hi) { return pg8::cvt_pk_bf16(lo, hi); }
__device__ __forceinline__ void st8bf(bf16_t* p, f32x4 a, f32x4 b) { u32x4 w; w.x = pkbf(a[0], a[1]); w.y = pkbf(a[2], a[3]); w.z = pkbf(b[0], b[1]); w.w = pkbf(b[2], b[3]); *(u32x4*)p = w; }
__device__ __forceinline__ f32x4 bflo(u32x4 g) { f32x4 o; o[0] = __uint_as_float(g.x << 16); o[1] = __uint_as_float(g.x & 0xffff0000u); o[2] = __uint_as_float(g.y << 16); o[3] = __uint_as_float(g.y & 0xffff0000u); return o; }
__device__ __forceinline__ f32x4 bfhi(u32x4 g) { f32x4 o; o[0] = __uint_as_float(g.z << 16); o[1] = __uint_as_float(g.z & 0xffff0000u); o[2] = __uint_as_float(g.w << 16); o[3] = __uint_as_float(g.w & 0xffff0000u); return o; }
__device__ __forceinline__ f32x4 bf4(u32x2 g) { f32x4 o; o[0] = __uint_as_float(g.x << 16); o[1] = __uint_as_float(g.x & 0xffff0000u); o[2] = __uint_as_float(g.y << 16); o[3] = __uint_as_float(g.y & 0xffff0000u); return o; }
__device__ __forceinline__ void rot8(f32x4& a, f32x4& b, f32x4 c, f32x4 s) {
    const f32x4 x = a, y = b;
    a[0] = x[0] * c[0] - x[1] * s[0]; a[1] = x[1] * c[0] + x[0] * s[0]; a[2] = x[2] * c[1] - x[3] * s[1]; a[3] = x[3] * c[1] + x[2] * s[1];
    b[0] = y[0] * c[2] - y[1] * s[2]; b[1] = y[1] * c[2] + y[0] * s[2]; b[2] = y[2] * c[3] - y[3] * s[3]; b[3] = y[3] * c[3] + y[2] * s[3];
}
__device__ __forceinline__ f32x4 sig4(f32x4 v) { f32x4 o; o[0] = 1.f / (1.f + __expf(-v[0])); o[1] = 1.f / (1.f + __expf(-v[1])); o[2] = 1.f / (1.f + __expf(-v[2])); o[3] = 1.f / (1.f + __expf(-v[3])); return o; }
__host__ __device__ __forceinline__ int src_in(int n) {
    if (n < 1024) return n;
    if (n < 4096) { const int seg = (n - 1024) >> 10, c = (n - 1024) & 1023, d = c & 127; int od = d; if (seg < 2 && d < 32) od = (d >> 1) + (d & 1) * 16; return 1088 + seg * 1024 + (c & ~127) + od; }
    if (n < 5120) { const int c = n - 4096, d = c & 63; const int od = d < 16 ? (d >> 1) + (d & 1) * 8 : d; return 4160 + (c & ~63) + od; }
    if (n < 7168) return 5264 + (n - 5120);
    if (n < 9216) return 7312 + (n - 7168);
    if (n < 9280) { const int d = n - 9216; return 1024 + (d >> 1) + (d & 1) * 32; }
    if (n < 9344) { const int d = n - 9280; const int od = d < 16 ? (d >> 1) + (d & 1) * 8 : d; return 5184 + od; }
    if (n < 9360) return 5248 + (n - 9344);
    return -1;
}
__host__ __device__ __forceinline__ int src_qa(int n) { const int h = n / 192, d = n - h * 192; if (d < 128) return n; const int dd = d - 128; return h * 192 + 128 + (dd >> 1) + (dd & 1) * 32; }

struct EpiIn {
    static constexpr bool PERM = true, AFTER_DRAIN = false;
    unsigned char* ws;
    __device__ __forceinline__ void operator()(const f32x4 (&acc)[2][2][4][2], const pg8::Unit& u, int wr, int wc, int fr, int fq) const {
        const int row0 = u.pm * 256 + wr * 64 + fr, cu = wc * 32 + 8 * fq, pn = u.pn;
        bf16_t* const CQ = (bf16_t*)(ws + WS_CQ); bf16_t* const QB = (bf16_t*)(ws + WS_QB); bf16_t* const QI = (bf16_t*)(ws + WS_QI); bf16_t* const GA = (bf16_t*)(ws + WS_GA);
        bf16_t* const KA = (bf16_t*)(ws + WS_KA); bf16_t* const KI = (bf16_t*)(ws + WS_KI); float* const WI = (float*)(ws + WS_WI); float* const part = (float*)(ws + WS_SSQ);
        const float* const cM = (const float*)(ws + WS_ROPE); const float* const sM = cM + T * 32; const float* const cD = cM + T * 64; const float* const sD = cM + T * 80; const float* const cI = cM + T * 96; const float* const sI = cM + T * 104;
#define EPI_ROWS(BODY) _Pragma("unroll") for (int ai = 0; ai < 2; ++ai) _Pragma("unroll") for (int m = 0; m < 4; ++m) { const int t = row0 + ai * 128 + m * 16; \
            _Pragma("unroll") for (int bj = 0; bj < 2; ++bj) { f32x4 a = acc[ai][bj][m][0], b = acc[ai][bj][m][1]; BODY } }
        if (pn < 4) {
            bf16_t* const dst = CQ + (size_t)(pn >> 1) * ((size_t)T * 512) + (pn & 1) * 256 + cu;
            EPI_ROWS(
                st8bf(dst + (size_t)t * 512 + bj * 128, a, b);
                float sq = ((a[0] * a[0] + a[1] * a[1]) + (a[2] * a[2] + a[3] * a[3])) + ((b[0] * b[0] + b[1] * b[1]) + (b[2] * b[2] + b[3] * b[3]));
                sq += __shfl_xor(sq, 16); sq += __shfl_xor(sq, 32);
                if (fq == 0) part[(size_t)t * 32 + pn * 8 + bj * 4 + wc] = sq; )
        } else if (pn < 16) {
            const int seg = (pn - 4) >> 2; const bool rot = seg < 2 && wc == 0;
            bf16_t* const dst = QB + (size_t)seg * ((size_t)T * 1024) + ((pn - 4) & 3) * 256 + cu;
            EPI_ROWS(
                if (rot) rot8(a, b, *(const f32x4*)(cD + (size_t)t * 16 + 4 * fq), *(const f32x4*)(sD + (size_t)t * 16 + 4 * fq));
                st8bf(dst + (size_t)t * 1024 + bj * 128, a, b); )
        } else if (pn < 20) {
            const bool rot = (wc & 1) == 0 && fq < 2;
            bf16_t* const dst = QI + (pn - 16) * 256 + cu;
            EPI_ROWS(
                if (rot) rot8(a, b, *(const f32x4*)(cI + (size_t)t * 8 + 4 * fq), *(const f32x4*)(sI + (size_t)t * 8 + 4 * fq));
                st8bf(dst + (size_t)t * 1024 + bj * 128, a, b); )
        } else if (pn < 36) {
            bf16_t* const dst = GA + (size_t)((pn - 20) >> 3) * ((size_t)T * D) + ((pn - 20) & 7) * 256 + cu;
            EPI_ROWS( st8bf(dst + (size_t)t * D + bj * 128, sig4(a), sig4(b)); )
        } else {
            EPI_ROWS(
                if (bj == 0) {
                    if (wc < 2) {
                        rot8(a, b, *(const f32x4*)(cM + (size_t)t * 32 + (cu >> 1)), *(const f32x4*)(sM + (size_t)t * 32 + (cu >> 1)));
                        _Pragma("unroll") for (int h = 0; h < 8; ++h) st8bf(KA + (size_t)t * 1536 + h * 192 + 128 + cu, a, b);
                    } else {
                        const int d = cu - 64;
                        if (d < 16) rot8(a, b, *(const f32x4*)(cI + (size_t)t * 8 + (d >> 1)), *(const f32x4*)(sI + (size_t)t * 8 + (d >> 1)));
                        st8bf(KI + (size_t)t * 64 + d, a, b);
                    }
                } else if (cu < 16) {
                    *(f32x4*)(WI + (size_t)t * 16 + cu) = a * 0.03125f; *(f32x4*)(WI + (size_t)t * 16 + cu + 4) = b * 0.03125f;
                } )
        }
#undef EPI_ROWS
    }
};
__device__ __forceinline__ float rms_from_part(const float* pp) {
    const f32x4 p0 = *(const f32x4*)pp, p1 = *(const f32x4*)(pp + 4), p2 = *(const f32x4*)(pp + 8), p3 = *(const f32x4*)(pp + 12);
    const float s = (((p0[0] + p0[1]) + (p0[2] + p0[3])) + ((p1[0] + p1[1]) + (p1[2] + p1[3]))) + (((p2[0] + p2[1]) + (p2[2] + p2[3])) + ((p3[0] + p3[1]) + (p3[2] + p3[3])));
    return rsqrtf(s * (1.f / 512.f) + 1e-6f);
}
struct EpiQA {
    static constexpr bool PERM = true, AFTER_DRAIN = false;
    unsigned char* ws;
    __device__ __forceinline__ void operator()(const f32x4 (&acc)[2][2][4][2], const pg8::Unit& u, int wr, int wc, int fr, int fq) const {
        const int row0 = u.pm * 256 + wr * 64 + fr, cu = wc * 32 + 8 * fq;
        bf16_t* const QA = (bf16_t*)(ws + WS_QA); const float* const part = (const float*)(ws + WS_SSQ); const float* const cM = (const float*)(ws + WS_ROPE); const float* const sM = cM + T * 32;
#pragma unroll
        for (int ai = 0; ai < 2; ++ai)
#pragma unroll
            for (int m = 0; m < 4; ++m) {
                const int t = row0 + ai * 128 + m * 16;
                const float r = rms_from_part(part + (size_t)t * 32);
#pragma unroll
                for (int bj = 0; bj < 2; ++bj) {
                    const int n = u.pn * 256 + bj * 128 + cu, h = n / 192, d = n - h * 192;
                    f32x4 a = acc[ai][bj][m][0] * r, b = acc[ai][bj][m][1] * r;
                    if (d >= 128) rot8(a, b, *(const f32x4*)(cM + (size_t)t * 32 + ((d - 128) >> 1)), *(const f32x4*)(sM + (size_t)t * 32 + ((d - 128) >> 1)));
                    st8bf(QA + (size_t)t * 1536 + n, a, b);
                }
            }
    }
};
struct EpiKV {
    static constexpr bool PERM = true, AFTER_DRAIN = false;
    unsigned char* ws;
    __device__ __forceinline__ void operator()(const f32x4 (&acc)[2][2][4][2], const pg8::Unit& u, int wr, int wc, int fr, int fq) const {
        const int row0 = u.pm * 256 + wr * 64 + fr, cu = wc * 32 + 8 * fq;
        bf16_t* const KA = (bf16_t*)(ws + WS_KA); bf16_t* const VA = (bf16_t*)(ws + WS_VA); const float* const part = (const float*)(ws + WS_SSQ);
#pragma unroll
        for (int ai = 0; ai < 2; ++ai)
#pragma unroll
            for (int m = 0; m < 4; ++m) {
                const int t = row0 + ai * 128 + m * 16;
                const float r = rms_from_part(part + (size_t)t * 32 + 16);
                st8bf(KA + (size_t)t * 1536 + u.pn * 192 + cu, acc[ai][0][m][0] * r, acc[ai][0][m][1] * r);
                st8bf(VA + (size_t)t * 1024 + u.pn * 128 + cu, acc[ai][1][m][0] * r, acc[ai][1][m][1] * r);
            }
    }
};
struct EpiYA {
    static constexpr bool PERM = true, AFTER_DRAIN = false;
    unsigned char* ws;
    __device__ __forceinline__ void operator()(const f32x4 (&acc)[2][2][4][2], const pg8::Unit& u, int wr, int wc, int fr, int fq) const {
        const int row0 = u.pm * 256 + wr * 64 + fr, col0 = u.pn * 256 + wc * 32 + 8 * fq;
        float* const YT = (float*)(ws + WS_YT); const bf16_t* const GA = (const bf16_t*)(ws + WS_GA);
#pragma unroll
        for (int ai = 0; ai < 2; ++ai)
#pragma unroll
            for (int m = 0; m < 4; ++m)
#pragma unroll
                for (int bj = 0; bj < 2; ++bj) {
                    const size_t o = (size_t)(row0 + ai * 128 + m * 16) * D + col0 + bj * 128;
                    const u32x4 g = *(const u32x4*)(GA + o);
                    *(f32x4*)(YT + o) = acc[ai][bj][m][0] * bflo(g); *(f32x4*)(YT + o + 4) = acc[ai][bj][m][1] * bfhi(g);
                }
    }
};
struct EpiYB {
    static constexpr bool PERM = true, AFTER_DRAIN = false;
    unsigned char* ws;
    __device__ __forceinline__ void operator()(const f32x4 (&acc)[2][2][4][2], const pg8::Unit& u, int wr, int wc, int fr, int fq) const {
        const int row0 = u.pm * 256 + wr * 64 + fr, col0 = u.pn * 256 + wc * 32 + 8 * fq;
        const float* const YT = (const float*)(ws + WS_YT); const bf16_t* const GB = (const bf16_t*)(ws + WS_GB); bf16_t* const Y = (bf16_t*)(ws + WS_Y);
#pragma unroll
        for (int ai = 0; ai < 2; ++ai)
#pragma unroll
            for (int m = 0; m < 4; ++m)
#pragma unroll
                for (int bj = 0; bj < 2; ++bj) {
                    const size_t o = (size_t)(row0 + ai * 128 + m * 16) * D + col0 + bj * 128;
                    const u32x4 g = *(const u32x4*)(GB + o);
                    const f32x4 y0 = *(const f32x4*)(YT + o), y1 = *(const f32x4*)(YT + o + 4);
                    st8bf(Y + o, y0 + acc[ai][bj][m][0] * bflo(g), y1 + acc[ai][bj][m][1] * bfhi(g));
                }
    }
};
struct EpiOut {
    static constexpr bool PERM = true, AFTER_DRAIN = false;
    const float* hin; float* V1;
    __device__ __forceinline__ void operator()(const f32x4 (&acc)[2][2][4][2], const pg8::Unit& u, int wr, int wc, int fr, int fq) const {
        const int row0 = u.pm * 256 + wr * 64 + fr, col0 = u.pn * 256 + wc * 32 + 8 * fq;
#pragma unroll
        for (int ai = 0; ai < 2; ++ai)
#pragma unroll
            for (int m = 0; m < 4; ++m)
#pragma unroll
                for (int bj = 0; bj < 2; ++bj) {
                    const size_t o = (size_t)(row0 + ai * 128 + m * 16) * D + col0 + bj * 128;
                    const f32x4 h0 = *(const f32x4*)(hin + o), h1 = *(const f32x4*)(hin + o + 4);
                    *(f32x4*)(V1 + o) = h0 * ALPHA + acc[ai][bj][m][0]; *(f32x4*)(V1 + o + 4) = h1 * ALPHA + acc[ai][bj][m][1];
                }
    }
};

#define LDS_WAIT() asm volatile("s_waitcnt lgkmcnt(0)" ::: "memory")
__device__ __forceinline__ void transpose_item(int MAP, const float* W, int ldw, int K, int N, const float* kscale, bf16_t* WT, LAS float* scr, int item, int lane) {
    const int nblk = N / 32, kb = item / nblk, nb = item % nblk, k0 = 64 * kb, n0 = 32 * nb;
    const int n = n0 + (lane & 31);
    const int sc = MAP == 0 ? n : (MAP == 1 ? src_in(n) : src_qa(n));
#pragma unroll 8
    for (int i = 0; i < 32; ++i) { const int kk = 2 * i + (lane >> 5);
        float v = sc >= 0 ? W[(size_t)(k0 + kk) * ldw + sc] : 0.f; if (kscale) v *= kscale[k0 + kk];
        scr[kk * 33 + (lane & 31)] = v; }
    LDS_WAIT(); asm volatile("" ::: "memory");
    const int c = lane & 7;
#pragma unroll
    for (int j = 0; j < 4; ++j) { const int nn = (lane >> 3) + 8 * j; const LAS float* sp = scr + (8 * c) * 33 + nn;
        u32x4 o; o.x = pkbf(sp[0 * 33], sp[1 * 33]); o.y = pkbf(sp[2 * 33], sp[3 * 33]); o.z = pkbf(sp[4 * 33], sp[5 * 33]); o.w = pkbf(sp[6 * 33], sp[7 * 33]);
        *(u32x4*)(WT + (size_t)(n0 + nn) * K + k0 + 8 * c) = o; }
    LDS_WAIT(); asm volatile("" ::: "memory");
}
__device__ __forceinline__ void p_prologue(LAS unsigned char* ldsb, const Params& p) {
    float* rope = (float*)(p.ws + WS_ROPE);
    float *cM = rope, *sM = rope + T * 32, *cD = rope + T * 64, *sD = rope + T * 80, *cI = rope + T * 96, *sI = rope + T * 104;
    const int gtid = opaque_bid() * NTHREADS + threadIdx.x, gstride = gridDim.x * NTHREADS;
    for (int idx = gtid; idx < T * 56; idx += gstride) {
        const int t = idx / 56, j = idx - t * 56;
        int rot, i; float *ct, *st; int w;
        if (j < 32) { rot = 64; i = j; ct = cM; st = sM; w = 32; } else if (j < 48) { rot = 32; i = j - 32; ct = cD; st = sD; w = 16; } else { rot = 16; i = j - 48; ct = cI; st = sI; w = 8; }
        const float inv = exp2f(-((float)(2 * i) / (float)rot) * 18.931568569324174f);
        const float ang = (float)p.pos[t] * inv;
        double rev = (double)ang * 0.15915494309189535; rev -= rint(rev);
        const float r = (float)(rev * 6.283185307179586);
        ct[t * w + i] = __cosf(r); st[t * w + i] = __sinf(r);
    }
    bf16_t* XB = (bf16_t*)(p.ws + WS_XB);
    for (size_t i = (size_t)gtid * 4; i < (size_t)T * D; i += (size_t)gstride * 4) st4bf(XB + i, *(const f32x4*)(p.x + i));
    const int wave = threadIdx.x >> 6, lane = threadIdx.x & 63;
    LAS float* scr = (LAS float*)(ldsb + wave * 16384);
    const int gw = opaque_bid() * 8 + wave, NGW = gridDim.x * 8;
    constexpr int I_IN = (D / 64) * (INP / 32), I_QB = (512 / 64) * (1536 / 32), I_KV = (512 / 64) * (2048 / 32), I_O = (1024 / 64) * (D / 32), I_OUT = (D / 64) * (D / 32);
    constexpr int I_LAYER = I_IN + I_QB + I_KV + 2 * I_O + I_OUT;
    for (int it = gw; it < DEPTH * I_LAYER; it += NGW) {
        const int l = it / I_LAYER; int r = it - l * I_LAYER;
        int map = 0, ldw, K, N; const float* W; const float* ks = nullptr; bf16_t* WT;
        if (r < I_IN) { map = 1; W = p.w_in + (size_t)l * D * INW; ldw = INW; K = D; N = INP; WT = (bf16_t*)(p.ws + WS_WIN_T) + (size_t)l * INP * D; }
        else if ((r -= I_IN) < I_QB) { map = 2; W = p.w_qb + (size_t)l * 512 * 1536; ldw = 1536; K = 512; N = 1536; ks = p.g_q + l * 512; WT = (bf16_t*)(p.ws + WS_WQB_T) + (size_t)l * 1536 * 512; }
        else if ((r -= I_QB) < I_KV) { W = p.w_kvb + (size_t)l * 512 * 2048; ldw = 2048; K = 512; N = 2048; ks = p.g_kv + l * 512; WT = (bf16_t*)(p.ws + WS_WKVB_T) + (size_t)l * 2048 * 512; }
        else if ((r -= I_KV) < I_O) { W = p.w_oa + (size_t)l * 1024 * D; ldw = D; K = 1024; N = D; WT = (bf16_t*)(p.ws + WS_WOA_T) + (size_t)l * D * 1024; }
        else if ((r -= I_O) < I_O) { W = p.w_ob + (size_t)l * 1024 * D; ldw = D; K = 1024; N = D; WT = (bf16_t*)(p.ws + WS_WOB_T) + (size_t)l * D * 1024; }
        else { r -= I_O; W = p.w_out + (size_t)l * D * D; ldw = D; K = D; N = D; WT = (bf16_t*)(p.ws + WS_WOUT_T) + (size_t)l * D * D; }
        transpose_item(map, W, ldw, K, N, ks, WT, scr, r, lane);
    }
    __syncthreads();
}

__device__ __forceinline__ unsigned f2key(float f) { const unsigned u = __float_as_uint(f); return (u & 0x80000000u) ? ~u : (u | 0x80000000u); }
__device__ __forceinline__ void p_index(float* lds, const Params& p) {
    const bf16_t* QI = (const bf16_t*)(p.ws + WS_QI); const bf16_t* KI = (const bf16_t*)(p.ws + WS_KI); const float* WI = (const float*)(p.ws + WS_WI);
    unsigned* MASK = (unsigned*)(p.ws + WS_MASK);
    float* qs = lds; float* wsc = lds + 1024; float* sc = lds + 1040; int* red = (int*)(lds + 1040 + 4096);
    const int tid = opaque_tid(), lane = tid & 63, wv = tid >> 6;
    for (int t = blockIdx.x; t < T; t += gridDim.x) {
        const int b = t >> 12, ti = t & 4095, nk = ti + 1;
        __syncthreads();
        for (int i = tid; i < 1024; i += NTHREADS) qs[i] = bf2f(QI[(size_t)t * 1024 + i]);
        if (tid < 16) wsc[tid] = WI[(size_t)t * 16 + tid];
        __syncthreads();
        for (int s = tid; s < nk; s += NTHREADS) {
            const bf16_t* kr = KI + (size_t)(b * S + s) * 64;
            float score = 0.f;
#pragma unroll 1
            for (int h = 0; h < 16; ++h) {
                asm volatile("" ::: "memory");
                float dot = 0.f;
#pragma unroll
                for (int c = 0; c < 8; ++c) {
                    const u32x4 raw = *(const u32x4*)(kr + c * 8);
                    const f32x4 q0 = *(const f32x4*)(qs + h * 64 + c * 8), q1 = *(const f32x4*)(qs + h * 64 + c * 8 + 4);
                    dot = fmaf(q0[0], __uint_as_float(raw.x << 16), dot); dot = fmaf(q0[1], __uint_as_float(raw.x & 0xffff0000u), dot);
                    dot = fmaf(q0[2], __uint_as_float(raw.y << 16), dot); dot = fmaf(q0[3], __uint_as_float(raw.y & 0xffff0000u), dot);
                    dot = fmaf(q1[0], __uint_as_float(raw.z << 16), dot); dot = fmaf(q1[1], __uint_as_float(raw.z & 0xffff0000u), dot);
                    dot = fmaf(q1[2], __uint_as_float(raw.w << 16), dot); dot = fmaf(q1[3], __uint_as_float(raw.w & 0xffff0000u), dot);
                }
                score = fmaf(wsc[h], fmaxf(dot, 0.f), score);
            }
            sc[s] = score;
        }
        __syncthreads();
        unsigned k0 = 0u, k1 = 0u, k2 = 0u, k3 = 0u, k4 = 0u, k5 = 0u, k6 = 0u, k7 = 0u;
        if (tid < nk) k0 = f2key(sc[tid]);
        if (tid + 512 < nk) k1 = f2key(sc[tid + 512]);
        if (tid + 1024 < nk) k2 = f2key(sc[tid + 1024]);
        if (tid + 1536 < nk) k3 = f2key(sc[tid + 1536]);
        if (tid + 2048 < nk) k4 = f2key(sc[tid + 2048]);
        if (tid + 2560 < nk) k5 = f2key(sc[tid + 2560]);
        if (tid + 3072 < nk) k6 = f2key(sc[tid + 3072]);
        if (tid + 3584 < nk) k7 = f2key(sc[tid + 3584]);
        unsigned res = 0u;
        if (nk > 256) {
#pragma unroll 1
            for (int bit = 31; bit >= 0; --bit) {
                const unsigned cand = res | (1u << bit);
                const int c = (k0 >= cand) + (k1 >= cand) + (k2 >= cand) + (k3 >= cand) + (k4 >= cand) + (k5 >= cand) + (k6 >= cand) + (k7 >= cand);
                if (block_sum_int(c, red) >= 256) res = cand;
            }
        }
        unsigned* mw = MASK + (size_t)t * 128 + 2 * wv;
#define MASK_OUT(j, kj) do { const unsigned long long bal = __ballot((tid + 512 * (j) < nk) && ((kj) >= res)); if (lane == 0) { mw[16 * (j)] = (unsigned)bal; mw[16 * (j) + 1] = (unsigned)(bal >> 32); } } while (0)
        MASK_OUT(0, k0); MASK_OUT(1, k1); MASK_OUT(2, k2); MASK_OUT(3, k3); MASK_OUT(4, k4); MASK_OUT(5, k5); MASK_OUT(6, k6); MASK_OUT(7, k7);
#undef MASK_OUT
    }
    __syncthreads();
}

typedef short bf16x8 __attribute__((ext_vector_type(8)));
typedef short s16x4 __attribute__((ext_vector_type(4)));
typedef float f32x16 __attribute__((ext_vector_type(16)));
__device__ __forceinline__ void p_score(LAS unsigned char* ldsb, unsigned char* ws) {
    const bf16_t* QI = (const bf16_t*)(ws + WS_QI); const bf16_t* KI = (const bf16_t*)(ws + WS_KI); const float* WI = (const float*)(ws + WS_WI);
    unsigned* SC = (unsigned*)(ws + WS_SCORE);
    const int tid = opaque_tid(), lane = tid & 63, wv = __builtin_amdgcn_readfirstlane(tid >> 6), r32 = lane & 31, hi = lane >> 5;
    const int ksw = ((r32 >> 1) & 7) ^ hi;
    const unsigned krow = (unsigned)(size_t)ldsb + (unsigned)r32 * 128u;
    for (int item = opaque_bid(); item < 544; item += gridDim.x) {
        const int b = item / 272; int r = item - b * 272, qb = 0;
        while (r >= 2 * qb + 2) { r -= 2 * qb + 2; ++qb; }
        const int kc = r, q0 = qb * 256 + wv * 32;
        __builtin_amdgcn_s_barrier();
#pragma unroll
        for (int i = 0; i < 2; ++i) { const int g = i * 512 + tid, row = g >> 3, ch = (g & 7) ^ ((row >> 1) & 7);
            __builtin_amdgcn_global_load_lds((const unsigned*)(KI + (size_t)(b * S + kc * 128 + row) * 64 + ch * 8), (LAS unsigned*)(ldsb + (i * 512 + wv * 64) * 16), 16, 0, 0); }
        asm volatile("s_waitcnt vmcnt(0)" ::: "memory");
        __builtin_amdgcn_s_barrier();
        if (kc * 128 <= q0 + 31) {
            const size_t t = (size_t)b * S + q0 + r32;
            bf16x8 ka[4][4];
#pragma unroll
            for (int kb = 0; kb < 4; ++kb)
#pragma unroll
                for (int d0 = 0; d0 < 4; ++d0) ka[kb][d0] = *(const LAS bf16x8*)(size_t)(krow + kb * 4096 + ((unsigned)((2 * d0) ^ ksw) << 4));
            f32x16 acc[4];
#pragma unroll
            for (int kb = 0; kb < 4; ++kb)
#pragma unroll
                for (int rr = 0; rr < 16; ++rr) acc[kb][rr] = 0.f;
            const bf16_t* qrow = QI + t * 1024 + 8 * hi; const float* wrow = WI + t * 16;
            bf16x8 qf[4]; float wh = wrow[0];
#pragma unroll
            for (int d0 = 0; d0 < 4; ++d0) qf[d0] = *(const bf16x8*)(qrow + 16 * d0);
#pragma unroll 1
            for (int h = 0; h < 16; ++h) {
                const int hn = (h + 1) & 15;
                bf16x8 qn[4]; const float wn = wrow[hn];
#pragma unroll
                for (int d0 = 0; d0 < 4; ++d0) qn[d0] = *(const bf16x8*)(qrow + hn * 64 + 16 * d0);
#pragma unroll
                for (int kb = 0; kb < 4; ++kb) {
                    f32x16 pz;
#pragma unroll
                    for (int rr = 0; rr < 16; ++rr) pz[rr] = 0.f;
#pragma unroll
                    for (int d0 = 0; d0 < 4; ++d0) pz = __builtin_amdgcn_mfma_f32_32x32x16_bf16(ka[kb][d0], qf[d0], pz, 0, 0, 0);
#pragma unroll
                    for (int rr = 0; rr < 16; ++rr) acc[kb][rr] = fmaf(wh, fmaxf(pz[rr], 0.f), acc[kb][rr]);
                }
#pragma unroll
                for (int d0 = 0; d0 < 4; ++d0) qf[d0] = qn[d0];
                wh = wn;
            }
            const int dq = q0 + r32 - kc * 128 - 4 * hi;
            unsigned* srow = SC + t * 4096 + kc * 128 + 4 * hi;
#pragma unroll
            for (int kb = 0; kb < 4; ++kb)
#pragma unroll
                for (int rq = 0; rq < 4; ++rq) { u32x4 o; const int c0 = 32 * kb + 8 * rq;
                    o.x = (c0 <= dq) ? f2key(acc[kb][4 * rq]) : 0u; o.y = (c0 + 1 <= dq) ? f2key(acc[kb][4 * rq + 1]) : 0u;
                    o.z = (c0 + 2 <= dq) ? f2key(acc[kb][4 * rq + 2]) : 0u; o.w = (c0 + 3 <= dq) ? f2key(acc[kb][4 * rq + 3]) : 0u;
                    *(u32x4*)(srow + c0) = o; }
        }
    }
    __builtin_amdgcn_s_barrier();
}
__device__ __forceinline__ void p_select(unsigned char* ws) {
    const unsigned* SC = (const unsigned*)(ws + WS_SCORE); unsigned* MASK = (unsigned*)(ws + WS_MASK);
    const int tid = opaque_tid(), lane = tid & 63, wv = tid >> 6;
    const int tstride = gridDim.x * 8;
#define SEL_LOAD(KK, t_) do { const int ti_ = (t_) & 4095, nq_ = (ti_ >> 8) + 1; const unsigned* row_ = SC + (size_t)(t_) * 4096 + 4 * lane; \
        _Pragma("unroll") for (int j = 0; j < 16; ++j) { KK[j] = (u32x4){0u, 0u, 0u, 0u}; if (j < nq_) KK[j] = *(const u32x4*)(row_ + 256 * j); } } while (0)
    u32x4 k[16], kn[16];
    int t = opaque_bid() * 8 + wv;
    if (t < T) SEL_LOAD(k, t);
    for (; t < T; t += tstride) {
        const int ti = t & 4095, nq = (ti >> 8) + 1;
        if (t + tstride < T) SEL_LOAD(kn, t + tstride);
#pragma unroll
        for (int j = 0; j < 16; ++j) { const int p0 = 256 * j + 4 * lane; if (p0 > ti) k[j].x = 0u; if (p0 + 1 > ti) k[j].y = 0u; if (p0 + 2 > ti) k[j].z = 0u; if (p0 + 3 > ti) k[j].w = 0u; }
        unsigned res = 1u;
        if (ti >= 256) {
            res = 0u;
#pragma unroll 1
            for (int bit = 31; bit >= 0; --bit) {
                const unsigned cand = res | (1u << bit);
                unsigned c = 0u;
#pragma unroll
                for (int g4 = 0; g4 < 4; ++g4) if (4 * g4 < nq) {
#pragma unroll
                    for (int j = 4 * g4; j < 4 * g4 + 4; ++j) c += (unsigned)(k[j].x >= cand) + (unsigned)(k[j].y >= cand) + (unsigned)(k[j].z >= cand) + (unsigned)(k[j].w >= cand); }
                int tot = 0;
#pragma unroll
                for (int b7 = 0; b7 < 7; ++b7) tot += __popcll(__ballot((c >> b7) & 1u)) << b7;
                if (tot >= 256) res = cand;
                if (tot == 256) break;
            }
        }
        unsigned* mrow = MASK + (size_t)t * 128 + (lane >> 3);
#pragma unroll
        for (int j = 0; j < 16; ++j) {
            unsigned nib = (unsigned)(k[j].x >= res) | ((unsigned)(k[j].y >= res) << 1) | ((unsigned)(k[j].z >= res) << 2) | ((unsigned)(k[j].w >= res) << 3);
            nib <<= 4 * (lane & 7);
            nib |= __shfl_xor(nib, 1); nib |= __shfl_xor(nib, 2); nib |= __shfl_xor(nib, 4);
            if ((lane & 7) == 0) mrow[8 * j] = nib;
        }
#pragma unroll
        for (int j = 0; j < 16; ++j) k[j] = kn[j];
    }
#undef SEL_LOAD
}

template <int DQK, bool MASKED>
__device__ __forceinline__ void attn_unit(LAS unsigned char* ldsb, const bf16_t* Qg, int ldq, const bf16_t* Kg, int ldk, const bf16_t* Vg, int ldv, const unsigned* maskg, bf16_t* Og, int ldo, int qb, float sl2) {
    constexpr int CPR = DQK / 8, KBYTES = 64 * DQK * 2, VBYTES = 64 * 128 * 2, NKI = CPR * 64 / 512, ND = DQK / 16;
    constexpr int VOFF = 2 * KBYTES;
    const int tid = opaque_tid(), lane = tid & 63, wv = __builtin_amdgcn_readfirstlane(tid >> 6), r32 = lane & 31, hi = lane >> 5;
    const int NT = 4 * qb + 4, q0 = qb * 256 + wv * 32;
    const float NEG = -__builtin_inff();
    bf16x8 qr[ND];
#pragma unroll
    for (int d0 = 0; d0 < ND; ++d0) qr[d0] = *(const bf16x8*)(Qg + (size_t)(q0 + r32) * ldq + 16 * d0 + 8 * hi);
    const bf16_t* ksrc[NKI]; const bf16_t* vsrc[2];
#pragma unroll
    for (int i = 0; i < NKI; ++i) { const int g = i * 512 + tid, row = g / CPR, cp = g - row * CPR; const int ch = cp ^ (DQK == 128 ? (row & 15) : ((row >> 1) & 7)); ksrc[i] = Kg + (size_t)row * ldk + ch * 8; }
#pragma unroll
    for (int i = 0; i < 2; ++i) { const int g = i * 512 + tid, row = g >> 4, c16 = g & 15; const int blk = (c16 >> 2) ^ (row & 3); vsrc[i] = Vg + (size_t)row * ldv + (blk * 4 + (c16 & 3)) * 8; }
#define AT_STAGE(t_, buf_) do { \
        _Pragma("unroll") for (int i_ = 0; i_ < NKI; ++i_) __builtin_amdgcn_global_load_lds((const unsigned*)(ksrc[i_] + (size_t)(t_) * 64 * ldk), (LAS unsigned*)(ldsb + (buf_) * KBYTES + (i_ * 512 + wv * 64) * 16), 16, 0, 0); \
        _Pragma("unroll") for (int i_ = 0; i_ < 2; ++i_) __builtin_amdgcn_global_load_lds((const unsigned*)(vsrc[i_] + (size_t)(t_) * 64 * ldv), (LAS unsigned*)(ldsb + VOFF + (buf_) * VBYTES + (i_ * 512 + wv * 64) * 16), 16, 0, 0); } while (0)
    const int ksw = (DQK == 128 ? (r32 & 15) : ((r32 >> 1) & 7)) ^ hi;
    const unsigned krow = (unsigned)(size_t)ldsb + (unsigned)r32 * (DQK * 2);
    const int vq = (lane >> 2) & 3, vp = lane & 3, vg = lane >> 4;
    const unsigned vrow = (unsigned)(size_t)ldsb + VOFF + (unsigned)(4 * (vg >> 1) + vq) * 256 + (vg & 1) * 32 + vp * 8;
    float m_run = -1e30f, l_run = 0.f;
    f32x16 oT[4];
#pragma unroll
    for (int d0 = 0; d0 < 4; ++d0)
#pragma unroll
        for (int r = 0; r < 16; ++r) oT[d0][r] = 0.f;
    u32x2 mw_cur = {0u, 0u}, mw_nxt = {0u, 0u};
    const unsigned* mrow = MASKED ? maskg + (size_t)(q0 + r32) * 128 : nullptr;
    if (MASKED) mw_cur = *(const u32x2*)mrow;
    AT_STAGE(0, 0);
    asm volatile("s_waitcnt vmcnt(0)" ::: "memory");
    __builtin_amdgcn_s_barrier();
#define TRRD(dst, addr, off) asm volatile("ds_read_b64_tr_b16 %0, %1 offset:%2" : "=&v"(dst) : "v"(addr), "i"(off) : "memory")
#define AT_STEP(t_, buf_) do { \
        const int t = (t_); \
        if (t + 1 < NT) { if (MASKED) mw_nxt = *(const u32x2*)(mrow + 2 * (t + 1)); AT_STAGE(t + 1, (buf_) ^ 1); } \
        if (t * 64 <= q0 + 31) {                                    \
            int kx = ksw; asm volatile("" : "+v"(kx)); \
            f32x16 p0, p1; \
            _Pragma("unroll") for (int r = 0; r < 16; ++r) { p0[r] = 0.f; p1[r] = 0.f; } \
            _Pragma("unroll") for (int d0 = 0; d0 < ND; ++d0) { \
                const unsigned ka = krow + (buf_) * KBYTES + ((unsigned)((2 * d0) ^ kx) << 4); \
                const bf16x8 a0 = *(const LAS bf16x8*)(size_t)ka; const bf16x8 a1 = *(const LAS bf16x8*)(size_t)(ka + 32 * DQK * 2); \
                p0 = __builtin_amdgcn_mfma_f32_32x32x16_bf16(a0, qr[d0], p0, 0, 0, 0); \
                p1 = __builtin_amdgcn_mfma_f32_32x32x16_bf16(a1, qr[d0], p1, 0, 0, 0); } \
            if (MASKED) { \
                _Pragma("unroll") for (int r = 0; r < 16; ++r) { const int c = (r & 3) + 8 * (r >> 2) + 4 * hi; \
                    if (!((mw_cur.x >> c) & 1u)) p0[r] = NEG; if (!((mw_cur.y >> c) & 1u)) p1[r] = NEG; } \
            } else if (t * 64 + 63 > q0) {                          \
                const int dq = q0 + r32 - t * 64 - 4 * hi; \
                _Pragma("unroll") for (int r = 0; r < 16; ++r) { const int c = (r & 3) + 8 * (r >> 2); if (c > dq) p0[r] = NEG; if (c + 32 > dq) p1[r] = NEG; } \
            } \
            float mx = p0[0]; \
            _Pragma("unroll") for (int r = 1; r < 16; ++r) mx = fmaxf(mx, p0[r]); \
            _Pragma("unroll") for (int r = 0; r < 16; ++r) mx = fmaxf(mx, p1[r]); \
            { auto rr = __builtin_amdgcn_permlane32_swap(__float_as_uint(mx), __float_as_uint(mx), false, false); mx = fmaxf(__uint_as_float(rr[0]), __uint_as_float(rr[1])); } \
            const float mnew = fmaxf(m_run, mx); \
            const float alpha = __builtin_amdgcn_exp2f((m_run - mnew) * sl2); \
            m_run = mnew; const float mb = -mnew * sl2; \
            float ps = 0.f; \
            _Pragma("unroll") for (int r = 0; r < 16; ++r) { p0[r] = __builtin_amdgcn_exp2f(fmaf(p0[r], sl2, mb)); ps += p0[r]; } \
            _Pragma("unroll") for (int r = 0; r < 16; ++r) { p1[r] = __builtin_amdgcn_exp2f(fmaf(p1[r], sl2, mb)); ps += p1[r]; } \
            l_run = l_run * alpha + ps; \
            if (__any(alpha != 1.f)) { \
                _Pragma("unroll") for (int d0 = 0; d0 < 4; ++d0) _Pragma("unroll") for (int r = 0; r < 16; ++r) oT[d0][r] *= alpha; } \
            bf16x8 pb[4];                                            \
            { u32x4 w; \
              w.x = pkbf(p0[0], p0[1]); w.y = pkbf(p0[2], p0[3]); w.z = pkbf(p0[4], p0[5]); w.w = pkbf(p0[6], p0[7]); pb[0] = *reinterpret_cast<bf16x8*>(&w); \
              w.x = pkbf(p0[8], p0[9]); w.y = pkbf(p0[10], p0[11]); w.z = pkbf(p0[12], p0[13]); w.w = pkbf(p0[14], p0[15]); pb[1] = *reinterpret_cast<bf16x8*>(&w); \
              w.x = pkbf(p1[0], p1[1]); w.y = pkbf(p1[2], p1[3]); w.z = pkbf(p1[4], p1[5]); w.w = pkbf(p1[6], p1[7]); pb[2] = *reinterpret_cast<bf16x8*>(&w); \
              w.x = pkbf(p1[8], p1[9]); w.y = pkbf(p1[10], p1[11]); w.z = pkbf(p1[12], p1[13]); w.w = pkbf(p1[14], p1[15]); pb[3] = *reinterpret_cast<bf16x8*>(&w); } \
            int vx = vq; asm volatile("" : "+v"(vx)); \
            _Pragma("unroll") for (int d0 = 0; d0 < 4; ++d0) { \
                const unsigned va = vrow + (buf_) * VBYTES + ((unsigned)(d0 ^ vx) << 6); \
                s16x4 l0, h0, l1, h1, l2, h2, l3, h3; \
                TRRD(l0, va, 0); TRRD(h0, va, 2048); TRRD(l1, va, 4096); TRRD(h1, va, 6144); TRRD(l2, va, 8192); TRRD(h2, va, 10240); TRRD(l3, va, 12288); TRRD(h3, va, 14336); \
                asm volatile("s_waitcnt lgkmcnt(0)" ::: "memory"); __builtin_amdgcn_sched_barrier(0); \
                oT[d0] = __builtin_amdgcn_mfma_f32_32x32x16_bf16((bf16x8){l0[0], l0[1], l0[2], l0[3], h0[0], h0[1], h0[2], h0[3]}, pb[0], oT[d0], 0, 0, 0); \
                oT[d0] = __builtin_amdgcn_mfma_f32_32x32x16_bf16((bf16x8){l1[0], l1[1], l1[2], l1[3], h1[0], h1[1], h1[2], h1[3]}, pb[1], oT[d0], 0, 0, 0); \
                oT[d0] = __builtin_amdgcn_mfma_f32_32x32x16_bf16((bf16x8){l2[0], l2[1], l2[2], l2[3], h2[0], h2[1], h2[2], h2[3]}, pb[2], oT[d0], 0, 0, 0); \
                oT[d0] = __builtin_amdgcn_mfma_f32_32x32x16_bf16((bf16x8){l3[0], l3[1], l3[2], l3[3], h3[0], h3[1], h3[2], h3[3]}, pb[3], oT[d0], 0, 0, 0); } \
        } \
        if (MASKED) mw_cur = mw_nxt; \
        asm volatile("s_waitcnt vmcnt(0)" ::: "memory"); \
        asm volatile("s_waitcnt lgkmcnt(0)" ::: "memory"); \
        __builtin_amdgcn_s_barrier(); } while (0)
    for (int tt = 0; tt < NT; tt += 2) { AT_STEP(tt, 0); AT_STEP(tt + 1, 1); }
#undef AT_STEP
#undef AT_STAGE
#undef TRRD
    { auto rr = __builtin_amdgcn_permlane32_swap(__float_as_uint(l_run), __float_as_uint(l_run), false, false); l_run = __uint_as_float(rr[0]) + __uint_as_float(rr[1]); }
    const float inv = 1.f / l_run;
    bf16_t* orow = Og + (size_t)(q0 + r32) * ldo + 4 * hi;
#pragma unroll
    for (int d0 = 0; d0 < 4; ++d0)
#pragma unroll
        for (int rq = 0; rq < 4; ++rq) { u32x2 w; w.x = pkbf(oT[d0][4 * rq] * inv, oT[d0][4 * rq + 1] * inv); w.y = pkbf(oT[d0][4 * rq + 2] * inv, oT[d0][4 * rq + 3] * inv);
            *(u32x2*)(orow + 32 * d0 + 8 * rq) = w; }
}
__device__ __forceinline__ void p_attn(LAS unsigned char* ldsb, unsigned char* ws) {
    const bf16_t* QA = (const bf16_t*)(ws + WS_QA); const bf16_t* KA = (const bf16_t*)(ws + WS_KA); const bf16_t* VA = (const bf16_t*)(ws + WS_VA); bf16_t* OA = (bf16_t*)(ws + WS_OA);
    const bf16_t* QB = (const bf16_t*)(ws + WS_QB); const bf16_t* KB = (const bf16_t*)(ws + WS_KB); const bf16_t* VB = (const bf16_t*)(ws + WS_VB); bf16_t* OB = (bf16_t*)(ws + WS_OB);
    const unsigned* MASK = (const unsigned*)(ws + WS_MASK);
    for (int w = opaque_bid(); w < 256; w += gridDim.x) {
        const int bh = (w & 7) * 2 + ((w >> 3) & 1), i = w >> 4, b = bh >> 3, h = bh & 7;
        const size_t r0 = (size_t)b * S;
        attn_unit<192, false>(ldsb, QA + r0 * 1536 + h * 192, 1536, KA + r0 * 1536 + h * 192, 1536, VA + r0 * 1024 + h * 128, 1024, nullptr, OA + r0 * 1024 + h * 128, 1024, i, 0.07216878364870322f * 1.4426950408889634f);
        attn_unit<128, true>(ldsb, QB + r0 * 1024 + h * 128, 1024, KB + r0 * 1024 + h * 128, 1024, VB + r0 * 1024 + h * 128, 1024, MASK + r0 * 128, OB + r0 * 1024 + h * 128, 1024, 15 - i, 0.08838834764831845f * 1.4426950408889634f);
    }
}

template <int DQK, bool MASKED>
__device__ __forceinline__ void nattn(float* lds, const bf16_t* Q, const bf16_t* Kp, int ldk, const bf16_t* Vp, const unsigned* mask, bf16_t* O, float scale) {
    float* qs = lds; float* scb = lds + 8 * 192;
    const int tid = opaque_tid(), lane = tid & 63, h = tid >> 6;
    float* sc = scb + h * 4096;
    for (int t = blockIdx.x; t < T; t += gridDim.x) {
        const int b = t >> 12, ti = t & 4095, nk = ti + 1;
        __syncthreads();
        for (int i = tid; i < 8 * DQK; i += NTHREADS) qs[i] = bf2f(Q[(size_t)t * (8 * DQK) + i]);
        __syncthreads();
        const float* q = qs + h * DQK;
        float mx = -__builtin_inff();
        for (int s0 = 0; s0 < nk; s0 += 64) {
            const int s = s0 + lane; float v = -__builtin_inff();
            bool on = s < nk;
            if (MASKED && on) on = (mask[(size_t)t * 128 + (s >> 5)] >> (s & 31)) & 1u;
            if (on) {
                const bf16_t* kr = Kp + (size_t)(b * S + s) * ldk + h * DQK;
                float dot = 0.f;
#pragma unroll 4
                for (int c = 0; c < DQK / 8; ++c) { const u32x4 raw = *(const u32x4*)(kr + c * 8); const unsigned w[4] = {raw.x, raw.y, raw.z, raw.w};
#pragma unroll
                    for (int j = 0; j < 4; ++j) { dot = fmaf(q[c * 8 + 2 * j], __uint_as_float(w[j] << 16), dot); dot = fmaf(q[c * 8 + 2 * j + 1], __uint_as_float(w[j] & 0xffff0000u), dot); } }
                v = dot * scale;
            }
            if (s < nk) sc[s] = v;
            mx = fmaxf(mx, v);
        }
        mx = wave_max(mx);
        __syncthreads();
        float sum = 0.f;
        for (int s = lane; s < nk; s += 64) { const float pz = __expf(sc[s] - mx); sc[s] = pz; sum += pz; }
        sum = wave_sum(sum);
        __syncthreads();
        float a0 = 0.f, a1 = 0.f;
        const bf16_t* vb = Vp + (size_t)(b * S) * 1024 + h * 128 + lane * 2;
        for (int s = 0; s < nk; ++s) {
            const float pz = sc[s];
            if (pz != 0.f) { const unsigned w = *(const unsigned*)(vb + (size_t)s * 1024); a0 = fmaf(pz, __uint_as_float(w << 16), a0); a1 = fmaf(pz, __uint_as_float(w & 0xffff0000u), a1); }
        }
        const float inv = 1.f / sum;
        *(unsigned*)(O + (size_t)t * 1024 + h * 128 + lane * 2) = pk2(a0 * inv, a1 * inv);
    }
    __syncthreads();
}

__device__ __forceinline__ void p_ln1_route(float* lds, const Params& p, int l) {
    const float* V1 = (const float*)(p.ws + WS_V1); float* H1F = (float*)(p.ws + WS_H1F); bf16_t* H1B = (bf16_t*)(p.ws + WS_H1B);
    unsigned* cnt = (unsigned*)(p.ws + WS_CNT) + l * 64; int* LIST = (int*)(p.ws + WS_LIST);
    int* TOKE = (int*)(p.ws + WS_TOKE); float* TOKW = (float*)(p.ws + WS_TOKW); int* TOKS = (int*)(p.ws + WS_TOKS);
    const float* g = p.ln1g + (size_t)l * D; const float* bb = p.ln1b + (size_t)l * D;
    const float* wr = p.w_router + (size_t)l * D * 64; const float* wg = p.w_group + (size_t)l * D * 8;
    const float* br = p.b_router + l * 64; const float* bg = p.b_group + l * 8;
    const int tid = opaque_tid(), lane = tid & 63, wv = tid >> 6;
    float* lg = lds + wv * 80;
    for (int t0 = blockIdx.x * 8; t0 < T; t0 += gridDim.x * 8) {
        const int t = t0 + wv;
        float s1 = 0.f;
#pragma unroll 4
        for (int j = 0; j < 32; ++j) s1 += V1[(size_t)t * D + lane + 64 * j];
        const float mean = wave_sum(s1) * (1.f / D);
        float s2 = 0.f;
#pragma unroll 4
        for (int j = 0; j < 32; ++j) { const float d = V1[(size_t)t * D + lane + 64 * j] - mean; s2 += d * d; }
        const float rstd = rsqrtf(wave_sum(s2) * (1.f / D) + 1e-5f);
        float acc[72];
#pragma unroll
        for (int e = 0; e < 72; ++e) acc[e] = 0.f;
#pragma unroll 1
        for (int j = 0; j < 32; ++j) {
            const int k = lane + 64 * j;
            const float hk = (V1[(size_t)t * D + k] - mean) * rstd * g[k] + bb[k];
            H1F[(size_t)t * D + k] = hk; H1B[(size_t)t * D + k] = f2bf(hk);
            const float* wrow = wr + (size_t)k * 64;
#pragma unroll
            for (int e4 = 0; e4 < 16; ++e4) { const f32x4 w = *(const f32x4*)(wrow + e4 * 4);
                acc[e4 * 4] = fmaf(hk, w[0], acc[e4 * 4]); acc[e4 * 4 + 1] = fmaf(hk, w[1], acc[e4 * 4 + 1]); acc[e4 * 4 + 2] = fmaf(hk, w[2], acc[e4 * 4 + 2]); acc[e4 * 4 + 3] = fmaf(hk, w[3], acc[e4 * 4 + 3]); }
            const float* grow = wg + (size_t)k * 8;
            const f32x4 w0 = *(const f32x4*)grow, w1 = *(const f32x4*)(grow + 4);
            acc[64] = fmaf(hk, w0[0], acc[64]); acc[65] = fmaf(hk, w0[1], acc[65]); acc[66] = fmaf(hk, w0[2], acc[66]); acc[67] = fmaf(hk, w0[3], acc[67]);
            acc[68] = fmaf(hk, w1[0], acc[68]); acc[69] = fmaf(hk, w1[1], acc[69]); acc[70] = fmaf(hk, w1[2], acc[70]); acc[71] = fmaf(hk, w1[3], acc[71]);
        }
#pragma unroll
        for (int e = 0; e < 72; ++e) { const float r = wave_sum(acc[e]); if (lane == 0) lg[e] = r; }
        __syncthreads();
        if (lane == 0) {
            float gl[8]; float gmax = -__builtin_inff(); int gi = 0;
#pragma unroll
            for (int i = 0; i < 8; ++i) { gl[i] = lg[64 + i] + bg[i]; if (gl[i] > gmax) { gmax = gl[i]; gi = i; } }
            float gs = 0.f;
#pragma unroll
            for (int i = 0; i < 8; ++i) gs += __expf(gl[i] - gmax);
            const float gp = 1.f / gs;
            float el[8]; float emax = -__builtin_inff(); int e1 = 0;
#pragma unroll
            for (int i = 0; i < 8; ++i) { el[i] = lg[gi * 8 + i] + br[gi * 8 + i]; if (el[i] > emax) { emax = el[i]; e1 = i; } }
            float e2max = -__builtin_inff(); int e2 = 0;
#pragma unroll
            for (int i = 0; i < 8; ++i) { if (i != e1 && el[i] > e2max) { e2max = el[i]; e2 = i; } }
            const float p1 = 1.f, p2 = __expf(e2max - emax);
            const float wa = gp * p1 / (p1 + p2), wb = gp * p2 / (p1 + p2);
            const int ea = gi * 8 + e1, eb = gi * 8 + e2;
            const int sa = (int)atomicAdd(cnt + ea, 1u), sb = (int)atomicAdd(cnt + eb, 1u);
            LIST[(size_t)ea * ECAP + sa] = t; LIST[(size_t)eb * ECAP + sb] = t;
            TOKE[t * 2] = ea; TOKE[t * 2 + 1] = eb; TOKW[t * 2] = wa; TOKW[t * 2 + 1] = wb; TOKS[t * 2] = sa; TOKS[t * 2 + 1] = sb;
        }
        __syncthreads();
    }
}

__device__ __forceinline__ void moe_tables(int* tab, const unsigned* cnt, int items_per_rb) {
    if (threadIdx.x == 0) { int a = 0, bsum = 0; for (int e = 0; e < 64; ++e) { tab[e] = a; tab[80 + e] = bsum; const int c = (int)cnt[e]; a += ((c + 127) / 128) * items_per_rb; bsum += ((c + 255) / 256) * 256; } tab[64] = a; tab[80 + 64] = bsum; }
    __syncthreads();
}
__device__ __forceinline__ void p_moe1(float* lds, const Params& p, int l) {
    const unsigned* cnt = (const unsigned*)(p.ws + WS_CNT) + l * 64; const int* LIST = (const int*)(p.ws + WS_LIST);
    const bf16_t* H1B = (const bf16_t*)(p.ws + WS_H1B); bf16_t* HID = (bf16_t*)(p.ws + WS_HID);
    float* As = lds; float* Wg = lds + 32 * 132; float* Wu = Wg + 32 * 64; int* tab = (int*)(Wu + 32 * 64);
    __syncthreads();
    moe_tables(tab, cnt, 8);
    const int tid = opaque_tid(), ty = tid >> 4, tx = tid & 15;
    const int total = tab[64];
    for (int item = opaque_bid(); item < total; item += gridDim.x) {
        int e = 0; while (tab[e + 1] <= item) ++e;
        const int local = item - tab[e], rb = local >> 3, ct = local & 7, ce = (int)cnt[e], base = tab[80 + e];
        const float* wgp = p.w_eg + ((size_t)(l * 64 + e) * D) * FE + ct * 64;
        const float* wup = p.w_eu + ((size_t)(l * 64 + e) * D) * FE + ct * 64;
        const f32x4 z4 = {0.f, 0.f, 0.f, 0.f};
        f32x4 ag0 = z4, ag1 = z4, ag2 = z4, ag3 = z4, au0 = z4, au1 = z4, au2 = z4, au3 = z4;
        const int ar = tid >> 2, akq = (tid & 3) * 8, wk = tid >> 4, wn4 = (tid & 15) * 4;
        const int ai = rb * 128 + ar; const int tok = ai < ce ? LIST[(size_t)e * ECAP + ai] : -1;
        const bf16_t* ap = H1B + (size_t)(tok < 0 ? 0 : tok) * D + akq;
        for (int k0 = 0; k0 < D; k0 += 32) {
            __syncthreads();
            { u32x4 raw = *(const u32x4*)(ap + k0); if (tok < 0) raw = (u32x4){0u, 0u, 0u, 0u};
              float* dst = As + akq * 132 + ar;
              dst[0 * 132] = __uint_as_float(raw.x << 16); dst[1 * 132] = __uint_as_float(raw.x & 0xffff0000u); dst[2 * 132] = __uint_as_float(raw.y << 16); dst[3 * 132] = __uint_as_float(raw.y & 0xffff0000u);
              dst[4 * 132] = __uint_as_float(raw.z << 16); dst[5 * 132] = __uint_as_float(raw.z & 0xffff0000u); dst[6 * 132] = __uint_as_float(raw.w << 16); dst[7 * 132] = __uint_as_float(raw.w & 0xffff0000u); }
            *(f32x4*)(Wg + wk * 64 + wn4) = *(const f32x4*)(wgp + (size_t)(k0 + wk) * FE + wn4);
            *(f32x4*)(Wu + wk * 64 + wn4) = *(const f32x4*)(wup + (size_t)(k0 + wk) * FE + wn4);
            __syncthreads();
#pragma unroll 4
            for (int kk = 0; kk < 32; ++kk) {
                const f32x4 a = *(const f32x4*)(As + kk * 132 + ty * 4);
                const f32x4 g4 = *(const f32x4*)(Wg + kk * 64 + tx * 4);
                const f32x4 u4 = *(const f32x4*)(Wu + kk * 64 + tx * 4);
                ag0 += a[0] * g4; ag1 += a[1] * g4; ag2 += a[2] * g4; ag3 += a[3] * g4;
                au0 += a[0] * u4; au1 += a[1] * u4; au2 += a[2] * u4; au3 += a[3] * u4;
            }
        }
#define MOE1_OUT(i, G_, U_) do { const int ri = rb * 128 + ty * 4 + (i); if (ri < ce) { f32x4 o; \
            o[0] = G_[0] / (1.f + __expf(-G_[0])) * U_[0]; o[1] = G_[1] / (1.f + __expf(-G_[1])) * U_[1]; o[2] = G_[2] / (1.f + __expf(-G_[2])) * U_[2]; o[3] = G_[3] / (1.f + __expf(-G_[3])) * U_[3]; \
            st4bf(HID + (size_t)(base + ri) * FE + ct * 64 + tx * 4, o); } } while (0)
        MOE1_OUT(0, ag0, au0); MOE1_OUT(1, ag1, au1); MOE1_OUT(2, ag2, au2); MOE1_OUT(3, ag3, au3);
#undef MOE1_OUT
    }
    __syncthreads();
}
__device__ __forceinline__ void p_moe2(float* lds, const Params& p, int l) {
    const unsigned* cnt = (const unsigned*)(p.ws + WS_CNT) + l * 64;
    const bf16_t* HID = (const bf16_t*)(p.ws + WS_HID); bf16_t* YE = (bf16_t*)(p.ws + WS_YE);
    float* As = lds; float* Ws = lds + 32 * 132; int* tab = (int*)(Ws + 32 * 64 * 2);
    __syncthreads();
    moe_tables(tab, cnt, 32);
    const int tid = opaque_tid(), ty = tid >> 4, tx = tid & 15;
    const int total = tab[64];
    for (int item = opaque_bid(); item < total; item += gridDim.x) {
        int e = 0; while (tab[e + 1] <= item) ++e;
        const int local = item - tab[e], rb = local >> 5, ct = local & 31, ce = (int)cnt[e], base = tab[80 + e];
        const float* wdp = p.w_ed + ((size_t)(l * 64 + e) * FE) * D + ct * 64;
        f32x4 acc0 = {0.f, 0.f, 0.f, 0.f}, acc1 = acc0, acc2 = acc0, acc3 = acc0;
        const int ar = tid >> 2, akq = (tid & 3) * 8, wk = tid >> 4, wn4 = (tid & 15) * 4;
        const int ai = rb * 128 + ar; const bool av = ai < ce;
        const bf16_t* ap = HID + (size_t)(base + (av ? ai : 0)) * FE + akq;
        for (int k0 = 0; k0 < FE; k0 += 32) {
            __syncthreads();
            { u32x4 raw = *(const u32x4*)(ap + k0); if (!av) raw = (u32x4){0u, 0u, 0u, 0u};
              float* dst = As + akq * 132 + ar;
              dst[0 * 132] = __uint_as_float(raw.x << 16); dst[1 * 132] = __uint_as_float(raw.x & 0xffff0000u); dst[2 * 132] = __uint_as_float(raw.y << 16); dst[3 * 132] = __uint_as_float(raw.y & 0xffff0000u);
              dst[4 * 132] = __uint_as_float(raw.z << 16); dst[5 * 132] = __uint_as_float(raw.z & 0xffff0000u); dst[6 * 132] = __uint_as_float(raw.w << 16); dst[7 * 132] = __uint_as_float(raw.w & 0xffff0000u); }
            *(f32x4*)(Ws + wk * 64 + wn4) = *(const f32x4*)(wdp + (size_t)(k0 + wk) * D + wn4);
            __syncthreads();
#pragma unroll 8
            for (int kk = 0; kk < 32; ++kk) {
                const f32x4 a = *(const f32x4*)(As + kk * 132 + ty * 4);
                const f32x4 w = *(const f32x4*)(Ws + kk * 64 + tx * 4);
                acc0 += a[0] * w; acc1 += a[1] * w; acc2 += a[2] * w; acc3 += a[3] * w;
            }
        }
        { const int ri = rb * 128 + ty * 4; bf16_t* yo = YE + (size_t)(base + ri) * D + ct * 64 + tx * 4;
          if (ri < ce) st4bf(yo, acc0); if (ri + 1 < ce) st4bf(yo + D, acc1); if (ri + 2 < ce) st4bf(yo + 2 * D, acc2); if (ri + 3 < ce) st4bf(yo + 3 * D, acc3); }
    }
    __syncthreads();
}
__device__ __forceinline__ void moe_tables256(int* tab, const unsigned* cnt, int ncol_tiles) {
    const int tid_ = opaque_tid();
    if (tid_ == 0) { int a = 0, bsum = 0; for (int e = 0; e < 64; ++e) { tab[e] = a; tab[80 + e] = bsum; const int c = (int)cnt[e], nrb = (c + 319) / 320; tab[160 + e] = nrb; a += nrb * ncol_tiles; bsum += nrb * 320; } tab[64] = a; tab[80 + 64] = bsum; }
    if (tid_ >= 64 && tid_ < 128) {
        const int e = tid_ - 64; const unsigned c = cnt[e]; int rank = 0;
        for (int o = 0; o < 64; ++o) { const unsigned co = cnt[o]; rank += (co > c || (co == c && o < e)) ? 1 : 0; }
        tab[240 + rank] = e; }
    __syncthreads();
}
__device__ __forceinline__ void p_ln1_route2(LAS unsigned char* ldsb, unsigned char* ws, const float* g, const float* bb, const float* wr, const float* wg, const float* br, const float* bg, int l, bool route) {
    const float* V1 = (const float*)(ws + WS_V1); float* H1F = (float*)(ws + WS_H1F); bf16_t* H1B = (bf16_t*)(ws + WS_H1B);
    unsigned* cnt = (unsigned*)(ws + WS_CNT) + l * 64; int* LIST = (int*)(ws + WS_LIST);
    int* TOKE = (int*)(ws + WS_TOKE); float* TOKW = (float*)(ws + WS_TOKW); int* TOKS = (int*)(ws + WS_TOKS);
    const int tid = opaque_tid(), lane = tid & 63, wv = __builtin_amdgcn_readfirstlane(tid >> 6);
    LAS float* red = (LAS float*)ldsb;
    for (int unit = opaque_bid(); unit < T / 32; unit += gridDim.x) {
        const int t0 = unit * 32;
#pragma unroll 1
        for (int i = 0; i < 4; ++i) {
            const size_t ro = (size_t)(t0 + 4 * wv + i) * D + 4 * lane;
            f32x4 v[8]; float s1 = 0.f;
#pragma unroll
            for (int j = 0; j < 8; ++j) { v[j] = *(const f32x4*)(V1 + ro + 256 * j); s1 += (v[j][0] + v[j][1]) + (v[j][2] + v[j][3]); }
            const float mean = wave_sum(s1) * (1.f / D); float s2 = 0.f;
#pragma unroll
            for (int j = 0; j < 8; ++j) { v[j] = v[j] - mean; s2 += (v[j][0] * v[j][0] + v[j][1] * v[j][1]) + (v[j][2] * v[j][2] + v[j][3] * v[j][3]); }
            const float rstd = rsqrtf(wave_sum(s2) * (1.f / D) + 1e-5f);
#pragma unroll
            for (int j = 0; j < 8; ++j) { const f32x4 gg = *(const f32x4*)(g + 4 * lane + 256 * j), b4 = *(const f32x4*)(bb + 4 * lane + 256 * j);
                const f32x4 h = v[j] * rstd * gg + b4;
                *(f32x4*)(H1F + ro + 256 * j) = h; st4bf(H1B + ro + 256 * j, h); }
        }
        asm volatile("s_waitcnt vmcnt(0)" ::: "memory");
        __syncthreads();
        {
            f32x16 c0, c1, c2;
#pragma unroll
            for (int r = 0; r < 16; ++r) { c0[r] = 0.f; c1[r] = 0.f; c2[r] = 0.f; }
            const int j = lane & 31, kh = lane >> 5, kb = 256 * wv + 4 * kh;
            const float* hp = H1F + (size_t)(t0 + j) * D + kb;
            const float* wrp = wr + (size_t)kb * 64 + j;
            const float* wgp = wg + (size_t)kb * 8 + (j & 7);
            const bool gcol = j < 8;
#pragma unroll 2
            for (int it = 0; it < 32; ++it) {
                const f32x4 a = *(const f32x4*)(hp + 8 * it);
#pragma unroll
                for (int sidx = 0; sidx < 4; ++sidx) {
                    const float b0 = wrp[(size_t)(8 * it + sidx) * 64], b1 = wrp[(size_t)(8 * it + sidx) * 64 + 32];
                    float b2 = wgp[(size_t)(8 * it + sidx) * 8]; b2 = gcol ? b2 : 0.f;
                    c0 = __builtin_amdgcn_mfma_f32_32x32x2f32(a[sidx], b0, c0, 0, 0, 0);
                    c1 = __builtin_amdgcn_mfma_f32_32x32x2f32(a[sidx], b1, c1, 0, 0, 0);
                    c2 = __builtin_amdgcn_mfma_f32_32x32x2f32(a[sidx], b2, c2, 0, 0, 0);
                }
            }
#pragma unroll
            for (int r = 0; r < 16; ++r) { const int tr = (r & 3) + 8 * (r >> 2) + 4 * kh; LAS float* o = red + (wv * 32 + tr) * 96 + j; o[0] = c0[r]; o[32] = c1[r]; o[64] = c2[r]; }
        }
        __syncthreads();
        for (int idx = tid; idx < 32 * 72; idx += NTHREADS) { const int tk = idx / 72, c = idx - tk * 72;
            float sacc = 0.f;
#pragma unroll
            for (int w = 0; w < 8; ++w) sacc += red[(w * 32 + tk) * 96 + c];
            red[tk * 96 + c] = sacc; }
        __syncthreads();
        if (route && tid < 32) {
            const int t = t0 + tid; const LAS float* lg = red + tid * 96;
            float gl[8]; float gmax = -__builtin_inff(); int gi = 0;
#pragma unroll
            for (int i = 0; i < 8; ++i) { gl[i] = lg[64 + i] + bg[i]; if (gl[i] > gmax) { gmax = gl[i]; gi = i; } }
            float gs = 0.f;
#pragma unroll
            for (int i = 0; i < 8; ++i) gs += __expf(gl[i] - gmax);
            const float gp = 1.f / gs;
            float el[8]; float emax = -__builtin_inff(); int e1 = 0;
#pragma unroll
            for (int i = 0; i < 8; ++i) { el[i] = lg[gi * 8 + i] + br[gi * 8 + i]; if (el[i] > emax) { emax = el[i]; e1 = i; } }
            float e2max = -__builtin_inff(); int e2 = 0;
#pragma unroll
            for (int i = 0; i < 8; ++i) { if (i != e1 && el[i] > e2max) { e2max = el[i]; e2 = i; } }
            const float p2 = __expf(e2max - emax);
            const float wa = gp / (1.f + p2), wb = gp * p2 / (1.f + p2);
            const int ea = gi * 8 + e1, eb = gi * 8 + e2;
            const int sa = (int)atomicAdd(cnt + ea, 1u), sb = (int)atomicAdd(cnt + eb, 1u);
            LIST[(size_t)ea * ECAP + sa] = t; LIST[(size_t)eb * ECAP + sb] = t;
            TOKE[t * 2] = ea; TOKE[t * 2 + 1] = eb; TOKW[t * 2] = wa; TOKW[t * 2 + 1] = wb; TOKS[t * 2] = sa; TOKS[t * 2 + 1] = sb;
        }
        __syncthreads();
    }
}
__device__ __forceinline__ void p_ln2v2(LAS unsigned char* ldsb, unsigned char* ws, const float* g, const float* bb, float* outF, int l) {
    const unsigned* cnt = (const unsigned*)(ws + WS_CNT) + l * 64;
    const float* H1F = (const float*)(ws + WS_H1F); const bf16_t* YE = (const bf16_t*)(ws + WS_YE);
    const int* TOKE = (const int*)(ws + WS_TOKE); const float* TOKW = (const float*)(ws + WS_TOKW); const int* TOKS = (const int*)(ws + WS_TOKS);
    bf16_t* XB = (bf16_t*)(ws + WS_XB);
    int* tab = (int*)(unsigned char*)ldsb;
    __syncthreads();
    moe_tables256(tab, cnt, 1);
    const int tid = opaque_tid(), lane = tid & 63, wv = tid >> 6;
    for (int t = opaque_bid() * 8 + wv; t < T; t += gridDim.x * 8) {
        const int r0 = tab[80 + TOKE[t * 2]] + TOKS[t * 2], r1 = tab[80 + TOKE[t * 2 + 1]] + TOKS[t * 2 + 1];
        const float w0 = TOKW[t * 2], w1 = TOKW[t * 2 + 1];
        const size_t ro = (size_t)t * D + 4 * lane;
        f32x4 v[8]; float s1 = 0.f;
#pragma unroll
        for (int j = 0; j < 8; ++j) { const f32x4 h = *(const f32x4*)(H1F + ro + 256 * j);
            const f32x4 y0 = bf4(*(const u32x2*)(YE + (size_t)r0 * D + 4 * lane + 256 * j)), y1 = bf4(*(const u32x2*)(YE + (size_t)r1 * D + 4 * lane + 256 * j));
            v[j] = h * ALPHA + y0 * w0 + y1 * w1; s1 += (v[j][0] + v[j][1]) + (v[j][2] + v[j][3]); }
        const float mean = wave_sum(s1) * (1.f / D); float s2 = 0.f;
#pragma unroll
        for (int j = 0; j < 8; ++j) { v[j] = v[j] - mean; s2 += (v[j][0] * v[j][0] + v[j][1] * v[j][1]) + (v[j][2] * v[j][2] + v[j][3] * v[j][3]); }
        const float rstd = rsqrtf(wave_sum(s2) * (1.f / D) + 1e-5f);
#pragma unroll
        for (int j = 0; j < 8; ++j) { const f32x4 gg = *(const f32x4*)(g + 4 * lane + 256 * j), b4 = *(const f32x4*)(bb + 4 * lane + 256 * j);
            const f32x4 o = v[j] * rstd * gg + b4;
            *(f32x4*)(outF + ro + 256 * j) = o; if (l != DEPTH - 1) st4bf(XB + ro + 256 * j, o); }
    }
    __syncthreads();
}

template <bool GATED>
__device__ __forceinline__ void moe_gemm(LAS unsigned char* ldsb, const int* tab, const unsigned* cnt, const int* LIST, const bf16_t* Asrc, const float* W0, const float* W1, bf16_t* Out) {
    constexpr int K = GATED ? D : FE, NT = K / 64, NCT = GATED ? FE / 64 : D / 128, LDW = GATED ? FE : D, LDO = GATED ? FE : D;
    constexpr int RBLK = 320, MT = 5, NAG = RBLK * 8 / 512;
    constexpr int ABYTES = RBLK * 128, BOFF = 2 * ABYTES, BBYTES = 64 * 256;
    const int tid = opaque_tid(), lane = tid & 63, wv = __builtin_amdgcn_readfirstlane(tid >> 6), wm = wv >> 1, wn = wv & 1, l15 = lane & 15, kq = lane >> 4;
    const unsigned lbase = (unsigned)(size_t)ldsb;
    const int arow = wm * (16 * MT) + l15;
    const unsigned afr = lbase + (unsigned)arow * 128u; const int asw = ((arow >> 1) & 7) ^ kq;
    const int bq = (lane >> 2) & 3, bp = lane & 3, bkey = bq | ((kq & 1) << 2);
    const unsigned bfr = lbase + BOFF + (unsigned)(8 * kq + bq) * 256u + 8u * bp;
    unsigned bb[4];
#pragma unroll
    for (int j = 0; j < 4; ++j) { const int np = GATED ? ((j >> 1) * 4 + 2 * wn + (j & 1)) : (4 * wn + j); bb[j] = bfr + ((unsigned)(np ^ bkey) << 5); }
    const int sa_r = tid >> 3, sa_c = tid & 7;
    const int sb_k = tid >> 5, sb_n = 4 * (tid & 31);
    const int G = gridDim.x;
    for (int i0 = opaque_bid(); i0 < 64 * NCT; i0 += G) {
      const int rnd = i0 / G, pos = i0 - rnd * G; int slot = rnd * G + ((rnd & 1) ? (G - 1 - pos) : pos); if (slot >= 64 * NCT) slot = i0;
      const int e = tab[240 + slot / NCT], ct = slot % NCT;
      const int ce = (int)cnt[e], base = tab[80 + e], nrb = tab[160 + e];
#pragma unroll 1
      for (int rb = 0; rb < nrb; ++rb) {
        unsigned aoff[NAG];
#pragma unroll
        for (int i = 0; i < NAG; ++i) { const int r = rb * RBLK + i * 64 + sa_r;
            const int ch = sa_c ^ (((i * 64 + sa_r) >> 1) & 7);
            if (GATED) { const int tok = r < ce ? LIST[(size_t)e * ECAP + r] : 0; aoff[i] = (unsigned)tok * (unsigned)(K * 2) + ch * 16; }
            else aoff[i] = (unsigned)(base + r) * (unsigned)(K * 2) + ch * 16; }
        const float* wp = (GATED ? (sb_n < 64 ? W0 : W1) : W0) + (size_t)e * K * LDW + (size_t)sb_k * LDW + (GATED ? ct * 64 + (sb_n & 63) : ct * 128 + sb_n);
        f32x4 acc[MT][4];
#pragma unroll
        for (int m = 0; m < MT; ++m)
#pragma unroll
            for (int n = 0; n < 4; ++n) acc[m][n] = (f32x4){0.f, 0.f, 0.f, 0.f};
        f32x4 rb0[4], rb1[4];
#define MG_DMA_A(t_, buf_) do { _Pragma("unroll") for (int i = 0; i < NAG; ++i) \
            __builtin_amdgcn_global_load_lds((const unsigned*)((const unsigned char*)Asrc + aoff[i] + (t_) * 128), (LAS unsigned*)(ldsb + (buf_) * ABYTES + (i * 512 + wv * 64) * 16), 16, 0, 0); } while (0)
#define MG_LOAD_B(RB, t_) do { _Pragma("unroll") for (int i = 0; i < 4; ++i) asm volatile("global_load_dwordx4 %0, %1, off" : "=v"(RB[i]) : "v"(wp + (size_t)((t_) * 64 + 16 * i) * LDW) : "memory"); } while (0)
#define MG_WAIT_ALL(n_) asm volatile("s_waitcnt vmcnt(" #n_ ")" : "+v"(rb0[0]), "+v"(rb0[1]), "+v"(rb0[2]), "+v"(rb0[3]), "+v"(rb1[0]), "+v"(rb1[1]), "+v"(rb1[2]), "+v"(rb1[3]) :: "memory")
#define MG_WRITE_B(RB, buf_) do { _Pragma("unroll") for (int i = 0; i < 4; ++i) { const int k = sb_k + 16 * i; u32x2 w; w.x = pkbf(RB[i][0], RB[i][1]); w.y = pkbf(RB[i][2], RB[i][3]); \
            *(LAS u32x2*)(ldsb + BOFF + (buf_) * BBYTES + k * 256 + ((((sb_n >> 4) ^ ((k & 3) | (((k >> 3) & 1) << 2)))) << 5) + (sb_n & 15) * 2) = w; } } while (0)
#define TRRD(dst, addr, off) asm volatile("ds_read_b64_tr_b16 %0, %1 offset:%2" : "=&v"(dst) : "v"(addr), "i"(off) : "memory")
#define MG_COMPUTE(buf_) do { \
            _Pragma("unroll") for (int kk = 0; kk < 2; ++kk) { \
                s16x4 b0l, b0h, b1l, b1h, b2l, b2h, b3l, b3h; \
                TRRD(b0l, bb[0], (buf_) * BBYTES + kk * 8192); TRRD(b0h, bb[0], (buf_) * BBYTES + kk * 8192 + 1024); \
                TRRD(b1l, bb[1], (buf_) * BBYTES + kk * 8192); TRRD(b1h, bb[1], (buf_) * BBYTES + kk * 8192 + 1024); \
                TRRD(b2l, bb[2], (buf_) * BBYTES + kk * 8192); TRRD(b2h, bb[2], (buf_) * BBYTES + kk * 8192 + 1024); \
                TRRD(b3l, bb[3], (buf_) * BBYTES + kk * 8192); TRRD(b3h, bb[3], (buf_) * BBYTES + kk * 8192 + 1024); \
                asm volatile("s_waitcnt lgkmcnt(0)" ::: "memory"); __builtin_amdgcn_sched_barrier(0); \
                const bf16x8 bf0 = {b0l[0], b0l[1], b0l[2], b0l[3], b0h[0], b0h[1], b0h[2], b0h[3]}, bf1 = {b1l[0], b1l[1], b1l[2], b1l[3], b1h[0], b1h[1], b1h[2], b1h[3]}; \
                const bf16x8 bf2 = {b2l[0], b2l[1], b2l[2], b2l[3], b2h[0], b2h[1], b2h[2], b2h[3]}, bf3 = {b3l[0], b3l[1], b3l[2], b3l[3], b3h[0], b3h[1], b3h[2], b3h[3]}; \
                _Pragma("unroll") for (int m = 0; m < MT; ++m) { \
                    const bf16x8 af = *(const LAS bf16x8*)(size_t)(afr + (buf_) * ABYTES + m * 2048 + ((unsigned)((4 * kk) ^ asw) << 4)); \
                    acc[m][0] = __builtin_amdgcn_mfma_f32_16x16x32_bf16(af, bf0, acc[m][0], 0, 0, 0); acc[m][1] = __builtin_amdgcn_mfma_f32_16x16x32_bf16(af, bf1, acc[m][1], 0, 0, 0); \
                    acc[m][2] = __builtin_amdgcn_mfma_f32_16x16x32_bf16(af, bf2, acc[m][2], 0, 0, 0); acc[m][3] = __builtin_amdgcn_mfma_f32_16x16x32_bf16(af, bf3, acc[m][3], 0, 0, 0); } } } while (0)
        asm volatile("s_waitcnt lgkmcnt(0)" ::: "memory");
        __builtin_amdgcn_s_barrier();
        MG_DMA_A(0, 0); MG_LOAD_B(rb0, 0); MG_LOAD_B(rb1, 1);
        MG_WAIT_ALL(4);
        MG_WRITE_B(rb0, 0);
        asm volatile("s_waitcnt lgkmcnt(0)" ::: "memory");
        __builtin_amdgcn_s_barrier();
#pragma unroll 1
        for (int t = 0; t < NT; t += 2) {
            MG_DMA_A(t + 1, 1);
            { const int tb = (t + 2 < NT) ? t + 2 : NT - 1; MG_LOAD_B(rb0, tb); }
            MG_COMPUTE(0);
            MG_WAIT_ALL(4);
            MG_WRITE_B(rb1, 1);
            asm volatile("s_waitcnt lgkmcnt(0)" ::: "memory");
            __builtin_amdgcn_s_barrier();
            if (t + 2 < NT) { MG_DMA_A(t + 2, 0); }
            { const int tb = (t + 3 < NT) ? t + 3 : NT - 1; MG_LOAD_B(rb1, tb); }
            MG_COMPUTE(1);
            MG_WAIT_ALL(4);
            if (t + 2 < NT) { MG_WRITE_B(rb0, 0); }
            asm volatile("s_waitcnt lgkmcnt(0)" ::: "memory");
            __builtin_amdgcn_s_barrier();
        }
        MG_WAIT_ALL(0);
#undef MG_WAIT_ALL
#undef MG_DMA_A
#undef MG_LOAD_B
#undef MG_WRITE_B
#undef MG_COMPUTE
#undef TRRD
#pragma unroll
        for (int m = 0; m < MT; ++m)
#pragma unroll
            for (int g = 0; g < 4; ++g) {
                const int r = rb * RBLK + wm * (16 * MT) + 16 * m + 4 * kq + g;
                if (r < ce) {
                    if (GATED) {
#pragma unroll
                        for (int j = 0; j < 2; ++j) { const float gv = acc[m][j][g], uv = acc[m][2 + j][g];
                            Out[(size_t)(base + r) * LDO + ct * 64 + 32 * wn + 16 * j + l15] = f2bf(gv / (1.f + __expf(-gv)) * uv); }
                    } else {
#pragma unroll
                        for (int n = 0; n < 4; ++n) Out[(size_t)(base + r) * LDO + ct * 128 + 64 * wn + 16 * n + l15] = f2bf(acc[m][n][g]);
                    }
                }
            }
      }
    }
    __syncthreads();
}
__device__ __forceinline__ void p_moe1_mfma(LAS unsigned char* ldsb, unsigned char* ws, const float* w_eg, const float* w_eu, int l) {
    const unsigned* cnt = (const unsigned*)(ws + WS_CNT) + l * 64;
    int* tab = (int*)((unsigned char*)ldsb + 132 * 1024);
    __syncthreads();
    moe_tables256(tab, cnt, FE / 64);
    moe_gemm<true>(ldsb, tab, cnt, (const int*)(ws + WS_LIST), (const bf16_t*)(ws + WS_H1B), w_eg + (size_t)l * NE * D * FE, w_eu + (size_t)l * NE * D * FE, (bf16_t*)(ws + WS_HID));
}
__device__ __forceinline__ void p_moe2_mfma(LAS unsigned char* ldsb, unsigned char* ws, const float* w_ed, int l) {
    const unsigned* cnt = (const unsigned*)(ws + WS_CNT) + l * 64;
    int* tab = (int*)((unsigned char*)ldsb + 132 * 1024);
    __syncthreads();
    moe_tables256(tab, cnt, D / 128);
    moe_gemm<false>(ldsb, tab, cnt, nullptr, (const bf16_t*)(ws + WS_HID), w_ed + (size_t)l * NE * FE * D, nullptr, (bf16_t*)(ws + WS_YE));
}

__device__ __forceinline__ void p_ln2(float* lds, const Params& p, int l) {
    const unsigned* cnt = (const unsigned*)(p.ws + WS_CNT) + l * 64;
    const float* H1F = (const float*)(p.ws + WS_H1F); const bf16_t* YE = (const bf16_t*)(p.ws + WS_YE);
    const int* TOKE = (const int*)(p.ws + WS_TOKE); const float* TOKW = (const float*)(p.ws + WS_TOKW); const int* TOKS = (const int*)(p.ws + WS_TOKS);
    float* outF = (l == DEPTH - 1) ? p.out : (float*)(p.ws + WS_H2F); bf16_t* XB = (bf16_t*)(p.ws + WS_XB);
    const float* g = p.ln2g + (size_t)l * D; const float* bb = p.ln2b + (size_t)l * D;
    int* tab = (int*)lds;
    __syncthreads();
    moe_tables(tab, cnt, 1);
    const int tid = opaque_tid(), lane = tid & 63, wv = tid >> 6;
    for (int t0 = blockIdx.x * 8; t0 < T; t0 += gridDim.x * 8) {
        const int t = t0 + wv;
        const int r0 = tab[80 + TOKE[t * 2]] + TOKS[t * 2], r1 = tab[80 + TOKE[t * 2 + 1]] + TOKS[t * 2 + 1];
        const float w0 = TOKW[t * 2], w1 = TOKW[t * 2 + 1];
        const float* hrow = H1F + (size_t)t * D; const bf16_t* y0 = YE + (size_t)r0 * D; const bf16_t* y1 = YE + (size_t)r1 * D;
        float s1 = 0.f;
#pragma unroll 4
        for (int j = 0; j < 32; ++j) { const int k = lane + 64 * j; s1 += ALPHA * hrow[k] + w0 * bf2f(y0[k]) + w1 * bf2f(y1[k]); }
        const float mean = wave_sum(s1) * (1.f / D);
        float s2 = 0.f;
#pragma unroll 4
        for (int j = 0; j < 32; ++j) { const int k = lane + 64 * j; const float d = ALPHA * hrow[k] + w0 * bf2f(y0[k]) + w1 * bf2f(y1[k]) - mean; s2 += d * d; }
        const float rstd = rsqrtf(wave_sum(s2) * (1.f / D) + 1e-5f);
#pragma unroll 4
        for (int j = 0; j < 32; ++j) { const int k = lane + 64 * j; const float v = ALPHA * hrow[k] + w0 * bf2f(y0[k]) + w1 * bf2f(y1[k]);
            const float o = (v - mean) * rstd * g[k] + bb[k];
            outF[(size_t)t * D + k] = o; if (l != DEPTH - 1) XB[(size_t)t * D + k] = f2bf(o); }
    }
    __syncthreads();
}

constexpr int NPH = 10;
#ifndef PH_MASK
#define PH_MASK 0x7ff
#endif
#define PHON(k) ((PH_MASK >> (k)) & 1)
#ifndef REP_PHASE
#define REP_PHASE -1
#endif
#define REPS(k) for (int rep_ = 0; rep_ < ((REP_PHASE == (k)) ? 2 : 1); ++rep_)
typedef const Params __attribute__((address_space(4))) CParams;
#define KP(field) ({ CParams* _k = kp; asm volatile("" : "+s"(_k)); _k->field; })
__global__ void __launch_bounds__(NTHREADS, 2) hybrid_fwd(Params p_unused, int ph_lo, int ph_hi) {
    extern __shared__ __attribute__((aligned(16))) unsigned char lds_raw[];
    float* lds = (float*)lds_raw;
    LAS unsigned char* ldsb = (LAS unsigned char*)lds_raw;
    CParams* kp = (CParams*)__builtin_amdgcn_kernarg_segment_ptr();
    unsigned char* const ws0 = KP(ws);
    volatile LAS unsigned* xbw = (volatile LAS unsigned*)(lds_raw + LDS_BYTES - 16);
    if (threadIdx.x == 0) { xbw[0] = 0u; xbw[1] = 0u; xbw[2] = 0u; xbw[3] = 0u; }
    __syncthreads();
    XcdBarrier bar; bar.bar = (unsigned*)(ws0 + WS_BAR); bar.x = 0; bar.st = xbw;
    if (ph_lo < ph_hi) bar = xcd_barrier_post((unsigned*)(ws0 + WS_BAR), xbw);
#define IN(ph) ((ph) >= ph_lo && (ph) <= ph_hi)
#define GRID_BAR(ph) do { if ((ph) >= ph_lo && (ph) < ph_hi) xcd_barrier(bar); } while (0)
    if (PHON(0) && IN(0)) REPS(0) { unsigned char* ws = ws0; asm volatile("" : "+s"(ws)); { Params q; q.ws = ws; q.x = KP(x); q.pos = KP(pos); q.w_in = KP(w_in); q.g_q = KP(g_q); q.w_qb = KP(w_qb); q.g_kv = KP(g_kv); q.w_kvb = KP(w_kvb);
        q.w_oa = KP(w_oa); q.w_ob = KP(w_ob); q.w_out = KP(w_out); p_prologue(ldsb, q); } }
    GRID_BAR(0);
    for (int l = 0; l < DEPTH; ++l) {
        const int pb = l * NPH;
        if (PHON(1) && IN(pb + 1)) REPS(1) { unsigned char* ws = ws0; asm volatile("" : "+s"(ws));
            EpiIn E; E.ws = ws;
            pg8::Gemm g{(const bf16_t*)(ws + WS_XB), (const bf16_t*)(ws + WS_WIN_T) + (size_t)l * INP * D, T, INP, D}; pg8::StaticOrder SO; SO.init(T, INP, (int)gridDim.x, opaque_bid());
            pg8::gemm_phase<EpiIn, pg8::StaticOrder, true, true>(ldsb, g, SO, E);
        }
        GRID_BAR(pb + 1);
        if (PHON(2) && IN(pb + 2)) REPS(2) { unsigned char* ws = ws0; asm volatile("" : "+s"(ws));
            { EpiQA E; E.ws = ws;
              pg8::Gemm g{(const bf16_t*)(ws + WS_CQ), (const bf16_t*)(ws + WS_WQB_T) + (size_t)l * 1536 * 512, T, 1536, 512}; pg8::StaticOrder SO; SO.init(T, 1536, (int)gridDim.x, opaque_bid());
              pg8::gemm_phase<EpiQA, pg8::StaticOrder, true, true>(ldsb, g, SO, E); }
            { EpiKV E; E.ws = ws;
              pg8::Gemm g{(const bf16_t*)(ws + WS_CKV), (const bf16_t*)(ws + WS_WKVB_T) + (size_t)l * 2048 * 512, T, 2048, 512}; pg8::StaticOrder SO; SO.init(T, 2048, (int)gridDim.x, opaque_bid());
              pg8::gemm_phase<EpiKV, pg8::StaticOrder, true, true>(ldsb, g, SO, E); }
            REPS(12) p_score(ldsb, ws);
        }
        GRID_BAR(pb + 2);
        if (PHON(3) && IN(pb + 3)) REPS(3) { unsigned char* ws = ws0; asm volatile("" : "+s"(ws)); p_select(ws); }
        GRID_BAR(pb + 3);
        if (PHON(4) && IN(pb + 4)) REPS(4) { unsigned char* ws = ws0; asm volatile("" : "+s"(ws));
            p_attn(ldsb, ws);
        }
        GRID_BAR(pb + 4);
        if (PHON(5) && IN(pb + 5)) REPS(5) { unsigned char* ws = ws0; asm volatile("" : "+s"(ws));
            pg8::StaticOrder SO; SO.init(T, D, (int)gridDim.x, opaque_bid());
            { EpiYA E; E.ws = ws;
              pg8::Gemm g{(const bf16_t*)(ws + WS_OA), (const bf16_t*)(ws + WS_WOA_T) + (size_t)l * D * 1024, T, D, 1024};
              pg8::gemm_phase<EpiYA, pg8::StaticOrder, true, true>(ldsb, g, SO, E); }
            { EpiYB E; E.ws = ws;
              pg8::Gemm g{(const bf16_t*)(ws + WS_OB), (const bf16_t*)(ws + WS_WOB_T) + (size_t)l * D * 1024, T, D, 1024};
              pg8::gemm_phase<EpiYB, pg8::StaticOrder, true, true>(ldsb, g, SO, E); }
        }
        GRID_BAR(pb + 5);
        if (PHON(6) && IN(pb + 6)) REPS(6) { unsigned char* ws = ws0; asm volatile("" : "+s"(ws));
            EpiOut E; E.hin = (l == 0) ? KP(x) : (const float*)(ws + WS_H2F); E.V1 = (float*)(ws + WS_V1);
            pg8::Gemm g{(const bf16_t*)(ws + WS_Y), (const bf16_t*)(ws + WS_WOUT_T) + (size_t)l * D * D, T, D, D}; pg8::StaticOrder SO; SO.init(T, D, (int)gridDim.x, opaque_bid());
            pg8::gemm_phase<EpiOut, pg8::StaticOrder, true, true>(ldsb, g, SO, E);
        }
        GRID_BAR(pb + 6);
        if (PHON(7) && IN(pb + 7)) REPS(7) { unsigned char* ws = ws0; asm volatile("" : "+s"(ws)); p_ln1_route2(ldsb, ws, KP(ln1g) + (size_t)l * D, KP(ln1b) + (size_t)l * D, KP(w_router) + (size_t)l * D * 64, KP(w_group) + (size_t)l * D * 8, KP(b_router) + l * 64, KP(b_group) + l * 8, l, true);
            if (REP_PHASE == 13) p_ln1_route2(ldsb, ws, KP(ln1g) + (size_t)l * D, KP(ln1b) + (size_t)l * D, KP(w_router) + (size_t)l * D * 64, KP(w_group) + (size_t)l * D * 8, KP(b_router) + l * 64, KP(b_group) + l * 8, l, false); }
        GRID_BAR(pb + 7);
        if (PHON(8) && IN(pb + 8)) REPS(8) { unsigned char* ws = ws0; asm volatile("" : "+s"(ws)); p_moe1_mfma(ldsb, ws, KP(w_eg), KP(w_eu), l); }
        GRID_BAR(pb + 8);
        if (PHON(9) && IN(pb + 9)) REPS(9) { unsigned char* ws = ws0; asm volatile("" : "+s"(ws)); p_moe2_mfma(ldsb, ws, KP(w_ed), l); }
        GRID_BAR(pb + 9);
        if (PHON(10) && IN(pb + 10)) REPS(10) { unsigned char* ws = ws0; asm volatile("" : "+s"(ws)); p_ln2v2(ldsb, ws, KP(ln2g) + (size_t)l * D, KP(ln2b) + (size_t)l * D, (l == DEPTH - 1) ? KP(out) : (float*)(ws + WS_H2F), l); }
        GRID_BAR(pb + 10);
    }
}

#ifndef MK_ONE_LAUNCH
#define MK_ONE_LAUNCH 1
#endif
extern "C" void kernel_launch(void* const* d_in, const int* in_sizes, int n_in, void* d_out, int out_size, void* d_ws, size_t ws_size, hipStream_t stream) {
    static int grid = 0;
    if (!grid) {
        if (n_in != 21 || in_sizes[0] != T * D || out_size != T * D || ws_size < WS_END) {
            fprintf(stderr, "kernel_launch: unexpected shapes (n_in %d, in0 %d, out %d, ws %zu, need %zu); nothing launched\n", n_in, n_in > 0 ? in_sizes[0] : -1, out_size, ws_size, (size_t)WS_END);
            grid = -1; return; }
        int dev = 0, cus = 0, per_cu = 0;
        hipGetDevice(&dev); hipDeviceGetAttribute(&cus, hipDeviceAttributeMultiprocessorCount, dev);
        if (hipFuncSetAttribute((const void*)hybrid_fwd, hipFuncAttributeMaxDynamicSharedMemorySize, LDS_BYTES) != hipSuccess) { fprintf(stderr, "kernel_launch: hipFuncSetAttribute failed\n"); grid = -1; return; }
        hipOccupancyMaxActiveBlocksPerMultiprocessor(&per_cu, (const void*)hybrid_fwd, NTHREADS, LDS_BYTES);
        if (per_cu < 1) fprintf(stderr, "kernel_launch: occupancy query reports %d blocks per CU\n", per_cu);
        grid = cus > 0 ? cus : 256;
    }
    if (grid < 0) return;
    hipMemsetAsync((char*)d_ws, 0, WS_CTL_END, stream);
    Params p{};
    p.x = (const float*)d_in[0]; p.pos = (const int*)d_in[1];
    p.w_in = (const float*)d_in[2]; p.g_q = (const float*)d_in[3]; p.w_qb = (const float*)d_in[4]; p.g_kv = (const float*)d_in[5]; p.w_kvb = (const float*)d_in[6];
    p.w_oa = (const float*)d_in[7]; p.w_ob = (const float*)d_in[8]; p.w_out = (const float*)d_in[9]; p.ln1g = (const float*)d_in[10]; p.ln1b = (const float*)d_in[11];
    p.w_group = (const float*)d_in[12]; p.b_group = (const float*)d_in[13]; p.w_router = (const float*)d_in[14]; p.b_router = (const float*)d_in[15];
    p.w_eg = (const float*)d_in[16]; p.w_eu = (const float*)d_in[17]; p.w_ed = (const float*)d_in[18]; p.ln2g = (const float*)d_in[19]; p.ln2b = (const float*)d_in[20];
    p.out = (float*)d_out; p.ws = (unsigned char*)d_ws;
#if MK_ONE_LAUNCH
    hipLaunchKernelGGL(hybrid_fwd, dim3(grid), dim3(NTHREADS), LDS_BYTES, stream, p, 0, DEPTH * NPH);
#else
    for (int ph = 0; ph <= DEPTH * NPH; ++ph) hipLaunchKernelGGL(hybrid_fwd, dim3(grid), dim3(NTHREADS), LDS_BYTES, stream, p, ph, ph);
#endif
}
```

```cpp
#include <hip/hip_runtime.h>
#include <cstdio>
#include <cstdint>

typedef unsigned short bf16_t;
typedef float f32x4 __attribute__((ext_vector_type(4)));
typedef unsigned u32x4 __attribute__((ext_vector_type(4)));
typedef unsigned u32x2 __attribute__((ext_vector_type(2)));

constexpr int T = 8192, D = 2048, S = 4096, NB = 2, DEPTH = 2;
constexpr int INW = 9360, INP = 9472;
constexpr int NE = 64, FE = 512;
constexpr int NTHREADS = 512;
constexpr int LDS_BYTES = 147456;
constexpr float ALPHA = 1.41421356237309515f;
constexpr int ECAP = 8192;
#ifndef MOE_RBLK
#define MOE_RBLK 384
#endif
constexpr int PMAX = 40960;

constexpr size_t al256(size_t x) { return (x + 255) & ~(size_t)255; }
constexpr size_t XCD_BAR_BYTES = 16384;
constexpr size_t WS_BAR = 0;
constexpr size_t WS_CNT = WS_BAR + XCD_BAR_BYTES;
constexpr size_t WS_CTL_END = WS_CNT + al256(DEPTH * 64 * 4);
constexpr size_t WS_SSQ = WS_CTL_END;
constexpr size_t WS_ROPE = WS_SSQ + al256((size_t)T * 32 * 4);
constexpr size_t WS_XB = WS_ROPE + al256((size_t)T * 112 * 4);
constexpr size_t WS_H2F = WS_XB + al256((size_t)T * D * 2);
constexpr size_t WS_CQ = WS_H2F + al256((size_t)T * D * 4);
constexpr size_t WS_CKV = WS_CQ + al256((size_t)T * 512 * 2);
constexpr size_t WS_QB = WS_CKV + al256((size_t)T * 512 * 2);
constexpr size_t WS_KB = WS_QB + al256((size_t)T * 1024 * 2);
constexpr size_t WS_VB = WS_KB + al256((size_t)T * 1024 * 2);
constexpr size_t WS_QI = WS_VB + al256((size_t)T * 1024 * 2);
constexpr size_t WS_KI = WS_QI + al256((size_t)T * 1024 * 2);
constexpr size_t WS_WI = WS_KI + al256((size_t)T * 64 * 2);
constexpr size_t WS_GA = WS_WI + al256((size_t)T * 16 * 4);
constexpr size_t WS_GB = WS_GA + al256((size_t)T * D * 2);
constexpr size_t WS_QA = WS_GB + al256((size_t)T * D * 2);
constexpr size_t WS_KA = WS_QA + al256((size_t)T * 1536 * 2);
constexpr size_t WS_VA = WS_KA + al256((size_t)T * 1536 * 2);
constexpr size_t WS_MASK = WS_VA + al256((size_t)T * 1024 * 2);
constexpr size_t WS_OA = WS_MASK + al256((size_t)T * 128 * 4);
constexpr size_t WS_OB = WS_OA + al256((size_t)T * 1024 * 2);
constexpr size_t WS_YT = WS_OB + al256((size_t)T * 1024 * 2);
constexpr size_t WS_Y = WS_YT + al256((size_t)T * D * 4);
constexpr size_t WS_V1 = WS_Y + al256((size_t)T * D * 2);
constexpr size_t WS_H1F = WS_V1 + al256((size_t)T * D * 4);
constexpr size_t WS_H1B = WS_H1F + al256((size_t)T * D * 4);
constexpr size_t WS_TOKE = WS_H1B + al256((size_t)T * D * 2);
constexpr size_t WS_TOKW = WS_TOKE + al256((size_t)T * 2 * 4);
constexpr size_t WS_TOKS = WS_TOKW + al256((size_t)T * 2 * 4);
constexpr size_t WS_LIST = WS_TOKS + al256((size_t)T * 2 * 4);
constexpr size_t WS_HID = WS_LIST + al256((size_t)NE * ECAP * 4);
constexpr size_t WS_YE = WS_HID + al256((size_t)PMAX * FE * 2);
constexpr size_t WS_RWS = WS_YE + al256((size_t)PMAX * D * 2);
constexpr size_t WS_GWS = WS_RWS + al256((size_t)DEPTH * D * 64 * 4);
constexpr size_t WS_SEC = WS_GWS + al256((size_t)DEPTH * D * 8 * 4);
constexpr size_t WS_RWH = WS_SEC + al256((size_t)DEPTH * 160 * 4);
constexpr size_t WS_RWL = WS_RWH + al256((size_t)DEPTH * 96 * D * 2);
constexpr size_t WS_STATS = WS_RWL + al256((size_t)DEPTH * 96 * D * 2);
constexpr size_t WS_SCORE = WS_STATS + al256((size_t)T * 2 * 4);
constexpr size_t WS_WIN_T = WS_SCORE + al256((size_t)T * 4096 * 4);
constexpr size_t WS_WQB_T = WS_WIN_T + al256((size_t)DEPTH * INP * D * 2);
constexpr size_t WS_WKVB_T = WS_WQB_T + al256((size_t)DEPTH * 1536 * 512 * 2);
constexpr size_t WS_WOA_T = WS_WKVB_T + al256((size_t)DEPTH * 2048 * 512 * 2);
constexpr size_t WS_WOB_T = WS_WOA_T + al256((size_t)DEPTH * D * 1024 * 2);
constexpr size_t WS_WOUT_T = WS_WOB_T + al256((size_t)DEPTH * D * 1024 * 2);
constexpr size_t WS_END = WS_WOUT_T + al256((size_t)DEPTH * D * D * 2);
static_assert(WS_CKV == WS_CQ + (size_t)T * 512 * 2, "CQ|CKV must be consecutive");

static_assert(WS_KB == WS_QB + (size_t)T * 1024 * 2 && WS_VB == WS_KB + (size_t)T * 1024 * 2 && WS_GB == WS_GA + (size_t)T * D * 2, "QB|KB|VB and GA|GB must be consecutive");
struct Params {
    const float* x; const int* pos;
    const float *w_in, *g_q, *w_qb, *g_kv, *w_kvb, *w_oa, *w_ob, *w_out, *ln1g, *ln1b, *w_group, *b_group, *w_router, *b_router, *w_eg, *w_eu, *w_ed, *ln2g, *ln2b;
    float* out; unsigned char* ws;
};

__device__ __forceinline__ float bf2f(bf16_t v) { return __uint_as_float((unsigned)v << 16); }
__device__ __forceinline__ bf16_t f2bf(float f) { unsigned u = __float_as_uint(f); u += 0x7fffu + ((u >> 16) & 1u); return (bf16_t)(u >> 16); }
__device__ __forceinline__ unsigned pk2(float a, float b) { return (unsigned)f2bf(a) | ((unsigned)f2bf(b) << 16); }
__device__ __forceinline__ void st4bf(bf16_t* p, f32x4 v) { u32x2 w; w.x = pk2(v[0], v[1]); w.y = pk2(v[2], v[3]); *(u32x2*)p = w; }
__device__ __forceinline__ float wave_sum(float v) {
#pragma unroll
    for (int o = 32; o >= 1; o >>= 1) v += __shfl_xor(v, o);
    return v;
}
__device__ __forceinline__ float wave_max(float v) {
#pragma unroll
    for (int o = 32; o >= 1; o >>= 1) v = fmaxf(v, __shfl_xor(v, o));
    return v;
}
__device__ __forceinline__ int block_sum_int(int v, int* red) {
#pragma unroll
    for (int o = 32; o >= 1; o >>= 1) v += __shfl_xor(v, o);
    if ((threadIdx.x & 63) == 0) red[threadIdx.x >> 6] = v;
    __syncthreads();
    int t = 0;
#pragma unroll
    for (int i = 0; i < 8; ++i) t += red[i];
    __syncthreads();
    return t;
}
__device__ __forceinline__ f32x4 rot4(f32x4 v, float c0, float s0, float c1, float s1) { f32x4 o; o[0] = v[0] * c0 - v[1] * s0; o[1] = v[1] * c0 + v[0] * s0; o[2] = v[2] * c1 - v[3] * s1; o[3] = v[3] * c1 + v[2] * s1; return o; }

#define XB_TMO      128
#define XB_XCNT(j)  (256  + 64 * (j))
#define XB_XSUB(j)  (1280 + 64 * (j))
#define XB_XGEN(j)  (2304 + 64 * (j))
#define XB_TOP      3328
#define XB_TOPGEN   3392
#define XCD_BAR_WORDS 3456
#define XB_SPIN_CAP (1u << 22)
#define LAS __attribute__((address_space(3)))
__device__ __forceinline__ unsigned xb_ld(unsigned* p)              { return __hip_atomic_load(p, __ATOMIC_RELAXED, __HIP_MEMORY_SCOPE_AGENT); }
__device__ __forceinline__ unsigned xb_add(unsigned* p, unsigned v) { return __hip_atomic_fetch_add(p, v, __ATOMIC_RELAXED, __HIP_MEMORY_SCOPE_AGENT); }
__device__ __forceinline__ unsigned xb_xcc_id() { return (unsigned)__builtin_amdgcn_s_getreg((3 << 11) | 20) & 0xFu; }
#define XB_SPIN(cond, bar) do { unsigned _sp = 0; while (cond) { __builtin_amdgcn_s_sleep(1); \
    if ((++_sp & 255u) == 0u) { if (xb_ld(&(bar)[XB_TMO])) break; if (_sp > XB_SPIN_CAP) { atomicAdd(&(bar)[XB_TMO], 1u); break; } } } } while (0)
struct XcdBarrier { unsigned* bar; unsigned x; volatile LAS unsigned* st; };
__device__ __forceinline__ XcdBarrier xcd_barrier_post(unsigned* bar, volatile LAS unsigned* st) {
    XcdBarrier b; b.bar = bar; b.x = xb_xcc_id(); b.st = st;
    if (threadIdx.x == 0) (void)xb_add(&bar[XB_XCNT(b.x)], 1u);
    return b;
}
__device__ __forceinline__ void xcd_barrier_complete(unsigned* bar, unsigned x, unsigned& nloc, unsigned& nx) {
    const unsigned G = gridDim.x * gridDim.y * gridDim.z;
    unsigned sum, cnt, mine, sp = 0u;
    for (;;) {
        sum = 0u; cnt = 0u; mine = 0u;
#pragma unroll
        for (unsigned j = 0; j < 16; ++j) { const unsigned c = xb_ld(&bar[XB_XCNT(j)]); sum += c; cnt += (c > 0u) ? 1u : 0u; mine = (j == x) ? c : mine; }
        if (sum == G) break;
        __builtin_amdgcn_s_sleep(1);
        if ((++sp & 255u) == 0u) { if (xb_ld(&bar[XB_TMO])) break; if (sp > XB_SPIN_CAP) { atomicAdd(&bar[XB_TMO], 1u); break; } }
    }
    nloc = mine > 0u ? mine : 1u; nx = cnt > 0u ? cnt : 1u;
}
__device__ __forceinline__ void xcd_barrier(const XcdBarrier& b) {
    asm volatile("s_waitcnt vmcnt(0)" ::: "memory");
    __syncthreads();
    if (threadIdx.x == 0) {
        unsigned* bar = b.bar; asm volatile("" : "+s"(bar));
        __builtin_amdgcn_s_waitcnt(0);
        unsigned nloc = b.st[0], nx = b.st[1];
        unsigned bx = b.x; asm volatile("" : "+s"(bx));
        if (nloc == 0u) { xcd_barrier_complete(bar, bx, nloc, nx); b.st[0] = nloc; b.st[1] = nx; }
        const unsigned old = xb_add(&bar[XB_XSUB(bx)], 1u);
        const unsigned gen = old / nloc;
        if (old + 1u == (gen + 1u) * nloc) {
            __builtin_amdgcn_fence(__ATOMIC_RELEASE, "agent");
            asm volatile("s_waitcnt vmcnt(0)" ::: "memory");
            const unsigned og = xb_add(&bar[XB_TOP], 1u);
            const unsigned tg = og / nx;
            if (og + 1u == (tg + 1u) * nx) xb_add(&bar[XB_TOPGEN], 1u);
            else XB_SPIN(xb_ld(&bar[XB_TOPGEN]) == tg, bar);
            __builtin_amdgcn_fence(__ATOMIC_ACQUIRE, "agent");
            xb_add(&bar[XB_XGEN(bx)], 1u);
            asm volatile("s_waitcnt vmcnt(0)" ::: "memory");
        } else {
            XB_SPIN(xb_ld(&bar[XB_XGEN(bx)]) == gen, bar);
            __builtin_amdgcn_fence(__ATOMIC_ACQUIRE, "agent");
            asm volatile("s_waitcnt vmcnt(0)" ::: "memory");
        }
    }
    __syncthreads();
}

__device__ __forceinline__ int opaque_tid() { int t = threadIdx.x; asm volatile("" : "+v"(t)); return t; }
__device__ __forceinline__ int opaque_bid() { int b = blockIdx.x; asm volatile("" : "+s"(b)); return b; }
namespace pg8 {
#define PG8_LAS __attribute__((address_space(3)))
typedef unsigned short bf16_t;
typedef short bf16x8 __attribute__((ext_vector_type(8)));
typedef float f32x4 __attribute__((ext_vector_type(4)));
typedef unsigned u32x4 __attribute__((ext_vector_type(4)));
constexpr int BM = 256, BK = 64, HALF = 128, HTB = HALF * BK * 2  , STAGE_BYTES = 8 * HTB, NXCD = 8, WGM = 8;

__host__ __device__ __forceinline__ int lds_byte(int r, int c) { const int st = (r >> 4) * 2 + (c >> 5), rr = r & 15, cc = c & 31, ob = rr * 64 + cc * 2; return st * 1024 + (ob ^ (((ob >> 9) & 1) << 5)); }
__host__ __device__ __forceinline__ void stage_rc(int b, int& R, int& C) { const int st = b / 1024, sb = b % 1024, swz = sb ^ (((sb >> 9) & 1) << 5); R = (st >> 1) * 16 + swz / 64; C = (st & 1) * 32 + (swz % 64) / 2; }
__host__ __device__ __forceinline__ int perm32(int rho) { const int n = rho >> 4, i = rho & 15; return 8 * (i >> 2) + 4 * n + (i & 3); }

struct Unit { int pm, pn; };
struct Gemm { const bf16_t* A; const bf16_t* Bt; int M, N, K; };

struct StaticOrder {
    int nM, nN, nwg, G, c;
    __host__ __device__ void init(int M, int N, int G_, int c_) { nM = M / BM; nN = N / BM; nwg = nM * nN; G = G_; c = c_; }
    __host__ __device__ bool next(int i, Unit& u) const {
        const long L = (long)i * G + c; if (L >= nwg) return false;
        int wgid = (int)L; { const int q = nwg / NXCD, r = nwg % NXCD, xcd = wgid % NXCD, off = wgid / NXCD; wgid = (xcd < r ? xcd * (q + 1) : r * (q + 1) + (xcd - r) * q) + off; }
        const int nig = WGM * nN, gid = wgid / nig, fm = gid * WGM, gsz = (nM - fm) < WGM ? (nM - fm) : WGM;
        u.pm = fm + ((wgid % nig) % gsz); u.pn = (wgid % nig) / gsz; return true;
    }
    __device__ __forceinline__ void a_ready(const Unit&) const {}
    __device__ __forceinline__ void done(const Unit&) const {}
};

__device__ __forceinline__ unsigned cvt_pk_bf16(float lo, float hi) { unsigned r; asm volatile("v_cvt_pk_bf16_f32 %0, %1, %2" : "=v"(r) : "v"(lo), "v"(hi)); return r; }
template <class Epi, class Sched, bool ALIGN_EPI = false, bool SP2 = false>
__device__ __forceinline__ void gemm_phase(PG8_LAS unsigned char* lds, const Gemm g, const Sched& S, const Epi& E) {
    const int tid = opaque_tid(), wid = __builtin_amdgcn_readfirstlane(tid >> 6), lane = tid & 63, wr = wid >> 2, wc = wid & 3, fr = lane & 15, fq = lane >> 4;
    const int K = g.K, nt = K / BK;
    unsigned voffA[2], voffB[2];
#pragma unroll
    for (int i = 0; i < 2; ++i) { int R, C; stage_rc(tid * 16 + i * 8192, R, C); const int Rb = Epi::PERM ? ((R & ~31) + perm32(R & 31)) : R;
        voffA[i] = (unsigned)(R * K + C) * 2u; voffB[i] = (unsigned)(Rb * K + C) * 2u; }
    const size_t kstep = (size_t)(BK * 2);
    const size_t hstep = (size_t)HALF * K * 2;
    const size_t tstep = 2 * hstep;
    const unsigned ldsw = (unsigned)wid * 1024u;
    const int aoff = lds_byte(wr * 64 + fr, fq * 8), boff = lds_byte(wc * 32 + fr, fq * 8);
#define PG8_SA(b, h) (((b) * 2 + (h)) * HTB)
#define PG8_SB(b, h) ((4 + (b) * 2 + (h)) * HTB)
#define PG8_STAGE(bufoff, gbase, voff) do { _Pragma("unroll") for (int _i = 0; _i < 2; ++_i) \
        __builtin_amdgcn_global_load_lds((const unsigned*)((const char*)(gbase) + (voff)[_i]), (PG8_LAS unsigned*)(lds + (bufoff) + ldsw + _i * 8192), 16, 0, 0); } while (0)
#define PG8_LDA(dst, b, h) do { _Pragma("unroll") for (int m = 0; m < 4; ++m) _Pragma("unroll") for (int k = 0; k < 2; ++k) dst[m][k] = *(const PG8_LAS bf16x8*)(lds + PG8_SA(b, h) + aoff + m * 2048 + k * 1024); } while (0)
#define PG8_LDB(dst, b, h) do { _Pragma("unroll") for (int n = 0; n < 2; ++n) _Pragma("unroll") for (int k = 0; k < 2; ++k) dst[n][k] = *(const PG8_LAS bf16x8*)(lds + PG8_SB(b, h) + boff + n * 2048 + k * 1024); } while (0)
#define PG8_MMA(ai, bj, At, Bt) do { __builtin_amdgcn_s_setprio(1); _Pragma("unroll") for (int m = 0; m < 4; ++m) _Pragma("unroll") for (int n = 0; n < 2; ++n) _Pragma("unroll") for (int k = 0; k < 2; ++k) \
        acc[ai][bj][m][n] = __builtin_amdgcn_mfma_f32_16x16x32_bf16(Bt[n][k], At[m][k], acc[ai][bj][m][n], 0, 0, 0); __builtin_amdgcn_s_setprio(0); } while (0)
#define PG8_WAIT_V(n) asm volatile("s_waitcnt vmcnt(" #n ")" ::: "memory")
#define PG8_WAIT_L(n) asm volatile("s_waitcnt lgkmcnt(" #n ")" ::: "memory")
#define PG8_BAR __builtin_amdgcn_s_barrier()
#define PG8_SCHED __builtin_amdgcn_sched_barrier(0)
    Unit cur, nxt; int ui = 0;
    if (!S.next(0, cur)) return;
    f32x4 acc[2][2][4][2];
#pragma unroll
    for (int a = 0; a < 2; ++a)
#pragma unroll
        for (int b = 0; b < 2; ++b)
#pragma unroll
            for (int m = 0; m < 4; ++m)
#pragma unroll
                for (int n = 0; n < 2; ++n) acc[a][b][m][n] = (f32x4){0.f, 0.f, 0.f, 0.f};
    bf16x8 At[4][2], B0[2][2], B1[2][2];
    const char* cA = (const char*)g.A + (size_t)cur.pm * tstep; const char* cB = (const char*)g.Bt + (size_t)cur.pn * tstep;
    S.a_ready(cur);
    if constexpr (SP2) {
        PG8_STAGE(PG8_SB(0, 0), cB, voffB); PG8_STAGE(PG8_SB(0, 1), cB + hstep, voffB); PG8_STAGE(PG8_SA(0, 0), cA, voffA); PG8_STAGE(PG8_SA(0, 1), cA + hstep, voffA);
        if (wr == 1) PG8_BAR;
        PG8_WAIT_V(2); PG8_BAR;
        PG8_STAGE(PG8_SB(1, 0), cB + kstep, voffB); PG8_STAGE(PG8_SA(1, 0), cA + kstep, voffA); PG8_STAGE(PG8_SB(1, 1), cB + hstep + kstep, voffB);
        PG8_WAIT_V(6); PG8_BAR;
    } else {
        PG8_STAGE(PG8_SB(0, 0), cB, voffB); PG8_STAGE(PG8_SA(0, 0), cA, voffA); PG8_STAGE(PG8_SB(0, 1), cB + hstep, voffB); PG8_STAGE(PG8_SA(0, 1), cA + hstep, voffA);
        if (wr == 1) PG8_BAR;
        PG8_WAIT_V(4); PG8_BAR;
        PG8_STAGE(PG8_SB(1, 0), cB + kstep, voffB); PG8_STAGE(PG8_SA(1, 0), cA + kstep, voffA); PG8_STAGE(PG8_SB(1, 1), cB + hstep + kstep, voffB);
        PG8_WAIT_V(6); PG8_BAR;
    }
    for (;;) {
        const bool has_next = S.next(ui + 1, nxt);
        const char* nA = has_next ? (const char*)g.A + (size_t)nxt.pm * tstep : cA; const char* nB = has_next ? (const char*)g.Bt + (size_t)nxt.pn * tstep : cB;
        for (int t = 0; t < nt; t += 2) {
            const bool last = (t == nt - 2);
            const char* a1 = cA + (size_t)(t + 1) * kstep;
            const char* a2 = last ? nA : cA + (size_t)(t + 2) * kstep; const char* b2 = last ? nB : cB + (size_t)(t + 2) * kstep;
            const char* a3 = a2 + kstep; const char* b3 = b2 + kstep;
            if (last && has_next) S.a_ready(nxt);
            if constexpr (SP2) {
            PG8_LDB(B0, 0, 0); PG8_LDB(B1, 0, 1); PG8_SCHED; PG8_LDA(At, 0, 0); PG8_STAGE(PG8_SA(1, 1), a1 + hstep, voffA);
            PG8_WAIT_V(8); PG8_WAIT_L(0); PG8_BAR; PG8_MMA(0, 0, At, B0); PG8_MMA(0, 1, At, B1); PG8_BAR; PG8_SCHED;
            PG8_LDA(At, 0, 1); PG8_STAGE(PG8_SB(0, 0), b2, voffB); PG8_STAGE(PG8_SB(0, 1), b2 + hstep, voffB); PG8_STAGE(PG8_SA(0, 0), a2, voffA);
            PG8_WAIT_V(8); PG8_WAIT_L(0); PG8_BAR; PG8_MMA(1, 0, At, B0); PG8_MMA(1, 1, At, B1); PG8_BAR; PG8_SCHED;
            PG8_LDB(B0, 1, 0); PG8_LDB(B1, 1, 1); PG8_SCHED; PG8_LDA(At, 1, 0); PG8_STAGE(PG8_SA(0, 1), a2 + hstep, voffA);
            PG8_WAIT_V(8); PG8_WAIT_L(0); PG8_BAR; PG8_MMA(0, 0, At, B0); PG8_MMA(0, 1, At, B1); PG8_BAR; PG8_SCHED;
            PG8_LDA(At, 1, 1); PG8_STAGE(PG8_SB(1, 0), b3, voffB); PG8_STAGE(PG8_SB(1, 1), b3 + hstep, voffB); PG8_STAGE(PG8_SA(1, 0), a3, voffA);
            PG8_WAIT_V(8); PG8_WAIT_L(0); PG8_BAR; PG8_MMA(1, 0, At, B0); PG8_MMA(1, 1, At, B1); PG8_BAR; PG8_SCHED;
            } else {
            PG8_LDB(B0, 0, 0); PG8_SCHED; PG8_LDA(At, 0, 0); PG8_STAGE(PG8_SA(1, 1), a1 + hstep, voffA);
            PG8_WAIT_L(8); PG8_BAR; PG8_WAIT_L(0); PG8_MMA(0, 0, At, B0); PG8_BAR; PG8_SCHED;
            PG8_LDB(B1, 0, 1); PG8_STAGE(PG8_SB(0, 0), b2, voffB);
            PG8_BAR; PG8_WAIT_L(0); PG8_MMA(0, 1, At, B1); PG8_BAR;
            PG8_LDA(At, 0, 1); PG8_STAGE(PG8_SA(0, 0), a2, voffA);
            PG8_BAR; PG8_WAIT_L(0); PG8_MMA(1, 0, At, B0); PG8_BAR; PG8_SCHED;
            PG8_STAGE(PG8_SB(0, 1), b2 + hstep, voffB);
            PG8_WAIT_V(6); PG8_BAR; PG8_MMA(1, 1, At, B1); PG8_BAR;
            PG8_LDB(B0, 1, 0); PG8_SCHED; PG8_LDA(At, 1, 0); PG8_STAGE(PG8_SA(0, 1), a2 + hstep, voffA);
            PG8_WAIT_L(8); PG8_BAR; PG8_WAIT_L(0); PG8_MMA(0, 0, At, B0); PG8_BAR; PG8_SCHED;
            PG8_LDB(B1, 1, 1); PG8_STAGE(PG8_SB(1, 0), b3, voffB);
            PG8_BAR; PG8_WAIT_L(0); PG8_MMA(0, 1, At, B1); PG8_BAR;
            PG8_LDA(At, 1, 1); PG8_STAGE(PG8_SA(1, 0), a3, voffA);
            PG8_BAR; PG8_WAIT_L(0); PG8_MMA(1, 0, At, B0); PG8_BAR; PG8_SCHED;
            PG8_STAGE(PG8_SB(1, 1), b3 + hstep, voffB);
            PG8_WAIT_V(6); PG8_BAR; PG8_MMA(1, 1, At, B1); PG8_BAR;
            }
        }
        if constexpr (ALIGN_EPI) { if (wr == 0) PG8_BAR; }
        if constexpr (!Epi::AFTER_DRAIN) { E(acc, cur, wr, wc, fr, fq); S.done(cur); }
        if (!has_next) break;
#pragma unroll
        for (int a = 0; a < 2; ++a)
#pragma unroll
            for (int b = 0; b < 2; ++b)
#pragma unroll
                for (int m = 0; m < 4; ++m)
#pragma unroll
                    for (int n = 0; n < 2; ++n) acc[a][b][m][n] = (f32x4){0.f, 0.f, 0.f, 0.f};
        cur = nxt; cA = nA; cB = nB; ++ui;
        if constexpr (ALIGN_EPI) { if (wr == 1) PG8_BAR; }
    }
    PG8_WAIT_V(0);
    if constexpr (!ALIGN_EPI) { if (wr == 0) PG8_BAR; }
    PG8_BAR;
    if constexpr (Epi::AFTER_DRAIN) { E.fused(acc, cur, wr, wc, fr, fq, lds, wid, lane); S.done(cur); }
#undef PG8_SA
#undef PG8_SB
#undef PG8_STAGE
#undef PG8_LDA
#undef PG8_LDB
#undef PG8_MMA
#undef PG8_WAIT_V
#undef PG8_WAIT_L
#undef PG8_BAR
#undef PG8_SCHED
}
}

__device__ __forceinline__ unsigned pkbf(float lo, float hi) { return pg8::cvt_pk_bf16(lo, hi); }
__device__ __forceinline__ void st8bf(bf16_t* p, f32x4 a, f32x4 b) { u32x4 w; w.x = pkbf(a[0], a[1]); w.y = pkbf(a[2], a[3]); w.z = pkbf(b[0], b[1]); w.w = pkbf(b[2], b[3]); *(u32x4*)p = w; }
__device__ __forceinline__ f32x4 bflo(u32x4 g) { f32x4 o; o[0] = __uint_as_float(g.x << 16); o[1] = __uint_as_float(g.x & 0xffff0000u); o[2] = __uint_as_float(g.y << 16); o[3] = __uint_as_float(g.y & 0xffff0000u); return o; }
__device__ __forceinline__ f32x4 bfhi(u32x4 g) { f32x4 o; o[0] = __uint_as_float(g.z << 16); o[1] = __uint_as_float(g.z & 0xffff0000u); o[2] = __uint_as_float(g.w << 16); o[3] = __uint_as_float(g.w & 0xffff0000u); return o; }
__device__ __forceinline__ f32x4 bf4(u32x2 g) { f32x4 o; o[0] = __uint_as_float(g.x << 16); o[1] = __uint_as_float(g.x & 0xffff0000u); o[2] = __uint_as_float(g.y << 16); o[3] = __uint_as_float(g.y & 0xffff0000u); return o; }
__device__ __forceinline__ void rot8(f32x4& a, f32x4& b, f32x4 c, f32x4 s) {
    const f32x4 x = a, y = b;
    a[0] = x[0] * c[0] - x[1] * s[0]; a[1] = x[1] * c[0] + x[0] * s[0]; a[2] = x[2] * c[1] - x[3] * s[1]; a[3] = x[3] * c[1] + x[2] * s[1];
    b[0] = y[0] * c[2] - y[1] * s[2]; b[1] = y[1] * c[2] + y[0] * s[2]; b[2] = y[2] * c[3] - y[3] * s[3]; b[3] = y[3] * c[3] + y[2] * s[3];
}
__device__ __forceinline__ f32x4 sig4(f32x4 v) { f32x4 o; o[0] = 1.f / (1.f + __expf(-v[0])); o[1] = 1.f / (1.f + __expf(-v[1])); o[2] = 1.f / (1.f + __expf(-v[2])); o[3] = 1.f / (1.f + __expf(-v[3])); return o; }
__host__ __device__ __forceinline__ int src_in(int n) {
    if (n < 1024) return n;
    if (n < 4096) { const int seg = (n - 1024) >> 10, c = (n - 1024) & 1023, d = c & 127; int od = d; if (seg < 2 && d < 32) od = (d >> 1) + (d & 1) * 16; return 1088 + seg * 1024 + (c & ~127) + od; }
    if (n < 5120) { const int c = n - 4096, d = c & 63; const int od = d < 16 ? (d >> 1) + (d & 1) * 8 : d; return 4160 + (c & ~63) + od; }
    if (n < 7168) return 5264 + (n - 5120);
    if (n < 9216) return 7312 + (n - 7168);
    if (n < 9280) { const int d = n - 9216; return 1024 + (d >> 1) + (d & 1) * 32; }
    if (n < 9344) { const int d = n - 9280; const int od = d < 16 ? (d >> 1) + (d & 1) * 8 : d; return 5184 + od; }
    if (n < 9360) return 5248 + (n - 9344);
    return -1;
}
__host__ __device__ __forceinline__ int src_qa(int n) { const int h = n / 192, d = n - h * 192; if (d < 128) return n; const int dd = d - 128; return h * 192 + 128 + (dd >> 1) + (dd & 1) * 32; }

struct EpiIn {
    static constexpr bool PERM = true, AFTER_DRAIN = false;
    unsigned char* ws;
    __device__ __forceinline__ void operator()(const f32x4 (&acc)[2][2][4][2], const pg8::Unit& u, int wr, int wc, int fr, int fq) const {
        const int row0 = u.pm * 256 + wr * 64 + fr, cu = wc * 32 + 8 * fq, pn = u.pn;
        bf16_t* const CQ = (bf16_t*)(ws + WS_CQ); bf16_t* const QB = (bf16_t*)(ws + WS_QB); bf16_t* const QI = (bf16_t*)(ws + WS_QI); bf16_t* const GA = (bf16_t*)(ws + WS_GA);
        bf16_t* const KA = (bf16_t*)(ws + WS_KA); bf16_t* const KI = (bf16_t*)(ws + WS_KI); float* const WI = (float*)(ws + WS_WI); float* const part = (float*)(ws + WS_SSQ);
        const float* const cM = (const float*)(ws + WS_ROPE); const float* const sM = cM + T * 32; const float* const cD = cM + T * 64; const float* const sD = cM + T * 80; const float* const cI = cM + T * 96; const float* const sI = cM + T * 104;
#define EPI_ROWS(BODY) _Pragma("unroll") for (int ai = 0; ai < 2; ++ai) _Pragma("unroll") for (int m = 0; m < 4; ++m) { const int t = row0 + ai * 128 + m * 16; \
            _Pragma("unroll") for (int bj = 0; bj < 2; ++bj) { f32x4 a = acc[ai][bj][m][0], b = acc[ai][bj][m][1]; BODY } }
        if (pn < 4) {
            bf16_t* const dst = CQ + (size_t)(pn >> 1) * ((size_t)T * 512) + (pn & 1) * 256 + cu;
            EPI_ROWS(
                st8bf(dst + (size_t)t * 512 + bj * 128, a, b);
                float sq = ((a[0] * a[0] + a[1] * a[1]) + (a[2] * a[2] + a[3] * a[3])) + ((b[0] * b[0] + b[1] * b[1]) + (b[2] * b[2] + b[3] * b[3]));
                sq += __shfl_xor(sq, 16); sq += __shfl_xor(sq, 32);
                if (fq == 0) part[(size_t)t * 32 + pn * 8 + bj * 4 + wc] = sq; )
        } else if (pn < 16) {
            const int seg = (pn - 4) >> 2; const bool rot = seg < 2 && wc == 0;
            bf16_t* const dst = QB + (size_t)seg * ((size_t)T * 1024) + ((pn - 4) & 3) * 256 + cu;
            EPI_ROWS(
                if (rot) rot8(a, b, *(const f32x4*)(cD + (size_t)t * 16 + 4 * fq), *(const f32x4*)(sD + (size_t)t * 16 + 4 * fq));
                st8bf(dst + (size_t)t * 1024 + bj * 128, a, b); )
        } else if (pn < 20) {
            const bool rot = (wc & 1) == 0 && fq < 2;
            bf16_t* const dst = QI + (size_t)(unsigned)((row0 >> 5) * 32768 + (row0 & 31) * 8 + (pn - 16) * 8192 + (cu >> 6) * 2048 + ((cu >> 4) & 3) * 512 + ((cu >> 3) & 1) * 256);
            EPI_ROWS(
                if (rot) rot8(a, b, *(const f32x4*)(cI + (size_t)t * 8 + 4 * fq), *(const f32x4*)(sI + (size_t)t * 8 + 4 * fq));
                st8bf(dst + (ai * 4 + (m >> 1)) * 32768 + (m & 1) * 128 + bj * 4096, a, b); )
        } else if (pn < 36) {
            bf16_t* const dst = GA + (size_t)((pn - 20) >> 3) * ((size_t)T * D) + ((pn - 20) & 7) * 256 + cu;
            EPI_ROWS( st8bf(dst + (size_t)t * D + bj * 128, sig4(a), sig4(b)); )
        } else {
            EPI_ROWS(
                if (bj == 0) {
                    if (wc < 2) {
                        rot8(a, b, *(const f32x4*)(cM + (size_t)t * 32 + (cu >> 1)), *(const f32x4*)(sM + (size_t)t * 32 + (cu >> 1)));
                        _Pragma("unroll") for (int h = 0; h < 8; ++h) st8bf(KA + (size_t)t * 1536 + h * 192 + 128 + cu, a, b);
                    } else {
                        const int d = cu - 64;
                        if (d < 16) rot8(a, b, *(const f32x4*)(cI + (size_t)t * 8 + (d >> 1)), *(const f32x4*)(sI + (size_t)t * 8 + (d >> 1)));
                        st8bf(KI + (size_t)t * 64 + d, a, b);
                    }
                } else if (cu < 16) {
                    *(f32x4*)(WI + (size_t)t * 16 + cu) = a * 0.03125f; *(f32x4*)(WI + (size_t)t * 16 + cu + 4) = b * 0.03125f;
                } )
        }
#undef EPI_ROWS
    }
};
__device__ __forceinline__ float rms_from_part(const float* pp) {
    const f32x4 p0 = *(const f32x4*)pp, p1 = *(const f32x4*)(pp + 4), p2 = *(const f32x4*)(pp + 8), p3 = *(const f32x4*)(pp + 12);
    const float s = (((p0[0] + p0[1]) + (p0[2] + p0[3])) + ((p1[0] + p1[1]) + (p1[2] + p1[3]))) + (((p2[0] + p2[1]) + (p2[2] + p2[3])) + ((p3[0] + p3[1]) + (p3[2] + p3[3])));
    return rsqrtf(s * (1.f / 512.f) + 1e-6f);
}
struct EpiQA {
    static constexpr bool PERM = true, AFTER_DRAIN = false;
    unsigned char* ws;
    __device__ __forceinline__ void operator()(const f32x4 (&acc)[2][2][4][2], const pg8::Unit& u, int wr, int wc, int fr, int fq) const {
        const int row0 = u.pm * 256 + wr * 64 + fr, cu = wc * 32 + 8 * fq;
        bf16_t* const QA = (bf16_t*)(ws + WS_QA); const float* const part = (const float*)(ws + WS_SSQ); const float* const cM = (const float*)(ws + WS_ROPE); const float* const sM = cM + T * 32;
#pragma unroll
        for (int ai = 0; ai < 2; ++ai)
#pragma unroll
            for (int m = 0; m < 4; ++m) {
                const int t = row0 + ai * 128 + m * 16;
                const float r = rms_from_part(part + (size_t)t * 32);
#pragma unroll
                for (int bj = 0; bj < 2; ++bj) {
                    const int n = u.pn * 256 + bj * 128 + cu, h = n / 192, d = n - h * 192;
                    f32x4 a = acc[ai][bj][m][0] * r, b = acc[ai][bj][m][1] * r;
                    if (d >= 128) rot8(a, b, *(const f32x4*)(cM + (size_t)t * 32 + ((d - 128) >> 1)), *(const f32x4*)(sM + (size_t)t * 32 + ((d - 128) >> 1)));
                    st8bf(QA + (size_t)t * 1536 + n, a, b);
                }
            }
    }
};
struct EpiKV {
    static constexpr bool PERM = true, AFTER_DRAIN = false;
    unsigned char* ws;
    __device__ __forceinline__ void operator()(const f32x4 (&acc)[2][2][4][2], const pg8::Unit& u, int wr, int wc, int fr, int fq) const {
        const int row0 = u.pm * 256 + wr * 64 + fr, cu = wc * 32 + 8 * fq;
        bf16_t* const KA = (bf16_t*)(ws + WS_KA); bf16_t* const VA = (bf16_t*)(ws + WS_VA); const float* const part = (const float*)(ws + WS_SSQ);
#pragma unroll
        for (int ai = 0; ai < 2; ++ai)
#pragma unroll
            for (int m = 0; m < 4; ++m) {
                const int t = row0 + ai * 128 + m * 16;
                const float r = rms_from_part(part + (size_t)t * 32 + 16);
                st8bf(KA + (size_t)t * 1536 + u.pn * 192 + cu, acc[ai][0][m][0] * r, acc[ai][0][m][1] * r);
                st8bf(VA + (size_t)t * 1024 + u.pn * 128 + cu, acc[ai][1][m][0] * r, acc[ai][1][m][1] * r);
            }
    }
};
struct EpiYA {
    static constexpr bool PERM = true, AFTER_DRAIN = false;
    unsigned char* ws;
    __device__ __forceinline__ void operator()(const f32x4 (&acc)[2][2][4][2], const pg8::Unit& u, int wr, int wc, int fr, int fq) const {
        const int row0 = u.pm * 256 + wr * 64 + fr, col0 = u.pn * 256 + wc * 32 + 8 * fq;
        bf16_t* const YT = (bf16_t*)(ws + WS_YT); const bf16_t* const GA = (const bf16_t*)(ws + WS_GA);
#pragma unroll
        for (int ai = 0; ai < 2; ++ai)
#pragma unroll
            for (int m = 0; m < 4; ++m)
#pragma unroll
                for (int bj = 0; bj < 2; ++bj) {
                    const size_t o = (size_t)(row0 + ai * 128 + m * 16) * D + col0 + bj * 128;
                    const u32x4 g = *(const u32x4*)(GA + o);
                    st8bf(YT + o, acc[ai][bj][m][0] * bflo(g), acc[ai][bj][m][1] * bfhi(g));
                }
    }
};
struct EpiYB {
    static constexpr bool PERM = true, AFTER_DRAIN = false;
    unsigned char* ws;
    __device__ __forceinline__ void operator()(const f32x4 (&acc)[2][2][4][2], const pg8::Unit& u, int wr, int wc, int fr, int fq) const {
        const int row0 = u.pm * 256 + wr * 64 + fr, col0 = u.pn * 256 + wc * 32 + 8 * fq;
        const bf16_t* const YT = (const bf16_t*)(ws + WS_YT); const bf16_t* const GB = (const bf16_t*)(ws + WS_GB); bf16_t* const Y = (bf16_t*)(ws + WS_Y);
#pragma unroll
        for (int ai = 0; ai < 2; ++ai)
#pragma unroll
            for (int m = 0; m < 4; ++m)
#pragma unroll
                for (int bj = 0; bj < 2; ++bj) {
                    const size_t o = (size_t)(row0 + ai * 128 + m * 16) * D + col0 + bj * 128;
                    const u32x4 g = *(const u32x4*)(GB + o);
                    const u32x4 yt = *(const u32x4*)(YT + o); const f32x4 y0 = bflo(yt), y1 = bfhi(yt);
                    st8bf(Y + o, y0 + acc[ai][bj][m][0] * bflo(g), y1 + acc[ai][bj][m][1] * bfhi(g));
                }
    }
};
struct EpiOut {
    static constexpr bool PERM = true, AFTER_DRAIN = false;
    const float* hin; float* V1;
    __device__ __forceinline__ void operator()(const f32x4 (&acc)[2][2][4][2], const pg8::Unit& u, int wr, int wc, int fr, int fq) const {
        const int row0 = u.pm * 256 + wr * 64 + fr, col0 = u.pn * 256 + wc * 32 + 8 * fq;
#pragma unroll
        for (int ai = 0; ai < 2; ++ai)
#pragma unroll
            for (int m = 0; m < 4; ++m)
#pragma unroll
                for (int bj = 0; bj < 2; ++bj) {
                    const size_t o = (size_t)(row0 + ai * 128 + m * 16) * D + col0 + bj * 128;
                    const f32x4 h0 = *(const f32x4*)(hin + o), h1 = *(const f32x4*)(hin + o + 4);
                    *(f32x4*)(V1 + o) = h0 * ALPHA + acc[ai][bj][m][0]; *(f32x4*)(V1 + o + 4) = h1 * ALPHA + acc[ai][bj][m][1];
                }
    }
};

#define LDS_WAIT() asm volatile("s_waitcnt lgkmcnt(0)" ::: "memory")
__device__ __forceinline__ void transpose_item(int MAP, const float* W, int ldw, int K, int N, const float* kscale, bf16_t* WT, LAS float* scr, int item, int lane) {
    const int nblk = N / 32, kb = item / nblk, nb = item % nblk, k0 = 64 * kb, n0 = 32 * nb;
    const int n = n0 + (lane & 31);
    const int sc = MAP == 0 ? n : (MAP == 1 ? src_in(n) : src_qa(n));
#pragma unroll 8
    for (int i = 0; i < 32; ++i) { const int kk = 2 * i + (lane >> 5);
        float v = sc >= 0 ? W[(size_t)(k0 + kk) * ldw + sc] : 0.f; if (kscale) v *= kscale[k0 + kk];
        scr[kk * 33 + (lane & 31)] = v; }
    LDS_WAIT(); asm volatile("" ::: "memory");
    const int c = lane & 7;
#pragma unroll
    for (int j = 0; j < 4; ++j) { const int nn = (lane >> 3) + 8 * j; const LAS float* sp = scr + (8 * c) * 33 + nn;
        u32x4 o; o.x = pkbf(sp[0 * 33], sp[1 * 33]); o.y = pkbf(sp[2 * 33], sp[3 * 33]); o.z = pkbf(sp[4 * 33], sp[5 * 33]); o.w = pkbf(sp[6 * 33], sp[7 * 33]);
        *(u32x4*)(WT + (size_t)(n0 + nn) * K + k0 + 8 * c) = o; }
    LDS_WAIT(); asm volatile("" ::: "memory");
}
__device__ __forceinline__ int tperm(int pm, int nn) {
    if (pm == 0) return nn;
    if (pm == 1) return nn < 32 ? (nn >> 1) + (nn & 1) * 16 : nn;
    if (pm == 2) return nn < 16 ? (nn >> 1) + (nn & 1) * 8 : nn;
    if (pm == 3) return (nn >> 1) + (nn & 1) * 32;
    if (pm == 4) return nn < 16 ? nn : -1;
    return -1;
}
__device__ __forceinline__ void transpose_block_vec(const float* W, int ldw, int K, int s0, int pm, int n0, int k0, const float* kscale, bf16_t* WT, LAS float* scr, int lane) {
    const int r = lane >> 4, c4 = lane & 15;
    f32x4 v[16];
#pragma unroll
    for (int i = 0; i < 16; ++i) v[i] = *(const f32x4*)(W + (size_t)(k0 + 4 * i + r) * ldw + s0 + 4 * c4);
    float ks[16];
#pragma unroll
    for (int i = 0; i < 16; ++i) ks[i] = kscale ? kscale[k0 + 4 * i + r] : 1.f;
#pragma unroll
    for (int i = 0; i < 16; ++i) { const int kk = 4 * i + r; const f32x4 w = v[i] * ks[i];
        LAS float* d = scr + kk * 65 + 4 * c4; d[0] = w[0]; d[1] = w[1]; d[2] = w[2]; d[3] = w[3]; }
    LDS_WAIT(); asm volatile("" ::: "memory");
    const int c = lane & 7;
#pragma unroll
    for (int j = 0; j < 8; ++j) { const int nn = (lane >> 3) + 8 * j, so = tperm(pm, nn); const LAS float* sp = scr + (8 * c) * 65 + (so < 0 ? 0 : so);
        u32x4 o; o.x = pkbf(sp[0 * 65], sp[1 * 65]); o.y = pkbf(sp[2 * 65], sp[3 * 65]); o.z = pkbf(sp[4 * 65], sp[5 * 65]); o.w = pkbf(sp[6 * 65], sp[7 * 65]);
        if (so < 0) o = (u32x4){0u, 0u, 0u, 0u};
        *(u32x4*)(WT + (size_t)(n0 + nn) * K + k0 + 8 * c) = o; }
    LDS_WAIT(); asm volatile("" ::: "memory");
}
__device__ __forceinline__ void p_wcopies(LAS unsigned char* ldsb, const Params& p, const int l1, const int lo1, const int hi1, const int l2, const int lo2, const int hi2, const int rank, const int nranks) {
    const int tid_ = opaque_tid(), wave = tid_ >> 6, lane = tid_ & 63;
    LAS float* scr = (LAS float*)(ldsb + wave * 16640);
    const int gw = rank * 8 + wave, NGW = nranks * 8;
    constexpr int B_IN = (D / 64) * (INP / 64), B_QB = (512 / 64) * (1536 / 64), B_KV = (512 / 64) * (2048 / 64), B_O = (1024 / 64) * (D / 64), B_OUT = (D / 64) * (D / 64);
    constexpr int B_LAYER = B_IN + B_QB + B_KV + 2 * B_O + B_OUT;
    const int n1 = hi1 - lo1, ntot = n1 + (hi2 - lo2);
    for (int it = gw; it < ntot; it += NGW) {
        const int l = it < n1 ? l1 : l2; int r = it < n1 ? lo1 + it : lo2 + (it - n1);
        int map = 0, ldw, K, N; const float* W; const float* ks = nullptr; bf16_t* WT;
        if (r < B_IN) { map = 1; W = p.w_in + (size_t)l * D * INW; ldw = INW; K = D; N = INP; WT = (bf16_t*)(p.ws + WS_WIN_T) + (size_t)l * INP * D; }
        else if ((r -= B_IN) < B_QB) { map = 2; W = p.w_qb + (size_t)l * 512 * 1536; ldw = 1536; K = 512; N = 1536; ks = p.g_q + l * 512; WT = (bf16_t*)(p.ws + WS_WQB_T) + (size_t)l * 1536 * 512; }
        else if ((r -= B_QB) < B_KV) { W = p.w_kvb + (size_t)l * 512 * 2048; ldw = 2048; K = 512; N = 2048; ks = p.g_kv + l * 512; WT = (bf16_t*)(p.ws + WS_WKVB_T) + (size_t)l * 2048 * 512; }
        else if ((r -= B_KV) < B_O) { W = p.w_oa + (size_t)l * 1024 * D; ldw = D; K = 1024; N = D; WT = (bf16_t*)(p.ws + WS_WOA_T) + (size_t)l * D * 1024; }
        else if ((r -= B_O) < B_O) { W = p.w_ob + (size_t)l * 1024 * D; ldw = D; K = 1024; N = D; WT = (bf16_t*)(p.ws + WS_WOB_T) + (size_t)l * D * 1024; }
        else { r -= B_O; W = p.w_out + (size_t)l * D * D; ldw = D; K = D; N = D; WT = (bf16_t*)(p.ws + WS_WOUT_T) + (size_t)l * D * D; }
        const int nb64 = N / 64, kb = r / nb64, nb = r - kb * nb64, n0 = 64 * nb, k0 = 64 * kb;
        int s0 = n0, pm = 0;
        if (map == 1) { s0 = src_in(n0);
            if (n0 >= 1024 && n0 < 3072 && !(n0 & 64)) pm = 1; else if (n0 >= 4096 && n0 < 5120) pm = 2; else if (n0 == 9216) pm = 3; else if (n0 == 9280) pm = 2; else if (n0 == 9344) pm = 4; else if (n0 >= 9408) { pm = 5; s0 = 0; } }
        else if (map == 2) { s0 = src_qa(n0); if ((n0 % 192) == 128) pm = 3; }
        transpose_block_vec(W, ldw, K, s0, pm, n0, k0, ks, WT, scr, lane);
    }
    __syncthreads();
}
__device__ __forceinline__ void p_prologue(LAS unsigned char* ldsb, const Params& p, const int parts = 31) {
    float* rope = (float*)(p.ws + WS_ROPE);
    float *cM = rope, *sM = rope + T * 32, *cD = rope + T * 64, *sD = rope + T * 80, *cI = rope + T * 96, *sI = rope + T * 104;
    const int gtid = opaque_bid() * NTHREADS + threadIdx.x, gstride = gridDim.x * NTHREADS;
    if (parts & 1) for (int idx = gtid; idx < T * 56; idx += gstride) {
        const int t = idx / 56, j = idx - t * 56;
        int rot, i; float *ct, *st; int w;
        if (j < 32) { rot = 64; i = j; ct = cM; st = sM; w = 32; } else if (j < 48) { rot = 32; i = j - 32; ct = cD; st = sD; w = 16; } else { rot = 16; i = j - 48; ct = cI; st = sI; w = 8; }
        const float inv = exp2f(-((float)(2 * i) / (float)rot) * 18.931568569324174f);
        const float ang = (float)p.pos[t] * inv;
        double rev = (double)ang * 0.15915494309189535; rev -= rint(rev);
        const float r = (float)(rev * 6.283185307179586);
        ct[t * w + i] = __cosf(r); st[t * w + i] = __sinf(r);
    }
    bf16_t* XB = (bf16_t*)(p.ws + WS_XB);
    if (parts & 2) for (size_t i = (size_t)gtid * 4; i < (size_t)T * D; i += (size_t)gstride * 32) {
        f32x4 a[8];
#pragma unroll
        for (int u = 0; u < 8; ++u) { const size_t iu = i + (size_t)u * gstride * 4; a[u] = iu < (size_t)T * D ? *(const f32x4*)(p.x + iu) : (f32x4){0.f, 0.f, 0.f, 0.f}; }
#pragma unroll
        for (int u = 0; u < 8; ++u) { const size_t iu = i + (size_t)u * gstride * 4; if (iu < (size_t)T * D) st4bf(XB + iu, a[u]); } }
    if (parts & 4) { float* SEC = (float*)(p.ws + WS_SEC);
      { bf16_t* RWH = (bf16_t*)(p.ws + WS_RWH); bf16_t* RWL = (bf16_t*)(p.ws + WS_RWL);
        for (int idx = gtid; idx < DEPTH * 96 * D; idx += gstride) { const int l = idx / (96 * D), r = idx - l * (96 * D), e = r / D, k = r - e * D;
            float w = 0.f; if (e < 64) w = p.ln1g[l * D + k] * p.w_router[((size_t)l * D + k) * 64 + e]; else if (e < 72) w = p.ln1g[l * D + k] * p.w_group[((size_t)l * D + k) * 8 + (e - 64)];
            const size_t fo = (size_t)l * (96 * D) + (size_t)((((k >> 8) * 16 + ((k >> 4) & 15)) * 3 + (e >> 5)) * 2 + ((k >> 3) & 1)) * 256 + (e & 31) * 8 + (k & 7);
            const bf16_t h = f2bf(w); RWH[fo] = h; RWL[fo] = f2bf(w - bf2f(h)); } }
      { const int wave_ = threadIdx.x >> 6, lane_ = threadIdx.x & 63, gwv = opaque_bid() * 8 + wave_;
        if (gwv < DEPTH * 72) { const int l = gwv / 72, e = gwv - l * 72; float sa = 0.f, ca = 0.f;
#pragma unroll 4
          for (int i = 0; i < D / 64; ++i) { const int k = lane_ + 64 * i; const float w = e < 64 ? p.w_router[((size_t)l * D + k) * 64 + e] : p.w_group[((size_t)l * D + k) * 8 + (e - 64)]; sa = fmaf(p.ln1g[l * D + k], w, sa); ca = fmaf(p.ln1b[l * D + k], w, ca); }
          sa = wave_sum(sa); ca = wave_sum(ca);
          if (lane_ == 0) { SEC[l * 160 + e] = sa; SEC[l * 160 + 80 + e] = ca + (e < 64 ? p.b_router[l * 64 + e] : p.b_group[l * 8 + (e - 64)]); } } } }
    __syncthreads();
}

__device__ __forceinline__ unsigned f2key(float f) { const unsigned u = __float_as_uint(f); return (u & 0x80000000u) ? ~u : (u | 0x80000000u); }
typedef short bf16x8 __attribute__((ext_vector_type(8)));
typedef short s16x4 __attribute__((ext_vector_type(4)));
typedef float f32x16 __attribute__((ext_vector_type(16)));
__device__ __forceinline__ void p_score(LAS unsigned char* ldsb, unsigned char* ws) {
    const bf16_t* QI = (const bf16_t*)(ws + WS_QI); const bf16_t* KI = (const bf16_t*)(ws + WS_KI); const float* WI = (const float*)(ws + WS_WI);
    unsigned* SC = (unsigned*)(ws + WS_SCORE);
    const int tid = opaque_tid(), lane = tid & 63, wv = __builtin_amdgcn_readfirstlane(tid >> 6), r32 = lane & 31, hi = lane >> 5;
    const int ksw = ((r32 >> 1) & 7) ^ hi;
    const unsigned krow = (unsigned)(size_t)ldsb + (unsigned)r32 * 128u;
    const int G_ = gridDim.x, bid_ = opaque_bid();
    const int nit_ = (G_ == 256) ? 3 : (544 - bid_ + G_ - 1) / G_;
    for (int it_ = 0; it_ < nit_; ++it_) {
        int item = bid_ + G_ * it_;
        if (G_ == 256 && it_ == 2) item = (bid_ >= 192 && bid_ < 224) ? 512 + (bid_ - 192) : 544;
        if (item >= 544) continue;
        const int b = item / 272; int r = item - b * 272, qb = 0;
        while (r >= 2 * qb + 2) { r -= 2 * qb + 2; ++qb; }
        const int kc = r, q0 = qb * 256 + wv * 32;
        __builtin_amdgcn_s_barrier();
#pragma unroll
        for (int i = 0; i < 2; ++i) { const int g = i * 512 + tid, row = g >> 3, ch = (g & 7) ^ ((row >> 1) & 7);
            __builtin_amdgcn_global_load_lds((const unsigned*)(KI + (size_t)(b * S + kc * 128 + row) * 64 + ch * 8), (LAS unsigned*)(ldsb + (i * 512 + wv * 64) * 16), 16, 0, 0); }
        asm volatile("s_waitcnt vmcnt(0)" ::: "memory");
        __builtin_amdgcn_s_barrier();
        if (kc * 128 <= q0 + 31) {
            const size_t t = (size_t)b * S + q0 + r32;
            bf16x8 ka[4][4];
#pragma unroll
            for (int kb = 0; kb < 4; ++kb)
#pragma unroll
                for (int d0 = 0; d0 < 4; ++d0) ka[kb][d0] = *(const LAS bf16x8*)(size_t)(krow + kb * 4096 + ((unsigned)((2 * d0) ^ ksw) << 4));
            f32x16 acc[4];
#pragma unroll
            for (int kb = 0; kb < 4; ++kb)
#pragma unroll
                for (int rr = 0; rr < 16; ++rr) acc[kb][rr] = 0.f;
            const bf16_t* qrow = QI + (t >> 5) * 32768 + hi * 256 + r32 * 8; const float* wrow = WI + t * 16;
            bf16x8 qa0, qa1, qa2, qa3, qc0, qc1, qc2, qc3; float wa, wc_;
#define SC_LOAD(Q0, Q1, Q2, Q3, W, h_) do { const bf16_t* p_ = qrow + (h_) * 2048; const float* w_ = wrow + (h_); \
                asm volatile("global_load_dwordx4 %0, %1, off" : "=v"(Q0) : "v"(p_) : "memory"); asm volatile("global_load_dwordx4 %0, %1, off offset:1024" : "=v"(Q1) : "v"(p_) : "memory"); \
                asm volatile("global_load_dwordx4 %0, %1, off offset:2048" : "=v"(Q2) : "v"(p_) : "memory"); asm volatile("global_load_dwordx4 %0, %1, off offset:3072" : "=v"(Q3) : "v"(p_) : "memory"); \
                asm volatile("global_load_dword %0, %1, off" : "=v"(W) : "v"(w_) : "memory"); } while (0)
#define SC_WAIT(n_) asm volatile("s_waitcnt vmcnt(" #n_ ")" : "+v"(qa0), "+v"(qa1), "+v"(qa2), "+v"(qa3), "+v"(wa), "+v"(qc0), "+v"(qc1), "+v"(qc2), "+v"(qc3), "+v"(wc_) :: "memory")
#define SC_CHAIN(PZ, kb_, Q0, Q1, Q2, Q3) do { _Pragma("unroll") for (int rr = 0; rr < 16; ++rr) PZ[rr] = 0.f; \
                PZ = __builtin_amdgcn_mfma_f32_32x32x16_bf16(ka[kb_][0], Q0, PZ, 0, 0, 0); PZ = __builtin_amdgcn_mfma_f32_32x32x16_bf16(ka[kb_][1], Q1, PZ, 0, 0, 0); \
                PZ = __builtin_amdgcn_mfma_f32_32x32x16_bf16(ka[kb_][2], Q2, PZ, 0, 0, 0); PZ = __builtin_amdgcn_mfma_f32_32x32x16_bf16(ka[kb_][3], Q3, PZ, 0, 0, 0); } while (0)
#define SC_ACC(PZ, kb_, W) do { _Pragma("unroll") for (int rr = 0; rr < 16; ++rr) { const float rl = __int_as_float(max(__float_as_int(PZ[rr]), 0)); \
                float av = acc[kb_][rr]; asm("v_fmac_f32 %0, %1, %2" : "+v"(av) : "v"(W), "v"(rl)); acc[kb_][rr] = av; } } while (0)
#define SC_HEAD(Q0, Q1, Q2, Q3, W) do { f32x16 pzA, pzB; SC_CHAIN(pzA, 0, Q0, Q1, Q2, Q3); SC_CHAIN(pzB, 1, Q0, Q1, Q2, Q3); SC_ACC(pzA, 0, W); SC_CHAIN(pzA, 2, Q0, Q1, Q2, Q3); SC_ACC(pzB, 1, W); \
                SC_CHAIN(pzB, 3, Q0, Q1, Q2, Q3); SC_ACC(pzA, 2, W); SC_ACC(pzB, 3, W); } while (0)
            SC_LOAD(qa0, qa1, qa2, qa3, wa, 0);
#pragma unroll 1
            for (int h = 0; h < 16; h += 2) {
                SC_LOAD(qc0, qc1, qc2, qc3, wc_, h + 1);
                SC_WAIT(5);
                SC_HEAD(qa0, qa1, qa2, qa3, wa);
                SC_LOAD(qa0, qa1, qa2, qa3, wa, (h + 2) & 15);
                SC_WAIT(5);
                SC_HEAD(qc0, qc1, qc2, qc3, wc_);
            }
            SC_WAIT(0);
#undef SC_LOAD
#undef SC_WAIT
#undef SC_CHAIN
#undef SC_ACC
#undef SC_HEAD
            const int dq = q0 + r32 - kc * 128 - 4 * hi;
            unsigned* srow = SC + t * 4096 + kc * 128 + 4 * hi;
#pragma unroll
            for (int kb = 0; kb < 4; ++kb)
#pragma unroll
                for (int rq = 0; rq < 4; ++rq) { u32x4 o; const int c0 = 32 * kb + 8 * rq;
                    o.x = (c0 <= dq) ? f2key(acc[kb][4 * rq]) : 0u; o.y = (c0 + 1 <= dq) ? f2key(acc[kb][4 * rq + 1]) : 0u;
                    o.z = (c0 + 2 <= dq) ? f2key(acc[kb][4 * rq + 2]) : 0u; o.w = (c0 + 3 <= dq) ? f2key(acc[kb][4 * rq + 3]) : 0u;
                    *(u32x4*)(srow + c0) = o; }
        }
    }
    __builtin_amdgcn_s_barrier();
}
__device__ __forceinline__ int wave_sum_dpp(int x) {
    x += __builtin_amdgcn_update_dpp(0, x, 0x111, 0xf, 0xf, true);
    x += __builtin_amdgcn_update_dpp(0, x, 0x112, 0xf, 0xf, true);
    x += __builtin_amdgcn_update_dpp(0, x, 0x114, 0xf, 0xf, true);
    x += __builtin_amdgcn_update_dpp(0, x, 0x118, 0xf, 0xf, true);
    x += __builtin_amdgcn_update_dpp(0, x, 0x142, 0xa, 0xf, false);
    x += __builtin_amdgcn_update_dpp(0, x, 0x143, 0xc, 0xf, false);
    return __builtin_amdgcn_readlane(x, 63);
}
__device__ __forceinline__ void p_select(unsigned char* ws) {
    const unsigned* SC = (const unsigned*)(ws + WS_SCORE); unsigned* MASK = (unsigned*)(ws + WS_MASK);
    const int tid = opaque_tid(), lane = tid & 63, wv = __builtin_amdgcn_readfirstlane(tid >> 6);
    const unsigned voff = (unsigned)lane * 16u;
#define SEL_LOAD(KK, t_) do { const int nq_ = ((((t_) & 4095)) >> 8) + 1; const unsigned char* rb_ = (const unsigned char*)(SC + (size_t)(t_) * 4096); \
        _Pragma("unroll") for (int j = 0; j < 16; ++j) { const unsigned char* a_ = rb_ + 1024 * (j < nq_ ? j : nq_ - 1); asm volatile("global_load_dwordx4 %0, %1, %2" : "=v"(KK[j]) : "v"(voff), "s"(a_) : "memory"); } } while (0)
#define SEL_WAIT(KK) asm volatile("s_waitcnt vmcnt(0)" : "+v"(KK[0]), "+v"(KK[1]), "+v"(KK[2]), "+v"(KK[3]), "+v"(KK[4]), "+v"(KK[5]), "+v"(KK[6]), "+v"(KK[7]), "+v"(KK[8]), "+v"(KK[9]), "+v"(KK[10]), "+v"(KK[11]), \
        "+v"(KK[12]), "+v"(KK[13]), "+v"(KK[14]), "+v"(KK[15]) :: "memory")
    u32x4 ka[16], kb[16];
    const int nwaves = gridDim.x * 8, wid_ = opaque_bid() * 8 + wv; const bool paired = nwaves * 4 == T;
    const int nrows = paired ? 4 : (wid_ < T ? (T - wid_ + nwaves - 1) / nwaves : 0);
#define SEL_ROW(i_) (paired ? ((((i_) >> 1) << 12) + (((i_) & 1) ? 4095 - wid_ : wid_)) : wid_ + (i_) * nwaves)
#define SW(K, i_) K[(i_) >> 2][(i_) & 3]
#define SEL_XT(x_, s_, m_) do { const unsigned y_ = (unsigned)__shfl_xor((int)(x_), (s_)); x_ = (lane & (s_)) ? (((x_) & (m_)) | ((y_ & (m_)) >> (4 * (s_)))) : (((x_) & ~(m_)) | ((y_ & ~(m_)) << (4 * (s_)))); } while (0)
#define SEL_TS(K, B0, J, M) _Pragma("unroll") for (int k_ = 0; k_ < 32; ++k_) if (!(k_ & (J))) { const unsigned a_ = SW(K, (B0) + k_), b_ = SW(K, (B0) + k_ + (J)); \
        SW(K, (B0) + k_) = (a_ & (M)) | ((b_ << (J)) & ~(M)); SW(K, (B0) + k_ + (J)) = ((a_ >> (J)) & (M)) | (b_ & ~(M)); }
#define SEL_BODY(K, KN, ri_) do { \
        const int t = SEL_ROW(ri_); \
        const int ti = t & 4095, nq = (ti >> 8) + 1; \
        SEL_LOAD(KN, SEL_ROW((ri_) + 1 < nrows ? (ri_) + 1 : (ri_)));        \
          \
        const int jq = ti >> 8; int nvp = (ti & 255) - 4 * lane + 1; nvp = nvp < 0 ? 0 : (nvp > 4 ? 4 : nvp); const unsigned pn = (1u << nvp) - 1u; \
        const unsigned vb0 = jq >= 8 ? 0xffffffffu : (((1u << (4 * jq)) - 1u) | (pn << (4 * jq))), vb1 = jq >= 8 ? (((1u << (4 * (jq - 8))) - 1u) | (pn << (4 * (jq - 8)))) : 0u; \
          \
          \
          \
        unsigned sel0, sel1 = 0u; \
        if (ti >= 256) { \
            SEL_TS(K, 0, 16, 0x0000ffffu); SEL_TS(K, 0, 8, 0x00ff00ffu); SEL_TS(K, 0, 4, 0x0f0f0f0fu); SEL_TS(K, 0, 2, 0x33333333u); SEL_TS(K, 0, 1, 0x55555555u); \
            if (nq > 8) { SEL_TS(K, 32, 16, 0x0000ffffu); SEL_TS(K, 32, 8, 0x00ff00ffu); SEL_TS(K, 32, 4, 0x0f0f0f0fu); SEL_TS(K, 32, 2, 0x33333333u); SEL_TS(K, 32, 1, 0x55555555u); }     \
            unsigned gt0 = 0u, gt1 = 0u, eq0 = vb0, eq1 = vb1; int tgt = 0; bool found = false; \
            _Pragma("unroll") for (int bit = 31; bit >= 0; --bit) if (!found) {        \
                const unsigned t0 = eq0 & SW(K, bit), t1 = eq1 & SW(K, 32 + bit); \
                const unsigned c = (unsigned)__popc(t0) + (unsigned)__popc(t1);            \
                const int tot = tgt + wave_sum_dpp((int)c); \
                if (tot >= 256) { eq0 = t0; eq1 = t1;                   \
                    if (tot == 256) { sel0 = gt0 | t0; sel1 = gt1 | t1; found = true; } }        \
                else { gt0 |= t0; gt1 |= t1; eq0 ^= t0; eq1 ^= t1; tgt = tot; } \
            } \
            if (!found) { sel0 = gt0 | eq0; sel1 = gt1 | eq1; }        \
        } else sel0 = vb0;                                                \
        SEL_WAIT(KN); \
          \
        SEL_XT(sel0, 1, 0xf0f0f0f0u); SEL_XT(sel0, 2, 0xff00ff00u); SEL_XT(sel0, 4, 0xffff0000u); SEL_XT(sel1, 1, 0xf0f0f0f0u); SEL_XT(sel1, 2, 0xff00ff00u); SEL_XT(sel1, 4, 0xffff0000u); \
        unsigned* mrow = MASK + (size_t)t * 128 + 8 * (lane & 7) + (lane >> 3);        \
        mrow[0] = sel0; mrow[64] = sel1; } while (0)
    if (nrows > 0) { SEL_LOAD(ka, SEL_ROW(0)); SEL_WAIT(ka); }
#pragma unroll 1
    for (int ri = 0; ri < nrows; ri += 2) {
        SEL_BODY(ka, kb, ri);
        if (ri + 1 < nrows) SEL_BODY(kb, ka, ri + 1);
    }
#undef SEL_BODY
#undef SEL_TS
#undef SEL_XT
#undef SW
#undef SEL_ROW
#undef SEL_LOAD
#undef SEL_WAIT
}

template <int DQK, bool MASKED, int AMODE = 0>
__device__ __forceinline__ void attn_unit(LAS unsigned char* ldsb, const bf16_t* Qg, int ldq, const bf16_t* Kg, int ldk, const bf16_t* Vg, int ldv, const unsigned* maskg, bf16_t* Og, int ldo, int qb, float sl2) {
    constexpr int CPR = DQK / 8, KBYTES = 64 * DQK * 2, VBYTES = 64 * 128 * 2, NKI = CPR * 64 / 512, ND = DQK / 16;
    constexpr int STAGE = KBYTES + VBYTES;
    static_assert(NKI + 2 + (MASKED ? 1 : 0) == 5, "five vector-memory operations per thread and tile in both instantiations");
    const int tid = opaque_tid(), lane = tid & 63, wv = __builtin_amdgcn_readfirstlane(tid >> 6), r32 = lane & 31, hi = lane >> 5;
    const int NT = 4 * qb + 4, NT3 = ((NT + 2) / 3) * 3, q0 = qb * 256 + wv * 32;
    const float NEG = -__builtin_inff();
    bf16x8 qr[ND];
#pragma unroll
    for (int d0 = 0; d0 < ND; ++d0) qr[d0] = *(const bf16x8*)(Qg + (size_t)(q0 + r32) * ldq + 16 * d0 + 8 * hi);
    const bf16_t* ksrc[NKI]; const bf16_t* vsrc[2];
#pragma unroll
    for (int i = 0; i < NKI; ++i) { const int g = i * 512 + tid, row = g / CPR, cp = g - row * CPR; const int ch = cp ^ (DQK == 128 ? (row & 15) : ((row >> 1) & 7)); ksrc[i] = Kg + (size_t)row * ldk + ch * 8; }
#pragma unroll
    for (int i = 0; i < 2; ++i) { const int g = i * 512 + tid, row = g >> 4, c16 = g & 15; const int blk = (c16 >> 2) ^ (row & 3); vsrc[i] = Vg + (size_t)row * ldv + (blk * 4 + (c16 & 3)) * 8; }
    const unsigned* mrow = MASKED ? maskg + (size_t)(q0 + r32) * 128 : nullptr;
    u32x2 mw0 = {0u, 0u}, mw1 = {0u, 0u}, mw2 = {0u, 0u};
#define AT_ISSUE(MW, t_, st_) do { const int tt_ = (t_) < NT ? (t_) : NT - 1; \
        if (MASKED) asm volatile("global_load_dwordx2 %0, %1, off" : "=v"(MW) : "v"(mrow + 2 * tt_) : "memory"); \
        _Pragma("unroll") for (int i_ = 0; i_ < NKI; ++i_) __builtin_amdgcn_global_load_lds((const unsigned*)(ksrc[i_] + (size_t)tt_ * 64 * ldk), (LAS unsigned*)(ldsb + (st_) * STAGE + (i_ * 512 + wv * 64) * 16), 16, 0, 0); \
        _Pragma("unroll") for (int i_ = 0; i_ < 2; ++i_) __builtin_amdgcn_global_load_lds((const unsigned*)(vsrc[i_] + (size_t)tt_ * 64 * ldv), (LAS unsigned*)(ldsb + (st_) * STAGE + KBYTES + (i_ * 512 + wv * 64) * 16), 16, 0, 0); } while (0)
#define AT_WAIT(n_) asm volatile("s_waitcnt vmcnt(" #n_ ")" : "+v"(mw0), "+v"(mw1), "+v"(mw2) :: "memory")
    const int ksw = (DQK == 128 ? (r32 & 15) : ((r32 >> 1) & 7)) ^ hi;
    const unsigned krow = (unsigned)(size_t)ldsb + (unsigned)r32 * (DQK * 2);
    const int vq = (lane >> 2) & 3, vp = lane & 3, vg = lane >> 4;
    const unsigned vrow = (unsigned)(size_t)ldsb + KBYTES + (unsigned)(4 * (vg >> 1) + vq) * 256 + (vg & 1) * 32 + vp * 8;
    float m_run = -1e30f, l_run = 0.f; const float mth = 8.f / sl2;
    f32x16 oT[4];
#pragma unroll
    for (int d0 = 0; d0 < 4; ++d0)
#pragma unroll
        for (int r = 0; r < 16; ++r) oT[d0][r] = 0.f;
    AT_ISSUE(mw0, 0, 0); AT_ISSUE(mw1, 1, 1);
    AT_WAIT(5);
    __builtin_amdgcn_s_barrier();
#define TRRD(dst, addr, off) asm volatile("ds_read_b64_tr_b16 %0, %1 offset:%2" : "=&v"(dst) : "v"(addr), "i"(off) : "memory")
#define AT_STEP(t_, st_, MWCUR, MWNEW) do { \
        const int t = (t_); \
        AT_ISSUE(MWNEW, t + 2, ((st_) + 2) % 3);                    \
        if (t * 64 <= q0 + 31) {                                    \
            int kx = ksw; asm volatile("" : "+v"(kx)); \
            f32x16 p0, p1; \
            _Pragma("unroll") for (int r = 0; r < 16; ++r) { p0[r] = 0.f; p1[r] = 0.f; } \
            _Pragma("unroll") for (int d0 = 0; d0 < ND; ++d0) { \
                const unsigned ka = krow + (st_) * STAGE + ((unsigned)((2 * d0) ^ kx) << 4); \
                const bf16x8 a0 = *(const LAS bf16x8*)(size_t)ka; const bf16x8 a1 = *(const LAS bf16x8*)(size_t)(ka + 32 * DQK * 2); \
                if (AMODE != 3) { p0 = __builtin_amdgcn_mfma_f32_32x32x16_bf16(a0, qr[d0], p0, 0, 0, 0); \
                p1 = __builtin_amdgcn_mfma_f32_32x32x16_bf16(a1, qr[d0], p1, 0, 0, 0); } else { asm volatile("" :: "v"(a0), "v"(a1)); } } \
            if (AMODE != 1) { if (MASKED) {                         \
                const int wx_ = (int)(MWCUR.x >> (4 * hi)), wy_ = (int)(MWCUR.y >> (4 * hi)); \
                _Pragma("unroll") for (int r = 0; r < 16; ++r) { const int c = (r & 3) + 8 * (r >> 2); \
                    const unsigned mx_ = (unsigned)__builtin_amdgcn_sbfe(wx_, c, 1), my_ = (unsigned)__builtin_amdgcn_sbfe(wy_, c, 1); \
                    p0[r] = __uint_as_float((__float_as_uint(p0[r]) & mx_) | (0xff800000u & ~mx_)); p1[r] = __uint_as_float((__float_as_uint(p1[r]) & my_) | (0xff800000u & ~my_)); } \
            } else if (t * 64 + 63 > q0) {                          \
                const int dq = q0 + r32 - t * 64 - 4 * hi; \
                _Pragma("unroll") for (int r = 0; r < 16; ++r) { const int c = (r & 3) + 8 * (r >> 2); if (c > dq) p0[r] = NEG; if (c + 32 > dq) p1[r] = NEG; } \
            } \
            float mx = p0[0]; \
            _Pragma("unroll") for (int r = 1; r < 16; ++r) mx = fmaxf(mx, p0[r]); \
            _Pragma("unroll") for (int r = 0; r < 16; ++r) mx = fmaxf(mx, p1[r]); \
            { auto rr = __builtin_amdgcn_permlane32_swap(__float_as_uint(mx), __float_as_uint(mx), false, false); mx = fmaxf(__uint_as_float(rr[0]), __uint_as_float(rr[1])); } \
            const float mnew = (mx > m_run + mth) ? mx : m_run;     \
            const float alpha = __builtin_amdgcn_exp2f((m_run - mnew) * sl2); \
            m_run = mnew; const float mb = -mnew * sl2; \
            float ps = 0.f; \
            _Pragma("unroll") for (int r = 0; r < 16; ++r) { p0[r] = __builtin_amdgcn_exp2f(fmaf(p0[r], sl2, mb)); ps += p0[r]; } \
            _Pragma("unroll") for (int r = 0; r < 16; ++r) { p1[r] = __builtin_amdgcn_exp2f(fmaf(p1[r], sl2, mb)); ps += p1[r]; } \
            l_run = l_run * alpha + ps; \
            if (__any(alpha != 1.f)) { \
                  \
                _Pragma("unroll") for (int d0 = 0; d0 < 4; ++d0) _Pragma("unroll") for (int r = 0; r < 16; ++r) { float ov = oT[d0][r]; asm("v_mul_f32 %0, %1, %0" : "+v"(ov) : "v"(alpha)); oT[d0][r] = ov; } } } \
            bf16x8 pb[4];                                            \
            { u32x4 w; \
              w.x = pkbf(p0[0], p0[1]); w.y = pkbf(p0[2], p0[3]); w.z = pkbf(p0[4], p0[5]); w.w = pkbf(p0[6], p0[7]); pb[0] = *reinterpret_cast<bf16x8*>(&w); \
              w.x = pkbf(p0[8], p0[9]); w.y = pkbf(p0[10], p0[11]); w.z = pkbf(p0[12], p0[13]); w.w = pkbf(p0[14], p0[15]); pb[1] = *reinterpret_cast<bf16x8*>(&w); \
              w.x = pkbf(p1[0], p1[1]); w.y = pkbf(p1[2], p1[3]); w.z = pkbf(p1[4], p1[5]); w.w = pkbf(p1[6], p1[7]); pb[2] = *reinterpret_cast<bf16x8*>(&w); \
              w.x = pkbf(p1[8], p1[9]); w.y = pkbf(p1[10], p1[11]); w.z = pkbf(p1[12], p1[13]); w.w = pkbf(p1[14], p1[15]); pb[3] = *reinterpret_cast<bf16x8*>(&w); } \
            int vx = vq; asm volatile("" : "+v"(vx)); \
            _Pragma("unroll") for (int d0 = 0; d0 < 4; ++d0) { \
                const unsigned va = vrow + (st_) * STAGE + ((unsigned)(d0 ^ vx) << 6); \
                s16x4 l0, h0, l1, h1, l2, h2, l3, h3; \
                TRRD(l0, va, 0); TRRD(h0, va, 2048); TRRD(l1, va, 4096); TRRD(h1, va, 6144); TRRD(l2, va, 8192); TRRD(h2, va, 10240); TRRD(l3, va, 12288); TRRD(h3, va, 14336); \
                asm volatile("s_waitcnt lgkmcnt(0)" ::: "memory"); __builtin_amdgcn_sched_barrier(0); \
                if (AMODE == 2) { asm volatile("" :: "v"(l0), "v"(h0), "v"(l1), "v"(h1), "v"(l2), "v"(h2), "v"(l3), "v"(h3), "v"(pb[0]), "v"(pb[1]), "v"(pb[2]), "v"(pb[3])); continue; } \
                oT[d0] = __builtin_amdgcn_mfma_f32_32x32x16_bf16((bf16x8){l0[0], l0[1], l0[2], l0[3], h0[0], h0[1], h0[2], h0[3]}, pb[0], oT[d0], 0, 0, 0); \
                oT[d0] = __builtin_amdgcn_mfma_f32_32x32x16_bf16((bf16x8){l1[0], l1[1], l1[2], l1[3], h1[0], h1[1], h1[2], h1[3]}, pb[1], oT[d0], 0, 0, 0); \
                oT[d0] = __builtin_amdgcn_mfma_f32_32x32x16_bf16((bf16x8){l2[0], l2[1], l2[2], l2[3], h2[0], h2[1], h2[2], h2[3]}, pb[2], oT[d0], 0, 0, 0); \
                oT[d0] = __builtin_amdgcn_mfma_f32_32x32x16_bf16((bf16x8){l3[0], l3[1], l3[2], l3[3], h3[0], h3[1], h3[2], h3[3]}, pb[3], oT[d0], 0, 0, 0); } \
        } \
        AT_WAIT(5);                                                 \
        asm volatile("s_waitcnt lgkmcnt(0)" ::: "memory"); \
        __builtin_amdgcn_s_barrier(); } while (0)
#pragma unroll 1
    for (int tt = 0; tt < NT3; tt += 3) { AT_STEP(tt, 0, mw0, mw2); AT_STEP(tt + 1, 1, mw1, mw0); AT_STEP(tt + 2, 2, mw2, mw1); }
    AT_WAIT(0);
    __builtin_amdgcn_s_barrier();
#undef AT_STEP
#undef AT_ISSUE
#undef AT_WAIT
#undef TRRD
    { auto rr = __builtin_amdgcn_permlane32_swap(__float_as_uint(l_run), __float_as_uint(l_run), false, false); l_run = __uint_as_float(rr[0]) + __uint_as_float(rr[1]); }
    const float inv = 1.f / l_run;
    bf16_t* orow = Og + (size_t)(q0 + r32) * ldo + 4 * hi;
#pragma unroll
    for (int d0 = 0; d0 < 4; ++d0)
#pragma unroll
        for (int rq = 0; rq < 4; ++rq) { u32x2 w; w.x = pkbf(oT[d0][4 * rq] * inv, oT[d0][4 * rq + 1] * inv); w.y = pkbf(oT[d0][4 * rq + 2] * inv, oT[d0][4 * rq + 3] * inv);
            *(u32x2*)(orow + 32 * d0 + 8 * rq) = w; }
}
template <int AMODE>
__device__ __forceinline__ void p_attn(LAS unsigned char* ldsb, unsigned char* ws) {
    const bf16_t* QA = (const bf16_t*)(ws + WS_QA); const bf16_t* KA = (const bf16_t*)(ws + WS_KA); const bf16_t* VA = (const bf16_t*)(ws + WS_VA); bf16_t* OA = (bf16_t*)(ws + WS_OA);
    const bf16_t* QB = (const bf16_t*)(ws + WS_QB); const bf16_t* KB = (const bf16_t*)(ws + WS_KB); const bf16_t* VB = (const bf16_t*)(ws + WS_VB); bf16_t* OB = (bf16_t*)(ws + WS_OB);
    const unsigned* MASK = (const unsigned*)(ws + WS_MASK);
    for (int w = opaque_bid(); w < 256; w += gridDim.x) {
        const int bh = (w & 7) * 2 + ((w >> 3) & 1), i = w >> 4, b = bh >> 3, h = bh & 7;
        const size_t r0 = (size_t)b * S;
        attn_unit<192, false, AMODE>(ldsb, QA + r0 * 1536 + h * 192, 1536, KA + r0 * 1536 + h * 192, 1536, VA + r0 * 1024 + h * 128, 1024, nullptr, OA + r0 * 1024 + h * 128, 1024, i, 0.07216878364870322f * 1.4426950408889634f);
        attn_unit<128, true, AMODE>(ldsb, QB + r0 * 1024 + h * 128, 1024, KB + r0 * 1024 + h * 128, 1024, VB + r0 * 1024 + h * 128, 1024, MASK + r0 * 128, OB + r0 * 1024 + h * 128, 1024, 15 - i, 0.08838834764831845f * 1.4426950408889634f);
    }
}

__device__ __forceinline__ void moe_tables256(int* tab, const unsigned* cnt, int ncol_tiles) {
    const int tid_ = opaque_tid();
    if (tid_ == 0) { int a = 0, bsum = 0; for (int e = 0; e < 64; ++e) { tab[e] = a; tab[80 + e] = bsum; const int c = (int)cnt[e], nrb = (c + MOE_RBLK - 1) / MOE_RBLK; tab[160 + e] = nrb; a += nrb * ncol_tiles; bsum += nrb * MOE_RBLK; } tab[64] = a; tab[80 + 64] = bsum; }
    if (tid_ >= 64 && tid_ < 128) {
        const int e = tid_ - 64; const unsigned c = cnt[e]; int rank = 0;
        for (int o = 0; o < 64; ++o) { const unsigned co = cnt[o]; rank += (co > c || (co == c && o < e)) ? 1 : 0; }
        tab[240 + rank] = e; }
    __syncthreads();
}
template <int RMODE>
__device__ __forceinline__ void p_ln1_route3(LAS unsigned char* ldsb, unsigned char* ws, const float* g, const float* bb, int l) {
    const float* V1 = (const float*)(ws + WS_V1); bf16_t* H1B = (bf16_t*)(ws + WS_H1B); float* STATS = (float*)(ws + WS_STATS);
    const float* sec = (const float*)(ws + WS_SEC) + l * 160;
    unsigned* cnt = (unsigned*)(ws + WS_CNT) + l * 64; int* LIST = (int*)(ws + WS_LIST);
    int* TOKE = (int*)(ws + WS_TOKE); float* TOKW = (float*)(ws + WS_TOKW); int* TOKS = (int*)(ws + WS_TOKS);
    const int tid = opaque_tid(), lane = tid & 63, wv = __builtin_amdgcn_readfirstlane(tid >> 6);
    LAS float* red = (LAS float*)ldsb;
    LAS float* stl = red + 8 * 32 * 96;
    for (int unit = opaque_bid(); unit < T / 32; unit += gridDim.x) {
        const int t0 = unit * 32;
        if (RMODE != 2) {
            const size_t ro = (size_t)(t0 + 4 * wv) * D + 4 * lane;
            f32x4 v[4][8]; float s1[4], s2[4], mean[4], rstd[4];
#pragma unroll
            for (int i = 0; i < 4; ++i)
#pragma unroll
                for (int j = 0; j < 8; ++j) v[i][j] = *(const f32x4*)(V1 + ro + (size_t)i * D + 256 * j);
#pragma unroll
            for (int i = 0; i < 4; ++i) { s1[i] = 0.f;
#pragma unroll
                for (int j = 0; j < 8; ++j) s1[i] += (v[i][j][0] + v[i][j][1]) + (v[i][j][2] + v[i][j][3]); }
#pragma unroll
            for (int o = 32; o >= 1; o >>= 1) { s1[0] += __shfl_xor(s1[0], o); s1[1] += __shfl_xor(s1[1], o); s1[2] += __shfl_xor(s1[2], o); s1[3] += __shfl_xor(s1[3], o); }
#pragma unroll
            for (int i = 0; i < 4; ++i) { mean[i] = s1[i] * (1.f / D); s2[i] = 0.f;
#pragma unroll
                for (int j = 0; j < 8; ++j) { v[i][j] = v[i][j] - mean[i]; s2[i] += (v[i][j][0] * v[i][j][0] + v[i][j][1] * v[i][j][1]) + (v[i][j][2] * v[i][j][2] + v[i][j][3] * v[i][j][3]); } }
#pragma unroll
            for (int o = 32; o >= 1; o >>= 1) { s2[0] += __shfl_xor(s2[0], o); s2[1] += __shfl_xor(s2[1], o); s2[2] += __shfl_xor(s2[2], o); s2[3] += __shfl_xor(s2[3], o); }
#pragma unroll
            for (int i = 0; i < 4; ++i) { rstd[i] = rsqrtf(s2[i] * (1.f / D) + 1e-5f);
                if (lane == 0) { stl[(4 * wv + i) * 2] = mean[i]; stl[(4 * wv + i) * 2 + 1] = rstd[i]; STATS[(size_t)(t0 + 4 * wv + i) * 2] = mean[i]; STATS[(size_t)(t0 + 4 * wv + i) * 2 + 1] = rstd[i]; } }
            f32x4 gg[8], b4[8];
#pragma unroll
            for (int j = 0; j < 8; ++j) { gg[j] = *(const f32x4*)(g + 4 * lane + 256 * j); b4[j] = *(const f32x4*)(bb + 4 * lane + 256 * j); }
#pragma unroll
            for (int j = 0; j < 8; ++j)
#pragma unroll
                for (int i = 0; i < 4; ++i) st4bf(H1B + ro + (size_t)i * D + 256 * j, v[i][j] * rstd[i] * gg[j] + b4[j]);
        }
        if (RMODE != 1) {
            f32x16 c0, c1, c2;
#pragma unroll
            for (int r = 0; r < 16; ++r) { c0[r] = 0.f; c1[r] = 0.f; c2[r] = 0.f; }
            const int j = lane & 31, kh = lane >> 5, kb = 256 * wv + 8 * kh;
            const float* hp = V1 + (size_t)(t0 + j) * D + kb;
            const bf16_t* wh = (const bf16_t*)(ws + WS_RWH) + (size_t)l * (96 * D) + (size_t)wv * (16 * 1536) + (kh * 32 + j) * 8;
            const bf16_t* wl = (const bf16_t*)(ws + WS_RWL) + (size_t)l * (96 * D) + (size_t)wv * (16 * 1536) + (kh * 32 + j) * 8;
            f32x4 xa0, xa1, xb0, xb1; bf16x8 ha0, ha1, ha2, la0, la1, la2, hb0, hb1, hb2, lb0, lb1, lb2;
#define RT_LOAD(X0, X1, H0, H1, H2, L0, L1, L2, st_) do { const float* px_ = hp + 16 * (st_); const bf16_t* ph_ = wh + 1536 * (st_); const bf16_t* pl_ = wl + 1536 * (st_); \
                asm volatile("global_load_dwordx4 %0, %1, off" : "=v"(X0) : "v"(px_) : "memory"); asm volatile("global_load_dwordx4 %0, %1, off offset:16" : "=v"(X1) : "v"(px_) : "memory"); \
                asm volatile("global_load_dwordx4 %0, %1, off" : "=v"(H0) : "v"(ph_) : "memory"); asm volatile("global_load_dwordx4 %0, %1, off offset:1024" : "=v"(H1) : "v"(ph_) : "memory"); \
                asm volatile("global_load_dwordx4 %0, %1, off offset:2048" : "=v"(H2) : "v"(ph_) : "memory"); \
                asm volatile("global_load_dwordx4 %0, %1, off" : "=v"(L0) : "v"(pl_) : "memory"); asm volatile("global_load_dwordx4 %0, %1, off offset:1024" : "=v"(L1) : "v"(pl_) : "memory"); \
                asm volatile("global_load_dwordx4 %0, %1, off offset:2048" : "=v"(L2) : "v"(pl_) : "memory"); } while (0)
#define RT_WAIT(n_) asm volatile("s_waitcnt vmcnt(" #n_ ")" : "+v"(xa0), "+v"(xa1), "+v"(ha0), "+v"(ha1), "+v"(ha2), "+v"(la0), "+v"(la1), "+v"(la2), "+v"(xb0), "+v"(xb1), "+v"(hb0), "+v"(hb1), "+v"(hb2), "+v"(lb0), "+v"(lb1), "+v"(lb2) :: "memory")
#define RT_STEP(x0, x1, bh0, bh1, bh2, bl0, bl1, bl2) do { \
                u32x4 hw; hw.x = pkbf(x0[0], x0[1]); hw.y = pkbf(x0[2], x0[3]); hw.z = pkbf(x1[0], x1[1]); hw.w = pkbf(x1[2], x1[3]); \
                u32x4 lw; lw.x = pkbf(x0[0] - __uint_as_float(hw.x << 16), x0[1] - __uint_as_float(hw.x & 0xffff0000u)); lw.y = pkbf(x0[2] - __uint_as_float(hw.y << 16), x0[3] - __uint_as_float(hw.y & 0xffff0000u)); \
                lw.z = pkbf(x1[0] - __uint_as_float(hw.z << 16), x1[1] - __uint_as_float(hw.z & 0xffff0000u)); lw.w = pkbf(x1[2] - __uint_as_float(hw.w << 16), x1[3] - __uint_as_float(hw.w & 0xffff0000u)); \
                const bf16x8 ah = *reinterpret_cast<bf16x8*>(&hw), al = *reinterpret_cast<bf16x8*>(&lw); \
                c0 = __builtin_amdgcn_mfma_f32_32x32x16_bf16(ah, bh0, c0, 0, 0, 0); c1 = __builtin_amdgcn_mfma_f32_32x32x16_bf16(ah, bh1, c1, 0, 0, 0); c2 = __builtin_amdgcn_mfma_f32_32x32x16_bf16(ah, bh2, c2, 0, 0, 0); \
                c0 = __builtin_amdgcn_mfma_f32_32x32x16_bf16(ah, bl0, c0, 0, 0, 0); c1 = __builtin_amdgcn_mfma_f32_32x32x16_bf16(ah, bl1, c1, 0, 0, 0); c2 = __builtin_amdgcn_mfma_f32_32x32x16_bf16(ah, bl2, c2, 0, 0, 0); \
                c0 = __builtin_amdgcn_mfma_f32_32x32x16_bf16(al, bh0, c0, 0, 0, 0); c1 = __builtin_amdgcn_mfma_f32_32x32x16_bf16(al, bh1, c1, 0, 0, 0); c2 = __builtin_amdgcn_mfma_f32_32x32x16_bf16(al, bh2, c2, 0, 0, 0); } while (0)
            RT_LOAD(xa0, xa1, ha0, ha1, ha2, la0, la1, la2, 0);
#pragma unroll 1
            for (int st = 0; st < 16; st += 2) {
                RT_LOAD(xb0, xb1, hb0, hb1, hb2, lb0, lb1, lb2, st + 1);
                RT_WAIT(8);
                RT_STEP(xa0, xa1, ha0, ha1, ha2, la0, la1, la2);
                RT_LOAD(xa0, xa1, ha0, ha1, ha2, la0, la1, la2, (st + 2) & 15);
                RT_WAIT(8);
                RT_STEP(xb0, xb1, hb0, hb1, hb2, lb0, lb1, lb2);
            }
            RT_WAIT(0);
#undef RT_LOAD
#undef RT_WAIT
#undef RT_STEP
#pragma unroll
            for (int r = 0; r < 16; ++r) { const int tr = (r & 3) + 8 * (r >> 2) + 4 * kh; LAS float* o = red + (wv * 32 + tr) * 96 + j; o[0] = c0[r]; o[32] = c1[r]; o[64] = c2[r]; }
        }
        __syncthreads();
        for (int idx = tid; idx < 32 * 72; idx += NTHREADS) { const int tk = idx / 72, c = idx - tk * 72;
            float sacc = 0.f;
#pragma unroll
            for (int w = 0; w < 8; ++w) sacc += red[(w * 32 + tk) * 96 + c];
            red[tk * 96 + c] = stl[tk * 2 + 1] * (sacc - stl[tk * 2] * sec[c]) + sec[80 + c]; }
        __syncthreads();
        if (RMODE == 0 && tid < 32) {
            const int t = t0 + tid; const LAS float* lg = red + tid * 96;
            float gl[8]; float gmax = -__builtin_inff(); int gi = 0;
#pragma unroll
            for (int i = 0; i < 8; ++i) { gl[i] = lg[64 + i]; if (gl[i] > gmax) { gmax = gl[i]; gi = i; } }
            float gs = 0.f;
#pragma unroll
            for (int i = 0; i < 8; ++i) gs += __expf(gl[i] - gmax);
            const float gp = 1.f / gs;
            float el[8]; float emax = -__builtin_inff(); int e1 = 0;
#pragma unroll
            for (int i = 0; i < 8; ++i) { el[i] = lg[gi * 8 + i]; if (el[i] > emax) { emax = el[i]; e1 = i; } }
            float e2max = -__builtin_inff(); int e2 = 0;
#pragma unroll
            for (int i = 0; i < 8; ++i) { if (i != e1 && el[i] > e2max) { e2max = el[i]; e2 = i; } }
            const float p2 = __expf(e2max - emax);
            const float wa = gp / (1.f + p2), wb = gp * p2 / (1.f + p2);
            const int ea = gi * 8 + e1, eb = gi * 8 + e2;
            const int sa = (int)atomicAdd(cnt + ea, 1u), sb = (int)atomicAdd(cnt + eb, 1u);
            LIST[(size_t)ea * ECAP + sa] = t; LIST[(size_t)eb * ECAP + sb] = t;
            TOKE[t * 2] = ea; TOKE[t * 2 + 1] = eb; TOKW[t * 2] = wa; TOKW[t * 2 + 1] = wb; TOKS[t * 2] = sa; TOKS[t * 2 + 1] = sb;
        }
        __syncthreads();
    }
}
__device__ __forceinline__ void p_ln2v2(LAS unsigned char* ldsb, unsigned char* ws, const float* g1, const float* b1, const float* g, const float* bb, float* outF, int l) {
    const unsigned* cnt = (const unsigned*)(ws + WS_CNT) + l * 64;
    const bf16_t* H1B = (const bf16_t*)(ws + WS_H1B); const bf16_t* YE = (const bf16_t*)(ws + WS_YE);
    const int* TOKE = (const int*)(ws + WS_TOKE); const float* TOKW = (const float*)(ws + WS_TOKW); const int* TOKS = (const int*)(ws + WS_TOKS);
    bf16_t* XB = (bf16_t*)(ws + WS_XB);
    int* tab = (int*)(unsigned char*)ldsb;
    __syncthreads();
    moe_tables256(tab, cnt, 1);
    const int tid = opaque_tid(), lane = tid & 63, wv = tid >> 6;
    const int tstride = gridDim.x * 8;
#define LN2_META(t_, R0, R1, W0, W1) do { const int tt_ = (t_) < T ? (t_) : T - 1; R0 = tab[80 + TOKE[tt_ * 2]] + TOKS[tt_ * 2]; R1 = tab[80 + TOKE[tt_ * 2 + 1]] + TOKS[tt_ * 2 + 1]; W0 = TOKW[tt_ * 2]; W1 = TOKW[tt_ * 2 + 1]; } while (0)
#define LN2_ROWS(t_, R0, R1, HH, Y0, Y1) do { const int tt_ = (t_) < T ? (t_) : T - 1; \
        _Pragma("unroll") for (int j = 0; j < 8; ++j) { HH[j] = *(const u32x2*)(H1B + (size_t)tt_ * D + 4 * lane + 256 * j); Y0[j] = *(const u32x2*)(YE + (size_t)(R0) * D + 4 * lane + 256 * j); Y1[j] = *(const u32x2*)(YE + (size_t)(R1) * D + 4 * lane + 256 * j); } } while (0)
#define LN2_TOKEN(t_, HH, Y0, Y1, W0, W1) do { if ((t_) < T) { const size_t ro = (size_t)(t_) * D + 4 * lane; f32x4 v[8]; float s1 = 0.f; \
        _Pragma("unroll") for (int j = 0; j < 8; ++j) { v[j] = bf4(HH[j]) * ALPHA + bf4(Y0[j]) * (W0) + bf4(Y1[j]) * (W1); s1 += (v[j][0] + v[j][1]) + (v[j][2] + v[j][3]); } \
        const float mean = wave_sum(s1) * (1.f / D); float s2 = 0.f; \
        _Pragma("unroll") for (int j = 0; j < 8; ++j) { v[j] = v[j] - mean; s2 += (v[j][0] * v[j][0] + v[j][1] * v[j][1]) + (v[j][2] * v[j][2] + v[j][3] * v[j][3]); } \
        const float rstd = rsqrtf(wave_sum(s2) * (1.f / D) + 1e-5f); \
        _Pragma("unroll") for (int j = 0; j < 8; ++j) { const f32x4 o = v[j] * rstd * gg[j] + b4[j]; \
            *(f32x4*)(outF + ro + 256 * j) = o; if (l != DEPTH - 1) st4bf(XB + ro + 256 * j, o); } } } while (0)
    int t = opaque_bid() * 8 + wv;
    f32x4 gg[8], b4[8];
#pragma unroll
    for (int j = 0; j < 8; ++j) { gg[j] = *(const f32x4*)(g + 4 * lane + 256 * j); b4[j] = *(const f32x4*)(bb + 4 * lane + 256 * j); }
    int ra0, ra1, rb0, rb1; float wa0, wa1, wb0, wb1;
    LN2_META(t, ra0, ra1, wa0, wa1); LN2_META(t + tstride, rb0, rb1, wb0, wb1);
    for (; t < T; t += 2 * tstride) {
        u32x2 ha[8], ya0[8], ya1[8], hb[8], yb0[8], yb1[8];
        LN2_ROWS(t, ra0, ra1, ha, ya0, ya1); LN2_ROWS(t + tstride, rb0, rb1, hb, yb0, yb1);
        int na0, na1, nb0, nb1; float nwa0, nwa1, nwb0, nwb1;
        LN2_META(t + 2 * tstride, na0, na1, nwa0, nwa1); LN2_META(t + 3 * tstride, nb0, nb1, nwb0, nwb1);
        LN2_TOKEN(t, ha, ya0, ya1, wa0, wa1);
        LN2_TOKEN(t + tstride, hb, yb0, yb1, wb0, wb1);
        ra0 = na0; ra1 = na1; rb0 = nb0; rb1 = nb1; wa0 = nwa0; wa1 = nwa1; wb0 = nwb0; wb1 = nwb1;
    }
#undef LN2_META
#undef LN2_ROWS
#undef LN2_TOKEN
    __syncthreads();
}

template <bool GATED, int PMODE = 0>
__device__ __forceinline__ void moe_gemm(LAS unsigned char* ldsb, const int* tab, const unsigned* cnt, const int* LIST, const bf16_t* Asrc, const float* W0, const float* W1, bf16_t* Out) {
    constexpr int K = GATED ? D : FE, NT = K / 32, NCT = GATED ? FE / 64 : D / 128, LDW = GATED ? FE : D, LDO = GATED ? FE : D;
    constexpr int RBLK = MOE_RBLK, MT = RBLK / 64, NAG = RBLK / 64;
    static_assert(RBLK % 64 == 0 && (NAG == 6 || NAG == 5 || NAG == 3), "the counted waits below are written for 6, 5 or 3 A granules per thread");
    constexpr int ASLOT = RBLK * 128, BOFF = 2 * ASLOT, BBYTES = 32 * 256;
    const int tid = opaque_tid(), lane = tid & 63, wv = __builtin_amdgcn_readfirstlane(tid >> 6), wm = wv >> 1, wn = wv & 1, l15 = lane & 15, kq = lane >> 4;
    const unsigned lbase = (unsigned)(size_t)ldsb;
    const int arow = wm * (16 * MT) + l15;
    const unsigned afr = lbase + (unsigned)arow * 128u; const int asw = ((arow >> 1) & 7) ^ kq;
    const int bq = (lane >> 2) & 3, bp = lane & 3, bkey = bq | ((kq & 1) << 2);
    const unsigned bfr = lbase + BOFF + (unsigned)(8 * kq + bq) * 256u + 8u * bp;
    unsigned bb[4];
#pragma unroll
    for (int j = 0; j < 4; ++j) { const int np = GATED ? ((j >> 1) * 4 + 2 * wn + (j & 1)) : (4 * wn + j); bb[j] = bfr + ((unsigned)(np ^ bkey) << 5); }
    const int sa_r = tid >> 3, sa_p = tid & 7;
    const int sb_k = tid >> 5, sb_n = 4 * (tid & 31);
    const int G = gridDim.x;
    const int NI = 64 * NCT;
#define MG_DECODE(i0_, e_, ct_) do { const int rnd = (i0_) / G, pos = (i0_) - rnd * G; int rank; \
      if ((G & 7) == 0 && ((G >> 3) % NCT) == 0 && (64 * NCT) % G == 0) { const int x = pos & 7, j = pos >> 3, epx = (G >> 3) / NCT;         \
          rank = rnd * (G / NCT) + x * epx + j / NCT; ct_ = j % NCT; if (rnd & 1) rank = rnd * (G / NCT) + (G / NCT - 1) - (x * epx + j / NCT); } \
      else { rank = (i0_) / NCT; ct_ = (i0_) % NCT; } \
      e_ = tab[240 + rank]; } while (0)
#define MG_AOFF(AO, e_, rb_, ce_, base_) do { _Pragma("unroll") for (int i = 0; i < NAG; ++i) { const int rl = i * 64 + sa_r, r = (rb_) * RBLK + rl; const int ch = sa_p ^ ((rl >> 1) & 7); \
            if (GATED) { const int rc_ = r < (ce_) ? r : ((ce_) > 0 ? (ce_) - 1 : 0); const int tok = LIST[(size_t)(e_) * ECAP + rc_] & (T - 1);     \
                AO[i] = (unsigned)tok * (unsigned)(K * 2) + ch * 16; } \
            else AO[i] = (unsigned)((base_) + r) * (unsigned)(K * 2) + ch * 16; } } while (0)
#define MG_WP(e_, ct_) ((GATED ? (sb_n < 64 ? W0 : W1) : W0) + (size_t)(e_) * K * LDW + (size_t)sb_k * LDW + (GATED ? (ct_) * 64 + (sb_n & 63) : (ct_) * 128 + sb_n))
#define MG_TROT(e_, ct_) ((((e_) * 5 + (ct_) * 9) & (NT - 1)) & ~1)
    int i0 = opaque_bid();
    if (i0 < NI) {
      int e, ct; MG_DECODE(i0, e, ct);
      int ce = (int)cnt[e], base = tab[80 + e], nrb = tab[160 + e] > 0 ? tab[160 + e] : 1, rb = 0;
      unsigned aoff[NAG], aoffn[NAG];
      MG_AOFF(aoff, e, rb, ce, base);
      const float* wp = MG_WP(e, ct); int trot = MG_TROT(e, ct);
      const float* wpn = wp; int trotn = trot;
      f32x4 rq0[2], rq1[2], rq2[2], rq3[2];
#define MG_ISSUE_A(t_, slot_) do { const bool nx_ = (t_) >= NT; const int ta_ = ((((nx_ ? (t_) - NT : (t_))) + (nx_ ? trotn : trot)) & (NT - 1)) >> 1;        \
            _Pragma("unroll") for (int i = 0; i < NAG; ++i) __builtin_amdgcn_global_load_lds((const unsigned*)((const unsigned char*)Asrc + (nx_ ? aoffn[i] : aoff[i]) + (PMODE == 1 ? 0 : ta_ * 128)), (LAS unsigned*)(ldsb + (slot_) * ASLOT + (i * 512 + wv * 64) * 16), 16, 0, 0); } while (0)
#define MG_ISSUE_B(RB, t_) do { const bool nx_ = (t_) >= NT; const int tb_ = ((nx_ ? (t_) - NT : (t_)) + (nx_ ? trotn : trot)) & (NT - 1); const float* wq_ = nx_ ? wpn : wp; \
            _Pragma("unroll") for (int i = 0; i < 2; ++i) asm volatile("global_load_dwordx4 %0, %1, off nt" : "=v"(RB[i]) : "v"(wq_ + (size_t)((PMODE == 2 ? 0 : tb_ * 32) + 16 * i) * LDW) : "memory"); } while (0)
#define MG_WAIT_ALL(n_) asm volatile("s_waitcnt vmcnt(" #n_ ")" : "+v"(rq0[0]), "+v"(rq0[1]), "+v"(rq1[0]), "+v"(rq1[1]), "+v"(rq2[0]), "+v"(rq2[1]), "+v"(rq3[0]), "+v"(rq3[1]) :: "memory")
#define MG_WRITE_B(RB, buf_) do { _Pragma("unroll") for (int i = 0; i < 2; ++i) { const int k = sb_k + 16 * i; u32x2 w; w.x = pkbf(RB[i][0], RB[i][1]); w.y = pkbf(RB[i][2], RB[i][3]); \
            *(LAS u32x2*)(ldsb + BOFF + (buf_) * BBYTES + k * 256 + ((((sb_n >> 4) ^ ((k & 3) | (((k >> 3) & 1) << 2)))) << 5) + (sb_n & 15) * 2) = w; } } while (0)
#define TRRD(dst, addr, off) asm volatile("ds_read_b64_tr_b16 %0, %1 offset:%2" : "=&v"(dst) : "v"(addr), "i"(off) : "memory")
#define MG_COMPUTE(slot_, half_, buf_) do { if (PMODE != 0) break; \
            s16x4 b0l, b0h, b1l, b1h, b2l, b2h, b3l, b3h; \
            TRRD(b0l, bb[0], (buf_) * BBYTES); TRRD(b0h, bb[0], (buf_) * BBYTES + 1024); TRRD(b1l, bb[1], (buf_) * BBYTES); TRRD(b1h, bb[1], (buf_) * BBYTES + 1024); \
            TRRD(b2l, bb[2], (buf_) * BBYTES); TRRD(b2h, bb[2], (buf_) * BBYTES + 1024); TRRD(b3l, bb[3], (buf_) * BBYTES); TRRD(b3h, bb[3], (buf_) * BBYTES + 1024); \
            asm volatile("s_waitcnt lgkmcnt(0)" ::: "memory"); __builtin_amdgcn_sched_barrier(0); \
            const bf16x8 bf0 = {b0l[0], b0l[1], b0l[2], b0l[3], b0h[0], b0h[1], b0h[2], b0h[3]}, bf1 = {b1l[0], b1l[1], b1l[2], b1l[3], b1h[0], b1h[1], b1h[2], b1h[3]}; \
            const bf16x8 bf2 = {b2l[0], b2l[1], b2l[2], b2l[3], b2h[0], b2h[1], b2h[2], b2h[3]}, bf3 = {b3l[0], b3l[1], b3l[2], b3l[3], b3h[0], b3h[1], b3h[2], b3h[3]}; \
            _Pragma("unroll") for (int m = 0; m < MT; ++m) if (m < mlim) { \
                const bf16x8 af = *(const LAS bf16x8*)(size_t)(afr + (slot_) * ASLOT + m * 2048 + ((unsigned)((4 * (half_)) ^ asw) << 4)); \
                acc[m][0] = __builtin_amdgcn_mfma_f32_16x16x32_bf16(af, bf0, acc[m][0], 0, 0, 0); acc[m][1] = __builtin_amdgcn_mfma_f32_16x16x32_bf16(af, bf1, acc[m][1], 0, 0, 0); \
                acc[m][2] = __builtin_amdgcn_mfma_f32_16x16x32_bf16(af, bf2, acc[m][2], 0, 0, 0); acc[m][3] = __builtin_amdgcn_mfma_f32_16x16x32_bf16(af, bf3, acc[m][3], 0, 0, 0); } } while (0)
#define MG_STEP_EVEN(t_, s0_, RBNEW, RBNEXT) do { \
            MG_ISSUE_A((t_) + 2, (((s0_) >> 1) + 1) & 1); MG_ISSUE_B(RBNEW, (t_) + 4); \
            MG_COMPUTE(((s0_) >> 1) & 1, 0, (s0_) & 1); \
            if constexpr (NAG == 6) MG_WAIT_ALL(12); else if constexpr (NAG == 5) MG_WAIT_ALL(11); else MG_WAIT_ALL(9); \
            MG_WRITE_B(RBNEXT, ((s0_) + 1) & 1); \
            asm volatile("s_waitcnt lgkmcnt(0)" ::: "memory"); \
            __builtin_amdgcn_s_barrier(); } while (0)
#define MG_STEP_ODD(t_, s0_, RBNEW, RBNEXT) do { \
            MG_ISSUE_B(RBNEW, (t_) + 4); \
            MG_COMPUTE(((s0_) >> 1) & 1, 1, (s0_) & 1); \
            MG_WAIT_ALL(4); \
            MG_WRITE_B(RBNEXT, ((s0_) + 1) & 1); \
            asm volatile("s_waitcnt lgkmcnt(0)" ::: "memory"); \
            __builtin_amdgcn_s_barrier(); } while (0)
      asm volatile("s_waitcnt lgkmcnt(0)" ::: "memory");
      __builtin_amdgcn_s_barrier();
      MG_ISSUE_A(0, 0); MG_ISSUE_B(rq0, 0); MG_ISSUE_B(rq1, 1); MG_ISSUE_B(rq2, 2); MG_ISSUE_B(rq3, 3);
      MG_WAIT_ALL(6);
      MG_WRITE_B(rq0, 0);
      asm volatile("s_waitcnt lgkmcnt(0)" ::: "memory");
      __builtin_amdgcn_s_barrier();
#pragma unroll 1
      for (;;) {
        int en = e, ctn = ct, cen = ce, basen = base, nrbn = nrb, rbn = rb, i0n = i0; bool last = false;
        if (rb + 1 < nrb) rbn = rb + 1;
        else if (i0 + G < NI) { i0n = i0 + G; MG_DECODE(i0n, en, ctn); cen = (int)cnt[en]; basen = tab[80 + en]; nrbn = tab[160 + en] > 0 ? tab[160 + en] : 1; rbn = 0; }
        else last = true;
        MG_AOFF(aoffn, en, rbn, cen, basen);
        wpn = MG_WP(en, ctn); trotn = MG_TROT(en, ctn);
#pragma unroll
        for (int i = 0; i < NAG; ++i) asm volatile("" : "+v"(aoffn[i]));
        int mlim = (ce - rb * RBLK - wm * (16 * MT) + 15) >> 4; mlim = mlim < 0 ? 0 : (mlim > MT ? MT : mlim); mlim = __builtin_amdgcn_readfirstlane(mlim);
        f32x4 acc[MT][4];
#pragma unroll
        for (int m = 0; m < MT; ++m)
#pragma unroll
            for (int n = 0; n < 4; ++n) acc[m][n] = (f32x4){0.f, 0.f, 0.f, 0.f};
#pragma unroll 1
        for (int t = 0; t < NT; t += 4) {
            MG_STEP_EVEN(t, 0, rq0, rq1); MG_STEP_ODD(t + 1, 1, rq1, rq2); MG_STEP_EVEN(t + 2, 2, rq2, rq3); MG_STEP_ODD(t + 3, 3, rq3, rq0);
        }
#pragma unroll
        for (int m = 0; m < MT; ++m)
#pragma unroll
            for (int g = 0; g < 4; ++g) {
                const int r = rb * RBLK + wm * (16 * MT) + 16 * m + 4 * kq + g;
                if (r < ce) {
                    if (GATED) {
#pragma unroll
                        for (int j = 0; j < 2; ++j) { const float gv = acc[m][j][g], uv = acc[m][2 + j][g];
                            Out[(size_t)(base + r) * LDO + ct * 64 + 32 * wn + 16 * j + l15] = f2bf(gv / (1.f + __expf(-gv)) * uv); }
                    } else {
#pragma unroll
                        for (int n = 0; n < 4; ++n) Out[(size_t)(base + r) * LDO + ct * 128 + 64 * wn + 16 * n + l15] = f2bf(acc[m][n][g]);
                    }
                }
            }
        if (last) break;
        e = en; ct = ctn; ce = cen; base = basen; nrb = nrbn; rb = rbn; i0 = i0n; wp = wpn; trot = trotn;
#pragma unroll
        for (int i = 0; i < NAG; ++i) aoff[i] = aoffn[i];
      }
      MG_WAIT_ALL(0);
#undef MG_STEP_EVEN
#undef MG_STEP_ODD
#undef MG_ISSUE_A
#undef MG_ISSUE_B
#undef MG_WAIT_ALL
#undef MG_WRITE_B
#undef MG_COMPUTE
#undef TRRD
    }
#undef MG_DECODE
#undef MG_AOFF
#undef MG_WP
#undef MG_TROT
    __syncthreads();
}
template <int PMODE>
__device__ __forceinline__ void p_moe1_mfma(LAS unsigned char* ldsb, unsigned char* ws, const float* w_eg, const float* w_eu, int l, int lc) {
    const unsigned* cnt = (const unsigned*)(ws + WS_CNT) + lc * 64;
    int* tab = (int*)((unsigned char*)ldsb + 120 * 1024);
    __syncthreads();
    moe_tables256(tab, cnt, FE / 64);
    moe_gemm<true, PMODE>(ldsb, tab, cnt, (const int*)(ws + WS_LIST), (const bf16_t*)(ws + WS_H1B), w_eg + (size_t)l * NE * D * FE, w_eu + (size_t)l * NE * D * FE, (bf16_t*)(ws + WS_HID));
}
__device__ __forceinline__ void p_moe2_mfma(LAS unsigned char* ldsb, unsigned char* ws, const float* w_ed, int l) {
    const unsigned* cnt = (const unsigned*)(ws + WS_CNT) + l * 64;
    int* tab = (int*)((unsigned char*)ldsb + 120 * 1024);
    __syncthreads();
    moe_tables256(tab, cnt, D / 128);
    moe_gemm<false>(ldsb, tab, cnt, nullptr, (const bf16_t*)(ws + WS_HID), w_ed + (size_t)l * NE * FE * D, nullptr, (bf16_t*)(ws + WS_YE));
}

constexpr int NPH = 10;
#ifndef PH_MASK
#define PH_MASK 0x7ff
#endif
#define PHON(k) ((PH_MASK >> (k)) & 1)
#ifndef REP_PHASE
#define REP_PHASE -1
#endif
#ifndef STAMP_A
#define STAMP_A -1
#define STAMP_B -1
#endif
#define REPS(k) for (int rep_ = 0; rep_ < ((REP_PHASE == (k)) ? 2 : 1); ++rep_)
template <class Tp> __device__ __forceinline__ Tp* as_global(Tp* p) {
    __attribute__((address_space(1))) Tp* g = (__attribute__((address_space(1))) Tp*)p; asm volatile("" : "+s"(g)); return (Tp*)g; }
typedef const Params __attribute__((address_space(4))) CParams;
#define KP(field) ({ CParams* _k = kp; asm volatile("" : "+s"(_k)); _k->field; })
__global__ void __launch_bounds__(NTHREADS, 2) hybrid_fwd(Params p_unused, int ph_lo, int ph_hi) {
    extern __shared__ __attribute__((aligned(16))) unsigned char lds_raw[];
    float* lds = (float*)lds_raw;
    LAS unsigned char* ldsb = (LAS unsigned char*)lds_raw;
    CParams* kp = (CParams*)__builtin_amdgcn_kernarg_segment_ptr();
    unsigned char* const ws0 = KP(ws);
    volatile LAS unsigned* xbw = (volatile LAS unsigned*)(lds_raw + LDS_BYTES - 16);
    if (threadIdx.x == 0) { xbw[0] = 0u; xbw[1] = 0u; xbw[2] = 0u; xbw[3] = 0u; }
    __syncthreads();
    XcdBarrier bar; bar.bar = (unsigned*)(ws0 + WS_BAR); bar.x = 0; bar.st = xbw;
    if (ph_lo < ph_hi) bar = xcd_barrier_post((unsigned*)(ws0 + WS_BAR), xbw);
#define IN(ph) ((ph) >= ph_lo && (ph) <= ph_hi)
#define GRID_BAR(ph) do { if ((ph) >= ph_lo && (ph) < ph_hi) xcd_barrier(bar); \
    if (STAMP_A >= 0 && blockIdx.x == 0 && threadIdx.x == 0) ((volatile unsigned long long*)(ws0 + WS_BAR + 14800))[(ph) + 1] = __builtin_amdgcn_s_memrealtime(); } while (0)
    if (STAMP_A >= 0 && blockIdx.x == 0 && threadIdx.x == 0) ((volatile unsigned long long*)(ws0 + WS_BAR + 14800))[0] = __builtin_amdgcn_s_memrealtime();
    if (PHON(0) && IN(0)) REPS(0) { unsigned char* ws = ws0; asm volatile("" : "+s"(ws)); ws = as_global(ws); { Params q; q.ws = ws; q.x = as_global(KP(x)); q.pos = as_global(KP(pos)); q.w_in = as_global(KP(w_in)); q.g_q = as_global(KP(g_q)); q.w_qb = as_global(KP(w_qb)); q.g_kv = as_global(KP(g_kv)); q.w_kvb = as_global(KP(w_kvb));
        q.w_oa = as_global(KP(w_oa)); q.w_ob = as_global(KP(w_ob)); q.w_out = as_global(KP(w_out)); q.ln1g = as_global(KP(ln1g)); q.ln1b = as_global(KP(ln1b)); q.w_router = as_global(KP(w_router)); q.w_group = as_global(KP(w_group)); q.b_router = as_global(KP(b_router)); q.b_group = as_global(KP(b_group)); if (REP_PHASE >= 31 && REP_PHASE <= 34) p_prologue(ldsb, q, 1 << (REP_PHASE - 31)); p_prologue(ldsb, q); } }
    int lfirst = -1; asm volatile("" : "+s"(lfirst));
    for (int l = lfirst; l < DEPTH; ++l) {
        const int pb = l * NPH;
        if (l >= 0 && PHON(1) && IN(pb + 1)) REPS(1) { unsigned char* ws = ws0; asm volatile("" : "+s"(ws)); ws = as_global(ws);
            EpiIn E; E.ws = ws;
            pg8::Gemm g{(const bf16_t*)(ws + WS_XB), (const bf16_t*)(ws + WS_WIN_T) + (size_t)l * INP * D, T, INP, D}; pg8::StaticOrder SO; SO.init(T, INP, (int)gridDim.x, opaque_bid());
            pg8::gemm_phase<EpiIn, pg8::StaticOrder, true, true>(ldsb, g, SO, E);
        }
        if ((l < 0 ? (PHON(0) && IN(0)) : (PHON(1) && IN(pb + 1)))) { unsigned char* ws = ws0; asm volatile("" : "+s"(ws)); ws = as_global(ws);
            const int G_ = (int)gridDim.x, nfull = l < 0 ? 0 : ((T / 256) * (INP / 256)) % G_, bid_ = opaque_bid();
            if (l < 0 || (nfull > 0 && bid_ >= nfull)) { __syncthreads();
                Params q; q.ws = ws; q.w_in = as_global(KP(w_in)); q.g_q = as_global(KP(g_q)); q.w_qb = as_global(KP(w_qb)); q.g_kv = as_global(KP(g_kv)); q.w_kvb = as_global(KP(w_kvb));
                q.w_oa = as_global(KP(w_oa)); q.w_ob = as_global(KP(w_ob)); q.w_out = as_global(KP(w_out));
                constexpr int WC_IN = (D / 64) * (INP / 64), WC_ALL = WC_IN + (512 / 64) * (1536 / 64) + (512 / 64) * (2048 / 64) + 2 * (1024 / 64) * (D / 64) + (D / 64) * (D / 64);
                const int a_l1 = l < 0 ? 0 : l, a_lo1 = l < 0 ? 0 : WC_IN, a_hi1 = l < 0 ? WC_IN : WC_ALL, a_l2 = l + 1, a_hi2 = (l >= 0 && l + 1 < DEPTH) ? WC_IN : 0;
                p_wcopies(ldsb, q, a_l1, a_lo1, a_hi1, a_l2, 0, a_hi2, bid_ - nfull, G_ - nfull); } }
        GRID_BAR(l < 0 ? 0 : pb + 1);
        if (l < 0) continue;
        if (PHON(2) && IN(pb + 2)) REPS(2) { unsigned char* ws = ws0; asm volatile("" : "+s"(ws)); ws = as_global(ws);
            { EpiQA E; E.ws = ws;
              pg8::Gemm g{(const bf16_t*)(ws + WS_CQ), (const bf16_t*)(ws + WS_WQB_T) + (size_t)l * 1536 * 512, T, 1536, 512}; pg8::StaticOrder SO; SO.init(T, 1536, (int)gridDim.x, opaque_bid());
              pg8::gemm_phase<EpiQA, pg8::StaticOrder, true, true>(ldsb, g, SO, E); }
            { EpiKV E; E.ws = ws;
              pg8::Gemm g{(const bf16_t*)(ws + WS_CKV), (const bf16_t*)(ws + WS_WKVB_T) + (size_t)l * 2048 * 512, T, 2048, 512}; pg8::StaticOrder SO; SO.init(T, 2048, (int)gridDim.x, opaque_bid());
              pg8::gemm_phase<EpiKV, pg8::StaticOrder, true, true>(ldsb, g, SO, E); }
            REPS(12) p_score(ldsb, ws);
        }
        GRID_BAR(pb + 2);
        if (PHON(3) && IN(pb + 3)) REPS(3) { unsigned char* ws = ws0; asm volatile("" : "+s"(ws)); ws = as_global(ws); p_select(ws); }
        GRID_BAR(pb + 3);
        if (PHON(4) && IN(pb + 4)) REPS(4) { unsigned char* ws = ws0; asm volatile("" : "+s"(ws)); ws = as_global(ws);
            if (REP_PHASE == 14) p_attn<1>(ldsb, ws); if (REP_PHASE == 15) p_attn<2>(ldsb, ws); if (REP_PHASE == 16) p_attn<3>(ldsb, ws);
            p_attn<0>(ldsb, ws);
        }
        GRID_BAR(pb + 4);
        if (PHON(5) && IN(pb + 5)) REPS(5) { unsigned char* ws = ws0; asm volatile("" : "+s"(ws)); ws = as_global(ws);
            pg8::StaticOrder SO; SO.init(T, D, (int)gridDim.x, opaque_bid());
            { EpiYA E; E.ws = ws;
              pg8::Gemm g{(const bf16_t*)(ws + WS_OA), (const bf16_t*)(ws + WS_WOA_T) + (size_t)l * D * 1024, T, D, 1024};
              pg8::gemm_phase<EpiYA, pg8::StaticOrder, true, true>(ldsb, g, SO, E); }
            { EpiYB E; E.ws = ws;
              pg8::Gemm g{(const bf16_t*)(ws + WS_OB), (const bf16_t*)(ws + WS_WOB_T) + (size_t)l * D * 1024, T, D, 1024};
              pg8::gemm_phase<EpiYB, pg8::StaticOrder, true, true>(ldsb, g, SO, E); }
        }
        GRID_BAR(pb + 5);
        if (PHON(6) && IN(pb + 6)) REPS(6) { unsigned char* ws = ws0; asm volatile("" : "+s"(ws)); ws = as_global(ws);
            EpiOut E; E.hin = (l == 0) ? as_global(KP(x)) : (const float*)(ws + WS_H2F); E.V1 = (float*)(ws + WS_V1);
            pg8::Gemm g{(const bf16_t*)(ws + WS_Y), (const bf16_t*)(ws + WS_WOUT_T) + (size_t)l * D * D, T, D, D}; pg8::StaticOrder SO; SO.init(T, D, (int)gridDim.x, opaque_bid());
            pg8::gemm_phase<EpiOut, pg8::StaticOrder, true, true>(ldsb, g, SO, E);
        }
        GRID_BAR(pb + 6);
        if (PHON(7) && IN(pb + 7)) REPS(7) { unsigned char* ws = ws0; asm volatile("" : "+s"(ws)); ws = as_global(ws); if (REP_PHASE == 21) p_ln1_route3<1>(ldsb, ws, as_global(KP(ln1g)) + (size_t)l * D, as_global(KP(ln1b)) + (size_t)l * D, l); if (REP_PHASE == 22) p_ln1_route3<2>(ldsb, ws, as_global(KP(ln1g)) + (size_t)l * D, as_global(KP(ln1b)) + (size_t)l * D, l);
            p_ln1_route3<0>(ldsb, ws, as_global(KP(ln1g)) + (size_t)l * D, as_global(KP(ln1b)) + (size_t)l * D, l); }
        GRID_BAR(pb + 7);
        if (PHON(8) && IN(pb + 8)) REPS(8) { unsigned char* ws = ws0; asm volatile("" : "+s"(ws)); ws = as_global(ws); if (REP_PHASE == 18) p_moe1_mfma<0>(ldsb, ws, as_global(KP(w_eg)), as_global(KP(w_eu)), l ^ 1, l); if (REP_PHASE == 19) p_moe1_mfma<1>(ldsb, ws, as_global(KP(w_eg)), as_global(KP(w_eu)), l ^ 1, l); if (REP_PHASE == 20) p_moe1_mfma<2>(ldsb, ws, as_global(KP(w_eg)), as_global(KP(w_eu)), l ^ 1, l);
            p_moe1_mfma<0>(ldsb, ws, as_global(KP(w_eg)), as_global(KP(w_eu)), l, l); }
        GRID_BAR(pb + 8);
        if (PHON(9) && IN(pb + 9)) REPS(9) { unsigned char* ws = ws0; asm volatile("" : "+s"(ws)); ws = as_global(ws); p_moe2_mfma(ldsb, ws, as_global(KP(w_ed)), l); }
        GRID_BAR(pb + 9);
        if (PHON(10) && IN(pb + 10)) REPS(10) { unsigned char* ws = ws0; asm volatile("" : "+s"(ws)); ws = as_global(ws); p_ln2v2(ldsb, ws, as_global(KP(ln1g)) + (size_t)l * D, as_global(KP(ln1b)) + (size_t)l * D, as_global(KP(ln2g)) + (size_t)l * D, as_global(KP(ln2b)) + (size_t)l * D, (l == DEPTH - 1) ? as_global(KP(out)) : (float*)(ws + WS_H2F), l); }
        GRID_BAR(pb + 10);
    }
    if (STAMP_A >= 0) {
        if (ph_lo < ph_hi) xcd_barrier(bar);
        if (blockIdx.x == 0) {
            volatile unsigned long long* st = (volatile unsigned long long*)(ws0 + WS_BAR + 14800);
            if (threadIdx.x == 0) st[DEPTH * NPH + 1] = __builtin_amdgcn_s_memrealtime();
            __syncthreads();
            float da = 0.f, db = 0.f;
            for (int l = 0; l < DEPTH; ++l) {
                if (STAMP_A == 0) { if (l == 0) da += (float)(st[1] - st[0]); } else da += (float)(st[l * NPH + STAMP_A + 1] - st[l * NPH + STAMP_A]);
                if (STAMP_B == 0) { if (l == 0) db += (float)(st[1] - st[0]); } else if (STAMP_B > 0) db += (float)(st[l * NPH + STAMP_B + 1] - st[l * NPH + STAMP_B]);
            }
            da *= 0.01f; db *= 0.01f;
            float* o = as_global(KP(out));
            for (int i = threadIdx.x; i < 65536; i += NTHREADS) o[i] = sqrtf(da);
            if (threadIdx.x == 0 && STAMP_B >= 0) o[70000] = db;
        }
    }
}

#ifndef MK_ONE_LAUNCH
#define MK_ONE_LAUNCH 1
#endif
extern "C" void kernel_launch(void* const* d_in, const int* in_sizes, int n_in, void* d_out, int out_size, void* d_ws, size_t ws_size, hipStream_t stream) {
    static int grid = 0;
    if (!grid) {
        if (n_in != 21 || in_sizes[0] != T * D || out_size != T * D || ws_size < WS_END) {
            fprintf(stderr, "kernel_launch: unexpected shapes (n_in %d, in0 %d, out %d, ws %zu, need %zu); nothing launched\n", n_in, n_in > 0 ? in_sizes[0] : -1, out_size, ws_size, (size_t)WS_END);
            grid = -1; return; }
        int dev = 0, cus = 0, per_cu = 0;
        hipGetDevice(&dev); hipDeviceGetAttribute(&cus, hipDeviceAttributeMultiprocessorCount, dev);
        if (hipFuncSetAttribute((const void*)hybrid_fwd, hipFuncAttributeMaxDynamicSharedMemorySize, LDS_BYTES) != hipSuccess) { fprintf(stderr, "kernel_launch: hipFuncSetAttribute failed\n"); grid = -1; return; }
        hipOccupancyMaxActiveBlocksPerMultiprocessor(&per_cu, (const void*)hybrid_fwd, NTHREADS, LDS_BYTES);
        if (per_cu < 1) fprintf(stderr, "kernel_launch: occupancy query reports %d blocks per CU\n", per_cu);
        grid = cus > 0 ? cus : 256;
    }
    if (grid < 0) return;
    hipMemsetAsync((char*)d_ws, 0, WS_CTL_END, stream);
    Params p{};
    p.x = (const float*)d_in[0]; p.pos = (const int*)d_in[1];
    p.w_in = (const float*)d_in[2]; p.g_q = (const float*)d_in[3]; p.w_qb = (const float*)d_in[4]; p.g_kv = (const float*)d_in[5]; p.w_kvb = (const float*)d_in[6];
    p.w_oa = (const float*)d_in[7]; p.w_ob = (const float*)d_in[8]; p.w_out = (const float*)d_in[9]; p.ln1g = (const float*)d_in[10]; p.ln1b = (const float*)d_in[11];
    p.w_group = (const float*)d_in[12]; p.b_group = (const float*)d_in[13]; p.w_router = (const float*)d_in[14]; p.b_router = (const float*)d_in[15];
    p.w_eg = (const float*)d_in[16]; p.w_eu = (const float*)d_in[17]; p.w_ed = (const float*)d_in[18]; p.ln2g = (const float*)d_in[19]; p.ln2b = (const float*)d_in[20];
    p.out = (float*)d_out; p.ws = (unsigned char*)d_ws;
#if MK_ONE_LAUNCH
    hipLaunchKernelGGL(hybrid_fwd, dim3(grid), dim3(NTHREADS), LDS_BYTES, stream, p, 0, DEPTH * NPH);
#else
    for (int ph = 0; ph <= DEPTH * NPH; ++ph) hipLaunchKernelGGL(hybrid_fwd, dim3(grid), dim3(NTHREADS), LDS_BYTES, stream, p, ph, ph);
#endif
}
```

```cpp
#include <hip/hip_runtime.h>
#include <cstdio>
#include <cstdint>

typedef unsigned short bf16_t;
typedef float f32x4 __attribute__((ext_vector_type(4)));
typedef unsigned u32x4 __attribute__((ext_vector_type(4)));
typedef unsigned u32x2 __attribute__((ext_vector_type(2)));

constexpr int T = 8192, D = 2048, S = 4096, NB = 2, DEPTH = 2;
constexpr int INW = 9360, INP = 9472;
constexpr int NE = 64, FE = 512;
constexpr int NTHREADS = 512;
constexpr int LDS_BYTES = 147456;
constexpr float ALPHA = 1.41421356237309515f;
constexpr int ECAP = 8192;
#ifndef MOE_RBLK
#define MOE_RBLK 384
#endif
constexpr int PMAX = 40960;

constexpr size_t al256(size_t x) { return (x + 255) & ~(size_t)255; }
constexpr size_t XCD_BAR_BYTES = 16384;
constexpr size_t WS_BAR = 0;
constexpr size_t WS_CNT = WS_BAR + XCD_BAR_BYTES;
constexpr size_t WS_CTL_END = WS_CNT + al256(DEPTH * 64 * 4);
constexpr size_t WS_SSQ = WS_CTL_END;
constexpr size_t WS_ROPE = WS_SSQ + al256((size_t)T * 32 * 4);
constexpr size_t WS_XB = WS_ROPE + al256((size_t)T * 112 * 4);
constexpr size_t WS_H2F = WS_XB + al256((size_t)T * D * 2);
constexpr size_t WS_CQ = WS_H2F + al256((size_t)T * D * 4);
constexpr size_t WS_CKV = WS_CQ + al256((size_t)T * 512 * 2);
constexpr size_t WS_QB = WS_CKV + al256((size_t)T * 512 * 2);
constexpr size_t WS_KB = WS_QB + al256((size_t)T * 1024 * 2);
constexpr size_t WS_VB = WS_KB + al256((size_t)T * 1024 * 2);
constexpr size_t WS_QI = WS_VB + al256((size_t)T * 1024 * 2);
constexpr size_t WS_KI = WS_QI + al256((size_t)T * 1024 * 2);
constexpr size_t WS_WI = WS_KI + al256((size_t)T * 64 * 2);
constexpr size_t WS_GA = WS_WI + al256((size_t)T * 16 * 4);
constexpr size_t WS_GB = WS_GA + al256((size_t)T * D * 2);
constexpr size_t WS_QA = WS_GB + al256((size_t)T * D * 2);
constexpr size_t WS_KA = WS_QA + al256((size_t)T * 1536 * 2);
constexpr size_t WS_VA = WS_KA + al256((size_t)T * 1536 * 2);
constexpr size_t WS_MASK = WS_VA + al256((size_t)T * 1024 * 2);
constexpr size_t WS_OA = WS_MASK + al256((size_t)T * 128 * 4);
constexpr size_t WS_OB = WS_OA + al256((size_t)T * 1024 * 2);
constexpr size_t WS_YT = WS_OB + al256((size_t)T * 1024 * 2);
constexpr size_t WS_Y = WS_YT + al256((size_t)T * D * 4);
constexpr size_t WS_V1 = WS_Y + al256((size_t)T * D * 2);
constexpr size_t WS_H1F = WS_V1 + al256((size_t)T * D * 4);
constexpr size_t WS_H1B = WS_H1F + al256((size_t)T * D * 4);
constexpr size_t WS_TOKE = WS_H1B + al256((size_t)T * D * 2);
constexpr size_t WS_TOKW = WS_TOKE + al256((size_t)T * 2 * 4);
constexpr size_t WS_TOKS = WS_TOKW + al256((size_t)T * 2 * 4);
constexpr size_t WS_LIST = WS_TOKS + al256((size_t)T * 2 * 4);
constexpr size_t WS_HID = WS_LIST + al256((size_t)NE * ECAP * 4);
constexpr size_t WS_YE = WS_HID + al256((size_t)PMAX * FE * 2);
constexpr size_t WS_RWS = WS_YE + al256((size_t)PMAX * D * 2);
constexpr size_t WS_GWS = WS_RWS + al256((size_t)DEPTH * D * 64 * 4);
constexpr size_t WS_SEC = WS_GWS + al256((size_t)DEPTH * D * 8 * 4);
constexpr size_t WS_RWH = WS_SEC + al256((size_t)DEPTH * 160 * 4);
constexpr size_t WS_RWL = WS_RWH + al256((size_t)DEPTH * 96 * D * 2);
constexpr size_t WS_STATS = WS_RWL + al256((size_t)DEPTH * 96 * D * 2);
constexpr size_t WS_SCORE = WS_STATS + al256((size_t)T * 2 * 4);
constexpr size_t WS_WIN_T = WS_SCORE + al256((size_t)T * 4096 * 4);
constexpr size_t WS_WQB_T = WS_WIN_T + al256((size_t)DEPTH * INP * D * 2);
constexpr size_t WS_WKVB_T = WS_WQB_T + al256((size_t)DEPTH * 1536 * 512 * 2);
constexpr size_t WS_WOA_T = WS_WKVB_T + al256((size_t)DEPTH * 2048 * 512 * 2);
constexpr size_t WS_WOB_T = WS_WOA_T + al256((size_t)DEPTH * D * 1024 * 2);
constexpr size_t WS_WOUT_T = WS_WOB_T + al256((size_t)DEPTH * D * 1024 * 2);
constexpr size_t WS_END = WS_WOUT_T + al256((size_t)DEPTH * D * D * 2);
static_assert(WS_CKV == WS_CQ + (size_t)T * 512 * 2, "CQ|CKV must be consecutive");

static_assert(WS_KB == WS_QB + (size_t)T * 1024 * 2 && WS_VB == WS_KB + (size_t)T * 1024 * 2 && WS_GB == WS_GA + (size_t)T * D * 2, "QB|KB|VB and GA|GB must be consecutive");
struct Params {
    const float* x; const int* pos;
    const float *w_in, *g_q, *w_qb, *g_kv, *w_kvb, *w_oa, *w_ob, *w_out, *ln1g, *ln1b, *w_group, *b_group, *w_router, *b_router, *w_eg, *w_eu, *w_ed, *ln2g, *ln2b;
    float* out; unsigned char* ws;
};

__device__ __forceinline__ float bf2f(bf16_t v) { return __uint_as_float((unsigned)v << 16); }
__device__ __forceinline__ bf16_t f2bf(float f) { unsigned u = __float_as_uint(f); u += 0x7fffu + ((u >> 16) & 1u); return (bf16_t)(u >> 16); }
__device__ __forceinline__ unsigned pk2(float a, float b) { return (unsigned)f2bf(a) | ((unsigned)f2bf(b) << 16); }
__device__ __forceinline__ void st4bf(bf16_t* p, f32x4 v) { u32x2 w; w.x = pk2(v[0], v[1]); w.y = pk2(v[2], v[3]); *(u32x2*)p = w; }
__device__ __forceinline__ float wave_sum(float v) {
#pragma unroll
    for (int o = 32; o >= 1; o >>= 1) v += __shfl_xor(v, o);
    return v;
}
__device__ __forceinline__ float wave_max(float v) {
#pragma unroll
    for (int o = 32; o >= 1; o >>= 1) v = fmaxf(v, __shfl_xor(v, o));
    return v;
}
__device__ __forceinline__ int block_sum_int(int v, int* red) {
#pragma unroll
    for (int o = 32; o >= 1; o >>= 1) v += __shfl_xor(v, o);
    if ((threadIdx.x & 63) == 0) red[threadIdx.x >> 6] = v;
    __syncthreads();
    int t = 0;
#pragma unroll
    for (int i = 0; i < 8; ++i) t += red[i];
    __syncthreads();
    return t;
}
__device__ __forceinline__ f32x4 rot4(f32x4 v, float c0, float s0, float c1, float s1) { f32x4 o; o[0] = v[0] * c0 - v[1] * s0; o[1] = v[1] * c0 + v[0] * s0; o[2] = v[2] * c1 - v[3] * s1; o[3] = v[3] * c1 + v[2] * s1; return o; }

#define XB_TMO      128
#define XB_XCNT(j)  (256  + 64 * (j))
#define XB_XSUB(j)  (1280 + 64 * (j))
#define XB_XGEN(j)  (2304 + 64 * (j))
#define XB_TOP      3328
#define XB_TOPGEN   3392
#define XCD_BAR_WORDS 3456
#define XB_SPIN_CAP (1u << 22)
#define LAS __attribute__((address_space(3)))
__device__ __forceinline__ unsigned xb_ld(unsigned* p)              { return __hip_atomic_load(p, __ATOMIC_RELAXED, __HIP_MEMORY_SCOPE_AGENT); }
__device__ __forceinline__ unsigned xb_add(unsigned* p, unsigned v) { return __hip_atomic_fetch_add(p, v, __ATOMIC_RELAXED, __HIP_MEMORY_SCOPE_AGENT); }
__device__ __forceinline__ unsigned xb_xcc_id() { return (unsigned)__builtin_amdgcn_s_getreg((3 << 11) | 20) & 0xFu; }
#define XB_SPIN(cond, bar) do { unsigned _sp = 0; while (cond) { __builtin_amdgcn_s_sleep(1); \
    if ((++_sp & 255u) == 0u) { if (xb_ld(&(bar)[XB_TMO])) break; if (_sp > XB_SPIN_CAP) { atomicAdd(&(bar)[XB_TMO], 1u); break; } } } } while (0)
struct XcdBarrier { unsigned* bar; unsigned x; volatile LAS unsigned* st; };
__device__ __forceinline__ XcdBarrier xcd_barrier_post(unsigned* bar, volatile LAS unsigned* st) {
    XcdBarrier b; b.bar = bar; b.x = xb_xcc_id(); b.st = st;
    if (threadIdx.x == 0) (void)xb_add(&bar[XB_XCNT(b.x)], 1u);
    return b;
}
__device__ __forceinline__ void xcd_barrier_complete(unsigned* bar, unsigned x, unsigned& nloc, unsigned& nx) {
    const unsigned G = gridDim.x * gridDim.y * gridDim.z;
    unsigned sum, cnt, mine, sp = 0u;
    for (;;) {
        sum = 0u; cnt = 0u; mine = 0u;
#pragma unroll
        for (unsigned j = 0; j < 16; ++j) { const unsigned c = xb_ld(&bar[XB_XCNT(j)]); sum += c; cnt += (c > 0u) ? 1u : 0u; mine = (j == x) ? c : mine; }
        if (sum == G) break;
        __builtin_amdgcn_s_sleep(1);
        if ((++sp & 255u) == 0u) { if (xb_ld(&bar[XB_TMO])) break; if (sp > XB_SPIN_CAP) { atomicAdd(&bar[XB_TMO], 1u); break; } }
    }
    nloc = mine > 0u ? mine : 1u; nx = cnt > 0u ? cnt : 1u;
}
__device__ __forceinline__ void xcd_barrier(const XcdBarrier& b) {
    asm volatile("s_waitcnt vmcnt(0)" ::: "memory");
    __syncthreads();
    if (threadIdx.x == 0) {
        unsigned* bar = b.bar; asm volatile("" : "+s"(bar));
        __builtin_amdgcn_s_waitcnt(0);
        unsigned nloc = b.st[0], nx = b.st[1];
        unsigned bx = b.x; asm volatile("" : "+s"(bx));
        if (nloc == 0u) { xcd_barrier_complete(bar, bx, nloc, nx); b.st[0] = nloc; b.st[1] = nx; }
        const unsigned old = xb_add(&bar[XB_XSUB(bx)], 1u);
        const unsigned gen = old / nloc;
        if (old + 1u == (gen + 1u) * nloc) {
            __builtin_amdgcn_fence(__ATOMIC_RELEASE, "agent");
            asm volatile("s_waitcnt vmcnt(0)" ::: "memory");
            const unsigned og = xb_add(&bar[XB_TOP], 1u);
            const unsigned tg = og / nx;
            if (og + 1u == (tg + 1u) * nx) xb_add(&bar[XB_TOPGEN], 1u);
            else XB_SPIN(xb_ld(&bar[XB_TOPGEN]) == tg, bar);
            __builtin_amdgcn_fence(__ATOMIC_ACQUIRE, "agent");
            xb_add(&bar[XB_XGEN(bx)], 1u);
            asm volatile("s_waitcnt vmcnt(0)" ::: "memory");
        } else {
            XB_SPIN(xb_ld(&bar[XB_XGEN(bx)]) == gen, bar);
            __builtin_amdgcn_fence(__ATOMIC_ACQUIRE, "agent");
            asm volatile("s_waitcnt vmcnt(0)" ::: "memory");
        }
    }
    __syncthreads();
}

__device__ __forceinline__ int opaque_tid() { int t = threadIdx.x; asm volatile("" : "+v"(t)); return t; }
__device__ __forceinline__ int opaque_bid() { int b = blockIdx.x; asm volatile("" : "+s"(b)); return b; }
namespace pg8 {
#define PG8_LAS __attribute__((address_space(3)))
typedef unsigned short bf16_t;
typedef short bf16x8 __attribute__((ext_vector_type(8)));
typedef float f32x4 __attribute__((ext_vector_type(4)));
typedef unsigned u32x4 __attribute__((ext_vector_type(4)));
constexpr int BM = 256, BK = 64, HALF = 128, HTB = HALF * BK * 2  , STAGE_BYTES = 8 * HTB, NXCD = 8, WGM = 8;

__host__ __device__ __forceinline__ int lds_byte(int r, int c) { const int st = (r >> 4) * 2 + (c >> 5), rr = r & 15, cc = c & 31, ob = rr * 64 + cc * 2; return st * 1024 + (ob ^ (((ob >> 9) & 1) << 5)); }
__host__ __device__ __forceinline__ void stage_rc(int b, int& R, int& C) { const int st = b / 1024, sb = b % 1024, swz = sb ^ (((sb >> 9) & 1) << 5); R = (st >> 1) * 16 + swz / 64; C = (st & 1) * 32 + (swz % 64) / 2; }
__host__ __device__ __forceinline__ int perm32(int rho) { const int n = rho >> 4, i = rho & 15; return 8 * (i >> 2) + 4 * n + (i & 3); }

struct Unit { int pm, pn; };
struct Gemm { const bf16_t* A; const bf16_t* Bt; int M, N, K; };

struct StaticOrder {
    int nM, nN, nwg, G, c;
    __host__ __device__ void init(int M, int N, int G_, int c_) { nM = M / BM; nN = N / BM; nwg = nM * nN; G = G_; c = c_; }
    __host__ __device__ bool next(int i, Unit& u) const {
        const long L = (long)i * G + c; if (L >= nwg) return false;
        int wgid = (int)L; { const int q = nwg / NXCD, r = nwg % NXCD, xcd = wgid % NXCD, off = wgid / NXCD; wgid = (xcd < r ? xcd * (q + 1) : r * (q + 1) + (xcd - r) * q) + off; }
        const int nig = WGM * nN, gid = wgid / nig, fm = gid * WGM, gsz = (nM - fm) < WGM ? (nM - fm) : WGM;
        u.pm = fm + ((wgid % nig) % gsz); u.pn = (wgid % nig) / gsz; return true;
    }
    __device__ __forceinline__ void a_ready(const Unit&) const {}
    __device__ __forceinline__ void done(const Unit&) const {}
};

__device__ __forceinline__ unsigned cvt_pk_bf16(float lo, float hi) { unsigned r; asm volatile("v_cvt_pk_bf16_f32 %0, %1, %2" : "=v"(r) : "v"(lo), "v"(hi)); return r; }
template <class Epi, class Sched, bool ALIGN_EPI = false, bool SP2 = false>
__device__ __forceinline__ void gemm_phase(PG8_LAS unsigned char* lds, const Gemm g, const Sched& S, const Epi& E) {
    const int tid = opaque_tid(), wid = __builtin_amdgcn_readfirstlane(tid >> 6), lane = tid & 63, wr = wid >> 2, wc = wid & 3, fr = lane & 15, fq = lane >> 4;
    const int K = g.K, nt = K / BK;
    unsigned voffA[2], voffB[2];
#pragma unroll
    for (int i = 0; i < 2; ++i) { int R, C; stage_rc(tid * 16 + i * 8192, R, C); const int Rb = Epi::PERM ? ((R & ~31) + perm32(R & 31)) : R;
        voffA[i] = (unsigned)(R * K + C) * 2u; voffB[i] = (unsigned)(Rb * K + C) * 2u; }
    const size_t kstep = (size_t)(BK * 2);
    const size_t hstep = (size_t)HALF * K * 2;
    const size_t tstep = 2 * hstep;
    const unsigned ldsw = (unsigned)wid * 1024u;
    const int aoff = lds_byte(wr * 64 + fr, fq * 8), boff = lds_byte(wc * 32 + fr, fq * 8);
#define PG8_SA(b, h) (((b) * 2 + (h)) * HTB)
#define PG8_SB(b, h) ((4 + (b) * 2 + (h)) * HTB)
#define PG8_STAGE(bufoff, gbase, voff) do { _Pragma("unroll") for (int _i = 0; _i < 2; ++_i) \
        __builtin_amdgcn_global_load_lds((const unsigned*)((const char*)(gbase) + (voff)[_i]), (PG8_LAS unsigned*)(lds + (bufoff) + ldsw + _i * 8192), 16, 0, 0); } while (0)
#define PG8_LDA(dst, b, h) do { _Pragma("unroll") for (int m = 0; m < 4; ++m) _Pragma("unroll") for (int k = 0; k < 2; ++k) dst[m][k] = *(const PG8_LAS bf16x8*)(lds + PG8_SA(b, h) + aoff + m * 2048 + k * 1024); } while (0)
#define PG8_LDB(dst, b, h) do { _Pragma("unroll") for (int n = 0; n < 2; ++n) _Pragma("unroll") for (int k = 0; k < 2; ++k) dst[n][k] = *(const PG8_LAS bf16x8*)(lds + PG8_SB(b, h) + boff + n * 2048 + k * 1024); } while (0)
#define PG8_MMA(ai, bj, At, Bt) do { __builtin_amdgcn_s_setprio(1); _Pragma("unroll") for (int m = 0; m < 4; ++m) _Pragma("unroll") for (int n = 0; n < 2; ++n) _Pragma("unroll") for (int k = 0; k < 2; ++k) \
        acc[ai][bj][m][n] = __builtin_amdgcn_mfma_f32_16x16x32_bf16(Bt[n][k], At[m][k], acc[ai][bj][m][n], 0, 0, 0); __builtin_amdgcn_s_setprio(0); } while (0)
#define PG8_WAIT_V(n) asm volatile("s_waitcnt vmcnt(" #n ")" ::: "memory")
#define PG8_WAIT_L(n) asm volatile("s_waitcnt lgkmcnt(" #n ")" ::: "memory")
#define PG8_BAR __builtin_amdgcn_s_barrier()
#define PG8_SCHED __builtin_amdgcn_sched_barrier(0)
    Unit cur, nxt; int ui = 0;
    if (!S.next(0, cur)) return;
    f32x4 acc[2][2][4][2];
#pragma unroll
    for (int a = 0; a < 2; ++a)
#pragma unroll
        for (int b = 0; b < 2; ++b)
#pragma unroll
            for (int m = 0; m < 4; ++m)
#pragma unroll
                for (int n = 0; n < 2; ++n) acc[a][b][m][n] = (f32x4){0.f, 0.f, 0.f, 0.f};
    bf16x8 At[4][2], B0[2][2], B1[2][2];
    const char* cA = (const char*)g.A + (size_t)cur.pm * tstep; const char* cB = (const char*)g.Bt + (size_t)cur.pn * tstep;
    S.a_ready(cur);
    if constexpr (SP2) {
        PG8_STAGE(PG8_SB(0, 0), cB, voffB); PG8_STAGE(PG8_SB(0, 1), cB + hstep, voffB); PG8_STAGE(PG8_SA(0, 0), cA, voffA); PG8_STAGE(PG8_SA(0, 1), cA + hstep, voffA);
        if (wr == 1) PG8_BAR;
        PG8_WAIT_V(2); PG8_BAR;
        PG8_STAGE(PG8_SB(1, 0), cB + kstep, voffB); PG8_STAGE(PG8_SA(1, 0), cA + kstep, voffA); PG8_STAGE(PG8_SB(1, 1), cB + hstep + kstep, voffB);
        PG8_WAIT_V(6); PG8_BAR;
    } else {
        PG8_STAGE(PG8_SB(0, 0), cB, voffB); PG8_STAGE(PG8_SA(0, 0), cA, voffA); PG8_STAGE(PG8_SB(0, 1), cB + hstep, voffB); PG8_STAGE(PG8_SA(0, 1), cA + hstep, voffA);
        if (wr == 1) PG8_BAR;
        PG8_WAIT_V(4); PG8_BAR;
        PG8_STAGE(PG8_SB(1, 0), cB + kstep, voffB); PG8_STAGE(PG8_SA(1, 0), cA + kstep, voffA); PG8_STAGE(PG8_SB(1, 1), cB + hstep + kstep, voffB);
        PG8_WAIT_V(6); PG8_BAR;
    }
    for (;;) {
        const bool has_next = S.next(ui + 1, nxt);
        const char* nA = has_next ? (const char*)g.A + (size_t)nxt.pm * tstep : cA; const char* nB = has_next ? (const char*)g.Bt + (size_t)nxt.pn * tstep : cB;
        for (int t = 0; t < nt; t += 2) {
            const bool last = (t == nt - 2);
            const char* a1 = cA + (size_t)(t + 1) * kstep;
            const char* a2 = last ? nA : cA + (size_t)(t + 2) * kstep; const char* b2 = last ? nB : cB + (size_t)(t + 2) * kstep;
            const char* a3 = a2 + kstep; const char* b3 = b2 + kstep;
            if (last && has_next) S.a_ready(nxt);
            if constexpr (SP2) {
            PG8_LDB(B0, 0, 0); PG8_LDB(B1, 0, 1); PG8_SCHED; PG8_LDA(At, 0, 0); PG8_STAGE(PG8_SA(1, 1), a1 + hstep, voffA);
            PG8_WAIT_V(8); PG8_WAIT_L(0); PG8_BAR; PG8_MMA(0, 0, At, B0); PG8_MMA(0, 1, At, B1); PG8_BAR; PG8_SCHED;
            PG8_LDA(At, 0, 1); PG8_STAGE(PG8_SB(0, 0), b2, voffB); PG8_STAGE(PG8_SB(0, 1), b2 + hstep, voffB); PG8_STAGE(PG8_SA(0, 0), a2, voffA);
            PG8_WAIT_V(8); PG8_WAIT_L(0); PG8_BAR; PG8_MMA(1, 0, At, B0); PG8_MMA(1, 1, At, B1); PG8_BAR; PG8_SCHED;
            PG8_LDB(B0, 1, 0); PG8_LDB(B1, 1, 1); PG8_SCHED; PG8_LDA(At, 1, 0); PG8_STAGE(PG8_SA(0, 1), a2 + hstep, voffA);
            PG8_WAIT_V(8); PG8_WAIT_L(0); PG8_BAR; PG8_MMA(0, 0, At, B0); PG8_MMA(0, 1, At, B1); PG8_BAR; PG8_SCHED;
            PG8_LDA(At, 1, 1); PG8_STAGE(PG8_SB(1, 0), b3, voffB); PG8_STAGE(PG8_SB(1, 1), b3 + hstep, voffB); PG8_STAGE(PG8_SA(1, 0), a3, voffA);
            PG8_WAIT_V(8); PG8_WAIT_L(0); PG8_BAR; PG8_MMA(1, 0, At, B0); PG8_MMA(1, 1, At, B1); PG8_BAR; PG8_SCHED;
            } else {
            PG8_LDB(B0, 0, 0); PG8_SCHED; PG8_LDA(At, 0, 0); PG8_STAGE(PG8_SA(1, 1), a1 + hstep, voffA);
            PG8_WAIT_L(8); PG8_BAR; PG8_WAIT_L(0); PG8_MMA(0, 0, At, B0); PG8_BAR; PG8_SCHED;
            PG8_LDB(B1, 0, 1); PG8_STAGE(PG8_SB(0, 0), b2, voffB);
            PG8_BAR; PG8_WAIT_L(0); PG8_MMA(0, 1, At, B1); PG8_BAR;
            PG8_LDA(At, 0, 1); PG8_STAGE(PG8_SA(0, 0), a2, voffA);
            PG8_BAR; PG8_WAIT_L(0); PG8_MMA(1, 0, At, B0); PG8_BAR; PG8_SCHED;
            PG8_STAGE(PG8_SB(0, 1), b2 + hstep, voffB);
            PG8_WAIT_V(6); PG8_BAR; PG8_MMA(1, 1, At, B1); PG8_BAR;
            PG8_LDB(B0, 1, 0); PG8_SCHED; PG8_LDA(At, 1, 0); PG8_STAGE(PG8_SA(0, 1), a2 + hstep, voffA);
            PG8_WAIT_L(8); PG8_BAR; PG8_WAIT_L(0); PG8_MMA(0, 0, At, B0); PG8_BAR; PG8_SCHED;
            PG8_LDB(B1, 1, 1); PG8_STAGE(PG8_SB(1, 0), b3, voffB);
            PG8_BAR; PG8_WAIT_L(0); PG8_MMA(0, 1, At, B1); PG8_BAR;
            PG8_LDA(At, 1, 1); PG8_STAGE(PG8_SA(1, 0), a3, voffA);
            PG8_BAR; PG8_WAIT_L(0); PG8_MMA(1, 0, At, B0); PG8_BAR; PG8_SCHED;
            PG8_STAGE(PG8_SB(1, 1), b3 + hstep, voffB);
            PG8_WAIT_V(6); PG8_BAR; PG8_MMA(1, 1, At, B1); PG8_BAR;
            }
        }
        if constexpr (ALIGN_EPI) { if (wr == 0) PG8_BAR; }
        if constexpr (!Epi::AFTER_DRAIN) { E(acc, cur, wr, wc, fr, fq); S.done(cur); }
        if (!has_next) break;
#pragma unroll
        for (int a = 0; a < 2; ++a)
#pragma unroll
            for (int b = 0; b < 2; ++b)
#pragma unroll
                for (int m = 0; m < 4; ++m)
#pragma unroll
                    for (int n = 0; n < 2; ++n) acc[a][b][m][n] = (f32x4){0.f, 0.f, 0.f, 0.f};
        cur = nxt; cA = nA; cB = nB; ++ui;
        if constexpr (ALIGN_EPI) { if (wr == 1) PG8_BAR; }
    }
    PG8_WAIT_V(0);
    if constexpr (!ALIGN_EPI) { if (wr == 0) PG8_BAR; }
    PG8_BAR;
    if constexpr (Epi::AFTER_DRAIN) { E.fused(acc, cur, wr, wc, fr, fq, lds, wid, lane); S.done(cur); }
#undef PG8_SA
#undef PG8_SB
#undef PG8_STAGE
#undef PG8_LDA
#undef PG8_LDB
#undef PG8_MMA
#undef PG8_WAIT_V
#undef PG8_WAIT_L
#undef PG8_BAR
#undef PG8_SCHED
}
}

__device__ __forceinline__ unsigned pkbf(float lo, float hi) { return pg8::cvt_pk_bf16(lo, hi); }
__device__ __forceinline__ void st8bf(bf16_t* p, f32x4 a, f32x4 b) { u32x4 w; w.x = pkbf(a[0], a[1]); w.y = pkbf(a[2], a[3]); w.z = pkbf(b[0], b[1]); w.w = pkbf(b[2], b[3]); *(u32x4*)p = w; }
__device__ __forceinline__ f32x4 bflo(u32x4 g) { f32x4 o; o[0] = __uint_as_float(g.x << 16); o[1] = __uint_as_float(g.x & 0xffff0000u); o[2] = __uint_as_float(g.y << 16); o[3] = __uint_as_float(g.y & 0xffff0000u); return o; }
__device__ __forceinline__ f32x4 bfhi(u32x4 g) { f32x4 o; o[0] = __uint_as_float(g.z << 16); o[1] = __uint_as_float(g.z & 0xffff0000u); o[2] = __uint_as_float(g.w << 16); o[3] = __uint_as_float(g.w & 0xffff0000u); return o; }
__device__ __forceinline__ f32x4 bf4(u32x2 g) { f32x4 o; o[0] = __uint_as_float(g.x << 16); o[1] = __uint_as_float(g.x & 0xffff0000u); o[2] = __uint_as_float(g.y << 16); o[3] = __uint_as_float(g.y & 0xffff0000u); return o; }
__device__ __forceinline__ void rot8(f32x4& a, f32x4& b, f32x4 c, f32x4 s) {
    const f32x4 x = a, y = b;
    a[0] = x[0] * c[0] - x[1] * s[0]; a[1] = x[1] * c[0] + x[0] * s[0]; a[2] = x[2] * c[1] - x[3] * s[1]; a[3] = x[3] * c[1] + x[2] * s[1];
    b[0] = y[0] * c[2] - y[1] * s[2]; b[1] = y[1] * c[2] + y[0] * s[2]; b[2] = y[2] * c[3] - y[3] * s[3]; b[3] = y[3] * c[3] + y[2] * s[3];
}
__device__ __forceinline__ f32x4 sig4(f32x4 v) { f32x4 o; o[0] = 1.f / (1.f + __expf(-v[0])); o[1] = 1.f / (1.f + __expf(-v[1])); o[2] = 1.f / (1.f + __expf(-v[2])); o[3] = 1.f / (1.f + __expf(-v[3])); return o; }
__host__ __device__ __forceinline__ int src_in(int n) {
    if (n < 1024) return n;
    if (n < 4096) { const int seg = (n - 1024) >> 10, c = (n - 1024) & 1023, d = c & 127; int od = d; if (seg < 2 && d < 32) od = (d >> 1) + (d & 1) * 16; return 1088 + seg * 1024 + (c & ~127) + od; }
    if (n < 5120) { const int c = n - 4096, d = c & 63; const int od = d < 16 ? (d >> 1) + (d & 1) * 8 : d; return 4160 + (c & ~63) + od; }
    if (n < 7168) return 5264 + (n - 5120);
    if (n < 9216) return 7312 + (n - 7168);
    if (n < 9280) { const int d = n - 9216; return 1024 + (d >> 1) + (d & 1) * 32; }
    if (n < 9344) { const int d = n - 9280; const int od = d < 16 ? (d >> 1) + (d & 1) * 8 : d; return 5184 + od; }
    if (n < 9360) return 5248 + (n - 9344);
    return -1;
}
__host__ __device__ __forceinline__ int src_qa(int n) { const int h = n / 192, d = n - h * 192; if (d < 128) return n; const int dd = d - 128; return h * 192 + 128 + (dd >> 1) + (dd & 1) * 32; }

struct EpiIn {
    static constexpr bool PERM = true, AFTER_DRAIN = false;
    unsigned char* ws;
    __device__ __forceinline__ void operator()(const f32x4 (&acc)[2][2][4][2], const pg8::Unit& u, int wr, int wc, int fr, int fq) const {
        const int row0 = u.pm * 256 + wr * 64 + fr, cu = wc * 32 + 8 * fq, pn = u.pn;
        bf16_t* const CQ = (bf16_t*)(ws + WS_CQ); bf16_t* const QB = (bf16_t*)(ws + WS_QB); bf16_t* const QI = (bf16_t*)(ws + WS_QI); bf16_t* const GA = (bf16_t*)(ws + WS_GA);
        bf16_t* const KA = (bf16_t*)(ws + WS_KA); bf16_t* const KI = (bf16_t*)(ws + WS_KI); float* const WI = (float*)(ws + WS_WI); float* const part = (float*)(ws + WS_SSQ);
        const float* const cM = (const float*)(ws + WS_ROPE); const float* const sM = cM + T * 32; const float* const cD = cM + T * 64; const float* const sD = cM + T * 80; const float* const cI = cM + T * 96; const float* const sI = cM + T * 104;
#define EPI_ROWS(BODY) _Pragma("unroll") for (int ai = 0; ai < 2; ++ai) _Pragma("unroll") for (int m = 0; m < 4; ++m) { const int t = row0 + ai * 128 + m * 16; \
            _Pragma("unroll") for (int bj = 0; bj < 2; ++bj) { f32x4 a = acc[ai][bj][m][0], b = acc[ai][bj][m][1]; BODY } }
        if (pn < 4) {
            bf16_t* const dst = CQ + (size_t)(pn >> 1) * ((size_t)T * 512) + (pn & 1) * 256 + cu;
            EPI_ROWS(
                st8bf(dst + (size_t)t * 512 + bj * 128, a, b);
                float sq = ((a[0] * a[0] + a[1] * a[1]) + (a[2] * a[2] + a[3] * a[3])) + ((b[0] * b[0] + b[1] * b[1]) + (b[2] * b[2] + b[3] * b[3]));
                sq += __shfl_xor(sq, 16); sq += __shfl_xor(sq, 32);
                if (fq == 0) part[(size_t)t * 32 + pn * 8 + bj * 4 + wc] = sq; )
        } else if (pn < 16) {
            const int seg = (pn - 4) >> 2; const bool rot = seg < 2 && wc == 0;
            bf16_t* const dst = QB + (size_t)seg * ((size_t)T * 1024) + ((pn - 4) & 3) * 256 + cu;
            EPI_ROWS(
                if (rot) rot8(a, b, *(const f32x4*)(cD + (size_t)t * 16 + 4 * fq), *(const f32x4*)(sD + (size_t)t * 16 + 4 * fq));
                st8bf(dst + (size_t)t * 1024 + bj * 128, a, b); )
        } else if (pn < 20) {
            const bool rot = (wc & 1) == 0 && fq < 2;
            bf16_t* const dst = QI + (size_t)(unsigned)((row0 >> 5) * 32768 + (row0 & 31) * 8 + (pn - 16) * 8192 + (cu >> 6) * 2048 + ((cu >> 4) & 3) * 512 + ((cu >> 3) & 1) * 256);
            EPI_ROWS(
                if (rot) rot8(a, b, *(const f32x4*)(cI + (size_t)t * 8 + 4 * fq), *(const f32x4*)(sI + (size_t)t * 8 + 4 * fq));
                st8bf(dst + (ai * 4 + (m >> 1)) * 32768 + (m & 1) * 128 + bj * 4096, a, b); )
        } else if (pn < 36) {
            bf16_t* const dst = GA + (size_t)((pn - 20) >> 3) * ((size_t)T * D) + ((pn - 20) & 7) * 256 + cu;
            EPI_ROWS( st8bf(dst + (size_t)t * D + bj * 128, sig4(a), sig4(b)); )
        } else {
            EPI_ROWS(
                if (bj == 0) {
                    if (wc < 2) {
                        rot8(a, b, *(const f32x4*)(cM + (size_t)t * 32 + (cu >> 1)), *(const f32x4*)(sM + (size_t)t * 32 + (cu >> 1)));
                        _Pragma("unroll") for (int h = 0; h < 8; ++h) st8bf(KA + (size_t)t * 1536 + h * 192 + 128 + cu, a, b);
                    } else {
                        const int d = cu - 64;
                        if (d < 16) rot8(a, b, *(const f32x4*)(cI + (size_t)t * 8 + (d >> 1)), *(const f32x4*)(sI + (size_t)t * 8 + (d >> 1)));
                        st8bf(KI + (size_t)t * 64 + d, a, b);
                    }
                } else if (cu < 16) {
                    *(f32x4*)(WI + (size_t)t * 16 + cu) = a * 0.03125f; *(f32x4*)(WI + (size_t)t * 16 + cu + 4) = b * 0.03125f;
                } )
        }
#undef EPI_ROWS
    }
};
__device__ __forceinline__ float rms_from_part(const float* pp) {
    const f32x4 p0 = *(const f32x4*)pp, p1 = *(const f32x4*)(pp + 4), p2 = *(const f32x4*)(pp + 8), p3 = *(const f32x4*)(pp + 12);
    const float s = (((p0[0] + p0[1]) + (p0[2] + p0[3])) + ((p1[0] + p1[1]) + (p1[2] + p1[3]))) + (((p2[0] + p2[1]) + (p2[2] + p2[3])) + ((p3[0] + p3[1]) + (p3[2] + p3[3])));
    return rsqrtf(s * (1.f / 512.f) + 1e-6f);
}
struct EpiQA {
    static constexpr bool PERM = true, AFTER_DRAIN = false;
    unsigned char* ws;
    __device__ __forceinline__ void operator()(const f32x4 (&acc)[2][2][4][2], const pg8::Unit& u, int wr, int wc, int fr, int fq) const {
        const int row0 = u.pm * 256 + wr * 64 + fr, cu = wc * 32 + 8 * fq;
        bf16_t* const QA = (bf16_t*)(ws + WS_QA); const float* const part = (const float*)(ws + WS_SSQ); const float* const cM = (const float*)(ws + WS_ROPE); const float* const sM = cM + T * 32;
#pragma unroll
        for (int ai = 0; ai < 2; ++ai)
#pragma unroll
            for (int m = 0; m < 4; ++m) {
                const int t = row0 + ai * 128 + m * 16;
                const float r = rms_from_part(part + (size_t)t * 32);
#pragma unroll
                for (int bj = 0; bj < 2; ++bj) {
                    const int n = u.pn * 256 + bj * 128 + cu, h = n / 192, d = n - h * 192;
                    f32x4 a = acc[ai][bj][m][0] * r, b = acc[ai][bj][m][1] * r;
                    if (d >= 128) rot8(a, b, *(const f32x4*)(cM + (size_t)t * 32 + ((d - 128) >> 1)), *(const f32x4*)(sM + (size_t)t * 32 + ((d - 128) >> 1)));
                    st8bf(QA + (size_t)t * 1536 + n, a, b);
                }
            }
    }
};
struct EpiKV {
    static constexpr bool PERM = true, AFTER_DRAIN = false;
    unsigned char* ws;
    __device__ __forceinline__ void operator()(const f32x4 (&acc)[2][2][4][2], const pg8::Unit& u, int wr, int wc, int fr, int fq) const {
        const int row0 = u.pm * 256 + wr * 64 + fr, cu = wc * 32 + 8 * fq;
        bf16_t* const KA = (bf16_t*)(ws + WS_KA); bf16_t* const VA = (bf16_t*)(ws + WS_VA); const float* const part = (const float*)(ws + WS_SSQ);
#pragma unroll
        for (int ai = 0; ai < 2; ++ai)
#pragma unroll
            for (int m = 0; m < 4; ++m) {
                const int t = row0 + ai * 128 + m * 16;
                const float r = rms_from_part(part + (size_t)t * 32 + 16);
                st8bf(KA + (size_t)t * 1536 + u.pn * 192 + cu, acc[ai][0][m][0] * r, acc[ai][0][m][1] * r);
                st8bf(VA + (size_t)t * 1024 + u.pn * 128 + cu, acc[ai][1][m][0] * r, acc[ai][1][m][1] * r);
            }
    }
};
struct EpiYA {
    static constexpr bool PERM = true, AFTER_DRAIN = false;
    unsigned char* ws;
    __device__ __forceinline__ void operator()(const f32x4 (&acc)[2][2][4][2], const pg8::Unit& u, int wr, int wc, int fr, int fq) const {
        const int row0 = u.pm * 256 + wr * 64 + fr, col0 = u.pn * 256 + wc * 32 + 8 * fq;
        bf16_t* const YT = (bf16_t*)(ws + WS_YT); const bf16_t* const GA = (const bf16_t*)(ws + WS_GA);
#pragma unroll
        for (int ai = 0; ai < 2; ++ai)
#pragma unroll
            for (int m = 0; m < 4; ++m)
#pragma unroll
                for (int bj = 0; bj < 2; ++bj) {
                    const size_t o = (size_t)(row0 + ai * 128 + m * 16) * D + col0 + bj * 128;
                    const u32x4 g = *(const u32x4*)(GA + o);
                    st8bf(YT + o, acc[ai][bj][m][0] * bflo(g), acc[ai][bj][m][1] * bfhi(g));
                }
    }
};
struct EpiYB {
    static constexpr bool PERM = true, AFTER_DRAIN = false;
    unsigned char* ws;
    __device__ __forceinline__ void operator()(const f32x4 (&acc)[2][2][4][2], const pg8::Unit& u, int wr, int wc, int fr, int fq) const {
        const int row0 = u.pm * 256 + wr * 64 + fr, col0 = u.pn * 256 + wc * 32 + 8 * fq;
        const bf16_t* const YT = (const bf16_t*)(ws + WS_YT); const bf16_t* const GB = (const bf16_t*)(ws + WS_GB); bf16_t* const Y = (bf16_t*)(ws + WS_Y);
#pragma unroll
        for (int ai = 0; ai < 2; ++ai)
#pragma unroll
            for (int m = 0; m < 4; ++m)
#pragma unroll
                for (int bj = 0; bj < 2; ++bj) {
                    const size_t o = (size_t)(row0 + ai * 128 + m * 16) * D + col0 + bj * 128;
                    const u32x4 g = *(const u32x4*)(GB + o);
                    const u32x4 yt = *(const u32x4*)(YT + o); const f32x4 y0 = bflo(yt), y1 = bfhi(yt);
                    st8bf(Y + o, y0 + acc[ai][bj][m][0] * bflo(g), y1 + acc[ai][bj][m][1] * bfhi(g));
                }
    }
};
struct EpiOut {
    static constexpr bool PERM = true, AFTER_DRAIN = false;
    const float* hin; float* V1;
    __device__ __forceinline__ void operator()(const f32x4 (&acc)[2][2][4][2], const pg8::Unit& u, int wr, int wc, int fr, int fq) const {
        const int row0 = u.pm * 256 + wr * 64 + fr, col0 = u.pn * 256 + wc * 32 + 8 * fq;
#pragma unroll
        for (int ai = 0; ai < 2; ++ai)
#pragma unroll
            for (int m = 0; m < 4; ++m)
#pragma unroll
                for (int bj = 0; bj < 2; ++bj) {
                    const size_t o = (size_t)(row0 + ai * 128 + m * 16) * D + col0 + bj * 128;
                    const f32x4 h0 = *(const f32x4*)(hin + o), h1 = *(const f32x4*)(hin + o + 4);
                    *(f32x4*)(V1 + o) = h0 * ALPHA + acc[ai][bj][m][0]; *(f32x4*)(V1 + o + 4) = h1 * ALPHA + acc[ai][bj][m][1];
                }
    }
};

#define LDS_WAIT() asm volatile("s_waitcnt lgkmcnt(0)" ::: "memory")
__device__ __forceinline__ void transpose_item(int MAP, const float* W, int ldw, int K, int N, const float* kscale, bf16_t* WT, LAS float* scr, int item, int lane) {
    const int nblk = N / 32, kb = item / nblk, nb = item % nblk, k0 = 64 * kb, n0 = 32 * nb;
    const int n = n0 + (lane & 31);
    const int sc = MAP == 0 ? n : (MAP == 1 ? src_in(n) : src_qa(n));
#pragma unroll 8
    for (int i = 0; i < 32; ++i) { const int kk = 2 * i + (lane >> 5);
        float v = sc >= 0 ? W[(size_t)(k0 + kk) * ldw + sc] : 0.f; if (kscale) v *= kscale[k0 + kk];
        scr[kk * 33 + (lane & 31)] = v; }
    LDS_WAIT(); asm volatile("" ::: "memory");
    const int c = lane & 7;
#pragma unroll
    for (int j = 0; j < 4; ++j) { const int nn = (lane >> 3) + 8 * j; const LAS float* sp = scr + (8 * c) * 33 + nn;
        u32x4 o; o.x = pkbf(sp[0 * 33], sp[1 * 33]); o.y = pkbf(sp[2 * 33], sp[3 * 33]); o.z = pkbf(sp[4 * 33], sp[5 * 33]); o.w = pkbf(sp[6 * 33], sp[7 * 33]);
        *(u32x4*)(WT + (size_t)(n0 + nn) * K + k0 + 8 * c) = o; }
    LDS_WAIT(); asm volatile("" ::: "memory");
}
__device__ __forceinline__ int tperm(int pm, int nn) {
    if (pm == 0) return nn;
    if (pm == 1) return nn < 32 ? (nn >> 1) + (nn & 1) * 16 : nn;
    if (pm == 2) return nn < 16 ? (nn >> 1) + (nn & 1) * 8 : nn;
    if (pm == 3) return (nn >> 1) + (nn & 1) * 32;
    if (pm == 4) return nn < 16 ? nn : -1;
    return -1;
}
__device__ __forceinline__ void transpose_block_vec(const float* W, int ldw, int K, int s0, int pm, int n0, int k0, const float* kscale, bf16_t* WT, LAS float* scr, int lane) {
    const int r = lane >> 4, c4 = lane & 15;
    f32x4 v[16];
#pragma unroll
    for (int i = 0; i < 16; ++i) v[i] = *(const f32x4*)(W + (size_t)(k0 + 4 * i + r) * ldw + s0 + 4 * c4);
    float ks[16];
#pragma unroll
    for (int i = 0; i < 16; ++i) ks[i] = kscale ? kscale[k0 + 4 * i + r] : 1.f;
#pragma unroll
    for (int i = 0; i < 16; ++i) { const int kk = 4 * i + r; const f32x4 w = v[i] * ks[i];
        LAS float* d = scr + kk * 65 + 4 * c4; d[0] = w[0]; d[1] = w[1]; d[2] = w[2]; d[3] = w[3]; }
    LDS_WAIT(); asm volatile("" ::: "memory");
    const int c = lane & 7;
#pragma unroll
    for (int j = 0; j < 8; ++j) { const int nn = (lane >> 3) + 8 * j, so = tperm(pm, nn); const LAS float* sp = scr + (8 * c) * 65 + (so < 0 ? 0 : so);
        u32x4 o; o.x = pkbf(sp[0 * 65], sp[1 * 65]); o.y = pkbf(sp[2 * 65], sp[3 * 65]); o.z = pkbf(sp[4 * 65], sp[5 * 65]); o.w = pkbf(sp[6 * 65], sp[7 * 65]);
        if (so < 0) o = (u32x4){0u, 0u, 0u, 0u};
        *(u32x4*)(WT + (size_t)(n0 + nn) * K + k0 + 8 * c) = o; }
    LDS_WAIT(); asm volatile("" ::: "memory");
}
__device__ __forceinline__ void p_wcopies(LAS unsigned char* ldsb, const Params& p, const int l1, const int lo1, const int hi1, const int l2, const int lo2, const int hi2, const int rank, const int nranks) {
    const int tid_ = opaque_tid(), wave = tid_ >> 6, lane = tid_ & 63;
    LAS float* scr = (LAS float*)(ldsb + wave * 16640);
    const int gw = rank * 8 + wave, NGW = nranks * 8;
    constexpr int B_IN = (D / 64) * (INP / 64), B_QB = (512 / 64) * (1536 / 64), B_KV = (512 / 64) * (2048 / 64), B_O = (1024 / 64) * (D / 64), B_OUT = (D / 64) * (D / 64);
    constexpr int B_LAYER = B_IN + B_QB + B_KV + 2 * B_O + B_OUT;
    const int n1 = hi1 - lo1, ntot = n1 + (hi2 - lo2);
    for (int it = gw; it < ntot; it += NGW) {
        const int l = it < n1 ? l1 : l2; int r = it < n1 ? lo1 + it : lo2 + (it - n1);
        int map = 0, ldw, K, N; const float* W; const float* ks = nullptr; bf16_t* WT;
        if (r < B_IN) { map = 1; W = p.w_in + (size_t)l * D * INW; ldw = INW; K = D; N = INP; WT = (bf16_t*)(p.ws + WS_WIN_T) + (size_t)l * INP * D; }
        else if ((r -= B_IN) < B_QB) { map = 2; W = p.w_qb + (size_t)l * 512 * 1536; ldw = 1536; K = 512; N = 1536; ks = p.g_q + l * 512; WT = (bf16_t*)(p.ws + WS_WQB_T) + (size_t)l * 1536 * 512; }
        else if ((r -= B_QB) < B_KV) { W = p.w_kvb + (size_t)l * 512 * 2048; ldw = 2048; K = 512; N = 2048; ks = p.g_kv + l * 512; WT = (bf16_t*)(p.ws + WS_WKVB_T) + (size_t)l * 2048 * 512; }
        else if ((r -= B_KV) < B_O) { W = p.w_oa + (size_t)l * 1024 * D; ldw = D; K = 1024; N = D; WT = (bf16_t*)(p.ws + WS_WOA_T) + (size_t)l * D * 1024; }
        else if ((r -= B_O) < B_O) { W = p.w_ob + (size_t)l * 1024 * D; ldw = D; K = 1024; N = D; WT = (bf16_t*)(p.ws + WS_WOB_T) + (size_t)l * D * 1024; }
        else { r -= B_O; W = p.w_out + (size_t)l * D * D; ldw = D; K = D; N = D; WT = (bf16_t*)(p.ws + WS_WOUT_T) + (size_t)l * D * D; }
        const int nb64 = N / 64, kb = r / nb64, nb = r - kb * nb64, n0 = 64 * nb, k0 = 64 * kb;
        int s0 = n0, pm = 0;
        if (map == 1) { s0 = src_in(n0);
            if (n0 >= 1024 && n0 < 3072 && !(n0 & 64)) pm = 1; else if (n0 >= 4096 && n0 < 5120) pm = 2; else if (n0 == 9216) pm = 3; else if (n0 == 9280) pm = 2; else if (n0 == 9344) pm = 4; else if (n0 >= 9408) { pm = 5; s0 = 0; } }
        else if (map == 2) { s0 = src_qa(n0); if ((n0 % 192) == 128) pm = 3; }
        transpose_block_vec(W, ldw, K, s0, pm, n0, k0, ks, WT, scr, lane);
    }
    __syncthreads();
}
__device__ __forceinline__ void p_prologue(LAS unsigned char* ldsb, const Params& p, const int parts = 31) {
    float* rope = (float*)(p.ws + WS_ROPE);
    float *cM = rope, *sM = rope + T * 32, *cD = rope + T * 64, *sD = rope + T * 80, *cI = rope + T * 96, *sI = rope + T * 104;
    const int gtid = opaque_bid() * NTHREADS + threadIdx.x, gstride = gridDim.x * NTHREADS;
    if (parts & 1) for (int idx = gtid; idx < T * 56; idx += gstride) {
        const int t = idx / 56, j = idx - t * 56;
        int rot, i; float *ct, *st; int w;
        if (j < 32) { rot = 64; i = j; ct = cM; st = sM; w = 32; } else if (j < 48) { rot = 32; i = j - 32; ct = cD; st = sD; w = 16; } else { rot = 16; i = j - 48; ct = cI; st = sI; w = 8; }
        const float inv = exp2f(-((float)(2 * i) / (float)rot) * 18.931568569324174f);
        const float ang = (float)p.pos[t] * inv;
        double rev = (double)ang * 0.15915494309189535; rev -= rint(rev);
        const float r = (float)(rev * 6.283185307179586);
        ct[t * w + i] = __cosf(r); st[t * w + i] = __sinf(r);
    }
    bf16_t* XB = (bf16_t*)(p.ws + WS_XB);
    if (parts & 2) for (size_t i = (size_t)gtid * 4; i < (size_t)T * D; i += (size_t)gstride * 32) {
        f32x4 a[8];
#pragma unroll
        for (int u = 0; u < 8; ++u) { const size_t iu = i + (size_t)u * gstride * 4; a[u] = iu < (size_t)T * D ? *(const f32x4*)(p.x + iu) : (f32x4){0.f, 0.f, 0.f, 0.f}; }
#pragma unroll
        for (int u = 0; u < 8; ++u) { const size_t iu = i + (size_t)u * gstride * 4; if (iu < (size_t)T * D) st4bf(XB + iu, a[u]); } }
    if (parts & 4) { float* SEC = (float*)(p.ws + WS_SEC);
      { bf16_t* RWH = (bf16_t*)(p.ws + WS_RWH); bf16_t* RWL = (bf16_t*)(p.ws + WS_RWL);
        for (int idx = gtid; idx < DEPTH * 96 * D; idx += gstride) { const int l = idx / (96 * D), r = idx - l * (96 * D), e = r / D, k = r - e * D;
            float w = 0.f; if (e < 64) w = p.ln1g[l * D + k] * p.w_router[((size_t)l * D + k) * 64 + e]; else if (e < 72) w = p.ln1g[l * D + k] * p.w_group[((size_t)l * D + k) * 8 + (e - 64)];
            const size_t fo = (size_t)l * (96 * D) + (size_t)((((k >> 8) * 16 + ((k >> 4) & 15)) * 3 + (e >> 5)) * 2 + ((k >> 3) & 1)) * 256 + (e & 31) * 8 + (k & 7);
            const bf16_t h = f2bf(w); RWH[fo] = h; RWL[fo] = f2bf(w - bf2f(h)); } }
      { const int wave_ = threadIdx.x >> 6, lane_ = threadIdx.x & 63, gwv = opaque_bid() * 8 + wave_;
        if (gwv < DEPTH * 72) { const int l = gwv / 72, e = gwv - l * 72; float sa = 0.f, ca = 0.f;
#pragma unroll 4
          for (int i = 0; i < D / 64; ++i) { const int k = lane_ + 64 * i; const float w = e < 64 ? p.w_router[((size_t)l * D + k) * 64 + e] : p.w_group[((size_t)l * D + k) * 8 + (e - 64)]; sa = fmaf(p.ln1g[l * D + k], w, sa); ca = fmaf(p.ln1b[l * D + k], w, ca); }
          sa = wave_sum(sa); ca = wave_sum(ca);
          if (lane_ == 0) { SEC[l * 160 + e] = sa; SEC[l * 160 + 80 + e] = ca + (e < 64 ? p.b_router[l * 64 + e] : p.b_group[l * 8 + (e - 64)]); } } } }
    __syncthreads();
}

__device__ __forceinline__ unsigned f2key(float f) { const unsigned u = __float_as_uint(f); return (u & 0x80000000u) ? ~u : (u | 0x80000000u); }
typedef short bf16x8 __attribute__((ext_vector_type(8)));
typedef short s16x4 __attribute__((ext_vector_type(4)));
typedef float f32x16 __attribute__((ext_vector_type(16)));
__device__ __forceinline__ void p_score(LAS unsigned char* ldsb, unsigned char* ws) {
    const bf16_t* QI = (const bf16_t*)(ws + WS_QI); const bf16_t* KI = (const bf16_t*)(ws + WS_KI); const float* WI = (const float*)(ws + WS_WI);
    unsigned* SC = (unsigned*)(ws + WS_SCORE);
    const int tid = opaque_tid(), lane = tid & 63, wv = __builtin_amdgcn_readfirstlane(tid >> 6), r32 = lane & 31, hi = lane >> 5;
    const int ksw = ((r32 >> 1) & 7) ^ hi;
    const unsigned krow = (unsigned)(size_t)ldsb + (unsigned)r32 * 128u;
    const int G_ = gridDim.x, bid_ = opaque_bid();
    const int nit_ = (G_ == 256) ? 3 : (544 - bid_ + G_ - 1) / G_;
    for (int it_ = 0; it_ < nit_; ++it_) {
        int item = bid_ + G_ * it_;
        if (G_ == 256 && it_ == 2) item = (bid_ >= 192 && bid_ < 224) ? 512 + (bid_ - 192) : 544;
        if (item >= 544) continue;
        const int b = item / 272; int r = item - b * 272, qb = 0;
        while (r >= 2 * qb + 2) { r -= 2 * qb + 2; ++qb; }
        const int kc = r, q0 = qb * 256 + wv * 32;
        __builtin_amdgcn_s_barrier();
#pragma unroll
        for (int i = 0; i < 2; ++i) { const int g = i * 512 + tid, row = g >> 3, ch = (g & 7) ^ ((row >> 1) & 7);
            __builtin_amdgcn_global_load_lds((const unsigned*)(KI + (size_t)(b * S + kc * 128 + row) * 64 + ch * 8), (LAS unsigned*)(ldsb + (i * 512 + wv * 64) * 16), 16, 0, 0); }
        asm volatile("s_waitcnt vmcnt(0)" ::: "memory");
        __builtin_amdgcn_s_barrier();
        if (kc * 128 <= q0 + 31) {
            const size_t t = (size_t)b * S + q0 + r32;
            bf16x8 ka[4][4];
#pragma unroll
            for (int kb = 0; kb < 4; ++kb)
#pragma unroll
                for (int d0 = 0; d0 < 4; ++d0) ka[kb][d0] = *(const LAS bf16x8*)(size_t)(krow + kb * 4096 + ((unsigned)((2 * d0) ^ ksw) << 4));
            f32x16 acc[4];
#pragma unroll
            for (int kb = 0; kb < 4; ++kb)
#pragma unroll
                for (int rr = 0; rr < 16; ++rr) acc[kb][rr] = 0.f;
            const bf16_t* qrow = QI + (t >> 5) * 32768 + hi * 256 + r32 * 8; const float* wrow = WI + t * 16;
            bf16x8 qa0, qa1, qa2, qa3, qc0, qc1, qc2, qc3; float wa, wc_;
#define SC_LOAD(Q0, Q1, Q2, Q3, W, h_) do { const bf16_t* p_ = qrow + (h_) * 2048; const float* w_ = wrow + (h_); \
                asm volatile("global_load_dwordx4 %0, %1, off" : "=v"(Q0) : "v"(p_) : "memory"); asm volatile("global_load_dwordx4 %0, %1, off offset:1024" : "=v"(Q1) : "v"(p_) : "memory"); \
                asm volatile("global_load_dwordx4 %0, %1, off offset:2048" : "=v"(Q2) : "v"(p_) : "memory"); asm volatile("global_load_dwordx4 %0, %1, off offset:3072" : "=v"(Q3) : "v"(p_) : "memory"); \
                asm volatile("global_load_dword %0, %1, off" : "=v"(W) : "v"(w_) : "memory"); } while (0)
#define SC_WAIT(n_) asm volatile("s_waitcnt vmcnt(" #n_ ")" : "+v"(qa0), "+v"(qa1), "+v"(qa2), "+v"(qa3), "+v"(wa), "+v"(qc0), "+v"(qc1), "+v"(qc2), "+v"(qc3), "+v"(wc_) :: "memory")
#define SC_CHAIN(PZ, kb_, Q0, Q1, Q2, Q3) do { _Pragma("unroll") for (int rr = 0; rr < 16; ++rr) PZ[rr] = 0.f; \
                PZ = __builtin_amdgcn_mfma_f32_32x32x16_bf16(ka[kb_][0], Q0, PZ, 0, 0, 0); PZ = __builtin_amdgcn_mfma_f32_32x32x16_bf16(ka[kb_][1], Q1, PZ, 0, 0, 0); \
                PZ = __builtin_amdgcn_mfma_f32_32x32x16_bf16(ka[kb_][2], Q2, PZ, 0, 0, 0); PZ = __builtin_amdgcn_mfma_f32_32x32x16_bf16(ka[kb_][3], Q3, PZ, 0, 0, 0); } while (0)
#define SC_ACC(PZ, kb_, W) do { _Pragma("unroll") for (int rr = 0; rr < 16; ++rr) { const float rl = __int_as_float(max(__float_as_int(PZ[rr]), 0)); \
                float av = acc[kb_][rr]; asm("v_fmac_f32 %0, %1, %2" : "+v"(av) : "v"(W), "v"(rl)); acc[kb_][rr] = av; } } while (0)
#define SC_HEAD(Q0, Q1, Q2, Q3, W) do { f32x16 pzA, pzB; SC_CHAIN(pzA, 0, Q0, Q1, Q2, Q3); SC_CHAIN(pzB, 1, Q0, Q1, Q2, Q3); SC_ACC(pzA, 0, W); SC_CHAIN(pzA, 2, Q0, Q1, Q2, Q3); SC_ACC(pzB, 1, W); \
                SC_CHAIN(pzB, 3, Q0, Q1, Q2, Q3); SC_ACC(pzA, 2, W); SC_ACC(pzB, 3, W); } while (0)
            SC_LOAD(qa0, qa1, qa2, qa3, wa, 0);
#pragma unroll 1
            for (int h = 0; h < 16; h += 2) {
                SC_LOAD(qc0, qc1, qc2, qc3, wc_, h + 1);
                SC_WAIT(5);
                SC_HEAD(qa0, qa1, qa2, qa3, wa);
                SC_LOAD(qa0, qa1, qa2, qa3, wa, (h + 2) & 15);
                SC_WAIT(5);
                SC_HEAD(qc0, qc1, qc2, qc3, wc_);
            }
            SC_WAIT(0);
#undef SC_LOAD
#undef SC_WAIT
#undef SC_CHAIN
#undef SC_ACC
#undef SC_HEAD
            const int dq = q0 + r32 - kc * 128 - 4 * hi;
            unsigned* srow = SC + t * 4096 + kc * 128 + 4 * hi;
#pragma unroll
            for (int kb = 0; kb < 4; ++kb)
#pragma unroll
                for (int rq = 0; rq < 4; ++rq) { u32x4 o; const int c0 = 32 * kb + 8 * rq;
                    o.x = (c0 <= dq) ? f2key(acc[kb][4 * rq]) : 0u; o.y = (c0 + 1 <= dq) ? f2key(acc[kb][4 * rq + 1]) : 0u;
                    o.z = (c0 + 2 <= dq) ? f2key(acc[kb][4 * rq + 2]) : 0u; o.w = (c0 + 3 <= dq) ? f2key(acc[kb][4 * rq + 3]) : 0u;
                    *(u32x4*)(srow + c0) = o; }
        }
    }
    __builtin_amdgcn_s_barrier();
}
__device__ __forceinline__ int wave_sum_dpp(int x) {
    x += __builtin_amdgcn_update_dpp(0, x, 0x111, 0xf, 0xf, true);
    x += __builtin_amdgcn_update_dpp(0, x, 0x112, 0xf, 0xf, true);
    x += __builtin_amdgcn_update_dpp(0, x, 0x114, 0xf, 0xf, true);
    x += __builtin_amdgcn_update_dpp(0, x, 0x118, 0xf, 0xf, true);
    x += __builtin_amdgcn_update_dpp(0, x, 0x142, 0xa, 0xf, false);
    x += __builtin_amdgcn_update_dpp(0, x, 0x143, 0xc, 0xf, false);
    return __builtin_amdgcn_readlane(x, 63);
}
__device__ __forceinline__ void p_select(unsigned char* ws) {
    const unsigned* SC = (const unsigned*)(ws + WS_SCORE); unsigned* MASK = (unsigned*)(ws + WS_MASK);
    const int tid = opaque_tid(), lane = tid & 63, wv = __builtin_amdgcn_readfirstlane(tid >> 6);
    const unsigned voff = (unsigned)lane * 16u;
#define SEL_LOAD(KK, t_) do { const int nq_ = ((((t_) & 4095)) >> 8) + 1; const unsigned char* rb_ = (const unsigned char*)(SC + (size_t)(t_) * 4096); \
        _Pragma("unroll") for (int j = 0; j < 16; ++j) { const unsigned char* a_ = rb_ + 1024 * (j < nq_ ? j : nq_ - 1); asm volatile("global_load_dwordx4 %0, %1, %2" : "=v"(KK[j]) : "v"(voff), "s"(a_) : "memory"); } } while (0)
#define SEL_WAIT(KK) asm volatile("s_waitcnt vmcnt(0)" : "+v"(KK[0]), "+v"(KK[1]), "+v"(KK[2]), "+v"(KK[3]), "+v"(KK[4]), "+v"(KK[5]), "+v"(KK[6]), "+v"(KK[7]), "+v"(KK[8]), "+v"(KK[9]), "+v"(KK[10]), "+v"(KK[11]), \
        "+v"(KK[12]), "+v"(KK[13]), "+v"(KK[14]), "+v"(KK[15]) :: "memory")
    u32x4 ka[16], kb[16];
    const int nwaves = gridDim.x * 8, wid_ = opaque_bid() * 8 + wv; const bool paired = nwaves * 4 == T;
    const int nrows = paired ? 4 : (wid_ < T ? (T - wid_ + nwaves - 1) / nwaves : 0);
#define SEL_ROW(i_) (paired ? ((((i_) >> 1) << 12) + (((i_) & 1) ? 4095 - wid_ : wid_)) : wid_ + (i_) * nwaves)
#define SW(K, i_) K[(i_) >> 2][(i_) & 3]
#define SEL_XT(x_, s_, m_) do { const unsigned y_ = (unsigned)__shfl_xor((int)(x_), (s_)); x_ = (lane & (s_)) ? (((x_) & (m_)) | ((y_ & (m_)) >> (4 * (s_)))) : (((x_) & ~(m_)) | ((y_ & ~(m_)) << (4 * (s_)))); } while (0)
#define SEL_TS(K, B0, J, M) _Pragma("unroll") for (int k_ = 0; k_ < 32; ++k_) if (!(k_ & (J))) { const unsigned a_ = SW(K, (B0) + k_), b_ = SW(K, (B0) + k_ + (J)); \
        SW(K, (B0) + k_) = (a_ & (M)) | ((b_ << (J)) & ~(M)); SW(K, (B0) + k_ + (J)) = ((a_ >> (J)) & (M)) | (b_ & ~(M)); }
#define SEL_BODY(K, KN, ri_) do { \
        const int t = SEL_ROW(ri_); \
        const int ti = t & 4095, nq = (ti >> 8) + 1; \
        SEL_LOAD(KN, SEL_ROW((ri_) + 1 < nrows ? (ri_) + 1 : (ri_)));        \
          \
        const int jq = ti >> 8; int nvp = (ti & 255) - 4 * lane + 1; nvp = nvp < 0 ? 0 : (nvp > 4 ? 4 : nvp); const unsigned pn = (1u << nvp) - 1u; \
        const unsigned vb0 = jq >= 8 ? 0xffffffffu : (((1u << (4 * jq)) - 1u) | (pn << (4 * jq))), vb1 = jq >= 8 ? (((1u << (4 * (jq - 8))) - 1u) | (pn << (4 * (jq - 8)))) : 0u; \
          \
          \
          \
        unsigned sel0, sel1 = 0u; \
        if (ti >= 256) { \
            SEL_TS(K, 0, 16, 0x0000ffffu); SEL_TS(K, 0, 8, 0x00ff00ffu); SEL_TS(K, 0, 4, 0x0f0f0f0fu); SEL_TS(K, 0, 2, 0x33333333u); SEL_TS(K, 0, 1, 0x55555555u); \
            if (nq > 8) { SEL_TS(K, 32, 16, 0x0000ffffu); SEL_TS(K, 32, 8, 0x00ff00ffu); SEL_TS(K, 32, 4, 0x0f0f0f0fu); SEL_TS(K, 32, 2, 0x33333333u); SEL_TS(K, 32, 1, 0x55555555u); }     \
            unsigned gt0 = 0u, gt1 = 0u, eq0 = vb0, eq1 = vb1; int tgt = 0; bool found = false; \
            _Pragma("unroll") for (int bit = 31; bit >= 0; --bit) if (!found) {        \
                const unsigned t0 = eq0 & SW(K, bit), t1 = eq1 & SW(K, 32 + bit); \
                const unsigned c = (unsigned)__popc(t0) + (unsigned)__popc(t1);            \
                const int tot = tgt + wave_sum_dpp((int)c); \
                if (tot >= 256) { eq0 = t0; eq1 = t1;                   \
                    if (tot == 256) { sel0 = gt0 | t0; sel1 = gt1 | t1; found = true; } }        \
                else { gt0 |= t0; gt1 |= t1; eq0 ^= t0; eq1 ^= t1; tgt = tot; } \
            } \
            if (!found) { sel0 = gt0 | eq0; sel1 = gt1 | eq1; }        \
        } else sel0 = vb0;                                                \
        SEL_WAIT(KN); \
          \
        SEL_XT(sel0, 1, 0xf0f0f0f0u); SEL_XT(sel0, 2, 0xff00ff00u); SEL_XT(sel0, 4, 0xffff0000u); SEL_XT(sel1, 1, 0xf0f0f0f0u); SEL_XT(sel1, 2, 0xff00ff00u); SEL_XT(sel1, 4, 0xffff0000u); \
        unsigned* mrow = MASK + (size_t)t * 128 + 8 * (lane & 7) + (lane >> 3);        \
        mrow[0] = sel0; mrow[64] = sel1; } while (0)
    if (nrows > 0) { SEL_LOAD(ka, SEL_ROW(0)); SEL_WAIT(ka); }
#pragma unroll 1
    for (int ri = 0; ri < nrows; ri += 2) {
        SEL_BODY(ka, kb, ri);
        if (ri + 1 < nrows) SEL_BODY(kb, ka, ri + 1);
    }
#undef SEL_BODY
#undef SEL_TS
#undef SEL_XT
#undef SW
#undef SEL_ROW
#undef SEL_LOAD
#undef SEL_WAIT
}

template <int DQK, bool MASKED, int AMODE = 0>
__device__ __forceinline__ void attn_unit(LAS unsigned char* ldsb, const bf16_t* Qg, int ldq, const bf16_t* Kg, int ldk, const bf16_t* Vg, int ldv, const unsigned* maskg, bf16_t* Og, int ldo, int qb, float sl2) {
    constexpr int CPR = DQK / 8, KBYTES = 64 * DQK * 2, VBYTES = 64 * 128 * 2, NKI = CPR * 64 / 512, ND = DQK / 16;
    constexpr int STAGE = KBYTES + VBYTES;
    static_assert(NKI + 2 + (MASKED ? 1 : 0) == 5, "five vector-memory operations per thread and tile in both instantiations");
    const int tid = opaque_tid(), lane = tid & 63, wv = __builtin_amdgcn_readfirstlane(tid >> 6), r32 = lane & 31, hi = lane >> 5;
    const int NT = 4 * qb + 4, NT3 = ((NT + 2) / 3) * 3, q0 = qb * 256 + wv * 32;
    const float NEG = -__builtin_inff();
    bf16x8 qr[ND];
#pragma unroll
    for (int d0 = 0; d0 < ND; ++d0) qr[d0] = *(const bf16x8*)(Qg + (size_t)(q0 + r32) * ldq + 16 * d0 + 8 * hi);
    const bf16_t* ksrc[NKI]; const bf16_t* vsrc[2];
#pragma unroll
    for (int i = 0; i < NKI; ++i) { const int g = i * 512 + tid, row = g / CPR, cp = g - row * CPR; const int ch = cp ^ (DQK == 128 ? (row & 15) : ((row >> 1) & 7)); ksrc[i] = Kg + (size_t)row * ldk + ch * 8; }
#pragma unroll
    for (int i = 0; i < 2; ++i) { const int g = i * 512 + tid, row = g >> 4, c16 = g & 15; const int blk = (c16 >> 2) ^ (row & 3); vsrc[i] = Vg + (size_t)row * ldv + (blk * 4 + (c16 & 3)) * 8; }
    const unsigned* mrow = MASKED ? maskg + (size_t)(q0 + r32) * 128 : nullptr;
    u32x2 mw0 = {0u, 0u}, mw1 = {0u, 0u}, mw2 = {0u, 0u};
#define AT_ISSUE(MW, t_, st_) do { const int tt_ = (t_) < NT ? (t_) : NT - 1; \
        if (MASKED) asm volatile("global_load_dwordx2 %0, %1, off" : "=v"(MW) : "v"(mrow + 2 * tt_) : "memory"); \
        _Pragma("unroll") for (int i_ = 0; i_ < NKI; ++i_) __builtin_amdgcn_global_load_lds((const unsigned*)(ksrc[i_] + (size_t)tt_ * 64 * ldk), (LAS unsigned*)(ldsb + (st_) * STAGE + (i_ * 512 + wv * 64) * 16), 16, 0, 0); \
        _Pragma("unroll") for (int i_ = 0; i_ < 2; ++i_) __builtin_amdgcn_global_load_lds((const unsigned*)(vsrc[i_] + (size_t)tt_ * 64 * ldv), (LAS unsigned*)(ldsb + (st_) * STAGE + KBYTES + (i_ * 512 + wv * 64) * 16), 16, 0, 0); } while (0)
#define AT_WAIT(n_) asm volatile("s_waitcnt vmcnt(" #n_ ")" : "+v"(mw0), "+v"(mw1), "+v"(mw2) :: "memory")
    const int ksw = (DQK == 128 ? (r32 & 15) : ((r32 >> 1) & 7)) ^ hi;
    const unsigned krow = (unsigned)(size_t)ldsb + (unsigned)r32 * (DQK * 2);
    const int vq = (lane >> 2) & 3, vp = lane & 3, vg = lane >> 4;
    const unsigned vrow = (unsigned)(size_t)ldsb + KBYTES + (unsigned)(4 * (vg >> 1) + vq) * 256 + (vg & 1) * 32 + vp * 8;
    float m_run = -1e30f, l_run = 0.f; const float mth = 8.f / sl2;
    f32x16 oT[4];
#pragma unroll
    for (int d0 = 0; d0 < 4; ++d0)
#pragma unroll
        for (int r = 0; r < 16; ++r) oT[d0][r] = 0.f;
    AT_ISSUE(mw0, 0, 0); AT_ISSUE(mw1, 1, 1);
    AT_WAIT(5);
    __builtin_amdgcn_s_barrier();
#define TRRD(dst, addr, off) asm volatile("ds_read_b64_tr_b16 %0, %1 offset:%2" : "=&v"(dst) : "v"(addr), "i"(off) : "memory")
#define AT_STEP(t_, st_, MWCUR, MWNEW) do { \
        const int t = (t_); \
        AT_ISSUE(MWNEW, t + 2, ((st_) + 2) % 3);                    \
        if (t * 64 <= q0 + 31) {                                    \
            int kx = ksw; asm volatile("" : "+v"(kx)); \
            f32x16 p0, p1; \
            _Pragma("unroll") for (int r = 0; r < 16; ++r) { p0[r] = 0.f; p1[r] = 0.f; } \
            _Pragma("unroll") for (int d0 = 0; d0 < ND; ++d0) { \
                const unsigned ka = krow + (st_) * STAGE + ((unsigned)((2 * d0) ^ kx) << 4); \
                const bf16x8 a0 = *(const LAS bf16x8*)(size_t)ka; const bf16x8 a1 = *(const LAS bf16x8*)(size_t)(ka + 32 * DQK * 2); \
                if (AMODE != 3) { p0 = __builtin_amdgcn_mfma_f32_32x32x16_bf16(a0, qr[d0], p0, 0, 0, 0); \
                p1 = __builtin_amdgcn_mfma_f32_32x32x16_bf16(a1, qr[d0], p1, 0, 0, 0); } else { asm volatile("" :: "v"(a0), "v"(a1)); } } \
            if (AMODE != 1) { if (MASKED) {                         \
                const int wx_ = (int)(MWCUR.x >> (4 * hi)), wy_ = (int)(MWCUR.y >> (4 * hi)); \
                _Pragma("unroll") for (int r = 0; r < 16; ++r) { const int c = (r & 3) + 8 * (r >> 2); \
                    const unsigned mx_ = (unsigned)__builtin_amdgcn_sbfe(wx_, c, 1), my_ = (unsigned)__builtin_amdgcn_sbfe(wy_, c, 1); \
                    p0[r] = __uint_as_float((__float_as_uint(p0[r]) & mx_) | (0xff800000u & ~mx_)); p1[r] = __uint_as_float((__float_as_uint(p1[r]) & my_) | (0xff800000u & ~my_)); } \
            } else if (t * 64 + 63 > q0) {                          \
                const int dq = q0 + r32 - t * 64 - 4 * hi; \
                _Pragma("unroll") for (int r = 0; r < 16; ++r) { const int c = (r & 3) + 8 * (r >> 2); if (c > dq) p0[r] = NEG; if (c + 32 > dq) p1[r] = NEG; } \
            } \
            float mx = p0[0]; \
            _Pragma("unroll") for (int r = 1; r < 16; ++r) mx = fmaxf(mx, p0[r]); \
            _Pragma("unroll") for (int r = 0; r < 16; ++r) mx = fmaxf(mx, p1[r]); \
            { auto rr = __builtin_amdgcn_permlane32_swap(__float_as_uint(mx), __float_as_uint(mx), false, false); mx = fmaxf(__uint_as_float(rr[0]), __uint_as_float(rr[1])); } \
            const float mnew = (mx > m_run + mth) ? mx : m_run;     \
            const float alpha = __builtin_amdgcn_exp2f((m_run - mnew) * sl2); \
            m_run = mnew; const float mb = -mnew * sl2; \
            float ps = 0.f; \
            _Pragma("unroll") for (int r = 0; r < 16; ++r) { p0[r] = __builtin_amdgcn_exp2f(fmaf(p0[r], sl2, mb)); ps += p0[r]; } \
            _Pragma("unroll") for (int r = 0; r < 16; ++r) { p1[r] = __builtin_amdgcn_exp2f(fmaf(p1[r], sl2, mb)); ps += p1[r]; } \
            l_run = l_run * alpha + ps; \
            if (__any(alpha != 1.f)) { \
                  \
                _Pragma("unroll") for (int d0 = 0; d0 < 4; ++d0) _Pragma("unroll") for (int r = 0; r < 16; ++r) { float ov = oT[d0][r]; asm("v_mul_f32 %0, %1, %0" : "+v"(ov) : "v"(alpha)); oT[d0][r] = ov; } } } \
            bf16x8 pb[4];                                            \
            { u32x4 w; \
              w.x = pkbf(p0[0], p0[1]); w.y = pkbf(p0[2], p0[3]); w.z = pkbf(p0[4], p0[5]); w.w = pkbf(p0[6], p0[7]); pb[0] = *reinterpret_cast<bf16x8*>(&w); \
              w.x = pkbf(p0[8], p0[9]); w.y = pkbf(p0[10], p0[11]); w.z = pkbf(p0[12], p0[13]); w.w = pkbf(p0[14], p0[15]); pb[1] = *reinterpret_cast<bf16x8*>(&w); \
              w.x = pkbf(p1[0], p1[1]); w.y = pkbf(p1[2], p1[3]); w.z = pkbf(p1[4], p1[5]); w.w = pkbf(p1[6], p1[7]); pb[2] = *reinterpret_cast<bf16x8*>(&w); \
              w.x = pkbf(p1[8], p1[9]); w.y = pkbf(p1[10], p1[11]); w.z = pkbf(p1[12], p1[13]); w.w = pkbf(p1[14], p1[15]); pb[3] = *reinterpret_cast<bf16x8*>(&w); } \
            int vx = vq; asm volatile("" : "+v"(vx)); \
            _Pragma("unroll") for (int d0 = 0; d0 < 4; ++d0) { \
                const unsigned va = vrow + (st_) * STAGE + ((unsigned)(d0 ^ vx) << 6); \
                s16x4 l0, h0, l1, h1, l2, h2, l3, h3; \
                TRRD(l0, va, 0); TRRD(h0, va, 2048); TRRD(l1, va, 4096); TRRD(h1, va, 6144); TRRD(l2, va, 8192); TRRD(h2, va, 10240); TRRD(l3, va, 12288); TRRD(h3, va, 14336); \
                asm volatile("s_waitcnt lgkmcnt(0)" ::: "memory"); __builtin_amdgcn_sched_barrier(0); \
                if (AMODE == 2) { asm volatile("" :: "v"(l0), "v"(h0), "v"(l1), "v"(h1), "v"(l2), "v"(h2), "v"(l3), "v"(h3), "v"(pb[0]), "v"(pb[1]), "v"(pb[2]), "v"(pb[3])); continue; } \
                oT[d0] = __builtin_amdgcn_mfma_f32_32x32x16_bf16((bf16x8){l0[0], l0[1], l0[2], l0[3], h0[0], h0[1], h0[2], h0[3]}, pb[0], oT[d0], 0, 0, 0); \
                oT[d0] = __builtin_amdgcn_mfma_f32_32x32x16_bf16((bf16x8){l1[0], l1[1], l1[2], l1[3], h1[0], h1[1], h1[2], h1[3]}, pb[1], oT[d0], 0, 0, 0); \
                oT[d0] = __builtin_amdgcn_mfma_f32_32x32x16_bf16((bf16x8){l2[0], l2[1], l2[2], l2[3], h2[0], h2[1], h2[2], h2[3]}, pb[2], oT[d0], 0, 0, 0); \
                oT[d0] = __builtin_amdgcn_mfma_f32_32x32x16_bf16((bf16x8){l3[0], l3[1], l3[2], l3[3], h3[0], h3[1], h3[2], h3[3]}, pb[3], oT[d0], 0, 0, 0); } \
        } \
        AT_WAIT(5);                                                 \
        asm volatile("s_waitcnt lgkmcnt(0)" ::: "memory"); \
        __builtin_amdgcn_s_barrier(); } while (0)
#pragma unroll 1
    for (int tt = 0; tt < NT3; tt += 3) { AT_STEP(tt, 0, mw0, mw2); AT_STEP(tt + 1, 1, mw1, mw0); AT_STEP(tt + 2, 2, mw2, mw1); }
    AT_WAIT(0);
    __builtin_amdgcn_s_barrier();
#undef AT_STEP
#undef AT_ISSUE
#undef AT_WAIT
#undef TRRD
    { auto rr = __builtin_amdgcn_permlane32_swap(__float_as_uint(l_run), __float_as_uint(l_run), false, false); l_run = __uint_as_float(rr[0]) + __uint_as_float(rr[1]); }
    const float inv = 1.f / l_run;
    bf16_t* orow = Og + (size_t)(q0 + r32) * ldo + 4 * hi;
#pragma unroll
    for (int d0 = 0; d0 < 4; ++d0)
#pragma unroll
        for (int rq = 0; rq < 4; ++rq) { u32x2 w; w.x = pkbf(oT[d0][4 * rq] * inv, oT[d0][4 * rq + 1] * inv); w.y = pkbf(oT[d0][4 * rq + 2] * inv, oT[d0][4 * rq + 3] * inv);
            *(u32x2*)(orow + 32 * d0 + 8 * rq) = w; }
}
template <int AMODE>
__device__ __forceinline__ void p_attn(LAS unsigned char* ldsb, unsigned char* ws) {
    const bf16_t* QA = (const bf16_t*)(ws + WS_QA); const bf16_t* KA = (const bf16_t*)(ws + WS_KA); const bf16_t* VA = (const bf16_t*)(ws + WS_VA); bf16_t* OA = (bf16_t*)(ws + WS_OA);
    const bf16_t* QB = (const bf16_t*)(ws + WS_QB); const bf16_t* KB = (const bf16_t*)(ws + WS_KB); const bf16_t* VB = (const bf16_t*)(ws + WS_VB); bf16_t* OB = (bf16_t*)(ws + WS_OB);
    const unsigned* MASK = (const unsigned*)(ws + WS_MASK);
    for (int w = opaque_bid(); w < 256; w += gridDim.x) {
        const int bh = (w & 7) * 2 + ((w >> 3) & 1), i = w >> 4, b = bh >> 3, h = bh & 7;
        const size_t r0 = (size_t)b * S;
        attn_unit<192, false, AMODE>(ldsb, QA + r0 * 1536 + h * 192, 1536, KA + r0 * 1536 + h * 192, 1536, VA + r0 * 1024 + h * 128, 1024, nullptr, OA + r0 * 1024 + h * 128, 1024, i, 0.07216878364870322f * 1.4426950408889634f);
        attn_unit<128, true, AMODE>(ldsb, QB + r0 * 1024 + h * 128, 1024, KB + r0 * 1024 + h * 128, 1024, VB + r0 * 1024 + h * 128, 1024, MASK + r0 * 128, OB + r0 * 1024 + h * 128, 1024, 15 - i, 0.08838834764831845f * 1.4426950408889634f);
    }
}

__device__ __forceinline__ void moe_tables256(int* tab, const unsigned* cnt, int ncol_tiles) {
    const int tid_ = opaque_tid();
    if (tid_ == 0) { int a = 0, bsum = 0; for (int e = 0; e < 64; ++e) { tab[e] = a; tab[80 + e] = bsum; const int c = (int)cnt[e], nrb = (c + MOE_RBLK - 1) / MOE_RBLK; tab[160 + e] = nrb; a += nrb * ncol_tiles; bsum += nrb * MOE_RBLK; } tab[64] = a; tab[80 + 64] = bsum; }
    if (tid_ >= 64 && tid_ < 128) {
        const int e = tid_ - 64; const unsigned c = cnt[e]; int rank = 0;
        for (int o = 0; o < 64; ++o) { const unsigned co = cnt[o]; rank += (co > c || (co == c && o < e)) ? 1 : 0; }
        tab[240 + rank] = e; }
    __syncthreads();
}
template <int RMODE>
__device__ __forceinline__ void p_ln1_route3(LAS unsigned char* ldsb, unsigned char* ws, const float* g, const float* bb, int l) {
    const float* V1 = (const float*)(ws + WS_V1); bf16_t* H1B = (bf16_t*)(ws + WS_H1B); float* STATS = (float*)(ws + WS_STATS);
    const float* sec = (const float*)(ws + WS_SEC) + l * 160;
    unsigned* cnt = (unsigned*)(ws + WS_CNT) + l * 64; int* LIST = (int*)(ws + WS_LIST);
    int* TOKE = (int*)(ws + WS_TOKE); float* TOKW = (float*)(ws + WS_TOKW); int* TOKS = (int*)(ws + WS_TOKS);
    const int tid = opaque_tid(), lane = tid & 63, wv = __builtin_amdgcn_readfirstlane(tid >> 6);
    LAS float* red = (LAS float*)ldsb;
    LAS float* stl = red + 8 * 32 * 96;
    for (int unit = opaque_bid(); unit < T / 32; unit += gridDim.x) {
        const int t0 = unit * 32;
        if (RMODE != 2) {
            const size_t ro = (size_t)(t0 + 4 * wv) * D + 4 * lane;
            f32x4 v[4][8]; float s1[4], s2[4], mean[4], rstd[4];
#pragma unroll
            for (int i = 0; i < 4; ++i)
#pragma unroll
                for (int j = 0; j < 8; ++j) v[i][j] = *(const f32x4*)(V1 + ro + (size_t)i * D + 256 * j);
#pragma unroll
            for (int i = 0; i < 4; ++i) { s1[i] = 0.f;
#pragma unroll
                for (int j = 0; j < 8; ++j) s1[i] += (v[i][j][0] + v[i][j][1]) + (v[i][j][2] + v[i][j][3]); }
#pragma unroll
            for (int o = 32; o >= 1; o >>= 1) { s1[0] += __shfl_xor(s1[0], o); s1[1] += __shfl_xor(s1[1], o); s1[2] += __shfl_xor(s1[2], o); s1[3] += __shfl_xor(s1[3], o); }
#pragma unroll
            for (int i = 0; i < 4; ++i) { mean[i] = s1[i] * (1.f / D); s2[i] = 0.f;
#pragma unroll
                for (int j = 0; j < 8; ++j) { v[i][j] = v[i][j] - mean[i]; s2[i] += (v[i][j][0] * v[i][j][0] + v[i][j][1] * v[i][j][1]) + (v[i][j][2] * v[i][j][2] + v[i][j][3] * v[i][j][3]); } }
#pragma unroll
            for (int o = 32; o >= 1; o >>= 1) { s2[0] += __shfl_xor(s2[0], o); s2[1] += __shfl_xor(s2[1], o); s2[2] += __shfl_xor(s2[2], o); s2[3] += __shfl_xor(s2[3], o); }
#pragma unroll
            for (int i = 0; i < 4; ++i) { rstd[i] = rsqrtf(s2[i] * (1.f / D) + 1e-5f);
                if (lane == 0) { stl[(4 * wv + i) * 2] = mean[i]; stl[(4 * wv + i) * 2 + 1] = rstd[i]; STATS[(size_t)(t0 + 4 * wv + i) * 2] = mean[i]; STATS[(size_t)(t0 + 4 * wv + i) * 2 + 1] = rstd[i]; } }
            f32x4 gg[8], b4[8];
#pragma unroll
            for (int j = 0; j < 8; ++j) { gg[j] = *(const f32x4*)(g + 4 * lane + 256 * j); b4[j] = *(const f32x4*)(bb + 4 * lane + 256 * j); }
#pragma unroll
            for (int j = 0; j < 8; ++j)
#pragma unroll
                for (int i = 0; i < 4; ++i) st4bf(H1B + ro + (size_t)i * D + 256 * j, v[i][j] * rstd[i] * gg[j] + b4[j]);
        }
        if (RMODE != 1) {
            f32x16 c0, c1, c2;
#pragma unroll
            for (int r = 0; r < 16; ++r) { c0[r] = 0.f; c1[r] = 0.f; c2[r] = 0.f; }
            const int j = lane & 31, kh = lane >> 5, kb = 256 * wv + 8 * kh;
            const float* hp = V1 + (size_t)(t0 + j) * D + kb;
            const bf16_t* wh = (const bf16_t*)(ws + WS_RWH) + (size_t)l * (96 * D) + (size_t)wv * (16 * 1536) + (kh * 32 + j) * 8;
            const bf16_t* wl = (const bf16_t*)(ws + WS_RWL) + (size_t)l * (96 * D) + (size_t)wv * (16 * 1536) + (kh * 32 + j) * 8;
            f32x4 xa0, xa1, xb0, xb1; bf16x8 ha0, ha1, ha2, la0, la1, la2, hb0, hb1, hb2, lb0, lb1, lb2;
#define RT_LOAD(X0, X1, H0, H1, H2, L0, L1, L2, st_) do { const float* px_ = hp + 16 * (st_); const bf16_t* ph_ = wh + 1536 * (st_); const bf16_t* pl_ = wl + 1536 * (st_); \
                asm volatile("global_load_dwordx4 %0, %1, off" : "=v"(X0) : "v"(px_) : "memory"); asm volatile("global_load_dwordx4 %0, %1, off offset:16" : "=v"(X1) : "v"(px_) : "memory"); \
                asm volatile("global_load_dwordx4 %0, %1, off" : "=v"(H0) : "v"(ph_) : "memory"); asm volatile("global_load_dwordx4 %0, %1, off offset:1024" : "=v"(H1) : "v"(ph_) : "memory"); \
                asm volatile("global_load_dwordx4 %0, %1, off offset:2048" : "=v"(H2) : "v"(ph_) : "memory"); \
                asm volatile("global_load_dwordx4 %0, %1, off" : "=v"(L0) : "v"(pl_) : "memory"); asm volatile("global_load_dwordx4 %0, %1, off offset:1024" : "=v"(L1) : "v"(pl_) : "memory"); \
                asm volatile("global_load_dwordx4 %0, %1, off offset:2048" : "=v"(L2) : "v"(pl_) : "memory"); } while (0)
#define RT_WAIT(n_) asm volatile("s_waitcnt vmcnt(" #n_ ")" : "+v"(xa0), "+v"(xa1), "+v"(ha0), "+v"(ha1), "+v"(ha2), "+v"(la0), "+v"(la1), "+v"(la2), "+v"(xb0), "+v"(xb1), "+v"(hb0), "+v"(hb1), "+v"(hb2), "+v"(lb0), "+v"(lb1), "+v"(lb2) :: "memory")
#define RT_STEP(x0, x1, bh0, bh1, bh2, bl0, bl1, bl2) do { \
                u32x4 hw; hw.x = pkbf(x0[0], x0[1]); hw.y = pkbf(x0[2], x0[3]); hw.z = pkbf(x1[0], x1[1]); hw.w = pkbf(x1[2], x1[3]); \
                u32x4 lw; lw.x = pkbf(x0[0] - __uint_as_float(hw.x << 16), x0[1] - __uint_as_float(hw.x & 0xffff0000u)); lw.y = pkbf(x0[2] - __uint_as_float(hw.y << 16), x0[3] - __uint_as_float(hw.y & 0xffff0000u)); \
                lw.z = pkbf(x1[0] - __uint_as_float(hw.z << 16), x1[1] - __uint_as_float(hw.z & 0xffff0000u)); lw.w = pkbf(x1[2] - __uint_as_float(hw.w << 16), x1[3] - __uint_as_float(hw.w & 0xffff0000u)); \
                const bf16x8 ah = *reinterpret_cast<bf16x8*>(&hw), al = *reinterpret_cast<bf16x8*>(&lw); \
                c0 = __builtin_amdgcn_mfma_f32_32x32x16_bf16(ah, bh0, c0, 0, 0, 0); c1 = __builtin_amdgcn_mfma_f32_32x32x16_bf16(ah, bh1, c1, 0, 0, 0); c2 = __builtin_amdgcn_mfma_f32_32x32x16_bf16(ah, bh2, c2, 0, 0, 0); \
                c0 = __builtin_amdgcn_mfma_f32_32x32x16_bf16(ah, bl0, c0, 0, 0, 0); c1 = __builtin_amdgcn_mfma_f32_32x32x16_bf16(ah, bl1, c1, 0, 0, 0); c2 = __builtin_amdgcn_mfma_f32_32x32x16_bf16(ah, bl2, c2, 0, 0, 0); \
                c0 = __builtin_amdgcn_mfma_f32_32x32x16_bf16(al, bh0, c0, 0, 0, 0); c1 = __builtin_amdgcn_mfma_f32_32x32x16_bf16(al, bh1, c1, 0, 0, 0); c2 = __builtin_amdgcn_mfma_f32_32x32x16_bf16(al, bh2, c2, 0, 0, 0); } while (0)
            RT_LOAD(xa0, xa1, ha0, ha1, ha2, la0, la1, la2, 0);
#pragma unroll 1
            for (int st = 0; st < 16; st += 2) {
                RT_LOAD(xb0, xb1, hb0, hb1, hb2, lb0, lb1, lb2, st + 1);
                RT_WAIT(8);
                RT_STEP(xa0, xa1, ha0, ha1, ha2, la0, la1, la2);
                RT_LOAD(xa0, xa1, ha0, ha1, ha2, la0, la1, la2, (st + 2) & 15);
                RT_WAIT(8);
                RT_STEP(xb0, xb1, hb0, hb1, hb2, lb0, lb1, lb2);
            }
            RT_WAIT(0);
#undef RT_LOAD
#undef RT_WAIT
#undef RT_STEP
#pragma unroll
            for (int r = 0; r < 16; ++r) { const int tr = (r & 3) + 8 * (r >> 2) + 4 * kh; LAS float* o = red + (wv * 32 + tr) * 96 + j; o[0] = c0[r]; o[32] = c1[r]; o[64] = c2[r]; }
        }
        __syncthreads();
        for (int idx = tid; idx < 32 * 72; idx += NTHREADS) { const int tk = idx / 72, c = idx - tk * 72;
            float sacc = 0.f;
#pragma unroll
            for (int w = 0; w < 8; ++w) sacc += red[(w * 32 + tk) * 96 + c];
            red[tk * 96 + c] = stl[tk * 2 + 1] * (sacc - stl[tk * 2] * sec[c]) + sec[80 + c]; }
        __syncthreads();
        if (RMODE == 0 && tid < 32) {
            const int t = t0 + tid; const LAS float* lg = red + tid * 96;
            float gl[8]; float gmax = -__builtin_inff(); int gi = 0;
#pragma unroll
            for (int i = 0; i < 8; ++i) { gl[i] = lg[64 + i]; if (gl[i] > gmax) { gmax = gl[i]; gi = i; } }
            float gs = 0.f;
#pragma unroll
            for (int i = 0; i < 8; ++i) gs += __expf(gl[i] - gmax);
            const float gp = 1.f / gs;
            float el[8]; float emax = -__builtin_inff(); int e1 = 0;
#pragma unroll
            for (int i = 0; i < 8; ++i) { el[i] = lg[gi * 8 + i]; if (el[i] > emax) { emax = el[i]; e1 = i; } }
            float e2max = -__builtin_inff(); int e2 = 0;
#pragma unroll
            for (int i = 0; i < 8; ++i) { if (i != e1 && el[i] > e2max) { e2max = el[i]; e2 = i; } }
            const float p2 = __expf(e2max - emax);
            const float wa = gp / (1.f + p2), wb = gp * p2 / (1.f + p2);
            const int ea = gi * 8 + e1, eb = gi * 8 + e2;
            const int sa = (int)atomicAdd(cnt + ea, 1u), sb = (int)atomicAdd(cnt + eb, 1u);
            LIST[(size_t)ea * ECAP + sa] = t; LIST[(size_t)eb * ECAP + sb] = t;
            TOKE[t * 2] = ea; TOKE[t * 2 + 1] = eb; TOKW[t * 2] = wa; TOKW[t * 2 + 1] = wb; TOKS[t * 2] = sa; TOKS[t * 2 + 1] = sb;
        }
        __syncthreads();
    }
}
__device__ __forceinline__ void p_ln2v2(LAS unsigned char* ldsb, unsigned char* ws, const float* g1, const float* b1, const float* g, const float* bb, float* outF, int l) {
    const unsigned* cnt = (const unsigned*)(ws + WS_CNT) + l * 64;
    const bf16_t* H1B = (const bf16_t*)(ws + WS_H1B); const bf16_t* YE = (const bf16_t*)(ws + WS_YE);
    const int* TOKE = (const int*)(ws + WS_TOKE); const float* TOKW = (const float*)(ws + WS_TOKW); const int* TOKS = (const int*)(ws + WS_TOKS);
    bf16_t* XB = (bf16_t*)(ws + WS_XB);
    int* tab = (int*)(unsigned char*)ldsb;
    __syncthreads();
    moe_tables256(tab, cnt, 1);
    const int tid = opaque_tid(), lane = tid & 63, wv = tid >> 6;
    const int tstride = gridDim.x * 8;
#define LN2_META(t_, R0, R1, W0, W1) do { const int tt_ = (t_) < T ? (t_) : T - 1; R0 = tab[80 + TOKE[tt_ * 2]] + TOKS[tt_ * 2]; R1 = tab[80 + TOKE[tt_ * 2 + 1]] + TOKS[tt_ * 2 + 1]; W0 = TOKW[tt_ * 2]; W1 = TOKW[tt_ * 2 + 1]; } while (0)
#define LN2_ROWS(t_, R0, R1, HH, Y0, Y1) do { const int tt_ = (t_) < T ? (t_) : T - 1; \
        _Pragma("unroll") for (int j = 0; j < 8; ++j) { HH[j] = *(const u32x2*)(H1B + (size_t)tt_ * D + 4 * lane + 256 * j); Y0[j] = *(const u32x2*)(YE + (size_t)(R0) * D + 4 * lane + 256 * j); Y1[j] = *(const u32x2*)(YE + (size_t)(R1) * D + 4 * lane + 256 * j); } } while (0)
#define LN2_TOKEN(t_, HH, Y0, Y1, W0, W1) do { if ((t_) < T) { const size_t ro = (size_t)(t_) * D + 4 * lane; f32x4 v[8]; float s1 = 0.f; \
        _Pragma("unroll") for (int j = 0; j < 8; ++j) { v[j] = bf4(HH[j]) * ALPHA + bf4(Y0[j]) * (W0) + bf4(Y1[j]) * (W1); s1 += (v[j][0] + v[j][1]) + (v[j][2] + v[j][3]); } \
        const float mean = wave_sum(s1) * (1.f / D); float s2 = 0.f; \
        _Pragma("unroll") for (int j = 0; j < 8; ++j) { v[j] = v[j] - mean; s2 += (v[j][0] * v[j][0] + v[j][1] * v[j][1]) + (v[j][2] * v[j][2] + v[j][3] * v[j][3]); } \
        const float rstd = rsqrtf(wave_sum(s2) * (1.f / D) + 1e-5f); \
        _Pragma("unroll") for (int j = 0; j < 8; ++j) { const f32x4 o = v[j] * rstd * gg[j] + b4[j]; \
            *(f32x4*)(outF + ro + 256 * j) = o; if (l != DEPTH - 1) st4bf(XB + ro + 256 * j, o); } } } while (0)
    int t = opaque_bid() * 8 + wv;
    f32x4 gg[8], b4[8];
#pragma unroll
    for (int j = 0; j < 8; ++j) { gg[j] = *(const f32x4*)(g + 4 * lane + 256 * j); b4[j] = *(const f32x4*)(bb + 4 * lane + 256 * j); }
    int ra0, ra1, rb0, rb1; float wa0, wa1, wb0, wb1;
    LN2_META(t, ra0, ra1, wa0, wa1); LN2_META(t + tstride, rb0, rb1, wb0, wb1);
    for (; t < T; t += 2 * tstride) {
        u32x2 ha[8], ya0[8], ya1[8], hb[8], yb0[8], yb1[8];
        LN2_ROWS(t, ra0, ra1, ha, ya0, ya1); LN2_ROWS(t + tstride, rb0, rb1, hb, yb0, yb1);
        int na0, na1, nb0, nb1; float nwa0, nwa1, nwb0, nwb1;
        LN2_META(t + 2 * tstride, na0, na1, nwa0, nwa1); LN2_META(t + 3 * tstride, nb0, nb1, nwb0, nwb1);
        LN2_TOKEN(t, ha, ya0, ya1, wa0, wa1);
        LN2_TOKEN(t + tstride, hb, yb0, yb1, wb0, wb1);
        ra0 = na0; ra1 = na1; rb0 = nb0; rb1 = nb1; wa0 = nwa0; wa1 = nwa1; wb0 = nwb0; wb1 = nwb1;
    }
#undef LN2_META
#undef LN2_ROWS
#undef LN2_TOKEN
    __syncthreads();
}

template <bool GATED, int PMODE = 0>
__device__ __forceinline__ void moe_gemm(LAS unsigned char* ldsb, const int* tab, const unsigned* cnt, const int* LIST, const bf16_t* Asrc, const float* W0, const float* W1, bf16_t* Out) {
    constexpr int K = GATED ? D : FE, NT = K / 32, NCT = GATED ? FE / 64 : D / 128, LDW = GATED ? FE : D, LDO = GATED ? FE : D;
    constexpr int RBLK = MOE_RBLK, MT = RBLK / 64, NAG = RBLK / 64;
    static_assert(RBLK % 64 == 0 && (NAG == 6 || NAG == 5 || NAG == 3), "the counted waits below are written for 6, 5 or 3 A granules per thread");
    constexpr int ASLOT = RBLK * 128, BOFF = 2 * ASLOT, BBYTES = 32 * 256;
    const int tid = opaque_tid(), lane = tid & 63, wv = __builtin_amdgcn_readfirstlane(tid >> 6), wm = wv >> 1, wn = wv & 1, l15 = lane & 15, kq = lane >> 4;
    const unsigned lbase = (unsigned)(size_t)ldsb;
    const int arow = wm * (16 * MT) + l15;
    const unsigned afr = lbase + (unsigned)arow * 128u; const int asw = ((arow >> 1) & 7) ^ kq;
    const unsigned afa0 = afr + ((unsigned)(0 ^ asw) << 4), afa1 = afr + ((unsigned)(4 ^ asw) << 4);
    const int bq = (lane >> 2) & 3, bp = lane & 3, bkey = bq | ((kq & 1) << 2);
    const unsigned bfr = lbase + BOFF + (unsigned)(8 * kq + bq) * 256u + 8u * bp;
    unsigned bb[4];
#pragma unroll
    for (int j = 0; j < 4; ++j) { const int np = GATED ? ((j >> 1) * 4 + 2 * wn + (j & 1)) : (4 * wn + j); bb[j] = bfr + ((unsigned)(np ^ bkey) << 5); }
    const int sa_r = tid >> 3, sa_p = tid & 7;
    const int sb_k = tid >> 5, sb_n = 4 * (tid & 31);
    const int G = gridDim.x;
    const int NI = 64 * NCT;
#define MG_DECODE(i0_, e_, ct_) do { const int rnd = (i0_) / G, pos = (i0_) - rnd * G; int rank; \
      if ((G & 7) == 0 && ((G >> 3) % NCT) == 0 && (64 * NCT) % G == 0) { const int x = pos & 7, j = pos >> 3, epx = (G >> 3) / NCT;         \
          rank = rnd * (G / NCT) + x * epx + j / NCT; ct_ = j % NCT; if (rnd & 1) rank = rnd * (G / NCT) + (G / NCT - 1) - (x * epx + j / NCT); } \
      else { rank = (i0_) / NCT; ct_ = (i0_) % NCT; } \
      e_ = tab[240 + rank]; } while (0)
#define MG_AOFF(AO, e_, rb_, ce_, base_) do { _Pragma("unroll") for (int i = 0; i < NAG; ++i) { const int rl = i * 64 + sa_r, r = (rb_) * RBLK + rl; const int ch = sa_p ^ ((rl >> 1) & 7); \
            if (GATED) { const int rc_ = r < (ce_) ? r : ((ce_) > 0 ? (ce_) - 1 : 0); const int tok = LIST[(size_t)(e_) * ECAP + rc_] & (T - 1);     \
                AO[i] = (unsigned)tok * (unsigned)(K * 2) + ch * 16; } \
            else AO[i] = (unsigned)((base_) + r) * (unsigned)(K * 2) + ch * 16; } } while (0)
#define MG_WP(e_, ct_) ((GATED ? (sb_n < 64 ? W0 : W1) : W0) + (size_t)(e_) * K * LDW + (size_t)sb_k * LDW + (GATED ? (ct_) * 64 + (sb_n & 63) : (ct_) * 128 + sb_n))
#define MG_TROT(e_, ct_) ((((e_) * 5 + (ct_) * 9) & (NT - 1)) & ~1)
    int i0 = opaque_bid();
    if (i0 < NI) {
      int e, ct; MG_DECODE(i0, e, ct);
      int ce = (int)cnt[e], base = tab[80 + e], nrb = tab[160 + e] > 0 ? tab[160 + e] : 1, rb = 0;
      unsigned aoff[NAG], aoffn[NAG];
      MG_AOFF(aoff, e, rb, ce, base);
      const float* wp = MG_WP(e, ct); int trot = MG_TROT(e, ct);
      const float* wpn = wp; int trotn = trot;
      f32x4 rq0[2], rq1[2], rq2[2], rq3[2];
#define MG_ISSUE_A(t_, slot_) do { const bool nx_ = (t_) >= NT; const int ta_ = ((((nx_ ? (t_) - NT : (t_))) + (nx_ ? trotn : trot)) & (NT - 1)) >> 1;        \
            _Pragma("unroll") for (int i = 0; i < NAG; ++i) __builtin_amdgcn_global_load_lds((const unsigned*)((const unsigned char*)Asrc + (nx_ ? aoffn[i] : aoff[i]) + (PMODE == 1 ? 0 : ta_ * 128)), (LAS unsigned*)(ldsb + (slot_) * ASLOT + (i * 512 + wv * 64) * 16), 16, 0, 0); } while (0)
#define MG_ISSUE_B(RB, t_) do { const bool nx_ = (t_) >= NT; const int tb_ = ((nx_ ? (t_) - NT : (t_)) + (nx_ ? trotn : trot)) & (NT - 1); const float* wq_ = nx_ ? wpn : wp; \
            _Pragma("unroll") for (int i = 0; i < 2; ++i) asm volatile("global_load_dwordx4 %0, %1, off nt" : "=v"(RB[i]) : "v"(wq_ + (size_t)((PMODE == 2 ? 0 : tb_ * 32) + 16 * i) * LDW) : "memory"); } while (0)
#define MG_WAIT_ALL(n_) asm volatile("s_waitcnt vmcnt(" #n_ ")" : "+v"(rq0[0]), "+v"(rq0[1]), "+v"(rq1[0]), "+v"(rq1[1]), "+v"(rq2[0]), "+v"(rq2[1]), "+v"(rq3[0]), "+v"(rq3[1]) :: "memory")
#define MG_WRITE_B(RB, buf_) do { _Pragma("unroll") for (int i = 0; i < 2; ++i) { const int k = sb_k + 16 * i; u32x2 w; w.x = pkbf(RB[i][0], RB[i][1]); w.y = pkbf(RB[i][2], RB[i][3]); \
            *(LAS u32x2*)(ldsb + BOFF + (buf_) * BBYTES + k * 256 + ((((sb_n >> 4) ^ ((k & 3) | (((k >> 3) & 1) << 2)))) << 5) + (sb_n & 15) * 2) = w; } } while (0)
#define TRRD(dst, addr, off) asm volatile("ds_read_b64_tr_b16 %0, %1 offset:%2" : "=&v"(dst) : "v"(addr), "i"(off) : "memory")
#define ARD(dst, addr, off) asm volatile("ds_read_b128 %0, %1 offset:%2" : "=&v"(dst) : "v"(addr), "i"(off) : "memory")
#define MG_COMPUTE(slot_, half_, buf_) do { if (PMODE != 0) break; \
            s16x4 b0l, b0h, b1l, b1h, b2l, b2h, b3l, b3h; \
            TRRD(b0l, bb[0], (buf_) * BBYTES); TRRD(b0h, bb[0], (buf_) * BBYTES + 1024); TRRD(b1l, bb[1], (buf_) * BBYTES); TRRD(b1h, bb[1], (buf_) * BBYTES + 1024); \
            TRRD(b2l, bb[2], (buf_) * BBYTES); TRRD(b2h, bb[2], (buf_) * BBYTES + 1024); TRRD(b3l, bb[3], (buf_) * BBYTES); TRRD(b3h, bb[3], (buf_) * BBYTES + 1024); \
              \
            bf16x8 af[MT]; { const unsigned ad_ = (half_) ? afa1 : afa0; \
              ARD(af[0], ad_, (slot_) * ASLOT + 0 * 2048); ARD(af[1], ad_, (slot_) * ASLOT + 1 * 2048); ARD(af[2], ad_, (slot_) * ASLOT + 2 * 2048); \
              if constexpr (MT > 3) { ARD(af[3 % MT], ad_, (slot_) * ASLOT + 3 * 2048); ARD(af[4 % MT], ad_, (slot_) * ASLOT + 4 * 2048); } \
              if constexpr (MT > 5) { ARD(af[5 % MT], ad_, (slot_) * ASLOT + 5 * 2048); } } \
            asm volatile("s_waitcnt lgkmcnt(0)" ::: "memory"); __builtin_amdgcn_sched_barrier(0); \
            const bf16x8 bf0 = {b0l[0], b0l[1], b0l[2], b0l[3], b0h[0], b0h[1], b0h[2], b0h[3]}, bf1 = {b1l[0], b1l[1], b1l[2], b1l[3], b1h[0], b1h[1], b1h[2], b1h[3]}; \
            const bf16x8 bf2 = {b2l[0], b2l[1], b2l[2], b2l[3], b2h[0], b2h[1], b2h[2], b2h[3]}, bf3 = {b3l[0], b3l[1], b3l[2], b3l[3], b3h[0], b3h[1], b3h[2], b3h[3]}; \
            _Pragma("unroll") for (int m = 0; m < MT; ++m) if (m < mlim) { \
                acc[m][0] = __builtin_amdgcn_mfma_f32_16x16x32_bf16(af[m], bf0, acc[m][0], 0, 0, 0); acc[m][1] = __builtin_amdgcn_mfma_f32_16x16x32_bf16(af[m], bf1, acc[m][1], 0, 0, 0); \
                acc[m][2] = __builtin_amdgcn_mfma_f32_16x16x32_bf16(af[m], bf2, acc[m][2], 0, 0, 0); acc[m][3] = __builtin_amdgcn_mfma_f32_16x16x32_bf16(af[m], bf3, acc[m][3], 0, 0, 0); } } while (0)
#define MG_STEP_EVEN(t_, s0_, RBNEW, RBNEXT) do { \
            MG_ISSUE_A((t_) + 2, (((s0_) >> 1) + 1) & 1); MG_ISSUE_B(RBNEW, (t_) + 3); \
            MG_COMPUTE(((s0_) >> 1) & 1, 0, (s0_) & 1); \
            if constexpr (NAG == 6) MG_WAIT_ALL(10); else if constexpr (NAG == 5) MG_WAIT_ALL(9); else MG_WAIT_ALL(7); \
            MG_WRITE_B(RBNEXT, ((s0_) + 1) & 1); \
            asm volatile("s_waitcnt lgkmcnt(0)" ::: "memory"); \
            __builtin_amdgcn_s_barrier(); } while (0)
#define MG_STEP_ODD(t_, s0_, RBNEW, RBNEXT) do { \
            MG_ISSUE_B(RBNEW, (t_) + 3); \
            MG_COMPUTE(((s0_) >> 1) & 1, 1, (s0_) & 1); \
            MG_WAIT_ALL(4); \
            MG_WRITE_B(RBNEXT, ((s0_) + 1) & 1); \
            asm volatile("s_waitcnt lgkmcnt(0)" ::: "memory"); \
            __builtin_amdgcn_s_barrier(); } while (0)
      asm volatile("s_waitcnt lgkmcnt(0)" ::: "memory");
      __builtin_amdgcn_s_barrier();
      MG_ISSUE_A(0, 0); MG_ISSUE_B(rq0, 0); MG_ISSUE_B(rq1, 1); MG_ISSUE_B(rq2, 2);
      MG_WAIT_ALL(4);
      MG_WRITE_B(rq0, 0);
      asm volatile("s_waitcnt lgkmcnt(0)" ::: "memory");
      __builtin_amdgcn_s_barrier();
#pragma unroll 1
      for (;;) {
        int en = e, ctn = ct, cen = ce, basen = base, nrbn = nrb, rbn = rb, i0n = i0; bool last = false;
        if (rb + 1 < nrb) rbn = rb + 1;
        else if (i0 + G < NI) { i0n = i0 + G; MG_DECODE(i0n, en, ctn); cen = (int)cnt[en]; basen = tab[80 + en]; nrbn = tab[160 + en] > 0 ? tab[160 + en] : 1; rbn = 0; }
        else last = true;
        MG_AOFF(aoffn, en, rbn, cen, basen);
        wpn = MG_WP(en, ctn); trotn = MG_TROT(en, ctn);
#pragma unroll
        for (int i = 0; i < NAG; ++i) asm volatile("" : "+v"(aoffn[i]));
        int mlim = (ce - rb * RBLK - wm * (16 * MT) + 15) >> 4; mlim = mlim < 0 ? 0 : (mlim > MT ? MT : mlim); mlim = __builtin_amdgcn_readfirstlane(mlim);
        f32x4 acc[MT][4];
#pragma unroll
        for (int m = 0; m < MT; ++m)
#pragma unroll
            for (int n = 0; n < 4; ++n) acc[m][n] = (f32x4){0.f, 0.f, 0.f, 0.f};
#pragma unroll 1
        for (int t = 0; t < NT; t += 4) {
            MG_STEP_EVEN(t, 0, rq3, rq1); MG_STEP_ODD(t + 1, 1, rq0, rq2); MG_STEP_EVEN(t + 2, 2, rq1, rq3); MG_STEP_ODD(t + 3, 3, rq2, rq0);
        }
#pragma unroll
        for (int m = 0; m < MT; ++m)
#pragma unroll
            for (int g = 0; g < 4; ++g) {
                const int r = rb * RBLK + wm * (16 * MT) + 16 * m + 4 * kq + g;
                if (r < ce) {
                    if (GATED) {
#pragma unroll
                        for (int j = 0; j < 2; ++j) { const float gv = acc[m][j][g], uv = acc[m][2 + j][g];
                            Out[(size_t)(base + r) * LDO + ct * 64 + 32 * wn + 16 * j + l15] = f2bf(gv / (1.f + __expf(-gv)) * uv); }
                    } else {
#pragma unroll
                        for (int n = 0; n < 4; ++n) Out[(size_t)(base + r) * LDO + ct * 128 + 64 * wn + 16 * n + l15] = f2bf(acc[m][n][g]);
                    }
                }
            }
        if (last) break;
        e = en; ct = ctn; ce = cen; base = basen; nrb = nrbn; rb = rbn; i0 = i0n; wp = wpn; trot = trotn;
#pragma unroll
        for (int i = 0; i < NAG; ++i) aoff[i] = aoffn[i];
      }
      MG_WAIT_ALL(0);
#undef MG_STEP_EVEN
#undef MG_STEP_ODD
#undef MG_ISSUE_A
#undef MG_ISSUE_B
#undef MG_WAIT_ALL
#undef MG_WRITE_B
#undef MG_COMPUTE
#undef ARD
#undef TRRD
    }
#undef MG_DECODE
#undef MG_AOFF
#undef MG_WP
#undef MG_TROT
    __syncthreads();
}
template <int PMODE>
__device__ __forceinline__ void p_moe1_mfma(LAS unsigned char* ldsb, unsigned char* ws, const float* w_eg, const float* w_eu, int l, int lc) {
    const unsigned* cnt = (const unsigned*)(ws + WS_CNT) + lc * 64;
    int* tab = (int*)((unsigned char*)ldsb + 120 * 1024);
    __syncthreads();
    moe_tables256(tab, cnt, FE / 64);
    moe_gemm<true, PMODE>(ldsb, tab, cnt, (const int*)(ws + WS_LIST), (const bf16_t*)(ws + WS_H1B), w_eg + (size_t)l * NE * D * FE, w_eu + (size_t)l * NE * D * FE, (bf16_t*)(ws + WS_HID));
}
__device__ __forceinline__ void p_moe2_mfma(LAS unsigned char* ldsb, unsigned char* ws, const float* w_ed, int l) {
    const unsigned* cnt = (const unsigned*)(ws + WS_CNT) + l * 64;
    int* tab = (int*)((unsigned char*)ldsb + 120 * 1024);
    __syncthreads();
    moe_tables256(tab, cnt, D / 128);
    moe_gemm<false>(ldsb, tab, cnt, nullptr, (const bf16_t*)(ws + WS_HID), w_ed + (size_t)l * NE * FE * D, nullptr, (bf16_t*)(ws + WS_YE));
}

constexpr int NPH = 10;
#ifndef PH_MASK
#define PH_MASK 0x7ff
#endif
#define PHON(k) ((PH_MASK >> (k)) & 1)
#ifndef REP_PHASE
#define REP_PHASE -1
#endif
#ifndef STAMP_A
#define STAMP_A -1
#define STAMP_B -1
#endif
#define REPS(k) for (int rep_ = 0; rep_ < ((REP_PHASE == (k)) ? 2 : 1); ++rep_)
template <class Tp> __device__ __forceinline__ Tp* as_global(Tp* p) {
    __attribute__((address_space(1))) Tp* g = (__attribute__((address_space(1))) Tp*)p; asm volatile("" : "+s"(g)); return (Tp*)g; }
typedef const Params __attribute__((address_space(4))) CParams;
#define KP(field) ({ CParams* _k = kp; asm volatile("" : "+s"(_k)); _k->field; })
__global__ void __launch_bounds__(NTHREADS, 2) hybrid_fwd(Params p_unused, int ph_lo, int ph_hi) {
    extern __shared__ __attribute__((aligned(16))) unsigned char lds_raw[];
    float* lds = (float*)lds_raw;
    LAS unsigned char* ldsb = (LAS unsigned char*)lds_raw;
    CParams* kp = (CParams*)__builtin_amdgcn_kernarg_segment_ptr();
    unsigned char* const ws0 = KP(ws);
    volatile LAS unsigned* xbw = (volatile LAS unsigned*)(lds_raw + LDS_BYTES - 16);
    if (threadIdx.x == 0) { xbw[0] = 0u; xbw[1] = 0u; xbw[2] = 0u; xbw[3] = 0u; }
    __syncthreads();
    XcdBarrier bar; bar.bar = (unsigned*)(ws0 + WS_BAR); bar.x = 0; bar.st = xbw;
    if (ph_lo < ph_hi) bar = xcd_barrier_post((unsigned*)(ws0 + WS_BAR), xbw);
#define IN(ph) ((ph) >= ph_lo && (ph) <= ph_hi)
#define GRID_BAR(ph) do { if ((ph) >= ph_lo && (ph) < ph_hi) xcd_barrier(bar); \
    if (STAMP_A >= 0 && blockIdx.x == 0 && threadIdx.x == 0) ((volatile unsigned long long*)(ws0 + WS_BAR + 14800))[(ph) + 1] = __builtin_amdgcn_s_memrealtime(); } while (0)
    if (STAMP_A >= 0 && blockIdx.x == 0 && threadIdx.x == 0) ((volatile unsigned long long*)(ws0 + WS_BAR + 14800))[0] = __builtin_amdgcn_s_memrealtime();
    if (PHON(0) && IN(0)) REPS(0) { unsigned char* ws = ws0; asm volatile("" : "+s"(ws)); ws = as_global(ws); { Params q; q.ws = ws; q.x = as_global(KP(x)); q.pos = as_global(KP(pos)); q.w_in = as_global(KP(w_in)); q.g_q = as_global(KP(g_q)); q.w_qb = as_global(KP(w_qb)); q.g_kv = as_global(KP(g_kv)); q.w_kvb = as_global(KP(w_kvb));
        q.w_oa = as_global(KP(w_oa)); q.w_ob = as_global(KP(w_ob)); q.w_out = as_global(KP(w_out)); q.ln1g = as_global(KP(ln1g)); q.ln1b = as_global(KP(ln1b)); q.w_router = as_global(KP(w_router)); q.w_group = as_global(KP(w_group)); q.b_router = as_global(KP(b_router)); q.b_group = as_global(KP(b_group)); if (REP_PHASE >= 31 && REP_PHASE <= 34) p_prologue(ldsb, q, 1 << (REP_PHASE - 31)); p_prologue(ldsb, q); } }
    int lfirst = -1; asm volatile("" : "+s"(lfirst));
    for (int l = lfirst; l < DEPTH; ++l) {
        const int pb = l * NPH;
        if (l >= 0 && PHON(1) && IN(pb + 1)) REPS(1) { unsigned char* ws = ws0; asm volatile("" : "+s"(ws)); ws = as_global(ws);
            EpiIn E; E.ws = ws;
            pg8::Gemm g{(const bf16_t*)(ws + WS_XB), (const bf16_t*)(ws + WS_WIN_T) + (size_t)l * INP * D, T, INP, D}; pg8::StaticOrder SO; SO.init(T, INP, (int)gridDim.x, opaque_bid());
            pg8::gemm_phase<EpiIn, pg8::StaticOrder, true, true>(ldsb, g, SO, E);
        }
        if ((l < 0 ? (PHON(0) && IN(0)) : (PHON(1) && IN(pb + 1)))) { unsigned char* ws = ws0; asm volatile("" : "+s"(ws)); ws = as_global(ws);
            const int G_ = (int)gridDim.x, nfull = l < 0 ? 0 : ((T / 256) * (INP / 256)) % G_, bid_ = opaque_bid();
            if (l < 0 || (nfull > 0 && bid_ >= nfull)) { __syncthreads();
                Params q; q.ws = ws; q.w_in = as_global(KP(w_in)); q.g_q = as_global(KP(g_q)); q.w_qb = as_global(KP(w_qb)); q.g_kv = as_global(KP(g_kv)); q.w_kvb = as_global(KP(w_kvb));
                q.w_oa = as_global(KP(w_oa)); q.w_ob = as_global(KP(w_ob)); q.w_out = as_global(KP(w_out));
                constexpr int WC_IN = (D / 64) * (INP / 64), WC_ALL = WC_IN + (512 / 64) * (1536 / 64) + (512 / 64) * (2048 / 64) + 2 * (1024 / 64) * (D / 64) + (D / 64) * (D / 64);
                const int a_l1 = l < 0 ? 0 : l, a_lo1 = l < 0 ? 0 : WC_IN, a_hi1 = l < 0 ? WC_IN : WC_ALL, a_l2 = l + 1, a_hi2 = (l >= 0 && l + 1 < DEPTH) ? WC_IN : 0;
                p_wcopies(ldsb, q, a_l1, a_lo1, a_hi1, a_l2, 0, a_hi2, bid_ - nfull, G_ - nfull); } }
        GRID_BAR(l < 0 ? 0 : pb + 1);
        if (l < 0) continue;
        if (PHON(2) && IN(pb + 2)) REPS(2) { unsigned char* ws = ws0; asm volatile("" : "+s"(ws)); ws = as_global(ws);
            { EpiQA E; E.ws = ws;
              pg8::Gemm g{(const bf16_t*)(ws + WS_CQ), (const bf16_t*)(ws + WS_WQB_T) + (size_t)l * 1536 * 512, T, 1536, 512}; pg8::StaticOrder SO; SO.init(T, 1536, (int)gridDim.x, opaque_bid());
              pg8::gemm_phase<EpiQA, pg8::StaticOrder, true, true>(ldsb, g, SO, E); }
            { EpiKV E; E.ws = ws;
              pg8::Gemm g{(const bf16_t*)(ws + WS_CKV), (const bf16_t*)(ws + WS_WKVB_T) + (size_t)l * 2048 * 512, T, 2048, 512}; pg8::StaticOrder SO; SO.init(T, 2048, (int)gridDim.x, opaque_bid());
              pg8::gemm_phase<EpiKV, pg8::StaticOrder, true, true>(ldsb, g, SO, E); }
            REPS(12) p_score(ldsb, ws);
        }
        GRID_BAR(pb + 2);
        if (PHON(3) && IN(pb + 3)) REPS(3) { unsigned char* ws = ws0; asm volatile("" : "+s"(ws)); ws = as_global(ws); p_select(ws); }
        GRID_BAR(pb + 3);
        if (PHON(4) && IN(pb + 4)) REPS(4) { unsigned char* ws = ws0; asm volatile("" : "+s"(ws)); ws = as_global(ws);
            if (REP_PHASE == 14) p_attn<1>(ldsb, ws); if (REP_PHASE == 15) p_attn<2>(ldsb, ws); if (REP_PHASE == 16) p_attn<3>(ldsb, ws);
            p_attn<0>(ldsb, ws);
        }
        GRID_BAR(pb + 4);
        if (PHON(5) && IN(pb + 5)) REPS(5) { unsigned char* ws = ws0; asm volatile("" : "+s"(ws)); ws = as_global(ws);
            pg8::StaticOrder SO; SO.init(T, D, (int)gridDim.x, opaque_bid());
            { EpiYA E; E.ws = ws;
              pg8::Gemm g{(const bf16_t*)(ws + WS_OA), (const bf16_t*)(ws + WS_WOA_T) + (size_t)l * D * 1024, T, D, 1024};
              pg8::gemm_phase<EpiYA, pg8::StaticOrder, true, true>(ldsb, g, SO, E); }
            { EpiYB E; E.ws = ws;
              pg8::Gemm g{(const bf16_t*)(ws + WS_OB), (const bf16_t*)(ws + WS_WOB_T) + (size_t)l * D * 1024, T, D, 1024};
              pg8::gemm_phase<EpiYB, pg8::StaticOrder, true, true>(ldsb, g, SO, E); }
        }
        GRID_BAR(pb + 5);
        if (PHON(6) && IN(pb + 6)) REPS(6) { unsigned char* ws = ws0; asm volatile("" : "+s"(ws)); ws = as_global(ws);
            EpiOut E; E.hin = (l == 0) ? as_global(KP(x)) : (const float*)(ws + WS_H2F); E.V1 = (float*)(ws + WS_V1);
            pg8::Gemm g{(const bf16_t*)(ws + WS_Y), (const bf16_t*)(ws + WS_WOUT_T) + (size_t)l * D * D, T, D, D}; pg8::StaticOrder SO; SO.init(T, D, (int)gridDim.x, opaque_bid());
            pg8::gemm_phase<EpiOut, pg8::StaticOrder, true, true>(ldsb, g, SO, E);
        }
        GRID_BAR(pb + 6);
        if (PHON(7) && IN(pb + 7)) REPS(7) { unsigned char* ws = ws0; asm volatile("" : "+s"(ws)); ws = as_global(ws); if (REP_PHASE == 21) p_ln1_route3<1>(ldsb, ws, as_global(KP(ln1g)) + (size_t)l * D, as_global(KP(ln1b)) + (size_t)l * D, l); if (REP_PHASE == 22) p_ln1_route3<2>(ldsb, ws, as_global(KP(ln1g)) + (size_t)l * D, as_global(KP(ln1b)) + (size_t)l * D, l);
            p_ln1_route3<0>(ldsb, ws, as_global(KP(ln1g)) + (size_t)l * D, as_global(KP(ln1b)) + (size_t)l * D, l); }
        GRID_BAR(pb + 7);
        if (PHON(8) && IN(pb + 8)) REPS(8) { unsigned char* ws = ws0; asm volatile("" : "+s"(ws)); ws = as_global(ws); if (REP_PHASE == 18) p_moe1_mfma<0>(ldsb, ws, as_global(KP(w_eg)), as_global(KP(w_eu)), l ^ 1, l); if (REP_PHASE == 19) p_moe1_mfma<1>(ldsb, ws, as_global(KP(w_eg)), as_global(KP(w_eu)), l ^ 1, l); if (REP_PHASE == 20) p_moe1_mfma<2>(ldsb, ws, as_global(KP(w_eg)), as_global(KP(w_eu)), l ^ 1, l);
            p_moe1_mfma<0>(ldsb, ws, as_global(KP(w_eg)), as_global(KP(w_eu)), l, l); }
        GRID_BAR(pb + 8);
        if (PHON(9) && IN(pb + 9)) REPS(9) { unsigned char* ws = ws0; asm volatile("" : "+s"(ws)); ws = as_global(ws); p_moe2_mfma(ldsb, ws, as_global(KP(w_ed)), l); }
        GRID_BAR(pb + 9);
        if (PHON(10) && IN(pb + 10)) REPS(10) { unsigned char* ws = ws0; asm volatile("" : "+s"(ws)); ws = as_global(ws); p_ln2v2(ldsb, ws, as_global(KP(ln1g)) + (size_t)l * D, as_global(KP(ln1b)) + (size_t)l * D, as_global(KP(ln2g)) + (size_t)l * D, as_global(KP(ln2b)) + (size_t)l * D, (l == DEPTH - 1) ? as_global(KP(out)) : (float*)(ws + WS_H2F), l); }
        GRID_BAR(pb + 10);
    }
    if (STAMP_A >= 0) {
        if (ph_lo < ph_hi) xcd_barrier(bar);
        if (blockIdx.x == 0) {
            volatile unsigned long long* st = (volatile unsigned long long*)(ws0 + WS_BAR + 14800);
            if (threadIdx.x == 0) st[DEPTH * NPH + 1] = __builtin_amdgcn_s_memrealtime();
            __syncthreads();
            float da = 0.f, db = 0.f;
            for (int l = 0; l < DEPTH; ++l) {
                if (STAMP_A == 0) { if (l == 0) da += (float)(st[1] - st[0]); } else da += (float)(st[l * NPH + STAMP_A + 1] - st[l * NPH + STAMP_A]);
                if (STAMP_B == 0) { if (l == 0) db += (float)(st[1] - st[0]); } else if (STAMP_B > 0) db += (float)(st[l * NPH + STAMP_B + 1] - st[l * NPH + STAMP_B]);
            }
            da *= 0.01f; db *= 0.01f;
            float* o = as_global(KP(out));
            for (int i = threadIdx.x; i < 65536; i += NTHREADS) o[i] = sqrtf(da);
            if (threadIdx.x == 0 && STAMP_B >= 0) o[70000] = db;
        }
    }
}

#ifndef MK_ONE_LAUNCH
#define MK_ONE_LAUNCH 1
#endif
extern "C" void kernel_launch(void* const* d_in, const int* in_sizes, int n_in, void* d_out, int out_size, void* d_ws, size_t ws_size, hipStream_t stream) {
    static int grid = 0;
    if (!grid) {
        if (n_in != 21 || in_sizes[0] != T * D || out_size != T * D || ws_size < WS_END) {
            fprintf(stderr, "kernel_launch: unexpected shapes (n_in %d, in0 %d, out %d, ws %zu, need %zu); nothing launched\n", n_in, n_in > 0 ? in_sizes[0] : -1, out_size, ws_size, (size_t)WS_END);
            grid = -1; return; }
        int dev = 0, cus = 0, per_cu = 0;
        hipGetDevice(&dev); hipDeviceGetAttribute(&cus, hipDeviceAttributeMultiprocessorCount, dev);
        if (hipFuncSetAttribute((const void*)hybrid_fwd, hipFuncAttributeMaxDynamicSharedMemorySize, LDS_BYTES) != hipSuccess) { fprintf(stderr, "kernel_launch: hipFuncSetAttribute failed\n"); grid = -1; return; }
        hipOccupancyMaxActiveBlocksPerMultiprocessor(&per_cu, (const void*)hybrid_fwd, NTHREADS, LDS_BYTES);
        if (per_cu < 1) fprintf(stderr, "kernel_launch: occupancy query reports %d blocks per CU\n", per_cu);
        grid = cus > 0 ? cus : 256;
    }
    if (grid < 0) return;
    hipMemsetAsync((char*)d_ws, 0, WS_CTL_END, stream);
    Params p{};
    p.x = (const float*)d_in[0]; p.pos = (const int*)d_in[1];
    p.w_in = (const float*)d_in[2]; p.g_q = (const float*)d_in[3]; p.w_qb = (const float*)d_in[4]; p.g_kv = (const float*)d_in[5]; p.w_kvb = (const float*)d_in[6];
    p.w_oa = (const float*)d_in[7]; p.w_ob = (const float*)d_in[8]; p.w_out = (const float*)d_in[9]; p.ln1g = (const float*)d_in[10]; p.ln1b = (const float*)d_in[11];
    p.w_group = (const float*)d_in[12]; p.b_group = (const float*)d_in[13]; p.w_router = (const float*)d_in[14]; p.b_router = (const float*)d_in[15];
    p.w_eg = (const float*)d_in[16]; p.w_eu = (const float*)d_in[17]; p.w_ed = (const float*)d_in[18]; p.ln2g = (const float*)d_in[19]; p.ln2b = (const float*)d_in[20];
    p.out = (float*)d_out; p.ws = (unsigned char*)d_ws;
#if MK_ONE_LAUNCH
    hipLaunchKernelGGL(hybrid_fwd, dim3(grid), dim3(NTHREADS), LDS_BYTES, stream, p, 0, DEPTH * NPH);
#else
    for (int ph = 0; ph <= DEPTH * NPH; ++ph) hipLaunchKernelGGL(hybrid_fwd, dim3(grid), dim3(NTHREADS), LDS_BYTES, stream, p, ph, ph);
#endif
}
```

```cpp
#include <hip/hip_runtime.h>
#include <cstdio>
#include <cstdint>

typedef unsigned short bf16_t;
typedef float f32x4 __attribute__((ext_vector_type(4)));
typedef unsigned u32x4 __attribute__((ext_vector_type(4)));
typedef unsigned u32x2 __attribute__((ext_vector_type(2)));

constexpr int T = 8192, D = 2048, S = 4096, NB = 2, DEPTH = 2;
constexpr int INW = 9360, INP = 9472;
constexpr int NE = 64, FE = 512;
constexpr int NTHREADS = 512;
constexpr int LDS_BYTES = 147456;
constexpr float ALPHA = 1.41421356237309515f;
constexpr int ECAP = 8192;
#ifndef MOE_RBLK
#define MOE_RBLK 384
#endif
constexpr int PMAX = 40960;

constexpr size_t al256(size_t x) { return (x + 255) & ~(size_t)255; }
constexpr size_t XCD_BAR_BYTES = 16384;
constexpr size_t WS_BAR = 0;
constexpr size_t WS_CNT = WS_BAR + XCD_BAR_BYTES;
constexpr size_t WS_CTL_END = WS_CNT + al256(DEPTH * 64 * 4);
constexpr size_t WS_SSQ = WS_CTL_END;
constexpr size_t WS_ROPE = WS_SSQ + al256((size_t)T * 32 * 4);
constexpr size_t WS_XB = WS_ROPE + al256((size_t)T * 112 * 4);
constexpr size_t WS_H2F = WS_XB + al256((size_t)T * D * 2);
constexpr size_t WS_CQ = WS_H2F + al256((size_t)T * D * 4);
constexpr size_t WS_CKV = WS_CQ + al256((size_t)T * 512 * 2);
constexpr size_t WS_QB = WS_CKV + al256((size_t)T * 512 * 2);
constexpr size_t WS_KB = WS_QB + al256((size_t)T * 1024 * 2);
constexpr size_t WS_VB = WS_KB + al256((size_t)T * 1024 * 2);
constexpr size_t WS_QI = WS_VB + al256((size_t)T * 1024 * 2);
constexpr size_t WS_KI = WS_QI + al256((size_t)T * 1024 * 2);
constexpr size_t WS_WI = WS_KI + al256((size_t)T * 64 * 2);
constexpr size_t WS_GA = WS_WI + al256((size_t)T * 16 * 4);
constexpr size_t WS_GB = WS_GA + al256((size_t)T * D * 2);
constexpr size_t WS_QA = WS_GB + al256((size_t)T * D * 2);
constexpr size_t WS_KA = WS_QA + al256((size_t)T * 1536 * 2);
constexpr size_t WS_VA = WS_KA + al256((size_t)T * 1536 * 2);
constexpr size_t WS_MASK = WS_VA + al256((size_t)T * 1024 * 2);
constexpr size_t WS_OA = WS_MASK + al256((size_t)T * 128 * 4);
constexpr size_t WS_OB = WS_OA + al256((size_t)T * 1024 * 2);
constexpr size_t WS_YT = WS_OB + al256((size_t)T * 1024 * 2);
constexpr size_t WS_Y = WS_YT + al256((size_t)T * D * 4);
constexpr size_t WS_V1 = WS_Y + al256((size_t)T * D * 2);
constexpr size_t WS_H1F = WS_V1 + al256((size_t)T * D * 4);
constexpr size_t WS_H1B = WS_H1F + al256((size_t)T * D * 4);
constexpr size_t WS_TOKE = WS_H1B + al256((size_t)T * D * 2);
constexpr size_t WS_TOKW = WS_TOKE + al256((size_t)T * 2 * 4);
constexpr size_t WS_TOKS = WS_TOKW + al256((size_t)T * 2 * 4);
constexpr size_t WS_LIST = WS_TOKS + al256((size_t)T * 2 * 4);
constexpr size_t WS_HID = WS_LIST + al256((size_t)NE * ECAP * 4);
constexpr size_t WS_YE = WS_HID + al256((size_t)PMAX * FE * 2);
constexpr size_t WS_RWS = WS_YE + al256((size_t)PMAX * D * 2);
constexpr size_t WS_GWS = WS_RWS + al256((size_t)DEPTH * D * 64 * 4);
constexpr size_t WS_SEC = WS_GWS + al256((size_t)DEPTH * D * 8 * 4);
constexpr size_t WS_RWH = WS_SEC + al256((size_t)DEPTH * 160 * 4);
constexpr size_t WS_RWL = WS_RWH + al256((size_t)DEPTH * 96 * D * 2);
constexpr size_t WS_STATS = WS_RWL + al256((size_t)DEPTH * 96 * D * 2);
constexpr size_t WS_SCORE = WS_STATS + al256((size_t)T * 2 * 4);
constexpr size_t WS_WIN_T = WS_SCORE + al256((size_t)T * 4096 * 4);
constexpr size_t WS_WQB_T = WS_WIN_T + al256((size_t)DEPTH * INP * D * 2);
constexpr size_t WS_WKVB_T = WS_WQB_T + al256((size_t)DEPTH * 1536 * 512 * 2);
constexpr size_t WS_WOA_T = WS_WKVB_T + al256((size_t)DEPTH * 2048 * 512 * 2);
constexpr size_t WS_WOB_T = WS_WOA_T + al256((size_t)DEPTH * D * 1024 * 2);
constexpr size_t WS_WOUT_T = WS_WOB_T + al256((size_t)DEPTH * D * 1024 * 2);
constexpr size_t WS_END = WS_WOUT_T + al256((size_t)DEPTH * D * D * 2);
static_assert(WS_CKV == WS_CQ + (size_t)T * 512 * 2, "CQ|CKV must be consecutive");

static_assert(WS_KB == WS_QB + (size_t)T * 1024 * 2 && WS_VB == WS_KB + (size_t)T * 1024 * 2 && WS_GB == WS_GA + (size_t)T * D * 2, "QB|KB|VB and GA|GB must be consecutive");
struct Params {
    const float* x; const int* pos;
    const float *w_in, *g_q, *w_qb, *g_kv, *w_kvb, *w_oa, *w_ob, *w_out, *ln1g, *ln1b, *w_group, *b_group, *w_router, *b_router, *w_eg, *w_eu, *w_ed, *ln2g, *ln2b;
    float* out; unsigned char* ws;
};

__device__ __forceinline__ float bf2f(bf16_t v) { return __uint_as_float((unsigned)v << 16); }
__device__ __forceinline__ bf16_t f2bf(float f) { unsigned u = __float_as_uint(f); u += 0x7fffu + ((u >> 16) & 1u); return (bf16_t)(u >> 16); }
__device__ __forceinline__ unsigned pk2(float a, float b) { return (unsigned)f2bf(a) | ((unsigned)f2bf(b) << 16); }
__device__ __forceinline__ void st4bf(bf16_t* p, f32x4 v) { u32x2 w; w.x = pk2(v[0], v[1]); w.y = pk2(v[2], v[3]); *(u32x2*)p = w; }
__device__ __forceinline__ float wave_sum(float v) {
#pragma unroll
    for (int o = 32; o >= 1; o >>= 1) v += __shfl_xor(v, o);
    return v;
}
__device__ __forceinline__ float wave_max(float v) {
#pragma unroll
    for (int o = 32; o >= 1; o >>= 1) v = fmaxf(v, __shfl_xor(v, o));
    return v;
}
__device__ __forceinline__ int block_sum_int(int v, int* red) {
#pragma unroll
    for (int o = 32; o >= 1; o >>= 1) v += __shfl_xor(v, o);
    if ((threadIdx.x & 63) == 0) red[threadIdx.x >> 6] = v;
    __syncthreads();
    int t = 0;
#pragma unroll
    for (int i = 0; i < 8; ++i) t += red[i];
    __syncthreads();
    return t;
}
__device__ __forceinline__ f32x4 rot4(f32x4 v, float c0, float s0, float c1, float s1) { f32x4 o; o[0] = v[0] * c0 - v[1] * s0; o[1] = v[1] * c0 + v[0] * s0; o[2] = v[2] * c1 - v[3] * s1; o[3] = v[3] * c1 + v[2] * s1; return o; }

#define XB_TMO      128
#define XB_XCNT(j)  (256  + 64 * (j))
#define XB_XSUB(j)  (1280 + 64 * (j))
#define XB_XGEN(j)  (2304 + 64 * (j))
#define XB_TOP      3328
#define XB_TOPGEN   3392
#define XCD_BAR_WORDS 3456
#define XB_SPIN_CAP (1u << 22)
#define LAS __attribute__((address_space(3)))
__device__ __forceinline__ unsigned xb_ld(unsigned* p)              { return __hip_atomic_load(p, __ATOMIC_RELAXED, __HIP_MEMORY_SCOPE_AGENT); }
__device__ __forceinline__ unsigned xb_add(unsigned* p, unsigned v) { return __hip_atomic_fetch_add(p, v, __ATOMIC_RELAXED, __HIP_MEMORY_SCOPE_AGENT); }
__device__ __forceinline__ unsigned xb_xcc_id() { return (unsigned)__builtin_amdgcn_s_getreg((3 << 11) | 20) & 0xFu; }
#define XB_SPIN(cond, bar) do { unsigned _sp = 0; while (cond) { __builtin_amdgcn_s_sleep(1); \
    if ((++_sp & 255u) == 0u) { if (xb_ld(&(bar)[XB_TMO])) break; if (_sp > XB_SPIN_CAP) { atomicAdd(&(bar)[XB_TMO], 1u); break; } } } } while (0)
struct XcdBarrier { unsigned* bar; unsigned x; volatile LAS unsigned* st; };
__device__ __forceinline__ XcdBarrier xcd_barrier_post(unsigned* bar, volatile LAS unsigned* st) {
    XcdBarrier b; b.bar = bar; b.x = xb_xcc_id(); b.st = st;
    if (threadIdx.x == 0) (void)xb_add(&bar[XB_XCNT(b.x)], 1u);
    return b;
}
__device__ __forceinline__ void xcd_barrier_complete(unsigned* bar, unsigned x, unsigned& nloc, unsigned& nx) {
    const unsigned G = gridDim.x * gridDim.y * gridDim.z;
    unsigned sum, cnt, mine, sp = 0u;
    for (;;) {
        sum = 0u; cnt = 0u; mine = 0u;
#pragma unroll
        for (unsigned j = 0; j < 16; ++j) { const unsigned c = xb_ld(&bar[XB_XCNT(j)]); sum += c; cnt += (c > 0u) ? 1u : 0u; mine = (j == x) ? c : mine; }
        if (sum == G) break;
        __builtin_amdgcn_s_sleep(1);
        if ((++sp & 255u) == 0u) { if (xb_ld(&bar[XB_TMO])) break; if (sp > XB_SPIN_CAP) { atomicAdd(&bar[XB_TMO], 1u); break; } }
    }
    nloc = mine > 0u ? mine : 1u; nx = cnt > 0u ? cnt : 1u;
}
__device__ __forceinline__ void xcd_barrier(const XcdBarrier& b) {
    asm volatile("s_waitcnt vmcnt(0)" ::: "memory");
    __syncthreads();
    if (threadIdx.x == 0) {
        unsigned* bar = b.bar; asm volatile("" : "+s"(bar));
        __builtin_amdgcn_s_waitcnt(0);
        unsigned nloc = b.st[0], nx = b.st[1];
        unsigned bx = b.x; asm volatile("" : "+s"(bx));
        if (nloc == 0u) { xcd_barrier_complete(bar, bx, nloc, nx); b.st[0] = nloc; b.st[1] = nx; }
        const unsigned old = xb_add(&bar[XB_XSUB(bx)], 1u);
        const unsigned gen = old / nloc;
        if (old + 1u == (gen + 1u) * nloc) {
            __builtin_amdgcn_fence(__ATOMIC_RELEASE, "agent");
            asm volatile("s_waitcnt vmcnt(0)" ::: "memory");
            const unsigned og = xb_add(&bar[XB_TOP], 1u);
            const unsigned tg = og / nx;
            if (og + 1u == (tg + 1u) * nx) xb_add(&bar[XB_TOPGEN], 1u);
            else XB_SPIN(xb_ld(&bar[XB_TOPGEN]) == tg, bar);
            __builtin_amdgcn_fence(__ATOMIC_ACQUIRE, "agent");
            xb_add(&bar[XB_XGEN(bx)], 1u);
            asm volatile("s_waitcnt vmcnt(0)" ::: "memory");
        } else {
            XB_SPIN(xb_ld(&bar[XB_XGEN(bx)]) == gen, bar);
            __builtin_amdgcn_fence(__ATOMIC_ACQUIRE, "agent");
            asm volatile("s_waitcnt vmcnt(0)" ::: "memory");
        }
    }
    __syncthreads();
}

__device__ __forceinline__ int opaque_tid() { int t = threadIdx.x; asm volatile("" : "+v"(t)); return t; }
__device__ __forceinline__ int opaque_bid() { int b = blockIdx.x; asm volatile("" : "+s"(b)); return b; }
namespace pg8 {
#define PG8_LAS __attribute__((address_space(3)))
typedef unsigned short bf16_t;
typedef short bf16x8 __attribute__((ext_vector_type(8)));
typedef float f32x4 __attribute__((ext_vector_type(4)));
typedef unsigned u32x4 __attribute__((ext_vector_type(4)));
constexpr int BM = 256, BK = 64, HALF = 128, HTB = HALF * BK * 2  , STAGE_BYTES = 8 * HTB, NXCD = 8, WGM = 8;

__host__ __device__ __forceinline__ int lds_byte(int r, int c) { const int st = (r >> 4) * 2 + (c >> 5), rr = r & 15, cc = c & 31, ob = rr * 64 + cc * 2; return st * 1024 + (ob ^ (((ob >> 9) & 1) << 5)); }
__host__ __device__ __forceinline__ void stage_rc(int b, int& R, int& C) { const int st = b / 1024, sb = b % 1024, swz = sb ^ (((sb >> 9) & 1) << 5); R = (st >> 1) * 16 + swz / 64; C = (st & 1) * 32 + (swz % 64) / 2; }
__host__ __device__ __forceinline__ int perm32(int rho) { const int n = rho >> 4, i = rho & 15; return 8 * (i >> 2) + 4 * n + (i & 3); }

struct Unit { int pm, pn; };
struct Gemm { const bf16_t* A; const bf16_t* Bt; int M, N, K; };

struct StaticOrder {
    int nM, nN, nwg, G, c;
    __host__ __device__ void init(int M, int N, int G_, int c_) { nM = M / BM; nN = N / BM; nwg = nM * nN; G = G_; c = c_; }
    __host__ __device__ bool next(int i, Unit& u) const {
        const long L = (long)i * G + c; if (L >= nwg) return false;
        int wgid = (int)L; { const int q = nwg / NXCD, r = nwg % NXCD, xcd = wgid % NXCD, off = wgid / NXCD; wgid = (xcd < r ? xcd * (q + 1) : r * (q + 1) + (xcd - r) * q) + off; }
        const int nig = WGM * nN, gid = wgid / nig, fm = gid * WGM, gsz = (nM - fm) < WGM ? (nM - fm) : WGM;
        u.pm = fm + ((wgid % nig) % gsz); u.pn = (wgid % nig) / gsz; return true;
    }
    __device__ __forceinline__ void a_ready(const Unit&) const {}
    __device__ __forceinline__ void done(const Unit&) const {}
};

__device__ __forceinline__ unsigned cvt_pk_bf16(float lo, float hi) { unsigned r; asm volatile("v_cvt_pk_bf16_f32 %0, %1, %2" : "=v"(r) : "v"(lo), "v"(hi)); return r; }
template <class Epi, class Sched, bool ALIGN_EPI = false, bool SP2 = false>
__device__ __forceinline__ void gemm_phase(PG8_LAS unsigned char* lds, const Gemm g, const Sched& S, const Epi& E) {
    const int tid = opaque_tid(), wid = __builtin_amdgcn_readfirstlane(tid >> 6), lane = tid & 63, wr = wid >> 2, wc = wid & 3, fr = lane & 15, fq = lane >> 4;
    const int K = g.K, nt = K / BK;
    unsigned voffA[2], voffB[2];
#pragma unroll
    for (int i = 0; i < 2; ++i) { int R, C; stage_rc(tid * 16 + i * 8192, R, C); const int Rb = Epi::PERM ? ((R & ~31) + perm32(R & 31)) : R;
        voffA[i] = (unsigned)(R * K + C) * 2u; voffB[i] = (unsigned)(Rb * K + C) * 2u; }
    const size_t kstep = (size_t)(BK * 2);
    const size_t hstep = (size_t)HALF * K * 2;
    const size_t tstep = 2 * hstep;
    const unsigned ldsw = (unsigned)wid * 1024u;
    const int aoff = lds_byte(wr * 64 + fr, fq * 8), boff = lds_byte(wc * 32 + fr, fq * 8);
#define PG8_SA(b, h) (((b) * 2 + (h)) * HTB)
#define PG8_SB(b, h) ((4 + (b) * 2 + (h)) * HTB)
#define PG8_STAGE(bufoff, gbase, voff) do { _Pragma("unroll") for (int _i = 0; _i < 2; ++_i) \
        __builtin_amdgcn_global_load_lds((const unsigned*)((const char*)(gbase) + (voff)[_i]), (PG8_LAS unsigned*)(lds + (bufoff) + ldsw + _i * 8192), 16, 0, 0); } while (0)
#define PG8_LDA(dst, b, h) do { _Pragma("unroll") for (int m = 0; m < 4; ++m) _Pragma("unroll") for (int k = 0; k < 2; ++k) dst[m][k] = *(const PG8_LAS bf16x8*)(lds + PG8_SA(b, h) + aoff + m * 2048 + k * 1024); } while (0)
#define PG8_LDB(dst, b, h) do { _Pragma("unroll") for (int n = 0; n < 2; ++n) _Pragma("unroll") for (int k = 0; k < 2; ++k) dst[n][k] = *(const PG8_LAS bf16x8*)(lds + PG8_SB(b, h) + boff + n * 2048 + k * 1024); } while (0)
#define PG8_MMA(ai, bj, At, Bt) do { __builtin_amdgcn_s_setprio(1); _Pragma("unroll") for (int m = 0; m < 4; ++m) _Pragma("unroll") for (int n = 0; n < 2; ++n) _Pragma("unroll") for (int k = 0; k < 2; ++k) \
        acc[ai][bj][m][n] = __builtin_amdgcn_mfma_f32_16x16x32_bf16(Bt[n][k], At[m][k], acc[ai][bj][m][n], 0, 0, 0); __builtin_amdgcn_s_setprio(0); } while (0)
#define PG8_WAIT_V(n) asm volatile("s_waitcnt vmcnt(" #n ")" ::: "memory")
#define PG8_WAIT_L(n) asm volatile("s_waitcnt lgkmcnt(" #n ")" ::: "memory")
#define PG8_BAR __builtin_amdgcn_s_barrier()
#define PG8_SCHED __builtin_amdgcn_sched_barrier(0)
    Unit cur, nxt; int ui = 0;
    if (!S.next(0, cur)) return;
    f32x4 acc[2][2][4][2];
#pragma unroll
    for (int a = 0; a < 2; ++a)
#pragma unroll
        for (int b = 0; b < 2; ++b)
#pragma unroll
            for (int m = 0; m < 4; ++m)
#pragma unroll
                for (int n = 0; n < 2; ++n) acc[a][b][m][n] = (f32x4){0.f, 0.f, 0.f, 0.f};
    bf16x8 At[4][2], B0[2][2], B1[2][2];
    const char* cA = (const char*)g.A + (size_t)cur.pm * tstep; const char* cB = (const char*)g.Bt + (size_t)cur.pn * tstep;
    S.a_ready(cur);
    if constexpr (SP2) {
        PG8_STAGE(PG8_SB(0, 0), cB, voffB); PG8_STAGE(PG8_SB(0, 1), cB + hstep, voffB); PG8_STAGE(PG8_SA(0, 0), cA, voffA); PG8_STAGE(PG8_SA(0, 1), cA + hstep, voffA);
        if (wr == 1) PG8_BAR;
        PG8_WAIT_V(2); PG8_BAR;
        PG8_STAGE(PG8_SB(1, 0), cB + kstep, voffB); PG8_STAGE(PG8_SA(1, 0), cA + kstep, voffA); PG8_STAGE(PG8_SB(1, 1), cB + hstep + kstep, voffB);
        PG8_WAIT_V(6); PG8_BAR;
    } else {
        PG8_STAGE(PG8_SB(0, 0), cB, voffB); PG8_STAGE(PG8_SA(0, 0), cA, voffA); PG8_STAGE(PG8_SB(0, 1), cB + hstep, voffB); PG8_STAGE(PG8_SA(0, 1), cA + hstep, voffA);
        if (wr == 1) PG8_BAR;
        PG8_WAIT_V(4); PG8_BAR;
        PG8_STAGE(PG8_SB(1, 0), cB + kstep, voffB); PG8_STAGE(PG8_SA(1, 0), cA + kstep, voffA); PG8_STAGE(PG8_SB(1, 1), cB + hstep + kstep, voffB);
        PG8_WAIT_V(6); PG8_BAR;
    }
    for (;;) {
        const bool has_next = S.next(ui + 1, nxt);
        const char* nA = has_next ? (const char*)g.A + (size_t)nxt.pm * tstep : cA; const char* nB = has_next ? (const char*)g.Bt + (size_t)nxt.pn * tstep : cB;
        for (int t = 0; t < nt; t += 2) {
            const bool last = (t == nt - 2);
            const char* a1 = cA + (size_t)(t + 1) * kstep;
            const char* a2 = last ? nA : cA + (size_t)(t + 2) * kstep; const char* b2 = last ? nB : cB + (size_t)(t + 2) * kstep;
            const char* a3 = a2 + kstep; const char* b3 = b2 + kstep;
            if (last && has_next) S.a_ready(nxt);
            if constexpr (SP2) {
            PG8_LDB(B0, 0, 0); PG8_LDB(B1, 0, 1); PG8_SCHED; PG8_LDA(At, 0, 0); PG8_STAGE(PG8_SA(1, 1), a1 + hstep, voffA);
            PG8_WAIT_V(8); PG8_WAIT_L(0); PG8_BAR; PG8_MMA(0, 0, At, B0); PG8_MMA(0, 1, At, B1); PG8_BAR; PG8_SCHED;
            PG8_LDA(At, 0, 1); PG8_STAGE(PG8_SB(0, 0), b2, voffB); PG8_STAGE(PG8_SB(0, 1), b2 + hstep, voffB); PG8_STAGE(PG8_SA(0, 0), a2, voffA);
            PG8_WAIT_V(8); PG8_WAIT_L(0); PG8_BAR; PG8_MMA(1, 0, At, B0); PG8_MMA(1, 1, At, B1); PG8_BAR; PG8_SCHED;
            PG8_LDB(B0, 1, 0); PG8_LDB(B1, 1, 1); PG8_SCHED; PG8_LDA(At, 1, 0); PG8_STAGE(PG8_SA(0, 1), a2 + hstep, voffA);
            PG8_WAIT_V(8); PG8_WAIT_L(0); PG8_BAR; PG8_MMA(0, 0, At, B0); PG8_MMA(0, 1, At, B1); PG8_BAR; PG8_SCHED;
            PG8_LDA(At, 1, 1); PG8_STAGE(PG8_SB(1, 0), b3, voffB); PG8_STAGE(PG8_SB(1, 1), b3 + hstep, voffB); PG8_STAGE(PG8_SA(1, 0), a3, voffA);
            PG8_WAIT_V(8); PG8_WAIT_L(0); PG8_BAR; PG8_MMA(1, 0, At, B0); PG8_MMA(1, 1, At, B1); PG8_BAR; PG8_SCHED;
            } else {
            PG8_LDB(B0, 0, 0); PG8_SCHED; PG8_LDA(At, 0, 0); PG8_STAGE(PG8_SA(1, 1), a1 + hstep, voffA);
            PG8_WAIT_L(8); PG8_BAR; PG8_WAIT_L(0); PG8_MMA(0, 0, At, B0); PG8_BAR; PG8_SCHED;
            PG8_LDB(B1, 0, 1); PG8_STAGE(PG8_SB(0, 0), b2, voffB);
            PG8_BAR; PG8_WAIT_L(0); PG8_MMA(0, 1, At, B1); PG8_BAR;
            PG8_LDA(At, 0, 1); PG8_STAGE(PG8_SA(0, 0), a2, voffA);
            PG8_BAR; PG8_WAIT_L(0); PG8_MMA(1, 0, At, B0); PG8_BAR; PG8_SCHED;
            PG8_STAGE(PG8_SB(0, 1), b2 + hstep, voffB);
            PG8_WAIT_V(6); PG8_BAR; PG8_MMA(1, 1, At, B1); PG8_BAR;
            PG8_LDB(B0, 1, 0); PG8_SCHED; PG8_LDA(At, 1, 0); PG8_STAGE(PG8_SA(0, 1), a2 + hstep, voffA);
            PG8_WAIT_L(8); PG8_BAR; PG8_WAIT_L(0); PG8_MMA(0, 0, At, B0); PG8_BAR; PG8_SCHED;
            PG8_LDB(B1, 1, 1); PG8_STAGE(PG8_SB(1, 0), b3, voffB);
            PG8_BAR; PG8_WAIT_L(0); PG8_MMA(0, 1, At, B1); PG8_BAR;
            PG8_LDA(At, 1, 1); PG8_STAGE(PG8_SA(1, 0), a3, voffA);
            PG8_BAR; PG8_WAIT_L(0); PG8_MMA(1, 0, At, B0); PG8_BAR; PG8_SCHED;
            PG8_STAGE(PG8_SB(1, 1), b3 + hstep, voffB);
            PG8_WAIT_V(6); PG8_BAR; PG8_MMA(1, 1, At, B1); PG8_BAR;
            }
        }
        if constexpr (ALIGN_EPI) { if (wr == 0) PG8_BAR; }
        if constexpr (!Epi::AFTER_DRAIN) { E(acc, cur, wr, wc, fr, fq); S.done(cur); }
        if (!has_next) break;
#pragma unroll
        for (int a = 0; a < 2; ++a)
#pragma unroll
            for (int b = 0; b < 2; ++b)
#pragma unroll
                for (int m = 0; m < 4; ++m)
#pragma unroll
                    for (int n = 0; n < 2; ++n) acc[a][b][m][n] = (f32x4){0.f, 0.f, 0.f, 0.f};
        cur = nxt; cA = nA; cB = nB; ++ui;
        if constexpr (ALIGN_EPI) { if (wr == 1) PG8_BAR; }
    }
    PG8_WAIT_V(0);
    if constexpr (!ALIGN_EPI) { if (wr == 0) PG8_BAR; }
    PG8_BAR;
    if constexpr (Epi::AFTER_DRAIN) { E.fused(acc, cur, wr, wc, fr, fq, lds, wid, lane); S.done(cur); }
#undef PG8_SA
#undef PG8_SB
#undef PG8_STAGE
#undef PG8_LDA
#undef PG8_LDB
#undef PG8_MMA
#undef PG8_WAIT_V
#undef PG8_WAIT_L
#undef PG8_BAR
#undef PG8_SCHED
}
}

__device__ __forceinline__ unsigned pkbf(float lo, float hi) { return pg8::cvt_pk_bf16(lo, hi); }
__device__ __forceinline__ void st8bf(bf16_t* p, f32x4 a, f32x4 b) { u32x4 w; w.x = pkbf(a[0], a[1]); w.y = pkbf(a[2], a[3]); w.z = pkbf(b[0], b[1]); w.w = pkbf(b[2], b[3]); *(u32x4*)p = w; }
__device__ __forceinline__ f32x4 bflo(u32x4 g) { f32x4 o; o[0] = __uint_as_float(g.x << 16); o[1] = __uint_as_float(g.x & 0xffff0000u); o[2] = __uint_as_float(g.y << 16); o[3] = __uint_as_float(g.y & 0xffff0000u); return o; }
__device__ __forceinline__ f32x4 bfhi(u32x4 g) { f32x4 o; o[0] = __uint_as_float(g.z << 16); o[1] = __uint_as_float(g.z & 0xffff0000u); o[2] = __uint_as_float(g.w << 16); o[3] = __uint_as_float(g.w & 0xffff0000u); return o; }
__device__ __forceinline__ f32x4 bf4(u32x2 g) { f32x4 o; o[0] = __uint_as_float(g.x << 16); o[1] = __uint_as_float(g.x & 0xffff0000u); o[2] = __uint_as_float(g.y << 16); o[3] = __uint_as_float(g.y & 0xffff0000u); return o; }
__device__ __forceinline__ void rot8(f32x4& a, f32x4& b, f32x4 c, f32x4 s) {
    const f32x4 x = a, y = b;
    a[0] = x[0] * c[0] - x[1] * s[0]; a[1] = x[1] * c[0] + x[0] * s[0]; a[2] = x[2] * c[1] - x[3] * s[1]; a[3] = x[3] * c[1] + x[2] * s[1];
    b[0] = y[0] * c[2] - y[1] * s[2]; b[1] = y[1] * c[2] + y[0] * s[2]; b[2] = y[2] * c[3] - y[3] * s[3]; b[3] = y[3] * c[3] + y[2] * s[3];
}
__device__ __forceinline__ f32x4 sig4(f32x4 v) { f32x4 o; o[0] = 1.f / (1.f + __expf(-v[0])); o[1] = 1.f / (1.f + __expf(-v[1])); o[2] = 1.f / (1.f + __expf(-v[2])); o[3] = 1.f / (1.f + __expf(-v[3])); return o; }
__host__ __device__ __forceinline__ int src_in(int n) {
    if (n < 1024) return n;
    if (n < 4096) { const int seg = (n - 1024) >> 10, c = (n - 1024) & 1023, d = c & 127; int od = d; if (seg < 2 && d < 32) od = (d >> 1) + (d & 1) * 16; return 1088 + seg * 1024 + (c & ~127) + od; }
    if (n < 5120) { const int c = n - 4096, d = c & 63; const int od = d < 16 ? (d >> 1) + (d & 1) * 8 : d; return 4160 + (c & ~63) + od; }
    if (n < 7168) return 5264 + (n - 5120);
    if (n < 9216) return 7312 + (n - 7168);
    if (n < 9280) { const int d = n - 9216; return 1024 + (d >> 1) + (d & 1) * 32; }
    if (n < 9344) { const int d = n - 9280; const int od = d < 16 ? (d >> 1) + (d & 1) * 8 : d; return 5184 + od; }
    if (n < 9360) return 5248 + (n - 9344);
    return -1;
}
__host__ __device__ __forceinline__ int src_qa(int n) { const int h = n / 192, d = n - h * 192; if (d < 128) return n; const int dd = d - 128; return h * 192 + 128 + (dd >> 1) + (dd & 1) * 32; }

struct EpiIn {
    static constexpr bool PERM = true, AFTER_DRAIN = false;
    unsigned char* ws;
    __device__ __forceinline__ void operator()(const f32x4 (&acc)[2][2][4][2], const pg8::Unit& u, int wr, int wc, int fr, int fq) const {
        const int row0 = u.pm * 256 + wr * 64 + fr, cu = wc * 32 + 8 * fq, pn = u.pn;
        bf16_t* const CQ = (bf16_t*)(ws + WS_CQ); bf16_t* const QB = (bf16_t*)(ws + WS_QB); bf16_t* const QI = (bf16_t*)(ws + WS_QI); bf16_t* const GA = (bf16_t*)(ws + WS_GA);
        bf16_t* const KA = (bf16_t*)(ws + WS_KA); bf16_t* const KI = (bf16_t*)(ws + WS_KI); float* const WI = (float*)(ws + WS_WI); float* const part = (float*)(ws + WS_SSQ);
        const float* const cM = (const float*)(ws + WS_ROPE); const float* const sM = cM + T * 32; const float* const cD = cM + T * 64; const float* const sD = cM + T * 80; const float* const cI = cM + T * 96; const float* const sI = cM + T * 104;
#define EPI_ROWS(BODY) _Pragma("unroll") for (int ai = 0; ai < 2; ++ai) _Pragma("unroll") for (int m = 0; m < 4; ++m) { const int t = row0 + ai * 128 + m * 16; \
            _Pragma("unroll") for (int bj = 0; bj < 2; ++bj) { f32x4 a = acc[ai][bj][m][0], b = acc[ai][bj][m][1]; BODY } }
        if (pn < 4) {
            bf16_t* const dst = CQ + (size_t)(pn >> 1) * ((size_t)T * 512) + (pn & 1) * 256 + cu;
            EPI_ROWS(
                st8bf(dst + (size_t)t * 512 + bj * 128, a, b);
                float sq = ((a[0] * a[0] + a[1] * a[1]) + (a[2] * a[2] + a[3] * a[3])) + ((b[0] * b[0] + b[1] * b[1]) + (b[2] * b[2] + b[3] * b[3]));
                sq += __shfl_xor(sq, 16); sq += __shfl_xor(sq, 32);
                if (fq == 0) part[(size_t)t * 32 + pn * 8 + bj * 4 + wc] = sq; )
        } else if (pn < 16) {
            const int seg = (pn - 4) >> 2; const bool rot = seg < 2 && wc == 0;
            bf16_t* const dst = QB + (size_t)seg * ((size_t)T * 1024) + ((pn - 4) & 3) * 256 + cu;
            EPI_ROWS(
                if (rot) rot8(a, b, *(const f32x4*)(cD + (size_t)t * 16 + 4 * fq), *(const f32x4*)(sD + (size_t)t * 16 + 4 * fq));
                st8bf(dst + (size_t)t * 1024 + bj * 128, a, b); )
        } else if (pn < 20) {
            const bool rot = (wc & 1) == 0 && fq < 2;
            bf16_t* const dst = QI + (size_t)(unsigned)((row0 >> 5) * 32768 + (row0 & 31) * 8 + (pn - 16) * 8192 + (cu >> 6) * 2048 + ((cu >> 4) & 3) * 512 + ((cu >> 3) & 1) * 256);
            EPI_ROWS(
                if (rot) rot8(a, b, *(const f32x4*)(cI + (size_t)t * 8 + 4 * fq), *(const f32x4*)(sI + (size_t)t * 8 + 4 * fq));
                st8bf(dst + (ai * 4 + (m >> 1)) * 32768 + (m & 1) * 128 + bj * 4096, a, b); )
        } else if (pn < 36) {
            bf16_t* const dst = GA + (size_t)((pn - 20) >> 3) * ((size_t)T * D) + ((pn - 20) & 7) * 256 + cu;
            EPI_ROWS( st8bf(dst + (size_t)t * D + bj * 128, sig4(a), sig4(b)); )
        } else {
            EPI_ROWS(
                if (bj == 0) {
                    if (wc < 2) {
                        rot8(a, b, *(const f32x4*)(cM + (size_t)t * 32 + (cu >> 1)), *(const f32x4*)(sM + (size_t)t * 32 + (cu >> 1)));
                        _Pragma("unroll") for (int h = 0; h < 8; ++h) st8bf(KA + (size_t)t * 1536 + h * 192 + 128 + cu, a, b);
                    } else {
                        const int d = cu - 64;
                        if (d < 16) rot8(a, b, *(const f32x4*)(cI + (size_t)t * 8 + (d >> 1)), *(const f32x4*)(sI + (size_t)t * 8 + (d >> 1)));
                        st8bf(KI + (size_t)t * 64 + d, a, b);
                    }
                } else if (cu < 16) {
                    *(f32x4*)(WI + (size_t)t * 16 + cu) = a * 0.03125f; *(f32x4*)(WI + (size_t)t * 16 + cu + 4) = b * 0.03125f;
                } )
        }
#undef EPI_ROWS
    }
};
__device__ __forceinline__ float rms_from_part(const float* pp) {
    const f32x4 p0 = *(const f32x4*)pp, p1 = *(const f32x4*)(pp + 4), p2 = *(const f32x4*)(pp + 8), p3 = *(const f32x4*)(pp + 12);
    const float s = (((p0[0] + p0[1]) + (p0[2] + p0[3])) + ((p1[0] + p1[1]) + (p1[2] + p1[3]))) + (((p2[0] + p2[1]) + (p2[2] + p2[3])) + ((p3[0] + p3[1]) + (p3[2] + p3[3])));
    return rsqrtf(s * (1.f / 512.f) + 1e-6f);
}
struct EpiQA {
    static constexpr bool PERM = true, AFTER_DRAIN = false;
    unsigned char* ws;
    __device__ __forceinline__ void operator()(const f32x4 (&acc)[2][2][4][2], const pg8::Unit& u, int wr, int wc, int fr, int fq) const {
        const int row0 = u.pm * 256 + wr * 64 + fr, cu = wc * 32 + 8 * fq;
        bf16_t* const QA = (bf16_t*)(ws + WS_QA); const float* const part = (const float*)(ws + WS_SSQ); const float* const cM = (const float*)(ws + WS_ROPE); const float* const sM = cM + T * 32;
#pragma unroll
        for (int ai = 0; ai < 2; ++ai)
#pragma unroll
            for (int m = 0; m < 4; ++m) {
                const int t = row0 + ai * 128 + m * 16;
                const float r = rms_from_part(part + (size_t)t * 32);
#pragma unroll
                for (int bj = 0; bj < 2; ++bj) {
                    const int n = u.pn * 256 + bj * 128 + cu, h = n / 192, d = n - h * 192;
                    f32x4 a = acc[ai][bj][m][0] * r, b = acc[ai][bj][m][1] * r;
                    if (d >= 128) rot8(a, b, *(const f32x4*)(cM + (size_t)t * 32 + ((d - 128) >> 1)), *(const f32x4*)(sM + (size_t)t * 32 + ((d - 128) >> 1)));
                    st8bf(QA + (size_t)t * 1536 + n, a, b);
                }
            }
    }
};
struct EpiKV {
    static constexpr bool PERM = true, AFTER_DRAIN = false;
    unsigned char* ws;
    __device__ __forceinline__ void operator()(const f32x4 (&acc)[2][2][4][2], const pg8::Unit& u, int wr, int wc, int fr, int fq) const {
        const int row0 = u.pm * 256 + wr * 64 + fr, cu = wc * 32 + 8 * fq;
        bf16_t* const KA = (bf16_t*)(ws + WS_KA); bf16_t* const VA = (bf16_t*)(ws + WS_VA); const float* const part = (const float*)(ws + WS_SSQ);
#pragma unroll
        for (int ai = 0; ai < 2; ++ai)
#pragma unroll
            for (int m = 0; m < 4; ++m) {
                const int t = row0 + ai * 128 + m * 16;
                const float r = rms_from_part(part + (size_t)t * 32 + 16);
                st8bf(KA + (size_t)t * 1536 + u.pn * 192 + cu, acc[ai][0][m][0] * r, acc[ai][0][m][1] * r);
                st8bf(VA + (size_t)t * 1024 + u.pn * 128 + cu, acc[ai][1][m][0] * r, acc[ai][1][m][1] * r);
            }
    }
};
struct EpiYA {
    static constexpr bool PERM = true, AFTER_DRAIN = false;
    unsigned char* ws;
    __device__ __forceinline__ void operator()(const f32x4 (&acc)[2][2][4][2], const pg8::Unit& u, int wr, int wc, int fr, int fq) const {
        const int row0 = u.pm * 256 + wr * 64 + fr, col0 = u.pn * 256 + wc * 32 + 8 * fq;
        bf16_t* const YT = (bf16_t*)(ws + WS_YT); const bf16_t* const GA = (const bf16_t*)(ws + WS_GA);
#pragma unroll
        for (int ai = 0; ai < 2; ++ai)
#pragma unroll
            for (int m = 0; m < 4; ++m)
#pragma unroll
                for (int bj = 0; bj < 2; ++bj) {
                    const size_t o = (size_t)(row0 + ai * 128 + m * 16) * D + col0 + bj * 128;
                    const u32x4 g = *(const u32x4*)(GA + o);
                    st8bf(YT + o, acc[ai][bj][m][0] * bflo(g), acc[ai][bj][m][1] * bfhi(g));
                }
    }
};
struct EpiYB {
    static constexpr bool PERM = true, AFTER_DRAIN = false;
    unsigned char* ws;
    __device__ __forceinline__ void operator()(const f32x4 (&acc)[2][2][4][2], const pg8::Unit& u, int wr, int wc, int fr, int fq) const {
        const int row0 = u.pm * 256 + wr * 64 + fr, col0 = u.pn * 256 + wc * 32 + 8 * fq;
        const bf16_t* const YT = (const bf16_t*)(ws + WS_YT); const bf16_t* const GB = (const bf16_t*)(ws + WS_GB); bf16_t* const Y = (bf16_t*)(ws + WS_Y);
#pragma unroll
        for (int ai = 0; ai < 2; ++ai)
#pragma unroll
            for (int m = 0; m < 4; ++m)
#pragma unroll
                for (int bj = 0; bj < 2; ++bj) {
                    const size_t o = (size_t)(row0 + ai * 128 + m * 16) * D + col0 + bj * 128;
                    const u32x4 g = *(const u32x4*)(GB + o);
                    const u32x4 yt = *(const u32x4*)(YT + o); const f32x4 y0 = bflo(yt), y1 = bfhi(yt);
                    st8bf(Y + o, y0 + acc[ai][bj][m][0] * bflo(g), y1 + acc[ai][bj][m][1] * bfhi(g));
                }
    }
};
struct EpiOut {
    static constexpr bool PERM = true, AFTER_DRAIN = false;
    const float* hin; float* V1;
    __device__ __forceinline__ void operator()(const f32x4 (&acc)[2][2][4][2], const pg8::Unit& u, int wr, int wc, int fr, int fq) const {
        const int row0 = u.pm * 256 + wr * 64 + fr, col0 = u.pn * 256 + wc * 32 + 8 * fq;
#pragma unroll
        for (int ai = 0; ai < 2; ++ai)
#pragma unroll
            for (int m = 0; m < 4; ++m)
#pragma unroll
                for (int bj = 0; bj < 2; ++bj) {
                    const size_t o = (size_t)(row0 + ai * 128 + m * 16) * D + col0 + bj * 128;
                    const f32x4 h0 = *(const f32x4*)(hin + o), h1 = *(const f32x4*)(hin + o + 4);
                    *(f32x4*)(V1 + o) = h0 * ALPHA + acc[ai][bj][m][0]; *(f32x4*)(V1 + o + 4) = h1 * ALPHA + acc[ai][bj][m][1];
                }
    }
};

#define LDS_WAIT() asm volatile("s_waitcnt lgkmcnt(0)" ::: "memory")
__device__ __forceinline__ void transpose_item(int MAP, const float* W, int ldw, int K, int N, const float* kscale, bf16_t* WT, LAS float* scr, int item, int lane) {
    const int nblk = N / 32, kb = item / nblk, nb = item % nblk, k0 = 64 * kb, n0 = 32 * nb;
    const int n = n0 + (lane & 31);
    const int sc = MAP == 0 ? n : (MAP == 1 ? src_in(n) : src_qa(n));
#pragma unroll 8
    for (int i = 0; i < 32; ++i) { const int kk = 2 * i + (lane >> 5);
        float v = sc >= 0 ? W[(size_t)(k0 + kk) * ldw + sc] : 0.f; if (kscale) v *= kscale[k0 + kk];
        scr[kk * 33 + (lane & 31)] = v; }
    LDS_WAIT(); asm volatile("" ::: "memory");
    const int c = lane & 7;
#pragma unroll
    for (int j = 0; j < 4; ++j) { const int nn = (lane >> 3) + 8 * j; const LAS float* sp = scr + (8 * c) * 33 + nn;
        u32x4 o; o.x = pkbf(sp[0 * 33], sp[1 * 33]); o.y = pkbf(sp[2 * 33], sp[3 * 33]); o.z = pkbf(sp[4 * 33], sp[5 * 33]); o.w = pkbf(sp[6 * 33], sp[7 * 33]);
        *(u32x4*)(WT + (size_t)(n0 + nn) * K + k0 + 8 * c) = o; }
    LDS_WAIT(); asm volatile("" ::: "memory");
}
__device__ __forceinline__ int tperm(int pm, int nn) {
    if (pm == 0) return nn;
    if (pm == 1) return nn < 32 ? (nn >> 1) + (nn & 1) * 16 : nn;
    if (pm == 2) return nn < 16 ? (nn >> 1) + (nn & 1) * 8 : nn;
    if (pm == 3) return (nn >> 1) + (nn & 1) * 32;
    if (pm == 4) return nn < 16 ? nn : -1;
    return -1;
}
__device__ __forceinline__ void transpose_block_vec(const float* W, int ldw, int K, int s0, int pm, int n0, int k0, const float* kscale, bf16_t* WT, LAS float* scr, int lane) {
    const int r = lane >> 4, c4 = lane & 15;
    f32x4 v[16];
#pragma unroll
    for (int i = 0; i < 16; ++i) v[i] = *(const f32x4*)(W + (size_t)(k0 + 4 * i + r) * ldw + s0 + 4 * c4);
    float ks[16];
#pragma unroll
    for (int i = 0; i < 16; ++i) ks[i] = kscale ? kscale[k0 + 4 * i + r] : 1.f;
#pragma unroll
    for (int i = 0; i < 16; ++i) { const int kk = 4 * i + r; const f32x4 w = v[i] * ks[i];
        LAS float* d = scr + kk * 65 + 4 * c4; d[0] = w[0]; d[1] = w[1]; d[2] = w[2]; d[3] = w[3]; }
    LDS_WAIT(); asm volatile("" ::: "memory");
    const int c = lane & 7;
#pragma unroll
    for (int j = 0; j < 8; ++j) { const int nn = (lane >> 3) + 8 * j, so = tperm(pm, nn); const LAS float* sp = scr + (8 * c) * 65 + (so < 0 ? 0 : so);
        u32x4 o; o.x = pkbf(sp[0 * 65], sp[1 * 65]); o.y = pkbf(sp[2 * 65], sp[3 * 65]); o.z = pkbf(sp[4 * 65], sp[5 * 65]); o.w = pkbf(sp[6 * 65], sp[7 * 65]);
        if (so < 0) o = (u32x4){0u, 0u, 0u, 0u};
        *(u32x4*)(WT + (size_t)(n0 + nn) * K + k0 + 8 * c) = o; }
    LDS_WAIT(); asm volatile("" ::: "memory");
}
__device__ __forceinline__ void p_wcopies(LAS unsigned char* ldsb, const Params& p, const int l1, const int lo1, const int hi1, const int l2, const int lo2, const int hi2, const int rank, const int nranks) {
    const int tid_ = opaque_tid(), wave = tid_ >> 6, lane = tid_ & 63;
    LAS float* scr = (LAS float*)(ldsb + wave * 16640);
    const int gw = rank * 8 + wave, NGW = nranks * 8;
    constexpr int B_IN = (D / 64) * (INP / 64), B_QB = (512 / 64) * (1536 / 64), B_KV = (512 / 64) * (2048 / 64), B_O = (1024 / 64) * (D / 64), B_OUT = (D / 64) * (D / 64);
    constexpr int B_LAYER = B_IN + B_QB + B_KV + 2 * B_O + B_OUT;
    const int n1 = hi1 - lo1, ntot = n1 + (hi2 - lo2);
    for (int it = gw; it < ntot; it += NGW) {
        const int l = it < n1 ? l1 : l2; int r = it < n1 ? lo1 + it : lo2 + (it - n1);
        int map = 0, ldw, K, N; const float* W; const float* ks = nullptr; bf16_t* WT;
        if (r < B_IN) { map = 1; W = p.w_in + (size_t)l * D * INW; ldw = INW; K = D; N = INP; WT = (bf16_t*)(p.ws + WS_WIN_T) + (size_t)l * INP * D; }
        else if ((r -= B_IN) < B_QB) { map = 2; W = p.w_qb + (size_t)l * 512 * 1536; ldw = 1536; K = 512; N = 1536; ks = p.g_q + l * 512; WT = (bf16_t*)(p.ws + WS_WQB_T) + (size_t)l * 1536 * 512; }
        else if ((r -= B_QB) < B_KV) { W = p.w_kvb + (size_t)l * 512 * 2048; ldw = 2048; K = 512; N = 2048; ks = p.g_kv + l * 512; WT = (bf16_t*)(p.ws + WS_WKVB_T) + (size_t)l * 2048 * 512; }
        else if ((r -= B_KV) < B_O) { W = p.w_oa + (size_t)l * 1024 * D; ldw = D; K = 1024; N = D; WT = (bf16_t*)(p.ws + WS_WOA_T) + (size_t)l * D * 1024; }
        else if ((r -= B_O) < B_O) { W = p.w_ob + (size_t)l * 1024 * D; ldw = D; K = 1024; N = D; WT = (bf16_t*)(p.ws + WS_WOB_T) + (size_t)l * D * 1024; }
        else { r -= B_O; W = p.w_out + (size_t)l * D * D; ldw = D; K = D; N = D; WT = (bf16_t*)(p.ws + WS_WOUT_T) + (size_t)l * D * D; }
        const int nb64 = N / 64, kb = r / nb64, nb = r - kb * nb64, n0 = 64 * nb, k0 = 64 * kb;
        int s0 = n0, pm = 0;
        if (map == 1) { s0 = src_in(n0);
            if (n0 >= 1024 && n0 < 3072 && !(n0 & 64)) pm = 1; else if (n0 >= 4096 && n0 < 5120) pm = 2; else if (n0 == 9216) pm = 3; else if (n0 == 9280) pm = 2; else if (n0 == 9344) pm = 4; else if (n0 >= 9408) { pm = 5; s0 = 0; } }
        else if (map == 2) { s0 = src_qa(n0); if ((n0 % 192) == 128) pm = 3; }
        transpose_block_vec(W, ldw, K, s0, pm, n0, k0, ks, WT, scr, lane);
    }
    __syncthreads();
}
__device__ __forceinline__ void p_prologue(LAS unsigned char* ldsb, const Params& p, const int parts = 31) {
    float* rope = (float*)(p.ws + WS_ROPE);
    float *cM = rope, *sM = rope + T * 32, *cD = rope + T * 64, *sD = rope + T * 80, *cI = rope + T * 96, *sI = rope + T * 104;
    const int gtid = opaque_bid() * NTHREADS + threadIdx.x, gstride = gridDim.x * NTHREADS;
    if (parts & 1) for (int idx = gtid; idx < T * 56; idx += gstride) {
        const int t = idx / 56, j = idx - t * 56;
        int rot, i; float *ct, *st; int w;
        if (j < 32) { rot = 64; i = j; ct = cM; st = sM; w = 32; } else if (j < 48) { rot = 32; i = j - 32; ct = cD; st = sD; w = 16; } else { rot = 16; i = j - 48; ct = cI; st = sI; w = 8; }
        const float inv = exp2f(-((float)(2 * i) / (float)rot) * 18.931568569324174f);
        const float ang = (float)p.pos[t] * inv;
        double rev = (double)ang * 0.15915494309189535; rev -= rint(rev);
        const float r = (float)(rev * 6.283185307179586);
        ct[t * w + i] = __cosf(r); st[t * w + i] = __sinf(r);
    }
    bf16_t* XB = (bf16_t*)(p.ws + WS_XB);
    if (parts & 2) for (size_t i = (size_t)gtid * 4; i < (size_t)T * D; i += (size_t)gstride * 32) {
        f32x4 a[8];
#pragma unroll
        for (int u = 0; u < 8; ++u) { const size_t iu = i + (size_t)u * gstride * 4; a[u] = iu < (size_t)T * D ? *(const f32x4*)(p.x + iu) : (f32x4){0.f, 0.f, 0.f, 0.f}; }
#pragma unroll
        for (int u = 0; u < 8; ++u) { const size_t iu = i + (size_t)u * gstride * 4; if (iu < (size_t)T * D) st4bf(XB + iu, a[u]); } }
    if (parts & 4) { float* SEC = (float*)(p.ws + WS_SEC);
      { bf16_t* RWH = (bf16_t*)(p.ws + WS_RWH); bf16_t* RWL = (bf16_t*)(p.ws + WS_RWL);
        for (int idx = gtid; idx < DEPTH * 96 * D; idx += gstride) { const int l = idx / (96 * D), r = idx - l * (96 * D), e = r / D, k = r - e * D;
            float w = 0.f; if (e < 64) w = p.ln1g[l * D + k] * p.w_router[((size_t)l * D + k) * 64 + e]; else if (e < 72) w = p.ln1g[l * D + k] * p.w_group[((size_t)l * D + k) * 8 + (e - 64)];
            const size_t fo = (size_t)l * (96 * D) + (size_t)((((k >> 8) * 16 + ((k >> 4) & 15)) * 3 + (e >> 5)) * 2 + ((k >> 3) & 1)) * 256 + (e & 31) * 8 + (k & 7);
            const bf16_t h = f2bf(w); RWH[fo] = h; RWL[fo] = f2bf(w - bf2f(h)); } }
      { const int wave_ = threadIdx.x >> 6, lane_ = threadIdx.x & 63, gwv = opaque_bid() * 8 + wave_;
        if (gwv < DEPTH * 72) { const int l = gwv / 72, e = gwv - l * 72; float sa = 0.f, ca = 0.f;
#pragma unroll 4
          for (int i = 0; i < D / 64; ++i) { const int k = lane_ + 64 * i; const float w = e < 64 ? p.w_router[((size_t)l * D + k) * 64 + e] : p.w_group[((size_t)l * D + k) * 8 + (e - 64)]; sa = fmaf(p.ln1g[l * D + k], w, sa); ca = fmaf(p.ln1b[l * D + k], w, ca); }
          sa = wave_sum(sa); ca = wave_sum(ca);
          if (lane_ == 0) { SEC[l * 160 + e] = sa; SEC[l * 160 + 80 + e] = ca + (e < 64 ? p.b_router[l * 64 + e] : p.b_group[l * 8 + (e - 64)]); } } } }
    __syncthreads();
}

__device__ __forceinline__ unsigned f2key(float f) { const unsigned u = __float_as_uint(f); return (u & 0x80000000u) ? ~u : (u | 0x80000000u); }
typedef short bf16x8 __attribute__((ext_vector_type(8)));
typedef short s16x4 __attribute__((ext_vector_type(4)));
typedef float f32x16 __attribute__((ext_vector_type(16)));
__device__ __forceinline__ void p_score(LAS unsigned char* ldsb, unsigned char* ws) {
    const bf16_t* QI = (const bf16_t*)(ws + WS_QI); const bf16_t* KI = (const bf16_t*)(ws + WS_KI); const float* WI = (const float*)(ws + WS_WI);
    unsigned* SC = (unsigned*)(ws + WS_SCORE);
    const int tid = opaque_tid(), lane = tid & 63, wv = __builtin_amdgcn_readfirstlane(tid >> 6), r32 = lane & 31, hi = lane >> 5;
    const int ksw = ((r32 >> 1) & 7) ^ hi;
    const unsigned krow = (unsigned)(size_t)ldsb + (unsigned)r32 * 128u;
    const int G_ = gridDim.x, bid_ = opaque_bid();
    const int nit_ = (G_ == 256) ? 3 : (544 - bid_ + G_ - 1) / G_;
    for (int it_ = 0; it_ < nit_; ++it_) {
        int item = bid_ + G_ * it_;
        if (G_ == 256 && it_ == 2) item = (bid_ >= 192 && bid_ < 224) ? 512 + (bid_ - 192) : 544;
        if (item >= 544) continue;
        const int b = item / 272; int r = item - b * 272, qb = 0;
        while (r >= 2 * qb + 2) { r -= 2 * qb + 2; ++qb; }
        const int kc = r, q0 = qb * 256 + wv * 32;
        __builtin_amdgcn_s_barrier();
#pragma unroll
        for (int i = 0; i < 2; ++i) { const int g = i * 512 + tid, row = g >> 3, ch = (g & 7) ^ ((row >> 1) & 7);
            __builtin_amdgcn_global_load_lds((const unsigned*)(KI + (size_t)(b * S + kc * 128 + row) * 64 + ch * 8), (LAS unsigned*)(ldsb + (i * 512 + wv * 64) * 16), 16, 0, 0); }
        asm volatile("s_waitcnt vmcnt(0)" ::: "memory");
        __builtin_amdgcn_s_barrier();
        if (kc * 128 <= q0 + 31) {
            const size_t t = (size_t)b * S + q0 + r32;
            bf16x8 ka[4][4];
#pragma unroll
            for (int kb = 0; kb < 4; ++kb)
#pragma unroll
                for (int d0 = 0; d0 < 4; ++d0) ka[kb][d0] = *(const LAS bf16x8*)(size_t)(krow + kb * 4096 + ((unsigned)((2 * d0) ^ ksw) << 4));
            f32x16 acc[4];
#pragma unroll
            for (int kb = 0; kb < 4; ++kb)
#pragma unroll
                for (int rr = 0; rr < 16; ++rr) acc[kb][rr] = 0.f;
            const bf16_t* qrow = QI + (t >> 5) * 32768 + hi * 256 + r32 * 8; const float* wrow = WI + t * 16;
            bf16x8 qa0, qa1, qa2, qa3, qc0, qc1, qc2, qc3; float wa, wc_;
#define SC_LOAD(Q0, Q1, Q2, Q3, W, h_) do { const bf16_t* p_ = qrow + (h_) * 2048; const float* w_ = wrow + (h_); \
                asm volatile("global_load_dwordx4 %0, %1, off" : "=v"(Q0) : "v"(p_) : "memory"); asm volatile("global_load_dwordx4 %0, %1, off offset:1024" : "=v"(Q1) : "v"(p_) : "memory"); \
                asm volatile("global_load_dwordx4 %0, %1, off offset:2048" : "=v"(Q2) : "v"(p_) : "memory"); asm volatile("global_load_dwordx4 %0, %1, off offset:3072" : "=v"(Q3) : "v"(p_) : "memory"); \
                asm volatile("global_load_dword %0, %1, off" : "=v"(W) : "v"(w_) : "memory"); } while (0)
#define SC_WAIT(n_) asm volatile("s_waitcnt vmcnt(" #n_ ")" : "+v"(qa0), "+v"(qa1), "+v"(qa2), "+v"(qa3), "+v"(wa), "+v"(qc0), "+v"(qc1), "+v"(qc2), "+v"(qc3), "+v"(wc_) :: "memory")
#define SC_CHAIN(PZ, kb_, Q0, Q1, Q2, Q3) do { _Pragma("unroll") for (int rr = 0; rr < 16; ++rr) PZ[rr] = 0.f; \
                PZ = __builtin_amdgcn_mfma_f32_32x32x16_bf16(ka[kb_][0], Q0, PZ, 0, 0, 0); PZ = __builtin_amdgcn_mfma_f32_32x32x16_bf16(ka[kb_][1], Q1, PZ, 0, 0, 0); \
                PZ = __builtin_amdgcn_mfma_f32_32x32x16_bf16(ka[kb_][2], Q2, PZ, 0, 0, 0); PZ = __builtin_amdgcn_mfma_f32_32x32x16_bf16(ka[kb_][3], Q3, PZ, 0, 0, 0); } while (0)
#define SC_ACC(PZ, kb_, W) do { _Pragma("unroll") for (int rr = 0; rr < 16; ++rr) { const float rl = __int_as_float(max(__float_as_int(PZ[rr]), 0)); \
                float av = acc[kb_][rr]; asm("v_fmac_f32 %0, %1, %2" : "+v"(av) : "v"(W), "v"(rl)); acc[kb_][rr] = av; } } while (0)
#define SC_HEAD(Q0, Q1, Q2, Q3, W) do { f32x16 pzA, pzB; SC_CHAIN(pzA, 0, Q0, Q1, Q2, Q3); SC_CHAIN(pzB, 1, Q0, Q1, Q2, Q3); SC_ACC(pzA, 0, W); SC_CHAIN(pzA, 2, Q0, Q1, Q2, Q3); SC_ACC(pzB, 1, W); \
                SC_CHAIN(pzB, 3, Q0, Q1, Q2, Q3); SC_ACC(pzA, 2, W); SC_ACC(pzB, 3, W); } while (0)
            SC_LOAD(qa0, qa1, qa2, qa3, wa, 0);
#pragma unroll 1
            for (int h = 0; h < 16; h += 2) {
                SC_LOAD(qc0, qc1, qc2, qc3, wc_, h + 1);
                SC_WAIT(5);
                SC_HEAD(qa0, qa1, qa2, qa3, wa);
                SC_LOAD(qa0, qa1, qa2, qa3, wa, (h + 2) & 15);
                SC_WAIT(5);
                SC_HEAD(qc0, qc1, qc2, qc3, wc_);
            }
            SC_WAIT(0);
#undef SC_LOAD
#undef SC_WAIT
#undef SC_CHAIN
#undef SC_ACC
#undef SC_HEAD
            const int dq = q0 + r32 - kc * 128 - 4 * hi;
            unsigned* srow = SC + t * 4096 + kc * 128 + 4 * hi;
#pragma unroll
            for (int kb = 0; kb < 4; ++kb)
#pragma unroll
                for (int rq = 0; rq < 4; ++rq) { u32x4 o; const int c0 = 32 * kb + 8 * rq;
                    o.x = (c0 <= dq) ? f2key(acc[kb][4 * rq]) : 0u; o.y = (c0 + 1 <= dq) ? f2key(acc[kb][4 * rq + 1]) : 0u;
                    o.z = (c0 + 2 <= dq) ? f2key(acc[kb][4 * rq + 2]) : 0u; o.w = (c0 + 3 <= dq) ? f2key(acc[kb][4 * rq + 3]) : 0u;
                    *(u32x4*)(srow + c0) = o; }
        }
    }
    __builtin_amdgcn_s_barrier();
}
__device__ __forceinline__ int wave_sum_dpp(int x) {
    x += __builtin_amdgcn_update_dpp(0, x, 0x111, 0xf, 0xf, true);
    x += __builtin_amdgcn_update_dpp(0, x, 0x112, 0xf, 0xf, true);
    x += __builtin_amdgcn_update_dpp(0, x, 0x114, 0xf, 0xf, true);
    x += __builtin_amdgcn_update_dpp(0, x, 0x118, 0xf, 0xf, true);
    x += __builtin_amdgcn_update_dpp(0, x, 0x142, 0xa, 0xf, false);
    x += __builtin_amdgcn_update_dpp(0, x, 0x143, 0xc, 0xf, false);
    return __builtin_amdgcn_readlane(x, 63);
}
__device__ __forceinline__ void p_select(unsigned char* ws) {
    const unsigned* SC = (const unsigned*)(ws + WS_SCORE); unsigned* MASK = (unsigned*)(ws + WS_MASK);
    const int tid = opaque_tid(), lane = tid & 63, wv = __builtin_amdgcn_readfirstlane(tid >> 6);
    const unsigned voff = (unsigned)lane * 16u;
#define SEL_LOAD(KK, t_) do { const int nq_ = ((((t_) & 4095)) >> 8) + 1; const unsigned char* rb_ = (const unsigned char*)(SC + (size_t)(t_) * 4096); \
        _Pragma("unroll") for (int j = 0; j < 16; ++j) { const unsigned char* a_ = rb_ + 1024 * (j < nq_ ? j : nq_ - 1); asm volatile("global_load_dwordx4 %0, %1, %2" : "=v"(KK[j]) : "v"(voff), "s"(a_) : "memory"); } } while (0)
#define SEL_WAIT(KK) asm volatile("s_waitcnt vmcnt(0)" : "+v"(KK[0]), "+v"(KK[1]), "+v"(KK[2]), "+v"(KK[3]), "+v"(KK[4]), "+v"(KK[5]), "+v"(KK[6]), "+v"(KK[7]), "+v"(KK[8]), "+v"(KK[9]), "+v"(KK[10]), "+v"(KK[11]), \
        "+v"(KK[12]), "+v"(KK[13]), "+v"(KK[14]), "+v"(KK[15]) :: "memory")
    u32x4 ka[16], kb[16];
    const int nwaves = gridDim.x * 8, wid_ = opaque_bid() * 8 + wv; const bool paired = nwaves * 4 == T;
    const int nrows = paired ? 4 : (wid_ < T ? (T - wid_ + nwaves - 1) / nwaves : 0);
#define SEL_ROW(i_) (paired ? ((((i_) >> 1) << 12) + (((i_) & 1) ? 4095 - wid_ : wid_)) : wid_ + (i_) * nwaves)
#define SW(K, i_) K[(i_) >> 2][(i_) & 3]
#define SEL_XT(x_, s_, m_) do { const unsigned y_ = (unsigned)__shfl_xor((int)(x_), (s_)); x_ = (lane & (s_)) ? (((x_) & (m_)) | ((y_ & (m_)) >> (4 * (s_)))) : (((x_) & ~(m_)) | ((y_ & ~(m_)) << (4 * (s_)))); } while (0)
#define SEL_TS(K, B0, J, M) _Pragma("unroll") for (int k_ = 0; k_ < 32; ++k_) if (!(k_ & (J))) { const unsigned a_ = SW(K, (B0) + k_), b_ = SW(K, (B0) + k_ + (J)); \
        SW(K, (B0) + k_) = (a_ & (M)) | ((b_ << (J)) & ~(M)); SW(K, (B0) + k_ + (J)) = ((a_ >> (J)) & (M)) | (b_ & ~(M)); }
#define SEL_BODY(K, KN, ri_) do { \
        const int t = SEL_ROW(ri_); \
        const int ti = t & 4095, nq = (ti >> 8) + 1; \
        SEL_LOAD(KN, SEL_ROW((ri_) + 1 < nrows ? (ri_) + 1 : (ri_)));        \
          \
        const int jq = ti >> 8; int nvp = (ti & 255) - 4 * lane + 1; nvp = nvp < 0 ? 0 : (nvp > 4 ? 4 : nvp); const unsigned pn = (1u << nvp) - 1u; \
        const unsigned vb0 = jq >= 8 ? 0xffffffffu : (((1u << (4 * jq)) - 1u) | (pn << (4 * jq))), vb1 = jq >= 8 ? (((1u << (4 * (jq - 8))) - 1u) | (pn << (4 * (jq - 8)))) : 0u; \
          \
          \
          \
        unsigned sel0, sel1 = 0u; \
        if (ti >= 256) { \
            SEL_TS(K, 0, 16, 0x0000ffffu); SEL_TS(K, 0, 8, 0x00ff00ffu); SEL_TS(K, 0, 4, 0x0f0f0f0fu); SEL_TS(K, 0, 2, 0x33333333u); SEL_TS(K, 0, 1, 0x55555555u); \
            if (nq > 8) { SEL_TS(K, 32, 16, 0x0000ffffu); SEL_TS(K, 32, 8, 0x00ff00ffu); SEL_TS(K, 32, 4, 0x0f0f0f0fu); SEL_TS(K, 32, 2, 0x33333333u); SEL_TS(K, 32, 1, 0x55555555u); }     \
            unsigned gt0 = 0u, gt1 = 0u, eq0 = vb0, eq1 = vb1; int tgt = 0; bool found = false; \
            _Pragma("unroll") for (int bit = 31; bit >= 0; --bit) if (!found) {        \
                const unsigned t0 = eq0 & SW(K, bit), t1 = eq1 & SW(K, 32 + bit); \
                const unsigned c = (unsigned)__popc(t0) + (unsigned)__popc(t1);            \
                const int tot = tgt + wave_sum_dpp((int)c); \
                if (tot >= 256) { eq0 = t0; eq1 = t1;                   \
                    if (tot == 256) { sel0 = gt0 | t0; sel1 = gt1 | t1; found = true; } }        \
                else { gt0 |= t0; gt1 |= t1; eq0 ^= t0; eq1 ^= t1; tgt = tot; } \
            } \
            if (!found) { sel0 = gt0 | eq0; sel1 = gt1 | eq1; }        \
        } else sel0 = vb0;                                                \
        SEL_WAIT(KN); \
          \
        SEL_XT(sel0, 1, 0xf0f0f0f0u); SEL_XT(sel0, 2, 0xff00ff00u); SEL_XT(sel0, 4, 0xffff0000u); SEL_XT(sel1, 1, 0xf0f0f0f0u); SEL_XT(sel1, 2, 0xff00ff00u); SEL_XT(sel1, 4, 0xffff0000u); \
        unsigned* mrow = MASK + (size_t)t * 128 + 8 * (lane & 7) + (lane >> 3);        \
        mrow[0] = sel0; mrow[64] = sel1; } while (0)
    if (nrows > 0) { SEL_LOAD(ka, SEL_ROW(0)); SEL_WAIT(ka); }
#pragma unroll 1
    for (int ri = 0; ri < nrows; ri += 2) {
        SEL_BODY(ka, kb, ri);
        if (ri + 1 < nrows) SEL_BODY(kb, ka, ri + 1);
    }
#undef SEL_BODY
#undef SEL_TS
#undef SEL_XT
#undef SW
#undef SEL_ROW
#undef SEL_LOAD
#undef SEL_WAIT
}

template <int DQK, bool MASKED, int AMODE = 0>
__device__ __forceinline__ void attn_unit(LAS unsigned char* ldsb, const bf16_t* Qg, int ldq, const bf16_t* Kg, int ldk, const bf16_t* Vg, int ldv, const unsigned* maskg, bf16_t* Og, int ldo, int qb, float sl2) {
    constexpr int CPR = DQK / 8, KBYTES = 64 * DQK * 2, VBYTES = 64 * 128 * 2, NKI = CPR * 64 / 512, ND = DQK / 16;
    constexpr int STAGE = KBYTES + VBYTES;
    static_assert(NKI + 2 + (MASKED ? 1 : 0) == 5, "five vector-memory operations per thread and tile in both instantiations");
    const int tid = opaque_tid(), lane = tid & 63, wv = __builtin_amdgcn_readfirstlane(tid >> 6), r32 = lane & 31, hi = lane >> 5;
    const int NT = 4 * qb + 4, NT3 = ((NT + 2) / 3) * 3, q0 = qb * 256 + wv * 32;
    const float NEG = -__builtin_inff();
    bf16x8 qr[ND];
#pragma unroll
    for (int d0 = 0; d0 < ND; ++d0) qr[d0] = *(const bf16x8*)(Qg + (size_t)(q0 + r32) * ldq + 16 * d0 + 8 * hi);
    const bf16_t* ksrc[NKI]; const bf16_t* vsrc[2];
#pragma unroll
    for (int i = 0; i < NKI; ++i) { const int g = i * 512 + tid, row = g / CPR, cp = g - row * CPR; const int ch = cp ^ (DQK == 128 ? (row & 15) : ((row >> 1) & 7)); ksrc[i] = Kg + (size_t)row * ldk + ch * 8; }
#pragma unroll
    for (int i = 0; i < 2; ++i) { const int g = i * 512 + tid, row = g >> 4, c16 = g & 15; const int blk = (c16 >> 2) ^ (row & 3); vsrc[i] = Vg + (size_t)row * ldv + (blk * 4 + (c16 & 3)) * 8; }
    const unsigned* mrow = MASKED ? maskg + (size_t)(q0 + r32) * 128 : nullptr;
    u32x2 mw0 = {0u, 0u}, mw1 = {0u, 0u}, mw2 = {0u, 0u};
#define AT_ISSUE(MW, t_, st_) do { const int tt_ = (t_) < NT ? (t_) : NT - 1; \
        if (MASKED) asm volatile("global_load_dwordx2 %0, %1, off" : "=v"(MW) : "v"(mrow + 2 * tt_) : "memory"); \
        _Pragma("unroll") for (int i_ = 0; i_ < NKI; ++i_) __builtin_amdgcn_global_load_lds((const unsigned*)(ksrc[i_] + (size_t)tt_ * 64 * ldk), (LAS unsigned*)(ldsb + (st_) * STAGE + (i_ * 512 + wv * 64) * 16), 16, 0, 0); \
        _Pragma("unroll") for (int i_ = 0; i_ < 2; ++i_) __builtin_amdgcn_global_load_lds((const unsigned*)(vsrc[i_] + (size_t)tt_ * 64 * ldv), (LAS unsigned*)(ldsb + (st_) * STAGE + KBYTES + (i_ * 512 + wv * 64) * 16), 16, 0, 0); } while (0)
#define AT_WAIT(n_) asm volatile("s_waitcnt vmcnt(" #n_ ")" : "+v"(mw0), "+v"(mw1), "+v"(mw2) :: "memory")
    const int ksw = (DQK == 128 ? (r32 & 15) : ((r32 >> 1) & 7)) ^ hi;
    const unsigned krow = (unsigned)(size_t)ldsb + (unsigned)r32 * (DQK * 2);
    const int vq = (lane >> 2) & 3, vp = lane & 3, vg = lane >> 4;
    const unsigned vrow = (unsigned)(size_t)ldsb + KBYTES + (unsigned)(4 * (vg >> 1) + vq) * 256 + (vg & 1) * 32 + vp * 8;
    float m_run = -1e30f, l_run = 0.f; const float mth = 8.f / sl2;
    f32x16 oT[4];
#pragma unroll
    for (int d0 = 0; d0 < 4; ++d0)
#pragma unroll
        for (int r = 0; r < 16; ++r) oT[d0][r] = 0.f;
    AT_ISSUE(mw0, 0, 0); AT_ISSUE(mw1, 1, 1);
    AT_WAIT(5);
    __builtin_amdgcn_s_barrier();
#define TRRD(dst, addr, off) asm volatile("ds_read_b64_tr_b16 %0, %1 offset:%2" : "=&v"(dst) : "v"(addr), "i"(off) : "memory")
#define AT_STEP(t_, st_, MWCUR, MWNEW) do { \
        const int t = (t_); \
        AT_ISSUE(MWNEW, t + 2, ((st_) + 2) % 3);                    \
        if (t * 64 <= q0 + 31) {                                    \
            int kx = ksw; asm volatile("" : "+v"(kx)); \
            f32x16 p0, p1; \
            _Pragma("unroll") for (int r = 0; r < 16; ++r) { p0[r] = 0.f; p1[r] = 0.f; } \
            _Pragma("unroll") for (int d0 = 0; d0 < ND; ++d0) { \
                const unsigned ka = krow + (st_) * STAGE + ((unsigned)((2 * d0) ^ kx) << 4); \
                const bf16x8 a0 = *(const LAS bf16x8*)(size_t)ka; const bf16x8 a1 = *(const LAS bf16x8*)(size_t)(ka + 32 * DQK * 2); \
                if (AMODE != 3) { p0 = __builtin_amdgcn_mfma_f32_32x32x16_bf16(a0, qr[d0], p0, 0, 0, 0); \
                p1 = __builtin_amdgcn_mfma_f32_32x32x16_bf16(a1, qr[d0], p1, 0, 0, 0); } else { asm volatile("" :: "v"(a0), "v"(a1)); } } \
            if (AMODE != 1) { if (MASKED) {                         \
                const int wx_ = (int)(MWCUR.x >> (4 * hi)), wy_ = (int)(MWCUR.y >> (4 * hi)); \
                _Pragma("unroll") for (int r = 0; r < 16; ++r) { const int c = (r & 3) + 8 * (r >> 2); \
                    const unsigned mx_ = (unsigned)__builtin_amdgcn_sbfe(wx_, c, 1), my_ = (unsigned)__builtin_amdgcn_sbfe(wy_, c, 1); \
                    p0[r] = __uint_as_float((__float_as_uint(p0[r]) & mx_) | (0xff800000u & ~mx_)); p1[r] = __uint_as_float((__float_as_uint(p1[r]) & my_) | (0xff800000u & ~my_)); } \
            } else if (t * 64 + 63 > q0) {                          \
                const int dq = q0 + r32 - t * 64 - 4 * hi; \
                _Pragma("unroll") for (int r = 0; r < 16; ++r) { const int c = (r & 3) + 8 * (r >> 2); if (c > dq) p0[r] = NEG; if (c + 32 > dq) p1[r] = NEG; } \
            } \
            float mx = p0[0]; \
            _Pragma("unroll") for (int r = 1; r < 16; ++r) mx = fmaxf(mx, p0[r]); \
            _Pragma("unroll") for (int r = 0; r < 16; ++r) mx = fmaxf(mx, p1[r]); \
            { auto rr = __builtin_amdgcn_permlane32_swap(__float_as_uint(mx), __float_as_uint(mx), false, false); mx = fmaxf(__uint_as_float(rr[0]), __uint_as_float(rr[1])); } \
            const float mnew = (mx > m_run + mth) ? mx : m_run;     \
            const float alpha = __builtin_amdgcn_exp2f((m_run - mnew) * sl2); \
            m_run = mnew; const float mb = -mnew * sl2; \
            float ps = 0.f; \
            _Pragma("unroll") for (int r = 0; r < 16; ++r) { p0[r] = __builtin_amdgcn_exp2f(fmaf(p0[r], sl2, mb)); ps += p0[r]; } \
            _Pragma("unroll") for (int r = 0; r < 16; ++r) { p1[r] = __builtin_amdgcn_exp2f(fmaf(p1[r], sl2, mb)); ps += p1[r]; } \
            l_run = l_run * alpha + ps; \
            if (__any(alpha != 1.f)) { \
                  \
                _Pragma("unroll") for (int d0 = 0; d0 < 4; ++d0) _Pragma("unroll") for (int r = 0; r < 16; ++r) { float ov = oT[d0][r]; asm("v_mul_f32 %0, %1, %0" : "+v"(ov) : "v"(alpha)); oT[d0][r] = ov; } } } \
            bf16x8 pb[4];                                            \
            { u32x4 w; \
              w.x = pkbf(p0[0], p0[1]); w.y = pkbf(p0[2], p0[3]); w.z = pkbf(p0[4], p0[5]); w.w = pkbf(p0[6], p0[7]); pb[0] = *reinterpret_cast<bf16x8*>(&w); \
              w.x = pkbf(p0[8], p0[9]); w.y = pkbf(p0[10], p0[11]); w.z = pkbf(p0[12], p0[13]); w.w = pkbf(p0[14], p0[15]); pb[1] = *reinterpret_cast<bf16x8*>(&w); \
              w.x = pkbf(p1[0], p1[1]); w.y = pkbf(p1[2], p1[3]); w.z = pkbf(p1[4], p1[5]); w.w = pkbf(p1[6], p1[7]); pb[2] = *reinterpret_cast<bf16x8*>(&w); \
              w.x = pkbf(p1[8], p1[9]); w.y = pkbf(p1[10], p1[11]); w.z = pkbf(p1[12], p1[13]); w.w = pkbf(p1[14], p1[15]); pb[3] = *reinterpret_cast<bf16x8*>(&w); } \
            int vx = vq; asm volatile("" : "+v"(vx)); \
            _Pragma("unroll") for (int d0 = 0; d0 < 4; ++d0) { \
                const unsigned va = vrow + (st_) * STAGE + ((unsigned)(d0 ^ vx) << 6); \
                s16x4 l0, h0, l1, h1, l2, h2, l3, h3; \
                TRRD(l0, va, 0); TRRD(h0, va, 2048); TRRD(l1, va, 4096); TRRD(h1, va, 6144); TRRD(l2, va, 8192); TRRD(h2, va, 10240); TRRD(l3, va, 12288); TRRD(h3, va, 14336); \
                asm volatile("s_waitcnt lgkmcnt(0)" ::: "memory"); __builtin_amdgcn_sched_barrier(0); \
                if (AMODE == 2) { asm volatile("" :: "v"(l0), "v"(h0), "v"(l1), "v"(h1), "v"(l2), "v"(h2), "v"(l3), "v"(h3), "v"(pb[0]), "v"(pb[1]), "v"(pb[2]), "v"(pb[3])); continue; } \
                oT[d0] = __builtin_amdgcn_mfma_f32_32x32x16_bf16((bf16x8){l0[0], l0[1], l0[2], l0[3], h0[0], h0[1], h0[2], h0[3]}, pb[0], oT[d0], 0, 0, 0); \
                oT[d0] = __builtin_amdgcn_mfma_f32_32x32x16_bf16((bf16x8){l1[0], l1[1], l1[2], l1[3], h1[0], h1[1], h1[2], h1[3]}, pb[1], oT[d0], 0, 0, 0); \
                oT[d0] = __builtin_amdgcn_mfma_f32_32x32x16_bf16((bf16x8){l2[0], l2[1], l2[2], l2[3], h2[0], h2[1], h2[2], h2[3]}, pb[2], oT[d0], 0, 0, 0); \
                oT[d0] = __builtin_amdgcn_mfma_f32_32x32x16_bf16((bf16x8){l3[0], l3[1], l3[2], l3[3], h3[0], h3[1], h3[2], h3[3]}, pb[3], oT[d0], 0, 0, 0); } \
        } \
        AT_WAIT(5);                                                 \
        asm volatile("s_waitcnt lgkmcnt(0)" ::: "memory"); \
        __builtin_amdgcn_s_barrier(); } while (0)
#pragma unroll 1
    for (int tt = 0; tt < NT3; tt += 3) { AT_STEP(tt, 0, mw0, mw2); AT_STEP(tt + 1, 1, mw1, mw0); AT_STEP(tt + 2, 2, mw2, mw1); }
    AT_WAIT(0);
    __builtin_amdgcn_s_barrier();
#undef AT_STEP
#undef AT_ISSUE
#undef AT_WAIT
#undef TRRD
    { auto rr = __builtin_amdgcn_permlane32_swap(__float_as_uint(l_run), __float_as_uint(l_run), false, false); l_run = __uint_as_float(rr[0]) + __uint_as_float(rr[1]); }
    const float inv = 1.f / l_run;
    bf16_t* orow = Og + (size_t)(q0 + r32) * ldo + 4 * hi;
#pragma unroll
    for (int d0 = 0; d0 < 4; ++d0)
#pragma unroll
        for (int rq = 0; rq < 4; ++rq) { u32x2 w; w.x = pkbf(oT[d0][4 * rq] * inv, oT[d0][4 * rq + 1] * inv); w.y = pkbf(oT[d0][4 * rq + 2] * inv, oT[d0][4 * rq + 3] * inv);
            *(u32x2*)(orow + 32 * d0 + 8 * rq) = w; }
}
template <int AMODE>
__device__ __forceinline__ void p_attn(LAS unsigned char* ldsb, unsigned char* ws) {
    const bf16_t* QA = (const bf16_t*)(ws + WS_QA); const bf16_t* KA = (const bf16_t*)(ws + WS_KA); const bf16_t* VA = (const bf16_t*)(ws + WS_VA); bf16_t* OA = (bf16_t*)(ws + WS_OA);
    const bf16_t* QB = (const bf16_t*)(ws + WS_QB); const bf16_t* KB = (const bf16_t*)(ws + WS_KB); const bf16_t* VB = (const bf16_t*)(ws + WS_VB); bf16_t* OB = (bf16_t*)(ws + WS_OB);
    const unsigned* MASK = (const unsigned*)(ws + WS_MASK);
    for (int w = opaque_bid(); w < 256; w += gridDim.x) {
        const int bh = (w & 7) * 2 + ((w >> 3) & 1), i = w >> 4, b = bh >> 3, h = bh & 7;
        const size_t r0 = (size_t)b * S;
        attn_unit<192, false, AMODE>(ldsb, QA + r0 * 1536 + h * 192, 1536, KA + r0 * 1536 + h * 192, 1536, VA + r0 * 1024 + h * 128, 1024, nullptr, OA + r0 * 1024 + h * 128, 1024, i, 0.07216878364870322f * 1.4426950408889634f);
        attn_unit<128, true, AMODE>(ldsb, QB + r0 * 1024 + h * 128, 1024, KB + r0 * 1024 + h * 128, 1024, VB + r0 * 1024 + h * 128, 1024, MASK + r0 * 128, OB + r0 * 1024 + h * 128, 1024, 15 - i, 0.08838834764831845f * 1.4426950408889634f);
    }
}

__device__ __forceinline__ void moe_tables256(int* tab, const unsigned* cnt, int ncol_tiles) {
    const int tid_ = opaque_tid();
    if (tid_ == 0) { int a = 0, bsum = 0; for (int e = 0; e < 64; ++e) { tab[e] = a; tab[80 + e] = bsum; const int c = (int)cnt[e], nrb = (c + MOE_RBLK - 1) / MOE_RBLK; tab[160 + e] = nrb; a += nrb * ncol_tiles; bsum += nrb * MOE_RBLK; } tab[64] = a; tab[80 + 64] = bsum; }
    if (tid_ >= 64 && tid_ < 128) {
        const int e = tid_ - 64; const unsigned c = cnt[e]; int rank = 0;
        for (int o = 0; o < 64; ++o) { const unsigned co = cnt[o]; rank += (co > c || (co == c && o < e)) ? 1 : 0; }
        tab[240 + rank] = e; }
    __syncthreads();
}
template <int RMODE>
__device__ __forceinline__ void p_ln1_route3(LAS unsigned char* ldsb, unsigned char* ws, const float* g, const float* bb, int l) {
    const float* V1 = (const float*)(ws + WS_V1); bf16_t* H1B = (bf16_t*)(ws + WS_H1B); float* STATS = (float*)(ws + WS_STATS);
    const float* sec = (const float*)(ws + WS_SEC) + l * 160;
    unsigned* cnt = (unsigned*)(ws + WS_CNT) + l * 64; int* LIST = (int*)(ws + WS_LIST);
    int* TOKE = (int*)(ws + WS_TOKE); float* TOKW = (float*)(ws + WS_TOKW); int* TOKS = (int*)(ws + WS_TOKS);
    const int tid = opaque_tid(), lane = tid & 63, wv = __builtin_amdgcn_readfirstlane(tid >> 6);
    LAS float* red = (LAS float*)ldsb;
    LAS float* stl = red + 8 * 32 * 96;
    for (int unit = opaque_bid(); unit < T / 32; unit += gridDim.x) {
        const int t0 = unit * 32;
        if (RMODE != 2) {
            const size_t ro = (size_t)(t0 + 4 * wv) * D + 4 * lane;
            f32x4 v[4][8]; float s1[4], s2[4], mean[4], rstd[4];
#pragma unroll
            for (int i = 0; i < 4; ++i)
#pragma unroll
                for (int j = 0; j < 8; ++j) v[i][j] = *(const f32x4*)(V1 + ro + (size_t)i * D + 256 * j);
#pragma unroll
            for (int i = 0; i < 4; ++i) { s1[i] = 0.f;
#pragma unroll
                for (int j = 0; j < 8; ++j) s1[i] += (v[i][j][0] + v[i][j][1]) + (v[i][j][2] + v[i][j][3]); }
#pragma unroll
            for (int o = 32; o >= 1; o >>= 1) { s1[0] += __shfl_xor(s1[0], o); s1[1] += __shfl_xor(s1[1], o); s1[2] += __shfl_xor(s1[2], o); s1[3] += __shfl_xor(s1[3], o); }
#pragma unroll
            for (int i = 0; i < 4; ++i) { mean[i] = s1[i] * (1.f / D); s2[i] = 0.f;
#pragma unroll
                for (int j = 0; j < 8; ++j) { v[i][j] = v[i][j] - mean[i]; s2[i] += (v[i][j][0] * v[i][j][0] + v[i][j][1] * v[i][j][1]) + (v[i][j][2] * v[i][j][2] + v[i][j][3] * v[i][j][3]); } }
#pragma unroll
            for (int o = 32; o >= 1; o >>= 1) { s2[0] += __shfl_xor(s2[0], o); s2[1] += __shfl_xor(s2[1], o); s2[2] += __shfl_xor(s2[2], o); s2[3] += __shfl_xor(s2[3], o); }
#pragma unroll
            for (int i = 0; i < 4; ++i) { rstd[i] = rsqrtf(s2[i] * (1.f / D) + 1e-5f);
                if (lane == 0) { stl[(4 * wv + i) * 2] = mean[i]; stl[(4 * wv + i) * 2 + 1] = rstd[i]; STATS[(size_t)(t0 + 4 * wv + i) * 2] = mean[i]; STATS[(size_t)(t0 + 4 * wv + i) * 2 + 1] = rstd[i]; } }
            f32x4 gg[8], b4[8];
#pragma unroll
            for (int j = 0; j < 8; ++j) { gg[j] = *(const f32x4*)(g + 4 * lane + 256 * j); b4[j] = *(const f32x4*)(bb + 4 * lane + 256 * j); }
#pragma unroll
            for (int j = 0; j < 8; ++j)
#pragma unroll
                for (int i = 0; i < 4; ++i) st4bf(H1B + ro + (size_t)i * D + 256 * j, v[i][j] * rstd[i] * gg[j] + b4[j]);
        }
        if (RMODE != 1) {
            f32x16 c0, c1, c2;
#pragma unroll
            for (int r = 0; r < 16; ++r) { c0[r] = 0.f; c1[r] = 0.f; c2[r] = 0.f; }
            const int j = lane & 31, kh = lane >> 5, kb = 256 * wv + 8 * kh;
            const float* hp = V1 + (size_t)(t0 + j) * D + kb;
            const bf16_t* wh = (const bf16_t*)(ws + WS_RWH) + (size_t)l * (96 * D) + (size_t)wv * (16 * 1536) + (kh * 32 + j) * 8;
            const bf16_t* wl = (const bf16_t*)(ws + WS_RWL) + (size_t)l * (96 * D) + (size_t)wv * (16 * 1536) + (kh * 32 + j) * 8;
            f32x4 xa0, xa1, xb0, xb1; bf16x8 ha0, ha1, ha2, la0, la1, la2, hb0, hb1, hb2, lb0, lb1, lb2;
#define RT_LOAD(X0, X1, H0, H1, H2, L0, L1, L2, st_) do { const float* px_ = hp + 16 * (st_); const bf16_t* ph_ = wh + 1536 * (st_); const bf16_t* pl_ = wl + 1536 * (st_); \
                asm volatile("global_load_dwordx4 %0, %1, off" : "=v"(X0) : "v"(px_) : "memory"); asm volatile("global_load_dwordx4 %0, %1, off offset:16" : "=v"(X1) : "v"(px_) : "memory"); \
                asm volatile("global_load_dwordx4 %0, %1, off" : "=v"(H0) : "v"(ph_) : "memory"); asm volatile("global_load_dwordx4 %0, %1, off offset:1024" : "=v"(H1) : "v"(ph_) : "memory"); \
                asm volatile("global_load_dwordx4 %0, %1, off offset:2048" : "=v"(H2) : "v"(ph_) : "memory"); \
                asm volatile("global_load_dwordx4 %0, %1, off" : "=v"(L0) : "v"(pl_) : "memory"); asm volatile("global_load_dwordx4 %0, %1, off offset:1024" : "=v"(L1) : "v"(pl_) : "memory"); \
                asm volatile("global_load_dwordx4 %0, %1, off offset:2048" : "=v"(L2) : "v"(pl_) : "memory"); } while (0)
#define RT_WAIT(n_) asm volatile("s_waitcnt vmcnt(" #n_ ")" : "+v"(xa0), "+v"(xa1), "+v"(ha0), "+v"(ha1), "+v"(ha2), "+v"(la0), "+v"(la1), "+v"(la2), "+v"(xb0), "+v"(xb1), "+v"(hb0), "+v"(hb1), "+v"(hb2), "+v"(lb0), "+v"(lb1), "+v"(lb2) :: "memory")
#define RT_STEP(x0, x1, bh0, bh1, bh2, bl0, bl1, bl2) do { \
                u32x4 hw; hw.x = pkbf(x0[0], x0[1]); hw.y = pkbf(x0[2], x0[3]); hw.z = pkbf(x1[0], x1[1]); hw.w = pkbf(x1[2], x1[3]); \
                u32x4 lw; lw.x = pkbf(x0[0] - __uint_as_float(hw.x << 16), x0[1] - __uint_as_float(hw.x & 0xffff0000u)); lw.y = pkbf(x0[2] - __uint_as_float(hw.y << 16), x0[3] - __uint_as_float(hw.y & 0xffff0000u)); \
                lw.z = pkbf(x1[0] - __uint_as_float(hw.z << 16), x1[1] - __uint_as_float(hw.z & 0xffff0000u)); lw.w = pkbf(x1[2] - __uint_as_float(hw.w << 16), x1[3] - __uint_as_float(hw.w & 0xffff0000u)); \
                const bf16x8 ah = *reinterpret_cast<bf16x8*>(&hw), al = *reinterpret_cast<bf16x8*>(&lw); \
                c0 = __builtin_amdgcn_mfma_f32_32x32x16_bf16(ah, bh0, c0, 0, 0, 0); c1 = __builtin_amdgcn_mfma_f32_32x32x16_bf16(ah, bh1, c1, 0, 0, 0); c2 = __builtin_amdgcn_mfma_f32_32x32x16_bf16(ah, bh2, c2, 0, 0, 0); \
                c0 = __builtin_amdgcn_mfma_f32_32x32x16_bf16(ah, bl0, c0, 0, 0, 0); c1 = __builtin_amdgcn_mfma_f32_32x32x16_bf16(ah, bl1, c1, 0, 0, 0); c2 = __builtin_amdgcn_mfma_f32_32x32x16_bf16(ah, bl2, c2, 0, 0, 0); \
                c0 = __builtin_amdgcn_mfma_f32_32x32x16_bf16(al, bh0, c0, 0, 0, 0); c1 = __builtin_amdgcn_mfma_f32_32x32x16_bf16(al, bh1, c1, 0, 0, 0); c2 = __builtin_amdgcn_mfma_f32_32x32x16_bf16(al, bh2, c2, 0, 0, 0); } while (0)
            RT_LOAD(xa0, xa1, ha0, ha1, ha2, la0, la1, la2, 0);
#pragma unroll 1
            for (int st = 0; st < 16; st += 2) {
                RT_LOAD(xb0, xb1, hb0, hb1, hb2, lb0, lb1, lb2, st + 1);
                RT_WAIT(8);
                RT_STEP(xa0, xa1, ha0, ha1, ha2, la0, la1, la2);
                RT_LOAD(xa0, xa1, ha0, ha1, ha2, la0, la1, la2, (st + 2) & 15);
                RT_WAIT(8);
                RT_STEP(xb0, xb1, hb0, hb1, hb2, lb0, lb1, lb2);
            }
            RT_WAIT(0);
#undef RT_LOAD
#undef RT_WAIT
#undef RT_STEP
#pragma unroll
            for (int r = 0; r < 16; ++r) { const int tr = (r & 3) + 8 * (r >> 2) + 4 * kh; LAS float* o = red + (wv * 32 + tr) * 96 + j; o[0] = c0[r]; o[32] = c1[r]; o[64] = c2[r]; }
        }
        __syncthreads();
        for (int idx = tid; idx < 32 * 72; idx += NTHREADS) { const int tk = idx / 72, c = idx - tk * 72;
            float sacc = 0.f;
#pragma unroll
            for (int w = 0; w < 8; ++w) sacc += red[(w * 32 + tk) * 96 + c];
            red[tk * 96 + c] = stl[tk * 2 + 1] * (sacc - stl[tk * 2] * sec[c]) + sec[80 + c]; }
        __syncthreads();
        if (RMODE == 0 && tid < 32) {
            const int t = t0 + tid; const LAS float* lg = red + tid * 96;
            float gl[8]; float gmax = -__builtin_inff(); int gi = 0;
#pragma unroll
            for (int i = 0; i < 8; ++i) { gl[i] = lg[64 + i]; if (gl[i] > gmax) { gmax = gl[i]; gi = i; } }
            float gs = 0.f;
#pragma unroll
            for (int i = 0; i < 8; ++i) gs += __expf(gl[i] - gmax);
            const float gp = 1.f / gs;
            float el[8]; float emax = -__builtin_inff(); int e1 = 0;
#pragma unroll
            for (int i = 0; i < 8; ++i) { el[i] = lg[gi * 8 + i]; if (el[i] > emax) { emax = el[i]; e1 = i; } }
            float e2max = -__builtin_inff(); int e2 = 0;
#pragma unroll
            for (int i = 0; i < 8; ++i) { if (i != e1 && el[i] > e2max) { e2max = el[i]; e2 = i; } }
            const float p2 = __expf(e2max - emax);
            const float wa = gp / (1.f + p2), wb = gp * p2 / (1.f + p2);
            const int ea = gi * 8 + e1, eb = gi * 8 + e2;
            const int sa = (int)atomicAdd(cnt + ea, 1u), sb = (int)atomicAdd(cnt + eb, 1u);
            LIST[(size_t)ea * ECAP + sa] = t; LIST[(size_t)eb * ECAP + sb] = t;
            TOKE[t * 2] = ea; TOKE[t * 2 + 1] = eb; TOKW[t * 2] = wa; TOKW[t * 2 + 1] = wb; TOKS[t * 2] = sa; TOKS[t * 2 + 1] = sb;
        }
        __syncthreads();
    }
}
__device__ __forceinline__ void p_ln2v2(LAS unsigned char* ldsb, unsigned char* ws, const float* g1, const float* b1, const float* g, const float* bb, float* outF, int l) {
    const unsigned* cnt = (const unsigned*)(ws + WS_CNT) + l * 64;
    const bf16_t* H1B = (const bf16_t*)(ws + WS_H1B); const bf16_t* YE = (const bf16_t*)(ws + WS_YE);
    const int* TOKE = (const int*)(ws + WS_TOKE); const float* TOKW = (const float*)(ws + WS_TOKW); const int* TOKS = (const int*)(ws + WS_TOKS);
    bf16_t* XB = (bf16_t*)(ws + WS_XB);
    int* tab = (int*)(unsigned char*)ldsb;
    __syncthreads();
    moe_tables256(tab, cnt, 1);
    const int tid = opaque_tid(), lane = tid & 63, wv = tid >> 6;
    const int tstride = gridDim.x * 8;
#define LN2_META(t_, R0, R1, W0, W1) do { const int tt_ = (t_) < T ? (t_) : T - 1; R0 = tab[80 + TOKE[tt_ * 2]] + TOKS[tt_ * 2]; R1 = tab[80 + TOKE[tt_ * 2 + 1]] + TOKS[tt_ * 2 + 1]; W0 = TOKW[tt_ * 2]; W1 = TOKW[tt_ * 2 + 1]; } while (0)
#define LN2_ROWS(t_, R0, R1, HH, Y0, Y1) do { const int tt_ = (t_) < T ? (t_) : T - 1; \
        _Pragma("unroll") for (int j = 0; j < 8; ++j) { HH[j] = *(const u32x2*)(H1B + (size_t)tt_ * D + 4 * lane + 256 * j); Y0[j] = *(const u32x2*)(YE + (size_t)(R0) * D + 4 * lane + 256 * j); Y1[j] = *(const u32x2*)(YE + (size_t)(R1) * D + 4 * lane + 256 * j); } } while (0)
#define LN2_TOKEN(t_, HH, Y0, Y1, W0, W1) do { if ((t_) < T) { const size_t ro = (size_t)(t_) * D + 4 * lane; f32x4 v[8]; float s1 = 0.f; \
        _Pragma("unroll") for (int j = 0; j < 8; ++j) { v[j] = bf4(HH[j]) * ALPHA + bf4(Y0[j]) * (W0) + bf4(Y1[j]) * (W1); s1 += (v[j][0] + v[j][1]) + (v[j][2] + v[j][3]); } \
        const float mean = wave_sum(s1) * (1.f / D); float s2 = 0.f; \
        _Pragma("unroll") for (int j = 0; j < 8; ++j) { v[j] = v[j] - mean; s2 += (v[j][0] * v[j][0] + v[j][1] * v[j][1]) + (v[j][2] * v[j][2] + v[j][3] * v[j][3]); } \
        const float rstd = rsqrtf(wave_sum(s2) * (1.f / D) + 1e-5f); \
        _Pragma("unroll") for (int j = 0; j < 8; ++j) { const f32x4 o = v[j] * rstd * gg[j] + b4[j]; \
            *(f32x4*)(outF + ro + 256 * j) = o; if (l != DEPTH - 1) st4bf(XB + ro + 256 * j, o); } } } while (0)
    int t = opaque_bid() * 8 + wv;
    f32x4 gg[8], b4[8];
#pragma unroll
    for (int j = 0; j < 8; ++j) { gg[j] = *(const f32x4*)(g + 4 * lane + 256 * j); b4[j] = *(const f32x4*)(bb + 4 * lane + 256 * j); }
    int ra0, ra1, rb0, rb1; float wa0, wa1, wb0, wb1;
    LN2_META(t, ra0, ra1, wa0, wa1); LN2_META(t + tstride, rb0, rb1, wb0, wb1);
    for (; t < T; t += 2 * tstride) {
        u32x2 ha[8], ya0[8], ya1[8], hb[8], yb0[8], yb1[8];
        LN2_ROWS(t, ra0, ra1, ha, ya0, ya1); LN2_ROWS(t + tstride, rb0, rb1, hb, yb0, yb1);
        int na0, na1, nb0, nb1; float nwa0, nwa1, nwb0, nwb1;
        LN2_META(t + 2 * tstride, na0, na1, nwa0, nwa1); LN2_META(t + 3 * tstride, nb0, nb1, nwb0, nwb1);
        LN2_TOKEN(t, ha, ya0, ya1, wa0, wa1);
        LN2_TOKEN(t + tstride, hb, yb0, yb1, wb0, wb1);
        ra0 = na0; ra1 = na1; rb0 = nb0; rb1 = nb1; wa0 = nwa0; wa1 = nwa1; wb0 = nwb0; wb1 = nwb1;
    }
#undef LN2_META
#undef LN2_ROWS
#undef LN2_TOKEN
    __syncthreads();
}

template <bool GATED, int PMODE = 0>
__device__ __forceinline__ void moe_gemm(LAS unsigned char* ldsb, const int* tab, const unsigned* cnt, const int* LIST, const bf16_t* Asrc, const float* W0, const float* W1, bf16_t* Out) {
    constexpr int K = GATED ? D : FE, NT = K / 32, NCT = GATED ? FE / 64 : D / 128, LDW = GATED ? FE : D, LDO = GATED ? FE : D;
    constexpr int RBLK = MOE_RBLK, MT = RBLK / 64, NAG = RBLK / 64;
    static_assert(RBLK % 64 == 0 && (NAG == 6 || NAG == 5 || NAG == 3), "the counted waits below are written for 6, 5 or 3 A granules per thread");
    constexpr int ASLOT = RBLK * 128, BOFF = 2 * ASLOT, BBYTES = 32 * 256;
    const int tid = opaque_tid(), lane = tid & 63, wv = __builtin_amdgcn_readfirstlane(tid >> 6), wm = wv >> 1, wn = wv & 1, l15 = lane & 15, kq = lane >> 4;
    const unsigned lbase = (unsigned)(size_t)ldsb;
    const int arow = wm * (16 * MT) + l15;
    const unsigned afr = lbase + (unsigned)arow * 128u; const int asw = ((arow >> 1) & 7) ^ kq;
    const unsigned afa0 = afr + ((unsigned)(0 ^ asw) << 4), afa1 = afr + ((unsigned)(4 ^ asw) << 4);
    const int bq = (lane >> 2) & 3, bp = lane & 3, bkey = bq | ((kq & 1) << 2);
    const unsigned bfr = lbase + BOFF + (unsigned)(8 * kq + bq) * 256u + 8u * bp;
    unsigned bb[4];
#pragma unroll
    for (int j = 0; j < 4; ++j) { const int np = GATED ? ((j >> 1) * 4 + 2 * wn + (j & 1)) : (4 * wn + j); bb[j] = bfr + ((unsigned)(np ^ bkey) << 5); }
    const int sa_r = tid >> 3, sa_p = tid & 7;
    const int sb_k = tid >> 5, sb_n = 4 * (tid & 31);
    const int G = gridDim.x;
    const int NI = 64 * NCT;
#define MG_DECODE(i0_, e_, ct_) do { const int rnd = (i0_) / G, pos = (i0_) - rnd * G; int rank; \
      if ((G & 7) == 0 && ((G >> 3) % NCT) == 0 && (64 * NCT) % G == 0) { const int x = pos & 7, j = pos >> 3, epx = (G >> 3) / NCT;         \
          rank = rnd * (G / NCT) + x * epx + j / NCT; ct_ = j % NCT; if (rnd & 1) rank = rnd * (G / NCT) + (G / NCT - 1) - (x * epx + j / NCT); } \
      else { rank = (i0_) / NCT; ct_ = (i0_) % NCT; } \
      e_ = tab[240 + rank]; } while (0)
#define MG_AOFF(AO, e_, rb_, ce_, base_) do { _Pragma("unroll") for (int i = 0; i < NAG; ++i) { const int rl = i * 64 + sa_r, r = (rb_) * RBLK + rl; const int ch = sa_p ^ ((rl >> 1) & 7); \
            if (GATED) { const int rc_ = r < (ce_) ? r : ((ce_) > 0 ? (ce_) - 1 : 0); const int tok = LIST[(size_t)(e_) * ECAP + rc_] & (T - 1);     \
                AO[i] = (unsigned)tok * (unsigned)(K * 2) + ch * 16; } \
            else AO[i] = (unsigned)((base_) + r) * (unsigned)(K * 2) + ch * 16; } } while (0)
#define MG_WP(e_, ct_) ((GATED ? (sb_n < 64 ? W0 : W1) : W0) + (size_t)(e_) * K * LDW + (size_t)sb_k * LDW + (GATED ? (ct_) * 64 + (sb_n & 63) : (ct_) * 128 + sb_n))
#define MG_TROT(e_, ct_) ((((e_) * 5 + (ct_) * 9) & (NT - 1)) & ~1)
    int i0 = opaque_bid();
    if (i0 < NI) {
      int e, ct; MG_DECODE(i0, e, ct);
      int ce = (int)cnt[e], base = tab[80 + e], nrb = tab[160 + e] > 0 ? tab[160 + e] : 1, rb = 0;
      unsigned aoff[NAG], aoffn[NAG];
      MG_AOFF(aoff, e, rb, ce, base);
      const float* wp = MG_WP(e, ct); int trot = MG_TROT(e, ct);
      const float* wpn = wp; int trotn = trot;
      f32x4 rq0[2], rq1[2], rq2[2], rq3[2];
#define MG_ISSUE_A(t_, slot_) do { const bool nx_ = (t_) >= NT; const int ta_ = ((((nx_ ? (t_) - NT : (t_))) + (nx_ ? trotn : trot)) & (NT - 1)) >> 1;        \
            _Pragma("unroll") for (int i = 0; i < NAG; ++i) __builtin_amdgcn_global_load_lds((const unsigned*)((const unsigned char*)Asrc + (nx_ ? aoffn[i] : aoff[i]) + (PMODE == 1 ? 0 : ta_ * 128)), (LAS unsigned*)(ldsb + (slot_) * ASLOT + (i * 512 + wv * 64) * 16), 16, 0, 0); } while (0)
#define MG_ISSUE_B(RB, t_) do { const bool nx_ = (t_) >= NT; const int tb_ = ((nx_ ? (t_) - NT : (t_)) + (nx_ ? trotn : trot)) & (NT - 1); const float* wq_ = nx_ ? wpn : wp; \
            _Pragma("unroll") for (int i = 0; i < 2; ++i) asm volatile("global_load_dwordx4 %0, %1, off nt" : "=v"(RB[i]) : "v"(wq_ + (size_t)((PMODE == 2 ? 0 : tb_ * 32) + 16 * i) * LDW) : "memory"); } while (0)
#define MG_WAIT_ALL(n_) asm volatile("s_waitcnt vmcnt(" #n_ ")" : "+v"(rq0[0]), "+v"(rq0[1]), "+v"(rq1[0]), "+v"(rq1[1]), "+v"(rq2[0]), "+v"(rq2[1]), "+v"(rq3[0]), "+v"(rq3[1]) :: "memory")
#define MG_WRITE_B(RB, buf_) do { _Pragma("unroll") for (int i = 0; i < 2; ++i) { const int k = sb_k + 16 * i; u32x2 w; w.x = pkbf(RB[i][0], RB[i][1]); w.y = pkbf(RB[i][2], RB[i][3]); \
            *(LAS u32x2*)(ldsb + BOFF + (buf_) * BBYTES + k * 256 + ((((sb_n >> 4) ^ ((k & 3) | (((k >> 3) & 1) << 2)))) << 5) + (sb_n & 15) * 2) = w; } } while (0)
#define TRRD(dst, addr, off) asm volatile("ds_read_b64_tr_b16 %0, %1 offset:%2" : "=&v"(dst) : "v"(addr), "i"(off) : "memory")
#define ARD(dst, addr, off) asm volatile("ds_read_b128 %0, %1 offset:%2" : "=&v"(dst) : "v"(addr), "i"(off) : "memory")
#define MG_COMPUTE(slot_, half_, buf_) do { if (PMODE != 0) break; \
            s16x4 b0l, b0h, b1l, b1h, b2l, b2h, b3l, b3h; \
            TRRD(b0l, bb[0], (buf_) * BBYTES); TRRD(b0h, bb[0], (buf_) * BBYTES + 1024); TRRD(b1l, bb[1], (buf_) * BBYTES); TRRD(b1h, bb[1], (buf_) * BBYTES + 1024); \
            TRRD(b2l, bb[2], (buf_) * BBYTES); TRRD(b2h, bb[2], (buf_) * BBYTES + 1024); TRRD(b3l, bb[3], (buf_) * BBYTES); TRRD(b3h, bb[3], (buf_) * BBYTES + 1024); \
              \
            bf16x8 af[MT]; { const unsigned ad_ = (half_) ? afa1 : afa0; \
              ARD(af[0], ad_, (slot_) * ASLOT + 0 * 2048); ARD(af[1], ad_, (slot_) * ASLOT + 1 * 2048); ARD(af[2], ad_, (slot_) * ASLOT + 2 * 2048); \
              if constexpr (MT > 3) { ARD(af[3 % MT], ad_, (slot_) * ASLOT + 3 * 2048); ARD(af[4 % MT], ad_, (slot_) * ASLOT + 4 * 2048); } \
              if constexpr (MT > 5) { ARD(af[5 % MT], ad_, (slot_) * ASLOT + 5 * 2048); } } \
            asm volatile("s_waitcnt lgkmcnt(0)" ::: "memory"); __builtin_amdgcn_sched_barrier(0); \
            const bf16x8 bf0 = {b0l[0], b0l[1], b0l[2], b0l[3], b0h[0], b0h[1], b0h[2], b0h[3]}, bf1 = {b1l[0], b1l[1], b1l[2], b1l[3], b1h[0], b1h[1], b1h[2], b1h[3]}; \
            const bf16x8 bf2 = {b2l[0], b2l[1], b2l[2], b2l[3], b2h[0], b2h[1], b2h[2], b2h[3]}, bf3 = {b3l[0], b3l[1], b3l[2], b3l[3], b3h[0], b3h[1], b3h[2], b3h[3]}; \
            _Pragma("unroll") for (int m = 0; m < MT; ++m) if (m < mlim) { \
                acc[m][0] = __builtin_amdgcn_mfma_f32_16x16x32_bf16(af[m], bf0, acc[m][0], 0, 0, 0); acc[m][1] = __builtin_amdgcn_mfma_f32_16x16x32_bf16(af[m], bf1, acc[m][1], 0, 0, 0); \
                acc[m][2] = __builtin_amdgcn_mfma_f32_16x16x32_bf16(af[m], bf2, acc[m][2], 0, 0, 0); acc[m][3] = __builtin_amdgcn_mfma_f32_16x16x32_bf16(af[m], bf3, acc[m][3], 0, 0, 0); } } while (0)
#define MG_STEP_EVEN(t_, s0_, RBNEW, RBNEXT) do { \
            MG_ISSUE_A((t_) + 2, (((s0_) >> 1) + 1) & 1); MG_ISSUE_B(RBNEW, (t_) + 4); \
            MG_COMPUTE(((s0_) >> 1) & 1, 0, (s0_) & 1); \
            if constexpr (NAG == 6) MG_WAIT_ALL(12); else if constexpr (NAG == 5) MG_WAIT_ALL(11); else MG_WAIT_ALL(9); \
            MG_WRITE_B(RBNEXT, ((s0_) + 1) & 1); \
            asm volatile("s_waitcnt lgkmcnt(0)" ::: "memory"); \
            __builtin_amdgcn_s_barrier(); } while (0)
#define MG_STEP_ODD(t_, s0_, RBNEW, RBNEXT) do { \
            MG_ISSUE_B(RBNEW, (t_) + 4); \
            MG_COMPUTE(((s0_) >> 1) & 1, 1, (s0_) & 1); \
            MG_WAIT_ALL(4); \
            MG_WRITE_B(RBNEXT, ((s0_) + 1) & 1); \
            asm volatile("s_waitcnt lgkmcnt(0)" ::: "memory"); \
            __builtin_amdgcn_s_barrier(); } while (0)
      asm volatile("s_waitcnt lgkmcnt(0)" ::: "memory");
      __builtin_amdgcn_s_barrier();
      MG_ISSUE_A(0, 0); MG_ISSUE_B(rq0, 0); MG_ISSUE_B(rq1, 1); MG_ISSUE_B(rq2, 2); MG_ISSUE_B(rq3, 3);
      MG_WAIT_ALL(6);
      MG_WRITE_B(rq0, 0);
      asm volatile("s_waitcnt lgkmcnt(0)" ::: "memory");
      __builtin_amdgcn_s_barrier();
#pragma unroll 1
      for (;;) {
        int en = e, ctn = ct, cen = ce, basen = base, nrbn = nrb, rbn = rb, i0n = i0; bool last = false;
        if (rb + 1 < nrb) rbn = rb + 1;
        else if (i0 + G < NI) { i0n = i0 + G; MG_DECODE(i0n, en, ctn); cen = (int)cnt[en]; basen = tab[80 + en]; nrbn = tab[160 + en] > 0 ? tab[160 + en] : 1; rbn = 0; }
        else last = true;
        MG_AOFF(aoffn, en, rbn, cen, basen);
        wpn = MG_WP(en, ctn); trotn = MG_TROT(en, ctn);
#pragma unroll
        for (int i = 0; i < NAG; ++i) asm volatile("" : "+v"(aoffn[i]));
        int mlim = (ce - rb * RBLK - wm * (16 * MT) + 15) >> 4; mlim = mlim < 0 ? 0 : (mlim > MT ? MT : mlim); mlim = __builtin_amdgcn_readfirstlane(mlim);
        f32x4 acc[MT][4];
#pragma unroll
        for (int m = 0; m < MT; ++m)
#pragma unroll
            for (int n = 0; n < 4; ++n) acc[m][n] = (f32x4){0.f, 0.f, 0.f, 0.f};
#pragma unroll 1
        for (int t = 0; t < NT; t += 4) {
            MG_STEP_EVEN(t, 0, rq0, rq1); MG_STEP_ODD(t + 1, 1, rq1, rq2); MG_STEP_EVEN(t + 2, 2, rq2, rq3); MG_STEP_ODD(t + 3, 3, rq3, rq0);
        }
#pragma unroll
        for (int m = 0; m < MT; ++m)
#pragma unroll
            for (int g = 0; g < 4; ++g) {
                const int r = rb * RBLK + wm * (16 * MT) + 16 * m + 4 * kq + g;
                if (r < ce) {
                    if (GATED) {
#pragma unroll
                        for (int j = 0; j < 2; ++j) { const float gv = acc[m][j][g], uv = acc[m][2 + j][g];
                            Out[(size_t)(base + r) * LDO + ct * 64 + 32 * wn + 16 * j + l15] = f2bf(gv / (1.f + __expf(-gv)) * uv); }
                    } else {
#pragma unroll
                        for (int n = 0; n < 4; ++n) Out[(size_t)(base + r) * LDO + ct * 128 + 64 * wn + 16 * n + l15] = f2bf(acc[m][n][g]);
                    }
                }
            }
        if (last) break;
        e = en; ct = ctn; ce = cen; base = basen; nrb = nrbn; rb = rbn; i0 = i0n; wp = wpn; trot = trotn;
#pragma unroll
        for (int i = 0; i < NAG; ++i) aoff[i] = aoffn[i];
      }
      MG_WAIT_ALL(0);
#undef MG_STEP_EVEN
#undef MG_STEP_ODD
#undef MG_ISSUE_A
#undef MG_ISSUE_B
#undef MG_WAIT_ALL
#undef MG_WRITE_B
#undef MG_COMPUTE
#undef ARD
#undef TRRD
    }
#undef MG_DECODE
#undef MG_AOFF
#undef MG_WP
#undef MG_TROT
    __syncthreads();
}
template <int PMODE>
__device__ __forceinline__ void p_moe1_mfma(LAS unsigned char* ldsb, unsigned char* ws, const float* w_eg, const float* w_eu, int l, int lc) {
    const unsigned* cnt = (const unsigned*)(ws + WS_CNT) + lc * 64;
    int* tab = (int*)((unsigned char*)ldsb + 120 * 1024);
    __syncthreads();
    moe_tables256(tab, cnt, FE / 64);
    moe_gemm<true, PMODE>(ldsb, tab, cnt, (const int*)(ws + WS_LIST), (const bf16_t*)(ws + WS_H1B), w_eg + (size_t)l * NE * D * FE, w_eu + (size_t)l * NE * D * FE, (bf16_t*)(ws + WS_HID));
}
__device__ __forceinline__ void p_moe2_mfma(LAS unsigned char* ldsb, unsigned char* ws, const float* w_ed, int l) {
    const unsigned* cnt = (const unsigned*)(ws + WS_CNT) + l * 64;
    int* tab = (int*)((unsigned char*)ldsb + 120 * 1024);
    __syncthreads();
    moe_tables256(tab, cnt, D / 128);
    moe_gemm<false>(ldsb, tab, cnt, nullptr, (const bf16_t*)(ws + WS_HID), w_ed + (size_t)l * NE * FE * D, nullptr, (bf16_t*)(ws + WS_YE));
}

constexpr int NPH = 10;
#ifndef PH_MASK
#define PH_MASK 0x7ff
#endif
#define PHON(k) ((PH_MASK >> (k)) & 1)
#ifndef REP_PHASE
#define REP_PHASE -1
#endif
#ifndef STAMP_A
#define STAMP_A -1
#define STAMP_B -1
#endif
#define REPS(k) for (int rep_ = 0; rep_ < ((REP_PHASE == (k)) ? 2 : 1); ++rep_)
template <class Tp> __device__ __forceinline__ Tp* as_global(Tp* p) {
    __attribute__((address_space(1))) Tp* g = (__attribute__((address_space(1))) Tp*)p; asm volatile("" : "+s"(g)); return (Tp*)g; }
typedef const Params __attribute__((address_space(4))) CParams;
#define KP(field) ({ CParams* _k = kp; asm volatile("" : "+s"(_k)); _k->field; })
__global__ void __launch_bounds__(NTHREADS, 2) hybrid_fwd(Params p_unused, int ph_lo, int ph_hi) {
    extern __shared__ __attribute__((aligned(16))) unsigned char lds_raw[];
    float* lds = (float*)lds_raw;
    LAS unsigned char* ldsb = (LAS unsigned char*)lds_raw;
    CParams* kp = (CParams*)__builtin_amdgcn_kernarg_segment_ptr();
    unsigned char* const ws0 = KP(ws);
    volatile LAS unsigned* xbw = (volatile LAS unsigned*)(lds_raw + LDS_BYTES - 16);
    if (threadIdx.x == 0) { xbw[0] = 0u; xbw[1] = 0u; xbw[2] = 0u; xbw[3] = 0u; }
    __syncthreads();
    XcdBarrier bar; bar.bar = (unsigned*)(ws0 + WS_BAR); bar.x = 0; bar.st = xbw;
    if (ph_lo < ph_hi) bar = xcd_barrier_post((unsigned*)(ws0 + WS_BAR), xbw);
#define IN(ph) ((ph) >= ph_lo && (ph) <= ph_hi)
#define GRID_BAR(ph) do { if ((ph) >= ph_lo && (ph) < ph_hi) xcd_barrier(bar); \
    if (STAMP_A >= 0 && blockIdx.x == 0 && threadIdx.x == 0) ((volatile unsigned long long*)(ws0 + WS_BAR + 14800))[(ph) + 1] = __builtin_amdgcn_s_memrealtime(); } while (0)
    if (STAMP_A >= 0 && blockIdx.x == 0 && threadIdx.x == 0) ((volatile unsigned long long*)(ws0 + WS_BAR + 14800))[0] = __builtin_amdgcn_s_memrealtime();
    if (PHON(0) && IN(0)) REPS(0) { unsigned char* ws = ws0; asm volatile("" : "+s"(ws)); ws = as_global(ws); { Params q; q.ws = ws; q.x = as_global(KP(x)); q.pos = as_global(KP(pos)); q.w_in = as_global(KP(w_in)); q.g_q = as_global(KP(g_q)); q.w_qb = as_global(KP(w_qb)); q.g_kv = as_global(KP(g_kv)); q.w_kvb = as_global(KP(w_kvb));
        q.w_oa = as_global(KP(w_oa)); q.w_ob = as_global(KP(w_ob)); q.w_out = as_global(KP(w_out)); q.ln1g = as_global(KP(ln1g)); q.ln1b = as_global(KP(ln1b)); q.w_router = as_global(KP(w_router)); q.w_group = as_global(KP(w_group)); q.b_router = as_global(KP(b_router)); q.b_group = as_global(KP(b_group)); if (REP_PHASE >= 31 && REP_PHASE <= 34) p_prologue(ldsb, q, 1 << (REP_PHASE - 31)); p_prologue(ldsb, q); } }
    int lfirst = -1; asm volatile("" : "+s"(lfirst));
    for (int l = lfirst; l < DEPTH; ++l) {
        const int pb = l * NPH;
        if (l >= 0 && PHON(1) && IN(pb + 1)) REPS(1) { unsigned char* ws = ws0; asm volatile("" : "+s"(ws)); ws = as_global(ws);
            EpiIn E; E.ws = ws;
            pg8::Gemm g{(const bf16_t*)(ws + WS_XB), (const bf16_t*)(ws + WS_WIN_T) + (size_t)l * INP * D, T, INP, D}; pg8::StaticOrder SO; SO.init(T, INP, (int)gridDim.x, opaque_bid());
            pg8::gemm_phase<EpiIn, pg8::StaticOrder, true, true>(ldsb, g, SO, E);
        }
        if ((l < 0 ? (PHON(0) && IN(0)) : (PHON(1) && IN(pb + 1)))) { unsigned char* ws = ws0; asm volatile("" : "+s"(ws)); ws = as_global(ws);
            const int G_ = (int)gridDim.x, nfull = l < 0 ? 0 : ((T / 256) * (INP / 256)) % G_, bid_ = opaque_bid();
            if (l < 0 || (nfull > 0 && bid_ >= nfull)) { __syncthreads();
                Params q; q.ws = ws; q.w_in = as_global(KP(w_in)); q.g_q = as_global(KP(g_q)); q.w_qb = as_global(KP(w_qb)); q.g_kv = as_global(KP(g_kv)); q.w_kvb = as_global(KP(w_kvb));
                q.w_oa = as_global(KP(w_oa)); q.w_ob = as_global(KP(w_ob)); q.w_out = as_global(KP(w_out));
                constexpr int WC_IN = (D / 64) * (INP / 64), WC_ALL = WC_IN + (512 / 64) * (1536 / 64) + (512 / 64) * (2048 / 64) + 2 * (1024 / 64) * (D / 64) + (D / 64) * (D / 64);
                const int a_l1 = l < 0 ? 0 : l, a_lo1 = l < 0 ? 0 : WC_IN, a_hi1 = l < 0 ? WC_IN : WC_ALL, a_l2 = l + 1, a_hi2 = (l >= 0 && l + 1 < DEPTH) ? WC_IN : 0;
                p_wcopies(ldsb, q, a_l1, a_lo1, a_hi1, a_l2, 0, a_hi2, bid_ - nfull, G_ - nfull); } }
        GRID_BAR(l < 0 ? 0 : pb + 1);
        if (l < 0) continue;
        if (PHON(2) && IN(pb + 2)) REPS(2) { unsigned char* ws = ws0; asm volatile("" : "+s"(ws)); ws = as_global(ws);
            { EpiQA E; E.ws = ws;
              pg8::Gemm g{(const bf16_t*)(ws + WS_CQ), (const bf16_t*)(ws + WS_WQB_T) + (size_t)l * 1536 * 512, T, 1536, 512}; pg8::StaticOrder SO; SO.init(T, 1536, (int)gridDim.x, opaque_bid());
              pg8::gemm_phase<EpiQA, pg8::StaticOrder, true, true>(ldsb, g, SO, E); }
            { EpiKV E; E.ws = ws;
              pg8::Gemm g{(const bf16_t*)(ws + WS_CKV), (const bf16_t*)(ws + WS_WKVB_T) + (size_t)l * 2048 * 512, T, 2048, 512}; pg8::StaticOrder SO; SO.init(T, 2048, (int)gridDim.x, opaque_bid());
              pg8::gemm_phase<EpiKV, pg8::StaticOrder, true, true>(ldsb, g, SO, E); }
            REPS(12) p_score(ldsb, ws);
        }
        GRID_BAR(pb + 2);
        if (PHON(3) && IN(pb + 3)) REPS(3) { unsigned char* ws = ws0; asm volatile("" : "+s"(ws)); ws = as_global(ws); p_select(ws); }
        GRID_BAR(pb + 3);
        if (PHON(4) && IN(pb + 4)) REPS(4) { unsigned char* ws = ws0; asm volatile("" : "+s"(ws)); ws = as_global(ws);
            if (REP_PHASE == 14) p_attn<1>(ldsb, ws); if (REP_PHASE == 15) p_attn<2>(ldsb, ws); if (REP_PHASE == 16) p_attn<3>(ldsb, ws);
            p_attn<0>(ldsb, ws);
        }
        GRID_BAR(pb + 4);
        if (PHON(5) && IN(pb + 5)) REPS(5) { unsigned char* ws = ws0; asm volatile("" : "+s"(ws)); ws = as_global(ws);
            pg8::StaticOrder SO; SO.init(T, D, (int)gridDim.x, opaque_bid());
            { EpiYA E; E.ws = ws;
              pg8::Gemm g{(const bf16_t*)(ws + WS_OA), (const bf16_t*)(ws + WS_WOA_T) + (size_t)l * D * 1024, T, D, 1024};
              pg8::gemm_phase<EpiYA, pg8::StaticOrder, true, true>(ldsb, g, SO, E); }
            { EpiYB E; E.ws = ws;
              pg8::Gemm g{(const bf16_t*)(ws + WS_OB), (const bf16_t*)(ws + WS_WOB_T) + (size_t)l * D * 1024, T, D, 1024};
              pg8::gemm_phase<EpiYB, pg8::StaticOrder, true, true>(ldsb, g, SO, E); }
        }
        GRID_BAR(pb + 5);
        if (PHON(6) && IN(pb + 6)) REPS(6) { unsigned char* ws = ws0; asm volatile("" : "+s"(ws)); ws = as_global(ws);
            EpiOut E; E.hin = (l == 0) ? as_global(KP(x)) : (const float*)(ws + WS_H2F); E.V1 = (float*)(ws + WS_V1);
            pg8::Gemm g{(const bf16_t*)(ws + WS_Y), (const bf16_t*)(ws + WS_WOUT_T) + (size_t)l * D * D, T, D, D}; pg8::StaticOrder SO; SO.init(T, D, (int)gridDim.x, opaque_bid());
            pg8::gemm_phase<EpiOut, pg8::StaticOrder, true, true>(ldsb, g, SO, E);
        }
        GRID_BAR(pb + 6);
        if (PHON(7) && IN(pb + 7)) REPS(7) { unsigned char* ws = ws0; asm volatile("" : "+s"(ws)); ws = as_global(ws); if (REP_PHASE == 21) p_ln1_route3<1>(ldsb, ws, as_global(KP(ln1g)) + (size_t)l * D, as_global(KP(ln1b)) + (size_t)l * D, l); if (REP_PHASE == 22) p_ln1_route3<2>(ldsb, ws, as_global(KP(ln1g)) + (size_t)l * D, as_global(KP(ln1b)) + (size_t)l * D, l);
            p_ln1_route3<0>(ldsb, ws, as_global(KP(ln1g)) + (size_t)l * D, as_global(KP(ln1b)) + (size_t)l * D, l); }
        GRID_BAR(pb + 7);
        if (PHON(8) && IN(pb + 8)) REPS(8) { unsigned char* ws = ws0; asm volatile("" : "+s"(ws)); ws = as_global(ws); if (REP_PHASE == 18) p_moe1_mfma<0>(ldsb, ws, as_global(KP(w_eg)), as_global(KP(w_eu)), l ^ 1, l); if (REP_PHASE == 19) p_moe1_mfma<1>(ldsb, ws, as_global(KP(w_eg)), as_global(KP(w_eu)), l ^ 1, l); if (REP_PHASE == 20) p_moe1_mfma<2>(ldsb, ws, as_global(KP(w_eg)), as_global(KP(w_eu)), l ^ 1, l);
            p_moe1_mfma<0>(ldsb, ws, as_global(KP(w_eg)), as_global(KP(w_eu)), l, l); }
        GRID_BAR(pb + 8);
        if (PHON(9) && IN(pb + 9)) REPS(9) { unsigned char* ws = ws0; asm volatile("" : "+s"(ws)); ws = as_global(ws); p_moe2_mfma(ldsb, ws, as_global(KP(w_ed)), l); }
        GRID_BAR(pb + 9);
        if (PHON(10) && IN(pb + 10)) REPS(10) { unsigned char* ws = ws0; asm volatile("" : "+s"(ws)); ws = as_global(ws); p_ln2v2(ldsb, ws, as_global(KP(ln1g)) + (size_t)l * D, as_global(KP(ln1b)) + (size_t)l * D, as_global(KP(ln2g)) + (size_t)l * D, as_global(KP(ln2b)) + (size_t)l * D, (l == DEPTH - 1) ? as_global(KP(out)) : (float*)(ws + WS_H2F), l); }
        GRID_BAR(pb + 10);
    }
    if (STAMP_A >= 0) {
        if (ph_lo < ph_hi) xcd_barrier(bar);
        if (blockIdx.x == 0) {
            volatile unsigned long long* st = (volatile unsigned long long*)(ws0 + WS_BAR + 14800);
            if (threadIdx.x == 0) st[DEPTH * NPH + 1] = __builtin_amdgcn_s_memrealtime();
            __syncthreads();
            float da = 0.f, db = 0.f;
            for (int l = 0; l < DEPTH; ++l) {
                if (STAMP_A == 0) { if (l == 0) da += (float)(st[1] - st[0]); } else da += (float)(st[l * NPH + STAMP_A + 1] - st[l * NPH + STAMP_A]);
                if (STAMP_B == 0) { if (l == 0) db += (float)(st[1] - st[0]); } else if (STAMP_B > 0) db += (float)(st[l * NPH + STAMP_B + 1] - st[l * NPH + STAMP_B]);
            }
            da *= 0.01f; db *= 0.01f;
            float* o = as_global(KP(out));
            for (int i = threadIdx.x; i < 65536; i += NTHREADS) o[i] = sqrtf(da);
            if (threadIdx.x == 0 && STAMP_B >= 0) o[70000] = db;
        }
    }
}

#ifndef MK_ONE_LAUNCH
#define MK_ONE_LAUNCH 1
#endif
extern "C" void kernel_launch(void* const* d_in, const int* in_sizes, int n_in, void* d_out, int out_size, void* d_ws, size_t ws_size, hipStream_t stream) {
    static int grid = 0;
    if (!grid) {
        if (n_in != 21 || in_sizes[0] != T * D || out_size != T * D || ws_size < WS_END) {
            fprintf(stderr, "kernel_launch: unexpected shapes (n_in %d, in0 %d, out %d, ws %zu, need %zu); nothing launched\n", n_in, n_in > 0 ? in_sizes[0] : -1, out_size, ws_size, (size_t)WS_END);
            grid = -1; return; }
        int dev = 0, cus = 0, per_cu = 0;
        hipGetDevice(&dev); hipDeviceGetAttribute(&cus, hipDeviceAttributeMultiprocessorCount, dev);
        if (hipFuncSetAttribute((const void*)hybrid_fwd, hipFuncAttributeMaxDynamicSharedMemorySize, LDS_BYTES) != hipSuccess) { fprintf(stderr, "kernel_launch: hipFuncSetAttribute failed\n"); grid = -1; return; }
        hipOccupancyMaxActiveBlocksPerMultiprocessor(&per_cu, (const void*)hybrid_fwd, NTHREADS, LDS_BYTES);
        if (per_cu < 1) fprintf(stderr, "kernel_launch: occupancy query reports %d blocks per CU\n", per_cu);
        grid = cus > 0 ? cus : 256;
    }
    if (grid < 0) return;
    hipMemsetAsync((char*)d_ws, 0, WS_CTL_END, stream);
    Params p{};
    p.x = (const float*)d_in[0]; p.pos = (const int*)d_in[1];
    p.w_in = (const float*)d_in[2]; p.g_q = (const float*)d_in[3]; p.w_qb = (const float*)d_in[4]; p.g_kv = (const float*)d_in[5]; p.w_kvb = (const float*)d_in[6];
    p.w_oa = (const float*)d_in[7]; p.w_ob = (const float*)d_in[8]; p.w_out = (const float*)d_in[9]; p.ln1g = (const float*)d_in[10]; p.ln1b = (const float*)d_in[11];
    p.w_group = (const float*)d_in[12]; p.b_group = (const float*)d_in[13]; p.w_router = (const float*)d_in[14]; p.b_router = (const float*)d_in[15];
    p.w_eg = (const float*)d_in[16]; p.w_eu = (const float*)d_in[17]; p.w_ed = (const float*)d_in[18]; p.ln2g = (const float*)d_in[19]; p.ln2b = (const float*)d_in[20];
    p.out = (float*)d_out; p.ws = (unsigned char*)d_ws;
#if MK_ONE_LAUNCH
    hipLaunchKernelGGL(hybrid_fwd, dim3(grid), dim3(NTHREADS), LDS_BYTES, stream, p, 0, DEPTH * NPH);
#else
    for (int ph = 0; ph <= DEPTH * NPH; ++ph) hipLaunchKernelGGL(hybrid_fwd, dim3(grid), dim3(NTHREADS), LDS_BYTES, stream, p, ph, ph);
#endif
}
```

```cpp
#include <hip/hip_runtime.h>
#include <cstdio>
#include <cstdint>

typedef unsigned short bf16_t;
typedef float f32x4 __attribute__((ext_vector_type(4)));
typedef unsigned u32x4 __attribute__((ext_vector_type(4)));
typedef unsigned u32x2 __attribute__((ext_vector_type(2)));

constexpr int T = 8192, D = 2048, S = 4096, NB = 2, DEPTH = 2;
constexpr int INW = 9360, INP = 9472;
constexpr int NE = 64, FE = 512;
constexpr int NTHREADS = 512;
constexpr int LDS_BYTES = 147456;
constexpr float ALPHA = 1.41421356237309515f;
constexpr int ECAP = 8192;
#ifndef MOE_RBLK
#define MOE_RBLK 384
#endif
constexpr int PMAX = 40960;

constexpr size_t al256(size_t x) { return (x + 255) & ~(size_t)255; }
constexpr size_t XCD_BAR_BYTES = 16384;
constexpr size_t WS_BAR = 0;
constexpr size_t WS_CNT = WS_BAR + XCD_BAR_BYTES;
constexpr size_t WS_CTL_END = WS_CNT + al256(DEPTH * 64 * 4);
constexpr size_t WS_SSQ = WS_CTL_END;
constexpr size_t WS_ROPE = WS_SSQ + al256((size_t)T * 32 * 4);
constexpr size_t WS_XB = WS_ROPE + al256((size_t)T * 112 * 4);
constexpr size_t WS_H2F = WS_XB + al256((size_t)T * D * 2);
constexpr size_t WS_CQ = WS_H2F + al256((size_t)T * D * 4);
constexpr size_t WS_CKV = WS_CQ + al256((size_t)T * 512 * 2);
constexpr size_t WS_QB = WS_CKV + al256((size_t)T * 512 * 2);
constexpr size_t WS_KB = WS_QB + al256((size_t)T * 1024 * 2);
constexpr size_t WS_VB = WS_KB + al256((size_t)T * 1024 * 2);
constexpr size_t WS_QI = WS_VB + al256((size_t)T * 1024 * 2);
constexpr size_t WS_KI = WS_QI + al256((size_t)T * 1024 * 2);
constexpr size_t WS_WI = WS_KI + al256((size_t)T * 64 * 2);
constexpr size_t WS_GA = WS_WI + al256((size_t)T * 16 * 4);
constexpr size_t WS_GB = WS_GA + al256((size_t)T * D * 2);
constexpr size_t WS_QA = WS_GB + al256((size_t)T * D * 2);
constexpr size_t WS_KA = WS_QA + al256((size_t)T * 1536 * 2);
constexpr size_t WS_VA = WS_KA + al256((size_t)T * 1536 * 2);
constexpr size_t WS_MASK = WS_VA + al256((size_t)T * 1024 * 2);
constexpr size_t WS_OA = WS_MASK + al256((size_t)T * 128 * 4);
constexpr size_t WS_OB = WS_OA + al256((size_t)T * 1024 * 2);
constexpr size_t WS_YT = WS_OB + al256((size_t)T * 1024 * 2);
constexpr size_t WS_Y = WS_YT + al256((size_t)T * D * 4);
constexpr size_t WS_V1 = WS_Y + al256((size_t)T * D * 2);
constexpr size_t WS_H1F = WS_V1 + al256((size_t)T * D * 4);
constexpr size_t WS_H1B = WS_H1F + al256((size_t)T * D * 4);
constexpr size_t WS_TOKE = WS_H1B + al256((size_t)T * D * 2);
constexpr size_t WS_TOKW = WS_TOKE + al256((size_t)T * 2 * 4);
constexpr size_t WS_TOKS = WS_TOKW + al256((size_t)T * 2 * 4);
constexpr size_t WS_LIST = WS_TOKS + al256((size_t)T * 2 * 4);
constexpr size_t WS_HID = WS_LIST + al256((size_t)NE * ECAP * 4);
constexpr size_t WS_YE = WS_HID + al256((size_t)PMAX * FE * 2);
constexpr size_t WS_RWS = WS_YE + al256((size_t)PMAX * D * 2);
constexpr size_t WS_GWS = WS_RWS + al256((size_t)DEPTH * D * 64 * 4);
constexpr size_t WS_SEC = WS_GWS + al256((size_t)DEPTH * D * 8 * 4);
constexpr size_t WS_RWH = WS_SEC + al256((size_t)DEPTH * 160 * 4);
constexpr size_t WS_RWL = WS_RWH + al256((size_t)DEPTH * 96 * D * 2);
constexpr size_t WS_STATS = WS_RWL + al256((size_t)DEPTH * 96 * D * 2);
constexpr size_t WS_SCORE = WS_STATS + al256((size_t)T * 2 * 4);
constexpr size_t WS_WIN_T = WS_SCORE + al256((size_t)T * 4096 * 4);
constexpr size_t WS_WQB_T = WS_WIN_T + al256((size_t)DEPTH * INP * D * 2);
constexpr size_t WS_WKVB_T = WS_WQB_T + al256((size_t)DEPTH * 1536 * 512 * 2);
constexpr size_t WS_WOA_T = WS_WKVB_T + al256((size_t)DEPTH * 2048 * 512 * 2);
constexpr size_t WS_WOB_T = WS_WOA_T + al256((size_t)DEPTH * D * 1024 * 2);
constexpr size_t WS_WOUT_T = WS_WOB_T + al256((size_t)DEPTH * D * 1024 * 2);
constexpr size_t WS_END = WS_WOUT_T + al256((size_t)DEPTH * D * D * 2);
static_assert(WS_CKV == WS_CQ + (size_t)T * 512 * 2, "CQ|CKV must be consecutive");

static_assert(WS_KB == WS_QB + (size_t)T * 1024 * 2 && WS_VB == WS_KB + (size_t)T * 1024 * 2 && WS_GB == WS_GA + (size_t)T * D * 2, "QB|KB|VB and GA|GB must be consecutive");
struct Params {
    const float* x; const int* pos;
    const float *w_in, *g_q, *w_qb, *g_kv, *w_kvb, *w_oa, *w_ob, *w_out, *ln1g, *ln1b, *w_group, *b_group, *w_router, *b_router, *w_eg, *w_eu, *w_ed, *ln2g, *ln2b;
    float* out; unsigned char* ws;
};

__device__ __forceinline__ float bf2f(bf16_t v) { return __uint_as_float((unsigned)v << 16); }
__device__ __forceinline__ bf16_t f2bf(float f) { unsigned u = __float_as_uint(f); u += 0x7fffu + ((u >> 16) & 1u); return (bf16_t)(u >> 16); }
__device__ __forceinline__ unsigned pk2(float a, float b) { return (unsigned)f2bf(a) | ((unsigned)f2bf(b) << 16); }
__device__ __forceinline__ void st4bf(bf16_t* p, f32x4 v) { u32x2 w; w.x = pk2(v[0], v[1]); w.y = pk2(v[2], v[3]); *(u32x2*)p = w; }
__device__ __forceinline__ float wave_sum(float v) {
#pragma unroll
    for (int o = 32; o >= 1; o >>= 1) v += __shfl_xor(v, o);
    return v;
}
__device__ __forceinline__ float wave_max(float v) {
#pragma unroll
    for (int o = 32; o >= 1; o >>= 1) v = fmaxf(v, __shfl_xor(v, o));
    return v;
}
__device__ __forceinline__ int block_sum_int(int v, int* red) {
#pragma unroll
    for (int o = 32; o >= 1; o >>= 1) v += __shfl_xor(v, o);
    if ((threadIdx.x & 63) == 0) red[threadIdx.x >> 6] = v;
    __syncthreads();
    int t = 0;
#pragma unroll
    for (int i = 0; i < 8; ++i) t += red[i];
    __syncthreads();
    return t;
}
__device__ __forceinline__ f32x4 rot4(f32x4 v, float c0, float s0, float c1, float s1) { f32x4 o; o[0] = v[0] * c0 - v[1] * s0; o[1] = v[1] * c0 + v[0] * s0; o[2] = v[2] * c1 - v[3] * s1; o[3] = v[3] * c1 + v[2] * s1; return o; }

#define XB_TMO      128
#define XB_XCNT(j)  (256  + 64 * (j))
#define XB_XSUB(j)  (1280 + 64 * (j))
#define XB_XGEN(j)  (2304 + 64 * (j))
#define XB_TOP      3328
#define XB_TOPGEN   3392
#define XCD_BAR_WORDS 3456
#define XB_SPIN_CAP (1u << 22)
#define LAS __attribute__((address_space(3)))
__device__ __forceinline__ unsigned xb_ld(unsigned* p)              { return __hip_atomic_load(p, __ATOMIC_RELAXED, __HIP_MEMORY_SCOPE_AGENT); }
__device__ __forceinline__ unsigned xb_add(unsigned* p, unsigned v) { return __hip_atomic_fetch_add(p, v, __ATOMIC_RELAXED, __HIP_MEMORY_SCOPE_AGENT); }
__device__ __forceinline__ unsigned xb_xcc_id() { return (unsigned)__builtin_amdgcn_s_getreg((3 << 11) | 20) & 0xFu; }
#define XB_SPIN(cond, bar) do { unsigned _sp = 0; while (cond) { __builtin_amdgcn_s_sleep(1); \
    if ((++_sp & 255u) == 0u) { if (xb_ld(&(bar)[XB_TMO])) break; if (_sp > XB_SPIN_CAP) { atomicAdd(&(bar)[XB_TMO], 1u); break; } } } } while (0)
struct XcdBarrier { unsigned* bar; unsigned x; volatile LAS unsigned* st; };
__device__ __forceinline__ XcdBarrier xcd_barrier_post(unsigned* bar, volatile LAS unsigned* st) {
    XcdBarrier b; b.bar = bar; b.x = xb_xcc_id(); b.st = st;
    if (threadIdx.x == 0) (void)xb_add(&bar[XB_XCNT(b.x)], 1u);
    return b;
}
__device__ __forceinline__ void xcd_barrier_complete(unsigned* bar, unsigned x, unsigned& nloc, unsigned& nx) {
    const unsigned G = gridDim.x * gridDim.y * gridDim.z;
    unsigned sum, cnt, mine, sp = 0u;
    for (;;) {
        sum = 0u; cnt = 0u; mine = 0u;
#pragma unroll
        for (unsigned j = 0; j < 16; ++j) { const unsigned c = xb_ld(&bar[XB_XCNT(j)]); sum += c; cnt += (c > 0u) ? 1u : 0u; mine = (j == x) ? c : mine; }
        if (sum == G) break;
        __builtin_amdgcn_s_sleep(1);
        if ((++sp & 255u) == 0u) { if (xb_ld(&bar[XB_TMO])) break; if (sp > XB_SPIN_CAP) { atomicAdd(&bar[XB_TMO], 1u); break; } }
    }
    nloc = mine > 0u ? mine : 1u; nx = cnt > 0u ? cnt : 1u;
}
__device__ __forceinline__ void xcd_barrier(const XcdBarrier& b) {
    asm volatile("s_waitcnt vmcnt(0)" ::: "memory");
    __syncthreads();
    if (threadIdx.x == 0) {
        unsigned* bar = b.bar; asm volatile("" : "+s"(bar));
        __builtin_amdgcn_s_waitcnt(0);
        unsigned nloc = b.st[0], nx = b.st[1];
        unsigned bx = b.x; asm volatile("" : "+s"(bx));
        if (nloc == 0u) { xcd_barrier_complete(bar, bx, nloc, nx); b.st[0] = nloc; b.st[1] = nx; }
        const unsigned old = xb_add(&bar[XB_XSUB(bx)], 1u);
        const unsigned gen = old / nloc;
        if (old + 1u == (gen + 1u) * nloc) {
            __builtin_amdgcn_fence(__ATOMIC_RELEASE, "agent");
            asm volatile("s_waitcnt vmcnt(0)" ::: "memory");
            const unsigned og = xb_add(&bar[XB_TOP], 1u);
            const unsigned tg = og / nx;
            if (og + 1u == (tg + 1u) * nx) xb_add(&bar[XB_TOPGEN], 1u);
            else XB_SPIN(xb_ld(&bar[XB_TOPGEN]) == tg, bar);
            __builtin_amdgcn_fence(__ATOMIC_ACQUIRE, "agent");
            xb_add(&bar[XB_XGEN(bx)], 1u);
            asm volatile("s_waitcnt vmcnt(0)" ::: "memory");
        } else {
            XB_SPIN(xb_ld(&bar[XB_XGEN(bx)]) == gen, bar);
            __builtin_amdgcn_fence(__ATOMIC_ACQUIRE, "agent");
            asm volatile("s_waitcnt vmcnt(0)" ::: "memory");
        }
    }
    __syncthreads();
}

__device__ __forceinline__ int opaque_tid() { int t = threadIdx.x; asm volatile("" : "+v"(t)); return t; }
__device__ __forceinline__ int opaque_bid() { int b = blockIdx.x; asm volatile("" : "+s"(b)); return b; }
namespace pg8 {
#define PG8_LAS __attribute__((address_space(3)))
typedef unsigned short bf16_t;
typedef short bf16x8 __attribute__((ext_vector_type(8)));
typedef float f32x4 __attribute__((ext_vector_type(4)));
typedef unsigned u32x4 __attribute__((ext_vector_type(4)));
constexpr int BM = 256, BK = 64, HALF = 128, HTB = HALF * BK * 2  , STAGE_BYTES = 8 * HTB, NXCD = 8, WGM = 8;

__host__ __device__ __forceinline__ int lds_byte(int r, int c) { const int st = (r >> 4) * 2 + (c >> 5), rr = r & 15, cc = c & 31, ob = rr * 64 + cc * 2; return st * 1024 + (ob ^ (((ob >> 9) & 1) << 5)); }
__host__ __device__ __forceinline__ void stage_rc(int b, int& R, int& C) { const int st = b / 1024, sb = b % 1024, swz = sb ^ (((sb >> 9) & 1) << 5); R = (st >> 1) * 16 + swz / 64; C = (st & 1) * 32 + (swz % 64) / 2; }
__host__ __device__ __forceinline__ int perm32(int rho) { const int n = rho >> 4, i = rho & 15; return 8 * (i >> 2) + 4 * n + (i & 3); }

struct Unit { int pm, pn; };
struct Gemm { const bf16_t* A; const bf16_t* Bt; int M, N, K; };

struct StaticOrder {
    int nM, nN, nwg, G, c;
    __host__ __device__ void init(int M, int N, int G_, int c_) { nM = M / BM; nN = N / BM; nwg = nM * nN; G = G_; c = c_; }
    __host__ __device__ bool next(int i, Unit& u) const {
        const long L = (long)i * G + c; if (L >= nwg) return false;
        int wgid = (int)L; { const int q = nwg / NXCD, r = nwg % NXCD, xcd = wgid % NXCD, off = wgid / NXCD; wgid = (xcd < r ? xcd * (q + 1) : r * (q + 1) + (xcd - r) * q) + off; }
        const int nig = WGM * nN, gid = wgid / nig, fm = gid * WGM, gsz = (nM - fm) < WGM ? (nM - fm) : WGM;
        u.pm = fm + ((wgid % nig) % gsz); u.pn = (wgid % nig) / gsz; return true;
    }
    __device__ __forceinline__ void a_ready(const Unit&) const {}
    __device__ __forceinline__ void done(const Unit&) const {}
};

__device__ __forceinline__ unsigned cvt_pk_bf16(float lo, float hi) { unsigned r; asm volatile("v_cvt_pk_bf16_f32 %0, %1, %2" : "=v"(r) : "v"(lo), "v"(hi)); return r; }
template <class Epi, class Sched, bool ALIGN_EPI = false, bool SP2 = false>
__device__ __forceinline__ void gemm_phase(PG8_LAS unsigned char* lds, const Gemm g, const Sched& S, const Epi& E) {
    const int tid = opaque_tid(), wid = __builtin_amdgcn_readfirstlane(tid >> 6), lane = tid & 63, wr = wid >> 2, wc = wid & 3, fr = lane & 15, fq = lane >> 4;
    const int K = g.K, nt = K / BK;
    unsigned voffA[2], voffB[2];
#pragma unroll
    for (int i = 0; i < 2; ++i) { int R, C; stage_rc(tid * 16 + i * 8192, R, C); const int Rb = Epi::PERM ? ((R & ~31) + perm32(R & 31)) : R;
        voffA[i] = (unsigned)(R * K + C) * 2u; voffB[i] = (unsigned)(Rb * K + C) * 2u; }
    const size_t kstep = (size_t)(BK * 2);
    const size_t hstep = (size_t)HALF * K * 2;
    const size_t tstep = 2 * hstep;
    const unsigned ldsw = (unsigned)wid * 1024u;
    const int aoff = lds_byte(wr * 64 + fr, fq * 8), boff = lds_byte(wc * 32 + fr, fq * 8);
#define PG8_SA(b, h) (((b) * 2 + (h)) * HTB)
#define PG8_SB(b, h) ((4 + (b) * 2 + (h)) * HTB)
#define PG8_STAGE(bufoff, gbase, voff) do { _Pragma("unroll") for (int _i = 0; _i < 2; ++_i) \
        __builtin_amdgcn_global_load_lds((const unsigned*)((const char*)(gbase) + (voff)[_i]), (PG8_LAS unsigned*)(lds + (bufoff) + ldsw + _i * 8192), 16, 0, 0); } while (0)
#define PG8_LDA(dst, b, h) do { _Pragma("unroll") for (int m = 0; m < 4; ++m) _Pragma("unroll") for (int k = 0; k < 2; ++k) dst[m][k] = *(const PG8_LAS bf16x8*)(lds + PG8_SA(b, h) + aoff + m * 2048 + k * 1024); } while (0)
#define PG8_LDB(dst, b, h) do { _Pragma("unroll") for (int n = 0; n < 2; ++n) _Pragma("unroll") for (int k = 0; k < 2; ++k) dst[n][k] = *(const PG8_LAS bf16x8*)(lds + PG8_SB(b, h) + boff + n * 2048 + k * 1024); } while (0)
#define PG8_MMA(ai, bj, At, Bt) do { __builtin_amdgcn_s_setprio(1); _Pragma("unroll") for (int m = 0; m < 4; ++m) _Pragma("unroll") for (int n = 0; n < 2; ++n) _Pragma("unroll") for (int k = 0; k < 2; ++k) \
        acc[ai][bj][m][n] = __builtin_amdgcn_mfma_f32_16x16x32_bf16(Bt[n][k], At[m][k], acc[ai][bj][m][n], 0, 0, 0); __builtin_amdgcn_s_setprio(0); } while (0)
#define PG8_WAIT_V(n) asm volatile("s_waitcnt vmcnt(" #n ")" ::: "memory")
#define PG8_WAIT_L(n) asm volatile("s_waitcnt lgkmcnt(" #n ")" ::: "memory")
#define PG8_BAR __builtin_amdgcn_s_barrier()
#define PG8_SCHED __builtin_amdgcn_sched_barrier(0)
    Unit cur, nxt; int ui = 0;
    if (!S.next(0, cur)) return;
    f32x4 acc[2][2][4][2];
#pragma unroll
    for (int a = 0; a < 2; ++a)
#pragma unroll
        for (int b = 0; b < 2; ++b)
#pragma unroll
            for (int m = 0; m < 4; ++m)
#pragma unroll
                for (int n = 0; n < 2; ++n) acc[a][b][m][n] = (f32x4){0.f, 0.f, 0.f, 0.f};
    bf16x8 At[4][2], B0[2][2], B1[2][2];
    const char* cA = (const char*)g.A + (size_t)cur.pm * tstep; const char* cB = (const char*)g.Bt + (size_t)cur.pn * tstep;
    S.a_ready(cur);
    if constexpr (SP2) {
        PG8_STAGE(PG8_SB(0, 0), cB, voffB); PG8_STAGE(PG8_SB(0, 1), cB + hstep, voffB); PG8_STAGE(PG8_SA(0, 0), cA, voffA); PG8_STAGE(PG8_SA(0, 1), cA + hstep, voffA);
        if (wr == 1) PG8_BAR;
        PG8_WAIT_V(2); PG8_BAR;
        PG8_STAGE(PG8_SB(1, 0), cB + kstep, voffB); PG8_STAGE(PG8_SA(1, 0), cA + kstep, voffA); PG8_STAGE(PG8_SB(1, 1), cB + hstep + kstep, voffB);
        PG8_WAIT_V(6); PG8_BAR;
    } else {
        PG8_STAGE(PG8_SB(0, 0), cB, voffB); PG8_STAGE(PG8_SA(0, 0), cA, voffA); PG8_STAGE(PG8_SB(0, 1), cB + hstep, voffB); PG8_STAGE(PG8_SA(0, 1), cA + hstep, voffA);
        if (wr == 1) PG8_BAR;
        PG8_WAIT_V(4); PG8_BAR;
        PG8_STAGE(PG8_SB(1, 0), cB + kstep, voffB); PG8_STAGE(PG8_SA(1, 0), cA + kstep, voffA); PG8_STAGE(PG8_SB(1, 1), cB + hstep + kstep, voffB);
        PG8_WAIT_V(6); PG8_BAR;
    }
    for (;;) {
        const bool has_next = S.next(ui + 1, nxt);
        const char* nA = has_next ? (const char*)g.A + (size_t)nxt.pm * tstep : cA; const char* nB = has_next ? (const char*)g.Bt + (size_t)nxt.pn * tstep : cB;
        for (int t = 0; t < nt; t += 2) {
            const bool last = (t == nt - 2);
            const char* a1 = cA + (size_t)(t + 1) * kstep;
            const char* a2 = last ? nA : cA + (size_t)(t + 2) * kstep; const char* b2 = last ? nB : cB + (size_t)(t + 2) * kstep;
            const char* a3 = a2 + kstep; const char* b3 = b2 + kstep;
            if (last && has_next) S.a_ready(nxt);
            if constexpr (SP2) {
            PG8_LDB(B0, 0, 0); PG8_LDB(B1, 0, 1); PG8_SCHED; PG8_LDA(At, 0, 0); PG8_STAGE(PG8_SA(1, 1), a1 + hstep, voffA);
            PG8_WAIT_V(8); PG8_WAIT_L(0); PG8_BAR; PG8_MMA(0, 0, At, B0); PG8_MMA(0, 1, At, B1); PG8_BAR; PG8_SCHED;
            PG8_LDA(At, 0, 1); PG8_STAGE(PG8_SB(0, 0), b2, voffB); PG8_STAGE(PG8_SB(0, 1), b2 + hstep, voffB); PG8_STAGE(PG8_SA(0, 0), a2, voffA);
            PG8_WAIT_V(8); PG8_WAIT_L(0); PG8_BAR; PG8_MMA(1, 0, At, B0); PG8_MMA(1, 1, At, B1); PG8_BAR; PG8_SCHED;
            PG8_LDB(B0, 1, 0); PG8_LDB(B1, 1, 1); PG8_SCHED; PG8_LDA(At, 1, 0); PG8_STAGE(PG8_SA(0, 1), a2 + hstep, voffA);
            PG8_WAIT_V(8); PG8_WAIT_L(0); PG8_BAR; PG8_MMA(0, 0, At, B0); PG8_MMA(0, 1, At, B1); PG8_BAR; PG8_SCHED;
            PG8_LDA(At, 1, 1); PG8_STAGE(PG8_SB(1, 0), b3, voffB); PG8_STAGE(PG8_SB(1, 1), b3 + hstep, voffB); PG8_STAGE(PG8_SA(1, 0), a3, voffA);
            PG8_WAIT_V(8); PG8_WAIT_L(0); PG8_BAR; PG8_MMA(1, 0, At, B0); PG8_MMA(1, 1, At, B1); PG8_BAR; PG8_SCHED;
            } else {
            PG8_LDB(B0, 0, 0); PG8_SCHED; PG8_LDA(At, 0, 0); PG8_STAGE(PG8_SA(1, 1), a1 + hstep, voffA);
            PG8_WAIT_L(8); PG8_BAR; PG8_WAIT_L(0); PG8_MMA(0, 0, At, B0); PG8_BAR; PG8_SCHED;
            PG8_LDB(B1, 0, 1); PG8_STAGE(PG8_SB(0, 0), b2, voffB);
            PG8_BAR; PG8_WAIT_L(0); PG8_MMA(0, 1, At, B1); PG8_BAR;
            PG8_LDA(At, 0, 1); PG8_STAGE(PG8_SA(0, 0), a2, voffA);
            PG8_BAR; PG8_WAIT_L(0); PG8_MMA(1, 0, At, B0); PG8_BAR; PG8_SCHED;
            PG8_STAGE(PG8_SB(0, 1), b2 + hstep, voffB);
            PG8_WAIT_V(6); PG8_BAR; PG8_MMA(1, 1, At, B1); PG8_BAR;
            PG8_LDB(B0, 1, 0); PG8_SCHED; PG8_LDA(At, 1, 0); PG8_STAGE(PG8_SA(0, 1), a2 + hstep, voffA);
            PG8_WAIT_L(8); PG8_BAR; PG8_WAIT_L(0); PG8_MMA(0, 0, At, B0); PG8_BAR; PG8_SCHED;
            PG8_LDB(B1, 1, 1); PG8_STAGE(PG8_SB(1, 0), b3, voffB);
            PG8_BAR; PG8_WAIT_L(0); PG8_MMA(0, 1, At, B1); PG8_BAR;
            PG8_LDA(At, 1, 1); PG8_STAGE(PG8_SA(1, 0), a3, voffA);
            PG8_BAR; PG8_WAIT_L(0); PG8_MMA(1, 0, At, B0); PG8_BAR; PG8_SCHED;
            PG8_STAGE(PG8_SB(1, 1), b3 + hstep, voffB);
            PG8_WAIT_V(6); PG8_BAR; PG8_MMA(1, 1, At, B1); PG8_BAR;
            }
        }
        if constexpr (ALIGN_EPI) { if (wr == 0) PG8_BAR; }
        if constexpr (!Epi::AFTER_DRAIN) { E(acc, cur, wr, wc, fr, fq); S.done(cur); }
        if (!has_next) break;
#pragma unroll
        for (int a = 0; a < 2; ++a)
#pragma unroll
            for (int b = 0; b < 2; ++b)
#pragma unroll
                for (int m = 0; m < 4; ++m)
#pragma unroll
                    for (int n = 0; n < 2; ++n) acc[a][b][m][n] = (f32x4){0.f, 0.f, 0.f, 0.f};
        cur = nxt; cA = nA; cB = nB; ++ui;
        if constexpr (ALIGN_EPI) { if (wr == 1) PG8_BAR; }
    }
    PG8_WAIT_V(0);
    if constexpr (!ALIGN_EPI) { if (wr == 0) PG8_BAR; }
    PG8_BAR;
    if constexpr (Epi::AFTER_DRAIN) { E.fused(acc, cur, wr, wc, fr, fq, lds, wid, lane); S.done(cur); }
#undef PG8_SA
#undef PG8_SB
#undef PG8_STAGE
#undef PG8_LDA
#undef PG8_LDB
#undef PG8_MMA
#undef PG8_WAIT_V
#undef PG8_WAIT_L
#undef PG8_BAR
#undef PG8_SCHED
}
}

__device__ __forceinline__ unsigned pkbf(float lo, float hi) { return pg8::cvt_pk_bf16(lo, hi); }
__device__ __forceinline__ void st8bf(bf16_t* p, f32x4 a, f32x4 b) { u32x4 w; w.x = pkbf(a[0], a[1]); w.y = pkbf(a[2], a[3]); w.z = pkbf(b[0], b[1]); w.w = pkbf(b[2], b[3]); *(u32x4*)p = w; }
__device__ __forceinline__ f32x4 bflo(u32x4 g) { f32x4 o; o[0] = __uint_as_float(g.x << 16); o[1] = __uint_as_float(g.x & 0xffff0000u); o[2] = __uint_as_float(g.y << 16); o[3] = __uint_as_float(g.y & 0xffff0000u); return o; }
__device__ __forceinline__ f32x4 bfhi(u32x4 g) { f32x4 o; o[0] = __uint_as_float(g.z << 16); o[1] = __uint_as_float(g.z & 0xffff0000u); o[2] = __uint_as_float(g.w << 16); o[3] = __uint_as_float(g.w & 0xffff0000u); return o; }
__device__ __forceinline__ f32x4 bf4(u32x2 g) { f32x4 o; o[0] = __uint_as_float(g.x << 16); o[1] = __uint_as_float(g.x & 0xffff0000u); o[2] = __uint_as_float(g.y << 16); o[3] = __uint_as_float(g.y & 0xffff0000u); return o; }
__device__ __forceinline__ void rot8(f32x4& a, f32x4& b, f32x4 c, f32x4 s) {
    const f32x4 x = a, y = b;
    a[0] = x[0] * c[0] - x[1] * s[0]; a[1] = x[1] * c[0] + x[0] * s[0]; a[2] = x[2] * c[1] - x[3] * s[1]; a[3] = x[3] * c[1] + x[2] * s[1];
    b[0] = y[0] * c[2] - y[1] * s[2]; b[1] = y[1] * c[2] + y[0] * s[2]; b[2] = y[2] * c[3] - y[3] * s[3]; b[3] = y[3] * c[3] + y[2] * s[3];
}
__device__ __forceinline__ f32x4 sig4(f32x4 v) { f32x4 o; o[0] = 1.f / (1.f + __expf(-v[0])); o[1] = 1.f / (1.f + __expf(-v[1])); o[2] = 1.f / (1.f + __expf(-v[2])); o[3] = 1.f / (1.f + __expf(-v[3])); return o; }
__host__ __device__ __forceinline__ int src_in(int n) {
    if (n < 1024) return n;
    if (n < 4096) { const int seg = (n - 1024) >> 10, c = (n - 1024) & 1023, d = c & 127; int od = d; if (seg < 2 && d < 32) od = (d >> 1) + (d & 1) * 16; return 1088 + seg * 1024 + (c & ~127) + od; }
    if (n < 5120) { const int c = n - 4096, d = c & 63; const int od = d < 16 ? (d >> 1) + (d & 1) * 8 : d; return 4160 + (c & ~63) + od; }
    if (n < 7168) return 5264 + (n - 5120);
    if (n < 9216) return 7312 + (n - 7168);
    if (n < 9280) { const int d = n - 9216; return 1024 + (d >> 1) + (d & 1) * 32; }
    if (n < 9344) { const int d = n - 9280; const int od = d < 16 ? (d >> 1) + (d & 1) * 8 : d; return 5184 + od; }
    if (n < 9360) return 5248 + (n - 9344);
    return -1;
}
__host__ __device__ __forceinline__ int src_qa(int n) { const int h = n / 192, d = n - h * 192; if (d < 128) return n; const int dd = d - 128; return h * 192 + 128 + (dd >> 1) + (dd & 1) * 32; }

struct EpiIn {
    static constexpr bool PERM = true, AFTER_DRAIN = false;
    unsigned char* ws;
    __device__ __forceinline__ void operator()(const f32x4 (&acc)[2][2][4][2], const pg8::Unit& u, int wr, int wc, int fr, int fq) const {
        const int row0 = u.pm * 256 + wr * 64 + fr, cu = wc * 32 + 8 * fq, pn = u.pn;
        bf16_t* const CQ = (bf16_t*)(ws + WS_CQ); bf16_t* const QB = (bf16_t*)(ws + WS_QB); bf16_t* const QI = (bf16_t*)(ws + WS_QI); bf16_t* const GA = (bf16_t*)(ws + WS_GA);
        bf16_t* const KA = (bf16_t*)(ws + WS_KA); bf16_t* const KI = (bf16_t*)(ws + WS_KI); float* const WI = (float*)(ws + WS_WI); float* const part = (float*)(ws + WS_SSQ);
        const float* const cM = (const float*)(ws + WS_ROPE); const float* const sM = cM + T * 32; const float* const cD = cM + T * 64; const float* const sD = cM + T * 80; const float* const cI = cM + T * 96; const float* const sI = cM + T * 104;
#define EPI_ROWS(BODY) _Pragma("unroll") for (int ai = 0; ai < 2; ++ai) _Pragma("unroll") for (int m = 0; m < 4; ++m) { const int t = row0 + ai * 128 + m * 16; \
            _Pragma("unroll") for (int bj = 0; bj < 2; ++bj) { f32x4 a = acc[ai][bj][m][0], b = acc[ai][bj][m][1]; BODY } }
        if (pn < 4) {
            bf16_t* const dst = CQ + (size_t)(pn >> 1) * ((size_t)T * 512) + (pn & 1) * 256 + cu;
            EPI_ROWS(
                st8bf(dst + (size_t)t * 512 + bj * 128, a, b);
                float sq = ((a[0] * a[0] + a[1] * a[1]) + (a[2] * a[2] + a[3] * a[3])) + ((b[0] * b[0] + b[1] * b[1]) + (b[2] * b[2] + b[3] * b[3]));
                sq += __shfl_xor(sq, 16); sq += __shfl_xor(sq, 32);
                if (fq == 0) part[(size_t)t * 32 + pn * 8 + bj * 4 + wc] = sq; )
        } else if (pn < 16) {
            const int seg = (pn - 4) >> 2; const bool rot = seg < 2 && wc == 0;
            bf16_t* const dst = QB + (size_t)seg * ((size_t)T * 1024) + ((pn - 4) & 3) * 256 + cu;
            EPI_ROWS(
                if (rot) rot8(a, b, *(const f32x4*)(cD + (size_t)t * 16 + 4 * fq), *(const f32x4*)(sD + (size_t)t * 16 + 4 * fq));
                st8bf(dst + (size_t)t * 1024 + bj * 128, a, b); )
        } else if (pn < 20) {
            const bool rot = (wc & 1) == 0 && fq < 2;
            bf16_t* const dst = QI + (size_t)(unsigned)((row0 >> 5) * 32768 + (row0 & 31) * 8 + (pn - 16) * 8192 + (cu >> 6) * 2048 + ((cu >> 4) & 3) * 512 + ((cu >> 3) & 1) * 256);
            EPI_ROWS(
                if (rot) rot8(a, b, *(const f32x4*)(cI + (size_t)t * 8 + 4 * fq), *(const f32x4*)(sI + (size_t)t * 8 + 4 * fq));
                st8bf(dst + (ai * 4 + (m >> 1)) * 32768 + (m & 1) * 128 + bj * 4096, a, b); )
        } else if (pn < 36) {
            bf16_t* const dst = GA + (size_t)((pn - 20) >> 3) * ((size_t)T * D) + ((pn - 20) & 7) * 256 + cu;
            EPI_ROWS( st8bf(dst + (size_t)t * D + bj * 128, sig4(a), sig4(b)); )
        } else {
            EPI_ROWS(
                if (bj == 0) {
                    if (wc < 2) {
                        rot8(a, b, *(const f32x4*)(cM + (size_t)t * 32 + (cu >> 1)), *(const f32x4*)(sM + (size_t)t * 32 + (cu >> 1)));
                        _Pragma("unroll") for (int h = 0; h < 8; ++h) st8bf(KA + (size_t)t * 1536 + h * 192 + 128 + cu, a, b);
                    } else {
                        const int d = cu - 64;
                        if (d < 16) rot8(a, b, *(const f32x4*)(cI + (size_t)t * 8 + (d >> 1)), *(const f32x4*)(sI + (size_t)t * 8 + (d >> 1)));
                        st8bf(KI + (size_t)t * 64 + d, a, b);
                    }
                } else if (cu < 16) {
                    *(f32x4*)(WI + (size_t)t * 16 + cu) = a * 0.03125f; *(f32x4*)(WI + (size_t)t * 16 + cu + 4) = b * 0.03125f;
                } )
        }
#undef EPI_ROWS
    }
};
__device__ __forceinline__ float rms_from_part(const float* pp) {
    const f32x4 p0 = *(const f32x4*)pp, p1 = *(const f32x4*)(pp + 4), p2 = *(const f32x4*)(pp + 8), p3 = *(const f32x4*)(pp + 12);
    const float s = (((p0[0] + p0[1]) + (p0[2] + p0[3])) + ((p1[0] + p1[1]) + (p1[2] + p1[3]))) + (((p2[0] + p2[1]) + (p2[2] + p2[3])) + ((p3[0] + p3[1]) + (p3[2] + p3[3])));
    return rsqrtf(s * (1.f / 512.f) + 1e-6f);
}
struct EpiQA {
    static constexpr bool PERM = true, AFTER_DRAIN = false;
    unsigned char* ws;
    __device__ __forceinline__ void operator()(const f32x4 (&acc)[2][2][4][2], const pg8::Unit& u, int wr, int wc, int fr, int fq) const {
        const int row0 = u.pm * 256 + wr * 64 + fr, cu = wc * 32 + 8 * fq;
        bf16_t* const QA = (bf16_t*)(ws + WS_QA); const float* const part = (const float*)(ws + WS_SSQ); const float* const cM = (const float*)(ws + WS_ROPE); const float* const sM = cM + T * 32;
#pragma unroll
        for (int ai = 0; ai < 2; ++ai)
#pragma unroll
            for (int m = 0; m < 4; ++m) {
                const int t = row0 + ai * 128 + m * 16;
                const float r = rms_from_part(part + (size_t)t * 32);
#pragma unroll
                for (int bj = 0; bj < 2; ++bj) {
                    const int n = u.pn * 256 + bj * 128 + cu, h = n / 192, d = n - h * 192;
                    f32x4 a = acc[ai][bj][m][0] * r, b = acc[ai][bj][m][1] * r;
                    if (d >= 128) rot8(a, b, *(const f32x4*)(cM + (size_t)t * 32 + ((d - 128) >> 1)), *(const f32x4*)(sM + (size_t)t * 32 + ((d - 128) >> 1)));
                    st8bf(QA + (size_t)t * 1536 + n, a, b);
                }
            }
    }
};
struct EpiKV {
    static constexpr bool PERM = true, AFTER_DRAIN = false;
    unsigned char* ws;
    __device__ __forceinline__ void operator()(const f32x4 (&acc)[2][2][4][2], const pg8::Unit& u, int wr, int wc, int fr, int fq) const {
        const int row0 = u.pm * 256 + wr * 64 + fr, cu = wc * 32 + 8 * fq;
        bf16_t* const KA = (bf16_t*)(ws + WS_KA); bf16_t* const VA = (bf16_t*)(ws + WS_VA); const float* const part = (const float*)(ws + WS_SSQ);
#pragma unroll
        for (int ai = 0; ai < 2; ++ai)
#pragma unroll
            for (int m = 0; m < 4; ++m) {
                const int t = row0 + ai * 128 + m * 16;
                const float r = rms_from_part(part + (size_t)t * 32 + 16);
                st8bf(KA + (size_t)t * 1536 + u.pn * 192 + cu, acc[ai][0][m][0] * r, acc[ai][0][m][1] * r);
                st8bf(VA + (size_t)t * 1024 + u.pn * 128 + cu, acc[ai][1][m][0] * r, acc[ai][1][m][1] * r);
            }
    }
};
struct EpiYA {
    static constexpr bool PERM = true, AFTER_DRAIN = false;
    unsigned char* ws;
    __device__ __forceinline__ void operator()(const f32x4 (&acc)[2][2][4][2], const pg8::Unit& u, int wr, int wc, int fr, int fq) const {
        const int row0 = u.pm * 256 + wr * 64 + fr, col0 = u.pn * 256 + wc * 32 + 8 * fq;
        bf16_t* const YT = (bf16_t*)(ws + WS_YT); const bf16_t* const GA = (const bf16_t*)(ws + WS_GA);
#pragma unroll
        for (int ai = 0; ai < 2; ++ai)
#pragma unroll
            for (int m = 0; m < 4; ++m)
#pragma unroll
                for (int bj = 0; bj < 2; ++bj) {
                    const size_t o = (size_t)(row0 + ai * 128 + m * 16) * D + col0 + bj * 128;
                    const u32x4 g = *(const u32x4*)(GA + o);
                    st8bf(YT + o, acc[ai][bj][m][0] * bflo(g), acc[ai][bj][m][1] * bfhi(g));
                }
    }
};
struct EpiYB {
    static constexpr bool PERM = true, AFTER_DRAIN = false;
    unsigned char* ws;
    __device__ __forceinline__ void operator()(const f32x4 (&acc)[2][2][4][2], const pg8::Unit& u, int wr, int wc, int fr, int fq) const {
        const int row0 = u.pm * 256 + wr * 64 + fr, col0 = u.pn * 256 + wc * 32 + 8 * fq;
        const bf16_t* const YT = (const bf16_t*)(ws + WS_YT); const bf16_t* const GB = (const bf16_t*)(ws + WS_GB); bf16_t* const Y = (bf16_t*)(ws + WS_Y);
#pragma unroll
        for (int ai = 0; ai < 2; ++ai)
#pragma unroll
            for (int m = 0; m < 4; ++m)
#pragma unroll
                for (int bj = 0; bj < 2; ++bj) {
                    const size_t o = (size_t)(row0 + ai * 128 + m * 16) * D + col0 + bj * 128;
                    const u32x4 g = *(const u32x4*)(GB + o);
                    const u32x4 yt = *(const u32x4*)(YT + o); const f32x4 y0 = bflo(yt), y1 = bfhi(yt);
                    st8bf(Y + o, y0 + acc[ai][bj][m][0] * bflo(g), y1 + acc[ai][bj][m][1] * bfhi(g));
                }
    }
};
struct EpiOut {
    static constexpr bool PERM = true, AFTER_DRAIN = false;
    const float* hin; float* V1;
    __device__ __forceinline__ void operator()(const f32x4 (&acc)[2][2][4][2], const pg8::Unit& u, int wr, int wc, int fr, int fq) const {
        const int row0 = u.pm * 256 + wr * 64 + fr, col0 = u.pn * 256 + wc * 32 + 8 * fq;
#pragma unroll
        for (int ai = 0; ai < 2; ++ai)
#pragma unroll
            for (int m = 0; m < 4; ++m)
#pragma unroll
                for (int bj = 0; bj < 2; ++bj) {
                    const size_t o = (size_t)(row0 + ai * 128 + m * 16) * D + col0 + bj * 128;
                    const f32x4 h0 = *(const f32x4*)(hin + o), h1 = *(const f32x4*)(hin + o + 4);
                    *(f32x4*)(V1 + o) = h0 * ALPHA + acc[ai][bj][m][0]; *(f32x4*)(V1 + o + 4) = h1 * ALPHA + acc[ai][bj][m][1];
                }
    }
};

#define LDS_WAIT() asm volatile("s_waitcnt lgkmcnt(0)" ::: "memory")
__device__ __forceinline__ void transpose_item(int MAP, const float* W, int ldw, int K, int N, const float* kscale, bf16_t* WT, LAS float* scr, int item, int lane) {
    const int nblk = N / 32, kb = item / nblk, nb = item % nblk, k0 = 64 * kb, n0 = 32 * nb;
    const int n = n0 + (lane & 31);
    const int sc = MAP == 0 ? n : (MAP == 1 ? src_in(n) : src_qa(n));
#pragma unroll 8
    for (int i = 0; i < 32; ++i) { const int kk = 2 * i + (lane >> 5);
        float v = sc >= 0 ? W[(size_t)(k0 + kk) * ldw + sc] : 0.f; if (kscale) v *= kscale[k0 + kk];
        scr[kk * 33 + (lane & 31)] = v; }
    LDS_WAIT(); asm volatile("" ::: "memory");
    const int c = lane & 7;
#pragma unroll
    for (int j = 0; j < 4; ++j) { const int nn = (lane >> 3) + 8 * j; const LAS float* sp = scr + (8 * c) * 33 + nn;
        u32x4 o; o.x = pkbf(sp[0 * 33], sp[1 * 33]); o.y = pkbf(sp[2 * 33], sp[3 * 33]); o.z = pkbf(sp[4 * 33], sp[5 * 33]); o.w = pkbf(sp[6 * 33], sp[7 * 33]);
        *(u32x4*)(WT + (size_t)(n0 + nn) * K + k0 + 8 * c) = o; }
    LDS_WAIT(); asm volatile("" ::: "memory");
}
__device__ __forceinline__ int tperm(int pm, int nn) {
    if (pm == 0) return nn;
    if (pm == 1) return nn < 32 ? (nn >> 1) + (nn & 1) * 16 : nn;
    if (pm == 2) return nn < 16 ? (nn >> 1) + (nn & 1) * 8 : nn;
    if (pm == 3) return (nn >> 1) + (nn & 1) * 32;
    if (pm == 4) return nn < 16 ? nn : -1;
    return -1;
}
__device__ __forceinline__ void transpose_block_vec(const float* W, int ldw, int K, int s0, int pm, int n0, int k0, const float* kscale, bf16_t* WT, LAS float* scr, int lane) {
    const int r = lane >> 4, c4 = lane & 15;
    f32x4 v[16];
#pragma unroll
    for (int i = 0; i < 16; ++i) v[i] = *(const f32x4*)(W + (size_t)(k0 + 4 * i + r) * ldw + s0 + 4 * c4);
    float ks[16];
#pragma unroll
    for (int i = 0; i < 16; ++i) ks[i] = kscale ? kscale[k0 + 4 * i + r] : 1.f;
#pragma unroll
    for (int i = 0; i < 16; ++i) { const int kk = 4 * i + r; const f32x4 w = v[i] * ks[i];
        LAS float* d = scr + kk * 65 + 4 * c4; d[0] = w[0]; d[1] = w[1]; d[2] = w[2]; d[3] = w[3]; }
    LDS_WAIT(); asm volatile("" ::: "memory");
    const int c = lane & 7;
#pragma unroll
    for (int j = 0; j < 8; ++j) { const int nn = (lane >> 3) + 8 * j, so = tperm(pm, nn); const LAS float* sp = scr + (8 * c) * 65 + (so < 0 ? 0 : so);
        u32x4 o; o.x = pkbf(sp[0 * 65], sp[1 * 65]); o.y = pkbf(sp[2 * 65], sp[3 * 65]); o.z = pkbf(sp[4 * 65], sp[5 * 65]); o.w = pkbf(sp[6 * 65], sp[7 * 65]);
        if (so < 0) o = (u32x4){0u, 0u, 0u, 0u};
        *(u32x4*)(WT + (size_t)(n0 + nn) * K + k0 + 8 * c) = o; }
    LDS_WAIT(); asm volatile("" ::: "memory");
}
__device__ __forceinline__ void p_wcopies(LAS unsigned char* ldsb, const Params& p, const int l1, const int lo1, const int hi1, const int l2, const int lo2, const int hi2, const int rank, const int nranks) {
    const int tid_ = opaque_tid(), wave = tid_ >> 6, lane = tid_ & 63;
    LAS float* scr = (LAS float*)(ldsb + wave * 16640);
    const int gw = rank * 8 + wave, NGW = nranks * 8;
    constexpr int B_IN = (D / 64) * (INP / 64), B_QB = (512 / 64) * (1536 / 64), B_KV = (512 / 64) * (2048 / 64), B_O = (1024 / 64) * (D / 64), B_OUT = (D / 64) * (D / 64);
    constexpr int B_LAYER = B_IN + B_QB + B_KV + 2 * B_O + B_OUT;
    const int n1 = hi1 - lo1, ntot = n1 + (hi2 - lo2);
    for (int it = gw; it < ntot; it += NGW) {
        const int l = it < n1 ? l1 : l2; int r = it < n1 ? lo1 + it : lo2 + (it - n1);
        int map = 0, ldw, K, N; const float* W; const float* ks = nullptr; bf16_t* WT;
        if (r < B_IN) { map = 1; W = p.w_in + (size_t)l * D * INW; ldw = INW; K = D; N = INP; WT = (bf16_t*)(p.ws + WS_WIN_T) + (size_t)l * INP * D; }
        else if ((r -= B_IN) < B_QB) { map = 2; W = p.w_qb + (size_t)l * 512 * 1536; ldw = 1536; K = 512; N = 1536; ks = p.g_q + l * 512; WT = (bf16_t*)(p.ws + WS_WQB_T) + (size_t)l * 1536 * 512; }
        else if ((r -= B_QB) < B_KV) { W = p.w_kvb + (size_t)l * 512 * 2048; ldw = 2048; K = 512; N = 2048; ks = p.g_kv + l * 512; WT = (bf16_t*)(p.ws + WS_WKVB_T) + (size_t)l * 2048 * 512; }
        else if ((r -= B_KV) < B_O) { W = p.w_oa + (size_t)l * 1024 * D; ldw = D; K = 1024; N = D; WT = (bf16_t*)(p.ws + WS_WOA_T) + (size_t)l * D * 1024; }
        else if ((r -= B_O) < B_O) { W = p.w_ob + (size_t)l * 1024 * D; ldw = D; K = 1024; N = D; WT = (bf16_t*)(p.ws + WS_WOB_T) + (size_t)l * D * 1024; }
        else { r -= B_O; W = p.w_out + (size_t)l * D * D; ldw = D; K = D; N = D; WT = (bf16_t*)(p.ws + WS_WOUT_T) + (size_t)l * D * D; }
        const int nb64 = N / 64, kb = r / nb64, nb = r - kb * nb64, n0 = 64 * nb, k0 = 64 * kb;
        int s0 = n0, pm = 0;
        if (map == 1) { s0 = src_in(n0);
            if (n0 >= 1024 && n0 < 3072 && !(n0 & 64)) pm = 1; else if (n0 >= 4096 && n0 < 5120) pm = 2; else if (n0 == 9216) pm = 3; else if (n0 == 9280) pm = 2; else if (n0 == 9344) pm = 4; else if (n0 >= 9408) { pm = 5; s0 = 0; } }
        else if (map == 2) { s0 = src_qa(n0); if ((n0 % 192) == 128) pm = 3; }
        transpose_block_vec(W, ldw, K, s0, pm, n0, k0, ks, WT, scr, lane);
    }
    __syncthreads();
}
__device__ __forceinline__ void p_prologue(LAS unsigned char* ldsb, const Params& p, const int parts = 31) {
    float* rope = (float*)(p.ws + WS_ROPE);
    float *cM = rope, *sM = rope + T * 32, *cD = rope + T * 64, *sD = rope + T * 80, *cI = rope + T * 96, *sI = rope + T * 104;
    const int gtid = opaque_bid() * NTHREADS + threadIdx.x, gstride = gridDim.x * NTHREADS;
    if (parts & 1) for (int idx = gtid; idx < T * 56; idx += gstride) {
        const int t = idx / 56, j = idx - t * 56;
        int rot, i; float *ct, *st; int w;
        if (j < 32) { rot = 64; i = j; ct = cM; st = sM; w = 32; } else if (j < 48) { rot = 32; i = j - 32; ct = cD; st = sD; w = 16; } else { rot = 16; i = j - 48; ct = cI; st = sI; w = 8; }
        const float inv = exp2f(-((float)(2 * i) / (float)rot) * 18.931568569324174f);
        const float ang = (float)p.pos[t] * inv;
        double rev = (double)ang * 0.15915494309189535; rev -= rint(rev);
        const float r = (float)(rev * 6.283185307179586);
        ct[t * w + i] = __cosf(r); st[t * w + i] = __sinf(r);
    }
    bf16_t* XB = (bf16_t*)(p.ws + WS_XB);
    if (parts & 2) for (size_t i = (size_t)gtid * 4; i < (size_t)T * D; i += (size_t)gstride * 32) {
        f32x4 a[8];
#pragma unroll
        for (int u = 0; u < 8; ++u) { const size_t iu = i + (size_t)u * gstride * 4; a[u] = iu < (size_t)T * D ? *(const f32x4*)(p.x + iu) : (f32x4){0.f, 0.f, 0.f, 0.f}; }
#pragma unroll
        for (int u = 0; u < 8; ++u) { const size_t iu = i + (size_t)u * gstride * 4; if (iu < (size_t)T * D) st4bf(XB + iu, a[u]); } }
    if (parts & 4) { float* SEC = (float*)(p.ws + WS_SEC);
      { bf16_t* RWH = (bf16_t*)(p.ws + WS_RWH); bf16_t* RWL = (bf16_t*)(p.ws + WS_RWL);
        for (int idx = gtid; idx < DEPTH * 96 * D; idx += gstride) { const int l = idx / (96 * D), r = idx - l * (96 * D), e = r / D, k = r - e * D;
            float w = 0.f; if (e < 64) w = p.ln1g[l * D + k] * p.w_router[((size_t)l * D + k) * 64 + e]; else if (e < 72) w = p.ln1g[l * D + k] * p.w_group[((size_t)l * D + k) * 8 + (e - 64)];
            const size_t fo = (size_t)l * (96 * D) + (size_t)((((k >> 8) * 16 + ((k >> 4) & 15)) * 3 + (e >> 5)) * 2 + ((k >> 3) & 1)) * 256 + (e & 31) * 8 + (k & 7);
            const bf16_t h = f2bf(w); RWH[fo] = h; RWL[fo] = f2bf(w - bf2f(h)); } }
      { const int wave_ = threadIdx.x >> 6, lane_ = threadIdx.x & 63, gwv = opaque_bid() * 8 + wave_;
        if (gwv < DEPTH * 72) { const int l = gwv / 72, e = gwv - l * 72; float sa = 0.f, ca = 0.f;
#pragma unroll 4
          for (int i = 0; i < D / 64; ++i) { const int k = lane_ + 64 * i; const float w = e < 64 ? p.w_router[((size_t)l * D + k) * 64 + e] : p.w_group[((size_t)l * D + k) * 8 + (e - 64)]; sa = fmaf(p.ln1g[l * D + k], w, sa); ca = fmaf(p.ln1b[l * D + k], w, ca); }
          sa = wave_sum(sa); ca = wave_sum(ca);
          if (lane_ == 0) { SEC[l * 160 + e] = sa; SEC[l * 160 + 80 + e] = ca + (e < 64 ? p.b_router[l * 64 + e] : p.b_group[l * 8 + (e - 64)]); } } } }
    __syncthreads();
}

__device__ __forceinline__ unsigned f2key(float f) { const unsigned u = __float_as_uint(f); return (u & 0x80000000u) ? ~u : (u | 0x80000000u); }
typedef short bf16x8 __attribute__((ext_vector_type(8)));
typedef short s16x4 __attribute__((ext_vector_type(4)));
typedef float f32x16 __attribute__((ext_vector_type(16)));
__device__ __forceinline__ void p_score(LAS unsigned char* ldsb, unsigned char* ws) {
    const bf16_t* QI = (const bf16_t*)(ws + WS_QI); const bf16_t* KI = (const bf16_t*)(ws + WS_KI); const float* WI = (const float*)(ws + WS_WI);
    unsigned* SC = (unsigned*)(ws + WS_SCORE);
    const int tid = opaque_tid(), lane = tid & 63, wv = __builtin_amdgcn_readfirstlane(tid >> 6), r32 = lane & 31, hi = lane >> 5;
    const int ksw = ((r32 >> 1) & 7) ^ hi;
    const unsigned krow = (unsigned)(size_t)ldsb + (unsigned)r32 * 128u;
    const int G_ = gridDim.x, bid_ = opaque_bid();
    const int nit_ = (G_ == 256) ? 3 : (544 - bid_ + G_ - 1) / G_;
    for (int it_ = 0; it_ < nit_; ++it_) {
        int item = bid_ + G_ * it_;
        if (G_ == 256 && it_ == 2) item = (bid_ >= 192 && bid_ < 224) ? 512 + (bid_ - 192) : 544;
        if (item >= 544) continue;
        const int b = item / 272; int r = item - b * 272, qb = 0;
        while (r >= 2 * qb + 2) { r -= 2 * qb + 2; ++qb; }
        const int kc = r, q0 = qb * 256 + wv * 32;
        __builtin_amdgcn_s_barrier();
#pragma unroll
        for (int i = 0; i < 2; ++i) { const int g = i * 512 + tid, row = g >> 3, ch = (g & 7) ^ ((row >> 1) & 7);
            __builtin_amdgcn_global_load_lds((const unsigned*)(KI + (size_t)(b * S + kc * 128 + row) * 64 + ch * 8), (LAS unsigned*)(ldsb + (i * 512 + wv * 64) * 16), 16, 0, 0); }
        asm volatile("s_waitcnt vmcnt(0)" ::: "memory");
        __builtin_amdgcn_s_barrier();
        if (kc * 128 <= q0 + 31) {
            const size_t t = (size_t)b * S + q0 + r32;
            bf16x8 ka[4][4];
#pragma unroll
            for (int kb = 0; kb < 4; ++kb)
#pragma unroll
                for (int d0 = 0; d0 < 4; ++d0) ka[kb][d0] = *(const LAS bf16x8*)(size_t)(krow + kb * 4096 + ((unsigned)((2 * d0) ^ ksw) << 4));
            f32x16 acc[4];
#pragma unroll
            for (int kb = 0; kb < 4; ++kb)
#pragma unroll
                for (int rr = 0; rr < 16; ++rr) acc[kb][rr] = 0.f;
            const bf16_t* qrow = QI + (t >> 5) * 32768 + hi * 256 + r32 * 8; const float* wrow = WI + t * 16;
            bf16x8 qa0, qa1, qa2, qa3, qc0, qc1, qc2, qc3; float wa, wc_;
#define SC_LOAD(Q0, Q1, Q2, Q3, W, h_) do { const bf16_t* p_ = qrow + (h_) * 2048; const float* w_ = wrow + (h_); \
                asm volatile("global_load_dwordx4 %0, %1, off" : "=v"(Q0) : "v"(p_) : "memory"); asm volatile("global_load_dwordx4 %0, %1, off offset:1024" : "=v"(Q1) : "v"(p_) : "memory"); \
                asm volatile("global_load_dwordx4 %0, %1, off offset:2048" : "=v"(Q2) : "v"(p_) : "memory"); asm volatile("global_load_dwordx4 %0, %1, off offset:3072" : "=v"(Q3) : "v"(p_) : "memory"); \
                asm volatile("global_load_dword %0, %1, off" : "=v"(W) : "v"(w_) : "memory"); } while (0)
#define SC_WAIT(n_) asm volatile("s_waitcnt vmcnt(" #n_ ")" : "+v"(qa0), "+v"(qa1), "+v"(qa2), "+v"(qa3), "+v"(wa), "+v"(qc0), "+v"(qc1), "+v"(qc2), "+v"(qc3), "+v"(wc_) :: "memory")
#define SC_CHAIN(PZ, kb_, Q0, Q1, Q2, Q3) do { _Pragma("unroll") for (int rr = 0; rr < 16; ++rr) PZ[rr] = 0.f; \
                PZ = __builtin_amdgcn_mfma_f32_32x32x16_bf16(ka[kb_][0], Q0, PZ, 0, 0, 0); PZ = __builtin_amdgcn_mfma_f32_32x32x16_bf16(ka[kb_][1], Q1, PZ, 0, 0, 0); \
                PZ = __builtin_amdgcn_mfma_f32_32x32x16_bf16(ka[kb_][2], Q2, PZ, 0, 0, 0); PZ = __builtin_amdgcn_mfma_f32_32x32x16_bf16(ka[kb_][3], Q3, PZ, 0, 0, 0); } while (0)
#define SC_ACC(PZ, kb_, W) do { _Pragma("unroll") for (int rr = 0; rr < 16; ++rr) { const float rl = __int_as_float(max(__float_as_int(PZ[rr]), 0)); \
                float av = acc[kb_][rr]; asm("v_fmac_f32 %0, %1, %2" : "+v"(av) : "v"(W), "v"(rl)); acc[kb_][rr] = av; } } while (0)
#define SC_HEAD(Q0, Q1, Q2, Q3, W) do { f32x16 pzA, pzB; SC_CHAIN(pzA, 0, Q0, Q1, Q2, Q3); SC_CHAIN(pzB, 1, Q0, Q1, Q2, Q3); SC_ACC(pzA, 0, W); SC_CHAIN(pzA, 2, Q0, Q1, Q2, Q3); SC_ACC(pzB, 1, W); \
                SC_CHAIN(pzB, 3, Q0, Q1, Q2, Q3); SC_ACC(pzA, 2, W); SC_ACC(pzB, 3, W); } while (0)
            SC_LOAD(qa0, qa1, qa2, qa3, wa, 0);
#pragma unroll 1
            for (int h = 0; h < 16; h += 2) {
                SC_LOAD(qc0, qc1, qc2, qc3, wc_, h + 1);
                SC_WAIT(5);
                SC_HEAD(qa0, qa1, qa2, qa3, wa);
                SC_LOAD(qa0, qa1, qa2, qa3, wa, (h + 2) & 15);
                SC_WAIT(5);
                SC_HEAD(qc0, qc1, qc2, qc3, wc_);
            }
            SC_WAIT(0);
#undef SC_LOAD
#undef SC_WAIT
#undef SC_CHAIN
#undef SC_ACC
#undef SC_HEAD
            const int dq = q0 + r32 - kc * 128 - 4 * hi;
            unsigned* srow = SC + t * 4096 + kc * 128 + 4 * hi;
#pragma unroll
            for (int kb = 0; kb < 4; ++kb)
#pragma unroll
                for (int rq = 0; rq < 4; ++rq) { u32x4 o; const int c0 = 32 * kb + 8 * rq;
                    o.x = (c0 <= dq) ? f2key(acc[kb][4 * rq]) : 0u; o.y = (c0 + 1 <= dq) ? f2key(acc[kb][4 * rq + 1]) : 0u;
                    o.z = (c0 + 2 <= dq) ? f2key(acc[kb][4 * rq + 2]) : 0u; o.w = (c0 + 3 <= dq) ? f2key(acc[kb][4 * rq + 3]) : 0u;
                    *(u32x4*)(srow + c0) = o; }
        }
    }
    __builtin_amdgcn_s_barrier();
}
__device__ __forceinline__ int wave_sum_dpp(int x) {
    x += __builtin_amdgcn_update_dpp(0, x, 0x111, 0xf, 0xf, true);
    x += __builtin_amdgcn_update_dpp(0, x, 0x112, 0xf, 0xf, true);
    x += __builtin_amdgcn_update_dpp(0, x, 0x114, 0xf, 0xf, true);
    x += __builtin_amdgcn_update_dpp(0, x, 0x118, 0xf, 0xf, true);
    x += __builtin_amdgcn_update_dpp(0, x, 0x142, 0xa, 0xf, false);
    x += __builtin_amdgcn_update_dpp(0, x, 0x143, 0xc, 0xf, false);
    return __builtin_amdgcn_readlane(x, 63);
}
__device__ __forceinline__ void p_select(unsigned char* ws) {
    const unsigned* SC = (const unsigned*)(ws + WS_SCORE); unsigned* MASK = (unsigned*)(ws + WS_MASK);
    const int tid = opaque_tid(), lane = tid & 63, wv = __builtin_amdgcn_readfirstlane(tid >> 6);
    const unsigned voff = (unsigned)lane * 16u;
#define SEL_LOAD(KK, t_) do { const int nq_ = ((((t_) & 4095)) >> 8) + 1; const unsigned char* rb_ = (const unsigned char*)(SC + (size_t)(t_) * 4096); \
        _Pragma("unroll") for (int j = 0; j < 16; ++j) { const unsigned char* a_ = rb_ + 1024 * (j < nq_ ? j : nq_ - 1); asm volatile("global_load_dwordx4 %0, %1, %2" : "=v"(KK[j]) : "v"(voff), "s"(a_) : "memory"); } } while (0)
#define SEL_WAIT(KK) asm volatile("s_waitcnt vmcnt(0)" : "+v"(KK[0]), "+v"(KK[1]), "+v"(KK[2]), "+v"(KK[3]), "+v"(KK[4]), "+v"(KK[5]), "+v"(KK[6]), "+v"(KK[7]), "+v"(KK[8]), "+v"(KK[9]), "+v"(KK[10]), "+v"(KK[11]), \
        "+v"(KK[12]), "+v"(KK[13]), "+v"(KK[14]), "+v"(KK[15]) :: "memory")
    u32x4 ka[16], kb[16];
    const int nwaves = gridDim.x * 8, wid_ = opaque_bid() * 8 + wv; const bool paired = nwaves * 4 == T;
    const int nrows = paired ? 4 : (wid_ < T ? (T - wid_ + nwaves - 1) / nwaves : 0);
#define SEL_ROW(i_) (paired ? ((((i_) >> 1) << 12) + (((i_) & 1) ? 4095 - wid_ : wid_)) : wid_ + (i_) * nwaves)
#define SW(K, i_) K[(i_) >> 2][(i_) & 3]
#define SEL_XT(x_, s_, m_) do { const unsigned y_ = (unsigned)__shfl_xor((int)(x_), (s_)); x_ = (lane & (s_)) ? (((x_) & (m_)) | ((y_ & (m_)) >> (4 * (s_)))) : (((x_) & ~(m_)) | ((y_ & ~(m_)) << (4 * (s_)))); } while (0)
#define SEL_TS(K, B0, J, M) _Pragma("unroll") for (int k_ = 0; k_ < 32; ++k_) if (!(k_ & (J))) { const unsigned a_ = SW(K, (B0) + k_), b_ = SW(K, (B0) + k_ + (J)); \
        SW(K, (B0) + k_) = (a_ & (M)) | ((b_ << (J)) & ~(M)); SW(K, (B0) + k_ + (J)) = ((a_ >> (J)) & (M)) | (b_ & ~(M)); }
#define SEL_BODY(K, KN, ri_) do { \
        const int t = SEL_ROW(ri_); \
        const int ti = t & 4095, nq = (ti >> 8) + 1; \
        SEL_LOAD(KN, SEL_ROW((ri_) + 1 < nrows ? (ri_) + 1 : (ri_)));        \
          \
        const int jq = ti >> 8; int nvp = (ti & 255) - 4 * lane + 1; nvp = nvp < 0 ? 0 : (nvp > 4 ? 4 : nvp); const unsigned pn = (1u << nvp) - 1u; \
        const unsigned vb0 = jq >= 8 ? 0xffffffffu : (((1u << (4 * jq)) - 1u) | (pn << (4 * jq))), vb1 = jq >= 8 ? (((1u << (4 * (jq - 8))) - 1u) | (pn << (4 * (jq - 8)))) : 0u; \
          \
          \
          \
        unsigned sel0, sel1 = 0u; \
        if (ti >= 256) { \
            SEL_TS(K, 0, 16, 0x0000ffffu); SEL_TS(K, 0, 8, 0x00ff00ffu); SEL_TS(K, 0, 4, 0x0f0f0f0fu); SEL_TS(K, 0, 2, 0x33333333u); SEL_TS(K, 0, 1, 0x55555555u); \
            if (nq > 8) { SEL_TS(K, 32, 16, 0x0000ffffu); SEL_TS(K, 32, 8, 0x00ff00ffu); SEL_TS(K, 32, 4, 0x0f0f0f0fu); SEL_TS(K, 32, 2, 0x33333333u); SEL_TS(K, 32, 1, 0x55555555u); }     \
            unsigned gt0 = 0u, gt1 = 0u, eq0 = vb0, eq1 = vb1; int tgt = 0; bool found = false; \
            _Pragma("unroll") for (int bit = 31; bit >= 0; --bit) if (!found) {        \
                const unsigned t0 = eq0 & SW(K, bit), t1 = eq1 & SW(K, 32 + bit); \
                const unsigned c = (unsigned)__popc(t0) + (unsigned)__popc(t1);            \
                const int tot = tgt + wave_sum_dpp((int)c); \
                if (tot >= 256) { eq0 = t0; eq1 = t1;                   \
                    if (tot == 256) { sel0 = gt0 | t0; sel1 = gt1 | t1; found = true; } }        \
                else { gt0 |= t0; gt1 |= t1; eq0 ^= t0; eq1 ^= t1; tgt = tot; } \
            } \
            if (!found) { sel0 = gt0 | eq0; sel1 = gt1 | eq1; }        \
        } else sel0 = vb0;                                                \
        SEL_WAIT(KN); \
          \
        SEL_XT(sel0, 1, 0xf0f0f0f0u); SEL_XT(sel0, 2, 0xff00ff00u); SEL_XT(sel0, 4, 0xffff0000u); SEL_XT(sel1, 1, 0xf0f0f0f0u); SEL_XT(sel1, 2, 0xff00ff00u); SEL_XT(sel1, 4, 0xffff0000u); \
        unsigned* mrow = MASK + (size_t)t * 128 + 8 * (lane & 7) + (lane >> 3);        \
        mrow[0] = sel0; mrow[64] = sel1; } while (0)
    if (nrows > 0) { SEL_LOAD(ka, SEL_ROW(0)); SEL_WAIT(ka); }
#pragma unroll 1
    for (int ri = 0; ri < nrows; ri += 2) {
        SEL_BODY(ka, kb, ri);
        if (ri + 1 < nrows) SEL_BODY(kb, ka, ri + 1);
    }
#undef SEL_BODY
#undef SEL_TS
#undef SEL_XT
#undef SW
#undef SEL_ROW
#undef SEL_LOAD
#undef SEL_WAIT
}

template <int DQK, bool MASKED, int AMODE = 0>
__device__ __forceinline__ void attn_unit(LAS unsigned char* ldsb, const bf16_t* Qg, int ldq, const bf16_t* Kg, int ldk, const bf16_t* Vg, int ldv, const unsigned* maskg, bf16_t* Og, int ldo, int qb, float sl2) {
    constexpr int CPR = DQK / 8, KBYTES = 64 * DQK * 2, VBYTES = 64 * 128 * 2, NKI = CPR * 64 / 512, ND = DQK / 16;
    constexpr int STAGE = KBYTES + VBYTES;
    static_assert(NKI + 2 + (MASKED ? 1 : 0) == 5, "five vector-memory operations per thread and tile in both instantiations");
    const int tid = opaque_tid(), lane = tid & 63, wv = __builtin_amdgcn_readfirstlane(tid >> 6), r32 = lane & 31, hi = lane >> 5;
    const int NT = 4 * qb + 4, NT3 = ((NT + 2) / 3) * 3, q0 = qb * 256 + wv * 32;
    const float NEG = -__builtin_inff();
    bf16x8 qr[ND];
#pragma unroll
    for (int d0 = 0; d0 < ND; ++d0) qr[d0] = *(const bf16x8*)(Qg + (size_t)(q0 + r32) * ldq + 16 * d0 + 8 * hi);
    const bf16_t* ksrc[NKI]; const bf16_t* vsrc[2];
#pragma unroll
    for (int i = 0; i < NKI; ++i) { const int g = i * 512 + tid, row = g / CPR, cp = g - row * CPR; const int ch = cp ^ (DQK == 128 ? (row & 15) : ((row >> 1) & 7)); ksrc[i] = Kg + (size_t)row * ldk + ch * 8; }
#pragma unroll
    for (int i = 0; i < 2; ++i) { const int g = i * 512 + tid, row = g >> 4, c16 = g & 15; const int blk = (c16 >> 2) ^ (row & 3); vsrc[i] = Vg + (size_t)row * ldv + (blk * 4 + (c16 & 3)) * 8; }
    const unsigned* mrow = MASKED ? maskg + (size_t)(q0 + r32) * 128 : nullptr;
    u32x2 mw0 = {0u, 0u}, mw1 = {0u, 0u}, mw2 = {0u, 0u};
#define AT_ISSUE(MW, t_, st_) do { const int tt_ = (t_) < NT ? (t_) : NT - 1; \
        if (MASKED) asm volatile("global_load_dwordx2 %0, %1, off" : "=v"(MW) : "v"(mrow + 2 * tt_) : "memory"); \
        _Pragma("unroll") for (int i_ = 0; i_ < NKI; ++i_) __builtin_amdgcn_global_load_lds((const unsigned*)(ksrc[i_] + (size_t)tt_ * 64 * ldk), (LAS unsigned*)(ldsb + (st_) * STAGE + (i_ * 512 + wv * 64) * 16), 16, 0, 0); \
        _Pragma("unroll") for (int i_ = 0; i_ < 2; ++i_) __builtin_amdgcn_global_load_lds((const unsigned*)(vsrc[i_] + (size_t)tt_ * 64 * ldv), (LAS unsigned*)(ldsb + (st_) * STAGE + KBYTES + (i_ * 512 + wv * 64) * 16), 16, 0, 0); } while (0)
#define AT_WAIT(n_) asm volatile("s_waitcnt vmcnt(" #n_ ")" : "+v"(mw0), "+v"(mw1), "+v"(mw2) :: "memory")
    const int ksw = (DQK == 128 ? (r32 & 15) : ((r32 >> 1) & 7)) ^ hi;
    const unsigned krow = (unsigned)(size_t)ldsb + (unsigned)r32 * (DQK * 2);
    const int vq = (lane >> 2) & 3, vp = lane & 3, vg = lane >> 4;
    const unsigned vrow = (unsigned)(size_t)ldsb + KBYTES + (unsigned)(4 * (vg >> 1) + vq) * 256 + (vg & 1) * 32 + vp * 8;
    float m_run = -1e30f, l_run = 0.f; const float mth = 8.f / sl2;
    f32x16 oT[4];
#pragma unroll
    for (int d0 = 0; d0 < 4; ++d0)
#pragma unroll
        for (int r = 0; r < 16; ++r) oT[d0][r] = 0.f;
    AT_ISSUE(mw0, 0, 0); AT_ISSUE(mw1, 1, 1);
    AT_WAIT(5);
    __builtin_amdgcn_s_barrier();
#define TRRD(dst, addr, off) asm volatile("ds_read_b64_tr_b16 %0, %1 offset:%2" : "=&v"(dst) : "v"(addr), "i"(off) : "memory")
#define KRD(dst, addr, off) asm volatile("ds_read_b128 %0, %1 offset:%2" : "=&v"(dst) : "v"(addr), "i"(off) : "memory")
#define KWAIT2(n_, x0, x1) asm volatile("s_waitcnt lgkmcnt(" #n_ ")" : "+v"(x0), "+v"(x1) :: "memory")
#define VWAIT8(n_, x0, x1, x2, x3, x4, x5, x6, x7) asm volatile("s_waitcnt lgkmcnt(" #n_ ")" : "+v"(x0), "+v"(x1), "+v"(x2), "+v"(x3), "+v"(x4), "+v"(x5), "+v"(x6), "+v"(x7) :: "memory")
#define TR8(l0, h0, l1, h1, l2, h2, l3, h3, va_) do { const unsigned va = (va_); TRRD(l0, va, 0); TRRD(h0, va, 2048); TRRD(l1, va, 4096); TRRD(h1, va, 6144); TRRD(l2, va, 8192); TRRD(h2, va, 10240); TRRD(l3, va, 12288); TRRD(h3, va, 14336); } while (0)
#define PV4(d0, l0, h0, l1, h1, l2, h2, l3, h3) do { \
        oT[d0] = __builtin_amdgcn_mfma_f32_32x32x16_bf16((bf16x8){l0[0], l0[1], l0[2], l0[3], h0[0], h0[1], h0[2], h0[3]}, pb[0], oT[d0], 0, 0, 0); \
        oT[d0] = __builtin_amdgcn_mfma_f32_32x32x16_bf16((bf16x8){l1[0], l1[1], l1[2], l1[3], h1[0], h1[1], h1[2], h1[3]}, pb[1], oT[d0], 0, 0, 0); \
        oT[d0] = __builtin_amdgcn_mfma_f32_32x32x16_bf16((bf16x8){l2[0], l2[1], l2[2], l2[3], h2[0], h2[1], h2[2], h2[3]}, pb[2], oT[d0], 0, 0, 0); \
        oT[d0] = __builtin_amdgcn_mfma_f32_32x32x16_bf16((bf16x8){l3[0], l3[1], l3[2], l3[3], h3[0], h3[1], h3[2], h3[3]}, pb[3], oT[d0], 0, 0, 0); } while (0)
#define AT_STEP(t_, st_, MWCUR, MWNEW) do { \
        const int t = (t_); \
        AT_ISSUE(MWNEW, t + 2, ((st_) + 2) % 3);                    \
        if (t * 64 <= q0 + 31) {                                    \
            int kx = ksw; asm volatile("" : "+v"(kx)); \
            f32x16 p0, p1; \
            _Pragma("unroll") for (int r = 0; r < 16; ++r) { p0[r] = 0.f; p1[r] = 0.f; } \
              \
              \
            bf16x8 ea0, ea1, eb0, eb1; \
            { const unsigned ka = krow + (st_) * STAGE + ((unsigned)(0 ^ kx) << 4); KRD(ea0, ka, 0); KRD(ea1, ka, 32 * DQK * 2); } \
            _Pragma("unroll") for (int d0 = 0; d0 < ND; d0 += 2) { \
                { const unsigned ka = krow + (st_) * STAGE + ((unsigned)((2 * (d0 + 1)) ^ kx) << 4); KRD(eb0, ka, 0); KRD(eb1, ka, 32 * DQK * 2); } \
                KWAIT2(2, ea0, ea1); \
                p0 = __builtin_amdgcn_mfma_f32_32x32x16_bf16(ea0, qr[d0], p0, 0, 0, 0); p1 = __builtin_amdgcn_mfma_f32_32x32x16_bf16(ea1, qr[d0], p1, 0, 0, 0); \
                if (d0 + 2 < ND) { const unsigned ka = krow + (st_) * STAGE + ((unsigned)((2 * (d0 + 2)) ^ kx) << 4); KRD(ea0, ka, 0); KRD(ea1, ka, 32 * DQK * 2); KWAIT2(2, eb0, eb1); } \
                else KWAIT2(0, eb0, eb1); \
                p0 = __builtin_amdgcn_mfma_f32_32x32x16_bf16(eb0, qr[d0 + 1], p0, 0, 0, 0); p1 = __builtin_amdgcn_mfma_f32_32x32x16_bf16(eb1, qr[d0 + 1], p1, 0, 0, 0); } \
            if (AMODE != 1) { if (MASKED) {                         \
                const int wx_ = (int)(MWCUR.x >> (4 * hi)), wy_ = (int)(MWCUR.y >> (4 * hi)); \
                _Pragma("unroll") for (int r = 0; r < 16; ++r) { const int c = (r & 3) + 8 * (r >> 2); \
                    const unsigned mx_ = (unsigned)__builtin_amdgcn_sbfe(wx_, c, 1), my_ = (unsigned)__builtin_amdgcn_sbfe(wy_, c, 1); \
                    p0[r] = __uint_as_float((__float_as_uint(p0[r]) & mx_) | (0xff800000u & ~mx_)); p1[r] = __uint_as_float((__float_as_uint(p1[r]) & my_) | (0xff800000u & ~my_)); } \
            } else if (t * 64 + 63 > q0) {                          \
                const int dq = q0 + r32 - t * 64 - 4 * hi; \
                _Pragma("unroll") for (int r = 0; r < 16; ++r) { const int c = (r & 3) + 8 * (r >> 2); if (c > dq) p0[r] = NEG; if (c + 32 > dq) p1[r] = NEG; } \
            } \
            float mx = p0[0]; \
            _Pragma("unroll") for (int r = 1; r < 16; ++r) mx = fmaxf(mx, p0[r]); \
            _Pragma("unroll") for (int r = 0; r < 16; ++r) mx = fmaxf(mx, p1[r]); \
            { auto rr = __builtin_amdgcn_permlane32_swap(__float_as_uint(mx), __float_as_uint(mx), false, false); mx = fmaxf(__uint_as_float(rr[0]), __uint_as_float(rr[1])); } \
            const float mnew = (mx > m_run + mth) ? mx : m_run;     \
            const float alpha = __builtin_amdgcn_exp2f((m_run - mnew) * sl2); \
            m_run = mnew; const float mb = -mnew * sl2; \
            float ps = 0.f; \
            _Pragma("unroll") for (int r = 0; r < 16; ++r) { p0[r] = __builtin_amdgcn_exp2f(fmaf(p0[r], sl2, mb)); ps += p0[r]; } \
            _Pragma("unroll") for (int r = 0; r < 16; ++r) { p1[r] = __builtin_amdgcn_exp2f(fmaf(p1[r], sl2, mb)); ps += p1[r]; } \
            l_run = l_run * alpha + ps; \
            if (__any(alpha != 1.f)) { \
                  \
                _Pragma("unroll") for (int d0 = 0; d0 < 4; ++d0) _Pragma("unroll") for (int r = 0; r < 16; ++r) { float ov = oT[d0][r]; asm("v_mul_f32 %0, %1, %0" : "+v"(ov) : "v"(alpha)); oT[d0][r] = ov; } } } \
            bf16x8 pb[4];                                            \
            { u32x4 w; \
              w.x = pkbf(p0[0], p0[1]); w.y = pkbf(p0[2], p0[3]); w.z = pkbf(p0[4], p0[5]); w.w = pkbf(p0[6], p0[7]); pb[0] = *reinterpret_cast<bf16x8*>(&w); \
              w.x = pkbf(p0[8], p0[9]); w.y = pkbf(p0[10], p0[11]); w.z = pkbf(p0[12], p0[13]); w.w = pkbf(p0[14], p0[15]); pb[1] = *reinterpret_cast<bf16x8*>(&w); \
              w.x = pkbf(p1[0], p1[1]); w.y = pkbf(p1[2], p1[3]); w.z = pkbf(p1[4], p1[5]); w.w = pkbf(p1[6], p1[7]); pb[2] = *reinterpret_cast<bf16x8*>(&w); \
              w.x = pkbf(p1[8], p1[9]); w.y = pkbf(p1[10], p1[11]); w.z = pkbf(p1[12], p1[13]); w.w = pkbf(p1[14], p1[15]); pb[3] = *reinterpret_cast<bf16x8*>(&w); } \
            int vx = vq; asm volatile("" : "+v"(vx)); \
              \
            s16x4 fa0, fa1, fa2, fa3, fa4, fa5, fa6, fa7, fb0, fb1, fb2, fb3, fb4, fb5, fb6, fb7; \
            TR8(fa0, fa1, fa2, fa3, fa4, fa5, fa6, fa7, vrow + (st_) * STAGE + ((unsigned)(0 ^ vx) << 6)); \
            TR8(fb0, fb1, fb2, fb3, fb4, fb5, fb6, fb7, vrow + (st_) * STAGE + ((unsigned)(1 ^ vx) << 6)); \
            VWAIT8(8, fa0, fa1, fa2, fa3, fa4, fa5, fa6, fa7); PV4(0, fa0, fa1, fa2, fa3, fa4, fa5, fa6, fa7); \
            TR8(fa0, fa1, fa2, fa3, fa4, fa5, fa6, fa7, vrow + (st_) * STAGE + ((unsigned)(2 ^ vx) << 6)); \
            VWAIT8(8, fb0, fb1, fb2, fb3, fb4, fb5, fb6, fb7); PV4(1, fb0, fb1, fb2, fb3, fb4, fb5, fb6, fb7); \
            TR8(fb0, fb1, fb2, fb3, fb4, fb5, fb6, fb7, vrow + (st_) * STAGE + ((unsigned)(3 ^ vx) << 6)); \
            VWAIT8(8, fa0, fa1, fa2, fa3, fa4, fa5, fa6, fa7); PV4(2, fa0, fa1, fa2, fa3, fa4, fa5, fa6, fa7); \
            VWAIT8(0, fb0, fb1, fb2, fb3, fb4, fb5, fb6, fb7); PV4(3, fb0, fb1, fb2, fb3, fb4, fb5, fb6, fb7); \
        } \
        AT_WAIT(5);                                                 \
        asm volatile("s_waitcnt lgkmcnt(0)" ::: "memory"); \
        __builtin_amdgcn_s_barrier(); } while (0)
#pragma unroll 1
    for (int tt = 0; tt < NT3; tt += 3) { AT_STEP(tt, 0, mw0, mw2); AT_STEP(tt + 1, 1, mw1, mw0); AT_STEP(tt + 2, 2, mw2, mw1); }
    AT_WAIT(0);
    __builtin_amdgcn_s_barrier();
#undef AT_STEP
#undef AT_ISSUE
#undef AT_WAIT
#undef TRRD
#undef KRD
#undef KWAIT2
#undef VWAIT8
#undef TR8
#undef PV4
    { auto rr = __builtin_amdgcn_permlane32_swap(__float_as_uint(l_run), __float_as_uint(l_run), false, false); l_run = __uint_as_float(rr[0]) + __uint_as_float(rr[1]); }
    const float inv = 1.f / l_run;
    bf16_t* orow = Og + (size_t)(q0 + r32) * ldo + 4 * hi;
#pragma unroll
    for (int d0 = 0; d0 < 4; ++d0)
#pragma unroll
        for (int rq = 0; rq < 4; ++rq) { u32x2 w; w.x = pkbf(oT[d0][4 * rq] * inv, oT[d0][4 * rq + 1] * inv); w.y = pkbf(oT[d0][4 * rq + 2] * inv, oT[d0][4 * rq + 3] * inv);
            *(u32x2*)(orow + 32 * d0 + 8 * rq) = w; }
}
template <int AMODE>
__device__ __forceinline__ void p_attn(LAS unsigned char* ldsb, unsigned char* ws) {
    const bf16_t* QA = (const bf16_t*)(ws + WS_QA); const bf16_t* KA = (const bf16_t*)(ws + WS_KA); const bf16_t* VA = (const bf16_t*)(ws + WS_VA); bf16_t* OA = (bf16_t*)(ws + WS_OA);
    const bf16_t* QB = (const bf16_t*)(ws + WS_QB); const bf16_t* KB = (const bf16_t*)(ws + WS_KB); const bf16_t* VB = (const bf16_t*)(ws + WS_VB); bf16_t* OB = (bf16_t*)(ws + WS_OB);
    const unsigned* MASK = (const unsigned*)(ws + WS_MASK);
    for (int w = opaque_bid(); w < 256; w += gridDim.x) {
        const int bh = (w & 7) * 2 + ((w >> 3) & 1), i = w >> 4, b = bh >> 3, h = bh & 7;
        const size_t r0 = (size_t)b * S;
        attn_unit<192, false, AMODE>(ldsb, QA + r0 * 1536 + h * 192, 1536, KA + r0 * 1536 + h * 192, 1536, VA + r0 * 1024 + h * 128, 1024, nullptr, OA + r0 * 1024 + h * 128, 1024, i, 0.07216878364870322f * 1.4426950408889634f);
        attn_unit<128, true, AMODE>(ldsb, QB + r0 * 1024 + h * 128, 1024, KB + r0 * 1024 + h * 128, 1024, VB + r0 * 1024 + h * 128, 1024, MASK + r0 * 128, OB + r0 * 1024 + h * 128, 1024, 15 - i, 0.08838834764831845f * 1.4426950408889634f);
    }
}

__device__ __forceinline__ void moe_tables256(int* tab, const unsigned* cnt, int ncol_tiles) {
    const int tid_ = opaque_tid();
    if (tid_ == 0) { int a = 0, bsum = 0; for (int e = 0; e < 64; ++e) { tab[e] = a; tab[80 + e] = bsum; const int c = (int)cnt[e], nrb = (c + MOE_RBLK - 1) / MOE_RBLK; tab[160 + e] = nrb; a += nrb * ncol_tiles; bsum += nrb * MOE_RBLK; } tab[64] = a; tab[80 + 64] = bsum; }
    if (tid_ >= 64 && tid_ < 128) {
        const int e = tid_ - 64; const unsigned c = cnt[e]; int rank = 0;
        for (int o = 0; o < 64; ++o) { const unsigned co = cnt[o]; rank += (co > c || (co == c && o < e)) ? 1 : 0; }
        tab[240 + rank] = e; }
    __syncthreads();
}
template <int RMODE>
__device__ __forceinline__ void p_ln1_route3(LAS unsigned char* ldsb, unsigned char* ws, const float* g, const float* bb, int l) {
    const float* V1 = (const float*)(ws + WS_V1); bf16_t* H1B = (bf16_t*)(ws + WS_H1B); float* STATS = (float*)(ws + WS_STATS);
    const float* sec = (const float*)(ws + WS_SEC) + l * 160;
    unsigned* cnt = (unsigned*)(ws + WS_CNT) + l * 64; int* LIST = (int*)(ws + WS_LIST);
    int* TOKE = (int*)(ws + WS_TOKE); float* TOKW = (float*)(ws + WS_TOKW); int* TOKS = (int*)(ws + WS_TOKS);
    const int tid = opaque_tid(), lane = tid & 63, wv = __builtin_amdgcn_readfirstlane(tid >> 6);
    LAS float* red = (LAS float*)ldsb;
    LAS float* stl = red + 8 * 32 * 96;
    for (int unit = opaque_bid(); unit < T / 32; unit += gridDim.x) {
        const int t0 = unit * 32;
        if (RMODE != 2) {
            const size_t ro = (size_t)(t0 + 4 * wv) * D + 4 * lane;
            f32x4 v[4][8]; float s1[4], s2[4], mean[4], rstd[4];
#pragma unroll
            for (int i = 0; i < 4; ++i)
#pragma unroll
                for (int j = 0; j < 8; ++j) v[i][j] = *(const f32x4*)(V1 + ro + (size_t)i * D + 256 * j);
#pragma unroll
            for (int i = 0; i < 4; ++i) { s1[i] = 0.f;
#pragma unroll
                for (int j = 0; j < 8; ++j) s1[i] += (v[i][j][0] + v[i][j][1]) + (v[i][j][2] + v[i][j][3]); }
#pragma unroll
            for (int o = 32; o >= 1; o >>= 1) { s1[0] += __shfl_xor(s1[0], o); s1[1] += __shfl_xor(s1[1], o); s1[2] += __shfl_xor(s1[2], o); s1[3] += __shfl_xor(s1[3], o); }
#pragma unroll
            for (int i = 0; i < 4; ++i) { mean[i] = s1[i] * (1.f / D); s2[i] = 0.f;
#pragma unroll
                for (int j = 0; j < 8; ++j) { v[i][j] = v[i][j] - mean[i]; s2[i] += (v[i][j][0] * v[i][j][0] + v[i][j][1] * v[i][j][1]) + (v[i][j][2] * v[i][j][2] + v[i][j][3] * v[i][j][3]); } }
#pragma unroll
            for (int o = 32; o >= 1; o >>= 1) { s2[0] += __shfl_xor(s2[0], o); s2[1] += __shfl_xor(s2[1], o); s2[2] += __shfl_xor(s2[2], o); s2[3] += __shfl_xor(s2[3], o); }
#pragma unroll
            for (int i = 0; i < 4; ++i) { rstd[i] = rsqrtf(s2[i] * (1.f / D) + 1e-5f);
                if (lane == 0) { stl[(4 * wv + i) * 2] = mean[i]; stl[(4 * wv + i) * 2 + 1] = rstd[i]; STATS[(size_t)(t0 + 4 * wv + i) * 2] = mean[i]; STATS[(size_t)(t0 + 4 * wv + i) * 2 + 1] = rstd[i]; } }
            f32x4 gg[8], b4[8];
#pragma unroll
            for (int j = 0; j < 8; ++j) { gg[j] = *(const f32x4*)(g + 4 * lane + 256 * j); b4[j] = *(const f32x4*)(bb + 4 * lane + 256 * j); }
#pragma unroll
            for (int j = 0; j < 8; ++j)
#pragma unroll
                for (int i = 0; i < 4; ++i) st4bf(H1B + ro + (size_t)i * D + 256 * j, v[i][j] * rstd[i] * gg[j] + b4[j]);
        }
        if (RMODE != 1) {
            f32x16 c0, c1, c2;
#pragma unroll
            for (int r = 0; r < 16; ++r) { c0[r] = 0.f; c1[r] = 0.f; c2[r] = 0.f; }
            const int j = lane & 31, kh = lane >> 5, kb = 256 * wv + 8 * kh;
            const float* hp = V1 + (size_t)(t0 + j) * D + kb;
            const bf16_t* wh = (const bf16_t*)(ws + WS_RWH) + (size_t)l * (96 * D) + (size_t)wv * (16 * 1536) + (kh * 32 + j) * 8;
            const bf16_t* wl = (const bf16_t*)(ws + WS_RWL) + (size_t)l * (96 * D) + (size_t)wv * (16 * 1536) + (kh * 32 + j) * 8;
            f32x4 xa0, xa1, xb0, xb1; bf16x8 ha0, ha1, ha2, la0, la1, la2, hb0, hb1, hb2, lb0, lb1, lb2;
#define RT_LOAD(X0, X1, H0, H1, H2, L0, L1, L2, st_) do { const float* px_ = hp + 16 * (st_); const bf16_t* ph_ = wh + 1536 * (st_); const bf16_t* pl_ = wl + 1536 * (st_); \
                asm volatile("global_load_dwordx4 %0, %1, off" : "=v"(X0) : "v"(px_) : "memory"); asm volatile("global_load_dwordx4 %0, %1, off offset:16" : "=v"(X1) : "v"(px_) : "memory"); \
                asm volatile("global_load_dwordx4 %0, %1, off" : "=v"(H0) : "v"(ph_) : "memory"); asm volatile("global_load_dwordx4 %0, %1, off offset:1024" : "=v"(H1) : "v"(ph_) : "memory"); \
                asm volatile("global_load_dwordx4 %0, %1, off offset:2048" : "=v"(H2) : "v"(ph_) : "memory"); \
                asm volatile("global_load_dwordx4 %0, %1, off" : "=v"(L0) : "v"(pl_) : "memory"); asm volatile("global_load_dwordx4 %0, %1, off offset:1024" : "=v"(L1) : "v"(pl_) : "memory"); \
                asm volatile("global_load_dwordx4 %0, %1, off offset:2048" : "=v"(L2) : "v"(pl_) : "memory"); } while (0)
#define RT_WAIT(n_) asm volatile("s_waitcnt vmcnt(" #n_ ")" : "+v"(xa0), "+v"(xa1), "+v"(ha0), "+v"(ha1), "+v"(ha2), "+v"(la0), "+v"(la1), "+v"(la2), "+v"(xb0), "+v"(xb1), "+v"(hb0), "+v"(hb1), "+v"(hb2), "+v"(lb0), "+v"(lb1), "+v"(lb2) :: "memory")
#define RT_STEP(x0, x1, bh0, bh1, bh2, bl0, bl1, bl2) do { \
                u32x4 hw; hw.x = pkbf(x0[0], x0[1]); hw.y = pkbf(x0[2], x0[3]); hw.z = pkbf(x1[0], x1[1]); hw.w = pkbf(x1[2], x1[3]); \
                u32x4 lw; lw.x = pkbf(x0[0] - __uint_as_float(hw.x << 16), x0[1] - __uint_as_float(hw.x & 0xffff0000u)); lw.y = pkbf(x0[2] - __uint_as_float(hw.y << 16), x0[3] - __uint_as_float(hw.y & 0xffff0000u)); \
                lw.z = pkbf(x1[0] - __uint_as_float(hw.z << 16), x1[1] - __uint_as_float(hw.z & 0xffff0000u)); lw.w = pkbf(x1[2] - __uint_as_float(hw.w << 16), x1[3] - __uint_as_float(hw.w & 0xffff0000u)); \
                const bf16x8 ah = *reinterpret_cast<bf16x8*>(&hw), al = *reinterpret_cast<bf16x8*>(&lw); \
                c0 = __builtin_amdgcn_mfma_f32_32x32x16_bf16(ah, bh0, c0, 0, 0, 0); c1 = __builtin_amdgcn_mfma_f32_32x32x16_bf16(ah, bh1, c1, 0, 0, 0); c2 = __builtin_amdgcn_mfma_f32_32x32x16_bf16(ah, bh2, c2, 0, 0, 0); \
                c0 = __builtin_amdgcn_mfma_f32_32x32x16_bf16(ah, bl0, c0, 0, 0, 0); c1 = __builtin_amdgcn_mfma_f32_32x32x16_bf16(ah, bl1, c1, 0, 0, 0); c2 = __builtin_amdgcn_mfma_f32_32x32x16_bf16(ah, bl2, c2, 0, 0, 0); \
                c0 = __builtin_amdgcn_mfma_f32_32x32x16_bf16(al, bh0, c0, 0, 0, 0); c1 = __builtin_amdgcn_mfma_f32_32x32x16_bf16(al, bh1, c1, 0, 0, 0); c2 = __builtin_amdgcn_mfma_f32_32x32x16_bf16(al, bh2, c2, 0, 0, 0); } while (0)
            RT_LOAD(xa0, xa1, ha0, ha1, ha2, la0, la1, la2, 0);
#pragma unroll 1
            for (int st = 0; st < 16; st += 2) {
                RT_LOAD(xb0, xb1, hb0, hb1, hb2, lb0, lb1, lb2, st + 1);
                RT_WAIT(8);
                RT_STEP(xa0, xa1, ha0, ha1, ha2, la0, la1, la2);
                RT_LOAD(xa0, xa1, ha0, ha1, ha2, la0, la1, la2, (st + 2) & 15);
                RT_WAIT(8);
                RT_STEP(xb0, xb1, hb0, hb1, hb2, lb0, lb1, lb2);
            }
            RT_WAIT(0);
#undef RT_LOAD
#undef RT_WAIT
#undef RT_STEP
#pragma unroll
            for (int r = 0; r < 16; ++r) { const int tr = (r & 3) + 8 * (r >> 2) + 4 * kh; LAS float* o = red + (wv * 32 + tr) * 96 + j; o[0] = c0[r]; o[32] = c1[r]; o[64] = c2[r]; }
        }
        __syncthreads();
        for (int idx = tid; idx < 32 * 72; idx += NTHREADS) { const int tk = idx / 72, c = idx - tk * 72;
            float sacc = 0.f;
#pragma unroll
            for (int w = 0; w < 8; ++w) sacc += red[(w * 32 + tk) * 96 + c];
            red[tk * 96 + c] = stl[tk * 2 + 1] * (sacc - stl[tk * 2] * sec[c]) + sec[80 + c]; }
        __syncthreads();
        if (RMODE == 0 && tid < 32) {
            const int t = t0 + tid; const LAS float* lg = red + tid * 96;
            float gl[8]; float gmax = -__builtin_inff(); int gi = 0;
#pragma unroll
            for (int i = 0; i < 8; ++i) { gl[i] = lg[64 + i]; if (gl[i] > gmax) { gmax = gl[i]; gi = i; } }
            float gs = 0.f;
#pragma unroll
            for (int i = 0; i < 8; ++i) gs += __expf(gl[i] - gmax);
            const float gp = 1.f / gs;
            float el[8]; float emax = -__builtin_inff(); int e1 = 0;
#pragma unroll
            for (int i = 0; i < 8; ++i) { el[i] = lg[gi * 8 + i]; if (el[i] > emax) { emax = el[i]; e1 = i; } }
            float e2max = -__builtin_inff(); int e2 = 0;
#pragma unroll
            for (int i = 0; i < 8; ++i) { if (i != e1 && el[i] > e2max) { e2max = el[i]; e2 = i; } }
            const float p2 = __expf(e2max - emax);
            const float wa = gp / (1.f + p2), wb = gp * p2 / (1.f + p2);
            const int ea = gi * 8 + e1, eb = gi * 8 + e2;
            const int sa = (int)atomicAdd(cnt + ea, 1u), sb = (int)atomicAdd(cnt + eb, 1u);
            LIST[(size_t)ea * ECAP + sa] = t; LIST[(size_t)eb * ECAP + sb] = t;
            TOKE[t * 2] = ea; TOKE[t * 2 + 1] = eb; TOKW[t * 2] = wa; TOKW[t * 2 + 1] = wb; TOKS[t * 2] = sa; TOKS[t * 2 + 1] = sb;
        }
        __syncthreads();
    }
}
__device__ __forceinline__ void p_ln2v2(LAS unsigned char* ldsb, unsigned char* ws, const float* g1, const float* b1, const float* g, const float* bb, float* outF, int l) {
    const unsigned* cnt = (const unsigned*)(ws + WS_CNT) + l * 64;
    const bf16_t* H1B = (const bf16_t*)(ws + WS_H1B); const bf16_t* YE = (const bf16_t*)(ws + WS_YE);
    const int* TOKE = (const int*)(ws + WS_TOKE); const float* TOKW = (const float*)(ws + WS_TOKW); const int* TOKS = (const int*)(ws + WS_TOKS);
    bf16_t* XB = (bf16_t*)(ws + WS_XB);
    int* tab = (int*)(unsigned char*)ldsb;
    __syncthreads();
    moe_tables256(tab, cnt, 1);
    const int tid = opaque_tid(), lane = tid & 63, wv = tid >> 6;
    const int tstride = gridDim.x * 8;
#define LN2_META(t_, R0, R1, W0, W1) do { const int tt_ = (t_) < T ? (t_) : T - 1; R0 = tab[80 + TOKE[tt_ * 2]] + TOKS[tt_ * 2]; R1 = tab[80 + TOKE[tt_ * 2 + 1]] + TOKS[tt_ * 2 + 1]; W0 = TOKW[tt_ * 2]; W1 = TOKW[tt_ * 2 + 1]; } while (0)
#define LN2_ROWS(t_, R0, R1, HH, Y0, Y1) do { const int tt_ = (t_) < T ? (t_) : T - 1; \
        _Pragma("unroll") for (int j = 0; j < 8; ++j) { HH[j] = *(const u32x2*)(H1B + (size_t)tt_ * D + 4 * lane + 256 * j); Y0[j] = *(const u32x2*)(YE + (size_t)(R0) * D + 4 * lane + 256 * j); Y1[j] = *(const u32x2*)(YE + (size_t)(R1) * D + 4 * lane + 256 * j); } } while (0)
#define LN2_TOKEN(t_, HH, Y0, Y1, W0, W1) do { if ((t_) < T) { const size_t ro = (size_t)(t_) * D + 4 * lane; f32x4 v[8]; float s1 = 0.f; \
        _Pragma("unroll") for (int j = 0; j < 8; ++j) { v[j] = bf4(HH[j]) * ALPHA + bf4(Y0[j]) * (W0) + bf4(Y1[j]) * (W1); s1 += (v[j][0] + v[j][1]) + (v[j][2] + v[j][3]); } \
        const float mean = wave_sum(s1) * (1.f / D); float s2 = 0.f; \
        _Pragma("unroll") for (int j = 0; j < 8; ++j) { v[j] = v[j] - mean; s2 += (v[j][0] * v[j][0] + v[j][1] * v[j][1]) + (v[j][2] * v[j][2] + v[j][3] * v[j][3]); } \
        const float rstd = rsqrtf(wave_sum(s2) * (1.f / D) + 1e-5f); \
        _Pragma("unroll") for (int j = 0; j < 8; ++j) { const f32x4 o = v[j] * rstd * gg[j] + b4[j]; \
            *(f32x4*)(outF + ro + 256 * j) = o; if (l != DEPTH - 1) st4bf(XB + ro + 256 * j, o); } } } while (0)
    int t = opaque_bid() * 8 + wv;
    f32x4 gg[8], b4[8];
#pragma unroll
    for (int j = 0; j < 8; ++j) { gg[j] = *(const f32x4*)(g + 4 * lane + 256 * j); b4[j] = *(const f32x4*)(bb + 4 * lane + 256 * j); }
    int ra0, ra1, rb0, rb1; float wa0, wa1, wb0, wb1;
    LN2_META(t, ra0, ra1, wa0, wa1); LN2_META(t + tstride, rb0, rb1, wb0, wb1);
    for (; t < T; t += 2 * tstride) {
        u32x2 ha[8], ya0[8], ya1[8], hb[8], yb0[8], yb1[8];
        LN2_ROWS(t, ra0, ra1, ha, ya0, ya1); LN2_ROWS(t + tstride, rb0, rb1, hb, yb0, yb1);
        int na0, na1, nb0, nb1; float nwa0, nwa1, nwb0, nwb1;
        LN2_META(t + 2 * tstride, na0, na1, nwa0, nwa1); LN2_META(t + 3 * tstride, nb0, nb1, nwb0, nwb1);
        LN2_TOKEN(t, ha, ya0, ya1, wa0, wa1);
        LN2_TOKEN(t + tstride, hb, yb0, yb1, wb0, wb1);
        ra0 = na0; ra1 = na1; rb0 = nb0; rb1 = nb1; wa0 = nwa0; wa1 = nwa1; wb0 = nwb0; wb1 = nwb1;
    }
#undef LN2_META
#undef LN2_ROWS
#undef LN2_TOKEN
    __syncthreads();
}

template <bool GATED, int PMODE = 0>
__device__ __forceinline__ void moe_gemm(LAS unsigned char* ldsb, const int* tab, const unsigned* cnt, const int* LIST, const bf16_t* Asrc, const float* W0, const float* W1, bf16_t* Out) {
    constexpr int K = GATED ? D : FE, NT = K / 32, NCT = GATED ? FE / 64 : D / 128, LDW = GATED ? FE : D, LDO = GATED ? FE : D;
    constexpr int RBLK = MOE_RBLK, MT = RBLK / 64, NAG = RBLK / 64;
    static_assert(RBLK % 64 == 0 && (NAG == 6 || NAG == 5 || NAG == 3), "the counted waits below are written for 6, 5 or 3 A granules per thread");
    constexpr int ASLOT = RBLK * 128, BOFF = 2 * ASLOT, BBYTES = 32 * 256;
    const int tid = opaque_tid(), lane = tid & 63, wv = __builtin_amdgcn_readfirstlane(tid >> 6), wm = wv >> 1, wn = wv & 1, l15 = lane & 15, kq = lane >> 4;
    const unsigned lbase = (unsigned)(size_t)ldsb;
    const int arow = wm * (16 * MT) + l15;
    const unsigned afr = lbase + (unsigned)arow * 128u; const int asw = ((arow >> 1) & 7) ^ kq;
    const unsigned afa0 = afr + ((unsigned)(0 ^ asw) << 4), afa1 = afr + ((unsigned)(4 ^ asw) << 4);
    const int bq = (lane >> 2) & 3, bp = lane & 3, bkey = bq | ((kq & 1) << 2);
    const unsigned bfr = lbase + BOFF + (unsigned)(8 * kq + bq) * 256u + 8u * bp;
    unsigned bb[4];
#pragma unroll
    for (int j = 0; j < 4; ++j) { const int np = GATED ? ((j >> 1) * 4 + 2 * wn + (j & 1)) : (4 * wn + j); bb[j] = bfr + ((unsigned)(np ^ bkey) << 5); }
    const int sa_r = tid >> 3, sa_p = tid & 7;
    const int sb_k = tid >> 5, sb_n = 4 * (tid & 31);
    const int G = gridDim.x;
    const int NI = 64 * NCT;
#define MG_DECODE(i0_, e_, ct_) do { const int rnd = (i0_) / G, pos = (i0_) - rnd * G; int rank; \
      if ((G & 7) == 0 && ((G >> 3) % NCT) == 0 && (64 * NCT) % G == 0) { const int x = pos & 7, j = pos >> 3, epx = (G >> 3) / NCT;         \
          rank = rnd * (G / NCT) + x * epx + j / NCT; ct_ = j % NCT; if (rnd & 1) rank = rnd * (G / NCT) + (G / NCT - 1) - (x * epx + j / NCT); } \
      else { rank = (i0_) / NCT; ct_ = (i0_) % NCT; } \
      e_ = tab[240 + rank]; } while (0)
#define MG_AOFF(AO, e_, rb_, ce_, base_) do { _Pragma("unroll") for (int i = 0; i < NAG; ++i) { const int rl = i * 64 + sa_r, r = (rb_) * RBLK + rl; const int ch = sa_p ^ ((rl >> 1) & 7); \
            if (GATED) { const int rc_ = r < (ce_) ? r : ((ce_) > 0 ? (ce_) - 1 : 0); const int tok = LIST[(size_t)(e_) * ECAP + rc_] & (T - 1);     \
                AO[i] = (unsigned)tok * (unsigned)(K * 2) + ch * 16; } \
            else AO[i] = (unsigned)((base_) + r) * (unsigned)(K * 2) + ch * 16; } } while (0)
#define MG_WP(e_, ct_) ((GATED ? (sb_n < 64 ? W0 : W1) : W0) + (size_t)(e_) * K * LDW + (size_t)sb_k * LDW + (GATED ? (ct_) * 64 + (sb_n & 63) : (ct_) * 128 + sb_n))
#define MG_TROT(e_, ct_) ((((e_) * 5 + (ct_) * 9) & (NT - 1)) & ~1)
    int i0 = opaque_bid();
    if (i0 < NI) {
      int e, ct; MG_DECODE(i0, e, ct);
      int ce = (int)cnt[e], base = tab[80 + e], nrb = tab[160 + e] > 0 ? tab[160 + e] : 1, rb = 0;
      unsigned aoff[NAG], aoffn[NAG];
      MG_AOFF(aoff, e, rb, ce, base);
      const float* wp = MG_WP(e, ct); int trot = MG_TROT(e, ct);
      const float* wpn = wp; int trotn = trot;
      f32x4 rq0[2], rq1[2], rq2[2], rq3[2];
#define MG_ISSUE_A(t_, slot_) do { const bool nx_ = (t_) >= NT; const int ta_ = ((((nx_ ? (t_) - NT : (t_))) + (nx_ ? trotn : trot)) & (NT - 1)) >> 1;        \
            _Pragma("unroll") for (int i = 0; i < NAG; ++i) __builtin_amdgcn_global_load_lds((const unsigned*)((const unsigned char*)Asrc + (nx_ ? aoffn[i] : aoff[i]) + (PMODE == 1 ? 0 : ta_ * 128)), (LAS unsigned*)(ldsb + (slot_) * ASLOT + (i * 512 + wv * 64) * 16), 16, 0, 0); } while (0)
#define MG_ISSUE_B(RB, t_) do { const bool nx_ = (t_) >= NT; const int tb_ = ((nx_ ? (t_) - NT : (t_)) + (nx_ ? trotn : trot)) & (NT - 1); const float* wq_ = nx_ ? wpn : wp; \
            _Pragma("unroll") for (int i = 0; i < 2; ++i) asm volatile("global_load_dwordx4 %0, %1, off nt" : "=v"(RB[i]) : "v"(wq_ + (size_t)((PMODE == 2 ? 0 : tb_ * 32) + 16 * i) * LDW) : "memory"); } while (0)
#define MG_WAIT_ALL(n_) asm volatile("s_waitcnt vmcnt(" #n_ ")" : "+v"(rq0[0]), "+v"(rq0[1]), "+v"(rq1[0]), "+v"(rq1[1]), "+v"(rq2[0]), "+v"(rq2[1]), "+v"(rq3[0]), "+v"(rq3[1]) :: "memory")
#define MG_WRITE_B(RB, buf_) do { _Pragma("unroll") for (int i = 0; i < 2; ++i) { const int k = sb_k + 16 * i; u32x2 w; w.x = pkbf(RB[i][0], RB[i][1]); w.y = pkbf(RB[i][2], RB[i][3]); \
            *(LAS u32x2*)(ldsb + BOFF + (buf_) * BBYTES + k * 256 + ((((sb_n >> 4) ^ ((k & 3) | (((k >> 3) & 1) << 2)))) << 5) + (sb_n & 15) * 2) = w; } } while (0)
#define TRRD(dst, addr, off) asm volatile("ds_read_b64_tr_b16 %0, %1 offset:%2" : "=&v"(dst) : "v"(addr), "i"(off) : "memory")
#define ARD(dst, addr, off) asm volatile("ds_read_b128 %0, %1 offset:%2" : "=&v"(dst) : "v"(addr), "i"(off) : "memory")
#define MG_COMPUTE(slot_, half_, buf_) do { if (PMODE != 0) break; \
            s16x4 b0l, b0h, b1l, b1h, b2l, b2h, b3l, b3h; \
            TRRD(b0l, bb[0], (buf_) * BBYTES); TRRD(b0h, bb[0], (buf_) * BBYTES + 1024); TRRD(b1l, bb[1], (buf_) * BBYTES); TRRD(b1h, bb[1], (buf_) * BBYTES + 1024); \
            TRRD(b2l, bb[2], (buf_) * BBYTES); TRRD(b2h, bb[2], (buf_) * BBYTES + 1024); TRRD(b3l, bb[3], (buf_) * BBYTES); TRRD(b3h, bb[3], (buf_) * BBYTES + 1024); \
              \
            bf16x8 af[MT]; { const unsigned ad_ = (half_) ? afa1 : afa0; \
              ARD(af[0], ad_, (slot_) * ASLOT + 0 * 2048); ARD(af[1], ad_, (slot_) * ASLOT + 1 * 2048); ARD(af[2], ad_, (slot_) * ASLOT + 2 * 2048); \
              if constexpr (MT > 3) { ARD(af[3 % MT], ad_, (slot_) * ASLOT + 3 * 2048); ARD(af[4 % MT], ad_, (slot_) * ASLOT + 4 * 2048); } \
              if constexpr (MT > 5) { ARD(af[5 % MT], ad_, (slot_) * ASLOT + 5 * 2048); } } \
            asm volatile("s_waitcnt lgkmcnt(0)" ::: "memory"); __builtin_amdgcn_sched_barrier(0); \
            const bf16x8 bf0 = {b0l[0], b0l[1], b0l[2], b0l[3], b0h[0], b0h[1], b0h[2], b0h[3]}, bf1 = {b1l[0], b1l[1], b1l[2], b1l[3], b1h[0], b1h[1], b1h[2], b1h[3]}; \
            const bf16x8 bf2 = {b2l[0], b2l[1], b2l[2], b2l[3], b2h[0], b2h[1], b2h[2], b2h[3]}, bf3 = {b3l[0], b3l[1], b3l[2], b3l[3], b3h[0], b3h[1], b3h[2], b3h[3]}; \
            _Pragma("unroll") for (int m = 0; m < MT; ++m) if (m < mlim) { \
                acc[m][0] = __builtin_amdgcn_mfma_f32_16x16x32_bf16(af[m], bf0, acc[m][0], 0, 0, 0); acc[m][1] = __builtin_amdgcn_mfma_f32_16x16x32_bf16(af[m], bf1, acc[m][1], 0, 0, 0); \
                acc[m][2] = __builtin_amdgcn_mfma_f32_16x16x32_bf16(af[m], bf2, acc[m][2], 0, 0, 0); acc[m][3] = __builtin_amdgcn_mfma_f32_16x16x32_bf16(af[m], bf3, acc[m][3], 0, 0, 0); } } while (0)
#define MG_STEP_EVEN(t_, s0_, RBNEW, RBNEXT) do { \
            MG_ISSUE_A((t_) + 2, (((s0_) >> 1) + 1) & 1); MG_ISSUE_B(RBNEW, (t_) + 4); \
            MG_COMPUTE(((s0_) >> 1) & 1, 0, (s0_) & 1); \
            if constexpr (NAG == 6) MG_WAIT_ALL(12); else if constexpr (NAG == 5) MG_WAIT_ALL(11); else MG_WAIT_ALL(9); \
            MG_WRITE_B(RBNEXT, ((s0_) + 1) & 1); \
            asm volatile("s_waitcnt lgkmcnt(0)" ::: "memory"); \
            __builtin_amdgcn_s_barrier(); } while (0)
#define MG_STEP_ODD(t_, s0_, RBNEW, RBNEXT) do { \
            MG_ISSUE_B(RBNEW, (t_) + 4); \
            MG_COMPUTE(((s0_) >> 1) & 1, 1, (s0_) & 1); \
            MG_WAIT_ALL(4); \
            MG_WRITE_B(RBNEXT, ((s0_) + 1) & 1); \
            asm volatile("s_waitcnt lgkmcnt(0)" ::: "memory"); \
            __builtin_amdgcn_s_barrier(); } while (0)
      asm volatile("s_waitcnt lgkmcnt(0)" ::: "memory");
      __builtin_amdgcn_s_barrier();
      MG_ISSUE_A(0, 0); MG_ISSUE_B(rq0, 0); MG_ISSUE_B(rq1, 1); MG_ISSUE_B(rq2, 2); MG_ISSUE_B(rq3, 3);
      MG_WAIT_ALL(6);
      MG_WRITE_B(rq0, 0);
      asm volatile("s_waitcnt lgkmcnt(0)" ::: "memory");
      __builtin_amdgcn_s_barrier();
#pragma unroll 1
      for (;;) {
        int en = e, ctn = ct, cen = ce, basen = base, nrbn = nrb, rbn = rb, i0n = i0; bool last = false;
        if (rb + 1 < nrb) rbn = rb + 1;
        else if (i0 + G < NI) { i0n = i0 + G; MG_DECODE(i0n, en, ctn); cen = (int)cnt[en]; basen = tab[80 + en]; nrbn = tab[160 + en] > 0 ? tab[160 + en] : 1; rbn = 0; }
        else last = true;
        MG_AOFF(aoffn, en, rbn, cen, basen);
        wpn = MG_WP(en, ctn); trotn = MG_TROT(en, ctn);
#pragma unroll
        for (int i = 0; i < NAG; ++i) asm volatile("" : "+v"(aoffn[i]));
        int mlim = (ce - rb * RBLK - wm * (16 * MT) + 15) >> 4; mlim = mlim < 0 ? 0 : (mlim > MT ? MT : mlim); mlim = __builtin_amdgcn_readfirstlane(mlim);
        f32x4 acc[MT][4];
#pragma unroll
        for (int m = 0; m < MT; ++m)
#pragma unroll
            for (int n = 0; n < 4; ++n) acc[m][n] = (f32x4){0.f, 0.f, 0.f, 0.f};
#pragma unroll 1
        for (int t = 0; t < NT; t += 4) {
            MG_STEP_EVEN(t, 0, rq0, rq1); MG_STEP_ODD(t + 1, 1, rq1, rq2); MG_STEP_EVEN(t + 2, 2, rq2, rq3); MG_STEP_ODD(t + 3, 3, rq3, rq0);
        }
#pragma unroll
        for (int m = 0; m < MT; ++m)
#pragma unroll
            for (int g = 0; g < 4; ++g) {
                const int r = rb * RBLK + wm * (16 * MT) + 16 * m + 4 * kq + g;
                if (r < ce) {
                    if (GATED) {
#pragma unroll
                        for (int j = 0; j < 2; ++j) { const float gv = acc[m][j][g], uv = acc[m][2 + j][g];
                            Out[(size_t)(base + r) * LDO + ct * 64 + 32 * wn + 16 * j + l15] = f2bf(gv / (1.f + __expf(-gv)) * uv); }
                    } else {
#pragma unroll
                        for (int n = 0; n < 4; ++n) Out[(size_t)(base + r) * LDO + ct * 128 + 64 * wn + 16 * n + l15] = f2bf(acc[m][n][g]);
                    }
                }
            }
        if (last) break;
        e = en; ct = ctn; ce = cen; base = basen; nrb = nrbn; rb = rbn; i0 = i0n; wp = wpn; trot = trotn;
#pragma unroll
        for (int i = 0; i < NAG; ++i) aoff[i] = aoffn[i];
      }
      MG_WAIT_ALL(0);
#undef MG_STEP_EVEN
#undef MG_STEP_ODD
#undef MG_ISSUE_A
#undef MG_ISSUE_B
#undef MG_WAIT_ALL
#undef MG_WRITE_B
#undef MG_COMPUTE
#undef ARD
#undef TRRD
    }
#undef MG_DECODE
#undef MG_AOFF
#undef MG_WP
#undef MG_TROT
    __syncthreads();
}
template <int PMODE>
__device__ __forceinline__ void p_moe1_mfma(LAS unsigned char* ldsb, unsigned char* ws, const float* w_eg, const float* w_eu, int l, int lc) {
    const unsigned* cnt = (const unsigned*)(ws + WS_CNT) + lc * 64;
    int* tab = (int*)((unsigned char*)ldsb + 120 * 1024);
    __syncthreads();
    moe_tables256(tab, cnt, FE / 64);
    moe_gemm<true, PMODE>(ldsb, tab, cnt, (const int*)(ws + WS_LIST), (const bf16_t*)(ws + WS_H1B), w_eg + (size_t)l * NE * D * FE, w_eu + (size_t)l * NE * D * FE, (bf16_t*)(ws + WS_HID));
}
__device__ __forceinline__ void p_moe2_mfma(LAS unsigned char* ldsb, unsigned char* ws, const float* w_ed, int l) {
    const unsigned* cnt = (const unsigned*)(ws + WS_CNT) + l * 64;
    int* tab = (int*)((unsigned char*)ldsb + 120 * 1024);
    __syncthreads();
    moe_tables256(tab, cnt, D / 128);
    moe_gemm<false>(ldsb, tab, cnt, nullptr, (const bf16_t*)(ws + WS_HID), w_ed + (size_t)l * NE * FE * D, nullptr, (bf16_t*)(ws + WS_YE));
}

constexpr int NPH = 10;
#ifndef PH_MASK
#define PH_MASK 0x7ff
#endif
#define PHON(k) ((PH_MASK >> (k)) & 1)
#ifndef REP_PHASE
#define REP_PHASE -1
#endif
#ifndef STAMP_A
#define STAMP_A -1
#define STAMP_B -1
#endif
#define REPS(k) for (int rep_ = 0; rep_ < ((REP_PHASE == (k)) ? 2 : 1); ++rep_)
template <class Tp> __device__ __forceinline__ Tp* as_global(Tp* p) {
    __attribute__((address_space(1))) Tp* g = (__attribute__((address_space(1))) Tp*)p; asm volatile("" : "+s"(g)); return (Tp*)g; }
typedef const Params __attribute__((address_space(4))) CParams;
#define KP(field) ({ CParams* _k = kp; asm volatile("" : "+s"(_k)); _k->field; })
__global__ void __launch_bounds__(NTHREADS, 2) hybrid_fwd(Params p_unused, int ph_lo, int ph_hi) {
    extern __shared__ __attribute__((aligned(16))) unsigned char lds_raw[];
    float* lds = (float*)lds_raw;
    LAS unsigned char* ldsb = (LAS unsigned char*)lds_raw;
    CParams* kp = (CParams*)__builtin_amdgcn_kernarg_segment_ptr();
    unsigned char* const ws0 = KP(ws);
    volatile LAS unsigned* xbw = (volatile LAS unsigned*)(lds_raw + LDS_BYTES - 16);
    if (threadIdx.x == 0) { xbw[0] = 0u; xbw[1] = 0u; xbw[2] = 0u; xbw[3] = 0u; }
    __syncthreads();
    XcdBarrier bar; bar.bar = (unsigned*)(ws0 + WS_BAR); bar.x = 0; bar.st = xbw;
    if (ph_lo < ph_hi) bar = xcd_barrier_post((unsigned*)(ws0 + WS_BAR), xbw);
#define IN(ph) ((ph) >= ph_lo && (ph) <= ph_hi)
#define GRID_BAR(ph) do { if ((ph) >= ph_lo && (ph) < ph_hi) xcd_barrier(bar); \
    if (STAMP_A >= 0 && blockIdx.x == 0 && threadIdx.x == 0) ((volatile unsigned long long*)(ws0 + WS_BAR + 14800))[(ph) + 1] = __builtin_amdgcn_s_memrealtime(); } while (0)
    if (STAMP_A >= 0 && blockIdx.x == 0 && threadIdx.x == 0) ((volatile unsigned long long*)(ws0 + WS_BAR + 14800))[0] = __builtin_amdgcn_s_memrealtime();
    if (PHON(0) && IN(0)) REPS(0) { unsigned char* ws = ws0; asm volatile("" : "+s"(ws)); ws = as_global(ws); { Params q; q.ws = ws; q.x = as_global(KP(x)); q.pos = as_global(KP(pos)); q.w_in = as_global(KP(w_in)); q.g_q = as_global(KP(g_q)); q.w_qb = as_global(KP(w_qb)); q.g_kv = as_global(KP(g_kv)); q.w_kvb = as_global(KP(w_kvb));
        q.w_oa = as_global(KP(w_oa)); q.w_ob = as_global(KP(w_ob)); q.w_out = as_global(KP(w_out)); q.ln1g = as_global(KP(ln1g)); q.ln1b = as_global(KP(ln1b)); q.w_router = as_global(KP(w_router)); q.w_group = as_global(KP(w_group)); q.b_router = as_global(KP(b_router)); q.b_group = as_global(KP(b_group)); if (REP_PHASE >= 31 && REP_PHASE <= 34) p_prologue(ldsb, q, 1 << (REP_PHASE - 31)); p_prologue(ldsb, q); } }
    int lfirst = -1; asm volatile("" : "+s"(lfirst));
    for (int l = lfirst; l < DEPTH; ++l) {
        const int pb = l * NPH;
        if (l >= 0 && PHON(1) && IN(pb + 1)) REPS(1) { unsigned char* ws = ws0; asm volatile("" : "+s"(ws)); ws = as_global(ws);
            EpiIn E; E.ws = ws;
            pg8::Gemm g{(const bf16_t*)(ws + WS_XB), (const bf16_t*)(ws + WS_WIN_T) + (size_t)l * INP * D, T, INP, D}; pg8::StaticOrder SO; SO.init(T, INP, (int)gridDim.x, opaque_bid());
            pg8::gemm_phase<EpiIn, pg8::StaticOrder, true, true>(ldsb, g, SO, E);
        }
        if ((l < 0 ? (PHON(0) && IN(0)) : (PHON(1) && IN(pb + 1)))) { unsigned char* ws = ws0; asm volatile("" : "+s"(ws)); ws = as_global(ws);
            const int G_ = (int)gridDim.x, nfull = l < 0 ? 0 : ((T / 256) * (INP / 256)) % G_, bid_ = opaque_bid();
            if (l < 0 || (nfull > 0 && bid_ >= nfull)) { __syncthreads();
                Params q; q.ws = ws; q.w_in = as_global(KP(w_in)); q.g_q = as_global(KP(g_q)); q.w_qb = as_global(KP(w_qb)); q.g_kv = as_global(KP(g_kv)); q.w_kvb = as_global(KP(w_kvb));
                q.w_oa = as_global(KP(w_oa)); q.w_ob = as_global(KP(w_ob)); q.w_out = as_global(KP(w_out));
                constexpr int WC_IN = (D / 64) * (INP / 64), WC_ALL = WC_IN + (512 / 64) * (1536 / 64) + (512 / 64) * (2048 / 64) + 2 * (1024 / 64) * (D / 64) + (D / 64) * (D / 64);
                const int a_l1 = l < 0 ? 0 : l, a_lo1 = l < 0 ? 0 : WC_IN, a_hi1 = l < 0 ? WC_IN : WC_ALL, a_l2 = l + 1, a_hi2 = (l >= 0 && l + 1 < DEPTH) ? WC_IN : 0;
                p_wcopies(ldsb, q, a_l1, a_lo1, a_hi1, a_l2, 0, a_hi2, bid_ - nfull, G_ - nfull); } }
        GRID_BAR(l < 0 ? 0 : pb + 1);
        if (l < 0) continue;
        if (PHON(2) && IN(pb + 2)) REPS(2) { unsigned char* ws = ws0; asm volatile("" : "+s"(ws)); ws = as_global(ws);
            { EpiQA E; E.ws = ws;
              pg8::Gemm g{(const bf16_t*)(ws + WS_CQ), (const bf16_t*)(ws + WS_WQB_T) + (size_t)l * 1536 * 512, T, 1536, 512}; pg8::StaticOrder SO; SO.init(T, 1536, (int)gridDim.x, opaque_bid());
              pg8::gemm_phase<EpiQA, pg8::StaticOrder, true, true>(ldsb, g, SO, E); }
            { EpiKV E; E.ws = ws;
              pg8::Gemm g{(const bf16_t*)(ws + WS_CKV), (const bf16_t*)(ws + WS_WKVB_T) + (size_t)l * 2048 * 512, T, 2048, 512}; pg8::StaticOrder SO; SO.init(T, 2048, (int)gridDim.x, opaque_bid());
              pg8::gemm_phase<EpiKV, pg8::StaticOrder, true, true>(ldsb, g, SO, E); }
            REPS(12) p_score(ldsb, ws);
        }
        GRID_BAR(pb + 2);
        if (PHON(3) && IN(pb + 3)) REPS(3) { unsigned char* ws = ws0; asm volatile("" : "+s"(ws)); ws = as_global(ws); p_select(ws); }
        GRID_BAR(pb + 3);
        if (PHON(4) && IN(pb + 4)) REPS(4) { unsigned char* ws = ws0; asm volatile("" : "+s"(ws)); ws = as_global(ws);
            if (REP_PHASE == 14) p_attn<1>(ldsb, ws); if (REP_PHASE == 15) p_attn<2>(ldsb, ws); if (REP_PHASE == 16) p_attn<3>(ldsb, ws);
            p_attn<0>(ldsb, ws);
        }
        GRID_BAR(pb + 4);
        if (PHON(5) && IN(pb + 5)) REPS(5) { unsigned char* ws = ws0; asm volatile("" : "+s"(ws)); ws = as_global(ws);
            pg8::StaticOrder SO; SO.init(T, D, (int)gridDim.x, opaque_bid());
            { EpiYA E; E.ws = ws;
              pg8::Gemm g{(const bf16_t*)(ws + WS_OA), (const bf16_t*)(ws + WS_WOA_T) + (size_t)l * D * 1024, T, D, 1024};
              pg8::gemm_phase<EpiYA, pg8::StaticOrder, true, true>(ldsb, g, SO, E); }
            { EpiYB E; E.ws = ws;
              pg8::Gemm g{(const bf16_t*)(ws + WS_OB), (const bf16_t*)(ws + WS_WOB_T) + (size_t)l * D * 1024, T, D, 1024};
              pg8::gemm_phase<EpiYB, pg8::StaticOrder, true, true>(ldsb, g, SO, E); }
        }
        GRID_BAR(pb + 5);
        if (PHON(6) && IN(pb + 6)) REPS(6) { unsigned char* ws = ws0; asm volatile("" : "+s"(ws)); ws = as_global(ws);
            EpiOut E; E.hin = (l == 0) ? as_global(KP(x)) : (const float*)(ws + WS_H2F); E.V1 = (float*)(ws + WS_V1);
            pg8::Gemm g{(const bf16_t*)(ws + WS_Y), (const bf16_t*)(ws + WS_WOUT_T) + (size_t)l * D * D, T, D, D}; pg8::StaticOrder SO; SO.init(T, D, (int)gridDim.x, opaque_bid());
            pg8::gemm_phase<EpiOut, pg8::StaticOrder, true, true>(ldsb, g, SO, E);
        }
        GRID_BAR(pb + 6);
        if (PHON(7) && IN(pb + 7)) REPS(7) { unsigned char* ws = ws0; asm volatile("" : "+s"(ws)); ws = as_global(ws); if (REP_PHASE == 21) p_ln1_route3<1>(ldsb, ws, as_global(KP(ln1g)) + (size_t)l * D, as_global(KP(ln1b)) + (size_t)l * D, l); if (REP_PHASE == 22) p_ln1_route3<2>(ldsb, ws, as_global(KP(ln1g)) + (size_t)l * D, as_global(KP(ln1b)) + (size_t)l * D, l);
            p_ln1_route3<0>(ldsb, ws, as_global(KP(ln1g)) + (size_t)l * D, as_global(KP(ln1b)) + (size_t)l * D, l); }
        GRID_BAR(pb + 7);
        if (PHON(8) && IN(pb + 8)) REPS(8) { unsigned char* ws = ws0; asm volatile("" : "+s"(ws)); ws = as_global(ws); if (REP_PHASE == 18) p_moe1_mfma<0>(ldsb, ws, as_global(KP(w_eg)), as_global(KP(w_eu)), l ^ 1, l); if (REP_PHASE == 19) p_moe1_mfma<1>(ldsb, ws, as_global(KP(w_eg)), as_global(KP(w_eu)), l ^ 1, l); if (REP_PHASE == 20) p_moe1_mfma<2>(ldsb, ws, as_global(KP(w_eg)), as_global(KP(w_eu)), l ^ 1, l);
            p_moe1_mfma<0>(ldsb, ws, as_global(KP(w_eg)), as_global(KP(w_eu)), l, l); }
        GRID_BAR(pb + 8);
        if (PHON(9) && IN(pb + 9)) REPS(9) { unsigned char* ws = ws0; asm volatile("" : "+s"(ws)); ws = as_global(ws); p_moe2_mfma(ldsb, ws, as_global(KP(w_ed)), l); }
        GRID_BAR(pb + 9);
        if (PHON(10) && IN(pb + 10)) REPS(10) { unsigned char* ws = ws0; asm volatile("" : "+s"(ws)); ws = as_global(ws); p_ln2v2(ldsb, ws, as_global(KP(ln1g)) + (size_t)l * D, as_global(KP(ln1b)) + (size_t)l * D, as_global(KP(ln2g)) + (size_t)l * D, as_global(KP(ln2b)) + (size_t)l * D, (l == DEPTH - 1) ? as_global(KP(out)) : (float*)(ws + WS_H2F), l); }
        GRID_BAR(pb + 10);
    }
    if (STAMP_A >= 0) {
        if (ph_lo < ph_hi) xcd_barrier(bar);
        if (blockIdx.x == 0) {
            volatile unsigned long long* st = (volatile unsigned long long*)(ws0 + WS_BAR + 14800);
            if (threadIdx.x == 0) st[DEPTH * NPH + 1] = __builtin_amdgcn_s_memrealtime();
            __syncthreads();
            float da = 0.f, db = 0.f;
            for (int l = 0; l < DEPTH; ++l) {
                if (STAMP_A == 0) { if (l == 0) da += (float)(st[1] - st[0]); } else da += (float)(st[l * NPH + STAMP_A + 1] - st[l * NPH + STAMP_A]);
                if (STAMP_B == 0) { if (l == 0) db += (float)(st[1] - st[0]); } else if (STAMP_B > 0) db += (float)(st[l * NPH + STAMP_B + 1] - st[l * NPH + STAMP_B]);
            }
            da *= 0.01f; db *= 0.01f;
            float* o = as_global(KP(out));
            for (int i = threadIdx.x; i < 65536; i += NTHREADS) o[i] = sqrtf(da);
            if (threadIdx.x == 0 && STAMP_B >= 0) o[70000] = db;
        }
    }
}

#ifndef MK_ONE_LAUNCH
#define MK_ONE_LAUNCH 1
#endif
extern "C" void kernel_launch(void* const* d_in, const int* in_sizes, int n_in, void* d_out, int out_size, void* d_ws, size_t ws_size, hipStream_t stream) {
    static int grid = 0;
    if (!grid) {
        if (n_in != 21 || in_sizes[0] != T * D || out_size != T * D || ws_size < WS_END) {
            fprintf(stderr, "kernel_launch: unexpected shapes (n_in %d, in0 %d, out %d, ws %zu, need %zu); nothing launched\n", n_in, n_in > 0 ? in_sizes[0] : -1, out_size, ws_size, (size_t)WS_END);
            grid = -1; return; }
        int dev = 0, cus = 0, per_cu = 0;
        hipGetDevice(&dev); hipDeviceGetAttribute(&cus, hipDeviceAttributeMultiprocessorCount, dev);
        if (hipFuncSetAttribute((const void*)hybrid_fwd, hipFuncAttributeMaxDynamicSharedMemorySize, LDS_BYTES) != hipSuccess) { fprintf(stderr, "kernel_launch: hipFuncSetAttribute failed\n"); grid = -1; return; }
        hipOccupancyMaxActiveBlocksPerMultiprocessor(&per_cu, (const void*)hybrid_fwd, NTHREADS, LDS_BYTES);
        if (per_cu < 1) fprintf(stderr, "kernel_launch: occupancy query reports %d blocks per CU\n", per_cu);
        grid = cus > 0 ? cus : 256;
    }
    if (grid < 0) return;
    hipMemsetAsync((char*)d_ws, 0, WS_CTL_END, stream);
    Params p{};
    p.x = (const float*)d_in[0]; p.pos = (const int*)d_in[1];
    p.w_in = (const float*)d_in[2]; p.g_q = (const float*)d_in[3]; p.w_qb = (const float*)d_in[4]; p.g_kv = (const float*)d_in[5]; p.w_kvb = (const float*)d_in[6];
    p.w_oa = (const float*)d_in[7]; p.w_ob = (const float*)d_in[8]; p.w_out = (const float*)d_in[9]; p.ln1g = (const float*)d_in[10]; p.ln1b = (const float*)d_in[11];
    p.w_group = (const float*)d_in[12]; p.b_group = (const float*)d_in[13]; p.w_router = (const float*)d_in[14]; p.b_router = (const float*)d_in[15];
    p.w_eg = (const float*)d_in[16]; p.w_eu = (const float*)d_in[17]; p.w_ed = (const float*)d_in[18]; p.ln2g = (const float*)d_in[19]; p.ln2b = (const float*)d_in[20];
    p.out = (float*)d_out; p.ws = (unsigned char*)d_ws;
#if MK_ONE_LAUNCH
    hipLaunchKernelGGL(hybrid_fwd, dim3(grid), dim3(NTHREADS), LDS_BYTES, stream, p, 0, DEPTH * NPH);
#else
    for (int ph = 0; ph <= DEPTH * NPH; ++ph) hipLaunchKernelGGL(hybrid_fwd, dim3(grid), dim3(NTHREADS), LDS_BYTES, stream, p, ph, ph);
#endif
}
```
